# Optimizing an MI355X kernel written in HIP

```python
import jax, jax.numpy as jnp
from jax import lax
import numpy as np

D_MODEL = 2048
BATCH = 2
SEQ = 4096
DEPTH = 4

GRID_W = 64
CTX_LEN = 256
EPS = 1e-6
N_MOD = 6
D_FF = 4 * D_MODEL
N_EVEN = (DEPTH + 1) // 2
N_ODD = DEPTH // 2

D_LRU = D_MODEL // 2
LRU_HEADS = 8
LRU_HEAD_DIM = D_LRU // LRU_HEADS
CONV_W = 4
CONV_LEFT = CONV_W // 2
LRU_C = 8.0

MLA_HEADS = 8
QK_NOPE = 128
QK_ROPE = 64
V_HEAD = 128
Q_LORA = 512
KV_LORA = 512
ROPE_BASE = 10000.0
Q_BLOCK = 128
ATTN_SCALE = (QK_NOPE + QK_ROPE) ** -0.5
D_MLA_OUT = MLA_HEADS * V_HEAD
D_AB_IN = 2 * D_LRU + Q_LORA + KV_LORA + QK_ROPE
D_AB_OUT = D_LRU + D_MLA_OUT

HG_EXPAND = 128
HG_HEADS = D_MODEL // HG_EXPAND
HG_DK = HG_EXPAND
HG_DV = D_MODEL // HG_HEADS
D_HG = HG_HEADS * HG_DK
D_HG_V = HG_HEADS * HG_DV
D_HG_IN = 3 * D_HG + 2 * D_HG_V
HG_CHUNK = 64

kernel_name = "hybrid_rglru_mla_hgrn2_diffusion_block"


def _same(t):
    return t


def _flip_seq(t):
    return jnp.flip(t, axis=1)


def rms_norm(x, w):
    xf = x.astype(jnp.float32)
    y = xf * lax.rsqrt(jnp.mean(xf * xf, axis=-1, keepdims=True) + EPS)
    return (y * w.astype(jnp.float32)).astype(x.dtype)


def modulate(h, shift, scale):
    return h * (1 + scale) + shift


def ada_params(cond, w, b):
    m = jnp.einsum('...d,de->...e', jax.nn.silu(cond), w) + b
    return jnp.split(m[..., None, :], N_MOD, axis=-1)


def squared_relu_mlp(h, w1, w2):
    return jnp.square(jax.nn.relu(h @ w1)) @ w2


def axial_rope_tables(row, col):
    half = QK_ROPE // 2
    inv_freq = ROPE_BASE ** (-jnp.arange(0, half, 2, dtype=jnp.float32) / half)
    ang_r = row.astype(jnp.float32)[:, None] * inv_freq
    ang_c = col.astype(jnp.float32)[:, None] * inv_freq
    ang = jnp.concatenate([ang_r, ang_r, ang_c, ang_c], axis=-1)
    return jnp.cos(ang), jnp.sin(ang)


def apply_rope(x, cos, sin):
    q = QK_ROPE // 4
    rot = jnp.concatenate([-x[..., q:2 * q], x[..., :q], -x[..., 3 * q:], x[..., 2 * q:3 * q]], axis=-1)
    return (x * cos + rot * sin).astype(x.dtype)


def dwconv_centred(u, w, b):
    T = u.shape[1]
    up = jnp.pad(u, ((0, 0), (CONV_LEFT, CONV_W - 1 - CONV_LEFT), (0, 0)))
    taps = [up[:, j:j + T] * w[j] for j in range(CONV_W)]
    return sum(taps[1:], taps[0]) + b


def linear_scan(a, b, h0):
    b = b.at[:, 0].add(a[:, 0] * h0)

    def combine(l, r):
        al, bl = l
        ar, br = r
        return al * ar, ar * bl + br

    _, h = lax.associative_scan(combine, (a, b), axis=1)
    return h


def rglru_gates(u, w_a, b_a, w_x, b_x, lam):
    uh = u.reshape(u.shape[:-1] + (LRU_HEADS, LRU_HEAD_DIM))
    r = jax.nn.sigmoid(jnp.einsum('bthd,hde->bthe', uh, w_a).reshape(u.shape) + b_a)
    i = jax.nn.sigmoid(jnp.einsum('bthd,hde->bthe', uh, w_x).reshape(u.shape) + b_x)
    log_a = -LRU_C * r * jax.nn.softplus(-lam)
    a = jnp.exp(log_a)
    b = jnp.sqrt(-jnp.expm1(2.0 * log_a)) * (i * u)
    return a, b


def rglru_bidir(uc, ux, w_a, b_a, w_x, b_x, lam, need_ctx):
    hc_dirs, hx_dirs = [], []
    for d in range(2):
        rev = _flip_seq if d == 1 else _same
        a, b = rglru_gates(rev(uc), w_a[d], b_a[d], w_x[d], b_x[d], lam[d])
        h_c = linear_scan(a, b, jnp.zeros_like(b[:, 0]))
        a, b = rglru_gates(rev(ux), w_a[d], b_a[d], w_x[d], b_x[d], lam[d])
        h_x = linear_scan(a, b, h_c[:, -1])
        hx_dirs.append(rev(h_x))
        if need_ctx:
            hc_dirs.append(rev(h_c))
    h_c_sum = hc_dirs[0] + hc_dirs[1] if need_ctx else None
    return h_c_sum, hx_dirs[0] + hx_dirs[1]


def mla_queries(pq, norm_w, w_uq):
    B, T = pq.shape[:2]
    q = (rms_norm(pq, norm_w) @ w_uq).reshape(B, T, MLA_HEADS, QK_NOPE + QK_ROPE)
    return q[..., :QK_NOPE], q[..., QK_NOPE:]


def mla_keys_values(pkv, norm_w, w_ukv):
    B, T = pkv.shape[:2]
    kv = (rms_norm(pkv, norm_w) @ w_ukv).reshape(B, T, MLA_HEADS, QK_NOPE + V_HEAD)
    return kv[..., :QK_NOPE], kv[..., QK_NOPE:]


def blocked_attention(qn, qr, kn, kr, v):
    B, T = qn.shape[:2]
    nb = T // Q_BLOCK

    def blocks(t):
        return jnp.swapaxes(t.reshape((B, nb, Q_BLOCK) + t.shape[2:]), 0, 1)

    def attend(blk):
        qn_i, qr_i = blk
        s = jnp.einsum('bqhd,bkhd->bhqk', qn_i, kn) + jnp.einsum('bqhr,bkr->bhqk', qr_i, kr)
        p = jax.nn.softmax(s.astype(jnp.float32) * ATTN_SCALE, axis=-1).astype(v.dtype)
        return jnp.einsum('bhqk,bkhd->bqhd', p, v)

    o = lax.map(attend, (blocks(qn), blocks(qr)))
    return jnp.swapaxes(o, 0, 1).reshape(B, T, D_MLA_OUT)


def split_ab(p):
    return jnp.split(p, [D_LRU, 2 * D_LRU, 2 * D_LRU + Q_LORA, 2 * D_LRU + Q_LORA + KV_LORA], axis=-1)


def mixer_ab(hc, hx, cos, sin, w_in, w_out, conv_w, conv_b, w_a, b_a, w_x, b_x, lam,
             q_norm_w, w_uq, kv_norm_w, w_ukv, need_ctx):
    gate_c, u_c, cq_c, ckv_c, kr_c = split_ab(hc @ w_in)
    gate_x, u_x, cq_x, ckv_x, kr_x = split_ab(hx @ w_in)
    uc = dwconv_centred(u_c, conv_w, conv_b).astype(jnp.float32)
    ux = dwconv_centred(u_x, conv_w, conv_b).astype(jnp.float32)
    h_c, h_x = rglru_bidir(uc, ux, w_a, b_a, w_x, b_x, lam, need_ctx)
    ya_x = (h_x * jax.nn.gelu(gate_x.astype(jnp.float32))).astype(hx.dtype)
    kn_c, v_c = mla_keys_values(ckv_c, kv_norm_w, w_ukv)
    kn_x, v_x = mla_keys_values(ckv_x, kv_norm_w, w_ukv)
    qn_x, qr_x = mla_queries(cq_x, q_norm_w, w_uq)
    qr_x = apply_rope(qr_x, cos[:, None], sin[:, None])
    kr_x = apply_rope(kr_x, cos, sin)
    yb_x = blocked_attention(qn_x, qr_x,
                             jnp.concatenate([kn_x, kn_c], axis=1),
                             jnp.concatenate([kr_x, kr_c], axis=1),
                             jnp.concatenate([v_x, v_c], axis=1))
    out_x = jnp.concatenate([ya_x, yb_x], axis=-1) @ w_out
    if not need_ctx:
        return None, out_x
    ya_c = (h_c * jax.nn.gelu(gate_c.astype(jnp.float32))).astype(hc.dtype)
    qn_c, qr_c = mla_queries(cq_c, q_norm_w, w_uq)
    yb_c = blocked_attention(qn_c, qr_c, kn_c, kr_c, v_c)
    out_c = jnp.concatenate([ya_c, yb_c], axis=-1) @ w_out
    return out_c, out_x


def hgrn2_scan(q, k, logf, v, s0):
    B, T = k.shape[:2]
    nc = T // HG_CHUNK
    with_out = q is not None

    def to_chunks(t):
        return t.reshape(B, nc, HG_CHUNK, HG_HEADS, t.shape[-1]).transpose(1, 0, 3, 2, 4)

    causal = jnp.tril(jnp.ones((HG_CHUNK, HG_CHUNK), dtype=bool))[:, :, None]

    def step(s, blk):
        kc, gc, vc = blk[0], blk[1], blk[2]
        bcum = jnp.cumsum(gc, axis=2)
        b_last = bcum[:, :, -1:]
        s_new = (jnp.exp(b_last[:, :, 0])[..., None] * s
                 + jnp.einsum('bhsd,bhse->bhde', kc * jnp.exp(b_last - bcum), vc))
        if not with_out:
            return s_new, None
        qc = blk[3]
        o_inter = jnp.einsum('bhtd,bhde->bhte', qc * jnp.exp(bcum), s)
        diff = bcum[:, :, :, None, :] - bcum[:, :, None, :, :]
        decay = jnp.exp(jnp.where(causal, diff, -jnp.inf))
        attn = jnp.einsum('bhtd,bhsd,bhtsd->bhts', qc, kc, decay)
        o_intra = jnp.einsum('bhts,bhse->bhte', attn, vc)
        return s_new, o_inter + o_intra

    xs = (to_chunks(k), to_chunks(logf), to_chunks(v)) + ((to_chunks(q),) if with_out else ())
    s_fin, o = lax.scan(step, s0, xs)
    if with_out:
        o = o.transpose(1, 0, 3, 2, 4).reshape(B, T, HG_HEADS, HG_DV)
    return o, s_fin


def hgrn2_project(h, w_in, lb):
    B, T = h.shape[:2]
    p = (h @ w_in).astype(jnp.float32)
    q, f_fwd, f_bwd, i, g = jnp.split(p, [D_HG, 2 * D_HG, 3 * D_HG, 3 * D_HG + D_HG_V], axis=-1)

    def heads(t):
        return t.reshape(B, T, HG_HEADS, -1)

    dirs = []
    for f_raw in (f_fwd, f_bwd):
        f = lb + (1.0 - lb) * jax.nn.sigmoid(f_raw)
        dirs.append((heads(1.0 - f), heads(jnp.log(f))))
    return heads(q), dirs, heads(i), g


def mixer_hgrn2(hc, hx, w_in, lb, norm_w, w_out, need_ctx):
    qc, dc, vc, gc = hgrn2_project(hc, w_in, lb)
    qx, dx, vx, gx = hgrn2_project(hx, w_in, lb)
    B = hx.shape[0]
    s0 = jnp.zeros((B, HG_HEADS, HG_DK, HG_DV), jnp.float32)
    oc_dirs, ox_dirs = [], []
    for d in range(2):
        rev = _flip_seq if d == 1 else _same
        kc, lfc = dc[d]
        kx, lfx = dx[d]
        q_ctx = jax.nn.silu(rev(qc)) if need_ctx else None
        o_c, s_c = hgrn2_scan(q_ctx, rev(kc), rev(lfc), rev(vc), s0)
        o_x, _ = hgrn2_scan(jax.nn.silu(rev(qx)), rev(kx), rev(lfx), rev(vx), s_c)
        ox_dirs.append(rev(o_x))
        if need_ctx:
            oc_dirs.append(rev(o_c))

    def readout(o, g, dtype):
        Bn, T = o.shape[:2]
        o = rms_norm(o, norm_w) * jax.nn.silu(g).reshape(Bn, T, HG_HEADS, HG_DV)
        return o.reshape(Bn, T, D_HG_V).astype(dtype) @ w_out

    out_x = readout(ox_dirs[0] + ox_dirs[1], gx, hx.dtype)
    if not need_ctx:
        return None, out_x
    return readout(oc_dirs[0] + oc_dirs[1], gc, hc.dtype), out_x


def setup_inputs(seed: int = 0) -> dict:
    key = jax.random.key(seed)
    ks = list(jax.random.split(key, 32))

    def nrm(i, shape, scale):
        return scale * jax.random.normal(ks[i], shape, jnp.float32)

    def gain(i, shape):
        return 1.0 + nrm(i, shape, 0.05)

    u = jax.random.uniform(ks[16], (N_EVEN, 2, D_LRU), jnp.float32, 0.9, 0.999)
    a_base = u ** (1.0 / LRU_C)
    return {
        "x": nrm(0, (BATCH, SEQ, D_MODEL), 1.0),
        "c": nrm(1, (BATCH, D_MODEL), 1.0),
        "ctx": nrm(2, (BATCH, CTX_LEN, D_MODEL), 1.0),
        "c_ctx": nrm(3, (D_MODEL,), 1.0),
        "ada_w": nrm(4, (DEPTH, D_MODEL, N_MOD * D_MODEL), 0.5 * D_MODEL ** -0.5),
        "ada_b": nrm(5, (DEPTH, N_MOD * D_MODEL), 0.02),
        "norm_mix_w": gain(6, (DEPTH, D_MODEL)),
        "norm_mlp_w": gain(7, (DEPTH, D_MODEL)),
        "ab_w_in": nrm(8, (N_EVEN, D_MODEL, D_AB_IN), D_MODEL ** -0.5),
        "ab_w_out": nrm(9, (N_EVEN, D_AB_OUT, D_MODEL), D_AB_OUT ** -0.5),
        "lru_conv_w": nrm(10, (N_EVEN, CONV_W, D_LRU), CONV_W ** -0.5),
        "lru_conv_b": nrm(11, (N_EVEN, D_LRU), 0.02),
        "lru_w_a": nrm(12, (N_EVEN, 2, LRU_HEADS, LRU_HEAD_DIM, LRU_HEAD_DIM), LRU_HEAD_DIM ** -0.5),
        "lru_b_a": nrm(13, (N_EVEN, 2, D_LRU), 0.02),
        "lru_w_x": nrm(14, (N_EVEN, 2, LRU_HEADS, LRU_HEAD_DIM, LRU_HEAD_DIM), LRU_HEAD_DIM ** -0.5),
        "lru_b_x": nrm(15, (N_EVEN, 2, D_LRU), 0.02),
        "lru_lambda": jnp.log(a_base) - jnp.log1p(-a_base),
        "mla_q_norm_w": gain(17, (N_EVEN, Q_LORA)),
        "mla_w_uq": nrm(18, (N_EVEN, Q_LORA, MLA_HEADS * (QK_NOPE + QK_ROPE)), Q_LORA ** -0.5),
        "mla_kv_norm_w": gain(19, (N_EVEN, KV_LORA)),
        "mla_w_ukv": nrm(20, (N_EVEN, KV_LORA, MLA_HEADS * (QK_NOPE + V_HEAD)), KV_LORA ** -0.5),
        "hg_w_in": nrm(21, (N_ODD, D_MODEL, D_HG_IN), D_MODEL ** -0.5),
        "hg_lb_logits": nrm(22, (DEPTH, D_HG), 0.1),
        "hg_norm_w": gain(23, (N_ODD, HG_DV)),
        "hg_w_out": nrm(24, (N_ODD, D_HG_V, D_MODEL), D_HG_V ** -0.5),
        "mlp_w1": nrm(25, (DEPTH, D_MODEL, D_FF), D_MODEL ** -0.5),
        "mlp_w2": nrm(26, (DEPTH, D_FF, D_MODEL), D_FF ** -0.5),
        "final_norm_w": gain(27, (D_MODEL,)),
    }


def reference(x, c, ctx, c_ctx, ada_w, ada_b, norm_mix_w, norm_mlp_w, ab_w_in, ab_w_out,
              lru_conv_w, lru_conv_b, lru_w_a, lru_b_a, lru_w_x, lru_b_x, lru_lambda,
              mla_q_norm_w, mla_w_uq, mla_kv_norm_w, mla_w_ukv,
              hg_w_in, hg_lb_logits, hg_norm_w, hg_w_out, mlp_w1, mlp_w2, final_norm_w):
    n_lat = x.shape[1]
    rows_n = n_lat // GRID_W
    row = jnp.repeat(jnp.arange(rows_n), GRID_W)
    col = jnp.tile(jnp.arange(GRID_W), rows_n)
    cos, sin = axial_rope_tables(row, col)
    p_lb = jax.nn.softmax(hg_lb_logits.astype(jnp.float32), axis=0)
    lb_all = jnp.cumsum(p_lb, axis=0) - p_lb[0]
    for l in range(DEPTH):
        last = l == DEPTH - 1
        sh1, sc1, g1, sh2, sc2, g2 = ada_params(c, ada_w[l], ada_b[l])
        csh1, csc1, cg1, csh2, csc2, cg2 = ada_params(c_ctx, ada_w[l], ada_b[l])
        hx = modulate(rms_norm(x, norm_mix_w[l]), sh1, sc1)
        hc = modulate(rms_norm(ctx, norm_mix_w[l]), csh1, csc1)
        if l % 2 == 0:
            e = l // 2
            mc, mx = mixer_ab(hc, hx, cos, sin, ab_w_in[e], ab_w_out[e], lru_conv_w[e], lru_conv_b[e],
                              lru_w_a[e], lru_b_a[e], lru_w_x[e], lru_b_x[e], lru_lambda[e],
                              mla_q_norm_w[e], mla_w_uq[e], mla_kv_norm_w[e], mla_w_ukv[e], not last)
        else:
            o = l // 2
            mc, mx = mixer_hgrn2(hc, hx, hg_w_in[o], lb_all[l], hg_norm_w[o], hg_w_out[o], not last)
        x = x + g1 * mx
        x = x + g2 * squared_relu_mlp(modulate(rms_norm(x, norm_mlp_w[l]), sh2, sc2), mlp_w1[l], mlp_w2[l])
        if not last:
            ctx = ctx + cg1 * mc
            ctx = ctx + cg2 * squared_relu_mlp(modulate(rms_norm(ctx, norm_mlp_w[l]), csh2, csc2),
                                               mlp_w1[l], mlp_w2[l])
    return rms_norm(x, final_norm_w)
```

```cpp
#include <hip/hip_runtime.h>
#include <cstdio>

#define LAS __attribute__((address_space(3)))
typedef unsigned short bf16_t;
typedef short bf16x8 __attribute__((ext_vector_type(8)));
typedef float f32x4 __attribute__((ext_vector_type(4)));
typedef float f32x2 __attribute__((ext_vector_type(2)));
typedef unsigned u32x4 __attribute__((ext_vector_type(4)));
typedef unsigned u32x2 __attribute__((ext_vector_type(2)));

constexpr int DM = 2048, NBATCH = 2, SEQ = 4096, DEPTH = 4, CTX = 256;
constexpr int SROW = CTX + SEQ;
constexpr int MROWS = NBATCH * SROW;
constexpr int DFF = 8192, MODW = 6 * DM;
constexpr int DLRU = 1024;
constexpr int ABN = 3136, ABNP = 3328;
constexpr int QW = 1536, KVW = 2048, HGN = 10240;
constexpr float EPS = 1e-6f;
constexpr float ATTN_SCALE = 0.07216878364870322f;

constexpr size_t al256(size_t x) { return (x + 255) & ~(size_t)255; }
constexpr size_t WS_CTL = 0, CTL_BYTES = 1u << 20;
constexpr size_t WS_MOD = WS_CTL + CTL_BYTES;
constexpr size_t WS_LB = WS_MOD + al256((size_t)DEPTH * 3 * MODW * 4);
constexpr size_t WS_ROPE = WS_LB + al256((size_t)DEPTH * 2048 * 4);
constexpr size_t WS_RSQ = WS_ROPE + al256(2 * 64 * 16 * 4);
constexpr size_t WS_RSKV = WS_RSQ + al256((size_t)MROWS * 4);
constexpr size_t WS_WABIN = WS_RSKV + al256((size_t)MROWS * 4);
constexpr size_t WS_WABOUT = WS_WABIN + (size_t)2 * ABNP * DM * 2;
constexpr size_t WS_WUQ = WS_WABOUT + (size_t)2 * DM * DM * 2;
constexpr size_t WS_WUKV = WS_WUQ + (size_t)2 * QW * 512 * 2;
constexpr size_t WS_WHGIN = WS_WUKV + (size_t)2 * KVW * 512 * 2;
constexpr size_t WS_WHGOUT = WS_WHGIN + (size_t)2 * HGN * DM * 2;
constexpr size_t WS_W1 = WS_WHGOUT + (size_t)2 * DM * DM * 2;
constexpr size_t WS_W2 = WS_W1 + (size_t)4 * DFF * DM * 2;
constexpr size_t WS_XS = WS_W2 + (size_t)4 * DFF * DM * 2;
constexpr size_t WS_H = WS_XS + (size_t)MROWS * DM * 4;
constexpr size_t WS_Y = WS_H + (size_t)MROWS * DM * 2;
constexpr size_t WS_BIG = WS_Y + (size_t)MROWS * DM * 2;
constexpr size_t WS_P = WS_BIG;
constexpr size_t WS_UC = WS_P + (size_t)MROWS * ABNP * 2;
constexpr size_t WS_LA = WS_UC + (size_t)MROWS * DLRU * 4;
constexpr size_t WS_LBB = WS_LA + (size_t)2 * MROWS * DLRU * 4;
constexpr size_t WS_HS = WS_LBB + (size_t)2 * MROWS * DLRU * 4;
constexpr size_t WS_Q = WS_HS + (size_t)MROWS * DLRU * 4;
constexpr size_t WS_KV = WS_Q + (size_t)MROWS * QW * 2;
constexpr size_t WS_KR = WS_KV + (size_t)MROWS * KVW * 2;
constexpr size_t WS_AB_END = WS_KR + (size_t)MROWS * 64 * 2;
constexpr size_t WS_QH = WS_BIG;
constexpr size_t WS_VH = WS_QH + (size_t)MROWS * DM * 2;
constexpr size_t WS_GH = WS_VH + (size_t)MROWS * DM * 2;
constexpr size_t WS_LOGF = WS_GH + (size_t)MROWS * DM * 2;
constexpr size_t WS_O = WS_LOGF + (size_t)2 * MROWS * DM * 4;
constexpr size_t WS_HG_END = WS_O + (size_t)MROWS * DM * 4;
constexpr size_t WS_HID = WS_BIG;
constexpr size_t WS_MLP_END = WS_HID + (size_t)MROWS * DFF * 2;
constexpr size_t cmax(size_t a, size_t b) { return a > b ? a : b; }
constexpr size_t WS_END = cmax(cmax(WS_AB_END, WS_HG_END), WS_MLP_END);

constexpr int LDS_BYTES = 147456;
constexpr int LDS_MISC = 131072;

__device__ __forceinline__ float bf2f(bf16_t v) { return __uint_as_float(((unsigned)v) << 16); }
__device__ __forceinline__ unsigned f2bf(float f) { unsigned u = __float_as_uint(f); return (u + 0x7fffu + ((u >> 16) & 1u)) >> 16; }
__device__ __forceinline__ unsigned pk2(float lo, float hi) { return f2bf(lo) | (f2bf(hi) << 16); }
__device__ __forceinline__ float wave_sum(float v) {
#pragma unroll
    for (int o = 1; o < 64; o <<= 1) v += __shfl_xor(v, o);
    return v;
}
__device__ __forceinline__ float wave_max(float v) {
#pragma unroll
    for (int o = 1; o < 64; o <<= 1) v = fmaxf(v, __shfl_xor(v, o));
    return v;
}
__device__ __forceinline__ float sigmoidf_(float x) { return 1.0f / (1.0f + expf(-x)); }
__device__ __forceinline__ float siluf_(float x) { return x / (1.0f + expf(-x)); }
__device__ __forceinline__ float gelu_tanh(float x) { const float u = 0.7978845608028654f * (x + 0.044715f * x * x * x); return 0.5f * x * (1.0f + tanhf(u)); }

#define XB_TMO      128
#define XB_XCNT(j)  (256  + 64 * (j))
#define XB_XSUB(j)  (1280 + 64 * (j))
#define XB_XGEN(j)  (2304 + 64 * (j))
#define XB_TOP      3328
#define XB_TOPGEN   3392
#define XCD_BAR_WORDS 3456
#define XB_SPIN_CAP (1u << 18)
__device__ __forceinline__ unsigned xb_ld(unsigned* p)              { return __hip_atomic_load(p, __ATOMIC_RELAXED, __HIP_MEMORY_SCOPE_AGENT); }
__device__ __forceinline__ unsigned xb_add(unsigned* p, unsigned v) { return __hip_atomic_fetch_add(p, v, __ATOMIC_RELAXED, __HIP_MEMORY_SCOPE_AGENT); }
__device__ __forceinline__ unsigned xb_xcc_id() { return (unsigned)__builtin_amdgcn_s_getreg((3 << 11) | 20) & 0xFu; }
#define XB_SPIN(cond, bar) do { unsigned _sp = 0; while (cond) { __builtin_amdgcn_s_sleep(1); \
    if ((++_sp & 255u) == 0u) { if (xb_ld(&(bar)[XB_TMO])) break; if (_sp > XB_SPIN_CAP) { atomicAdd(&(bar)[XB_TMO], 1u); break; } } } } while (0)
struct XcdBarrier { unsigned* bar; unsigned x; volatile LAS unsigned* st; };
__device__ __forceinline__ XcdBarrier xcd_barrier_post(unsigned* bar, volatile LAS unsigned* st) {
    XcdBarrier b; b.bar = bar; b.x = xb_xcc_id(); b.st = st;
    if (threadIdx.x == 0) (void)xb_add(&bar[XB_XCNT(b.x)], 1u);
    return b;
}
__device__ __forceinline__ void xcd_barrier_complete(unsigned* bar, unsigned x, unsigned& nloc, unsigned& nx) {
    const unsigned G = gridDim.x * gridDim.y * gridDim.z;
    unsigned sum, cnt, mine, sp = 0u;
    for (;;) {
        sum = 0u; cnt = 0u; mine = 0u;
#pragma unroll
        for (unsigned j = 0; j < 16; ++j) { const unsigned c = xb_ld(&bar[XB_XCNT(j)]); sum += c; cnt += (c > 0u) ? 1u : 0u; mine = (j == x) ? c : mine; }
        if (sum == G) break;
        __builtin_amdgcn_s_sleep(1);
        if ((++sp & 255u) == 0u) { if (xb_ld(&bar[XB_TMO])) break; if (sp > XB_SPIN_CAP) { atomicAdd(&bar[XB_TMO], 1u); break; } }
    }
    nloc = mine > 0u ? mine : 1u; nx = cnt > 0u ? cnt : 1u;
}
__device__ __forceinline__ void xcd_barrier(const XcdBarrier& b) {
    asm volatile("s_waitcnt vmcnt(0)" ::: "memory");
    __syncthreads();
    if (threadIdx.x == 0) {
        unsigned* bar = b.bar;
        __builtin_amdgcn_s_waitcnt(0);
        unsigned nloc = b.st[0], nx = b.st[1];
        if (nloc == 0u) { xcd_barrier_complete(bar, b.x, nloc, nx); b.st[0] = nloc; b.st[1] = nx; }
        const unsigned old = xb_add(&bar[XB_XSUB(b.x)], 1u);
        const unsigned gen = old / nloc;
        if (old + 1u == (gen + 1u) * nloc) {
            __builtin_amdgcn_fence(__ATOMIC_RELEASE, "agent");
            asm volatile("s_waitcnt vmcnt(0)" ::: "memory");
            const unsigned og = xb_add(&bar[XB_TOP], 1u);
            const unsigned tg = og / nx;
            if (og + 1u == (tg + 1u) * nx) xb_add(&bar[XB_TOPGEN], 1u);
            else XB_SPIN(xb_ld(&bar[XB_TOPGEN]) == tg, bar);
            __builtin_amdgcn_fence(__ATOMIC_ACQUIRE, "agent");
            xb_add(&bar[XB_XGEN(b.x)], 1u);
            asm volatile("s_waitcnt vmcnt(0)" ::: "memory");
        } else {
            XB_SPIN(xb_ld(&bar[XB_XGEN(b.x)]) == gen, bar);
            __builtin_amdgcn_fence(__ATOMIC_ACQUIRE, "agent");
            asm volatile("s_waitcnt vmcnt(0)" ::: "memory");
        }
    }
    __syncthreads();
}

namespace pg8 {
constexpr int BM = 256, BK = 64, HALF = 128, HTB = HALF * BK * 2, STAGE_BYTES = 8 * HTB, NXCD = 8, WGM = 8;
__host__ __device__ __forceinline__ int lds_byte(int r, int c) { const int st = (r >> 4) * 2 + (c >> 5), rr = r & 15, cc = c & 31, ob = rr * 64 + cc * 2; return st * 1024 + (ob ^ (((ob >> 9) & 1) << 5)); }
__host__ __device__ __forceinline__ void stage_rc(int b, int& R, int& C) { const int st = b / 1024, sb = b % 1024, swz = sb ^ (((sb >> 9) & 1) << 5); R = (st >> 1) * 16 + swz / 64; C = (st & 1) * 32 + (swz % 64) / 2; }
__host__ __device__ __forceinline__ int perm32(int rho) { const int n = rho >> 4, i = rho & 15; return 8 * (i >> 2) + 4 * n + (i & 3); }
struct Unit { int pm, pn; };
struct Gemm { const bf16_t* A; const bf16_t* Bt; int M, N, K, lda, ldb; };
struct StaticOrder {
    int nM, nN, nwg, G, c;
    __host__ __device__ void init(int M, int N, int G_, int c_) { nM = M / BM; nN = N / BM; nwg = nM * nN; G = G_; c = c_; }
    __host__ __device__ bool next(int i, Unit& u) const {
        const long L = (long)i * G + c; if (L >= nwg) return false;
        int wgid = (int)L; { const int q = nwg / NXCD, r = nwg % NXCD, xcd = wgid % NXCD, off = wgid / NXCD; wgid = (xcd < r ? xcd * (q + 1) : r * (q + 1) + (xcd - r) * q) + off; }
        const int nig = WGM * nN, gid = wgid / nig, fm = gid * WGM, gsz = (nM - fm) < WGM ? (nM - fm) : WGM;
        u.pm = fm + ((wgid % nig) % gsz); u.pn = (wgid % nig) / gsz; return true;
    }
};
__device__ __forceinline__ unsigned cvt_pk_bf16(float lo, float hi) { unsigned r; asm volatile("v_cvt_pk_bf16_f32 %0, %1, %2" : "=v"(r) : "v"(lo), "v"(hi)); return r; }

template <class Epi>
__device__ __forceinline__ void gemm_phase(LAS unsigned char* lds, const int tid, const Gemm g, const StaticOrder& S, const Epi& E) {
    const int wid = __builtin_amdgcn_readfirstlane(tid >> 6), lane = tid & 63, wr = wid >> 2, wc = wid & 3, fr = lane & 15, fq = lane >> 4;
    const int K = g.K, nt = K / BK;
    unsigned voffA[2], voffB[2];
#pragma unroll
    for (int i = 0; i < 2; ++i) { int R, C; stage_rc(tid * 16 + i * 8192, R, C); const int Rb = Epi::PERM ? ((R & ~31) + perm32(R & 31)) : R;
        voffA[i] = (unsigned)(R * g.lda + C) * 2u; voffB[i] = (unsigned)(Rb * g.ldb + C) * 2u; }
    const size_t kstep = (size_t)(BK * 2);
    const size_t hsA = (size_t)HALF * g.lda * 2, hsB = (size_t)HALF * g.ldb * 2;
    const size_t tsA = 2 * hsA, tsB = 2 * hsB;
    const unsigned ldsw = (unsigned)wid * 1024u;
    const int aoff = lds_byte(wr * 64 + fr, fq * 8), boff = lds_byte(wc * 32 + fr, fq * 8);
#define PG8_SA(b, h) (((b) * 2 + (h)) * HTB)
#define PG8_SB(b, h) ((4 + (b) * 2 + (h)) * HTB)
#define PG8_STAGE(bufoff, gbase, voff) do { _Pragma("unroll") for (int _i = 0; _i < 2; ++_i) \
        __builtin_amdgcn_global_load_lds((const unsigned*)((const char*)(gbase) + (voff)[_i]), (LAS unsigned*)(lds + (bufoff) + ldsw + _i * 8192), 16, 0, 0); } while (0)
#define PG8_LDA(dst, b, h) do { _Pragma("unroll") for (int m = 0; m < 4; ++m) _Pragma("unroll") for (int k = 0; k < 2; ++k) dst[m][k] = *(const LAS bf16x8*)(lds + PG8_SA(b, h) + aoff + m * 2048 + k * 1024); } while (0)
#define PG8_LDB(dst, b, h) do { _Pragma("unroll") for (int n = 0; n < 2; ++n) _Pragma("unroll") for (int k = 0; k < 2; ++k) dst[n][k] = *(const LAS bf16x8*)(lds + PG8_SB(b, h) + boff + n * 2048 + k * 1024); } while (0)
#define PG8_MMA(ai, bj, At, Bt) do { __builtin_amdgcn_s_setprio(1); _Pragma("unroll") for (int m = 0; m < 4; ++m) _Pragma("unroll") for (int n = 0; n < 2; ++n) _Pragma("unroll") for (int k = 0; k < 2; ++k) \
        acc[ai][bj][m][n] = __builtin_amdgcn_mfma_f32_16x16x32_bf16(Bt[n][k], At[m][k], acc[ai][bj][m][n], 0, 0, 0); __builtin_amdgcn_s_setprio(0); } while (0)
#define PG8_WAIT_V(n) asm volatile("s_waitcnt vmcnt(" #n ")" ::: "memory")
#define PG8_WAIT_L(n) asm volatile("s_waitcnt lgkmcnt(" #n ")" ::: "memory")
#define PG8_BAR __builtin_amdgcn_s_barrier()
#define PG8_SCHED __builtin_amdgcn_sched_barrier(0)
    Unit cur, nxt; int ui = 0;
    if (!S.next(0, cur)) return;
    f32x4 acc[2][2][4][2];
#pragma unroll
    for (int a = 0; a < 2; ++a)
#pragma unroll
        for (int b = 0; b < 2; ++b)
#pragma unroll
            for (int m = 0; m < 4; ++m)
#pragma unroll
                for (int n = 0; n < 2; ++n) acc[a][b][m][n] = (f32x4){0.f, 0.f, 0.f, 0.f};
    bf16x8 At[4][2], B0[2][2], B1[2][2];
    const char* cA = (const char*)g.A + (size_t)cur.pm * tsA; const char* cB = (const char*)g.Bt + (size_t)cur.pn * tsB;
    PG8_STAGE(PG8_SB(0, 0), cB, voffB); PG8_STAGE(PG8_SA(0, 0), cA, voffA); PG8_STAGE(PG8_SB(0, 1), cB + hsB, voffB); PG8_STAGE(PG8_SA(0, 1), cA + hsA, voffA);
    if (wr == 1) PG8_BAR;
    PG8_WAIT_V(4); PG8_BAR;
    PG8_STAGE(PG8_SB(1, 0), cB + kstep, voffB); PG8_STAGE(PG8_SA(1, 0), cA + kstep, voffA); PG8_STAGE(PG8_SB(1, 1), cB + hsB + kstep, voffB);
    PG8_WAIT_V(6); PG8_BAR;
    for (;;) {
        const bool has_next = S.next(ui + 1, nxt);
        const char* nA = has_next ? (const char*)g.A + (size_t)nxt.pm * tsA : cA; const char* nB = has_next ? (const char*)g.Bt + (size_t)nxt.pn * tsB : cB;
        for (int t = 0; t < nt; t += 2) {
            const bool last = (t == nt - 2);
            const char* a1 = cA + (size_t)(t + 1) * kstep;
            const char* a2 = last ? nA : cA + (size_t)(t + 2) * kstep; const char* b2 = last ? nB : cB + (size_t)(t + 2) * kstep;
            const char* a3 = a2 + kstep; const char* b3 = b2 + kstep;
            PG8_LDB(B0, 0, 0); PG8_SCHED; PG8_LDA(At, 0, 0); PG8_STAGE(PG8_SA(1, 1), a1 + hsA, voffA);
            PG8_WAIT_L(8); PG8_BAR; PG8_WAIT_L(0); PG8_MMA(0, 0, At, B0); PG8_BAR; PG8_SCHED;
            PG8_LDB(B1, 0, 1); PG8_STAGE(PG8_SB(0, 0), b2, voffB);
            PG8_BAR; PG8_WAIT_L(0); PG8_MMA(0, 1, At, B1); PG8_BAR;
            PG8_LDA(At, 0, 1); PG8_STAGE(PG8_SA(0, 0), a2, voffA);
            PG8_BAR; PG8_WAIT_L(0); PG8_MMA(1, 0, At, B0); PG8_BAR; PG8_SCHED;
            PG8_STAGE(PG8_SB(0, 1), b2 + hsB, voffB);
            PG8_WAIT_V(6); PG8_BAR; PG8_MMA(1, 1, At, B1); PG8_BAR;
            PG8_LDB(B0, 1, 0); PG8_SCHED; PG8_LDA(At, 1, 0); PG8_STAGE(PG8_SA(0, 1), a2 + hsA, voffA);
            PG8_WAIT_L(8); PG8_BAR; PG8_WAIT_L(0); PG8_MMA(0, 0, At, B0); PG8_BAR; PG8_SCHED;
            PG8_LDB(B1, 1, 1); PG8_STAGE(PG8_SB(1, 0), b3, voffB);
            PG8_BAR; PG8_WAIT_L(0); PG8_MMA(0, 1, At, B1); PG8_BAR;
            PG8_LDA(At, 1, 1); PG8_STAGE(PG8_SA(1, 0), a3, voffA);
            PG8_BAR; PG8_WAIT_L(0); PG8_MMA(1, 0, At, B0); PG8_BAR; PG8_SCHED;
            PG8_STAGE(PG8_SB(1, 1), b3 + hsB, voffB);
            PG8_WAIT_V(6); PG8_BAR; PG8_MMA(1, 1, At, B1); PG8_BAR;
        }
        E(acc, cur, wr, wc, fr, fq);
        if (!has_next) break;
#pragma unroll
        for (int a = 0; a < 2; ++a)
#pragma unroll
            for (int b = 0; b < 2; ++b)
#pragma unroll
                for (int m = 0; m < 4; ++m)
#pragma unroll
                    for (int n = 0; n < 2; ++n) acc[a][b][m][n] = (f32x4){0.f, 0.f, 0.f, 0.f};
        cur = nxt; cA = nA; cB = nB; ++ui;
    }
    PG8_WAIT_V(0);
    if (wr == 0) PG8_BAR;
    PG8_BAR;
#undef PG8_SA
#undef PG8_SB
#undef PG8_STAGE
#undef PG8_LDA
#undef PG8_LDB
#undef PG8_MMA
#undef PG8_WAIT_V
#undef PG8_WAIT_L
#undef PG8_BAR
#undef PG8_SCHED
}
}

#define EPI_ROWS_COLS_PERM \
    const int row0 = u.pm * 256 + wr * 64 + fr; const int col0 = u.pn * 256 + wc * 32 + 8 * fq;
struct EpiBf16Plain {
    static constexpr bool PERM = true;
    bf16_t* O; int ldc;
    __device__ __forceinline__ void operator()(const f32x4 (&acc)[2][2][4][2], const pg8::Unit& u, int wr, int wc, int fr, int fq) const {
        EPI_ROWS_COLS_PERM
#pragma unroll
        for (int ai = 0; ai < 2; ++ai)
#pragma unroll
            for (int m = 0; m < 4; ++m) { bf16_t* rowp = O + (size_t)(row0 + ai * 128 + m * 16) * ldc + col0;
#pragma unroll
                for (int bj = 0; bj < 2; ++bj) { const f32x4 v0 = acc[ai][bj][m][0], v1 = acc[ai][bj][m][1];
                    u32x4 w; w.x = pk2(v0[0], v0[1]); w.y = pk2(v0[2], v0[3]); w.z = pk2(v1[0], v1[1]); w.w = pk2(v1[2], v1[3]);
                    *(u32x4*)(rowp + bj * 128) = w; } }
    }
};
struct EpiBf16RowScale {
    static constexpr bool PERM = true;
    bf16_t* O; int ldc; const float* rs;
    __device__ __forceinline__ void operator()(const f32x4 (&acc)[2][2][4][2], const pg8::Unit& u, int wr, int wc, int fr, int fq) const {
        EPI_ROWS_COLS_PERM
#pragma unroll
        for (int ai = 0; ai < 2; ++ai)
#pragma unroll
            for (int m = 0; m < 4; ++m) { const int row = row0 + ai * 128 + m * 16; const float s = rs[row]; bf16_t* rowp = O + (size_t)row * ldc + col0;
#pragma unroll
                for (int bj = 0; bj < 2; ++bj) { const f32x4 v0 = acc[ai][bj][m][0] * s, v1 = acc[ai][bj][m][1] * s;
                    u32x4 w; w.x = pk2(v0[0], v0[1]); w.y = pk2(v0[2], v0[3]); w.z = pk2(v1[0], v1[1]); w.w = pk2(v1[2], v1[3]);
                    *(u32x4*)(rowp + bj * 128) = w; } }
    }
};
struct EpiRelu2 {
    static constexpr bool PERM = true;
    bf16_t* O; int ldc;
    __device__ __forceinline__ void operator()(const f32x4 (&acc)[2][2][4][2], const pg8::Unit& u, int wr, int wc, int fr, int fq) const {
        EPI_ROWS_COLS_PERM
#pragma unroll
        for (int ai = 0; ai < 2; ++ai)
#pragma unroll
            for (int m = 0; m < 4; ++m) { bf16_t* rowp = O + (size_t)(row0 + ai * 128 + m * 16) * ldc + col0;
#pragma unroll
                for (int bj = 0; bj < 2; ++bj) { f32x4 v0 = acc[ai][bj][m][0], v1 = acc[ai][bj][m][1];
#pragma unroll
                    for (int j = 0; j < 4; ++j) { const float a = fmaxf(v0[j], 0.f), b = fmaxf(v1[j], 0.f); v0[j] = a * a; v1[j] = b * b; }
                    u32x4 w; w.x = pk2(v0[0], v0[1]); w.y = pk2(v0[2], v0[3]); w.z = pk2(v1[0], v1[1]); w.w = pk2(v1[2], v1[3]);
                    *(u32x4*)(rowp + bj * 128) = w; } }
    }
};
struct EpiResid {
    static constexpr bool PERM = false;
    float* XS; const float* gate;
    __device__ __forceinline__ void operator()(const f32x4 (&acc)[2][2][4][2], const pg8::Unit& u, int wr, int wc, int fr, int fq) const {
        const int row0 = u.pm * 256 + wr * 64 + fr, col0 = u.pn * 256 + wc * 32 + 4 * fq;
        const int cond = (u.pm % 17 == 0) ? 2 : (u.pm / 17);
        const float* gp = gate + (size_t)cond * MODW + col0;
        f32x4 gv[2][2];
#pragma unroll
        for (int bj = 0; bj < 2; ++bj)
#pragma unroll
            for (int n = 0; n < 2; ++n) gv[bj][n] = *(const f32x4*)(gp + bj * 128 + n * 16);
#pragma unroll
        for (int ai = 0; ai < 2; ++ai)
#pragma unroll
            for (int m = 0; m < 4; ++m) { float* rowp = XS + (size_t)(row0 + ai * 128 + m * 16) * DM + col0;
#pragma unroll
                for (int bj = 0; bj < 2; ++bj)
#pragma unroll
                    for (int n = 0; n < 2; ++n) { f32x4* p = (f32x4*)(rowp + bj * 128 + n * 16); *p = *p + gv[bj][n] * acc[ai][bj][m][n]; } }
    }
};
struct EpiHG {
    static constexpr bool PERM = true;
    bf16_t* QVG; float* LOGF; const float* lb;
    __device__ __forceinline__ void operator()(const f32x4 (&acc)[2][2][4][2], const pg8::Unit& u, int wr, int wc, int fr, int fq) const {
        const int row0 = u.pm * 256 + wr * 64 + fr; const int seg = u.pn >> 3; const int col0 = (u.pn & 7) * 256 + wc * 32 + 8 * fq;
        if (seg == 1 || seg == 2) {
            float* base = LOGF + (size_t)(seg - 1) * MROWS * DM;
            f32x4 lbv[2][2];
#pragma unroll
            for (int bj = 0; bj < 2; ++bj)
#pragma unroll
                for (int n = 0; n < 2; ++n) lbv[bj][n] = *(const f32x4*)(lb + col0 + bj * 128 + 4 * n);
#pragma unroll
            for (int ai = 0; ai < 2; ++ai)
#pragma unroll
                for (int m = 0; m < 4; ++m) { float* rowp = base + (size_t)(row0 + ai * 128 + m * 16) * DM + col0;
#pragma unroll
                    for (int bj = 0; bj < 2; ++bj)
#pragma unroll
                        for (int n = 0; n < 2; ++n) { f32x4 v = acc[ai][bj][m][n];
#pragma unroll
                            for (int j = 0; j < 4; ++j) { const float l = lbv[bj][n][j]; v[j] = logf(l + (1.0f - l) * sigmoidf_(v[j])); }
                            *(f32x4*)(rowp + bj * 128 + 4 * n) = v; } }
        } else {
            const int bi = seg - 2 + (seg == 0 ? 2 : 0);
            bf16_t* base = QVG + (size_t)bi * MROWS * DM;
            const bool act = (seg != 3);
#pragma unroll
            for (int ai = 0; ai < 2; ++ai)
#pragma unroll
                for (int m = 0; m < 4; ++m) { bf16_t* rowp = base + (size_t)(row0 + ai * 128 + m * 16) * DM + col0;
#pragma unroll
                    for (int bj = 0; bj < 2; ++bj) { f32x4 v0 = acc[ai][bj][m][0], v1 = acc[ai][bj][m][1];
                        if (act) {
#pragma unroll
                            for (int j = 0; j < 4; ++j) { v0[j] = siluf_(v0[j]); v1[j] = siluf_(v1[j]); } }
                        u32x4 w; w.x = pk2(v0[0], v0[1]); w.y = pk2(v0[2], v0[3]); w.z = pk2(v1[0], v1[1]); w.w = pk2(v1[2], v1[3]);
                        *(u32x4*)(rowp + bj * 128) = w; } }
        }
    }
};

typedef const float* cfp_t;
typedef const __attribute__((address_space(4))) cfp_t* InPtr;
struct Ctx {
    LAS unsigned char* lds; int tid, lane, wave, gw, ngw, gtid, ngt;
    InPtr in; float* out; unsigned char* ws;
};
#define WSP(T, off) ((T*)(C.ws + (off)))

__device__ __forceinline__ void tr_item(const float* W, int K, int N, bf16_t* WT, const float* sck, LAS float* scr, int item, int lane) {
    const int nblk = N / 32, kb = item / nblk, nb = item % nblk, k0 = 64 * kb, n0 = 32 * nb;
#pragma unroll 8
    for (int i = 0; i < 32; ++i) { const int kk = 2 * i + (lane >> 5); float v = W[(size_t)(k0 + kk) * N + n0 + (lane & 31)]; if (sck) v *= sck[k0 + kk]; scr[kk * 33 + (lane & 31)] = v; }
    asm volatile("s_waitcnt lgkmcnt(0)" ::: "memory"); __builtin_amdgcn_wave_barrier();
    const int c = lane & 7;
#pragma unroll
    for (int j = 0; j < 4; ++j) { const int n = (lane >> 3) + 8 * j; const LAS float* s = scr + (8 * c) * 33 + n;
        u32x4 o; o.x = pk2(s[0 * 33], s[1 * 33]); o.y = pk2(s[2 * 33], s[3 * 33]); o.z = pk2(s[4 * 33], s[5 * 33]); o.w = pk2(s[6 * 33], s[7 * 33]);
        *(u32x4*)(WT + (size_t)(n0 + n) * K + k0 + 8 * c) = o; }
    asm volatile("s_waitcnt lgkmcnt(0)" ::: "memory"); __builtin_amdgcn_wave_barrier();
}
__device__ __forceinline__ void tr_matrix(const Ctx& C, const float* W, int K, int N, bf16_t* WT, const float* sck) {
    LAS float* scr = (LAS float*)(C.lds + C.wave * 16384);
    const int cnt = (K / 64) * (N / 32);
    for (int it = C.gw; it < cnt; it += C.ngw) tr_item(W, K, N, WT, sck, scr, it, C.lane);
}
__device__ __forceinline__ void sincos_d(double x, double& s, double& c) {
    const double twopi = 6.283185307179586476925286766559;
    const double k = __builtin_rint(x / twopi); const double y = x - k * twopi; const double y2 = y * y;
    double ts = y, ss = y, tc = 1.0, sc = 1.0;
#pragma unroll
    for (int n = 1; n <= 16; ++n) { tc *= -y2 / (double)((2 * n - 1) * (2 * n)); sc += tc; ts *= -y2 / (double)((2 * n) * (2 * n + 1)); ss += ts; }
    s = ss; c = sc;
}
__device__ __forceinline__ void phase_prologue(const Ctx& C) {
#pragma unroll 1
    for (int e = 0; e < 2; ++e) {
        tr_matrix(C, C.in[8] + (size_t)e * DM * ABN, DM, ABN, WSP(bf16_t, WS_WABIN) + (size_t)e * ABNP * DM, nullptr);
        tr_matrix(C, C.in[9] + (size_t)e * DM * DM, DM, DM, WSP(bf16_t, WS_WABOUT) + (size_t)e * DM * DM, nullptr);
        tr_matrix(C, C.in[18] + (size_t)e * 512 * QW, 512, QW, WSP(bf16_t, WS_WUQ) + (size_t)e * QW * 512, C.in[17] + e * 512);
        tr_matrix(C, C.in[20] + (size_t)e * 512 * KVW, 512, KVW, WSP(bf16_t, WS_WUKV) + (size_t)e * KVW * 512, C.in[19] + e * 512);
        tr_matrix(C, C.in[21] + (size_t)e * DM * HGN, DM, HGN, WSP(bf16_t, WS_WHGIN) + (size_t)e * HGN * DM, nullptr);
        tr_matrix(C, C.in[24] + (size_t)e * DM * DM, DM, DM, WSP(bf16_t, WS_WHGOUT) + (size_t)e * DM * DM, nullptr);
    }
#pragma unroll 1
    for (int l = 0; l < 4; ++l) {
        tr_matrix(C, C.in[25] + (size_t)l * DM * DFF, DM, DFF, WSP(bf16_t, WS_W1) + (size_t)l * DFF * DM, nullptr);
        tr_matrix(C, C.in[26] + (size_t)l * DFF * DM, DFF, DM, WSP(bf16_t, WS_W2) + (size_t)l * DM * DFF, nullptr);
    }
    for (int e = 0; e < 2; ++e) { u32x4* z = (u32x4*)(WSP(bf16_t, WS_WABIN) + (size_t)e * ABNP * DM + (size_t)ABN * DM);
        for (int i = C.gtid; i < (ABNP - ABN) * DM / 8; i += C.ngt) z[i] = (u32x4){0u, 0u, 0u, 0u}; }
    { float* XS = WSP(float, WS_XS);
      for (int i = C.gtid; i < MROWS * (DM / 4); i += C.ngt) { const int R = i / (DM / 4), c4 = i % (DM / 4); const int b = R / SROW, s = R % SROW;
          const float* src = s < CTX ? C.in[2] + ((size_t)(b * CTX + s)) * DM : C.in[0] + ((size_t)(b * SEQ + (s - CTX))) * DM;
          ((f32x4*)(XS + (size_t)R * DM))[c4] = ((const f32x4*)src)[c4]; } }
    { float* LB = WSP(float, WS_LB);
      for (int i = C.gtid; i < 2048; i += C.ngt) { float v[4], mx = -1e30f; for (int l = 0; l < 4; ++l) { v[l] = C.in[22][l * 2048 + i]; mx = fmaxf(mx, v[l]); }
          float sum = 0.f; for (int l = 0; l < 4; ++l) { v[l] = expf(v[l] - mx); sum += v[l]; }
          float cum = 0.f; const float p0 = v[0] / sum; for (int l = 0; l < 4; ++l) { cum += v[l] / sum; LB[l * 2048 + i] = cum - p0; } }
      float* RC = WSP(float, WS_ROPE); float* RS = RC + 1024;
      for (int i = C.gtid; i < 1024; i += C.ngt) { const int pos = i / 16, j = i % 16; double inv = 1.0; for (int q = 0; q < j; ++q) inv *= 0.56234132519034908;
          const float ang = (float)pos * (float)inv; double s, c; sincos_d((double)ang, s, c); RC[i] = (float)c; RS[i] = (float)s; } }
    { LAS float* sl = (LAS float*)C.lds;
      LAS float* red = sl + 3 * 2048;
      __syncthreads();
      for (int i = C.tid; i < 3 * 2048; i += 512) { const int r = i / 2048, d = i % 2048; const float v = r < 2 ? C.in[1][r * 2048 + d] : C.in[3][d]; sl[i] = siluf_(v); }
      __syncthreads();
      float* MOD = WSP(float, WS_MOD);
      const int kq = C.tid >> 4, cq = C.tid & 15;
      for (int u = blockIdx.x; u < 4 * (MODW / 64); u += gridDim.x) { const int l = u / (MODW / 64), e0 = (u % (MODW / 64)) * 64;
          const float* w = C.in[4] + (size_t)l * DM * MODW + e0 + 4 * cq;
          f32x4 a0 = {0, 0, 0, 0}, a1 = {0, 0, 0, 0}, a2 = {0, 0, 0, 0};
#pragma unroll 4
          for (int d = kq; d < DM; d += 32) { const f32x4 wv = *(const f32x4*)(w + (size_t)d * MODW); a0 += wv * sl[d]; a1 += wv * sl[2048 + d]; a2 += wv * sl[4096 + d]; }
#pragma unroll
          for (int j = 0; j < 4; ++j) { red[(kq * 3 + 0) * 64 + 4 * cq + j] = a0[j]; red[(kq * 3 + 1) * 64 + 4 * cq + j] = a1[j]; red[(kq * 3 + 2) * 64 + 4 * cq + j] = a2[j]; }
          __syncthreads();
          if (C.tid < 192) { const int r = C.tid / 64, c = C.tid % 64; float s = 0.f; for (int q = 0; q < 32; ++q) s += red[(q * 3 + r) * 64 + c];
              MOD[((size_t)l * 3 + r) * MODW + e0 + c] = s + C.in[5][l * MODW + e0 + c]; }
          __syncthreads(); } }
}

__device__ __forceinline__ void phase_norm_mod(const Ctx& C, const float* w, const float* mod, int sh_idx, int sc_idx) {
    const float* XS = WSP(float, WS_XS); bf16_t* H = WSP(bf16_t, WS_H);
    for (int R = C.gw; R < MROWS; R += C.ngw) {
        const int s = R % SROW, b = R / SROW, cond = s < CTX ? 2 : b;
        const float* shift = mod + (size_t)cond * MODW + sh_idx * DM; const float* scale = mod + (size_t)cond * MODW + sc_idx * DM;
        const f32x4* xr = (const f32x4*)(XS + (size_t)R * DM) + C.lane;
        f32x4 v[8]; float ss = 0.f;
#pragma unroll
        for (int j = 0; j < 8; ++j) { v[j] = xr[64 * j]; ss += (v[j].x * v[j].x + v[j].y * v[j].y) + (v[j].z * v[j].z + v[j].w * v[j].w); }
        const float rstd = 1.0f / sqrtf(wave_sum(ss) * (1.0f / DM) + EPS);
        u32x2* o = (u32x2*)(H + (size_t)R * DM) + C.lane;
#pragma unroll
        for (int j = 0; j < 8; ++j) { const int c = (C.lane + 64 * j) * 4; const f32x4 wv = *(const f32x4*)(w + c), sc = *(const f32x4*)(scale + c), sh = *(const f32x4*)(shift + c);
            const f32x4 y = (v[j] * rstd * wv) * (1.0f + sc) + sh; u32x2 pk; pk.x = pk2(y.x, y.y); pk.y = pk2(y.z, y.w); o[64 * j] = pk; }
    }
}

__device__ __forceinline__ void phase_conv_etc(const Ctx& C, int e) {
    const bf16_t* P = WSP(bf16_t, WS_P); float* UC = WSP(float, WS_UC);
    const float* cw = C.in[10] + (size_t)e * 4 * DLRU; const float* cb = C.in[11] + (size_t)e * DLRU;
    for (int idx = C.gtid; idx < MROWS * DLRU; idx += C.ngt) { const int R = idx / DLRU, ch = idx % DLRU, s = R % SROW; const int lo = s < CTX ? 0 : CTX, hi = s < CTX ? CTX : SROW;
        float a = cb[ch];
#pragma unroll
        for (int j = 0; j < 4; ++j) { const int ss = s + j - 2; if (ss >= lo && ss < hi) a += bf2f(P[(size_t)(R + j - 2) * ABNP + DLRU + ch]) * cw[j * DLRU + ch]; }
        UC[idx] = a; }
    float* RSQ = WSP(float, WS_RSQ); float* RSKV = WSP(float, WS_RSKV);
    for (int R = C.gw; R < MROWS; R += C.ngw) {
        const u32x4 a = *(const u32x4*)(P + (size_t)R * ABNP + 2048 + 8 * C.lane), b = *(const u32x4*)(P + (size_t)R * ABNP + 2560 + 8 * C.lane);
        float sa = 0.f, sb = 0.f;
#pragma unroll
        for (int j = 0; j < 4; ++j) { const float a0 = __uint_as_float(a[j] << 16), a1 = __uint_as_float(a[j] & 0xffff0000u), b0 = __uint_as_float(b[j] << 16), b1 = __uint_as_float(b[j] & 0xffff0000u);
            sa += a0 * a0 + a1 * a1; sb += b0 * b0 + b1 * b1; }
        sa = wave_sum(sa); sb = wave_sum(sb);
        if (C.lane == 0) { RSQ[R] = 1.0f / sqrtf(sa * (1.0f / 512.0f) + EPS); RSKV[R] = 1.0f / sqrtf(sb * (1.0f / 512.0f) + EPS); } }
    bf16_t* KR = WSP(bf16_t, WS_KR); const float* RC = WSP(float, WS_ROPE); const float* RS = RC + 1024;
    for (int idx = C.gtid; idx < MROWS * 32; idx += C.ngt) { const int R = idx / 32, p = idx % 32, s = R % SROW; const int i0 = p < 16 ? p : 32 + (p - 16);
        const float x0 = bf2f(P[(size_t)R * ABNP + 3072 + i0]), x1 = bf2f(P[(size_t)R * ABNP + 3072 + i0 + 16]); float o0 = x0, o1 = x1;
        if (s >= CTX) { const int t = s - CTX, pos = p < 16 ? t / 64 : t % 64; const float c = RC[pos * 16 + (p & 15)], sn = RS[pos * 16 + (p & 15)]; o0 = x0 * c - x1 * sn; o1 = x1 * c + x0 * sn; }
        KR[(size_t)R * 64 + i0] = (bf16_t)f2bf(o0); KR[(size_t)R * 64 + i0 + 16] = (bf16_t)f2bf(o1); }
}
__device__ __forceinline__ void phase_gates_naive(const Ctx& C, int e) {
    const float* UC = WSP(float, WS_UC); float* LA = WSP(float, WS_LA); float* LBv = WSP(float, WS_LBB);
    const float* wa = C.in[12] + (size_t)e * 2 * 8 * 128 * 128; const float* wx = C.in[14] + (size_t)e * 2 * 8 * 128 * 128;
    const float* ba = C.in[13] + (size_t)e * 2 * DLRU; const float* bx = C.in[15] + (size_t)e * 2 * DLRU; const float* lam = C.in[16] + (size_t)e * 2 * DLRU;
    for (int idx = C.gtid; idx < MROWS * DLRU; idx += C.ngt) { const int R = idx / DLRU, ch = idx % DLRU, h = ch / 128, ee = ch % 128;
        const float* u = UC + (size_t)R * DLRU + h * 128;
        const float* wa0 = wa + ((size_t)(0 * 8 + h) * 128) * 128 + ee; const float* wa1 = wa + ((size_t)(1 * 8 + h) * 128) * 128 + ee;
        const float* wx0 = wx + ((size_t)(0 * 8 + h) * 128) * 128 + ee; const float* wx1 = wx + ((size_t)(1 * 8 + h) * 128) * 128 + ee;
        float a0 = 0.f, a1 = 0.f, x0 = 0.f, x1 = 0.f;
#pragma unroll 4
        for (int d = 0; d < 128; ++d) { const float uv = u[d]; a0 += uv * wa0[d * 128]; a1 += uv * wa1[d * 128]; x0 += uv * wx0[d * 128]; x1 += uv * wx1[d * 128]; }
        const float ucv = UC[idx];
        { const float r = sigmoidf_(a0 + ba[ch]), ig = sigmoidf_(x0 + bx[ch]); const float la = -8.0f * r * log1pf(expf(-lam[ch])); LA[idx] = expf(la); LBv[idx] = sqrtf(-expm1f(2.0f * la)) * (ig * ucv); }
        { const float r = sigmoidf_(a1 + ba[DLRU + ch]), ig = sigmoidf_(x1 + bx[DLRU + ch]); const float la = -8.0f * r * log1pf(expf(-lam[DLRU + ch]));
          LA[(size_t)MROWS * DLRU + idx] = expf(la); LBv[(size_t)MROWS * DLRU + idx] = sqrtf(-expm1f(2.0f * la)) * (ig * ucv); } }
}
__device__ __forceinline__ void phase_scan_naive(const Ctx& C) {
    const float* LA = WSP(float, WS_LA); const float* LBv = WSP(float, WS_LBB); float* HS = WSP(float, WS_HS);
    if (C.tid < 64) for (int id = blockIdx.x * 64 + C.tid; id < NBATCH * DLRU; id += gridDim.x * 64) { const int b = id / DLRU, ch = id % DLRU;
        float h = 0.f;
#pragma unroll 8
        for (int s = 0; s < SROW; ++s) { const size_t i = (size_t)(b * SROW + s) * DLRU + ch; h = LA[i] * h + LBv[i]; HS[i] = h; }
        h = 0.f; const size_t d1 = (size_t)MROWS * DLRU;
#pragma unroll 8
        for (int s = CTX - 1; s >= 0; --s) { const size_t i = (size_t)(b * SROW + s) * DLRU + ch; h = LA[d1 + i] * h + LBv[d1 + i]; HS[i] += h; }
#pragma unroll 8
        for (int s = SROW - 1; s >= CTX; --s) { const size_t i = (size_t)(b * SROW + s) * DLRU + ch; h = LA[d1 + i] * h + LBv[d1 + i]; HS[i] += h; } }
    bf16_t* Q = WSP(bf16_t, WS_Q); const float* RC = WSP(float, WS_ROPE); const float* RS = RC + 1024;
    for (int idx = C.gtid; idx < MROWS * 8 * 32; idx += C.ngt) { const int R = idx / 256, rem = idx % 256, hh = rem / 32, p = rem % 32, s = R % SROW; if (s < CTX) continue;
        const int i0 = p < 16 ? p : 32 + (p - 16); bf16_t* q = Q + (size_t)R * QW + hh * 192 + 128 + i0;
        const float x0 = bf2f(q[0]), x1 = bf2f(q[16]); const int t = s - CTX, pos = p < 16 ? t / 64 : t % 64; const float c = RC[pos * 16 + (p & 15)], sn = RS[pos * 16 + (p & 15)];
        q[0] = (bf16_t)f2bf(x0 * c - x1 * sn); q[16] = (bf16_t)f2bf(x1 * c + x0 * sn); }
}
__device__ __forceinline__ void phase_attn_naive(const Ctx& C) {
    const bf16_t* P = WSP(bf16_t, WS_P); const float* HS = WSP(float, WS_HS); bf16_t* Y = WSP(bf16_t, WS_Y);
    for (int idx = C.gtid; idx < MROWS * DLRU; idx += C.ngt) { const int R = idx / DLRU, ch = idx % DLRU; Y[(size_t)R * DM + ch] = (bf16_t)f2bf(HS[idx] * gelu_tanh(bf2f(P[(size_t)R * ABNP + ch]))); }
    const bf16_t* Q = WSP(bf16_t, WS_Q); const bf16_t* KV = WSP(bf16_t, WS_KV); const bf16_t* KR = WSP(bf16_t, WS_KR);
    LAS float* qs = (LAS float*)(C.lds + C.wave * 4096); LAS float* ps = qs + 768;
    for (int u = C.gw; u < (MROWS / 4) * 8; u += C.ngw) { const int hh = u % 8, R0 = (u / 8) * 4, b = R0 / SROW, s0 = R0 % SROW, nk = s0 < CTX ? CTX : SROW, kb = b * SROW;
        __builtin_amdgcn_wave_barrier();
        for (int i = C.lane; i < 768; i += 64) { const int qi = i / 192, d = i % 192; qs[i] = bf2f(Q[(size_t)(R0 + qi) * QW + hh * 192 + d]) * ATTN_SCALE; }
        __builtin_amdgcn_wave_barrier();
        float m[4], l[4], o0[4], o1[4];
#pragma unroll
        for (int qi = 0; qi < 4; ++qi) { m[qi] = -1e30f; l[qi] = 0.f; o0[qi] = 0.f; o1[qi] = 0.f; }
        for (int k0 = 0; k0 < nk; k0 += 64) { const size_t kr = (size_t)(kb + k0 + C.lane);
            float sc[4] = {0.f, 0.f, 0.f, 0.f};
            for (int d8 = 0; d8 < 24; ++d8) { const u32x4 kk = d8 < 16 ? *(const u32x4*)(KV + kr * KVW + hh * 256 + d8 * 8) : *(const u32x4*)(KR + kr * 64 + (d8 - 16) * 8);
                float kf[8];
#pragma unroll
                for (int j = 0; j < 4; ++j) { kf[2 * j] = __uint_as_float(kk[j] << 16); kf[2 * j + 1] = __uint_as_float(kk[j] & 0xffff0000u); }
#pragma unroll
                for (int qi = 0; qi < 4; ++qi) { const f32x4 qa = *(const LAS f32x4*)(qs + qi * 192 + d8 * 8), qb = *(const LAS f32x4*)(qs + qi * 192 + d8 * 8 + 4);
                    sc[qi] += kf[0] * qa[0] + kf[1] * qa[1] + kf[2] * qa[2] + kf[3] * qa[3] + kf[4] * qb[0] + kf[5] * qb[1] + kf[6] * qb[2] + kf[7] * qb[3]; } }
            __builtin_amdgcn_wave_barrier();
#pragma unroll
            for (int qi = 0; qi < 4; ++qi) { const float mx = wave_max(sc[qi]); const float mn = fmaxf(m[qi], mx); const float alpha = expf(m[qi] - mn); const float p = expf(sc[qi] - mn);
                ps[qi * 64 + C.lane] = p; l[qi] = l[qi] * alpha + wave_sum(p); o0[qi] *= alpha; o1[qi] *= alpha; m[qi] = mn; }
            __builtin_amdgcn_wave_barrier();
            for (int kk = 0; kk < 64; ++kk) { const bf16_t* vr = KV + (size_t)(kb + k0 + kk) * KVW + hh * 256 + 128; const float v0 = bf2f(vr[C.lane]), v1 = bf2f(vr[64 + C.lane]);
#pragma unroll
                for (int qi = 0; qi < 4; ++qi) { const float pp = ps[qi * 64 + kk]; o0[qi] += pp * v0; o1[qi] += pp * v1; } }
        }
#pragma unroll
        for (int qi = 0; qi < 4; ++qi) { bf16_t* yo = Y + (size_t)(R0 + qi) * DM + DLRU + hh * 128; const float il = 1.0f / l[qi]; yo[C.lane] = (bf16_t)f2bf(o0[qi] * il); yo[64 + C.lane] = (bf16_t)f2bf(o1[qi] * il); }
    }
}
__device__ __forceinline__ void phase_hgrn_naive(const Ctx& C) {
    const bf16_t* QH = WSP(bf16_t, WS_QH); const float* LOGF = WSP(float, WS_LOGF); const bf16_t* VH = WSP(bf16_t, WS_VH); float* O = WSP(float, WS_O);
    LAS float* fs = (LAS float*)C.lds;
    LAS float* qsh = fs + 1024;
    const int g4 = C.tid >> 7, e = C.tid & 127;
    for (int bg = blockIdx.x; bg < 8; bg += gridDim.x) { const int grp = bg * 4 + g4, b = grp / 16, hh = grp % 16, col = hh * 128 + e;
        for (int dir = 0; dir < 2; ++dir) {
            float st[128];
#pragma unroll
            for (int d = 0; d < 128; ++d) st[d] = 0.f;
            const float* lf = LOGF + (size_t)dir * MROWS * DM;
            size_t R = (size_t)b * SROW + (dir == 0 ? 0 : CTX - 1);
            float nlf = lf[R * DM + col], nq = bf2f(QH[R * DM + col]), nv = bf2f(VH[R * DM + col]);
            for (int step = 0; step < SROW; ++step) {
                const size_t Rc = R; const float f_ = expf(nlf), q_ = nq, vv = nv;
                if (step + 1 < SROW) { const int s1 = step + 1; const int sidx = dir == 0 ? s1 : (s1 < CTX ? CTX - 1 - s1 : SROW + CTX - 1 - s1); R = (size_t)b * SROW + sidx;
                    nlf = lf[R * DM + col]; nq = bf2f(QH[R * DM + col]); nv = bf2f(VH[R * DM + col]); }
                const int buf = step & 1;
                fs[(buf * 4 + g4) * 128 + e] = f_; qsh[(buf * 4 + g4) * 128 + e] = q_;
                __syncthreads();
                const LAS f32x4* fp = (const LAS f32x4*)(fs + (buf * 4 + g4) * 128); const LAS f32x4* qp = (const LAS f32x4*)(qsh + (buf * 4 + g4) * 128);
                float o = 0.f;
#pragma unroll
                for (int d4 = 0; d4 < 32; ++d4) { const f32x4 f4 = fp[d4], q4 = qp[d4];
#pragma unroll
                    for (int j = 0; j < 4; ++j) { const float f = f4[j]; st[d4 * 4 + j] = f * st[d4 * 4 + j] + (1.0f - f) * vv; o += q4[j] * st[d4 * 4 + j]; } }
                if (dir == 0) O[Rc * DM + col] = o; else O[Rc * DM + col] += o;
            }
            __syncthreads();
        }
    }
}
__device__ __forceinline__ void phase_hg_readout(const Ctx& C, int o_idx) {
    const float* O = WSP(float, WS_O); const bf16_t* GH = WSP(bf16_t, WS_GH); bf16_t* Y = WSP(bf16_t, WS_Y); const float* nw = C.in[23] + o_idx * 128;
    const float w0 = nw[C.lane], w1 = nw[64 + C.lane];
    for (int u = C.gw; u < MROWS * 16; u += C.ngw) { const size_t base = (size_t)(u / 16) * DM + (u % 16) * 128;
        const float a = O[base + C.lane], b = O[base + 64 + C.lane]; const float rstd = 1.0f / sqrtf(wave_sum(a * a + b * b) * (1.0f / 128.0f) + EPS);
        Y[base + C.lane] = (bf16_t)f2bf(a * rstd * w0 * bf2f(GH[base + C.lane])); Y[base + 64 + C.lane] = (bf16_t)f2bf(b * rstd * w1 * bf2f(GH[base + 64 + C.lane])); }
}
__device__ __forceinline__ void phase_final(const Ctx& C) {
    const float* XS = WSP(float, WS_XS); const float* w = C.in[27];
    for (int r = C.gw; r < NBATCH * SEQ; r += C.ngw) { const int b = r / SEQ, t = r % SEQ; const size_t R = (size_t)b * SROW + CTX + t;
        const f32x4* xr = (const f32x4*)(XS + R * DM) + C.lane; f32x4 v[8]; float ss = 0.f;
#pragma unroll
        for (int j = 0; j < 8; ++j) { v[j] = xr[64 * j]; ss += (v[j].x * v[j].x + v[j].y * v[j].y) + (v[j].z * v[j].z + v[j].w * v[j].w); }
        const float rstd = 1.0f / sqrtf(wave_sum(ss) * (1.0f / DM) + EPS);
        f32x4* o = (f32x4*)(C.out + (size_t)r * DM) + C.lane;
#pragma unroll
        for (int j = 0; j < 8; ++j) { const f32x4 wv = *(const f32x4*)(w + (C.lane + 64 * j) * 4); o[64 * j] = v[j] * rstd * wv; } }
}

struct Args { const float* in[28]; float* out; unsigned char* ws; int ph_lo, ph_hi; };
constexpr int N_PHASES = 1 + 2 * 12 + 2 * 8 + 1;

__global__ void __launch_bounds__(512, 2) fwd_kernel(Args args) {
    extern __shared__ __attribute__((aligned(16))) unsigned char lds_raw[];
    LAS unsigned char* const lds0 = (LAS unsigned char*)lds_raw;
    const unsigned long long inaddr = (unsigned long long)__builtin_amdgcn_kernarg_segment_ptr();
    volatile LAS unsigned* misc = (volatile LAS unsigned*)(lds0 + LDS_MISC);
    if (threadIdx.x < 64) misc[threadIdx.x] = 0u;
    __syncthreads();
    const int lo = args.ph_lo, hi = args.ph_hi;
    XcdBarrier bar; bar.bar = (unsigned*)(args.ws + WS_CTL) + 4096; bar.x = 0; bar.st = misc + 8;
    if (hi - lo > 1) bar = xcd_barrier_post((unsigned*)(args.ws + WS_CTL) + 4096, misc + 8);
    int pid = 0;
    const unsigned long long wsaddr = (unsigned long long)args.ws;
#define PH_BEGIN if (pid >= lo && pid < hi) { int l = l_; Ctx C; { unsigned long long a_ = inaddr, w_ = wsaddr; int t_ = threadIdx.x; asm volatile("" : "+s"(a_), "+s"(w_), "+s"(l), "+v"(t_)); \
        C.in = (InPtr)a_; C.ws = (unsigned char*)w_; C.out = args.out; C.lds = lds0; C.tid = t_; C.lane = t_ & 63; C.wave = __builtin_amdgcn_readfirstlane(t_ >> 6); \
        C.gw = blockIdx.x * 8 + C.wave; C.ngw = gridDim.x * 8; C.gtid = blockIdx.x * 512 + t_; C.ngt = gridDim.x * 512; } \
        const int e = l >> 1; const float* mod = WSP(float, WS_MOD) + (size_t)l * 3 * MODW; const int G = gridDim.x, cb = blockIdx.x; (void)e; (void)mod; (void)G; (void)cb;
#define PH_END } if (pid >= lo && pid + 1 < hi) xcd_barrier(bar); ++pid;
    int l_ = 0;
    PH_BEGIN
#ifndef SKIP_PRO
    phase_prologue(C);
#endif
    PH_END

    for (l_ = 0; l_ < DEPTH; ++l_) {
        PH_BEGIN phase_norm_mod(C, C.in[6] + l * DM, mod, 0, 1); PH_END
        if ((l_ & 1) == 0) {
            PH_BEGIN { pg8::Gemm g{WSP(bf16_t, WS_H), WSP(bf16_t, WS_WABIN) + (size_t)e * ABNP * DM, MROWS, ABNP, DM, DM, DM}; pg8::StaticOrder S; S.init(MROWS, ABNP, G, cb);
                       EpiBf16Plain E{WSP(bf16_t, WS_P), ABNP}; pg8::gemm_phase(C.lds, C.tid, g, S, E); } PH_END
            PH_BEGIN phase_conv_etc(C, e); PH_END
            PH_BEGIN phase_gates_naive(C, e); PH_END
            PH_BEGIN { pg8::Gemm g{WSP(bf16_t, WS_P) + 2048, WSP(bf16_t, WS_WUQ) + (size_t)e * QW * 512, MROWS, QW, 512, ABNP, 512}; pg8::StaticOrder S; S.init(MROWS, QW, G, cb);
                       EpiBf16RowScale E{WSP(bf16_t, WS_Q), QW, WSP(float, WS_RSQ)}; pg8::gemm_phase(C.lds, C.tid, g, S, E); } PH_END
            PH_BEGIN { pg8::Gemm g{WSP(bf16_t, WS_P) + 2560, WSP(bf16_t, WS_WUKV) + (size_t)e * KVW * 512, MROWS, KVW, 512, ABNP, 512}; pg8::StaticOrder S; S.init(MROWS, KVW, G, cb);
                       EpiBf16RowScale E{WSP(bf16_t, WS_KV), KVW, WSP(float, WS_RSKV)}; pg8::gemm_phase(C.lds, C.tid, g, S, E); } PH_END
            PH_BEGIN phase_scan_naive(C); PH_END
            PH_BEGIN
#ifndef SKIP_ATTN
            phase_attn_naive(C);
#endif
            PH_END
        } else {
            PH_BEGIN { pg8::Gemm g{WSP(bf16_t, WS_H), WSP(bf16_t, WS_WHGIN) + (size_t)e * HGN * DM, MROWS, HGN, DM, DM, DM}; pg8::StaticOrder S; S.init(MROWS, HGN, G, cb);
                       EpiHG E{WSP(bf16_t, WS_QH), WSP(float, WS_LOGF), WSP(float, WS_LB) + l * 2048}; pg8::gemm_phase(C.lds, C.tid, g, S, E); } PH_END
            PH_BEGIN
#ifndef SKIP_HGRN
            phase_hgrn_naive(C);
#endif
            PH_END
            PH_BEGIN phase_hg_readout(C, e); PH_END
        }
        PH_BEGIN { const bf16_t* wout = (l & 1) ? WSP(bf16_t, WS_WHGOUT) + (size_t)e * DM * DM : WSP(bf16_t, WS_WABOUT) + (size_t)e * DM * DM;
                   pg8::Gemm g{WSP(bf16_t, WS_Y), wout, MROWS, DM, DM, DM, DM}; pg8::StaticOrder S; S.init(MROWS, DM, G, cb);
                   EpiResid E{WSP(float, WS_XS), mod + 2 * DM}; pg8::gemm_phase(C.lds, C.tid, g, S, E); } PH_END
        PH_BEGIN phase_norm_mod(C, C.in[7] + l * DM, mod, 3, 4); PH_END
        PH_BEGIN { pg8::Gemm g{WSP(bf16_t, WS_H), WSP(bf16_t, WS_W1) + (size_t)l * DFF * DM, MROWS, DFF, DM, DM, DM}; pg8::StaticOrder S; S.init(MROWS, DFF, G, cb);
                   EpiRelu2 E{WSP(bf16_t, WS_HID), DFF}; pg8::gemm_phase(C.lds, C.tid, g, S, E); } PH_END
        PH_BEGIN { pg8::Gemm g{WSP(bf16_t, WS_HID), WSP(bf16_t, WS_W2) + (size_t)l * DM * DFF, MROWS, DM, DFF, DFF, DFF}; pg8::StaticOrder S; S.init(MROWS, DM, G, cb);
                   EpiResid E{WSP(float, WS_XS), mod + 5 * DM}; pg8::gemm_phase(C.lds, C.tid, g, S, E); } PH_END
    }
    l_ = 0;
    PH_BEGIN phase_final(C); PH_END
}

#ifndef N_LAUNCH_MODE
#define N_LAUNCH_MODE 0
#endif
extern "C" void kernel_launch(void* const* d_in, const int* in_sizes, int n_in, void* d_out, int out_size, void* d_ws, size_t ws_size, hipStream_t stream) {
    static int grid = 0;
    if (grid == 0) {
        if (n_in != 28 || out_size != NBATCH * SEQ * DM || ws_size < WS_END) { fprintf(stderr, "kernel_launch: shape mismatch n_in %d out %d ws %zu (need %zu)\n", n_in, out_size, ws_size, (size_t)WS_END); grid = -1; return; }
        int dev = 0, cus = 0, per_cu = 0;
        if (hipGetDevice(&dev) != hipSuccess || hipDeviceGetAttribute(&cus, hipDeviceAttributeMultiprocessorCount, dev) != hipSuccess) { grid = -1; return; }
        if (hipFuncSetAttribute((const void*)fwd_kernel, hipFuncAttributeMaxDynamicSharedMemorySize, LDS_BYTES) != hipSuccess) { fprintf(stderr, "kernel_launch: hipFuncSetAttribute failed\n"); grid = -1; return; }
        if (hipOccupancyMaxActiveBlocksPerMultiprocessor(&per_cu, (const void*)fwd_kernel, 512, LDS_BYTES) != hipSuccess || per_cu < 1) fprintf(stderr, "kernel_launch: occupancy query says %d\n", per_cu);
        (void)hipGetLastError();
        grid = cus;
    }
    if (grid < 0) return;
    (void)hipMemsetAsync((char*)d_ws + WS_CTL, 0, CTL_BYTES, stream);
    Args a{};
    for (int i = 0; i < 28; ++i) a.in[i] = (const float*)d_in[i];
    a.out = (float*)d_out; a.ws = (unsigned char*)d_ws;
#if N_LAUNCH_MODE == 1
    a.ph_lo = 0; a.ph_hi = N_PHASES;
    hipLaunchKernelGGL(fwd_kernel, dim3(grid), dim3(512), LDS_BYTES, stream, a);
#else
    for (int p = 0; p < N_PHASES; ++p) { a.ph_lo = p; a.ph_hi = p + 1; hipLaunchKernelGGL(fwd_kernel, dim3(grid), dim3(512), LDS_BYTES, stream, a); }
#endif
    const hipError_t le = hipPeekAtLastError();
    if (le != hipSuccess) fprintf(stderr, "kernel_launch: launch failed: %s\n", hipGetErrorName(le));
}
```

```cpp
#include <hip/hip_runtime.h>
#include <cstdio>

#define LAS __attribute__((address_space(3)))
typedef unsigned short bf16_t;
typedef short bf16x8 __attribute__((ext_vector_type(8)));
typedef float f32x4 __attribute__((ext_vector_type(4)));
typedef float f32x2 __attribute__((ext_vector_type(2)));
typedef unsigned u32x4 __attribute__((ext_vector_type(4)));
typedef unsigned u32x2 __attribute__((ext_vector_type(2)));

constexpr int DM = 2048, NBATCH = 2, SEQ = 4096, DEPTH = 4, CTX = 256;
constexpr int SROW = CTX + SEQ;
constexpr int MROWS = NBATCH * SROW;
constexpr int DFF = 8192, MODW = 6 * DM;
constexpr int DLRU = 1024;
constexpr int ABN = 3136, ABNP = 3328;
constexpr int QW = 1536, KVW = 2048, HGN = 10240;
constexpr float EPS = 1e-6f;
constexpr float ATTN_SCALE = 0.07216878364870322f;

constexpr size_t al256(size_t x) { return (x + 255) & ~(size_t)255; }
constexpr size_t WS_CTL = 0, CTL_BYTES = 1u << 20;
constexpr size_t WS_MOD = WS_CTL + CTL_BYTES;
constexpr size_t WS_LB = WS_MOD + al256((size_t)DEPTH * 3 * MODW * 4);
constexpr size_t WS_ROPE = WS_LB + al256((size_t)DEPTH * 2048 * 4);
constexpr size_t WS_RSQ = WS_ROPE + al256(2 * 64 * 16 * 4);
constexpr size_t WS_RSKV = WS_RSQ + al256((size_t)MROWS * 4);
constexpr size_t WS_WABIN = WS_RSKV + al256((size_t)MROWS * 4);
constexpr size_t WS_WABOUT = WS_WABIN + (size_t)2 * ABNP * DM * 2;
constexpr size_t WS_WUQ = WS_WABOUT + (size_t)2 * DM * DM * 2;
constexpr size_t WS_WUKV = WS_WUQ + (size_t)2 * QW * 512 * 2;
constexpr size_t WS_WHGIN = WS_WUKV + (size_t)2 * KVW * 512 * 2;
constexpr size_t WS_WHGOUT = WS_WHGIN + (size_t)2 * HGN * DM * 2;
constexpr size_t WS_W1 = WS_WHGOUT + (size_t)2 * DM * DM * 2;
constexpr size_t WS_W2 = WS_W1 + (size_t)4 * DFF * DM * 2;
constexpr size_t WS_XS = WS_W2 + (size_t)4 * DFF * DM * 2;
constexpr size_t WS_H = WS_XS + (size_t)MROWS * DM * 4;
constexpr size_t WS_Y = WS_H + (size_t)MROWS * DM * 2;
constexpr size_t WS_BIG = WS_Y + (size_t)MROWS * DM * 2;
constexpr size_t WS_P = WS_BIG;
constexpr size_t WS_UC = WS_P + (size_t)MROWS * ABNP * 2;
constexpr size_t WS_LA = WS_UC + (size_t)MROWS * DLRU * 4;
constexpr size_t WS_LBB = WS_LA + (size_t)2 * MROWS * DLRU * 4;
constexpr size_t WS_HS = WS_LBB + (size_t)2 * MROWS * DLRU * 4;
constexpr size_t WS_Q = WS_HS + (size_t)MROWS * DLRU * 4;
constexpr size_t WS_KV = WS_Q + (size_t)MROWS * QW * 2;
constexpr size_t WS_KR = WS_KV + (size_t)MROWS * KVW * 2;
constexpr size_t WS_AB_END = WS_KR + (size_t)MROWS * 64 * 2;
constexpr size_t WS_QH = WS_BIG;
constexpr size_t WS_VH = WS_QH + (size_t)MROWS * DM * 2;
constexpr size_t WS_GH = WS_VH + (size_t)MROWS * DM * 2;
constexpr size_t WS_LOGF = WS_GH + (size_t)MROWS * DM * 2;
constexpr size_t WS_O = WS_LOGF + (size_t)2 * MROWS * DM * 4;
constexpr size_t WS_HG_END = WS_O + (size_t)MROWS * DM * 4;
constexpr size_t WS_HID = WS_BIG;
constexpr size_t WS_MLP_END = WS_HID + (size_t)MROWS * DFF * 2;
constexpr size_t cmax(size_t a, size_t b) { return a > b ? a : b; }
constexpr size_t WS_END = cmax(cmax(WS_AB_END, WS_HG_END), WS_MLP_END);

constexpr int LDS_BYTES = 147456;
constexpr int LDS_MISC = 131072;

__device__ __forceinline__ float bf2f(bf16_t v) { return __uint_as_float(((unsigned)v) << 16); }
__device__ __forceinline__ unsigned f2bf(float f) { unsigned u = __float_as_uint(f); return (u + 0x7fffu + ((u >> 16) & 1u)) >> 16; }
__device__ __forceinline__ unsigned pk2(float lo, float hi) { return f2bf(lo) | (f2bf(hi) << 16); }
__device__ __forceinline__ float wave_sum(float v) {
#pragma unroll
    for (int o = 1; o < 64; o <<= 1) v += __shfl_xor(v, o);
    return v;
}
__device__ __forceinline__ float wave_max(float v) {
#pragma unroll
    for (int o = 1; o < 64; o <<= 1) v = fmaxf(v, __shfl_xor(v, o));
    return v;
}
__device__ __forceinline__ float sigmoidf_(float x) { return 1.0f / (1.0f + expf(-x)); }
__device__ __forceinline__ float siluf_(float x) { return x / (1.0f + expf(-x)); }
__device__ __forceinline__ float gelu_tanh(float x) { const float u = 0.7978845608028654f * (x + 0.044715f * x * x * x); return 0.5f * x * (1.0f + tanhf(u)); }

#define XB_TMO      128
#define XB_XCNT(j)  (256  + 64 * (j))
#define XB_XSUB(j)  (1280 + 64 * (j))
#define XB_XGEN(j)  (2304 + 64 * (j))
#define XB_TOP      3328
#define XB_TOPGEN   3392
#define XCD_BAR_WORDS 3456
#define XB_SPIN_CAP (1u << 18)
__device__ __forceinline__ unsigned xb_ld(unsigned* p)              { return __hip_atomic_load(p, __ATOMIC_RELAXED, __HIP_MEMORY_SCOPE_AGENT); }
__device__ __forceinline__ unsigned xb_add(unsigned* p, unsigned v) { return __hip_atomic_fetch_add(p, v, __ATOMIC_RELAXED, __HIP_MEMORY_SCOPE_AGENT); }
__device__ __forceinline__ unsigned xb_xcc_id() { return (unsigned)__builtin_amdgcn_s_getreg((3 << 11) | 20) & 0xFu; }
#define XB_SPIN(cond, bar) do { unsigned _sp = 0; while (cond) { __builtin_amdgcn_s_sleep(1); \
    if ((++_sp & 255u) == 0u) { if (xb_ld(&(bar)[XB_TMO])) break; if (_sp > XB_SPIN_CAP) { atomicAdd(&(bar)[XB_TMO], 1u); break; } } } } while (0)
struct XcdBarrier { unsigned* bar; unsigned x; volatile LAS unsigned* st; };
__device__ __forceinline__ XcdBarrier xcd_barrier_post(unsigned* bar, volatile LAS unsigned* st) {
    XcdBarrier b; b.bar = bar; b.x = xb_xcc_id(); b.st = st;
    if (threadIdx.x == 0) (void)xb_add(&bar[XB_XCNT(b.x)], 1u);
    return b;
}
__device__ __forceinline__ void xcd_barrier_complete(unsigned* bar, unsigned x, unsigned& nloc, unsigned& nx) {
    const unsigned G = gridDim.x * gridDim.y * gridDim.z;
    unsigned sum, cnt, mine, sp = 0u;
    for (;;) {
        sum = 0u; cnt = 0u; mine = 0u;
#pragma unroll
        for (unsigned j = 0; j < 16; ++j) { const unsigned c = xb_ld(&bar[XB_XCNT(j)]); sum += c; cnt += (c > 0u) ? 1u : 0u; mine = (j == x) ? c : mine; }
        if (sum == G) break;
        __builtin_amdgcn_s_sleep(1);
        if ((++sp & 255u) == 0u) { if (xb_ld(&bar[XB_TMO])) break; if (sp > XB_SPIN_CAP) { atomicAdd(&bar[XB_TMO], 1u); break; } }
    }
    nloc = mine > 0u ? mine : 1u; nx = cnt > 0u ? cnt : 1u;
}
__device__ __forceinline__ void xcd_barrier(const XcdBarrier& b) {
    asm volatile("s_waitcnt vmcnt(0)" ::: "memory");
    __syncthreads();
    if (threadIdx.x == 0) {
        unsigned* bar = b.bar;
        __builtin_amdgcn_s_waitcnt(0);
        unsigned nloc = b.st[0], nx = b.st[1];
        if (nloc == 0u) { xcd_barrier_complete(bar, b.x, nloc, nx); b.st[0] = nloc; b.st[1] = nx; }
        const unsigned old = xb_add(&bar[XB_XSUB(b.x)], 1u);
        const unsigned gen = old / nloc;
        if (old + 1u == (gen + 1u) * nloc) {
            __builtin_amdgcn_fence(__ATOMIC_RELEASE, "agent");
            asm volatile("s_waitcnt vmcnt(0)" ::: "memory");
            const unsigned og = xb_add(&bar[XB_TOP], 1u);
            const unsigned tg = og / nx;
            if (og + 1u == (tg + 1u) * nx) xb_add(&bar[XB_TOPGEN], 1u);
            else XB_SPIN(xb_ld(&bar[XB_TOPGEN]) == tg, bar);
            __builtin_amdgcn_fence(__ATOMIC_ACQUIRE, "agent");
            xb_add(&bar[XB_XGEN(b.x)], 1u);
            asm volatile("s_waitcnt vmcnt(0)" ::: "memory");
        } else {
            XB_SPIN(xb_ld(&bar[XB_XGEN(b.x)]) == gen, bar);
            __builtin_amdgcn_fence(__ATOMIC_ACQUIRE, "agent");
            asm volatile("s_waitcnt vmcnt(0)" ::: "memory");
        }
    }
    __syncthreads();
}

namespace pg8 {
constexpr int BM = 256, BK = 64, HALF = 128, HTB = HALF * BK * 2, STAGE_BYTES = 8 * HTB, NXCD = 8, WGM = 8;
__host__ __device__ __forceinline__ int lds_byte(int r, int c) { const int st = (r >> 4) * 2 + (c >> 5), rr = r & 15, cc = c & 31, ob = rr * 64 + cc * 2; return st * 1024 + (ob ^ (((ob >> 9) & 1) << 5)); }
__host__ __device__ __forceinline__ void stage_rc(int b, int& R, int& C) { const int st = b / 1024, sb = b % 1024, swz = sb ^ (((sb >> 9) & 1) << 5); R = (st >> 1) * 16 + swz / 64; C = (st & 1) * 32 + (swz % 64) / 2; }
__host__ __device__ __forceinline__ int perm32(int rho) { const int n = rho >> 4, i = rho & 15; return 8 * (i >> 2) + 4 * n + (i & 3); }
struct Unit { int pm, pn; };
struct Gemm { const bf16_t* A; const bf16_t* Bt; int M, N, K, lda, ldb; };
struct StaticOrder {
    int nM, nN, nwg, G, c;
    __host__ __device__ void init(int M, int N, int G_, int c_) { nM = M / BM; nN = N / BM; nwg = nM * nN; G = G_; c = c_; }
    __host__ __device__ bool next(int i, Unit& u) const {
        const long L = (long)i * G + c; if (L >= nwg) return false;
        int wgid = (int)L; { const int q = nwg / NXCD, r = nwg % NXCD, xcd = wgid % NXCD, off = wgid / NXCD; wgid = (xcd < r ? xcd * (q + 1) : r * (q + 1) + (xcd - r) * q) + off; }
        const int nig = WGM * nN, gid = wgid / nig, fm = gid * WGM, gsz = (nM - fm) < WGM ? (nM - fm) : WGM;
        u.pm = fm + ((wgid % nig) % gsz); u.pn = (wgid % nig) / gsz; return true;
    }
};
__device__ __forceinline__ unsigned cvt_pk_bf16(float lo, float hi) { unsigned r; asm volatile("v_cvt_pk_bf16_f32 %0, %1, %2" : "=v"(r) : "v"(lo), "v"(hi)); return r; }

template <class Epi>
__device__ __forceinline__ void gemm_phase(LAS unsigned char* lds, const int tid, const Gemm g, const StaticOrder& S, const Epi& E) {
    const int wid = __builtin_amdgcn_readfirstlane(tid >> 6), lane = tid & 63, wr = wid >> 2, wc = wid & 3, fr = lane & 15, fq = lane >> 4;
    const int K = g.K, nt = K / BK;
    unsigned voffA[2], voffB[2];
#pragma unroll
    for (int i = 0; i < 2; ++i) { int R, C; stage_rc(tid * 16 + i * 8192, R, C); const int Rb = Epi::PERM ? ((R & ~31) + perm32(R & 31)) : R;
        voffA[i] = (unsigned)(R * g.lda + C) * 2u; voffB[i] = (unsigned)(Rb * g.ldb + C) * 2u; }
    const size_t kstep = (size_t)(BK * 2);
    const size_t hsA = (size_t)HALF * g.lda * 2, hsB = (size_t)HALF * g.ldb * 2;
    const size_t tsA = 2 * hsA, tsB = 2 * hsB;
    const unsigned ldsw = (unsigned)wid * 1024u;
    const int aoff = lds_byte(wr * 64 + fr, fq * 8), boff = lds_byte(wc * 32 + fr, fq * 8);
#define PG8_SA(b, h) (((b) * 2 + (h)) * HTB)
#define PG8_SB(b, h) ((4 + (b) * 2 + (h)) * HTB)
#define PG8_STAGE(bufoff, gbase, voff) do { _Pragma("unroll") for (int _i = 0; _i < 2; ++_i) \
        __builtin_amdgcn_global_load_lds((const unsigned*)((const char*)(gbase) + (voff)[_i]), (LAS unsigned*)(lds + (bufoff) + ldsw + _i * 8192), 16, 0, 0); } while (0)
#define PG8_LDA(dst, b, h) do { _Pragma("unroll") for (int m = 0; m < 4; ++m) _Pragma("unroll") for (int k = 0; k < 2; ++k) dst[m][k] = *(const LAS bf16x8*)(lds + PG8_SA(b, h) + aoff + m * 2048 + k * 1024); } while (0)
#define PG8_LDB(dst, b, h) do { _Pragma("unroll") for (int n = 0; n < 2; ++n) _Pragma("unroll") for (int k = 0; k < 2; ++k) dst[n][k] = *(const LAS bf16x8*)(lds + PG8_SB(b, h) + boff + n * 2048 + k * 1024); } while (0)
#define PG8_MMA(ai, bj, At, Bt) do { __builtin_amdgcn_s_setprio(1); _Pragma("unroll") for (int m = 0; m < 4; ++m) _Pragma("unroll") for (int n = 0; n < 2; ++n) _Pragma("unroll") for (int k = 0; k < 2; ++k) \
        acc[ai][bj][m][n] = __builtin_amdgcn_mfma_f32_16x16x32_bf16(Bt[n][k], At[m][k], acc[ai][bj][m][n], 0, 0, 0); __builtin_amdgcn_s_setprio(0); } while (0)
#define PG8_WAIT_V(n) asm volatile("s_waitcnt vmcnt(" #n ")" ::: "memory")
#define PG8_WAIT_L(n) asm volatile("s_waitcnt lgkmcnt(" #n ")" ::: "memory")
#define PG8_BAR __builtin_amdgcn_s_barrier()
#define PG8_SCHED __builtin_amdgcn_sched_barrier(0)
    Unit cur, nxt; int ui = 0;
    if (!S.next(0, cur)) return;
    f32x4 acc[2][2][4][2];
#pragma unroll
    for (int a = 0; a < 2; ++a)
#pragma unroll
        for (int b = 0; b < 2; ++b)
#pragma unroll
            for (int m = 0; m < 4; ++m)
#pragma unroll
                for (int n = 0; n < 2; ++n) acc[a][b][m][n] = (f32x4){0.f, 0.f, 0.f, 0.f};
    bf16x8 At[4][2], B0[2][2], B1[2][2];
    const char* cA = (const char*)g.A + (size_t)cur.pm * tsA; const char* cB = (const char*)g.Bt + (size_t)cur.pn * tsB;
    PG8_STAGE(PG8_SB(0, 0), cB, voffB); PG8_STAGE(PG8_SA(0, 0), cA, voffA); PG8_STAGE(PG8_SB(0, 1), cB + hsB, voffB); PG8_STAGE(PG8_SA(0, 1), cA + hsA, voffA);
    if (wr == 1) PG8_BAR;
    PG8_WAIT_V(4); PG8_BAR;
    PG8_STAGE(PG8_SB(1, 0), cB + kstep, voffB); PG8_STAGE(PG8_SA(1, 0), cA + kstep, voffA); PG8_STAGE(PG8_SB(1, 1), cB + hsB + kstep, voffB);
    PG8_WAIT_V(6); PG8_BAR;
    for (;;) {
        const bool has_next = S.next(ui + 1, nxt);
        const char* nA = has_next ? (const char*)g.A + (size_t)nxt.pm * tsA : cA; const char* nB = has_next ? (const char*)g.Bt + (size_t)nxt.pn * tsB : cB;
        for (int t = 0; t < nt; t += 2) {
            const bool last = (t == nt - 2);
            const char* a1 = cA + (size_t)(t + 1) * kstep;
            const char* a2 = last ? nA : cA + (size_t)(t + 2) * kstep; const char* b2 = last ? nB : cB + (size_t)(t + 2) * kstep;
            const char* a3 = a2 + kstep; const char* b3 = b2 + kstep;
            PG8_LDB(B0, 0, 0); PG8_SCHED; PG8_LDA(At, 0, 0); PG8_STAGE(PG8_SA(1, 1), a1 + hsA, voffA);
            PG8_WAIT_L(8); PG8_BAR; PG8_WAIT_L(0); PG8_MMA(0, 0, At, B0); PG8_BAR; PG8_SCHED;
            PG8_LDB(B1, 0, 1); PG8_STAGE(PG8_SB(0, 0), b2, voffB);
            PG8_BAR; PG8_WAIT_L(0); PG8_MMA(0, 1, At, B1); PG8_BAR;
            PG8_LDA(At, 0, 1); PG8_STAGE(PG8_SA(0, 0), a2, voffA);
            PG8_BAR; PG8_WAIT_L(0); PG8_MMA(1, 0, At, B0); PG8_BAR; PG8_SCHED;
            PG8_STAGE(PG8_SB(0, 1), b2 + hsB, voffB);
            PG8_WAIT_V(6); PG8_BAR; PG8_MMA(1, 1, At, B1); PG8_BAR;
            PG8_LDB(B0, 1, 0); PG8_SCHED; PG8_LDA(At, 1, 0); PG8_STAGE(PG8_SA(0, 1), a2 + hsA, voffA);
            PG8_WAIT_L(8); PG8_BAR; PG8_WAIT_L(0); PG8_MMA(0, 0, At, B0); PG8_BAR; PG8_SCHED;
            PG8_LDB(B1, 1, 1); PG8_STAGE(PG8_SB(1, 0), b3, voffB);
            PG8_BAR; PG8_WAIT_L(0); PG8_MMA(0, 1, At, B1); PG8_BAR;
            PG8_LDA(At, 1, 1); PG8_STAGE(PG8_SA(1, 0), a3, voffA);
            PG8_BAR; PG8_WAIT_L(0); PG8_MMA(1, 0, At, B0); PG8_BAR; PG8_SCHED;
            PG8_STAGE(PG8_SB(1, 1), b3 + hsB, voffB);
            PG8_WAIT_V(6); PG8_BAR; PG8_MMA(1, 1, At, B1); PG8_BAR;
        }
        E(acc, cur, wr, wc, fr, fq);
        if (!has_next) break;
#pragma unroll
        for (int a = 0; a < 2; ++a)
#pragma unroll
            for (int b = 0; b < 2; ++b)
#pragma unroll
                for (int m = 0; m < 4; ++m)
#pragma unroll
                    for (int n = 0; n < 2; ++n) acc[a][b][m][n] = (f32x4){0.f, 0.f, 0.f, 0.f};
        cur = nxt; cA = nA; cB = nB; ++ui;
    }
    PG8_WAIT_V(0);
    if (wr == 0) PG8_BAR;
    PG8_BAR;
#undef PG8_SA
#undef PG8_SB
#undef PG8_STAGE
#undef PG8_LDA
#undef PG8_LDB
#undef PG8_MMA
#undef PG8_WAIT_V
#undef PG8_WAIT_L
#undef PG8_BAR
#undef PG8_SCHED
}
}

#define EPI_ROWS_COLS_PERM \
    const int row0 = u.pm * 256 + wr * 64 + fr; const int col0 = u.pn * 256 + wc * 32 + 8 * fq;
struct EpiBf16Plain {
    static constexpr bool PERM = true;
    bf16_t* O; int ldc;
    __device__ __forceinline__ void operator()(const f32x4 (&acc)[2][2][4][2], const pg8::Unit& u, int wr, int wc, int fr, int fq) const {
        EPI_ROWS_COLS_PERM
#pragma unroll
        for (int ai = 0; ai < 2; ++ai)
#pragma unroll
            for (int m = 0; m < 4; ++m) { bf16_t* rowp = O + (size_t)(row0 + ai * 128 + m * 16) * ldc + col0;
#pragma unroll
                for (int bj = 0; bj < 2; ++bj) { const f32x4 v0 = acc[ai][bj][m][0], v1 = acc[ai][bj][m][1];
                    u32x4 w; w.x = pk2(v0[0], v0[1]); w.y = pk2(v0[2], v0[3]); w.z = pk2(v1[0], v1[1]); w.w = pk2(v1[2], v1[3]);
                    *(u32x4*)(rowp + bj * 128) = w; } }
    }
};
struct EpiBf16RowScale {
    static constexpr bool PERM = true;
    bf16_t* O; int ldc; const float* rs;
    __device__ __forceinline__ void operator()(const f32x4 (&acc)[2][2][4][2], const pg8::Unit& u, int wr, int wc, int fr, int fq) const {
        EPI_ROWS_COLS_PERM
#pragma unroll
        for (int ai = 0; ai < 2; ++ai)
#pragma unroll
            for (int m = 0; m < 4; ++m) { const int row = row0 + ai * 128 + m * 16; const float s = rs[row]; bf16_t* rowp = O + (size_t)row * ldc + col0;
#pragma unroll
                for (int bj = 0; bj < 2; ++bj) { const f32x4 v0 = acc[ai][bj][m][0] * s, v1 = acc[ai][bj][m][1] * s;
                    u32x4 w; w.x = pk2(v0[0], v0[1]); w.y = pk2(v0[2], v0[3]); w.z = pk2(v1[0], v1[1]); w.w = pk2(v1[2], v1[3]);
                    *(u32x4*)(rowp + bj * 128) = w; } }
    }
};
struct EpiRelu2 {
    static constexpr bool PERM = true;
    bf16_t* O; int ldc;
    __device__ __forceinline__ void operator()(const f32x4 (&acc)[2][2][4][2], const pg8::Unit& u, int wr, int wc, int fr, int fq) const {
        EPI_ROWS_COLS_PERM
#pragma unroll
        for (int ai = 0; ai < 2; ++ai)
#pragma unroll
            for (int m = 0; m < 4; ++m) { bf16_t* rowp = O + (size_t)(row0 + ai * 128 + m * 16) * ldc + col0;
#pragma unroll
                for (int bj = 0; bj < 2; ++bj) { f32x4 v0 = acc[ai][bj][m][0], v1 = acc[ai][bj][m][1];
#pragma unroll
                    for (int j = 0; j < 4; ++j) { const float a = fmaxf(v0[j], 0.f), b = fmaxf(v1[j], 0.f); v0[j] = a * a; v1[j] = b * b; }
                    u32x4 w; w.x = pk2(v0[0], v0[1]); w.y = pk2(v0[2], v0[3]); w.z = pk2(v1[0], v1[1]); w.w = pk2(v1[2], v1[3]);
                    *(u32x4*)(rowp + bj * 128) = w; } }
    }
};
struct EpiResid {
    static constexpr bool PERM = false;
    float* XS; const float* gate;
    __device__ __forceinline__ void operator()(const f32x4 (&acc)[2][2][4][2], const pg8::Unit& u, int wr, int wc, int fr, int fq) const {
        const int row0 = u.pm * 256 + wr * 64 + fr, col0 = u.pn * 256 + wc * 32 + 4 * fq;
        const int cond = (u.pm % 17 == 0) ? 2 : (u.pm / 17);
        const float* gp = gate + (size_t)cond * MODW + col0;
        f32x4 gv[2][2];
#pragma unroll
        for (int bj = 0; bj < 2; ++bj)
#pragma unroll
            for (int n = 0; n < 2; ++n) gv[bj][n] = *(const f32x4*)(gp + bj * 128 + n * 16);
#pragma unroll
        for (int ai = 0; ai < 2; ++ai)
#pragma unroll
            for (int m = 0; m < 4; ++m) { float* rowp = XS + (size_t)(row0 + ai * 128 + m * 16) * DM + col0;
#pragma unroll
                for (int bj = 0; bj < 2; ++bj)
#pragma unroll
                    for (int n = 0; n < 2; ++n) { f32x4* p = (f32x4*)(rowp + bj * 128 + n * 16); *p = *p + gv[bj][n] * acc[ai][bj][m][n]; } }
    }
};
struct EpiHG {
    static constexpr bool PERM = true;
    bf16_t* QVG; float* LOGF; const float* lb;
    __device__ __forceinline__ void operator()(const f32x4 (&acc)[2][2][4][2], const pg8::Unit& u, int wr, int wc, int fr, int fq) const {
        const int row0 = u.pm * 256 + wr * 64 + fr; const int seg = u.pn >> 3; const int col0 = (u.pn & 7) * 256 + wc * 32 + 8 * fq;
        if (seg == 1 || seg == 2) {
            float* base = LOGF + (size_t)(seg - 1) * MROWS * DM;
            f32x4 lbv[2][2];
#pragma unroll
            for (int bj = 0; bj < 2; ++bj)
#pragma unroll
                for (int n = 0; n < 2; ++n) lbv[bj][n] = *(const f32x4*)(lb + col0 + bj * 128 + 4 * n);
#pragma unroll
            for (int ai = 0; ai < 2; ++ai)
#pragma unroll
                for (int m = 0; m < 4; ++m) { float* rowp = base + (size_t)(row0 + ai * 128 + m * 16) * DM + col0;
#pragma unroll
                    for (int bj = 0; bj < 2; ++bj)
#pragma unroll
                        for (int n = 0; n < 2; ++n) { f32x4 v = acc[ai][bj][m][n];
#pragma unroll
                            for (int j = 0; j < 4; ++j) { const float l = lbv[bj][n][j]; v[j] = logf(l + (1.0f - l) * sigmoidf_(v[j])); }
                            *(f32x4*)(rowp + bj * 128 + 4 * n) = v; } }
        } else {
            const int bi = seg - 2 + (seg == 0 ? 2 : 0);
            bf16_t* base = QVG + (size_t)bi * MROWS * DM;
            const bool act = (seg != 3);
#pragma unroll
            for (int ai = 0; ai < 2; ++ai)
#pragma unroll
                for (int m = 0; m < 4; ++m) { bf16_t* rowp = base + (size_t)(row0 + ai * 128 + m * 16) * DM + col0;
#pragma unroll
                    for (int bj = 0; bj < 2; ++bj) { f32x4 v0 = acc[ai][bj][m][0], v1 = acc[ai][bj][m][1];
                        if (act) {
#pragma unroll
                            for (int j = 0; j < 4; ++j) { v0[j] = siluf_(v0[j]); v1[j] = siluf_(v1[j]); } }
                        u32x4 w; w.x = pk2(v0[0], v0[1]); w.y = pk2(v0[2], v0[3]); w.z = pk2(v1[0], v1[1]); w.w = pk2(v1[2], v1[3]);
                        *(u32x4*)(rowp + bj * 128) = w; } }
        }
    }
};

typedef const float* cfp_t;
typedef const __attribute__((address_space(4))) cfp_t* InPtr;
struct Ctx {
    LAS unsigned char* lds; int tid, lane, wave, gw, ngw, gtid, ngt;
    InPtr in; float* out; unsigned char* ws;
};
#define WSP(T, off) ((T*)(C.ws + (off)))

__device__ __forceinline__ void tr_item(const float* W, int K, int N, bf16_t* WT, const float* sck, LAS float* scr, int item, int lane) {
    const int nblk = N / 32, kb = item / nblk, nb = item % nblk, k0 = 64 * kb, n0 = 32 * nb;
#pragma unroll 8
    for (int i = 0; i < 32; ++i) { const int kk = 2 * i + (lane >> 5); float v = W[(size_t)(k0 + kk) * N + n0 + (lane & 31)]; if (sck) v *= sck[k0 + kk]; scr[kk * 33 + (lane & 31)] = v; }
    asm volatile("s_waitcnt lgkmcnt(0)" ::: "memory"); __builtin_amdgcn_wave_barrier();
    const int c = lane & 7;
#pragma unroll
    for (int j = 0; j < 4; ++j) { const int n = (lane >> 3) + 8 * j; const LAS float* s = scr + (8 * c) * 33 + n;
        u32x4 o; o.x = pk2(s[0 * 33], s[1 * 33]); o.y = pk2(s[2 * 33], s[3 * 33]); o.z = pk2(s[4 * 33], s[5 * 33]); o.w = pk2(s[6 * 33], s[7 * 33]);
        *(u32x4*)(WT + (size_t)(n0 + n) * K + k0 + 8 * c) = o; }
    asm volatile("s_waitcnt lgkmcnt(0)" ::: "memory"); __builtin_amdgcn_wave_barrier();
}
__device__ __forceinline__ void tr_matrix(const Ctx& C, const float* W, int K, int N, bf16_t* WT, const float* sck) {
    LAS float* scr = (LAS float*)(C.lds + C.wave * 16384);
    const int cnt = (K / 64) * (N / 32);
    for (int it = C.gw; it < cnt; it += C.ngw) tr_item(W, K, N, WT, sck, scr, it, C.lane);
}
__device__ __forceinline__ void sincos_d(double x, double& s, double& c) {
    const double twopi = 6.283185307179586476925286766559;
    const double k = __builtin_rint(x / twopi); const double y = x - k * twopi; const double y2 = y * y;
    double ts = y, ss = y, tc = 1.0, sc = 1.0;
#pragma unroll
    for (int n = 1; n <= 16; ++n) { tc *= -y2 / (double)((2 * n - 1) * (2 * n)); sc += tc; ts *= -y2 / (double)((2 * n) * (2 * n + 1)); ss += ts; }
    s = ss; c = sc;
}
__device__ __forceinline__ void phase_prologue(const Ctx& C) {
#pragma unroll 1
    for (int e = 0; e < 2; ++e) {
        tr_matrix(C, C.in[8] + (size_t)e * DM * ABN, DM, ABN, WSP(bf16_t, WS_WABIN) + (size_t)e * ABNP * DM, nullptr);
        tr_matrix(C, C.in[9] + (size_t)e * DM * DM, DM, DM, WSP(bf16_t, WS_WABOUT) + (size_t)e * DM * DM, nullptr);
        tr_matrix(C, C.in[18] + (size_t)e * 512 * QW, 512, QW, WSP(bf16_t, WS_WUQ) + (size_t)e * QW * 512, C.in[17] + e * 512);
        tr_matrix(C, C.in[20] + (size_t)e * 512 * KVW, 512, KVW, WSP(bf16_t, WS_WUKV) + (size_t)e * KVW * 512, C.in[19] + e * 512);
        tr_matrix(C, C.in[21] + (size_t)e * DM * HGN, DM, HGN, WSP(bf16_t, WS_WHGIN) + (size_t)e * HGN * DM, nullptr);
        tr_matrix(C, C.in[24] + (size_t)e * DM * DM, DM, DM, WSP(bf16_t, WS_WHGOUT) + (size_t)e * DM * DM, nullptr);
    }
#pragma unroll 1
    for (int l = 0; l < 4; ++l) {
        tr_matrix(C, C.in[25] + (size_t)l * DM * DFF, DM, DFF, WSP(bf16_t, WS_W1) + (size_t)l * DFF * DM, nullptr);
        tr_matrix(C, C.in[26] + (size_t)l * DFF * DM, DFF, DM, WSP(bf16_t, WS_W2) + (size_t)l * DM * DFF, nullptr);
    }
    for (int e = 0; e < 2; ++e) { u32x4* z = (u32x4*)(WSP(bf16_t, WS_WABIN) + (size_t)e * ABNP * DM + (size_t)ABN * DM);
        for (int i = C.gtid; i < (ABNP - ABN) * DM / 8; i += C.ngt) z[i] = (u32x4){0u, 0u, 0u, 0u}; }
    { float* XS = WSP(float, WS_XS);
      for (int i = C.gtid; i < MROWS * (DM / 4); i += C.ngt) { const int R = i / (DM / 4), c4 = i % (DM / 4); const int b = R / SROW, s = R % SROW;
          const float* src = s < CTX ? C.in[2] + ((size_t)(b * CTX + s)) * DM : C.in[0] + ((size_t)(b * SEQ + (s - CTX))) * DM;
          ((f32x4*)(XS + (size_t)R * DM))[c4] = ((const f32x4*)src)[c4]; } }
    { float* LB = WSP(float, WS_LB);
      for (int i = C.gtid; i < 2048; i += C.ngt) { float v[4], mx = -1e30f; for (int l = 0; l < 4; ++l) { v[l] = C.in[22][l * 2048 + i]; mx = fmaxf(mx, v[l]); }
          float sum = 0.f; for (int l = 0; l < 4; ++l) { v[l] = expf(v[l] - mx); sum += v[l]; }
          float cum = 0.f; const float p0 = v[0] / sum; for (int l = 0; l < 4; ++l) { cum += v[l] / sum; LB[l * 2048 + i] = cum - p0; } }
      float* RC = WSP(float, WS_ROPE); float* RS = RC + 1024;
      for (int i = C.gtid; i < 1024; i += C.ngt) { const int pos = i / 16, j = i % 16; double inv = 1.0; for (int q = 0; q < j; ++q) inv *= 0.56234132519034908;
          const float ang = (float)pos * (float)inv; double s, c; sincos_d((double)ang, s, c); RC[i] = (float)c; RS[i] = (float)s; } }
    { LAS float* sl = (LAS float*)C.lds;
      LAS float* red = sl + 3 * 2048;
      __syncthreads();
      for (int i = C.tid; i < 3 * 2048; i += 512) { const int r = i / 2048, d = i % 2048; const float v = r < 2 ? C.in[1][r * 2048 + d] : C.in[3][d]; sl[i] = siluf_(v); }
      __syncthreads();
      float* MOD = WSP(float, WS_MOD);
      const int kq = C.tid >> 4, cq = C.tid & 15;
      for (int u = blockIdx.x; u < 4 * (MODW / 64); u += gridDim.x) { const int l = u / (MODW / 64), e0 = (u % (MODW / 64)) * 64;
          const float* w = C.in[4] + (size_t)l * DM * MODW + e0 + 4 * cq;
          f32x4 a0 = {0, 0, 0, 0}, a1 = {0, 0, 0, 0}, a2 = {0, 0, 0, 0};
#pragma unroll 4
          for (int d = kq; d < DM; d += 32) { const f32x4 wv = *(const f32x4*)(w + (size_t)d * MODW); a0 += wv * sl[d]; a1 += wv * sl[2048 + d]; a2 += wv * sl[4096 + d]; }
#pragma unroll
          for (int j = 0; j < 4; ++j) { red[(kq * 3 + 0) * 64 + 4 * cq + j] = a0[j]; red[(kq * 3 + 1) * 64 + 4 * cq + j] = a1[j]; red[(kq * 3 + 2) * 64 + 4 * cq + j] = a2[j]; }
          __syncthreads();
          if (C.tid < 192) { const int r = C.tid / 64, c = C.tid % 64; float s = 0.f; for (int q = 0; q < 32; ++q) s += red[(q * 3 + r) * 64 + c];
              MOD[((size_t)l * 3 + r) * MODW + e0 + c] = s + C.in[5][l * MODW + e0 + c]; }
          __syncthreads(); } }
}

__device__ __forceinline__ void phase_norm_mod(const Ctx& C, const float* w, const float* mod, int sh_idx, int sc_idx) {
    const float* XS = WSP(float, WS_XS); bf16_t* H = WSP(bf16_t, WS_H);
    for (int R = C.gw; R < MROWS; R += C.ngw) {
        const int s = R % SROW, b = R / SROW, cond = s < CTX ? 2 : b;
        const float* shift = mod + (size_t)cond * MODW + sh_idx * DM; const float* scale = mod + (size_t)cond * MODW + sc_idx * DM;
        const f32x4* xr = (const f32x4*)(XS + (size_t)R * DM) + C.lane;
        f32x4 v[8]; float ss = 0.f;
#pragma unroll
        for (int j = 0; j < 8; ++j) { v[j] = xr[64 * j]; ss += (v[j].x * v[j].x + v[j].y * v[j].y) + (v[j].z * v[j].z + v[j].w * v[j].w); }
        const float rstd = 1.0f / sqrtf(wave_sum(ss) * (1.0f / DM) + EPS);
        u32x2* o = (u32x2*)(H + (size_t)R * DM) + C.lane;
#pragma unroll
        for (int j = 0; j < 8; ++j) { const int c = (C.lane + 64 * j) * 4; const f32x4 wv = *(const f32x4*)(w + c), sc = *(const f32x4*)(scale + c), sh = *(const f32x4*)(shift + c);
            const f32x4 y = (v[j] * rstd * wv) * (1.0f + sc) + sh; u32x2 pk; pk.x = pk2(y.x, y.y); pk.y = pk2(y.z, y.w); o[64 * j] = pk; }
    }
}

__device__ __forceinline__ void phase_conv_etc(const Ctx& C, int e) {
    const bf16_t* P = WSP(bf16_t, WS_P); float* UC = WSP(float, WS_UC);
    const float* cw = C.in[10] + (size_t)e * 4 * DLRU; const float* cb = C.in[11] + (size_t)e * DLRU;
    for (int idx = C.gtid; idx < MROWS * DLRU; idx += C.ngt) { const int R = idx / DLRU, ch = idx % DLRU, s = R % SROW; const int lo = s < CTX ? 0 : CTX, hi = s < CTX ? CTX : SROW;
        float a = cb[ch];
#pragma unroll
        for (int j = 0; j < 4; ++j) { const int ss = s + j - 2; if (ss >= lo && ss < hi) a += bf2f(P[(size_t)(R + j - 2) * ABNP + DLRU + ch]) * cw[j * DLRU + ch]; }
        UC[idx] = a; }
    float* RSQ = WSP(float, WS_RSQ); float* RSKV = WSP(float, WS_RSKV);
    for (int R = C.gw; R < MROWS; R += C.ngw) {
        const u32x4 a = *(const u32x4*)(P + (size_t)R * ABNP + 2048 + 8 * C.lane), b = *(const u32x4*)(P + (size_t)R * ABNP + 2560 + 8 * C.lane);
        float sa = 0.f, sb = 0.f;
#pragma unroll
        for (int j = 0; j < 4; ++j) { const float a0 = __uint_as_float(a[j] << 16), a1 = __uint_as_float(a[j] & 0xffff0000u), b0 = __uint_as_float(b[j] << 16), b1 = __uint_as_float(b[j] & 0xffff0000u);
            sa += a0 * a0 + a1 * a1; sb += b0 * b0 + b1 * b1; }
        sa = wave_sum(sa); sb = wave_sum(sb);
        if (C.lane == 0) { RSQ[R] = 1.0f / sqrtf(sa * (1.0f / 512.0f) + EPS); RSKV[R] = 1.0f / sqrtf(sb * (1.0f / 512.0f) + EPS); } }
    bf16_t* KR = WSP(bf16_t, WS_KR); const float* RC = WSP(float, WS_ROPE); const float* RS = RC + 1024;
    for (int idx = C.gtid; idx < MROWS * 32; idx += C.ngt) { const int R = idx / 32, p = idx % 32, s = R % SROW; const int i0 = p < 16 ? p : 32 + (p - 16);
        const float x0 = bf2f(P[(size_t)R * ABNP + 3072 + i0]), x1 = bf2f(P[(size_t)R * ABNP + 3072 + i0 + 16]); float o0 = x0, o1 = x1;
        if (s >= CTX) { const int t = s - CTX, pos = p < 16 ? t / 64 : t % 64; const float c = RC[pos * 16 + (p & 15)], sn = RS[pos * 16 + (p & 15)]; o0 = x0 * c - x1 * sn; o1 = x1 * c + x0 * sn; }
        KR[(size_t)R * 64 + i0] = (bf16_t)f2bf(o0); KR[(size_t)R * 64 + i0 + 16] = (bf16_t)f2bf(o1); }
}
__device__ __forceinline__ void phase_gates_naive(const Ctx& C, int e) {
    const float* UC = WSP(float, WS_UC); float* LA = WSP(float, WS_LA); float* LBv = WSP(float, WS_LBB);
    const float* wa = C.in[12] + (size_t)e * 2 * 8 * 128 * 128; const float* wx = C.in[14] + (size_t)e * 2 * 8 * 128 * 128;
    const float* ba = C.in[13] + (size_t)e * 2 * DLRU; const float* bx = C.in[15] + (size_t)e * 2 * DLRU; const float* lam = C.in[16] + (size_t)e * 2 * DLRU;
    for (int idx = C.gtid; idx < MROWS * DLRU; idx += C.ngt) { const int R = idx / DLRU, ch = idx % DLRU, h = ch / 128, ee = ch % 128;
        const float* u = UC + (size_t)R * DLRU + h * 128;
        const float* wa0 = wa + ((size_t)(0 * 8 + h) * 128) * 128 + ee; const float* wa1 = wa + ((size_t)(1 * 8 + h) * 128) * 128 + ee;
        const float* wx0 = wx + ((size_t)(0 * 8 + h) * 128) * 128 + ee; const float* wx1 = wx + ((size_t)(1 * 8 + h) * 128) * 128 + ee;
        float a0 = 0.f, a1 = 0.f, x0 = 0.f, x1 = 0.f;
#pragma unroll 4
        for (int d = 0; d < 128; ++d) { const float uv = u[d]; a0 += uv * wa0[d * 128]; a1 += uv * wa1[d * 128]; x0 += uv * wx0[d * 128]; x1 += uv * wx1[d * 128]; }
        const float ucv = UC[idx];
        { const float r = sigmoidf_(a0 + ba[ch]), ig = sigmoidf_(x0 + bx[ch]); const float la = -8.0f * r * log1pf(expf(-lam[ch])); LA[idx] = expf(la); LBv[idx] = sqrtf(-expm1f(2.0f * la)) * (ig * ucv); }
        { const float r = sigmoidf_(a1 + ba[DLRU + ch]), ig = sigmoidf_(x1 + bx[DLRU + ch]); const float la = -8.0f * r * log1pf(expf(-lam[DLRU + ch]));
          LA[(size_t)MROWS * DLRU + idx] = expf(la); LBv[(size_t)MROWS * DLRU + idx] = sqrtf(-expm1f(2.0f * la)) * (ig * ucv); } }
}
__device__ __forceinline__ void phase_scan_naive(const Ctx& C) {
    const float* LA = WSP(float, WS_LA); const float* LBv = WSP(float, WS_LBB); float* HS = WSP(float, WS_HS);
    if (C.tid < 64) for (int id = blockIdx.x * 64 + C.tid; id < NBATCH * DLRU; id += gridDim.x * 64) { const int b = id / DLRU, ch = id % DLRU;
        float h = 0.f;
#pragma unroll 8
        for (int s = 0; s < SROW; ++s) { const size_t i = (size_t)(b * SROW + s) * DLRU + ch; h = LA[i] * h + LBv[i]; HS[i] = h; }
        h = 0.f; const size_t d1 = (size_t)MROWS * DLRU;
#pragma unroll 8
        for (int s = CTX - 1; s >= 0; --s) { const size_t i = (size_t)(b * SROW + s) * DLRU + ch; h = LA[d1 + i] * h + LBv[d1 + i]; HS[i] += h; }
#pragma unroll 8
        for (int s = SROW - 1; s >= CTX; --s) { const size_t i = (size_t)(b * SROW + s) * DLRU + ch; h = LA[d1 + i] * h + LBv[d1 + i]; HS[i] += h; } }
    bf16_t* Q = WSP(bf16_t, WS_Q); const float* RC = WSP(float, WS_ROPE); const float* RS = RC + 1024;
    for (int idx = C.gtid; idx < MROWS * 8 * 32; idx += C.ngt) { const int R = idx / 256, rem = idx % 256, hh = rem / 32, p = rem % 32, s = R % SROW; if (s < CTX) continue;
        const int i0 = p < 16 ? p : 32 + (p - 16); bf16_t* q = Q + (size_t)R * QW + hh * 192 + 128 + i0;
        const float x0 = bf2f(q[0]), x1 = bf2f(q[16]); const int t = s - CTX, pos = p < 16 ? t / 64 : t % 64; const float c = RC[pos * 16 + (p & 15)], sn = RS[pos * 16 + (p & 15)];
        q[0] = (bf16_t)f2bf(x0 * c - x1 * sn); q[16] = (bf16_t)f2bf(x1 * c + x0 * sn); }
}
__device__ __forceinline__ void phase_attn_naive(const Ctx& C) {
    const bf16_t* P = WSP(bf16_t, WS_P); const float* HS = WSP(float, WS_HS); bf16_t* Y = WSP(bf16_t, WS_Y);
    for (int idx = C.gtid; idx < MROWS * DLRU; idx += C.ngt) { const int R = idx / DLRU, ch = idx % DLRU; Y[(size_t)R * DM + ch] = (bf16_t)f2bf(HS[idx] * gelu_tanh(bf2f(P[(size_t)R * ABNP + ch]))); }
    const bf16_t* Q = WSP(bf16_t, WS_Q); const bf16_t* KV = WSP(bf16_t, WS_KV); const bf16_t* KR = WSP(bf16_t, WS_KR);
    LAS float* qs = (LAS float*)(C.lds + C.wave * 4096); LAS float* ps = qs + 768;
    for (int u = C.gw; u < (MROWS / 4) * 8; u += C.ngw) { const int hh = u % 8, R0 = (u / 8) * 4, b = R0 / SROW, s0 = R0 % SROW, nk = s0 < CTX ? CTX : SROW, kb = b * SROW;
        __builtin_amdgcn_wave_barrier();
        for (int i = C.lane; i < 768; i += 64) { const int qi = i / 192, d = i % 192; qs[i] = bf2f(Q[(size_t)(R0 + qi) * QW + hh * 192 + d]) * ATTN_SCALE; }
        __builtin_amdgcn_wave_barrier();
        float m[4], l[4], o0[4], o1[4];
#pragma unroll
        for (int qi = 0; qi < 4; ++qi) { m[qi] = -1e30f; l[qi] = 0.f; o0[qi] = 0.f; o1[qi] = 0.f; }
        for (int k0 = 0; k0 < nk; k0 += 64) { const size_t kr = (size_t)(kb + k0 + C.lane);
            float sc[4] = {0.f, 0.f, 0.f, 0.f};
            for (int d8 = 0; d8 < 24; ++d8) { const u32x4 kk = d8 < 16 ? *(const u32x4*)(KV + kr * KVW + hh * 256 + d8 * 8) : *(const u32x4*)(KR + kr * 64 + (d8 - 16) * 8);
                float kf[8];
#pragma unroll
                for (int j = 0; j < 4; ++j) { kf[2 * j] = __uint_as_float(kk[j] << 16); kf[2 * j + 1] = __uint_as_float(kk[j] & 0xffff0000u); }
#pragma unroll
                for (int qi = 0; qi < 4; ++qi) { const f32x4 qa = *(const LAS f32x4*)(qs + qi * 192 + d8 * 8), qb = *(const LAS f32x4*)(qs + qi * 192 + d8 * 8 + 4);
                    sc[qi] += kf[0] * qa[0] + kf[1] * qa[1] + kf[2] * qa[2] + kf[3] * qa[3] + kf[4] * qb[0] + kf[5] * qb[1] + kf[6] * qb[2] + kf[7] * qb[3]; } }
            __builtin_amdgcn_wave_barrier();
#pragma unroll
            for (int qi = 0; qi < 4; ++qi) { const float mx = wave_max(sc[qi]); const float mn = fmaxf(m[qi], mx); const float alpha = expf(m[qi] - mn); const float p = expf(sc[qi] - mn);
                ps[qi * 64 + C.lane] = p; l[qi] = l[qi] * alpha + wave_sum(p); o0[qi] *= alpha; o1[qi] *= alpha; m[qi] = mn; }
            __builtin_amdgcn_wave_barrier();
            for (int kk = 0; kk < 64; ++kk) { const bf16_t* vr = KV + (size_t)(kb + k0 + kk) * KVW + hh * 256 + 128; const float v0 = bf2f(vr[C.lane]), v1 = bf2f(vr[64 + C.lane]);
#pragma unroll
                for (int qi = 0; qi < 4; ++qi) { const float pp = ps[qi * 64 + kk]; o0[qi] += pp * v0; o1[qi] += pp * v1; } }
        }
#pragma unroll
        for (int qi = 0; qi < 4; ++qi) { bf16_t* yo = Y + (size_t)(R0 + qi) * DM + DLRU + hh * 128; const float il = 1.0f / l[qi]; yo[C.lane] = (bf16_t)f2bf(o0[qi] * il); yo[64 + C.lane] = (bf16_t)f2bf(o1[qi] * il); }
    }
}
__device__ __forceinline__ void phase_hgrn_naive(const Ctx& C) {
    const bf16_t* QH = WSP(bf16_t, WS_QH); const float* LOGF = WSP(float, WS_LOGF); const bf16_t* VH = WSP(bf16_t, WS_VH); float* O = WSP(float, WS_O);
    LAS float* fs = (LAS float*)C.lds;
    LAS float* qsh = fs + 1024;
    const int g4 = C.tid >> 7, e = C.tid & 127;
    for (int bg = blockIdx.x; bg < 8; bg += gridDim.x) { const int grp = bg * 4 + g4, b = grp / 16, hh = grp % 16, col = hh * 128 + e;
        for (int dir = 0; dir < 2; ++dir) {
            float st[128];
#pragma unroll
            for (int d = 0; d < 128; ++d) st[d] = 0.f;
            const float* lf = LOGF + (size_t)dir * MROWS * DM;
            size_t R = (size_t)b * SROW + (dir == 0 ? 0 : CTX - 1);
            float nlf = lf[R * DM + col], nq = bf2f(QH[R * DM + col]), nv = bf2f(VH[R * DM + col]);
            for (int step = 0; step < SROW; ++step) {
                const size_t Rc = R; const float f_ = expf(nlf), q_ = nq, vv = nv;
                if (step + 1 < SROW) { const int s1 = step + 1; const int sidx = dir == 0 ? s1 : (s1 < CTX ? CTX - 1 - s1 : SROW + CTX - 1 - s1); R = (size_t)b * SROW + sidx;
                    nlf = lf[R * DM + col]; nq = bf2f(QH[R * DM + col]); nv = bf2f(VH[R * DM + col]); }
                const int buf = step & 1;
                fs[(buf * 4 + g4) * 128 + e] = f_; qsh[(buf * 4 + g4) * 128 + e] = q_;
                __syncthreads();
                const LAS f32x4* fp = (const LAS f32x4*)(fs + (buf * 4 + g4) * 128); const LAS f32x4* qp = (const LAS f32x4*)(qsh + (buf * 4 + g4) * 128);
                float o = 0.f;
#pragma unroll
                for (int d4 = 0; d4 < 32; ++d4) { const f32x4 f4 = fp[d4], q4 = qp[d4];
#pragma unroll
                    for (int j = 0; j < 4; ++j) { const float f = f4[j]; st[d4 * 4 + j] = f * st[d4 * 4 + j] + (1.0f - f) * vv; o += q4[j] * st[d4 * 4 + j]; } }
                if (dir == 0) O[Rc * DM + col] = o; else O[Rc * DM + col] += o;
            }
            __syncthreads();
        }
    }
}
__device__ __forceinline__ void phase_hg_readout(const Ctx& C, int o_idx) {
    const float* O = WSP(float, WS_O); const bf16_t* GH = WSP(bf16_t, WS_GH); bf16_t* Y = WSP(bf16_t, WS_Y); const float* nw = C.in[23] + o_idx * 128;
    const float w0 = nw[C.lane], w1 = nw[64 + C.lane];
    for (int u = C.gw; u < MROWS * 16; u += C.ngw) { const size_t base = (size_t)(u / 16) * DM + (u % 16) * 128;
        const float a = O[base + C.lane], b = O[base + 64 + C.lane]; const float rstd = 1.0f / sqrtf(wave_sum(a * a + b * b) * (1.0f / 128.0f) + EPS);
        Y[base + C.lane] = (bf16_t)f2bf(a * rstd * w0 * bf2f(GH[base + C.lane])); Y[base + 64 + C.lane] = (bf16_t)f2bf(b * rstd * w1 * bf2f(GH[base + 64 + C.lane])); }
}
__device__ __forceinline__ void phase_final(const Ctx& C) {
    const float* XS = WSP(float, WS_XS); const float* w = C.in[27];
    for (int r = C.gw; r < NBATCH * SEQ; r += C.ngw) { const int b = r / SEQ, t = r % SEQ; const size_t R = (size_t)b * SROW + CTX + t;
        const f32x4* xr = (const f32x4*)(XS + R * DM) + C.lane; f32x4 v[8]; float ss = 0.f;
#pragma unroll
        for (int j = 0; j < 8; ++j) { v[j] = xr[64 * j]; ss += (v[j].x * v[j].x + v[j].y * v[j].y) + (v[j].z * v[j].z + v[j].w * v[j].w); }
        const float rstd = 1.0f / sqrtf(wave_sum(ss) * (1.0f / DM) + EPS);
        f32x4* o = (f32x4*)(C.out + (size_t)r * DM) + C.lane;
#pragma unroll
        for (int j = 0; j < 8; ++j) { const f32x4 wv = *(const f32x4*)(w + (C.lane + 64 * j) * 4); o[64 * j] = v[j] * rstd * wv; } }
}

struct Args { const float* in[28]; float* out; unsigned char* ws; int ph_lo, ph_hi; };
constexpr int N_PHASES = 1 + 2 * 12 + 2 * 8 + 1;

__global__ void __launch_bounds__(512, 2) fwd_kernel(Args args) {
    extern __shared__ __attribute__((aligned(16))) unsigned char lds_raw[];
    LAS unsigned char* const lds0 = (LAS unsigned char*)lds_raw;
    const unsigned long long inaddr = (unsigned long long)__builtin_amdgcn_kernarg_segment_ptr();
    volatile LAS unsigned* misc = (volatile LAS unsigned*)(lds0 + LDS_MISC);
    if (threadIdx.x < 64) misc[threadIdx.x] = 0u;
    __syncthreads();
    const int lo = args.ph_lo, hi = args.ph_hi;
    XcdBarrier bar; bar.bar = (unsigned*)(args.ws + WS_CTL) + 4096; bar.x = 0; bar.st = misc + 8;
    if (hi - lo > 1) bar = xcd_barrier_post((unsigned*)(args.ws + WS_CTL) + 4096, misc + 8);
    int pid = 0;
    const unsigned long long wsaddr = (unsigned long long)args.ws;
#define PH_BEGIN if (pid >= lo && pid < hi) { int l = l_; Ctx C; { unsigned long long a_ = inaddr, w_ = wsaddr; int t_ = threadIdx.x; asm volatile("" : "+s"(a_), "+s"(w_), "+s"(l), "+v"(t_)); \
        C.in = (InPtr)a_; C.ws = (unsigned char*)w_; C.out = args.out; C.lds = lds0; C.tid = t_; C.lane = t_ & 63; C.wave = __builtin_amdgcn_readfirstlane(t_ >> 6); \
        C.gw = blockIdx.x * 8 + C.wave; C.ngw = gridDim.x * 8; C.gtid = blockIdx.x * 512 + t_; C.ngt = gridDim.x * 512; } \
        const int e = l >> 1; const float* mod = WSP(float, WS_MOD) + (size_t)l * 3 * MODW; const int G = gridDim.x, cb = blockIdx.x; (void)e; (void)mod; (void)G; (void)cb;
#define PH_END } if (pid >= lo && pid + 1 < hi) xcd_barrier(bar); ++pid;
    int l_ = 0;
    PH_BEGIN
#ifndef SKIP_PRO
    phase_prologue(C);
#endif
    PH_END

    for (l_ = 0; l_ < DEPTH; ++l_) {
        PH_BEGIN phase_norm_mod(C, C.in[6] + l * DM, mod, 0, 1); PH_END
        if ((l_ & 1) == 0) {
            PH_BEGIN { pg8::Gemm g{WSP(bf16_t, WS_H), WSP(bf16_t, WS_WABIN) + (size_t)e * ABNP * DM, MROWS, ABNP, DM, DM, DM}; pg8::StaticOrder S; S.init(MROWS, ABNP, G, cb);
                       EpiBf16Plain E{WSP(bf16_t, WS_P), ABNP}; pg8::gemm_phase(C.lds, C.tid, g, S, E); } PH_END
            PH_BEGIN phase_conv_etc(C, e); PH_END
            PH_BEGIN phase_gates_naive(C, e); PH_END
            PH_BEGIN { pg8::Gemm g{WSP(bf16_t, WS_P) + 2048, WSP(bf16_t, WS_WUQ) + (size_t)e * QW * 512, MROWS, QW, 512, ABNP, 512}; pg8::StaticOrder S; S.init(MROWS, QW, G, cb);
                       EpiBf16RowScale E{WSP(bf16_t, WS_Q), QW, WSP(float, WS_RSQ)}; pg8::gemm_phase(C.lds, C.tid, g, S, E); } PH_END
            PH_BEGIN { pg8::Gemm g{WSP(bf16_t, WS_P) + 2560, WSP(bf16_t, WS_WUKV) + (size_t)e * KVW * 512, MROWS, KVW, 512, ABNP, 512}; pg8::StaticOrder S; S.init(MROWS, KVW, G, cb);
                       EpiBf16RowScale E{WSP(bf16_t, WS_KV), KVW, WSP(float, WS_RSKV)}; pg8::gemm_phase(C.lds, C.tid, g, S, E); } PH_END
            PH_BEGIN phase_scan_naive(C); PH_END
            PH_BEGIN
#ifndef SKIP_ATTN
            phase_attn_naive(C);
#endif
            PH_END
        } else {
            PH_BEGIN { pg8::Gemm g{WSP(bf16_t, WS_H), WSP(bf16_t, WS_WHGIN) + (size_t)e * HGN * DM, MROWS, HGN, DM, DM, DM}; pg8::StaticOrder S; S.init(MROWS, HGN, G, cb);
                       EpiHG E{WSP(bf16_t, WS_QH), WSP(float, WS_LOGF), WSP(float, WS_LB) + l * 2048}; pg8::gemm_phase(C.lds, C.tid, g, S, E); } PH_END
            PH_BEGIN
#ifndef SKIP_HGRN
            phase_hgrn_naive(C);
#endif
            PH_END
            PH_BEGIN phase_hg_readout(C, e); PH_END
        }
        PH_BEGIN { const bf16_t* wout = (l & 1) ? WSP(bf16_t, WS_WHGOUT) + (size_t)e * DM * DM : WSP(bf16_t, WS_WABOUT) + (size_t)e * DM * DM;
                   pg8::Gemm g{WSP(bf16_t, WS_Y), wout, MROWS, DM, DM, DM, DM}; pg8::StaticOrder S; S.init(MROWS, DM, G, cb);
                   EpiResid E{WSP(float, WS_XS), mod + 2 * DM}; pg8::gemm_phase(C.lds, C.tid, g, S, E); } PH_END
        PH_BEGIN phase_norm_mod(C, C.in[7] + l * DM, mod, 3, 4); PH_END
        PH_BEGIN { pg8::Gemm g{WSP(bf16_t, WS_H), WSP(bf16_t, WS_W1) + (size_t)l * DFF * DM, MROWS, DFF, DM, DM, DM}; pg8::StaticOrder S; S.init(MROWS, DFF, G, cb);
                   EpiRelu2 E{WSP(bf16_t, WS_HID), DFF}; pg8::gemm_phase(C.lds, C.tid, g, S, E); } PH_END
        PH_BEGIN { pg8::Gemm g{WSP(bf16_t, WS_HID), WSP(bf16_t, WS_W2) + (size_t)l * DM * DFF, MROWS, DM, DFF, DFF, DFF}; pg8::StaticOrder S; S.init(MROWS, DM, G, cb);
                   EpiResid E{WSP(float, WS_XS), mod + 5 * DM}; pg8::gemm_phase(C.lds, C.tid, g, S, E); } PH_END
    }
    l_ = 0;
    PH_BEGIN phase_final(C); PH_END
}

#ifndef N_LAUNCH_MODE
#define N_LAUNCH_MODE 1
#endif
extern "C" void kernel_launch(void* const* d_in, const int* in_sizes, int n_in, void* d_out, int out_size, void* d_ws, size_t ws_size, hipStream_t stream) {
    static int grid = 0;
    if (grid == 0) {
        if (n_in != 28 || out_size != NBATCH * SEQ * DM || ws_size < WS_END) { fprintf(stderr, "kernel_launch: shape mismatch n_in %d out %d ws %zu (need %zu)\n", n_in, out_size, ws_size, (size_t)WS_END); grid = -1; return; }
        int dev = 0, cus = 0, per_cu = 0;
        if (hipGetDevice(&dev) != hipSuccess || hipDeviceGetAttribute(&cus, hipDeviceAttributeMultiprocessorCount, dev) != hipSuccess) { grid = -1; return; }
        if (hipFuncSetAttribute((const void*)fwd_kernel, hipFuncAttributeMaxDynamicSharedMemorySize, LDS_BYTES) != hipSuccess) { fprintf(stderr, "kernel_launch: hipFuncSetAttribute failed\n"); grid = -1; return; }
        if (hipOccupancyMaxActiveBlocksPerMultiprocessor(&per_cu, (const void*)fwd_kernel, 512, LDS_BYTES) != hipSuccess || per_cu < 1) fprintf(stderr, "kernel_launch: occupancy query says %d\n", per_cu);
        (void)hipGetLastError();
        grid = cus;
    }
    if (grid < 0) return;
    (void)hipMemsetAsync((char*)d_ws + WS_CTL, 0, CTL_BYTES, stream);
    Args a{};
    for (int i = 0; i < 28; ++i) a.in[i] = (const float*)d_in[i];
    a.out = (float*)d_out; a.ws = (unsigned char*)d_ws;
#if N_LAUNCH_MODE == 1
    a.ph_lo = 0; a.ph_hi = N_PHASES;
    hipLaunchKernelGGL(fwd_kernel, dim3(grid), dim3(512), LDS_BYTES, stream, a);
#else
    for (int p = 0; p < N_PHASES; ++p) { a.ph_lo = p; a.ph_hi = p + 1; hipLaunchKernelGGL(fwd_kernel, dim3(grid), dim3(512), LDS_BYTES, stream, a); }
#endif
    const hipError_t le = hipPeekAtLastError();
    if (le != hipSuccess) fprintf(stderr, "kernel_launch: launch failed: %s\n", hipGetErrorName(le));
}
```

```cpp
#include <hip/hip_runtime.h>
#include <cstdio>

#define LAS __attribute__((address_space(3)))
typedef unsigned short bf16_t;
typedef short bf16x8 __attribute__((ext_vector_type(8)));
typedef float f32x4 __attribute__((ext_vector_type(4)));
typedef float f32x2 __attribute__((ext_vector_type(2)));
typedef unsigned u32x4 __attribute__((ext_vector_type(4)));
typedef unsigned u32x2 __attribute__((ext_vector_type(2)));

constexpr int DM = 2048, NBATCH = 2, SEQ = 4096, DEPTH = 4, CTX = 256;
constexpr int SROW = CTX + SEQ;
constexpr int MROWS = NBATCH * SROW;
constexpr int DFF = 8192, MODW = 6 * DM;
constexpr int DLRU = 1024;
constexpr int ABN = 3136, ABNP = 3328;
constexpr int QW = 1536, KVW = 2048, HGN = 10240;
constexpr float EPS = 1e-6f;
constexpr float ATTN_SCALE = 0.07216878364870322f;

constexpr size_t al256(size_t x) { return (x + 255) & ~(size_t)255; }
constexpr size_t WS_CTL = 0, CTL_BYTES = 1u << 20;
constexpr size_t WS_MOD = WS_CTL + CTL_BYTES;
constexpr size_t WS_LB = WS_MOD + al256((size_t)DEPTH * 3 * MODW * 4);
constexpr size_t WS_ROPE = WS_LB + al256((size_t)DEPTH * 2048 * 4);
constexpr size_t WS_RSQ = WS_ROPE + al256(2 * 64 * 16 * 4);
constexpr size_t WS_RSKV = WS_RSQ + al256((size_t)MROWS * 4);
constexpr size_t WS_WABIN = WS_RSKV + al256((size_t)MROWS * 4);
constexpr size_t WS_WABOUT = WS_WABIN + (size_t)2 * ABNP * DM * 2;
constexpr size_t WS_WUQ = WS_WABOUT + (size_t)2 * DM * DM * 2;
constexpr size_t WS_WUKV = WS_WUQ + (size_t)2 * QW * 512 * 2;
constexpr size_t WS_WHGIN = WS_WUKV + (size_t)2 * KVW * 512 * 2;
constexpr size_t WS_WHGOUT = WS_WHGIN + (size_t)2 * HGN * DM * 2;
constexpr size_t WS_W1 = WS_WHGOUT + (size_t)2 * DM * DM * 2;
constexpr size_t WS_W2 = WS_W1 + (size_t)4 * DFF * DM * 2;
constexpr size_t WS_XS = WS_W2 + (size_t)4 * DFF * DM * 2;
constexpr size_t WS_H = WS_XS + (size_t)MROWS * DM * 4;
constexpr size_t WS_Y = WS_H + (size_t)MROWS * DM * 2;
constexpr size_t WS_BIG = WS_Y + (size_t)MROWS * DM * 2;
constexpr size_t WS_P = WS_BIG;
constexpr size_t WS_UC = WS_P + (size_t)MROWS * ABNP * 2;
constexpr size_t WS_LA = WS_UC + (size_t)MROWS * DLRU * 4;
constexpr size_t WS_LBB = WS_LA + (size_t)2 * MROWS * DLRU * 4;
constexpr size_t WS_HS = WS_LBB + (size_t)2 * MROWS * DLRU * 4;
constexpr size_t WS_Q = WS_HS + (size_t)MROWS * DLRU * 4;
constexpr size_t WS_KV = WS_Q + (size_t)MROWS * QW * 2;
constexpr size_t WS_KR = WS_KV + (size_t)MROWS * KVW * 2;
constexpr size_t WS_AB_END = WS_KR + (size_t)MROWS * 64 * 2;
constexpr size_t WS_QH = WS_BIG;
constexpr size_t WS_VH = WS_QH + (size_t)MROWS * DM * 2;
constexpr size_t WS_GH = WS_VH + (size_t)MROWS * DM * 2;
constexpr size_t WS_LOGF = WS_GH + (size_t)MROWS * DM * 2;
constexpr size_t WS_O = WS_LOGF + (size_t)2 * MROWS * DM * 4;
constexpr size_t WS_HG_END = WS_O + (size_t)MROWS * DM * 4;
constexpr size_t WS_HID = WS_BIG;
constexpr size_t WS_MLP_END = WS_HID + (size_t)MROWS * DFF * 2;
constexpr size_t cmax(size_t a, size_t b) { return a > b ? a : b; }
constexpr size_t WS_END = cmax(cmax(WS_AB_END, WS_HG_END), WS_MLP_END);

constexpr int LDS_BYTES = 147456;
constexpr int LDS_MISC = 131072;

__device__ __forceinline__ float bf2f(bf16_t v) { return __uint_as_float(((unsigned)v) << 16); }
__device__ __forceinline__ unsigned f2bf(float f) { unsigned u = __float_as_uint(f); return (u + 0x7fffu + ((u >> 16) & 1u)) >> 16; }
__device__ __forceinline__ unsigned pk2(float lo, float hi) { return f2bf(lo) | (f2bf(hi) << 16); }
__device__ __forceinline__ float wave_sum(float v) {
#pragma unroll
    for (int o = 1; o < 64; o <<= 1) v += __shfl_xor(v, o);
    return v;
}
__device__ __forceinline__ float wave_max(float v) {
#pragma unroll
    for (int o = 1; o < 64; o <<= 1) v = fmaxf(v, __shfl_xor(v, o));
    return v;
}
__device__ __forceinline__ float sigmoidf_(float x) { return 1.0f / (1.0f + expf(-x)); }
__device__ __forceinline__ float siluf_(float x) { return x / (1.0f + expf(-x)); }
__device__ __forceinline__ float gelu_tanh(float x) { const float u = 0.7978845608028654f * (x + 0.044715f * x * x * x); return 0.5f * x * (1.0f + tanhf(u)); }

#define XB_TMO      128
#define XB_XCNT(j)  (256  + 64 * (j))
#define XB_XSUB(j)  (1280 + 64 * (j))
#define XB_XGEN(j)  (2304 + 64 * (j))
#define XB_TOP      3328
#define XB_TOPGEN   3392
#define XCD_BAR_WORDS 3456
#define XB_SPIN_CAP (1u << 18)
__device__ __forceinline__ unsigned xb_ld(unsigned* p)              { return __hip_atomic_load(p, __ATOMIC_RELAXED, __HIP_MEMORY_SCOPE_AGENT); }
__device__ __forceinline__ unsigned xb_add(unsigned* p, unsigned v) { return __hip_atomic_fetch_add(p, v, __ATOMIC_RELAXED, __HIP_MEMORY_SCOPE_AGENT); }
__device__ __forceinline__ unsigned xb_xcc_id() { return (unsigned)__builtin_amdgcn_s_getreg((3 << 11) | 20) & 0xFu; }
#define XB_SPIN(cond, bar) do { unsigned _sp = 0; while (cond) { __builtin_amdgcn_s_sleep(1); \
    if ((++_sp & 255u) == 0u) { if (xb_ld(&(bar)[XB_TMO])) break; if (_sp > XB_SPIN_CAP) { atomicAdd(&(bar)[XB_TMO], 1u); break; } } } } while (0)
struct XcdBarrier { unsigned* bar; unsigned x; volatile LAS unsigned* st; };
__device__ __forceinline__ XcdBarrier xcd_barrier_post(unsigned* bar, volatile LAS unsigned* st) {
    XcdBarrier b; b.bar = bar; b.x = xb_xcc_id(); b.st = st;
    if (threadIdx.x == 0) (void)xb_add(&bar[XB_XCNT(b.x)], 1u);
    return b;
}
__device__ __forceinline__ void xcd_barrier_complete(unsigned* bar, unsigned x, unsigned& nloc, unsigned& nx) {
    const unsigned G = gridDim.x * gridDim.y * gridDim.z;
    unsigned sum, cnt, mine, sp = 0u;
    for (;;) {
        sum = 0u; cnt = 0u; mine = 0u;
#pragma unroll
        for (unsigned j = 0; j < 16; ++j) { const unsigned c = xb_ld(&bar[XB_XCNT(j)]); sum += c; cnt += (c > 0u) ? 1u : 0u; mine = (j == x) ? c : mine; }
        if (sum == G) break;
        __builtin_amdgcn_s_sleep(1);
        if ((++sp & 255u) == 0u) { if (xb_ld(&bar[XB_TMO])) break; if (sp > XB_SPIN_CAP) { atomicAdd(&bar[XB_TMO], 1u); break; } }
    }
    nloc = mine > 0u ? mine : 1u; nx = cnt > 0u ? cnt : 1u;
}
__device__ __forceinline__ void xcd_barrier(const XcdBarrier& b) {
    asm volatile("s_waitcnt vmcnt(0)" ::: "memory");
    __syncthreads();
    if (threadIdx.x == 0) {
        unsigned* bar = b.bar;
        __builtin_amdgcn_s_waitcnt(0);
        unsigned nloc = b.st[0], nx = b.st[1];
        if (nloc == 0u) { xcd_barrier_complete(bar, b.x, nloc, nx); b.st[0] = nloc; b.st[1] = nx; }
        const unsigned old = xb_add(&bar[XB_XSUB(b.x)], 1u);
        const unsigned gen = old / nloc;
        if (old + 1u == (gen + 1u) * nloc) {
            __builtin_amdgcn_fence(__ATOMIC_RELEASE, "agent");
            asm volatile("s_waitcnt vmcnt(0)" ::: "memory");
            const unsigned og = xb_add(&bar[XB_TOP], 1u);
            const unsigned tg = og / nx;
            if (og + 1u == (tg + 1u) * nx) xb_add(&bar[XB_TOPGEN], 1u);
            else XB_SPIN(xb_ld(&bar[XB_TOPGEN]) == tg, bar);
            __builtin_amdgcn_fence(__ATOMIC_ACQUIRE, "agent");
            xb_add(&bar[XB_XGEN(b.x)], 1u);
            asm volatile("s_waitcnt vmcnt(0)" ::: "memory");
        } else {
            XB_SPIN(xb_ld(&bar[XB_XGEN(b.x)]) == gen, bar);
            __builtin_amdgcn_fence(__ATOMIC_ACQUIRE, "agent");
            asm volatile("s_waitcnt vmcnt(0)" ::: "memory");
        }
    }
    __syncthreads();
}

namespace pg8 {
constexpr int BM = 256, BK = 64, HALF = 128, HTB = HALF * BK * 2, STAGE_BYTES = 8 * HTB, NXCD = 8, WGM = 8;
__host__ __device__ __forceinline__ int lds_byte(int r, int c) { const int st = (r >> 4) * 2 + (c >> 5), rr = r & 15, cc = c & 31, ob = rr * 64 + cc * 2; return st * 1024 + (ob ^ (((ob >> 9) & 1) << 5)); }
__host__ __device__ __forceinline__ void stage_rc(int b, int& R, int& C) { const int st = b / 1024, sb = b % 1024, swz = sb ^ (((sb >> 9) & 1) << 5); R = (st >> 1) * 16 + swz / 64; C = (st & 1) * 32 + (swz % 64) / 2; }
__host__ __device__ __forceinline__ int perm32(int rho) { const int n = rho >> 4, i = rho & 15; return 8 * (i >> 2) + 4 * n + (i & 3); }
struct Unit { int pm, pn; };
struct Gemm { const bf16_t* A; const bf16_t* Bt; int M, N, K, lda, ldb; };
struct StaticOrder {
    int nM, nN, nwg, G, c;
    __host__ __device__ void init(int M, int N, int G_, int c_) { nM = M / BM; nN = N / BM; nwg = nM * nN; G = G_; c = c_; }
    __host__ __device__ bool next(int i, Unit& u) const {
        const long L = (long)i * G + c; if (L >= nwg) return false;
        int wgid = (int)L; { const int q = nwg / NXCD, r = nwg % NXCD, xcd = wgid % NXCD, off = wgid / NXCD; wgid = (xcd < r ? xcd * (q + 1) : r * (q + 1) + (xcd - r) * q) + off; }
        const int nig = WGM * nN, gid = wgid / nig, fm = gid * WGM, gsz = (nM - fm) < WGM ? (nM - fm) : WGM;
        u.pm = fm + ((wgid % nig) % gsz); u.pn = (wgid % nig) / gsz; return true;
    }
};
__device__ __forceinline__ unsigned cvt_pk_bf16(float lo, float hi) { unsigned r; asm volatile("v_cvt_pk_bf16_f32 %0, %1, %2" : "=v"(r) : "v"(lo), "v"(hi)); return r; }

template <class Epi>
__device__ __forceinline__ void gemm_phase(LAS unsigned char* lds, const int tid, const Gemm g, const StaticOrder& S, const Epi& E) {
    const int wid = __builtin_amdgcn_readfirstlane(tid >> 6), lane = tid & 63, wr = wid >> 2, wc = wid & 3, fr = lane & 15, fq = lane >> 4;
    const int K = g.K, nt = K / BK;
    unsigned voffA[2], voffB[2];
#pragma unroll
    for (int i = 0; i < 2; ++i) { int R, C; stage_rc(tid * 16 + i * 8192, R, C); const int Rb = Epi::PERM ? ((R & ~31) + perm32(R & 31)) : R;
        voffA[i] = (unsigned)(R * g.lda + C) * 2u; voffB[i] = (unsigned)(Rb * g.ldb + C) * 2u; }
    const size_t kstep = (size_t)(BK * 2);
    const size_t hsA = (size_t)HALF * g.lda * 2, hsB = (size_t)HALF * g.ldb * 2;
    const size_t tsA = 2 * hsA, tsB = 2 * hsB;
    const unsigned ldsw = (unsigned)wid * 1024u;
    const int aoff = lds_byte(wr * 64 + fr, fq * 8), boff = lds_byte(wc * 32 + fr, fq * 8);
#define PG8_SA(b, h) (((b) * 2 + (h)) * HTB)
#define PG8_SB(b, h) ((4 + (b) * 2 + (h)) * HTB)
#define PG8_STAGE(bufoff, gbase, voff) do { _Pragma("unroll") for (int _i = 0; _i < 2; ++_i) \
        __builtin_amdgcn_global_load_lds((const unsigned*)((const char*)(gbase) + (voff)[_i]), (LAS unsigned*)(lds + (bufoff) + ldsw + _i * 8192), 16, 0, 0); } while (0)
#define PG8_LDA(dst, b, h) do { _Pragma("unroll") for (int m = 0; m < 4; ++m) _Pragma("unroll") for (int k = 0; k < 2; ++k) dst[m][k] = *(const LAS bf16x8*)(lds + PG8_SA(b, h) + aoff + m * 2048 + k * 1024); } while (0)
#define PG8_LDB(dst, b, h) do { _Pragma("unroll") for (int n = 0; n < 2; ++n) _Pragma("unroll") for (int k = 0; k < 2; ++k) dst[n][k] = *(const LAS bf16x8*)(lds + PG8_SB(b, h) + boff + n * 2048 + k * 1024); } while (0)
#define PG8_MMA(ai, bj, At, Bt) do { __builtin_amdgcn_s_setprio(1); _Pragma("unroll") for (int m = 0; m < 4; ++m) _Pragma("unroll") for (int n = 0; n < 2; ++n) _Pragma("unroll") for (int k = 0; k < 2; ++k) \
        acc[ai][bj][m][n] = __builtin_amdgcn_mfma_f32_16x16x32_bf16(Bt[n][k], At[m][k], acc[ai][bj][m][n], 0, 0, 0); __builtin_amdgcn_s_setprio(0); } while (0)
#define PG8_WAIT_V(n) asm volatile("s_waitcnt vmcnt(" #n ")" ::: "memory")
#define PG8_WAIT_L(n) asm volatile("s_waitcnt lgkmcnt(" #n ")" ::: "memory")
#define PG8_BAR __builtin_amdgcn_s_barrier()
#define PG8_SCHED __builtin_amdgcn_sched_barrier(0)
    Unit cur, nxt; int ui = 0;
    if (!S.next(0, cur)) return;
    f32x4 acc[2][2][4][2];
#pragma unroll
    for (int a = 0; a < 2; ++a)
#pragma unroll
        for (int b = 0; b < 2; ++b)
#pragma unroll
            for (int m = 0; m < 4; ++m)
#pragma unroll
                for (int n = 0; n < 2; ++n) acc[a][b][m][n] = (f32x4){0.f, 0.f, 0.f, 0.f};
    bf16x8 At[4][2], B0[2][2], B1[2][2];
    const char* cA = (const char*)g.A + (size_t)cur.pm * tsA; const char* cB = (const char*)g.Bt + (size_t)cur.pn * tsB;
    PG8_STAGE(PG8_SB(0, 0), cB, voffB); PG8_STAGE(PG8_SA(0, 0), cA, voffA); PG8_STAGE(PG8_SB(0, 1), cB + hsB, voffB); PG8_STAGE(PG8_SA(0, 1), cA + hsA, voffA);
    if (wr == 1) PG8_BAR;
    PG8_WAIT_V(4); PG8_BAR;
    PG8_STAGE(PG8_SB(1, 0), cB + kstep, voffB); PG8_STAGE(PG8_SA(1, 0), cA + kstep, voffA); PG8_STAGE(PG8_SB(1, 1), cB + hsB + kstep, voffB);
    PG8_WAIT_V(6); PG8_BAR;
    for (;;) {
        const bool has_next = S.next(ui + 1, nxt);
        const char* nA = has_next ? (const char*)g.A + (size_t)nxt.pm * tsA : cA; const char* nB = has_next ? (const char*)g.Bt + (size_t)nxt.pn * tsB : cB;
        for (int t = 0; t < nt; t += 2) {
            const bool last = (t == nt - 2);
            const char* a1 = cA + (size_t)(t + 1) * kstep;
            const char* a2 = last ? nA : cA + (size_t)(t + 2) * kstep; const char* b2 = last ? nB : cB + (size_t)(t + 2) * kstep;
            const char* a3 = a2 + kstep; const char* b3 = b2 + kstep;
            PG8_LDB(B0, 0, 0); PG8_SCHED; PG8_LDA(At, 0, 0); PG8_STAGE(PG8_SA(1, 1), a1 + hsA, voffA);
            PG8_WAIT_L(8); PG8_BAR; PG8_WAIT_L(0); PG8_MMA(0, 0, At, B0); PG8_BAR; PG8_SCHED;
            PG8_LDB(B1, 0, 1); PG8_STAGE(PG8_SB(0, 0), b2, voffB);
            PG8_BAR; PG8_WAIT_L(0); PG8_MMA(0, 1, At, B1); PG8_BAR;
            PG8_LDA(At, 0, 1); PG8_STAGE(PG8_SA(0, 0), a2, voffA);
            PG8_BAR; PG8_WAIT_L(0); PG8_MMA(1, 0, At, B0); PG8_BAR; PG8_SCHED;
            PG8_STAGE(PG8_SB(0, 1), b2 + hsB, voffB);
            PG8_WAIT_V(6); PG8_BAR; PG8_MMA(1, 1, At, B1); PG8_BAR;
            PG8_LDB(B0, 1, 0); PG8_SCHED; PG8_LDA(At, 1, 0); PG8_STAGE(PG8_SA(0, 1), a2 + hsA, voffA);
            PG8_WAIT_L(8); PG8_BAR; PG8_WAIT_L(0); PG8_MMA(0, 0, At, B0); PG8_BAR; PG8_SCHED;
            PG8_LDB(B1, 1, 1); PG8_STAGE(PG8_SB(1, 0), b3, voffB);
            PG8_BAR; PG8_WAIT_L(0); PG8_MMA(0, 1, At, B1); PG8_BAR;
            PG8_LDA(At, 1, 1); PG8_STAGE(PG8_SA(1, 0), a3, voffA);
            PG8_BAR; PG8_WAIT_L(0); PG8_MMA(1, 0, At, B0); PG8_BAR; PG8_SCHED;
            PG8_STAGE(PG8_SB(1, 1), b3 + hsB, voffB);
            PG8_WAIT_V(6); PG8_BAR; PG8_MMA(1, 1, At, B1); PG8_BAR;
        }
        E(acc, cur, wr, wc, fr, fq);
        if (!has_next) break;
#pragma unroll
        for (int a = 0; a < 2; ++a)
#pragma unroll
            for (int b = 0; b < 2; ++b)
#pragma unroll
                for (int m = 0; m < 4; ++m)
#pragma unroll
                    for (int n = 0; n < 2; ++n) acc[a][b][m][n] = (f32x4){0.f, 0.f, 0.f, 0.f};
        cur = nxt; cA = nA; cB = nB; ++ui;
    }
    PG8_WAIT_V(0);
    if (wr == 0) PG8_BAR;
    PG8_BAR;
#undef PG8_SA
#undef PG8_SB
#undef PG8_STAGE
#undef PG8_LDA
#undef PG8_LDB
#undef PG8_MMA
#undef PG8_WAIT_V
#undef PG8_WAIT_L
#undef PG8_BAR
#undef PG8_SCHED
}
}

#define EPI_ROWS_COLS_PERM \
    const int row0 = u.pm * 256 + wr * 64 + fr; const int col0 = u.pn * 256 + wc * 32 + 8 * fq;
struct EpiBf16Plain {
    static constexpr bool PERM = true;
    bf16_t* O; int ldc;
    __device__ __forceinline__ void operator()(const f32x4 (&acc)[2][2][4][2], const pg8::Unit& u, int wr, int wc, int fr, int fq) const {
        EPI_ROWS_COLS_PERM
#pragma unroll
        for (int ai = 0; ai < 2; ++ai)
#pragma unroll
            for (int m = 0; m < 4; ++m) { bf16_t* rowp = O + (size_t)(row0 + ai * 128 + m * 16) * ldc + col0;
#pragma unroll
                for (int bj = 0; bj < 2; ++bj) { const f32x4 v0 = acc[ai][bj][m][0], v1 = acc[ai][bj][m][1];
                    u32x4 w; w.x = pk2(v0[0], v0[1]); w.y = pk2(v0[2], v0[3]); w.z = pk2(v1[0], v1[1]); w.w = pk2(v1[2], v1[3]);
                    *(u32x4*)(rowp + bj * 128) = w; } }
    }
};
struct EpiBf16RowScale {
    static constexpr bool PERM = true;
    bf16_t* O; int ldc; const float* rs;
    __device__ __forceinline__ void operator()(const f32x4 (&acc)[2][2][4][2], const pg8::Unit& u, int wr, int wc, int fr, int fq) const {
        EPI_ROWS_COLS_PERM
#pragma unroll
        for (int ai = 0; ai < 2; ++ai)
#pragma unroll
            for (int m = 0; m < 4; ++m) { const int row = row0 + ai * 128 + m * 16; const float s = rs[row]; bf16_t* rowp = O + (size_t)row * ldc + col0;
#pragma unroll
                for (int bj = 0; bj < 2; ++bj) { const f32x4 v0 = acc[ai][bj][m][0] * s, v1 = acc[ai][bj][m][1] * s;
                    u32x4 w; w.x = pk2(v0[0], v0[1]); w.y = pk2(v0[2], v0[3]); w.z = pk2(v1[0], v1[1]); w.w = pk2(v1[2], v1[3]);
                    *(u32x4*)(rowp + bj * 128) = w; } }
    }
};
struct EpiRelu2 {
    static constexpr bool PERM = true;
    bf16_t* O; int ldc;
    __device__ __forceinline__ void operator()(const f32x4 (&acc)[2][2][4][2], const pg8::Unit& u, int wr, int wc, int fr, int fq) const {
        EPI_ROWS_COLS_PERM
#pragma unroll
        for (int ai = 0; ai < 2; ++ai)
#pragma unroll
            for (int m = 0; m < 4; ++m) { bf16_t* rowp = O + (size_t)(row0 + ai * 128 + m * 16) * ldc + col0;
#pragma unroll
                for (int bj = 0; bj < 2; ++bj) { f32x4 v0 = acc[ai][bj][m][0], v1 = acc[ai][bj][m][1];
#pragma unroll
                    for (int j = 0; j < 4; ++j) { const float a = fmaxf(v0[j], 0.f), b = fmaxf(v1[j], 0.f); v0[j] = a * a; v1[j] = b * b; }
                    u32x4 w; w.x = pk2(v0[0], v0[1]); w.y = pk2(v0[2], v0[3]); w.z = pk2(v1[0], v1[1]); w.w = pk2(v1[2], v1[3]);
                    *(u32x4*)(rowp + bj * 128) = w; } }
    }
};
struct EpiResid {
    static constexpr bool PERM = false;
    float* XS; const float* gate;
    __device__ __forceinline__ void operator()(const f32x4 (&acc)[2][2][4][2], const pg8::Unit& u, int wr, int wc, int fr, int fq) const {
        const int row0 = u.pm * 256 + wr * 64 + fr, col0 = u.pn * 256 + wc * 32 + 4 * fq;
        const int cond = (u.pm % 17 == 0) ? 2 : (u.pm / 17);
        const float* gp = gate + (size_t)cond * MODW + col0;
        f32x4 gv[2][2];
#pragma unroll
        for (int bj = 0; bj < 2; ++bj)
#pragma unroll
            for (int n = 0; n < 2; ++n) gv[bj][n] = *(const f32x4*)(gp + bj * 128 + n * 16);
#pragma unroll
        for (int ai = 0; ai < 2; ++ai)
#pragma unroll
            for (int m = 0; m < 4; ++m) { float* rowp = XS + (size_t)(row0 + ai * 128 + m * 16) * DM + col0;
#pragma unroll
                for (int bj = 0; bj < 2; ++bj)
#pragma unroll
                    for (int n = 0; n < 2; ++n) { f32x4* p = (f32x4*)(rowp + bj * 128 + n * 16); *p = *p + gv[bj][n] * acc[ai][bj][m][n]; } }
    }
};
struct EpiHG {
    static constexpr bool PERM = true;
    bf16_t* QVG; float* LOGF; const float* lb;
    __device__ __forceinline__ void operator()(const f32x4 (&acc)[2][2][4][2], const pg8::Unit& u, int wr, int wc, int fr, int fq) const {
        const int row0 = u.pm * 256 + wr * 64 + fr; const int seg = u.pn >> 3; const int col0 = (u.pn & 7) * 256 + wc * 32 + 8 * fq;
        if (seg == 1 || seg == 2) {
            float* base = LOGF + (size_t)(seg - 1) * MROWS * DM;
            f32x4 lbv[2][2];
#pragma unroll
            for (int bj = 0; bj < 2; ++bj)
#pragma unroll
                for (int n = 0; n < 2; ++n) lbv[bj][n] = *(const f32x4*)(lb + col0 + bj * 128 + 4 * n);
#pragma unroll
            for (int ai = 0; ai < 2; ++ai)
#pragma unroll
                for (int m = 0; m < 4; ++m) { float* rowp = base + (size_t)(row0 + ai * 128 + m * 16) * DM + col0;
#pragma unroll
                    for (int bj = 0; bj < 2; ++bj)
#pragma unroll
                        for (int n = 0; n < 2; ++n) { f32x4 v = acc[ai][bj][m][n];
#pragma unroll
                            for (int j = 0; j < 4; ++j) { const float l = lbv[bj][n][j]; v[j] = logf(l + (1.0f - l) * sigmoidf_(v[j])); }
                            *(f32x4*)(rowp + bj * 128 + 4 * n) = v; } }
        } else {
            const int bi = seg - 2 + (seg == 0 ? 2 : 0);
            bf16_t* base = QVG + (size_t)bi * MROWS * DM;
            const bool act = (seg != 3);
#pragma unroll
            for (int ai = 0; ai < 2; ++ai)
#pragma unroll
                for (int m = 0; m < 4; ++m) { bf16_t* rowp = base + (size_t)(row0 + ai * 128 + m * 16) * DM + col0;
#pragma unroll
                    for (int bj = 0; bj < 2; ++bj) { f32x4 v0 = acc[ai][bj][m][0], v1 = acc[ai][bj][m][1];
                        if (act) {
#pragma unroll
                            for (int j = 0; j < 4; ++j) { v0[j] = siluf_(v0[j]); v1[j] = siluf_(v1[j]); } }
                        u32x4 w; w.x = pk2(v0[0], v0[1]); w.y = pk2(v0[2], v0[3]); w.z = pk2(v1[0], v1[1]); w.w = pk2(v1[2], v1[3]);
                        *(u32x4*)(rowp + bj * 128) = w; } }
        }
    }
};


namespace att {
using s16x4  = __attribute__((ext_vector_type(4))) short;
using f32x16 = __attribute__((ext_vector_type(16))) float;
constexpr int NW = 8, QBLK = 32, KVBLK = 64;
constexpr float SCALE = ATTN_SCALE;
constexpr float THR = 8.f;
constexpr int SHM_V = KVBLK * 128 * 2, SHM_K = KVBLK * 128 * 2, SHM_KR = KVBLK * 64 * 2;
constexpr int OFF_V = 0, OFF_K = 2 * SHM_V, OFF_KR = OFF_K + 2 * SHM_K, OFF_WS = OFF_KR + 2 * SHM_KR, SHM_ATTN = OFF_WS + NW * 64 * 4;
constexpr int LDQ = QW, LDK = KVW, LDO = DM;
#define KSWZ(row, colB) ((row) * 256 + ((colB) ^ (((row) & 7) << 4)))
#define RSWZ(row, colB) ((row) * 128 + ((colB) ^ ((((row) >> 1) & 7) << 4)))
#define SBAR() __builtin_amdgcn_sched_barrier(0)
__device__ __forceinline__ int crow(int r, int hi) { return (r & 3) + 8 * (r >> 2) + 4 * hi; }
__device__ __forceinline__ unsigned cvtpk(float lo, float hi) { unsigned r; asm volatile("v_cvt_pk_bf16_f32 %0, %1, %2" : "=v"(r) : "v"(lo), "v"(hi)); return r; }
__device__ __forceinline__ bf16x8 ld8(const bf16_t* p) { return *reinterpret_cast<const bf16x8*>(p); }
__device__ __forceinline__ void partialSM(f32x16& p0, f32x16& p1, float& m_reg, float& mn, float& alpha) {
  constexpr float C = SCALE * 1.4426950408889634f;
  float pmax = p0[0];
#pragma unroll
  for (int r = 1; r < 16; ++r) pmax = fmaxf(pmax, p0[r]);
#pragma unroll
  for (int r = 0; r < 16; ++r) pmax = fmaxf(pmax, p1[r]);
  { auto rr = __builtin_amdgcn_permlane32_swap(__float_as_uint(pmax), __float_as_uint(pmax), false, false);
    pmax = fmaxf(__uint_as_float(rr[0]), __uint_as_float(rr[1])); }
  if (__builtin_expect(__all(pmax - m_reg <= THR / SCALE), 1)) { mn = m_reg; alpha = 1.f; }
  else { mn = fmaxf(m_reg, pmax); alpha = __builtin_amdgcn_exp2f((m_reg - mn) * C); m_reg = mn; }
  float mnC = -mn * C;
#pragma unroll
  for (int r = 0; r < 16; ++r) p0[r] = fmaf(p0[r], C, mnC);
#pragma unroll
  for (int r = 0; r < 16; ++r) p1[r] = fmaf(p1[r], C, mnC);
#pragma unroll
  for (int r = 0; r < 16; ++r) p0[r] = __builtin_amdgcn_exp2f(p0[r]);
}
__device__ __forceinline__ void finishSM(f32x16& p0, f32x16& p1, float alpha, float& l_reg, bf16x8& pa0, bf16x8& pa1, bf16x8& pa2, bf16x8& pa3) {
#pragma unroll
  for (int r = 0; r < 16; ++r) p1[r] = __builtin_amdgcn_exp2f(p1[r]);
  float ps = 0;
#pragma unroll
  for (int r = 0; r < 16; ++r) ps += p0[r];
#pragma unroll
  for (int r = 0; r < 16; ++r) ps += p1[r];
  { auto rr = __builtin_amdgcn_permlane32_swap(__float_as_uint(ps), __float_as_uint(ps), false, false);
    ps = __uint_as_float(rr[0]) + __uint_as_float(rr[1]); }
  l_reg = l_reg * alpha + ps;
#define PK4(P, BASE, OUT) do { unsigned a0 = cvtpk(P[BASE + 0], P[BASE + 1]), a1 = cvtpk(P[BASE + 2], P[BASE + 3]);   \
    unsigned b0 = cvtpk(P[BASE + 4], P[BASE + 5]), b1 = cvtpk(P[BASE + 6], P[BASE + 7]);                              \
    auto r0 = __builtin_amdgcn_permlane32_swap(a0, b0, false, false); auto r1 = __builtin_amdgcn_permlane32_swap(a1, b1, false, false); \
    u32x4 w = {r0[0], r1[0], r0[1], r1[1]}; OUT = *reinterpret_cast<bf16x8*>(&w); } while (0)
  PK4(p0, 0, pa0); PK4(p0, 8, pa1); PK4(p1, 0, pa2); PK4(p1, 8, pa3);
#undef PK4
}
__device__ __forceinline__ void qkt(f32x16& p0, f32x16& p1, const char* Ks, const char* Krs, const bf16x8* qr, int r32, int hi) {
  p0 = f32x16{}; p1 = f32x16{};
#pragma unroll
  for (int d0 = 0; d0 < 8; ++d0) { int cb = (d0 * 16 + hi * 8) * 2;
    bf16x8 b0 = *reinterpret_cast<const bf16x8*>(Ks + KSWZ(r32, cb));
    bf16x8 b1 = *reinterpret_cast<const bf16x8*>(Ks + KSWZ(32 + r32, cb));
    p0 = __builtin_amdgcn_mfma_f32_32x32x16_bf16(b0, qr[d0], p0, 0, 0, 0);
    p1 = __builtin_amdgcn_mfma_f32_32x32x16_bf16(b1, qr[d0], p1, 0, 0, 0); }
#pragma unroll
  for (int d0 = 0; d0 < 4; ++d0) { int cb = (d0 * 16 + hi * 8) * 2;
    bf16x8 b0 = *reinterpret_cast<const bf16x8*>(Krs + RSWZ(r32, cb));
    bf16x8 b1 = *reinterpret_cast<const bf16x8*>(Krs + RSWZ(32 + r32, cb));
    p0 = __builtin_amdgcn_mfma_f32_32x32x16_bf16(b0, qr[8 + d0], p0, 0, 0, 0);
    p1 = __builtin_amdgcn_mfma_f32_32x32x16_bf16(b1, qr[8 + d0], p1, 0, 0, 0); }
}
__device__ __forceinline__ int v_st(int k, int c) { const int kk = (k & ~0xC) | ((k & 4) << 1) | ((k & 8) >> 1); return ((kk >> 3) * 4 + (c >> 5)) * 512 + ((kk & 7) * 32 + (c & 31)) * 2; }
__device__ __forceinline__ int v_rd_base(int lane) { return ((lane & 3) << 3) | (((lane >> 2) & 3) << 6) | (((lane >> 4) & 1) << 5) | (((lane >> 5) & 1) << 8); }
constexpr int v_rd_off(int d0, int ks, int half) { return d0 * 512 + ks * 4096 + half * 2048; }
template <int OFF> __device__ __forceinline__ s16x4 tr_read(int vb) {
  s16x4 r; asm volatile("ds_read_b64_tr_b16 %0, %1 offset:%2" : "=&v"(r) : "v"(vb), "i"(OFF) : "memory"); return r;
}
template <int D0> __device__ __forceinline__ void pv_one(f32x16& od, int vb, bf16x8 pa0, bf16x8 pa1, bf16x8 pa2, bf16x8 pa3) {
  const s16x4 l0 = tr_read<v_rd_off(D0, 0, 0)>(vb), h0 = tr_read<v_rd_off(D0, 0, 1)>(vb), l1 = tr_read<v_rd_off(D0, 1, 0)>(vb), h1 = tr_read<v_rd_off(D0, 1, 1)>(vb);
  const s16x4 l2 = tr_read<v_rd_off(D0, 2, 0)>(vb), h2 = tr_read<v_rd_off(D0, 2, 1)>(vb), l3 = tr_read<v_rd_off(D0, 3, 0)>(vb), h3 = tr_read<v_rd_off(D0, 3, 1)>(vb);
  asm volatile("s_waitcnt lgkmcnt(0)" ::: "memory"); SBAR();
#define PK(L, H) (bf16x8){L[0], L[1], L[2], L[3], H[0], H[1], H[2], H[3]}
  od = __builtin_amdgcn_mfma_f32_32x32x16_bf16(pa0, PK(l0, h0), od, 0, 0, 0);
  od = __builtin_amdgcn_mfma_f32_32x32x16_bf16(pa1, PK(l1, h1), od, 0, 0, 0);
  od = __builtin_amdgcn_mfma_f32_32x32x16_bf16(pa2, PK(l2, h2), od, 0, 0, 0);
  od = __builtin_amdgcn_mfma_f32_32x32x16_bf16(pa3, PK(l3, h3), od, 0, 0, 0);
#undef PK
}
__device__ __forceinline__ void pv_d0(f32x16* o, int vb, bf16x8 pa0, bf16x8 pa1, bf16x8 pa2, bf16x8 pa3) {
  pv_one<0>(o[0], vb, pa0, pa1, pa2, pa3); pv_one<1>(o[1], vb, pa0, pa1, pa2, pa3); pv_one<2>(o[2], vb, pa0, pa1, pa2, pa3); pv_one<3>(o[3], vb, pa0, pa1, pa2, pa3);
}
__device__ __forceinline__ void attn_body(const bf16_t* __restrict__ Qb, const bf16_t* __restrict__ Kh, const bf16_t* __restrict__ KRb,
                                          bf16_t* __restrict__ Ob, int seq, int tq0, const float* __restrict__ RC, const float* __restrict__ RS, char* lds, int tid) {
  const bf16_t* Vh = Kh + 128;
  const int wid = tid >> 6, lane = tid & 63, r32 = lane & 31, hi = lane >> 5;
  char* V_lds = lds + OFF_V; char* K_lds = lds + OFF_K; char* KR_lds = lds + OFF_KR;
  float* ws = (float*)(lds + OFF_WS) + wid * 64; float* li_l = ws; float* al_l = ws + 32;
  float m_reg = -1e30f, l_reg = 0; f32x16 o[4] = {}; bf16x8 qr[12];
  const bf16_t* Qw = Qb + (long)(wid * QBLK + r32) * LDQ + hi * 8;
#pragma unroll
  for (int d0 = 0; d0 < 12; ++d0) qr[d0] = ld8(Qw + d0 * 16);
  if (tq0 >= 0) {
    const int t = tq0 + wid * QBLK + r32; const int pr = (t >> 6) * 16 + hi * 8, pc = (t & 63) * 16 + hi * 8;
#pragma unroll
    for (int j = 0; j < 8; ++j) {
      { const float c = RC[pr + j], sn = RS[pr + j]; const float x0 = bf2f((bf16_t)qr[8][j]), x1 = bf2f((bf16_t)qr[9][j]);
        qr[8][j] = (short)f2bf(x0 * c - x1 * sn); qr[9][j] = (short)f2bf(x1 * c + x0 * sn); }
      { const float c = RC[pc + j], sn = RS[pc + j]; const float x0 = bf2f((bf16_t)qr[10][j]), x1 = bf2f((bf16_t)qr[11][j]);
        qr[10][j] = (short)f2bf(x0 * c - x1 * sn); qr[11][j] = (short)f2bf(x1 * c + x0 * sn); }
    }
  }
  const int sr = tid >> 4, sc = (tid & 15) * 8, vst0 = v_st(sr, sc), vst1 = v_st(32 + sr, sc);
  const int rr = tid >> 3, rc = (tid & 7) * 8;
  const int vb0 = (int)(uintptr_t)V_lds + v_rd_base(lane);
  bf16x8 vs0, vs1, ks0, ks1, krs;
#define SLOAD(k0) do { vs0 = ld8(&Vh[(long)((k0) + sr) * LDK + sc]); vs1 = ld8(&Vh[(long)((k0) + 32 + sr) * LDK + sc]); \
    ks0 = ld8(&Kh[(long)((k0) + sr) * LDK + sc]); ks1 = ld8(&Kh[(long)((k0) + 32 + sr) * LDK + sc]); krs = ld8(&KRb[(long)((k0) + rr) * 64 + rc]); } while (0)
#define SWRITE(b) do { *(bf16x8*)(V_lds + (b) * SHM_V + vst0) = vs0; *(bf16x8*)(V_lds + (b) * SHM_V + vst1) = vs1; int kc = sc * 2;   \
    *(bf16x8*)(K_lds + (b) * SHM_K + KSWZ(sr, kc)) = ks0; *(bf16x8*)(K_lds + (b) * SHM_K + KSWZ(32 + sr, kc)) = ks1;                    \
    *(bf16x8*)(KR_lds + (b) * SHM_KR + RSWZ(rr, rc * 2)) = krs; } while (0)
#define SWAIT() asm volatile("s_waitcnt vmcnt(0)" ::: "memory")
#define RESC(a) do { if (__any((a) < 1.f)) { if (hi == 0) al_l[r32] = (a); asm volatile("s_waitcnt lgkmcnt(0)" ::: "memory"); \
    _Pragma("unroll") for (int d = 0; d < 4; ++d) _Pragma("unroll") for (int r = 0; r < 16; ++r) o[d][r] *= al_l[crow(r, hi)]; } } while (0)
  f32x16 p0, p1; float mn, al; bf16x8 pa0, pa1, pa2, pa3; const int NT = seq / KVBLK;
  SLOAD(0); SWAIT(); SWRITE(0); __syncthreads();
  SLOAD(KVBLK);
  for (int j = 0; j < NT; ++j) {
    const int buf = j & 1;
    SBAR(); qkt(p0, p1, K_lds + buf * SHM_K, KR_lds + buf * SHM_KR, qr, r32, hi);
    partialSM(p0, p1, m_reg, mn, al); RESC(al);
    finishSM(p0, p1, al, l_reg, pa0, pa1, pa2, pa3); SBAR();
    if (j + 1 < NT) { SWAIT(); SWRITE(buf ^ 1); }
    if (j + 2 < NT) SLOAD((j + 2) * KVBLK);
    SBAR();
    pv_d0(o, vb0 + buf * SHM_V, pa0, pa1, pa2, pa3);
    __syncthreads();
  }
  if (hi == 0) li_l[r32] = l_reg; asm volatile("s_waitcnt lgkmcnt(0)" ::: "memory");
  float rli[16];
#pragma unroll
  for (int r = 0; r < 16; ++r) rli[r] = __builtin_amdgcn_rcpf(li_l[crow(r, hi)]);
  bf16_t* Ow = Ob + (long)(wid * QBLK) * LDO;
#pragma unroll
  for (int r = 0; r < 16; ++r) { int orow = crow(r, hi);
#pragma unroll
    for (int d0 = 0; d0 < 4; ++d0) Ow[(long)orow * LDO + d0 * 32 + r32] = (bf16_t)f2bf(o[d0][r] * rli[r]); }
#undef SLOAD
#undef SWRITE
#undef SWAIT
#undef RESC
}
}

typedef const float* cfp_t;
typedef const __attribute__((address_space(4))) cfp_t* InPtr;
struct Ctx {
    LAS unsigned char* lds; int tid, lane, wave, gw, ngw, gtid, ngt;
    InPtr in; float* out; unsigned char* ws;
};
#define WSP(T, off) ((T*)(C.ws + (off)))

__device__ __forceinline__ void tr_item(const float* W, int K, int N, bf16_t* WT, const float* sck, LAS float* scr, int item, int lane) {
    const int nblk = N / 32, kb = item / nblk, nb = item % nblk, k0 = 64 * kb, n0 = 32 * nb;
#pragma unroll 8
    for (int i = 0; i < 32; ++i) { const int kk = 2 * i + (lane >> 5); float v = W[(size_t)(k0 + kk) * N + n0 + (lane & 31)]; if (sck) v *= sck[k0 + kk]; scr[kk * 33 + (lane & 31)] = v; }
    asm volatile("s_waitcnt lgkmcnt(0)" ::: "memory"); __builtin_amdgcn_wave_barrier();
    const int c = lane & 7;
#pragma unroll
    for (int j = 0; j < 4; ++j) { const int n = (lane >> 3) + 8 * j; const LAS float* s = scr + (8 * c) * 33 + n;
        u32x4 o; o.x = pk2(s[0 * 33], s[1 * 33]); o.y = pk2(s[2 * 33], s[3 * 33]); o.z = pk2(s[4 * 33], s[5 * 33]); o.w = pk2(s[6 * 33], s[7 * 33]);
        *(u32x4*)(WT + (size_t)(n0 + n) * K + k0 + 8 * c) = o; }
    asm volatile("s_waitcnt lgkmcnt(0)" ::: "memory"); __builtin_amdgcn_wave_barrier();
}
__device__ __forceinline__ void tr_matrix(const Ctx& C, const float* W, int K, int N, bf16_t* WT, const float* sck) {
    LAS float* scr = (LAS float*)(C.lds + C.wave * 16384);
    const int cnt = (K / 64) * (N / 32);
    for (int it = C.gw; it < cnt; it += C.ngw) tr_item(W, K, N, WT, sck, scr, it, C.lane);
}
__device__ __forceinline__ void sincos_d(double x, double& s, double& c) {
    const double twopi = 6.283185307179586476925286766559;
    const double k = __builtin_rint(x / twopi); const double y = x - k * twopi; const double y2 = y * y;
    double ts = y, ss = y, tc = 1.0, sc = 1.0;
#pragma unroll
    for (int n = 1; n <= 16; ++n) { tc *= -y2 / (double)((2 * n - 1) * (2 * n)); sc += tc; ts *= -y2 / (double)((2 * n) * (2 * n + 1)); ss += ts; }
    s = ss; c = sc;
}
__device__ __forceinline__ void phase_prologue(const Ctx& C) {
#pragma unroll 1
    for (int e = 0; e < 2; ++e) {
        tr_matrix(C, C.in[8] + (size_t)e * DM * ABN, DM, ABN, WSP(bf16_t, WS_WABIN) + (size_t)e * ABNP * DM, nullptr);
        tr_matrix(C, C.in[9] + (size_t)e * DM * DM, DM, DM, WSP(bf16_t, WS_WABOUT) + (size_t)e * DM * DM, nullptr);
        tr_matrix(C, C.in[18] + (size_t)e * 512 * QW, 512, QW, WSP(bf16_t, WS_WUQ) + (size_t)e * QW * 512, C.in[17] + e * 512);
        tr_matrix(C, C.in[20] + (size_t)e * 512 * KVW, 512, KVW, WSP(bf16_t, WS_WUKV) + (size_t)e * KVW * 512, C.in[19] + e * 512);
        tr_matrix(C, C.in[21] + (size_t)e * DM * HGN, DM, HGN, WSP(bf16_t, WS_WHGIN) + (size_t)e * HGN * DM, nullptr);
        tr_matrix(C, C.in[24] + (size_t)e * DM * DM, DM, DM, WSP(bf16_t, WS_WHGOUT) + (size_t)e * DM * DM, nullptr);
    }
#pragma unroll 1
    for (int l = 0; l < 4; ++l) {
        tr_matrix(C, C.in[25] + (size_t)l * DM * DFF, DM, DFF, WSP(bf16_t, WS_W1) + (size_t)l * DFF * DM, nullptr);
        tr_matrix(C, C.in[26] + (size_t)l * DFF * DM, DFF, DM, WSP(bf16_t, WS_W2) + (size_t)l * DM * DFF, nullptr);
    }
    for (int e = 0; e < 2; ++e) { u32x4* z = (u32x4*)(WSP(bf16_t, WS_WABIN) + (size_t)e * ABNP * DM + (size_t)ABN * DM);
        for (int i = C.gtid; i < (ABNP - ABN) * DM / 8; i += C.ngt) z[i] = (u32x4){0u, 0u, 0u, 0u}; }
    { float* XS = WSP(float, WS_XS);
      for (int i = C.gtid; i < MROWS * (DM / 4); i += C.ngt) { const int R = i / (DM / 4), c4 = i % (DM / 4); const int b = R / SROW, s = R % SROW;
          const float* src = s < CTX ? C.in[2] + ((size_t)(b * CTX + s)) * DM : C.in[0] + ((size_t)(b * SEQ + (s - CTX))) * DM;
          ((f32x4*)(XS + (size_t)R * DM))[c4] = ((const f32x4*)src)[c4]; } }
    { float* LB = WSP(float, WS_LB);
      for (int i = C.gtid; i < 2048; i += C.ngt) { float v[4], mx = -1e30f; for (int l = 0; l < 4; ++l) { v[l] = C.in[22][l * 2048 + i]; mx = fmaxf(mx, v[l]); }
          float sum = 0.f; for (int l = 0; l < 4; ++l) { v[l] = expf(v[l] - mx); sum += v[l]; }
          float cum = 0.f; const float p0 = v[0] / sum; for (int l = 0; l < 4; ++l) { cum += v[l] / sum; LB[l * 2048 + i] = cum - p0; } }
      float* RC = WSP(float, WS_ROPE); float* RS = RC + 1024;
      for (int i = C.gtid; i < 1024; i += C.ngt) { const int pos = i / 16, j = i % 16; double inv = 1.0; for (int q = 0; q < j; ++q) inv *= 0.56234132519034908;
          const float ang = (float)pos * (float)inv; double s, c; sincos_d((double)ang, s, c); RC[i] = (float)c; RS[i] = (float)s; } }
    { LAS float* sl = (LAS float*)C.lds;
      LAS float* red = sl + 3 * 2048;
      __syncthreads();
      for (int i = C.tid; i < 3 * 2048; i += 512) { const int r = i / 2048, d = i % 2048; const float v = r < 2 ? C.in[1][r * 2048 + d] : C.in[3][d]; sl[i] = siluf_(v); }
      __syncthreads();
      float* MOD = WSP(float, WS_MOD);
      const int kq = C.tid >> 4, cq = C.tid & 15;
      for (int u = blockIdx.x; u < 4 * (MODW / 64); u += gridDim.x) { const int l = u / (MODW / 64), e0 = (u % (MODW / 64)) * 64;
          const float* w = C.in[4] + (size_t)l * DM * MODW + e0 + 4 * cq;
          f32x4 a0 = {0, 0, 0, 0}, a1 = {0, 0, 0, 0}, a2 = {0, 0, 0, 0};
#pragma unroll 4
          for (int d = kq; d < DM; d += 32) { const f32x4 wv = *(const f32x4*)(w + (size_t)d * MODW); a0 += wv * sl[d]; a1 += wv * sl[2048 + d]; a2 += wv * sl[4096 + d]; }
#pragma unroll
          for (int j = 0; j < 4; ++j) { red[(kq * 3 + 0) * 64 + 4 * cq + j] = a0[j]; red[(kq * 3 + 1) * 64 + 4 * cq + j] = a1[j]; red[(kq * 3 + 2) * 64 + 4 * cq + j] = a2[j]; }
          __syncthreads();
          if (C.tid < 192) { const int r = C.tid / 64, c = C.tid % 64; float s = 0.f; for (int q = 0; q < 32; ++q) s += red[(q * 3 + r) * 64 + c];
              MOD[((size_t)l * 3 + r) * MODW + e0 + c] = s + C.in[5][l * MODW + e0 + c]; }
          __syncthreads(); } }
}

__device__ __forceinline__ void phase_norm_mod(const Ctx& C, const float* w, const float* mod, int sh_idx, int sc_idx) {
    const float* XS = WSP(float, WS_XS); bf16_t* H = WSP(bf16_t, WS_H);
    for (int R = C.gw; R < MROWS; R += C.ngw) {
        const int s = R % SROW, b = R / SROW, cond = s < CTX ? 2 : b;
        const float* shift = mod + (size_t)cond * MODW + sh_idx * DM; const float* scale = mod + (size_t)cond * MODW + sc_idx * DM;
        const f32x4* xr = (const f32x4*)(XS + (size_t)R * DM) + C.lane;
        f32x4 v[8]; float ss = 0.f;
#pragma unroll
        for (int j = 0; j < 8; ++j) { v[j] = xr[64 * j]; ss += (v[j].x * v[j].x + v[j].y * v[j].y) + (v[j].z * v[j].z + v[j].w * v[j].w); }
        const float rstd = 1.0f / sqrtf(wave_sum(ss) * (1.0f / DM) + EPS);
        u32x2* o = (u32x2*)(H + (size_t)R * DM) + C.lane;
#pragma unroll
        for (int j = 0; j < 8; ++j) { const int c = (C.lane + 64 * j) * 4; const f32x4 wv = *(const f32x4*)(w + c), sc = *(const f32x4*)(scale + c), sh = *(const f32x4*)(shift + c);
            const f32x4 y = (v[j] * rstd * wv) * (1.0f + sc) + sh; u32x2 pk; pk.x = pk2(y.x, y.y); pk.y = pk2(y.z, y.w); o[64 * j] = pk; }
    }
}

__device__ __forceinline__ void phase_conv_etc(const Ctx& C, int e) {
    const bf16_t* P = WSP(bf16_t, WS_P); float* UC = WSP(float, WS_UC);
    const float* cw = C.in[10] + (size_t)e * 4 * DLRU; const float* cb = C.in[11] + (size_t)e * DLRU;
    for (int idx = C.gtid; idx < MROWS * DLRU; idx += C.ngt) { const int R = idx / DLRU, ch = idx % DLRU, s = R % SROW; const int lo = s < CTX ? 0 : CTX, hi = s < CTX ? CTX : SROW;
        float a = cb[ch];
#pragma unroll
        for (int j = 0; j < 4; ++j) { const int ss = s + j - 2; if (ss >= lo && ss < hi) a += bf2f(P[(size_t)(R + j - 2) * ABNP + DLRU + ch]) * cw[j * DLRU + ch]; }
        UC[idx] = a; }
    float* RSQ = WSP(float, WS_RSQ); float* RSKV = WSP(float, WS_RSKV);
    for (int R = C.gw; R < MROWS; R += C.ngw) {
        const u32x4 a = *(const u32x4*)(P + (size_t)R * ABNP + 2048 + 8 * C.lane), b = *(const u32x4*)(P + (size_t)R * ABNP + 2560 + 8 * C.lane);
        float sa = 0.f, sb = 0.f;
#pragma unroll
        for (int j = 0; j < 4; ++j) { const float a0 = __uint_as_float(a[j] << 16), a1 = __uint_as_float(a[j] & 0xffff0000u), b0 = __uint_as_float(b[j] << 16), b1 = __uint_as_float(b[j] & 0xffff0000u);
            sa += a0 * a0 + a1 * a1; sb += b0 * b0 + b1 * b1; }
        sa = wave_sum(sa); sb = wave_sum(sb);
        if (C.lane == 0) { RSQ[R] = 1.0f / sqrtf(sa * (1.0f / 512.0f) + EPS); RSKV[R] = 1.0f / sqrtf(sb * (1.0f / 512.0f) + EPS); } }
    bf16_t* KR = WSP(bf16_t, WS_KR); const float* RC = WSP(float, WS_ROPE); const float* RS = RC + 1024;
    for (int idx = C.gtid; idx < MROWS * 32; idx += C.ngt) { const int R = idx / 32, p = idx % 32, s = R % SROW; const int i0 = p < 16 ? p : 32 + (p - 16);
        const float x0 = bf2f(P[(size_t)R * ABNP + 3072 + i0]), x1 = bf2f(P[(size_t)R * ABNP + 3072 + i0 + 16]); float o0 = x0, o1 = x1;
        if (s >= CTX) { const int t = s - CTX, pos = p < 16 ? t / 64 : t % 64; const float c = RC[pos * 16 + (p & 15)], sn = RS[pos * 16 + (p & 15)]; o0 = x0 * c - x1 * sn; o1 = x1 * c + x0 * sn; }
        KR[(size_t)R * 64 + i0] = (bf16_t)f2bf(o0); KR[(size_t)R * 64 + i0 + 16] = (bf16_t)f2bf(o1); }
}
__device__ __forceinline__ void phase_gates_naive(const Ctx& C, int e) {
    const float* UC = WSP(float, WS_UC); float* LA = WSP(float, WS_LA); float* LBv = WSP(float, WS_LBB);
    const float* wa = C.in[12] + (size_t)e * 2 * 8 * 128 * 128; const float* wx = C.in[14] + (size_t)e * 2 * 8 * 128 * 128;
    const float* ba = C.in[13] + (size_t)e * 2 * DLRU; const float* bx = C.in[15] + (size_t)e * 2 * DLRU; const float* lam = C.in[16] + (size_t)e * 2 * DLRU;
    for (int idx = C.gtid; idx < MROWS * DLRU; idx += C.ngt) { const int R = idx / DLRU, ch = idx % DLRU, h = ch / 128, ee = ch % 128;
        const float* u = UC + (size_t)R * DLRU + h * 128;
        const float* wa0 = wa + ((size_t)(0 * 8 + h) * 128) * 128 + ee; const float* wa1 = wa + ((size_t)(1 * 8 + h) * 128) * 128 + ee;
        const float* wx0 = wx + ((size_t)(0 * 8 + h) * 128) * 128 + ee; const float* wx1 = wx + ((size_t)(1 * 8 + h) * 128) * 128 + ee;
        float a0 = 0.f, a1 = 0.f, x0 = 0.f, x1 = 0.f;
#pragma unroll 4
        for (int d = 0; d < 128; ++d) { const float uv = u[d]; a0 += uv * wa0[d * 128]; a1 += uv * wa1[d * 128]; x0 += uv * wx0[d * 128]; x1 += uv * wx1[d * 128]; }
        const float ucv = UC[idx];
        { const float r = sigmoidf_(a0 + ba[ch]), ig = sigmoidf_(x0 + bx[ch]); const float la = -8.0f * r * log1pf(expf(-lam[ch])); LA[idx] = expf(la); LBv[idx] = sqrtf(-expm1f(2.0f * la)) * (ig * ucv); }
        { const float r = sigmoidf_(a1 + ba[DLRU + ch]), ig = sigmoidf_(x1 + bx[DLRU + ch]); const float la = -8.0f * r * log1pf(expf(-lam[DLRU + ch]));
          LA[(size_t)MROWS * DLRU + idx] = expf(la); LBv[(size_t)MROWS * DLRU + idx] = sqrtf(-expm1f(2.0f * la)) * (ig * ucv); } }
}
__device__ __forceinline__ void phase_scan_naive(const Ctx& C) {
    const float* LA = WSP(float, WS_LA); const float* LBv = WSP(float, WS_LBB); float* HS = WSP(float, WS_HS);
    if (C.tid < 64) for (int id = blockIdx.x * 64 + C.tid; id < NBATCH * DLRU; id += gridDim.x * 64) { const int b = id / DLRU, ch = id % DLRU;
        float h = 0.f;
#pragma unroll 8
        for (int s = 0; s < SROW; ++s) { const size_t i = (size_t)(b * SROW + s) * DLRU + ch; h = LA[i] * h + LBv[i]; HS[i] = h; }
        h = 0.f; const size_t d1 = (size_t)MROWS * DLRU;
#pragma unroll 8
        for (int s = CTX - 1; s >= 0; --s) { const size_t i = (size_t)(b * SROW + s) * DLRU + ch; h = LA[d1 + i] * h + LBv[d1 + i]; HS[i] += h; }
#pragma unroll 8
        for (int s = SROW - 1; s >= CTX; --s) { const size_t i = (size_t)(b * SROW + s) * DLRU + ch; h = LA[d1 + i] * h + LBv[d1 + i]; HS[i] += h; } }
}
__device__ __forceinline__ void phase_attn_naive(const Ctx& C) {
    const bf16_t* P = WSP(bf16_t, WS_P); const float* HS = WSP(float, WS_HS); bf16_t* Y = WSP(bf16_t, WS_Y);
    for (int idx = C.gtid; idx < MROWS * DLRU; idx += C.ngt) { const int R = idx / DLRU, ch = idx % DLRU; Y[(size_t)R * DM + ch] = (bf16_t)f2bf(HS[idx] * gelu_tanh(bf2f(P[(size_t)R * ABNP + ch]))); }
    const bf16_t* Q = WSP(bf16_t, WS_Q); const bf16_t* KV = WSP(bf16_t, WS_KV); const bf16_t* KR = WSP(bf16_t, WS_KR);
    LAS float* qs = (LAS float*)(C.lds + C.wave * 4096); LAS float* ps = qs + 768;
    for (int u = C.gw; u < (MROWS / 4) * 8; u += C.ngw) { const int hh = u % 8, R0 = (u / 8) * 4, b = R0 / SROW, s0 = R0 % SROW, nk = s0 < CTX ? CTX : SROW, kb = b * SROW;
        __builtin_amdgcn_wave_barrier();
        for (int i = C.lane; i < 768; i += 64) { const int qi = i / 192, d = i % 192; qs[i] = bf2f(Q[(size_t)(R0 + qi) * QW + hh * 192 + d]) * ATTN_SCALE; }
        __builtin_amdgcn_wave_barrier();
        float m[4], l[4], o0[4], o1[4];
#pragma unroll
        for (int qi = 0; qi < 4; ++qi) { m[qi] = -1e30f; l[qi] = 0.f; o0[qi] = 0.f; o1[qi] = 0.f; }
        for (int k0 = 0; k0 < nk; k0 += 64) { const size_t kr = (size_t)(kb + k0 + C.lane);
            float sc[4] = {0.f, 0.f, 0.f, 0.f};
            for (int d8 = 0; d8 < 24; ++d8) { const u32x4 kk = d8 < 16 ? *(const u32x4*)(KV + kr * KVW + hh * 256 + d8 * 8) : *(const u32x4*)(KR + kr * 64 + (d8 - 16) * 8);
                float kf[8];
#pragma unroll
                for (int j = 0; j < 4; ++j) { kf[2 * j] = __uint_as_float(kk[j] << 16); kf[2 * j + 1] = __uint_as_float(kk[j] & 0xffff0000u); }
#pragma unroll
                for (int qi = 0; qi < 4; ++qi) { const f32x4 qa = *(const LAS f32x4*)(qs + qi * 192 + d8 * 8), qb = *(const LAS f32x4*)(qs + qi * 192 + d8 * 8 + 4);
                    sc[qi] += kf[0] * qa[0] + kf[1] * qa[1] + kf[2] * qa[2] + kf[3] * qa[3] + kf[4] * qb[0] + kf[5] * qb[1] + kf[6] * qb[2] + kf[7] * qb[3]; } }
            __builtin_amdgcn_wave_barrier();
#pragma unroll
            for (int qi = 0; qi < 4; ++qi) { const float mx = wave_max(sc[qi]); const float mn = fmaxf(m[qi], mx); const float alpha = expf(m[qi] - mn); const float p = expf(sc[qi] - mn);
                ps[qi * 64 + C.lane] = p; l[qi] = l[qi] * alpha + wave_sum(p); o0[qi] *= alpha; o1[qi] *= alpha; m[qi] = mn; }
            __builtin_amdgcn_wave_barrier();
            for (int kk = 0; kk < 64; ++kk) { const bf16_t* vr = KV + (size_t)(kb + k0 + kk) * KVW + hh * 256 + 128; const float v0 = bf2f(vr[C.lane]), v1 = bf2f(vr[64 + C.lane]);
#pragma unroll
                for (int qi = 0; qi < 4; ++qi) { const float pp = ps[qi * 64 + kk]; o0[qi] += pp * v0; o1[qi] += pp * v1; } }
        }
#pragma unroll
        for (int qi = 0; qi < 4; ++qi) { bf16_t* yo = Y + (size_t)(R0 + qi) * DM + DLRU + hh * 128; const float il = 1.0f / l[qi]; yo[C.lane] = (bf16_t)f2bf(o0[qi] * il); yo[64 + C.lane] = (bf16_t)f2bf(o1[qi] * il); }
    }
}

__device__ __forceinline__ void phase_attn(const Ctx& C) {
    const bf16_t* Q = WSP(bf16_t, WS_Q); const bf16_t* KV = WSP(bf16_t, WS_KV); const bf16_t* KR = WSP(bf16_t, WS_KR); bf16_t* Y = WSP(bf16_t, WS_Y);
    const float* RC = WSP(float, WS_ROPE); const float* RS = RC + 1024;
    const int G = gridDim.x, c = blockIdx.x;
    for (int u0 = c; u0 < 272; u0 += G) {
        int b, hh, s0, nk, tq0;
        if (u0 < 256) { int v = u0; if (G == 256) { const int x = c & 7, j = c >> 3; v = (x * 2 + (j >> 4)) * 16 + (j & 15); }
            const int p = v >> 4, qb = v & 15; b = p >> 3; hh = p & 7; s0 = CTX + qb * 256; nk = SROW; tq0 = qb * 256; }
        else { const int p = u0 - 256; b = p >> 3; hh = p & 7; s0 = 0; nk = CTX; tq0 = -1; }
        const size_t R0 = (size_t)b * SROW + s0, K0 = (size_t)b * SROW;
        __syncthreads();
        att::attn_body(Q + R0 * QW + hh * 192, KV + K0 * KVW + hh * 256, KR + K0 * 64, Y + R0 * DM + DLRU + hh * 128, nk, tq0, RC, RS, (char*)C.lds, C.tid);
    }
}
__device__ __forceinline__ void phase_ya(const Ctx& C) {
    const bf16_t* P = WSP(bf16_t, WS_P); const float* HS = WSP(float, WS_HS); bf16_t* Y = WSP(bf16_t, WS_Y);
    for (int idx = C.gtid; idx < MROWS * DLRU; idx += C.ngt) { const int R = idx / DLRU, ch = idx % DLRU; Y[(size_t)R * DM + ch] = (bf16_t)f2bf(HS[idx] * gelu_tanh(bf2f(P[(size_t)R * ABNP + ch]))); }
}
__device__ __forceinline__ void phase_hgrn_naive(const Ctx& C) {
    const bf16_t* QH = WSP(bf16_t, WS_QH); const float* LOGF = WSP(float, WS_LOGF); const bf16_t* VH = WSP(bf16_t, WS_VH); float* O = WSP(float, WS_O);
    LAS float* fs = (LAS float*)C.lds;
    LAS float* qsh = fs + 1024;
    const int g4 = C.tid >> 7, e = C.tid & 127;
    for (int bg = blockIdx.x; bg < 8; bg += gridDim.x) { const int grp = bg * 4 + g4, b = grp / 16, hh = grp % 16, col = hh * 128 + e;
        for (int dir = 0; dir < 2; ++dir) {
            float st[128];
#pragma unroll
            for (int d = 0; d < 128; ++d) st[d] = 0.f;
            const float* lf = LOGF + (size_t)dir * MROWS * DM;
            size_t R = (size_t)b * SROW + (dir == 0 ? 0 : CTX - 1);
            float nlf = lf[R * DM + col], nq = bf2f(QH[R * DM + col]), nv = bf2f(VH[R * DM + col]);
            for (int step = 0; step < SROW; ++step) {
                const size_t Rc = R; const float f_ = expf(nlf), q_ = nq, vv = nv;
                if (step + 1 < SROW) { const int s1 = step + 1; const int sidx = dir == 0 ? s1 : (s1 < CTX ? CTX - 1 - s1 : SROW + CTX - 1 - s1); R = (size_t)b * SROW + sidx;
                    nlf = lf[R * DM + col]; nq = bf2f(QH[R * DM + col]); nv = bf2f(VH[R * DM + col]); }
                const int buf = step & 1;
                fs[(buf * 4 + g4) * 128 + e] = f_; qsh[(buf * 4 + g4) * 128 + e] = q_;
                __syncthreads();
                const LAS f32x4* fp = (const LAS f32x4*)(fs + (buf * 4 + g4) * 128); const LAS f32x4* qp = (const LAS f32x4*)(qsh + (buf * 4 + g4) * 128);
                float o = 0.f;
#pragma unroll
                for (int d4 = 0; d4 < 32; ++d4) { const f32x4 f4 = fp[d4], q4 = qp[d4];
#pragma unroll
                    for (int j = 0; j < 4; ++j) { const float f = f4[j]; st[d4 * 4 + j] = f * st[d4 * 4 + j] + (1.0f - f) * vv; o += q4[j] * st[d4 * 4 + j]; } }
                if (dir == 0) O[Rc * DM + col] = o; else O[Rc * DM + col] += o;
            }
            __syncthreads();
        }
    }
}
__device__ __forceinline__ void phase_hg_readout(const Ctx& C, int o_idx) {
    const float* O = WSP(float, WS_O); const bf16_t* GH = WSP(bf16_t, WS_GH); bf16_t* Y = WSP(bf16_t, WS_Y); const float* nw = C.in[23] + o_idx * 128;
    const float w0 = nw[C.lane], w1 = nw[64 + C.lane];
    for (int u = C.gw; u < MROWS * 16; u += C.ngw) { const size_t base = (size_t)(u / 16) * DM + (u % 16) * 128;
        const float a = O[base + C.lane], b = O[base + 64 + C.lane]; const float rstd = 1.0f / sqrtf(wave_sum(a * a + b * b) * (1.0f / 128.0f) + EPS);
        Y[base + C.lane] = (bf16_t)f2bf(a * rstd * w0 * bf2f(GH[base + C.lane])); Y[base + 64 + C.lane] = (bf16_t)f2bf(b * rstd * w1 * bf2f(GH[base + 64 + C.lane])); }
}
__device__ __forceinline__ void phase_final(const Ctx& C) {
    const float* XS = WSP(float, WS_XS); const float* w = C.in[27];
    for (int r = C.gw; r < NBATCH * SEQ; r += C.ngw) { const int b = r / SEQ, t = r % SEQ; const size_t R = (size_t)b * SROW + CTX + t;
        const f32x4* xr = (const f32x4*)(XS + R * DM) + C.lane; f32x4 v[8]; float ss = 0.f;
#pragma unroll
        for (int j = 0; j < 8; ++j) { v[j] = xr[64 * j]; ss += (v[j].x * v[j].x + v[j].y * v[j].y) + (v[j].z * v[j].z + v[j].w * v[j].w); }
        const float rstd = 1.0f / sqrtf(wave_sum(ss) * (1.0f / DM) + EPS);
        f32x4* o = (f32x4*)(C.out + (size_t)r * DM) + C.lane;
#pragma unroll
        for (int j = 0; j < 8; ++j) { const f32x4 wv = *(const f32x4*)(w + (C.lane + 64 * j) * 4); o[64 * j] = v[j] * rstd * wv; } }
}

struct Args { const float* in[28]; float* out; unsigned char* ws; int ph_lo, ph_hi; };
constexpr int N_PHASES = 1 + 2 * 12 + 2 * 8 + 1;

__global__ void __launch_bounds__(512, 2) fwd_kernel(Args args) {
    extern __shared__ __attribute__((aligned(16))) unsigned char lds_raw[];
    LAS unsigned char* const lds0 = (LAS unsigned char*)lds_raw;
    const unsigned long long inaddr = (unsigned long long)__builtin_amdgcn_kernarg_segment_ptr();
    volatile LAS unsigned* misc = (volatile LAS unsigned*)(lds0 + LDS_MISC);
    if (threadIdx.x < 64) misc[threadIdx.x] = 0u;
    __syncthreads();
    const int lo = args.ph_lo, hi = args.ph_hi;
    XcdBarrier bar; bar.bar = (unsigned*)(args.ws + WS_CTL) + 4096; bar.x = 0; bar.st = misc + 8;
    if (hi - lo > 1) bar = xcd_barrier_post((unsigned*)(args.ws + WS_CTL) + 4096, misc + 8);
    int pid = 0;
    const unsigned long long wsaddr = (unsigned long long)args.ws;
#define PH_BEGIN if (pid >= lo && pid < hi) { int l = l_; Ctx C; { unsigned long long a_ = inaddr, w_ = wsaddr; int t_ = threadIdx.x; asm volatile("" : "+s"(a_), "+s"(w_), "+s"(l), "+v"(t_)); \
        C.in = (InPtr)a_; C.ws = (unsigned char*)w_; C.out = args.out; C.lds = lds0; C.tid = t_; C.lane = t_ & 63; C.wave = __builtin_amdgcn_readfirstlane(t_ >> 6); \
        C.gw = blockIdx.x * 8 + C.wave; C.ngw = gridDim.x * 8; C.gtid = blockIdx.x * 512 + t_; C.ngt = gridDim.x * 512; } \
        const int e = l >> 1; const float* mod = WSP(float, WS_MOD) + (size_t)l * 3 * MODW; const int G = gridDim.x, cb = blockIdx.x; (void)e; (void)mod; (void)G; (void)cb;
#define PH_END } if (pid >= lo && pid + 1 < hi) xcd_barrier(bar); ++pid;
    int l_ = 0;
    PH_BEGIN
#ifndef SKIP_PRO
    phase_prologue(C);
#endif
    PH_END

    for (l_ = 0; l_ < DEPTH; ++l_) {
        PH_BEGIN phase_norm_mod(C, C.in[6] + l * DM, mod, 0, 1); PH_END
        if ((l_ & 1) == 0) {
            PH_BEGIN { pg8::Gemm g{WSP(bf16_t, WS_H), WSP(bf16_t, WS_WABIN) + (size_t)e * ABNP * DM, MROWS, ABNP, DM, DM, DM}; pg8::StaticOrder S; S.init(MROWS, ABNP, G, cb);
                       EpiBf16Plain E{WSP(bf16_t, WS_P), ABNP}; pg8::gemm_phase(C.lds, C.tid, g, S, E); } PH_END
            PH_BEGIN phase_conv_etc(C, e); PH_END
            PH_BEGIN phase_gates_naive(C, e); PH_END
            PH_BEGIN { pg8::Gemm g{WSP(bf16_t, WS_P) + 2048, WSP(bf16_t, WS_WUQ) + (size_t)e * QW * 512, MROWS, QW, 512, ABNP, 512}; pg8::StaticOrder S; S.init(MROWS, QW, G, cb);
                       EpiBf16RowScale E{WSP(bf16_t, WS_Q), QW, WSP(float, WS_RSQ)}; pg8::gemm_phase(C.lds, C.tid, g, S, E); } PH_END
            PH_BEGIN { pg8::Gemm g{WSP(bf16_t, WS_P) + 2560, WSP(bf16_t, WS_WUKV) + (size_t)e * KVW * 512, MROWS, KVW, 512, ABNP, 512}; pg8::StaticOrder S; S.init(MROWS, KVW, G, cb);
                       EpiBf16RowScale E{WSP(bf16_t, WS_KV), KVW, WSP(float, WS_RSKV)}; pg8::gemm_phase(C.lds, C.tid, g, S, E); } PH_END
            PH_BEGIN phase_scan_naive(C); PH_END
            PH_BEGIN
            phase_ya(C); phase_attn(C);
            PH_END
        } else {
            PH_BEGIN { pg8::Gemm g{WSP(bf16_t, WS_H), WSP(bf16_t, WS_WHGIN) + (size_t)e * HGN * DM, MROWS, HGN, DM, DM, DM}; pg8::StaticOrder S; S.init(MROWS, HGN, G, cb);
                       EpiHG E{WSP(bf16_t, WS_QH), WSP(float, WS_LOGF), WSP(float, WS_LB) + l * 2048}; pg8::gemm_phase(C.lds, C.tid, g, S, E); } PH_END
            PH_BEGIN
#ifndef SKIP_HGRN
            phase_hgrn_naive(C);
#endif
            PH_END
            PH_BEGIN phase_hg_readout(C, e); PH_END
        }
        PH_BEGIN { const bf16_t* wout = (l & 1) ? WSP(bf16_t, WS_WHGOUT) + (size_t)e * DM * DM : WSP(bf16_t, WS_WABOUT) + (size_t)e * DM * DM;
                   pg8::Gemm g{WSP(bf16_t, WS_Y), wout, MROWS, DM, DM, DM, DM}; pg8::StaticOrder S; S.init(MROWS, DM, G, cb);
                   EpiResid E{WSP(float, WS_XS), mod + 2 * DM}; pg8::gemm_phase(C.lds, C.tid, g, S, E); } PH_END
        PH_BEGIN phase_norm_mod(C, C.in[7] + l * DM, mod, 3, 4); PH_END
        PH_BEGIN { pg8::Gemm g{WSP(bf16_t, WS_H), WSP(bf16_t, WS_W1) + (size_t)l * DFF * DM, MROWS, DFF, DM, DM, DM}; pg8::StaticOrder S; S.init(MROWS, DFF, G, cb);
                   EpiRelu2 E{WSP(bf16_t, WS_HID), DFF}; pg8::gemm_phase(C.lds, C.tid, g, S, E); } PH_END
        PH_BEGIN { pg8::Gemm g{WSP(bf16_t, WS_HID), WSP(bf16_t, WS_W2) + (size_t)l * DM * DFF, MROWS, DM, DFF, DFF, DFF}; pg8::StaticOrder S; S.init(MROWS, DM, G, cb);
                   EpiResid E{WSP(float, WS_XS), mod + 5 * DM}; pg8::gemm_phase(C.lds, C.tid, g, S, E); } PH_END
    }
    l_ = 0;
    PH_BEGIN phase_final(C); PH_END
}

#ifndef N_LAUNCH_MODE
#define N_LAUNCH_MODE 1
#endif
extern "C" void kernel_launch(void* const* d_in, const int* in_sizes, int n_in, void* d_out, int out_size, void* d_ws, size_t ws_size, hipStream_t stream) {
    static int grid = 0;
    if (grid == 0) {
        if (n_in != 28 || out_size != NBATCH * SEQ * DM || ws_size < WS_END) { fprintf(stderr, "kernel_launch: shape mismatch n_in %d out %d ws %zu (need %zu)\n", n_in, out_size, ws_size, (size_t)WS_END); grid = -1; return; }
        int dev = 0, cus = 0, per_cu = 0;
        if (hipGetDevice(&dev) != hipSuccess || hipDeviceGetAttribute(&cus, hipDeviceAttributeMultiprocessorCount, dev) != hipSuccess) { grid = -1; return; }
        if (hipFuncSetAttribute((const void*)fwd_kernel, hipFuncAttributeMaxDynamicSharedMemorySize, LDS_BYTES) != hipSuccess) { fprintf(stderr, "kernel_launch: hipFuncSetAttribute failed\n"); grid = -1; return; }
        if (hipOccupancyMaxActiveBlocksPerMultiprocessor(&per_cu, (const void*)fwd_kernel, 512, LDS_BYTES) != hipSuccess || per_cu < 1) fprintf(stderr, "kernel_launch: occupancy query says %d\n", per_cu);
        (void)hipGetLastError();
        grid = cus;
    }
    if (grid < 0) return;
    (void)hipMemsetAsync((char*)d_ws + WS_CTL, 0, CTL_BYTES, stream);
    Args a{};
    for (int i = 0; i < 28; ++i) a.in[i] = (const float*)d_in[i];
    a.out = (float*)d_out; a.ws = (unsigned char*)d_ws;
#if N_LAUNCH_MODE == 1
    a.ph_lo = 0; a.ph_hi = N_PHASES;
    hipLaunchKernelGGL(fwd_kernel, dim3(grid), dim3(512), LDS_BYTES, stream, a);
#else
    for (int p = 0; p < N_PHASES; ++p) { a.ph_lo = p; a.ph_hi = p + 1; hipLaunchKernelGGL(fwd_kernel, dim3(grid), dim3(512), LDS_BYTES, stream, a); }
#endif
    const hipError_t le = hipPeekAtLastError();
    if (le != hipSuccess) fprintf(stderr, "kernel_launch: launch failed: %s\n", hipGetErrorName(le));
}
```

```cpp
#include <hip/hip_runtime.h>
#include <cstdio>

#define LAS __attribute__((address_space(3)))
typedef unsigned short bf16_t;
typedef short bf16x8 __attribute__((ext_vector_type(8)));
typedef float f32x4 __attribute__((ext_vector_type(4)));
typedef float f32x2 __attribute__((ext_vector_type(2)));
typedef unsigned u32x4 __attribute__((ext_vector_type(4)));
typedef unsigned u32x2 __attribute__((ext_vector_type(2)));

constexpr int DM = 2048, NBATCH = 2, SEQ = 4096, DEPTH = 4, CTX = 256;
constexpr int SROW = CTX + SEQ;
constexpr int MROWS = NBATCH * SROW;
constexpr int DFF = 8192, MODW = 6 * DM;
constexpr int DLRU = 1024;
constexpr int ABN = 3136, ABNP = 3328;
constexpr int QW = 1536, KVW = 2048, HGN = 10240;
constexpr float EPS = 1e-6f;
constexpr float ATTN_SCALE = 0.07216878364870322f;

constexpr size_t al256(size_t x) { return (x + 255) & ~(size_t)255; }
constexpr size_t WS_CTL = 0, CTL_BYTES = 1u << 20;
constexpr size_t WS_MOD = WS_CTL + CTL_BYTES;
constexpr size_t WS_LB = WS_MOD + al256((size_t)DEPTH * 3 * MODW * 4);
constexpr size_t WS_ROPE = WS_LB + al256((size_t)DEPTH * 2048 * 4);
constexpr size_t WS_RSQ = WS_ROPE + al256(2 * 64 * 16 * 4);
constexpr size_t WS_RSKV = WS_RSQ + al256((size_t)MROWS * 4);
constexpr size_t WS_WABIN = WS_RSKV + al256((size_t)MROWS * 4);
constexpr size_t WS_WABOUT = WS_WABIN + (size_t)2 * ABNP * DM * 2;
constexpr size_t WS_WUQ = WS_WABOUT + (size_t)2 * DM * DM * 2;
constexpr size_t WS_WUKV = WS_WUQ + (size_t)2 * QW * 512 * 2;
constexpr size_t WS_WHGIN = WS_WUKV + (size_t)2 * KVW * 512 * 2;
constexpr size_t WS_WHGOUT = WS_WHGIN + (size_t)2 * HGN * DM * 2;
constexpr size_t WS_W1 = WS_WHGOUT + (size_t)2 * DM * DM * 2;
constexpr size_t WS_W2 = WS_W1 + (size_t)4 * DFF * DM * 2;
constexpr size_t WS_XS = WS_W2 + (size_t)4 * DFF * DM * 2;
constexpr size_t WS_H = WS_XS + (size_t)MROWS * DM * 4;
constexpr size_t WS_Y = WS_H + (size_t)MROWS * DM * 2;
constexpr size_t WS_BIG = WS_Y + (size_t)MROWS * DM * 2;
constexpr size_t WS_P = WS_BIG;
constexpr size_t WS_UC = WS_P + (size_t)MROWS * ABNP * 2;
constexpr size_t WS_LA = WS_UC + (size_t)MROWS * DLRU * 4;
constexpr size_t WS_LBB = WS_LA + (size_t)2 * MROWS * DLRU * 4;
constexpr size_t WS_HS = WS_LBB + (size_t)2 * MROWS * DLRU * 4;
constexpr size_t WS_Q = WS_HS + (size_t)MROWS * DLRU * 4;
constexpr size_t WS_KV = WS_Q + (size_t)MROWS * QW * 2;
constexpr size_t WS_KR = WS_KV + (size_t)MROWS * KVW * 2;
constexpr size_t WS_AB_END = WS_KR + (size_t)MROWS * 64 * 2;
constexpr size_t WS_QH = WS_BIG;
constexpr size_t WS_VH = WS_QH + (size_t)MROWS * DM * 2;
constexpr size_t WS_GH = WS_VH + (size_t)MROWS * DM * 2;
constexpr size_t WS_LOGF = WS_GH + (size_t)MROWS * DM * 2;
constexpr size_t WS_DS = WS_LOGF + (size_t)2 * MROWS * DM * 4;
constexpr size_t WS_DEC = WS_DS + (size_t)64 * 68 * 16384 * 4;
constexpr size_t WS_SS = WS_DEC + (size_t)64 * 68 * 128 * 4;
constexpr size_t WS_HG_END = WS_SS + (size_t)64 * 68 * 16384 * 2;
constexpr size_t WS_HID = WS_BIG;
constexpr size_t WS_MLP_END = WS_HID + (size_t)MROWS * DFF * 2;
constexpr size_t cmax(size_t a, size_t b) { return a > b ? a : b; }
constexpr size_t WS_END = cmax(cmax(WS_AB_END, WS_HG_END), WS_MLP_END);

constexpr int LDS_BYTES = 147456;
constexpr int LDS_MISC = 131072;

__device__ __forceinline__ float bf2f(bf16_t v) { return __uint_as_float(((unsigned)v) << 16); }
__device__ __forceinline__ unsigned f2bf(float f) { unsigned u = __float_as_uint(f); return (u + 0x7fffu + ((u >> 16) & 1u)) >> 16; }
__device__ __forceinline__ unsigned pk2(float lo, float hi) { return f2bf(lo) | (f2bf(hi) << 16); }
__device__ __forceinline__ float wave_sum(float v) {
#pragma unroll
    for (int o = 1; o < 64; o <<= 1) v += __shfl_xor(v, o);
    return v;
}
__device__ __forceinline__ float wave_max(float v) {
#pragma unroll
    for (int o = 1; o < 64; o <<= 1) v = fmaxf(v, __shfl_xor(v, o));
    return v;
}
__device__ __forceinline__ float sigmoidf_(float x) { return 1.0f / (1.0f + expf(-x)); }
__device__ __forceinline__ float siluf_(float x) { return x / (1.0f + expf(-x)); }
__device__ __forceinline__ float gelu_tanh(float x) { const float u = 0.7978845608028654f * (x + 0.044715f * x * x * x); return 0.5f * x * (1.0f + tanhf(u)); }

#define XB_TMO      128
#define XB_XCNT(j)  (256  + 64 * (j))
#define XB_XSUB(j)  (1280 + 64 * (j))
#define XB_XGEN(j)  (2304 + 64 * (j))
#define XB_TOP      3328
#define XB_TOPGEN   3392
#define XCD_BAR_WORDS 3456
#define XB_SPIN_CAP (1u << 18)
__device__ __forceinline__ unsigned xb_ld(unsigned* p)              { return __hip_atomic_load(p, __ATOMIC_RELAXED, __HIP_MEMORY_SCOPE_AGENT); }
__device__ __forceinline__ unsigned xb_add(unsigned* p, unsigned v) { return __hip_atomic_fetch_add(p, v, __ATOMIC_RELAXED, __HIP_MEMORY_SCOPE_AGENT); }
__device__ __forceinline__ unsigned xb_xcc_id() { return (unsigned)__builtin_amdgcn_s_getreg((3 << 11) | 20) & 0xFu; }
#define XB_SPIN(cond, bar) do { unsigned _sp = 0; while (cond) { __builtin_amdgcn_s_sleep(1); \
    if ((++_sp & 255u) == 0u) { if (xb_ld(&(bar)[XB_TMO])) break; if (_sp > XB_SPIN_CAP) { atomicAdd(&(bar)[XB_TMO], 1u); break; } } } } while (0)
struct XcdBarrier { unsigned* bar; unsigned x; volatile LAS unsigned* st; };
__device__ __forceinline__ XcdBarrier xcd_barrier_post(unsigned* bar, volatile LAS unsigned* st) {
    XcdBarrier b; b.bar = bar; b.x = xb_xcc_id(); b.st = st;
    if (threadIdx.x == 0) (void)xb_add(&bar[XB_XCNT(b.x)], 1u);
    return b;
}
__device__ __forceinline__ void xcd_barrier_complete(unsigned* bar, unsigned x, unsigned& nloc, unsigned& nx) {
    const unsigned G = gridDim.x * gridDim.y * gridDim.z;
    unsigned sum, cnt, mine, sp = 0u;
    for (;;) {
        sum = 0u; cnt = 0u; mine = 0u;
#pragma unroll
        for (unsigned j = 0; j < 16; ++j) { const unsigned c = xb_ld(&bar[XB_XCNT(j)]); sum += c; cnt += (c > 0u) ? 1u : 0u; mine = (j == x) ? c : mine; }
        if (sum == G) break;
        __builtin_amdgcn_s_sleep(1);
        if ((++sp & 255u) == 0u) { if (xb_ld(&bar[XB_TMO])) break; if (sp > XB_SPIN_CAP) { atomicAdd(&bar[XB_TMO], 1u); break; } }
    }
    nloc = mine > 0u ? mine : 1u; nx = cnt > 0u ? cnt : 1u;
}
__device__ __forceinline__ void xcd_barrier(const XcdBarrier& b) {
    asm volatile("s_waitcnt vmcnt(0)" ::: "memory");
    __syncthreads();
    if (threadIdx.x == 0) {
        unsigned* bar = b.bar; asm volatile("" : "+s"(bar));
        __builtin_amdgcn_s_waitcnt(0);
        unsigned nloc = b.st[0], nx = b.st[1];
        if (nloc == 0u) { xcd_barrier_complete(bar, b.x, nloc, nx); b.st[0] = nloc; b.st[1] = nx; }
        const unsigned old = xb_add(&bar[XB_XSUB(b.x)], 1u);
        const unsigned gen = old / nloc;
        if (old + 1u == (gen + 1u) * nloc) {
            __builtin_amdgcn_fence(__ATOMIC_RELEASE, "agent");
            asm volatile("s_waitcnt vmcnt(0)" ::: "memory");
            const unsigned og = xb_add(&bar[XB_TOP], 1u);
            const unsigned tg = og / nx;
            if (og + 1u == (tg + 1u) * nx) xb_add(&bar[XB_TOPGEN], 1u);
            else XB_SPIN(xb_ld(&bar[XB_TOPGEN]) == tg, bar);
            __builtin_amdgcn_fence(__ATOMIC_ACQUIRE, "agent");
            xb_add(&bar[XB_XGEN(b.x)], 1u);
            asm volatile("s_waitcnt vmcnt(0)" ::: "memory");
        } else {
            XB_SPIN(xb_ld(&bar[XB_XGEN(b.x)]) == gen, bar);
            __builtin_amdgcn_fence(__ATOMIC_ACQUIRE, "agent");
            asm volatile("s_waitcnt vmcnt(0)" ::: "memory");
        }
    }
    __syncthreads();
}

namespace pg8 {
constexpr int BM = 256, BK = 64, HALF = 128, HTB = HALF * BK * 2, STAGE_BYTES = 8 * HTB, NXCD = 8, WGM = 8;
__host__ __device__ __forceinline__ int lds_byte(int r, int c) { const int st = (r >> 4) * 2 + (c >> 5), rr = r & 15, cc = c & 31, ob = rr * 64 + cc * 2; return st * 1024 + (ob ^ (((ob >> 9) & 1) << 5)); }
__host__ __device__ __forceinline__ void stage_rc(int b, int& R, int& C) { const int st = b / 1024, sb = b % 1024, swz = sb ^ (((sb >> 9) & 1) << 5); R = (st >> 1) * 16 + swz / 64; C = (st & 1) * 32 + (swz % 64) / 2; }
__host__ __device__ __forceinline__ int perm32(int rho) { const int n = rho >> 4, i = rho & 15; return 8 * (i >> 2) + 4 * n + (i & 3); }
struct Unit { int pm, pn; };
struct Gemm { const bf16_t* A; const bf16_t* Bt; int M, N, K, lda, ldb; };
struct StaticOrder {
    int nM, nN, nwg, G, c;
    __host__ __device__ void init(int M, int N, int G_, int c_) { nM = M / BM; nN = N / BM; nwg = nM * nN; G = G_; c = c_; }
    __host__ __device__ bool next(int i, Unit& u) const {
        const long L = (long)i * G + c; if (L >= nwg) return false;
        int wgid = (int)L; { const int q = nwg / NXCD, r = nwg % NXCD, xcd = wgid % NXCD, off = wgid / NXCD; wgid = (xcd < r ? xcd * (q + 1) : r * (q + 1) + (xcd - r) * q) + off; }
        const int nig = WGM * nN, gid = wgid / nig, fm = gid * WGM, gsz = (nM - fm) < WGM ? (nM - fm) : WGM;
        u.pm = fm + ((wgid % nig) % gsz); u.pn = (wgid % nig) / gsz; return true;
    }
};
__device__ __forceinline__ unsigned cvt_pk_bf16(float lo, float hi) { unsigned r; asm volatile("v_cvt_pk_bf16_f32 %0, %1, %2" : "=v"(r) : "v"(lo), "v"(hi)); return r; }

template <class Epi>
__device__ __forceinline__ void gemm_phase(LAS unsigned char* lds, const int tid, const Gemm g, const StaticOrder& S, const Epi& E) {
    const int wid = __builtin_amdgcn_readfirstlane(tid >> 6), lane = tid & 63, wr = wid >> 2, wc = wid & 3, fr = lane & 15, fq = lane >> 4;
    const int K = g.K, nt = K / BK;
    unsigned voffA[2], voffB[2];
#pragma unroll
    for (int i = 0; i < 2; ++i) { int R, C; stage_rc(tid * 16 + i * 8192, R, C); const int Rb = Epi::PERM ? ((R & ~31) + perm32(R & 31)) : R;
        voffA[i] = (unsigned)(R * g.lda + C) * 2u; voffB[i] = (unsigned)(Rb * g.ldb + C) * 2u; }
    const size_t kstep = (size_t)(BK * 2);
    const size_t hsA = (size_t)HALF * g.lda * 2, hsB = (size_t)HALF * g.ldb * 2;
    const size_t tsA = 2 * hsA, tsB = 2 * hsB;
    const unsigned ldsw = (unsigned)wid * 1024u;
    const int aoff = lds_byte(wr * 64 + fr, fq * 8), boff = lds_byte(wc * 32 + fr, fq * 8);
#define PG8_SA(b, h) (((b) * 2 + (h)) * HTB)
#define PG8_SB(b, h) ((4 + (b) * 2 + (h)) * HTB)
#define PG8_STAGE(bufoff, gbase, voff) do { _Pragma("unroll") for (int _i = 0; _i < 2; ++_i) \
        __builtin_amdgcn_global_load_lds((const unsigned*)((const char*)(gbase) + (voff)[_i]), (LAS unsigned*)(lds + (bufoff) + ldsw + _i * 8192), 16, 0, 0); } while (0)
#define PG8_LDA(dst, b, h) do { _Pragma("unroll") for (int m = 0; m < 4; ++m) _Pragma("unroll") for (int k = 0; k < 2; ++k) dst[m][k] = *(const LAS bf16x8*)(lds + PG8_SA(b, h) + aoff + m * 2048 + k * 1024); } while (0)
#define PG8_LDB(dst, b, h) do { _Pragma("unroll") for (int n = 0; n < 2; ++n) _Pragma("unroll") for (int k = 0; k < 2; ++k) dst[n][k] = *(const LAS bf16x8*)(lds + PG8_SB(b, h) + boff + n * 2048 + k * 1024); } while (0)
#define PG8_MMA(ai, bj, At, Bt) do { __builtin_amdgcn_s_setprio(1); _Pragma("unroll") for (int m = 0; m < 4; ++m) _Pragma("unroll") for (int n = 0; n < 2; ++n) _Pragma("unroll") for (int k = 0; k < 2; ++k) \
        acc[ai][bj][m][n] = __builtin_amdgcn_mfma_f32_16x16x32_bf16(Bt[n][k], At[m][k], acc[ai][bj][m][n], 0, 0, 0); __builtin_amdgcn_s_setprio(0); } while (0)
#define PG8_WAIT_V(n) asm volatile("s_waitcnt vmcnt(" #n ")" ::: "memory")
#define PG8_WAIT_L(n) asm volatile("s_waitcnt lgkmcnt(" #n ")" ::: "memory")
#define PG8_BAR __builtin_amdgcn_s_barrier()
#define PG8_SCHED __builtin_amdgcn_sched_barrier(0)
    Unit cur, nxt; int ui = 0;
    if (!S.next(0, cur)) return;
    f32x4 acc[2][2][4][2];
#pragma unroll
    for (int a = 0; a < 2; ++a)
#pragma unroll
        for (int b = 0; b < 2; ++b)
#pragma unroll
            for (int m = 0; m < 4; ++m)
#pragma unroll
                for (int n = 0; n < 2; ++n) acc[a][b][m][n] = (f32x4){0.f, 0.f, 0.f, 0.f};
    bf16x8 At[4][2], B0[2][2], B1[2][2];
    const char* cA = (const char*)g.A + (size_t)cur.pm * tsA; const char* cB = (const char*)g.Bt + (size_t)cur.pn * tsB;
    PG8_STAGE(PG8_SB(0, 0), cB, voffB); PG8_STAGE(PG8_SA(0, 0), cA, voffA); PG8_STAGE(PG8_SB(0, 1), cB + hsB, voffB); PG8_STAGE(PG8_SA(0, 1), cA + hsA, voffA);
    if (wr == 1) PG8_BAR;
    PG8_WAIT_V(4); PG8_BAR;
    PG8_STAGE(PG8_SB(1, 0), cB + kstep, voffB); PG8_STAGE(PG8_SA(1, 0), cA + kstep, voffA); PG8_STAGE(PG8_SB(1, 1), cB + hsB + kstep, voffB);
    PG8_WAIT_V(6); PG8_BAR;
    for (;;) {
        const bool has_next = S.next(ui + 1, nxt);
        const char* nA = has_next ? (const char*)g.A + (size_t)nxt.pm * tsA : cA; const char* nB = has_next ? (const char*)g.Bt + (size_t)nxt.pn * tsB : cB;
        for (int t = 0; t < nt; t += 2) {
            const bool last = (t == nt - 2);
            const char* a1 = cA + (size_t)(t + 1) * kstep;
            const char* a2 = last ? nA : cA + (size_t)(t + 2) * kstep; const char* b2 = last ? nB : cB + (size_t)(t + 2) * kstep;
            const char* a3 = a2 + kstep; const char* b3 = b2 + kstep;
            PG8_LDB(B0, 0, 0); PG8_SCHED; PG8_LDA(At, 0, 0); PG8_STAGE(PG8_SA(1, 1), a1 + hsA, voffA);
            PG8_WAIT_L(8); PG8_BAR; PG8_WAIT_L(0); PG8_MMA(0, 0, At, B0); PG8_BAR; PG8_SCHED;
            PG8_LDB(B1, 0, 1); PG8_STAGE(PG8_SB(0, 0), b2, voffB);
            PG8_BAR; PG8_WAIT_L(0); PG8_MMA(0, 1, At, B1); PG8_BAR;
            PG8_LDA(At, 0, 1); PG8_STAGE(PG8_SA(0, 0), a2, voffA);
            PG8_BAR; PG8_WAIT_L(0); PG8_MMA(1, 0, At, B0); PG8_BAR; PG8_SCHED;
            PG8_STAGE(PG8_SB(0, 1), b2 + hsB, voffB);
            PG8_WAIT_V(6); PG8_BAR; PG8_MMA(1, 1, At, B1); PG8_BAR;
            PG8_LDB(B0, 1, 0); PG8_SCHED; PG8_LDA(At, 1, 0); PG8_STAGE(PG8_SA(0, 1), a2 + hsA, voffA);
            PG8_WAIT_L(8); PG8_BAR; PG8_WAIT_L(0); PG8_MMA(0, 0, At, B0); PG8_BAR; PG8_SCHED;
            PG8_LDB(B1, 1, 1); PG8_STAGE(PG8_SB(1, 0), b3, voffB);
            PG8_BAR; PG8_WAIT_L(0); PG8_MMA(0, 1, At, B1); PG8_BAR;
            PG8_LDA(At, 1, 1); PG8_STAGE(PG8_SA(1, 0), a3, voffA);
            PG8_BAR; PG8_WAIT_L(0); PG8_MMA(1, 0, At, B0); PG8_BAR; PG8_SCHED;
            PG8_STAGE(PG8_SB(1, 1), b3 + hsB, voffB);
            PG8_WAIT_V(6); PG8_BAR; PG8_MMA(1, 1, At, B1); PG8_BAR;
        }
        E(acc, cur, wr, wc, fr, fq);
        if (!has_next) break;
#pragma unroll
        for (int a = 0; a < 2; ++a)
#pragma unroll
            for (int b = 0; b < 2; ++b)
#pragma unroll
                for (int m = 0; m < 4; ++m)
#pragma unroll
                    for (int n = 0; n < 2; ++n) acc[a][b][m][n] = (f32x4){0.f, 0.f, 0.f, 0.f};
        cur = nxt; cA = nA; cB = nB; ++ui;
    }
    PG8_WAIT_V(0);
    if (wr == 0) PG8_BAR;
    PG8_BAR;
#undef PG8_SA
#undef PG8_SB
#undef PG8_STAGE
#undef PG8_LDA
#undef PG8_LDB
#undef PG8_MMA
#undef PG8_WAIT_V
#undef PG8_WAIT_L
#undef PG8_BAR
#undef PG8_SCHED
}
}

#define EPI_ROWS_COLS_PERM \
    const int row0 = u.pm * 256 + wr * 64 + fr; const int col0 = u.pn * 256 + wc * 32 + 8 * fq;
struct EpiBf16Plain {
    static constexpr bool PERM = true;
    bf16_t* O; int ldc;
    __device__ __forceinline__ void operator()(const f32x4 (&acc)[2][2][4][2], const pg8::Unit& u, int wr, int wc, int fr, int fq) const {
        EPI_ROWS_COLS_PERM
#pragma unroll
        for (int ai = 0; ai < 2; ++ai)
#pragma unroll
            for (int m = 0; m < 4; ++m) { bf16_t* rowp = O + (size_t)(row0 + ai * 128 + m * 16) * ldc + col0;
#pragma unroll
                for (int bj = 0; bj < 2; ++bj) { const f32x4 v0 = acc[ai][bj][m][0], v1 = acc[ai][bj][m][1];
                    u32x4 w; w.x = pk2(v0[0], v0[1]); w.y = pk2(v0[2], v0[3]); w.z = pk2(v1[0], v1[1]); w.w = pk2(v1[2], v1[3]);
                    *(u32x4*)(rowp + bj * 128) = w; } }
    }
};
struct EpiBf16RowScale {
    static constexpr bool PERM = true;
    bf16_t* O; int ldc; const float* rs;
    __device__ __forceinline__ void operator()(const f32x4 (&acc)[2][2][4][2], const pg8::Unit& u, int wr, int wc, int fr, int fq) const {
        EPI_ROWS_COLS_PERM
#pragma unroll
        for (int ai = 0; ai < 2; ++ai)
#pragma unroll
            for (int m = 0; m < 4; ++m) { const int row = row0 + ai * 128 + m * 16; const float s = rs[row]; bf16_t* rowp = O + (size_t)row * ldc + col0;
#pragma unroll
                for (int bj = 0; bj < 2; ++bj) { const f32x4 v0 = acc[ai][bj][m][0] * s, v1 = acc[ai][bj][m][1] * s;
                    u32x4 w; w.x = pk2(v0[0], v0[1]); w.y = pk2(v0[2], v0[3]); w.z = pk2(v1[0], v1[1]); w.w = pk2(v1[2], v1[3]);
                    *(u32x4*)(rowp + bj * 128) = w; } }
    }
};
struct EpiRelu2 {
    static constexpr bool PERM = true;
    bf16_t* O; int ldc;
    __device__ __forceinline__ void operator()(const f32x4 (&acc)[2][2][4][2], const pg8::Unit& u, int wr, int wc, int fr, int fq) const {
        EPI_ROWS_COLS_PERM
#pragma unroll
        for (int ai = 0; ai < 2; ++ai)
#pragma unroll
            for (int m = 0; m < 4; ++m) { bf16_t* rowp = O + (size_t)(row0 + ai * 128 + m * 16) * ldc + col0;
#pragma unroll
                for (int bj = 0; bj < 2; ++bj) { f32x4 v0 = acc[ai][bj][m][0], v1 = acc[ai][bj][m][1];
#pragma unroll
                    for (int j = 0; j < 4; ++j) { const float a = fmaxf(v0[j], 0.f), b = fmaxf(v1[j], 0.f); v0[j] = a * a; v1[j] = b * b; }
                    u32x4 w; w.x = pk2(v0[0], v0[1]); w.y = pk2(v0[2], v0[3]); w.z = pk2(v1[0], v1[1]); w.w = pk2(v1[2], v1[3]);
                    *(u32x4*)(rowp + bj * 128) = w; } }
    }
};
struct EpiResid {
    static constexpr bool PERM = false;
    float* XS; const float* gate;
    __device__ __forceinline__ void operator()(const f32x4 (&acc)[2][2][4][2], const pg8::Unit& u, int wr, int wc, int fr, int fq) const {
        const int row0 = u.pm * 256 + wr * 64 + fr, col0 = u.pn * 256 + wc * 32 + 4 * fq;
        const int cond = (u.pm % 17 == 0) ? 2 : (u.pm / 17);
        const float* gp = gate + (size_t)cond * MODW + col0;
        f32x4 gv[2][2];
#pragma unroll
        for (int bj = 0; bj < 2; ++bj)
#pragma unroll
            for (int n = 0; n < 2; ++n) gv[bj][n] = *(const f32x4*)(gp + bj * 128 + n * 16);
#pragma unroll
        for (int ai = 0; ai < 2; ++ai)
#pragma unroll
            for (int m = 0; m < 4; ++m) { float* rowp = XS + (size_t)(row0 + ai * 128 + m * 16) * DM + col0;
#pragma unroll
                for (int bj = 0; bj < 2; ++bj)
#pragma unroll
                    for (int n = 0; n < 2; ++n) { f32x4* p = (f32x4*)(rowp + bj * 128 + n * 16); *p = *p + gv[bj][n] * acc[ai][bj][m][n]; } }
    }
};
struct EpiHG {
    static constexpr bool PERM = true;
    bf16_t* QVG; float* LOGF; const float* lb;
    __device__ __forceinline__ void operator()(const f32x4 (&acc)[2][2][4][2], const pg8::Unit& u, int wr, int wc, int fr, int fq) const {
        const int row0 = u.pm * 256 + wr * 64 + fr; const int seg = u.pn >> 3; const int col0 = (u.pn & 7) * 256 + wc * 32 + 8 * fq;
        if (seg == 1 || seg == 2) {
            float* base = LOGF + (size_t)(seg - 1) * MROWS * DM;
            f32x4 lbv[2][2];
#pragma unroll
            for (int bj = 0; bj < 2; ++bj)
#pragma unroll
                for (int n = 0; n < 2; ++n) lbv[bj][n] = *(const f32x4*)(lb + col0 + bj * 128 + 4 * n);
#pragma unroll
            for (int ai = 0; ai < 2; ++ai)
#pragma unroll
                for (int m = 0; m < 4; ++m) { float* rowp = base + (size_t)(row0 + ai * 128 + m * 16) * DM + col0;
#pragma unroll
                    for (int bj = 0; bj < 2; ++bj)
#pragma unroll
                        for (int n = 0; n < 2; ++n) { f32x4 v = acc[ai][bj][m][n];
#pragma unroll
                            for (int j = 0; j < 4; ++j) { const float l = lbv[bj][n][j]; v[j] = logf(l + (1.0f - l) * sigmoidf_(v[j])); }
                            *(f32x4*)(rowp + bj * 128 + 4 * n) = v; } }
        } else {
            const int bi = seg - 2 + (seg == 0 ? 2 : 0);
            bf16_t* base = QVG + (size_t)bi * MROWS * DM;
            const bool act = (seg != 3);
#pragma unroll
            for (int ai = 0; ai < 2; ++ai)
#pragma unroll
                for (int m = 0; m < 4; ++m) { bf16_t* rowp = base + (size_t)(row0 + ai * 128 + m * 16) * DM + col0;
#pragma unroll
                    for (int bj = 0; bj < 2; ++bj) { f32x4 v0 = acc[ai][bj][m][0], v1 = acc[ai][bj][m][1];
                        if (act) {
#pragma unroll
                            for (int j = 0; j < 4; ++j) { v0[j] = siluf_(v0[j]); v1[j] = siluf_(v1[j]); } }
                        u32x4 w; w.x = pk2(v0[0], v0[1]); w.y = pk2(v0[2], v0[3]); w.z = pk2(v1[0], v1[1]); w.w = pk2(v1[2], v1[3]);
                        *(u32x4*)(rowp + bj * 128) = w; } }
        }
    }
};


namespace att {
using s16x4  = __attribute__((ext_vector_type(4))) short;
using f32x16 = __attribute__((ext_vector_type(16))) float;
constexpr int NW = 8, QBLK = 32, KVBLK = 64;
constexpr float SCALE = ATTN_SCALE;
constexpr float THR = 8.f;
constexpr int SHM_V = KVBLK * 128 * 2, SHM_K = KVBLK * 128 * 2, SHM_KR = KVBLK * 64 * 2;
constexpr int OFF_V = 0, OFF_K = 2 * SHM_V, OFF_KR = OFF_K + 2 * SHM_K, OFF_WS = OFF_KR + 2 * SHM_KR, SHM_ATTN = OFF_WS + NW * 64 * 4;
constexpr int LDQ = QW, LDK = KVW, LDO = DM;
#define KSWZ(row, colB) ((row) * 256 + ((colB) ^ (((row) & 7) << 4)))
#define RSWZ(row, colB) ((row) * 128 + ((colB) ^ ((((row) >> 1) & 7) << 4)))
#define SBAR() __builtin_amdgcn_sched_barrier(0)
__device__ __forceinline__ int crow(int r, int hi) { return (r & 3) + 8 * (r >> 2) + 4 * hi; }
__device__ __forceinline__ unsigned cvtpk(float lo, float hi) { unsigned r; asm volatile("v_cvt_pk_bf16_f32 %0, %1, %2" : "=v"(r) : "v"(lo), "v"(hi)); return r; }
__device__ __forceinline__ bf16x8 ld8(const bf16_t* p) { return *reinterpret_cast<const bf16x8*>(p); }
__device__ __forceinline__ void partialSM(f32x16& p0, f32x16& p1, float& m_reg, float& mn, float& alpha) {
  constexpr float C = SCALE * 1.4426950408889634f;
  float pmax = p0[0];
#pragma unroll
  for (int r = 1; r < 16; ++r) pmax = fmaxf(pmax, p0[r]);
#pragma unroll
  for (int r = 0; r < 16; ++r) pmax = fmaxf(pmax, p1[r]);
  { auto rr = __builtin_amdgcn_permlane32_swap(__float_as_uint(pmax), __float_as_uint(pmax), false, false);
    pmax = fmaxf(__uint_as_float(rr[0]), __uint_as_float(rr[1])); }
  if (__builtin_expect(__all(pmax - m_reg <= THR / SCALE), 1)) { mn = m_reg; alpha = 1.f; }
  else { mn = fmaxf(m_reg, pmax); alpha = __builtin_amdgcn_exp2f((m_reg - mn) * C); m_reg = mn; }
  float mnC = -mn * C;
#pragma unroll
  for (int r = 0; r < 16; ++r) p0[r] = fmaf(p0[r], C, mnC);
#pragma unroll
  for (int r = 0; r < 16; ++r) p1[r] = fmaf(p1[r], C, mnC);
#pragma unroll
  for (int r = 0; r < 16; ++r) p0[r] = __builtin_amdgcn_exp2f(p0[r]);
}
__device__ __forceinline__ void finishSM(f32x16& p0, f32x16& p1, float alpha, float& l_reg, bf16x8& pa0, bf16x8& pa1, bf16x8& pa2, bf16x8& pa3) {
#pragma unroll
  for (int r = 0; r < 16; ++r) p1[r] = __builtin_amdgcn_exp2f(p1[r]);
  float ps = 0;
#pragma unroll
  for (int r = 0; r < 16; ++r) ps += p0[r];
#pragma unroll
  for (int r = 0; r < 16; ++r) ps += p1[r];
  { auto rr = __builtin_amdgcn_permlane32_swap(__float_as_uint(ps), __float_as_uint(ps), false, false);
    ps = __uint_as_float(rr[0]) + __uint_as_float(rr[1]); }
  l_reg = l_reg * alpha + ps;
#define PK4(P, BASE, OUT) do { unsigned a0 = cvtpk(P[BASE + 0], P[BASE + 1]), a1 = cvtpk(P[BASE + 2], P[BASE + 3]);   \
    unsigned b0 = cvtpk(P[BASE + 4], P[BASE + 5]), b1 = cvtpk(P[BASE + 6], P[BASE + 7]);                              \
    auto r0 = __builtin_amdgcn_permlane32_swap(a0, b0, false, false); auto r1 = __builtin_amdgcn_permlane32_swap(a1, b1, false, false); \
    u32x4 w = {r0[0], r1[0], r0[1], r1[1]}; OUT = *reinterpret_cast<bf16x8*>(&w); } while (0)
  PK4(p0, 0, pa0); PK4(p0, 8, pa1); PK4(p1, 0, pa2); PK4(p1, 8, pa3);
#undef PK4
}
__device__ __forceinline__ void qkt(f32x16& p0, f32x16& p1, const char* Ks, const char* Krs, const bf16x8* qr, int r32, int hi) {
  p0 = f32x16{}; p1 = f32x16{};
#pragma unroll
  for (int d0 = 0; d0 < 8; ++d0) { int cb = (d0 * 16 + hi * 8) * 2;
    bf16x8 b0 = *reinterpret_cast<const bf16x8*>(Ks + KSWZ(r32, cb));
    bf16x8 b1 = *reinterpret_cast<const bf16x8*>(Ks + KSWZ(32 + r32, cb));
    p0 = __builtin_amdgcn_mfma_f32_32x32x16_bf16(b0, qr[d0], p0, 0, 0, 0);
    p1 = __builtin_amdgcn_mfma_f32_32x32x16_bf16(b1, qr[d0], p1, 0, 0, 0); }
#pragma unroll
  for (int d0 = 0; d0 < 4; ++d0) { int cb = (d0 * 16 + hi * 8) * 2;
    bf16x8 b0 = *reinterpret_cast<const bf16x8*>(Krs + RSWZ(r32, cb));
    bf16x8 b1 = *reinterpret_cast<const bf16x8*>(Krs + RSWZ(32 + r32, cb));
    p0 = __builtin_amdgcn_mfma_f32_32x32x16_bf16(b0, qr[8 + d0], p0, 0, 0, 0);
    p1 = __builtin_amdgcn_mfma_f32_32x32x16_bf16(b1, qr[8 + d0], p1, 0, 0, 0); }
}
__device__ __forceinline__ int v_st(int k, int c) { const int kk = (k & ~0xC) | ((k & 4) << 1) | ((k & 8) >> 1); return ((kk >> 3) * 4 + (c >> 5)) * 512 + ((kk & 7) * 32 + (c & 31)) * 2; }
__device__ __forceinline__ int v_rd_base(int lane) { return ((lane & 3) << 3) | (((lane >> 2) & 3) << 6) | (((lane >> 4) & 1) << 5) | (((lane >> 5) & 1) << 8); }
constexpr int v_rd_off(int d0, int ks, int half) { return d0 * 512 + ks * 4096 + half * 2048; }
template <int OFF> __device__ __forceinline__ s16x4 tr_read(int vb) {
  s16x4 r; asm volatile("ds_read_b64_tr_b16 %0, %1 offset:%2" : "=&v"(r) : "v"(vb), "i"(OFF) : "memory"); return r;
}
template <int D0> __device__ __forceinline__ void pv_one(f32x16& od, int vb, bf16x8 pa0, bf16x8 pa1, bf16x8 pa2, bf16x8 pa3) {
  const s16x4 l0 = tr_read<v_rd_off(D0, 0, 0)>(vb), h0 = tr_read<v_rd_off(D0, 0, 1)>(vb), l1 = tr_read<v_rd_off(D0, 1, 0)>(vb), h1 = tr_read<v_rd_off(D0, 1, 1)>(vb);
  const s16x4 l2 = tr_read<v_rd_off(D0, 2, 0)>(vb), h2 = tr_read<v_rd_off(D0, 2, 1)>(vb), l3 = tr_read<v_rd_off(D0, 3, 0)>(vb), h3 = tr_read<v_rd_off(D0, 3, 1)>(vb);
  asm volatile("s_waitcnt lgkmcnt(0)" ::: "memory"); SBAR();
#define PK(L, H) (bf16x8){L[0], L[1], L[2], L[3], H[0], H[1], H[2], H[3]}
  od = __builtin_amdgcn_mfma_f32_32x32x16_bf16(pa0, PK(l0, h0), od, 0, 0, 0);
  od = __builtin_amdgcn_mfma_f32_32x32x16_bf16(pa1, PK(l1, h1), od, 0, 0, 0);
  od = __builtin_amdgcn_mfma_f32_32x32x16_bf16(pa2, PK(l2, h2), od, 0, 0, 0);
  od = __builtin_amdgcn_mfma_f32_32x32x16_bf16(pa3, PK(l3, h3), od, 0, 0, 0);
#undef PK
}
__device__ __forceinline__ void pv_d0(f32x16* o, int vb, bf16x8 pa0, bf16x8 pa1, bf16x8 pa2, bf16x8 pa3) {
  pv_one<0>(o[0], vb, pa0, pa1, pa2, pa3); pv_one<1>(o[1], vb, pa0, pa1, pa2, pa3); pv_one<2>(o[2], vb, pa0, pa1, pa2, pa3); pv_one<3>(o[3], vb, pa0, pa1, pa2, pa3);
}
__device__ __forceinline__ void attn_body(const bf16_t* __restrict__ Qb, const bf16_t* __restrict__ Kh, const bf16_t* __restrict__ KRb,
                                          bf16_t* __restrict__ Ob, int seq, int tq0, const float* __restrict__ RC, const float* __restrict__ RS, char* lds, int tid) {
  const bf16_t* Vh = Kh + 128;
  const int wid = tid >> 6, lane = tid & 63, r32 = lane & 31, hi = lane >> 5;
  char* V_lds = lds + OFF_V; char* K_lds = lds + OFF_K; char* KR_lds = lds + OFF_KR;
  float* ws = (float*)(lds + OFF_WS) + wid * 64; float* li_l = ws; float* al_l = ws + 32;
  float m_reg = -1e30f, l_reg = 0; f32x16 o[4] = {}; bf16x8 qr[12];
  const bf16_t* Qw = Qb + (long)(wid * QBLK + r32) * LDQ + hi * 8;
#pragma unroll
  for (int d0 = 0; d0 < 12; ++d0) qr[d0] = ld8(Qw + d0 * 16);
  if (tq0 >= 0) {
    const int t = tq0 + wid * QBLK + r32; const int pr = (t >> 6) * 16 + hi * 8, pc = (t & 63) * 16 + hi * 8;
#pragma unroll
    for (int j = 0; j < 8; ++j) {
      { const float c = RC[pr + j], sn = RS[pr + j]; const float x0 = bf2f((bf16_t)qr[8][j]), x1 = bf2f((bf16_t)qr[9][j]);
        qr[8][j] = (short)f2bf(x0 * c - x1 * sn); qr[9][j] = (short)f2bf(x1 * c + x0 * sn); }
      { const float c = RC[pc + j], sn = RS[pc + j]; const float x0 = bf2f((bf16_t)qr[10][j]), x1 = bf2f((bf16_t)qr[11][j]);
        qr[10][j] = (short)f2bf(x0 * c - x1 * sn); qr[11][j] = (short)f2bf(x1 * c + x0 * sn); }
    }
  }
  const int sr = tid >> 4, sc = (tid & 15) * 8, vst0 = v_st(sr, sc), vst1 = v_st(32 + sr, sc);
  const int rr = tid >> 3, rc = (tid & 7) * 8;
  const int vb0 = (int)(uintptr_t)V_lds + v_rd_base(lane);
  bf16x8 vs0, vs1, ks0, ks1, krs;
#define SLOAD(k0) do { vs0 = ld8(&Vh[(long)((k0) + sr) * LDK + sc]); vs1 = ld8(&Vh[(long)((k0) + 32 + sr) * LDK + sc]); \
    ks0 = ld8(&Kh[(long)((k0) + sr) * LDK + sc]); ks1 = ld8(&Kh[(long)((k0) + 32 + sr) * LDK + sc]); krs = ld8(&KRb[(long)((k0) + rr) * 64 + rc]); } while (0)
#define SWRITE(b) do { *(bf16x8*)(V_lds + (b) * SHM_V + vst0) = vs0; *(bf16x8*)(V_lds + (b) * SHM_V + vst1) = vs1; int kc = sc * 2;   \
    *(bf16x8*)(K_lds + (b) * SHM_K + KSWZ(sr, kc)) = ks0; *(bf16x8*)(K_lds + (b) * SHM_K + KSWZ(32 + sr, kc)) = ks1;                    \
    *(bf16x8*)(KR_lds + (b) * SHM_KR + RSWZ(rr, rc * 2)) = krs; } while (0)
#define SWAIT() asm volatile("s_waitcnt vmcnt(0)" ::: "memory")
#define RESC(a) do { if (__any((a) < 1.f)) { if (hi == 0) al_l[r32] = (a); asm volatile("s_waitcnt lgkmcnt(0)" ::: "memory"); \
    _Pragma("unroll") for (int d = 0; d < 4; ++d) _Pragma("unroll") for (int r = 0; r < 16; ++r) o[d][r] *= al_l[crow(r, hi)]; } } while (0)
  f32x16 p0, p1; float mn, al; bf16x8 pa0, pa1, pa2, pa3; const int NT = seq / KVBLK;
  SLOAD(0); SWAIT(); SWRITE(0); __syncthreads();
  SLOAD(KVBLK);
  for (int j = 0; j < NT; ++j) {
    const int buf = j & 1;
    SBAR(); qkt(p0, p1, K_lds + buf * SHM_K, KR_lds + buf * SHM_KR, qr, r32, hi);
    partialSM(p0, p1, m_reg, mn, al); RESC(al);
    finishSM(p0, p1, al, l_reg, pa0, pa1, pa2, pa3); SBAR();
    if (j + 1 < NT) { SWAIT(); SWRITE(buf ^ 1); }
    if (j + 2 < NT) SLOAD((j + 2) * KVBLK);
    SBAR();
    pv_d0(o, vb0 + buf * SHM_V, pa0, pa1, pa2, pa3);
    __syncthreads();
  }
  if (hi == 0) li_l[r32] = l_reg; asm volatile("s_waitcnt lgkmcnt(0)" ::: "memory");
  float rli[16];
#pragma unroll
  for (int r = 0; r < 16; ++r) rli[r] = __builtin_amdgcn_rcpf(li_l[crow(r, hi)]);
  bf16_t* Ow = Ob + (long)(wid * QBLK) * LDO;
#pragma unroll
  for (int r = 0; r < 16; ++r) { int orow = crow(r, hi);
#pragma unroll
    for (int d0 = 0; d0 < 4; ++d0) Ow[(long)orow * LDO + d0 * 32 + r32] = (bf16_t)f2bf(o[d0][r] * rli[r]); }
#undef SLOAD
#undef SWRITE
#undef SWAIT
#undef RESC
}
}

typedef const float* cfp_t;
typedef const __attribute__((address_space(4))) cfp_t* InPtr;
struct Ctx {
    LAS unsigned char* lds; int tid, lane, wave, gw, ngw, gtid, ngt;
    InPtr in; float* out; unsigned char* ws;
};
#define WSP(T, off) ((T*)(C.ws + (off)))

__device__ __forceinline__ void tr_item(const float* W, int K, int N, bf16_t* WT, const float* sck, LAS float* scr, int item, int lane) {
    const int nblk = N / 32, kb = item / nblk, nb = item % nblk, k0 = 64 * kb, n0 = 32 * nb;
#pragma unroll 8
    for (int i = 0; i < 32; ++i) { const int kk = 2 * i + (lane >> 5); float v = W[(size_t)(k0 + kk) * N + n0 + (lane & 31)]; if (sck) v *= sck[k0 + kk]; scr[kk * 33 + (lane & 31)] = v; }
    asm volatile("s_waitcnt lgkmcnt(0)" ::: "memory"); __builtin_amdgcn_wave_barrier();
    const int c = lane & 7;
#pragma unroll
    for (int j = 0; j < 4; ++j) { const int n = (lane >> 3) + 8 * j; const LAS float* s = scr + (8 * c) * 33 + n;
        u32x4 o; o.x = pk2(s[0 * 33], s[1 * 33]); o.y = pk2(s[2 * 33], s[3 * 33]); o.z = pk2(s[4 * 33], s[5 * 33]); o.w = pk2(s[6 * 33], s[7 * 33]);
        *(u32x4*)(WT + (size_t)(n0 + n) * K + k0 + 8 * c) = o; }
    asm volatile("s_waitcnt lgkmcnt(0)" ::: "memory"); __builtin_amdgcn_wave_barrier();
}
__device__ __forceinline__ void tr_matrix(const Ctx& C, const float* W, int K, int N, bf16_t* WT, const float* sck) {
    LAS float* scr = (LAS float*)(C.lds + C.wave * 16384);
    const int cnt = (K / 64) * (N / 32);
    for (int it = C.gw; it < cnt; it += C.ngw) tr_item(W, K, N, WT, sck, scr, it, C.lane);
}
__device__ __forceinline__ void sincos_d(double x, double& s, double& c) {
    const double twopi = 6.283185307179586476925286766559;
    const double k = __builtin_rint(x / twopi); const double y = x - k * twopi; const double y2 = y * y;
    double ts = y, ss = y, tc = 1.0, sc = 1.0;
#pragma unroll
    for (int n = 1; n <= 16; ++n) { tc *= -y2 / (double)((2 * n - 1) * (2 * n)); sc += tc; ts *= -y2 / (double)((2 * n) * (2 * n + 1)); ss += ts; }
    s = ss; c = sc;
}
__device__ __forceinline__ void phase_prologue(const Ctx& C) {
#pragma unroll 1
    for (int e = 0; e < 2; ++e) {
        tr_matrix(C, C.in[8] + (size_t)e * DM * ABN, DM, ABN, WSP(bf16_t, WS_WABIN) + (size_t)e * ABNP * DM, nullptr);
        tr_matrix(C, C.in[9] + (size_t)e * DM * DM, DM, DM, WSP(bf16_t, WS_WABOUT) + (size_t)e * DM * DM, nullptr);
        tr_matrix(C, C.in[18] + (size_t)e * 512 * QW, 512, QW, WSP(bf16_t, WS_WUQ) + (size_t)e * QW * 512, C.in[17] + e * 512);
        tr_matrix(C, C.in[20] + (size_t)e * 512 * KVW, 512, KVW, WSP(bf16_t, WS_WUKV) + (size_t)e * KVW * 512, C.in[19] + e * 512);
        tr_matrix(C, C.in[21] + (size_t)e * DM * HGN, DM, HGN, WSP(bf16_t, WS_WHGIN) + (size_t)e * HGN * DM, nullptr);
        tr_matrix(C, C.in[24] + (size_t)e * DM * DM, DM, DM, WSP(bf16_t, WS_WHGOUT) + (size_t)e * DM * DM, nullptr);
    }
#pragma unroll 1
    for (int l = 0; l < 4; ++l) {
        tr_matrix(C, C.in[25] + (size_t)l * DM * DFF, DM, DFF, WSP(bf16_t, WS_W1) + (size_t)l * DFF * DM, nullptr);
        tr_matrix(C, C.in[26] + (size_t)l * DFF * DM, DFF, DM, WSP(bf16_t, WS_W2) + (size_t)l * DM * DFF, nullptr);
    }
    for (int e = 0; e < 2; ++e) { u32x4* z = (u32x4*)(WSP(bf16_t, WS_WABIN) + (size_t)e * ABNP * DM + (size_t)ABN * DM);
        for (int i = C.gtid; i < (ABNP - ABN) * DM / 8; i += C.ngt) z[i] = (u32x4){0u, 0u, 0u, 0u}; }
    { float* XS = WSP(float, WS_XS);
      for (int i = C.gtid; i < MROWS * (DM / 4); i += C.ngt) { const int R = i / (DM / 4), c4 = i % (DM / 4); const int b = R / SROW, s = R % SROW;
          const float* src = s < CTX ? C.in[2] + ((size_t)(b * CTX + s)) * DM : C.in[0] + ((size_t)(b * SEQ + (s - CTX))) * DM;
          ((f32x4*)(XS + (size_t)R * DM))[c4] = ((const f32x4*)src)[c4]; } }
    { float* LB = WSP(float, WS_LB);
      for (int i = C.gtid; i < 2048; i += C.ngt) { float v[4], mx = -1e30f; for (int l = 0; l < 4; ++l) { v[l] = C.in[22][l * 2048 + i]; mx = fmaxf(mx, v[l]); }
          float sum = 0.f; for (int l = 0; l < 4; ++l) { v[l] = expf(v[l] - mx); sum += v[l]; }
          float cum = 0.f; const float p0 = v[0] / sum; for (int l = 0; l < 4; ++l) { cum += v[l] / sum; LB[l * 2048 + i] = cum - p0; } }
      float* RC = WSP(float, WS_ROPE); float* RS = RC + 1024;
      for (int i = C.gtid; i < 1024; i += C.ngt) { const int pos = i / 16, j = i % 16; double inv = 1.0; for (int q = 0; q < j; ++q) inv *= 0.56234132519034908;
          const float ang = (float)pos * (float)inv; double s, c; sincos_d((double)ang, s, c); RC[i] = (float)c; RS[i] = (float)s; } }
    { LAS float* sl = (LAS float*)C.lds;
      LAS float* red = sl + 3 * 2048;
      __syncthreads();
      for (int i = C.tid; i < 3 * 2048; i += 512) { const int r = i / 2048, d = i % 2048; const float v = r < 2 ? C.in[1][r * 2048 + d] : C.in[3][d]; sl[i] = siluf_(v); }
      __syncthreads();
      float* MOD = WSP(float, WS_MOD);
      const int kq = C.tid >> 4, cq = C.tid & 15;
      for (int u = blockIdx.x; u < 4 * (MODW / 64); u += gridDim.x) { const int l = u / (MODW / 64), e0 = (u % (MODW / 64)) * 64;
          const float* w = C.in[4] + (size_t)l * DM * MODW + e0 + 4 * cq;
          f32x4 a0 = {0, 0, 0, 0}, a1 = {0, 0, 0, 0}, a2 = {0, 0, 0, 0};
#pragma unroll 4
          for (int d = kq; d < DM; d += 32) { const f32x4 wv = *(const f32x4*)(w + (size_t)d * MODW); a0 += wv * sl[d]; a1 += wv * sl[2048 + d]; a2 += wv * sl[4096 + d]; }
#pragma unroll
          for (int j = 0; j < 4; ++j) { red[(kq * 3 + 0) * 64 + 4 * cq + j] = a0[j]; red[(kq * 3 + 1) * 64 + 4 * cq + j] = a1[j]; red[(kq * 3 + 2) * 64 + 4 * cq + j] = a2[j]; }
          __syncthreads();
          if (C.tid < 192) { const int r = C.tid / 64, c = C.tid % 64; float s = 0.f; for (int q = 0; q < 32; ++q) s += red[(q * 3 + r) * 64 + c];
              MOD[((size_t)l * 3 + r) * MODW + e0 + c] = s + C.in[5][l * MODW + e0 + c]; }
          __syncthreads(); } }
}

__device__ __forceinline__ void phase_norm_mod(const Ctx& C, const float* w, const float* mod, int sh_idx, int sc_idx) {
    const float* XS = WSP(float, WS_XS); bf16_t* H = WSP(bf16_t, WS_H);
    for (int R = C.gw; R < MROWS; R += C.ngw) {
        const int s = R % SROW, b = R / SROW, cond = s < CTX ? 2 : b;
        const float* shift = mod + (size_t)cond * MODW + sh_idx * DM; const float* scale = mod + (size_t)cond * MODW + sc_idx * DM;
        const f32x4* xr = (const f32x4*)(XS + (size_t)R * DM) + C.lane;
        f32x4 v[8]; float ss = 0.f;
#pragma unroll
        for (int j = 0; j < 8; ++j) { v[j] = xr[64 * j]; ss += (v[j].x * v[j].x + v[j].y * v[j].y) + (v[j].z * v[j].z + v[j].w * v[j].w); }
        const float rstd = 1.0f / sqrtf(wave_sum(ss) * (1.0f / DM) + EPS);
        u32x2* o = (u32x2*)(H + (size_t)R * DM) + C.lane;
#pragma unroll
        for (int j = 0; j < 8; ++j) { const int c = (C.lane + 64 * j) * 4; const f32x4 wv = *(const f32x4*)(w + c), sc = *(const f32x4*)(scale + c), sh = *(const f32x4*)(shift + c);
            const f32x4 y = (v[j] * rstd * wv) * (1.0f + sc) + sh; u32x2 pk; pk.x = pk2(y.x, y.y); pk.y = pk2(y.z, y.w); o[64 * j] = pk; }
    }
}

__device__ __forceinline__ void phase_conv_etc(const Ctx& C, int e) {
    const bf16_t* P = WSP(bf16_t, WS_P); float* UC = WSP(float, WS_UC);
    const float* cw = C.in[10] + (size_t)e * 4 * DLRU; const float* cb = C.in[11] + (size_t)e * DLRU;
    for (int idx = C.gtid; idx < MROWS * DLRU; idx += C.ngt) { const int R = idx / DLRU, ch = idx % DLRU, s = R % SROW; const int lo = s < CTX ? 0 : CTX, hi = s < CTX ? CTX : SROW;
        float a = cb[ch];
#pragma unroll
        for (int j = 0; j < 4; ++j) { const int ss = s + j - 2; if (ss >= lo && ss < hi) a += bf2f(P[(size_t)(R + j - 2) * ABNP + DLRU + ch]) * cw[j * DLRU + ch]; }
        UC[idx] = a; }
    float* RSQ = WSP(float, WS_RSQ); float* RSKV = WSP(float, WS_RSKV);
    for (int R = C.gw; R < MROWS; R += C.ngw) {
        const u32x4 a = *(const u32x4*)(P + (size_t)R * ABNP + 2048 + 8 * C.lane), b = *(const u32x4*)(P + (size_t)R * ABNP + 2560 + 8 * C.lane);
        float sa = 0.f, sb = 0.f;
#pragma unroll
        for (int j = 0; j < 4; ++j) { const float a0 = __uint_as_float(a[j] << 16), a1 = __uint_as_float(a[j] & 0xffff0000u), b0 = __uint_as_float(b[j] << 16), b1 = __uint_as_float(b[j] & 0xffff0000u);
            sa += a0 * a0 + a1 * a1; sb += b0 * b0 + b1 * b1; }
        sa = wave_sum(sa); sb = wave_sum(sb);
        if (C.lane == 0) { RSQ[R] = 1.0f / sqrtf(sa * (1.0f / 512.0f) + EPS); RSKV[R] = 1.0f / sqrtf(sb * (1.0f / 512.0f) + EPS); } }
    bf16_t* KR = WSP(bf16_t, WS_KR); const float* RC = WSP(float, WS_ROPE); const float* RS = RC + 1024;
    for (int idx = C.gtid; idx < MROWS * 32; idx += C.ngt) { const int R = idx / 32, p = idx % 32, s = R % SROW; const int i0 = p < 16 ? p : 32 + (p - 16);
        const float x0 = bf2f(P[(size_t)R * ABNP + 3072 + i0]), x1 = bf2f(P[(size_t)R * ABNP + 3072 + i0 + 16]); float o0 = x0, o1 = x1;
        if (s >= CTX) { const int t = s - CTX, pos = p < 16 ? t / 64 : t % 64; const float c = RC[pos * 16 + (p & 15)], sn = RS[pos * 16 + (p & 15)]; o0 = x0 * c - x1 * sn; o1 = x1 * c + x0 * sn; }
        KR[(size_t)R * 64 + i0] = (bf16_t)f2bf(o0); KR[(size_t)R * 64 + i0 + 16] = (bf16_t)f2bf(o1); }
}
__device__ __forceinline__ void phase_gates_naive(const Ctx& C, int e) {
    const float* UC = WSP(float, WS_UC); float* LA = WSP(float, WS_LA); float* LBv = WSP(float, WS_LBB);
    const float* wa = C.in[12] + (size_t)e * 2 * 8 * 128 * 128; const float* wx = C.in[14] + (size_t)e * 2 * 8 * 128 * 128;
    const float* ba = C.in[13] + (size_t)e * 2 * DLRU; const float* bx = C.in[15] + (size_t)e * 2 * DLRU; const float* lam = C.in[16] + (size_t)e * 2 * DLRU;
    for (int idx = C.gtid; idx < MROWS * DLRU; idx += C.ngt) { const int R = idx / DLRU, ch = idx % DLRU, h = ch / 128, ee = ch % 128;
        const float* u = UC + (size_t)R * DLRU + h * 128;
        const float* wa0 = wa + ((size_t)(0 * 8 + h) * 128) * 128 + ee; const float* wa1 = wa + ((size_t)(1 * 8 + h) * 128) * 128 + ee;
        const float* wx0 = wx + ((size_t)(0 * 8 + h) * 128) * 128 + ee; const float* wx1 = wx + ((size_t)(1 * 8 + h) * 128) * 128 + ee;
        float a0 = 0.f, a1 = 0.f, x0 = 0.f, x1 = 0.f;
#pragma unroll 4
        for (int d = 0; d < 128; ++d) { const float uv = u[d]; a0 += uv * wa0[d * 128]; a1 += uv * wa1[d * 128]; x0 += uv * wx0[d * 128]; x1 += uv * wx1[d * 128]; }
        const float ucv = UC[idx];
        { const float r = sigmoidf_(a0 + ba[ch]), ig = sigmoidf_(x0 + bx[ch]); const float la = -8.0f * r * log1pf(expf(-lam[ch])); LA[idx] = expf(la); LBv[idx] = sqrtf(-expm1f(2.0f * la)) * (ig * ucv); }
        { const float r = sigmoidf_(a1 + ba[DLRU + ch]), ig = sigmoidf_(x1 + bx[DLRU + ch]); const float la = -8.0f * r * log1pf(expf(-lam[DLRU + ch]));
          LA[(size_t)MROWS * DLRU + idx] = expf(la); LBv[(size_t)MROWS * DLRU + idx] = sqrtf(-expm1f(2.0f * la)) * (ig * ucv); } }
}
__device__ __forceinline__ void phase_scan_naive(const Ctx& C) {
    const float* LA = WSP(float, WS_LA); const float* LBv = WSP(float, WS_LBB); float* HS = WSP(float, WS_HS);
    if (C.tid < 64) for (int id = blockIdx.x * 64 + C.tid; id < NBATCH * DLRU; id += gridDim.x * 64) { const int b = id / DLRU, ch = id % DLRU;
        float h = 0.f;
#pragma unroll 8
        for (int s = 0; s < SROW; ++s) { const size_t i = (size_t)(b * SROW + s) * DLRU + ch; h = LA[i] * h + LBv[i]; HS[i] = h; }
        h = 0.f; const size_t d1 = (size_t)MROWS * DLRU;
#pragma unroll 8
        for (int s = CTX - 1; s >= 0; --s) { const size_t i = (size_t)(b * SROW + s) * DLRU + ch; h = LA[d1 + i] * h + LBv[d1 + i]; HS[i] += h; }
#pragma unroll 8
        for (int s = SROW - 1; s >= CTX; --s) { const size_t i = (size_t)(b * SROW + s) * DLRU + ch; h = LA[d1 + i] * h + LBv[d1 + i]; HS[i] += h; } }
}
__device__ __forceinline__ void phase_attn_naive(const Ctx& C) {
    const bf16_t* P = WSP(bf16_t, WS_P); const float* HS = WSP(float, WS_HS); bf16_t* Y = WSP(bf16_t, WS_Y);
    for (int idx = C.gtid; idx < MROWS * DLRU; idx += C.ngt) { const int R = idx / DLRU, ch = idx % DLRU; Y[(size_t)R * DM + ch] = (bf16_t)f2bf(HS[idx] * gelu_tanh(bf2f(P[(size_t)R * ABNP + ch]))); }
    const bf16_t* Q = WSP(bf16_t, WS_Q); const bf16_t* KV = WSP(bf16_t, WS_KV); const bf16_t* KR = WSP(bf16_t, WS_KR);
    LAS float* qs = (LAS float*)(C.lds + C.wave * 4096); LAS float* ps = qs + 768;
    for (int u = C.gw; u < (MROWS / 4) * 8; u += C.ngw) { const int hh = u % 8, R0 = (u / 8) * 4, b = R0 / SROW, s0 = R0 % SROW, nk = s0 < CTX ? CTX : SROW, kb = b * SROW;
        __builtin_amdgcn_wave_barrier();
        for (int i = C.lane; i < 768; i += 64) { const int qi = i / 192, d = i % 192; qs[i] = bf2f(Q[(size_t)(R0 + qi) * QW + hh * 192 + d]) * ATTN_SCALE; }
        __builtin_amdgcn_wave_barrier();
        float m[4], l[4], o0[4], o1[4];
#pragma unroll
        for (int qi = 0; qi < 4; ++qi) { m[qi] = -1e30f; l[qi] = 0.f; o0[qi] = 0.f; o1[qi] = 0.f; }
        for (int k0 = 0; k0 < nk; k0 += 64) { const size_t kr = (size_t)(kb + k0 + C.lane);
            float sc[4] = {0.f, 0.f, 0.f, 0.f};
            for (int d8 = 0; d8 < 24; ++d8) { const u32x4 kk = d8 < 16 ? *(const u32x4*)(KV + kr * KVW + hh * 256 + d8 * 8) : *(const u32x4*)(KR + kr * 64 + (d8 - 16) * 8);
                float kf[8];
#pragma unroll
                for (int j = 0; j < 4; ++j) { kf[2 * j] = __uint_as_float(kk[j] << 16); kf[2 * j + 1] = __uint_as_float(kk[j] & 0xffff0000u); }
#pragma unroll
                for (int qi = 0; qi < 4; ++qi) { const f32x4 qa = *(const LAS f32x4*)(qs + qi * 192 + d8 * 8), qb = *(const LAS f32x4*)(qs + qi * 192 + d8 * 8 + 4);
                    sc[qi] += kf[0] * qa[0] + kf[1] * qa[1] + kf[2] * qa[2] + kf[3] * qa[3] + kf[4] * qb[0] + kf[5] * qb[1] + kf[6] * qb[2] + kf[7] * qb[3]; } }
            __builtin_amdgcn_wave_barrier();
#pragma unroll
            for (int qi = 0; qi < 4; ++qi) { const float mx = wave_max(sc[qi]); const float mn = fmaxf(m[qi], mx); const float alpha = expf(m[qi] - mn); const float p = expf(sc[qi] - mn);
                ps[qi * 64 + C.lane] = p; l[qi] = l[qi] * alpha + wave_sum(p); o0[qi] *= alpha; o1[qi] *= alpha; m[qi] = mn; }
            __builtin_amdgcn_wave_barrier();
            for (int kk = 0; kk < 64; ++kk) { const bf16_t* vr = KV + (size_t)(kb + k0 + kk) * KVW + hh * 256 + 128; const float v0 = bf2f(vr[C.lane]), v1 = bf2f(vr[64 + C.lane]);
#pragma unroll
                for (int qi = 0; qi < 4; ++qi) { const float pp = ps[qi * 64 + kk]; o0[qi] += pp * v0; o1[qi] += pp * v1; } }
        }
#pragma unroll
        for (int qi = 0; qi < 4; ++qi) { bf16_t* yo = Y + (size_t)(R0 + qi) * DM + DLRU + hh * 128; const float il = 1.0f / l[qi]; yo[C.lane] = (bf16_t)f2bf(o0[qi] * il); yo[64 + C.lane] = (bf16_t)f2bf(o1[qi] * il); }
    }
}

__device__ __forceinline__ void phase_attn(const Ctx& C) {
    const bf16_t* Q = WSP(bf16_t, WS_Q); const bf16_t* KV = WSP(bf16_t, WS_KV); const bf16_t* KR = WSP(bf16_t, WS_KR); bf16_t* Y = WSP(bf16_t, WS_Y);
    const float* RC = WSP(float, WS_ROPE); const float* RS = RC + 1024;
    const int G = gridDim.x, c = blockIdx.x;
    for (int u0 = c; u0 < 272; u0 += G) {
        int b, hh, s0, nk, tq0;
        if (u0 < 256) { int v = u0; if (G == 256) { const int x = c & 7, j = c >> 3; v = (x * 2 + (j >> 4)) * 16 + (j & 15); }
            const int p = v >> 4, qb = v & 15; b = p >> 3; hh = p & 7; s0 = CTX + qb * 256; nk = SROW; tq0 = qb * 256; }
        else { const int p = u0 - 256; b = p >> 3; hh = p & 7; s0 = 0; nk = CTX; tq0 = -1; }
        const size_t R0 = (size_t)b * SROW + s0, K0 = (size_t)b * SROW;
        __syncthreads();
        att::attn_body(Q + R0 * QW + hh * 192, KV + K0 * KVW + hh * 256, KR + K0 * 64, Y + R0 * DM + DLRU + hh * 128, nk, tq0, RC, RS, (char*)C.lds, C.tid);
    }
}
__device__ __forceinline__ void phase_ya(const Ctx& C) {
    const bf16_t* P = WSP(bf16_t, WS_P); const float* HS = WSP(float, WS_HS); bf16_t* Y = WSP(bf16_t, WS_Y);
    for (int idx = C.gtid; idx < MROWS * DLRU; idx += C.ngt) { const int R = idx / DLRU, ch = idx % DLRU; Y[(size_t)R * DM + ch] = (bf16_t)f2bf(HS[idx] * gelu_tanh(bf2f(P[(size_t)R * ABNP + ch]))); }
}
namespace hg {
using s16x4  = __attribute__((ext_vector_type(4))) short;
using f32x16 = __attribute__((ext_vector_type(16))) float;
constexpr int NCH = SROW / 64;
constexpr int NCHAIN = NBATCH * 16 * 2;
__device__ __forceinline__ unsigned off_b(unsigned row, unsigned ch) { return 256u * row + 16u * (ch ^ (((row & 3u) << 2) | ((row >> 2) & 3u))); }
__device__ __forceinline__ s16x4 trr(unsigned addr) { s16x4 r; asm volatile("ds_read_b64_tr_b16 %0, %1" : "=&v"(r) : "v"(addr) : "memory"); return r; }
__device__ __forceinline__ bf16x8 pk8(s16x4 L, s16x4 H) { return (bf16x8){L[0], L[1], L[2], L[3], H[0], H[1], H[2], H[3]}; }
__device__ __forceinline__ unsigned tr_nat(unsigned lane, unsigned c, unsigned ks, unsigned t) {
    const unsigned h = lane >> 5, blk = (lane >> 4) & 1, q = (lane & 15) >> 2, p = lane & 3;
    return off_b(16 * ks + 8 * h + 4 * t + q, 4 * c + 2 * blk + (p >> 1)) + 8 * (p & 1); }
__device__ __forceinline__ unsigned tr_perm(unsigned lane, unsigned c, unsigned rb, unsigned t) {
    const unsigned h = lane >> 5, blk = (lane >> 4) & 1, q = (lane & 15) >> 2, p = lane & 3;
    return off_b(rb + 4 * h + 8 * t + q, 4 * c + 2 * blk + (p >> 1)) + 8 * (p & 1); }
__device__ __forceinline__ unsigned row_rd(unsigned lane, unsigned rb, unsigned ks) { return off_b(rb + (lane & 31), 2 * ks + (lane >> 5)); }
__device__ __forceinline__ int crow(int r, int hi) { return (r & 3) + 8 * (r >> 2) + 4 * hi; }
#define HG_WAITL() do { asm volatile("s_waitcnt lgkmcnt(0)" ::: "memory"); __builtin_amdgcn_sched_barrier(0); } while (0)
}

__device__ __forceinline__ void phase_hg_ds(const Ctx& C) {
    using namespace hg;
    LAS unsigned char* L = C.lds; const unsigned Lb = (unsigned)(uintptr_t)L;
    constexpr unsigned VT = 0, KP = 16384, TOT = 32768;
    const float* LOGF = WSP(float, WS_LOGF); const bf16_t* VH = WSP(bf16_t, WS_VH); float* DS = WSP(float, WS_DS); float* DEC = WSP(float, WS_DEC);
    const int w = C.wave, lane = C.lane, tid = C.tid, h5 = lane >> 5, r32 = lane & 31;
    for (int u = blockIdx.x; u < NBATCH * 16 * NCH; u += gridDim.x) {
        const int b = u / (16 * NCH), hh = (u / NCH) % 16, ci = u % NCH; const size_t R0 = (size_t)b * SROW + ci * 64;
        __syncthreads();
#pragma unroll
        for (int p = 0; p < 2; ++p) { const int row = (tid >> 4) + 32 * p, ch = tid & 15; const u32x4 v = *(const u32x4*)(VH + (R0 + row) * DM + hh * 128 + ch * 8); *(LAS u32x4*)(L + VT + off_b(row, ch)) = v; }
#pragma unroll 1
        for (int dir = 0; dir < 2; ++dir) {
            const int chain = (b * 16 + hh) * 2 + dir;
            const float* lfp = LOGF + (size_t)dir * MROWS * DM + (R0 + 8 * w) * DM + hh * 128 + 2 * lane;
            f32x2 lf[8]; f32x2 T = {0.f, 0.f};
#pragma unroll
            for (int i = 0; i < 8; ++i) { lf[i] = *(const f32x2*)(lfp + (size_t)i * DM); T += lf[i]; }
            *(LAS f32x2*)(L + TOT + (w * 128 + 2 * lane) * 4) = T;
            __syncthreads();
            f32x2 off = {0.f, 0.f}, total = {0.f, 0.f};
#pragma unroll
            for (int ww = 0; ww < 8; ++ww) { const f32x2 t = *(const LAS f32x2*)(L + TOT + (ww * 128 + 2 * lane) * 4); total += t; if (dir == 0 ? (ww > w) : (ww < w)) off += t; }
            f32x2 E[8];
            if (dir == 0) { E[7] = off;
#pragma unroll
                for (int i = 6; i >= 0; --i) E[i] = E[i + 1] + lf[i + 1]; }
            else { E[0] = off;
#pragma unroll
                for (int i = 1; i < 8; ++i) E[i] = E[i - 1] + lf[i - 1]; }
#pragma unroll
            for (int i = 0; i < 8; ++i) { const float k0 = (1.0f - __expf(lf[i].x)) * __expf(E[i].x), k1 = (1.0f - __expf(lf[i].y)) * __expf(E[i].y);
                *(LAS unsigned*)(L + KP + off_b(8 * w + i, lane >> 2) + (lane & 3) * 4) = pk2(k0, k1); }
            if (w == 0) { f32x2 d; d.x = __expf(total.x); d.y = __expf(total.y); *(f32x2*)(DEC + ((size_t)chain * NCH + ci) * 128 + 2 * lane) = d; }
            __syncthreads();
            const unsigned dkt = w >> 1, c0 = (w & 1) * 2;
            s16x4 al[4], ah[4], b0l[4], b0h[4], b1l[4], b1h[4];
#pragma unroll
            for (int ks = 0; ks < 4; ++ks) { al[ks] = trr(Lb + KP + tr_nat(lane, dkt, ks, 0)); ah[ks] = trr(Lb + KP + tr_nat(lane, dkt, ks, 1));
                b0l[ks] = trr(Lb + VT + tr_nat(lane, c0, ks, 0)); b0h[ks] = trr(Lb + VT + tr_nat(lane, c0, ks, 1));
                b1l[ks] = trr(Lb + VT + tr_nat(lane, c0 + 1, ks, 0)); b1h[ks] = trr(Lb + VT + tr_nat(lane, c0 + 1, ks, 1)); }
            HG_WAITL();
            f32x16 a0 = {}, a1 = {};
#pragma unroll
            for (int ks = 0; ks < 4; ++ks) { const bf16x8 A = pk8(al[ks], ah[ks]);
                a0 = __builtin_amdgcn_mfma_f32_32x32x16_bf16(A, pk8(b0l[ks], b0h[ks]), a0, 0, 0, 0);
                a1 = __builtin_amdgcn_mfma_f32_32x32x16_bf16(A, pk8(b1l[ks], b1h[ks]), a1, 0, 0, 0); }
            float* dsp = DS + ((size_t)chain * NCH + ci) * 16384;
#pragma unroll
            for (int r = 0; r < 16; ++r) { const int dk = 32 * dkt + crow(r, h5); dsp[dk * 128 + 32 * c0 + r32] = a0[r]; dsp[dk * 128 + 32 * (c0 + 1) + r32] = a1[r]; }
        }
    }
}
__device__ __forceinline__ void phase_hg_scan(const Ctx& C) {
    using namespace hg;
    const float* DS = WSP(float, WS_DS); const float* DEC = WSP(float, WS_DEC); bf16_t* SS = WSP(bf16_t, WS_SS);
    for (int g = C.gtid; g < NCHAIN * 2048; g += C.ngt) { const int chain = g >> 11, within = g & 2047, dk = within >> 4, dv0 = (within & 15) * 8, dir = chain & 1;
        f32x4 s0 = {0.f, 0.f, 0.f, 0.f}, s1 = {0.f, 0.f, 0.f, 0.f};
#pragma unroll 4
        for (int j = 0; j < NCH; ++j) { const int ci = dir == 0 ? j : (j < 4 ? 3 - j : 71 - j); const size_t cb = (size_t)chain * NCH + ci; const size_t idx = (cb * 128 + dk) * 128 + dv0;
            u32x4 o; o.x = pk2(s0.x, s0.y); o.y = pk2(s0.z, s0.w); o.z = pk2(s1.x, s1.y); o.w = pk2(s1.z, s1.w); *(u32x4*)(SS + idx) = o;
            const float d = DEC[cb * 128 + dk]; const f32x4 d0 = *(const f32x4*)(DS + idx), d1 = *(const f32x4*)(DS + idx + 4);
            s0 = s0 * d + d0; s1 = s1 * d + d1; } }
}
__device__ __forceinline__ void phase_hg_out(const Ctx& C, int o_idx) {
    using namespace hg;
    LAS unsigned char* L = C.lds; const unsigned Lb = (unsigned)(uintptr_t)L;
    constexpr unsigned VT = 0, QP = 16384, QM = 32768, KM = 49152, ST = 65536, TOT = 98304, RED = 102400;
    const float* LOGF = WSP(float, WS_LOGF); const bf16_t* VH = WSP(bf16_t, WS_VH); const bf16_t* QH = WSP(bf16_t, WS_QH); const bf16_t* GH = WSP(bf16_t, WS_GH);
    const bf16_t* SS = WSP(bf16_t, WS_SS); bf16_t* Y = WSP(bf16_t, WS_Y); const float* nw = C.in[23] + o_idx * 128;
    const int w = C.wave, lane = C.lane, tid = C.tid, h5 = lane >> 5, r32 = lane & 31;
    const unsigned tt = w >> 2, dvt = w & 3;
    for (int u = blockIdx.x; u < NBATCH * 16 * NCH; u += gridDim.x) {
        const int b = u / (16 * NCH), hh = (u / NCH) % 16, ci = u % NCH; const size_t R0 = (size_t)b * SROW + ci * 64;
        __syncthreads();
#pragma unroll
        for (int p = 0; p < 2; ++p) { const int row = (tid >> 4) + 32 * p, ch = tid & 15; const u32x4 v = *(const u32x4*)(VH + (R0 + row) * DM + hh * 128 + ch * 8); *(LAS u32x4*)(L + VT + off_b(row, ch)) = v; }
        f32x16 acc = {};
#pragma unroll 1
        for (int dir = 0; dir < 2; ++dir) {
            const int chain = (b * 16 + hh) * 2 + dir;
            u32x4 sreg[4];
#pragma unroll
            for (int p = 0; p < 4; ++p) sreg[p] = *(const u32x4*)(SS + (((size_t)chain * NCH + ci) * 128 + (tid >> 4) + 32 * p) * 128 + (tid & 15) * 8);
            const float* lfp = LOGF + (size_t)dir * MROWS * DM + (R0 + 8 * w) * DM + hh * 128 + 2 * lane;
            const bf16_t* qp = QH + (R0 + 8 * w) * DM + hh * 128 + 2 * lane;
            f32x2 lf[8]; unsigned qv[8]; f32x2 T = {0.f, 0.f};
#pragma unroll
            for (int i = 0; i < 8; ++i) { lf[i] = *(const f32x2*)(lfp + (size_t)i * DM); qv[i] = *(const unsigned*)(qp + (size_t)i * DM); T += lf[i]; }
            *(LAS f32x2*)(L + TOT + (w * 128 + 2 * lane) * 4) = T;
            __syncthreads();
            f32x2 off = {0.f, 0.f}, mid = {0.f, 0.f};
#pragma unroll
            for (int ww = 0; ww < 8; ++ww) { const f32x2 t = *(const LAS f32x2*)(L + TOT + (ww * 128 + 2 * lane) * 4);
                if (dir == 0 ? (ww < w) : (ww > w)) off += t; if (dir == 0 ? (ww < 4) : (ww >= 4)) mid += t; }
            f32x2 B[8];
            if (dir == 0) { B[0] = off + lf[0];
#pragma unroll
                for (int i = 1; i < 8; ++i) B[i] = B[i - 1] + lf[i]; }
            else { B[7] = off + lf[7];
#pragma unroll
                for (int i = 6; i >= 0; --i) B[i] = B[i + 1] + lf[i]; }
#pragma unroll
            for (int i = 0; i < 8; ++i) { const float q0 = __uint_as_float(qv[i] << 16), q1 = __uint_as_float(qv[i] & 0xffff0000u);
                const float k0 = 1.0f - __expf(lf[i].x), k1 = 1.0f - __expf(lf[i].y);
                const unsigned a = off_b(8 * w + i, lane >> 2) + (lane & 3) * 4;
                *(LAS unsigned*)(L + QP + a) = pk2(q0 * __expf(B[i].x), q1 * __expf(B[i].y));
                *(LAS unsigned*)(L + QM + a) = pk2(q0 * __expf(B[i].x - mid.x), q1 * __expf(B[i].y - mid.y));
                *(LAS unsigned*)(L + KM + a) = pk2(k0 * __expf(mid.x - B[i].x), k1 * __expf(mid.y - B[i].y)); }
#pragma unroll
            for (int p = 0; p < 4; ++p) *(LAS u32x4*)(L + ST + off_b((tid >> 4) + 32 * p, tid & 15)) = sreg[p];
            __syncthreads();
            { bf16x8 a[8]; s16x4 bl[8], bh[8];
#pragma unroll
              for (int ks = 0; ks < 8; ++ks) { a[ks] = *(const LAS bf16x8*)(L + QP + row_rd(lane, 32 * tt, ks)); bl[ks] = trr(Lb + ST + tr_nat(lane, dvt, ks, 0)); bh[ks] = trr(Lb + ST + tr_nat(lane, dvt, ks, 1)); }
              HG_WAITL();
#pragma unroll
              for (int ks = 0; ks < 8; ++ks) acc = __builtin_amdgcn_mfma_f32_32x32x16_bf16(a[ks], pk8(bl[ks], bh[ks]), acc, 0, 0, 0); }
            { bf16x8 qb[8];
#pragma unroll
              for (int ks = 0; ks < 8; ++ks) qb[ks] = *(const LAS bf16x8*)(L + QM + row_rd(lane, 32 * tt, ks));
#pragma unroll
              for (unsigned st = 0; st < 2; ++st) { const bool valid = dir == 0 ? (st <= tt) : (st >= tt);
                if (valid) {
                  f32x16 x = {};
#pragma unroll
                  for (int ks = 0; ks < 8; ++ks) { const bf16x8 ka = *(const LAS bf16x8*)(L + KM + row_rd(lane, 32 * st, ks)); x = __builtin_amdgcn_mfma_f32_32x32x16_bf16(ka, qb[ks], x, 0, 0, 0); }
                  if (st == tt) {
#pragma unroll
                    for (int r = 0; r < 16; ++r) { const int kr = crow(r, h5); const bool keep = dir == 0 ? (kr <= r32) : (kr >= r32); x[r] = keep ? x[r] : 0.f; } }
                  const s16x4 v0l = trr(Lb + VT + tr_perm(lane, dvt, 32 * st, 0)), v0h = trr(Lb + VT + tr_perm(lane, dvt, 32 * st, 1));
                  const s16x4 v1l = trr(Lb + VT + tr_perm(lane, dvt, 32 * st + 16, 0)), v1h = trr(Lb + VT + tr_perm(lane, dvt, 32 * st + 16, 1));
                  u32x4 A0, A1; A0.x = pk2(x[0], x[1]); A0.y = pk2(x[2], x[3]); A0.z = pk2(x[4], x[5]); A0.w = pk2(x[6], x[7]);
                  A1.x = pk2(x[8], x[9]); A1.y = pk2(x[10], x[11]); A1.z = pk2(x[12], x[13]); A1.w = pk2(x[14], x[15]);
                  HG_WAITL();
                  acc = __builtin_amdgcn_mfma_f32_32x32x16_bf16(*reinterpret_cast<bf16x8*>(&A0), pk8(v0l, v0h), acc, 0, 0, 0);
                  acc = __builtin_amdgcn_mfma_f32_32x32x16_bf16(*reinterpret_cast<bf16x8*>(&A1), pk8(v1l, v1h), acc, 0, 0, 0);
                } } }
        }
        LAS float* red = (LAS float*)(L + RED);
#pragma unroll
        for (int r = 0; r < 16; ++r) { float s = acc[r] * acc[r]; s += __shfl_xor(s, 1); s += __shfl_xor(s, 2); s += __shfl_xor(s, 4); s += __shfl_xor(s, 8); s += __shfl_xor(s, 16);
            if (r32 == 0) red[(tt * 32 + crow(r, h5)) * 4 + dvt] = s; }
        __syncthreads();
        const int col = hh * 128 + 32 * dvt + r32; const float wv = nw[32 * dvt + r32];
#pragma unroll
        for (int r = 0; r < 16; ++r) { const int row = 32 * tt + crow(r, h5); const f32x4 p = *(const LAS f32x4*)(red + row * 4);
            const float rstd = 1.0f / sqrtf(((p.x + p.y) + (p.z + p.w)) * (1.0f / 128.0f) + EPS); const size_t o = (R0 + row) * DM + col;
            Y[o] = (bf16_t)f2bf(acc[r] * rstd * wv * bf2f(GH[o])); }
    }
}
__device__ __forceinline__ void phase_final(const Ctx& C) {
    const float* XS = WSP(float, WS_XS); const float* w = C.in[27];
    for (int r = C.gw; r < NBATCH * SEQ; r += C.ngw) { const int b = r / SEQ, t = r % SEQ; const size_t R = (size_t)b * SROW + CTX + t;
        const f32x4* xr = (const f32x4*)(XS + R * DM) + C.lane; f32x4 v[8]; float ss = 0.f;
#pragma unroll
        for (int j = 0; j < 8; ++j) { v[j] = xr[64 * j]; ss += (v[j].x * v[j].x + v[j].y * v[j].y) + (v[j].z * v[j].z + v[j].w * v[j].w); }
        const float rstd = 1.0f / sqrtf(wave_sum(ss) * (1.0f / DM) + EPS);
        f32x4* o = (f32x4*)(C.out + (size_t)r * DM) + C.lane;
#pragma unroll
        for (int j = 0; j < 8; ++j) { const f32x4 wv = *(const f32x4*)(w + (C.lane + 64 * j) * 4); o[64 * j] = v[j] * rstd * wv; } }
}

struct Args { const float* in[28]; float* out; unsigned char* ws; int ph_lo, ph_hi; };
constexpr int N_PHASES = 1 + 2 * 12 + 2 * 9 + 1;

__global__ void __launch_bounds__(512, 2) fwd_kernel(Args args) {
    extern __shared__ __attribute__((aligned(16))) unsigned char lds_raw[];
    LAS unsigned char* const lds0 = (LAS unsigned char*)lds_raw;
    const unsigned long long inaddr = (unsigned long long)__builtin_amdgcn_kernarg_segment_ptr();
    volatile LAS unsigned* misc = (volatile LAS unsigned*)(lds0 + LDS_MISC);
    if (threadIdx.x < 64) misc[threadIdx.x] = 0u;
    __syncthreads();
    const int lo = args.ph_lo, hi = args.ph_hi;
    XcdBarrier bar; bar.bar = (unsigned*)(args.ws + WS_CTL) + 4096; bar.x = 0; bar.st = misc + 8;
    if (hi - lo > 1) bar = xcd_barrier_post((unsigned*)(args.ws + WS_CTL) + 4096, misc + 8);
    int pid = 0;
    const unsigned long long wsaddr = (unsigned long long)args.ws;
#define PH_BEGIN if (pid >= lo && pid < hi) { int l = l_; Ctx C; { unsigned long long a_ = inaddr, w_ = wsaddr; int t_ = threadIdx.x; asm volatile("" : "+s"(a_), "+s"(w_), "+s"(l), "+v"(t_)); \
        C.in = (InPtr)a_; C.ws = (unsigned char*)w_; C.out = args.out; C.lds = lds0; C.tid = t_; C.lane = t_ & 63; C.wave = __builtin_amdgcn_readfirstlane(t_ >> 6); \
        C.gw = blockIdx.x * 8 + C.wave; C.ngw = gridDim.x * 8; C.gtid = blockIdx.x * 512 + t_; C.ngt = gridDim.x * 512; } \
        const int e = l >> 1; const float* mod = WSP(float, WS_MOD) + (size_t)l * 3 * MODW; const int G = gridDim.x, cb = blockIdx.x; (void)e; (void)mod; (void)G; (void)cb;
#define PH_END } if (pid >= lo && pid + 1 < hi) xcd_barrier(bar); ++pid;
    int l_ = 0;
    PH_BEGIN
#ifndef SKIP_PRO
    phase_prologue(C);
#endif
    PH_END

    for (l_ = 0; l_ < DEPTH; ++l_) {
        PH_BEGIN phase_norm_mod(C, C.in[6] + l * DM, mod, 0, 1); PH_END
        if ((l_ & 1) == 0) {
            PH_BEGIN { pg8::Gemm g{WSP(bf16_t, WS_H), WSP(bf16_t, WS_WABIN) + (size_t)e * ABNP * DM, MROWS, ABNP, DM, DM, DM}; pg8::StaticOrder S; S.init(MROWS, ABNP, G, cb);
                       EpiBf16Plain E{WSP(bf16_t, WS_P), ABNP}; pg8::gemm_phase(C.lds, C.tid, g, S, E); } PH_END
            PH_BEGIN phase_conv_etc(C, e); PH_END
            PH_BEGIN phase_gates_naive(C, e); PH_END
            PH_BEGIN { pg8::Gemm g{WSP(bf16_t, WS_P) + 2048, WSP(bf16_t, WS_WUQ) + (size_t)e * QW * 512, MROWS, QW, 512, ABNP, 512}; pg8::StaticOrder S; S.init(MROWS, QW, G, cb);
                       EpiBf16RowScale E{WSP(bf16_t, WS_Q), QW, WSP(float, WS_RSQ)}; pg8::gemm_phase(C.lds, C.tid, g, S, E); } PH_END
            PH_BEGIN { pg8::Gemm g{WSP(bf16_t, WS_P) + 2560, WSP(bf16_t, WS_WUKV) + (size_t)e * KVW * 512, MROWS, KVW, 512, ABNP, 512}; pg8::StaticOrder S; S.init(MROWS, KVW, G, cb);
                       EpiBf16RowScale E{WSP(bf16_t, WS_KV), KVW, WSP(float, WS_RSKV)}; pg8::gemm_phase(C.lds, C.tid, g, S, E); } PH_END
            PH_BEGIN phase_scan_naive(C); PH_END
            PH_BEGIN
            phase_ya(C); phase_attn(C);
            PH_END
        } else {
            PH_BEGIN { pg8::Gemm g{WSP(bf16_t, WS_H), WSP(bf16_t, WS_WHGIN) + (size_t)e * HGN * DM, MROWS, HGN, DM, DM, DM}; pg8::StaticOrder S; S.init(MROWS, HGN, G, cb);
                       EpiHG E{WSP(bf16_t, WS_QH), WSP(float, WS_LOGF), WSP(float, WS_LB) + l * 2048}; pg8::gemm_phase(C.lds, C.tid, g, S, E); } PH_END
            PH_BEGIN phase_hg_ds(C); PH_END
            PH_BEGIN phase_hg_scan(C); PH_END
            PH_BEGIN phase_hg_out(C, e); PH_END
        }
        PH_BEGIN { const bf16_t* wout = (l & 1) ? WSP(bf16_t, WS_WHGOUT) + (size_t)e * DM * DM : WSP(bf16_t, WS_WABOUT) + (size_t)e * DM * DM;
                   pg8::Gemm g{WSP(bf16_t, WS_Y), wout, MROWS, DM, DM, DM, DM}; pg8::StaticOrder S; S.init(MROWS, DM, G, cb);
                   EpiResid E{WSP(float, WS_XS), mod + 2 * DM}; pg8::gemm_phase(C.lds, C.tid, g, S, E); } PH_END
        PH_BEGIN phase_norm_mod(C, C.in[7] + l * DM, mod, 3, 4); PH_END
        PH_BEGIN { pg8::Gemm g{WSP(bf16_t, WS_H), WSP(bf16_t, WS_W1) + (size_t)l * DFF * DM, MROWS, DFF, DM, DM, DM}; pg8::StaticOrder S; S.init(MROWS, DFF, G, cb);
                   EpiRelu2 E{WSP(bf16_t, WS_HID), DFF}; pg8::gemm_phase(C.lds, C.tid, g, S, E); } PH_END
        PH_BEGIN { pg8::Gemm g{WSP(bf16_t, WS_HID), WSP(bf16_t, WS_W2) + (size_t)l * DM * DFF, MROWS, DM, DFF, DFF, DFF}; pg8::StaticOrder S; S.init(MROWS, DM, G, cb);
                   EpiResid E{WSP(float, WS_XS), mod + 5 * DM}; pg8::gemm_phase(C.lds, C.tid, g, S, E); } PH_END
    }
    l_ = 0;
    PH_BEGIN phase_final(C); PH_END
}

#ifndef N_LAUNCH_MODE
#define N_LAUNCH_MODE 1
#endif
extern "C" void kernel_launch(void* const* d_in, const int* in_sizes, int n_in, void* d_out, int out_size, void* d_ws, size_t ws_size, hipStream_t stream) {
    static int grid = 0;
    if (grid == 0) {
        if (n_in != 28 || out_size != NBATCH * SEQ * DM || ws_size < WS_END) { fprintf(stderr, "kernel_launch: shape mismatch n_in %d out %d ws %zu (need %zu)\n", n_in, out_size, ws_size, (size_t)WS_END); grid = -1; return; }
        int dev = 0, cus = 0, per_cu = 0;
        if (hipGetDevice(&dev) != hipSuccess || hipDeviceGetAttribute(&cus, hipDeviceAttributeMultiprocessorCount, dev) != hipSuccess) { grid = -1; return; }
        if (hipFuncSetAttribute((const void*)fwd_kernel, hipFuncAttributeMaxDynamicSharedMemorySize, LDS_BYTES) != hipSuccess) { fprintf(stderr, "kernel_launch: hipFuncSetAttribute failed\n"); grid = -1; return; }
        if (hipOccupancyMaxActiveBlocksPerMultiprocessor(&per_cu, (const void*)fwd_kernel, 512, LDS_BYTES) != hipSuccess || per_cu < 1) fprintf(stderr, "kernel_launch: occupancy query says %d\n", per_cu);
        (void)hipGetLastError();
        grid = cus;
    }
    if (grid < 0) return;
    (void)hipMemsetAsync((char*)d_ws + WS_CTL, 0, CTL_BYTES, stream);
    Args a{};
    for (int i = 0; i < 28; ++i) a.in[i] = (const float*)d_in[i];
    a.out = (float*)d_out; a.ws = (unsigned char*)d_ws;
#if N_LAUNCH_MODE == 1
    a.ph_lo = 0; a.ph_hi = N_PHASES;
    hipLaunchKernelGGL(fwd_kernel, dim3(grid), dim3(512), LDS_BYTES, stream, a);
#else
    for (int p = 0; p < N_PHASES; ++p) { a.ph_lo = p; a.ph_hi = p + 1; hipLaunchKernelGGL(fwd_kernel, dim3(grid), dim3(512), LDS_BYTES, stream, a); }
#endif
    const hipError_t le = hipPeekAtLastError();
    if (le != hipSuccess) fprintf(stderr, "kernel_launch: launch failed: %s\n", hipGetErrorName(le));
}
```

```cpp
#include <hip/hip_runtime.h>
#include <cstdio>

#define LAS __attribute__((address_space(3)))
typedef unsigned short bf16_t;
typedef short bf16x8 __attribute__((ext_vector_type(8)));
typedef float f32x4 __attribute__((ext_vector_type(4)));
typedef float f32x2 __attribute__((ext_vector_type(2)));
typedef unsigned u32x4 __attribute__((ext_vector_type(4)));
typedef unsigned u32x2 __attribute__((ext_vector_type(2)));

constexpr int DM = 2048, NBATCH = 2, SEQ = 4096, DEPTH = 4, CTX = 256;
constexpr int SROW = CTX + SEQ;
constexpr int MROWS = NBATCH * SROW;
constexpr int DFF = 8192, MODW = 6 * DM;
constexpr int DLRU = 1024;
constexpr int ABN = 3136, ABNP = 3328;
constexpr int QW = 1536, KVW = 2048, HGN = 10240;
constexpr float EPS = 1e-6f;
constexpr float ATTN_SCALE = 0.07216878364870322f;

constexpr size_t al256(size_t x) { return (x + 255) & ~(size_t)255; }
constexpr size_t WS_CTL = 0, CTL_BYTES = 1u << 20;
constexpr size_t WS_MOD = WS_CTL + CTL_BYTES;
constexpr size_t WS_LB = WS_MOD + al256((size_t)DEPTH * 3 * MODW * 4);
constexpr size_t WS_ROPE = WS_LB + al256((size_t)DEPTH * 2048 * 4);
constexpr size_t WS_RSQ = WS_ROPE + al256(2 * 64 * 16 * 4);
constexpr size_t WS_RSKV = WS_RSQ + al256((size_t)MROWS * 4);
constexpr size_t WS_WABIN = WS_RSKV + al256((size_t)MROWS * 4);
constexpr size_t WS_WABOUT = WS_WABIN + (size_t)2 * ABNP * DM * 2;
constexpr size_t WS_WUQ = WS_WABOUT + (size_t)2 * DM * DM * 2;
constexpr size_t WS_WUKV = WS_WUQ + (size_t)2 * QW * 512 * 2;
constexpr size_t WS_WHGIN = WS_WUKV + (size_t)2 * KVW * 512 * 2;
constexpr size_t WS_WHGOUT = WS_WHGIN + (size_t)2 * HGN * DM * 2;
constexpr size_t WS_W1 = WS_WHGOUT + (size_t)2 * DM * DM * 2;
constexpr size_t WS_W2 = WS_W1 + (size_t)4 * DFF * DM * 2;
constexpr size_t WS_WG = WS_W2 + (size_t)4 * DFF * DM * 2;
constexpr size_t WS_XS = WS_WG + (size_t)2 * 4 * 128 * 1024 * 2;
constexpr size_t WS_H = WS_XS + (size_t)MROWS * DM * 4;
constexpr size_t WS_Y = WS_H + (size_t)MROWS * DM * 2;
constexpr size_t WS_BIG = WS_Y + (size_t)MROWS * DM * 2;
constexpr size_t WS_P = WS_BIG;
constexpr size_t WS_AG = WS_P + (size_t)MROWS * ABNP * 2;
constexpr size_t WS_Q = WS_AG + al256((size_t)(MROWS / 64) * 2 * 2 * DLRU * 4);
constexpr size_t WS_KV = WS_Q + (size_t)MROWS * QW * 2;
constexpr size_t WS_KR = WS_KV + (size_t)MROWS * KVW * 2;
constexpr size_t WS_AB_END = WS_KR + (size_t)MROWS * 64 * 2;
constexpr size_t WS_QH = WS_BIG;
constexpr size_t WS_VH = WS_QH + (size_t)MROWS * DM * 2;
constexpr size_t WS_GH = WS_VH + (size_t)MROWS * DM * 2;
constexpr size_t WS_LOGF = WS_GH + (size_t)MROWS * DM * 2;
constexpr size_t WS_DS = WS_LOGF + (size_t)2 * MROWS * DM * 4;
constexpr size_t WS_DEC = WS_DS + (size_t)64 * 68 * 16384 * 4;
constexpr size_t WS_SS = WS_DEC + (size_t)64 * 68 * 128 * 4;
constexpr size_t WS_HG_END = WS_SS + (size_t)64 * 68 * 16384 * 2;
constexpr size_t WS_HID = WS_BIG;
constexpr size_t WS_MLP_END = WS_HID + (size_t)MROWS * DFF * 2;
constexpr size_t cmax(size_t a, size_t b) { return a > b ? a : b; }
constexpr size_t WS_END = cmax(cmax(WS_AB_END, WS_HG_END), WS_MLP_END);

constexpr int LDS_BYTES = 147456;
constexpr int LDS_MISC = 131072;

__device__ __forceinline__ float bf2f(bf16_t v) { return __uint_as_float(((unsigned)v) << 16); }
__device__ __forceinline__ unsigned f2bf(float f) { unsigned u = __float_as_uint(f); return (u + 0x7fffu + ((u >> 16) & 1u)) >> 16; }
__device__ __forceinline__ unsigned pk2(float lo, float hi) { return f2bf(lo) | (f2bf(hi) << 16); }
__device__ __forceinline__ float wave_sum(float v) {
#pragma unroll
    for (int o = 1; o < 64; o <<= 1) v += __shfl_xor(v, o);
    return v;
}
__device__ __forceinline__ float wave_max(float v) {
#pragma unroll
    for (int o = 1; o < 64; o <<= 1) v = fmaxf(v, __shfl_xor(v, o));
    return v;
}
__device__ __forceinline__ float sigmoidf_(float x) { return 1.0f / (1.0f + expf(-x)); }
__device__ __forceinline__ float siluf_(float x) { return x / (1.0f + expf(-x)); }
__device__ __forceinline__ float gelu_tanh(float x) { const float u = 0.7978845608028654f * (x + 0.044715f * x * x * x); return 0.5f * x * (1.0f + tanhf(u)); }

#define XB_TMO      128
#define XB_XCNT(j)  (256  + 64 * (j))
#define XB_XSUB(j)  (1280 + 64 * (j))
#define XB_XGEN(j)  (2304 + 64 * (j))
#define XB_TOP      3328
#define XB_TOPGEN   3392
#define XCD_BAR_WORDS 3456
#define XB_SPIN_CAP (1u << 18)
__device__ __forceinline__ unsigned xb_ld(unsigned* p)              { return __hip_atomic_load(p, __ATOMIC_RELAXED, __HIP_MEMORY_SCOPE_AGENT); }
__device__ __forceinline__ unsigned xb_add(unsigned* p, unsigned v) { return __hip_atomic_fetch_add(p, v, __ATOMIC_RELAXED, __HIP_MEMORY_SCOPE_AGENT); }
__device__ __forceinline__ unsigned xb_xcc_id() { return (unsigned)__builtin_amdgcn_s_getreg((3 << 11) | 20) & 0xFu; }
#define XB_SPIN(cond, bar) do { unsigned _sp = 0; while (cond) { __builtin_amdgcn_s_sleep(1); \
    if ((++_sp & 255u) == 0u) { if (xb_ld(&(bar)[XB_TMO])) break; if (_sp > XB_SPIN_CAP) { atomicAdd(&(bar)[XB_TMO], 1u); break; } } } } while (0)
struct XcdBarrier { unsigned* bar; unsigned x; volatile LAS unsigned* st; };
__device__ __forceinline__ XcdBarrier xcd_barrier_post(unsigned* bar, volatile LAS unsigned* st) {
    XcdBarrier b; b.bar = bar; b.x = xb_xcc_id(); b.st = st;
    if (threadIdx.x == 0) (void)xb_add(&bar[XB_XCNT(b.x)], 1u);
    return b;
}
__device__ __forceinline__ void xcd_barrier_complete(unsigned* bar, unsigned x, unsigned& nloc, unsigned& nx) {
    const unsigned G = gridDim.x * gridDim.y * gridDim.z;
    unsigned sum, cnt, mine, sp = 0u;
    for (;;) {
        sum = 0u; cnt = 0u; mine = 0u;
#pragma unroll
        for (unsigned j = 0; j < 16; ++j) { const unsigned c = xb_ld(&bar[XB_XCNT(j)]); sum += c; cnt += (c > 0u) ? 1u : 0u; mine = (j == x) ? c : mine; }
        if (sum == G) break;
        __builtin_amdgcn_s_sleep(1);
        if ((++sp & 255u) == 0u) { if (xb_ld(&bar[XB_TMO])) break; if (sp > XB_SPIN_CAP) { atomicAdd(&bar[XB_TMO], 1u); break; } }
    }
    nloc = mine > 0u ? mine : 1u; nx = cnt > 0u ? cnt : 1u;
}
__device__ __forceinline__ void xcd_barrier(const XcdBarrier& b) {
    asm volatile("s_waitcnt vmcnt(0)" ::: "memory");
    __syncthreads();
    if (threadIdx.x == 0) {
        unsigned* bar = b.bar; asm volatile("" : "+s"(bar));
        __builtin_amdgcn_s_waitcnt(0);
        unsigned nloc = b.st[0], nx = b.st[1];
        if (nloc == 0u) { xcd_barrier_complete(bar, b.x, nloc, nx); b.st[0] = nloc; b.st[1] = nx; }
        const unsigned old = xb_add(&bar[XB_XSUB(b.x)], 1u);
        const unsigned gen = old / nloc;
        if (old + 1u == (gen + 1u) * nloc) {
            __builtin_amdgcn_fence(__ATOMIC_RELEASE, "agent");
            asm volatile("s_waitcnt vmcnt(0)" ::: "memory");
            const unsigned og = xb_add(&bar[XB_TOP], 1u);
            const unsigned tg = og / nx;
            if (og + 1u == (tg + 1u) * nx) xb_add(&bar[XB_TOPGEN], 1u);
            else XB_SPIN(xb_ld(&bar[XB_TOPGEN]) == tg, bar);
            __builtin_amdgcn_fence(__ATOMIC_ACQUIRE, "agent");
            xb_add(&bar[XB_XGEN(b.x)], 1u);
            asm volatile("s_waitcnt vmcnt(0)" ::: "memory");
        } else {
            XB_SPIN(xb_ld(&bar[XB_XGEN(b.x)]) == gen, bar);
            __builtin_amdgcn_fence(__ATOMIC_ACQUIRE, "agent");
            asm volatile("s_waitcnt vmcnt(0)" ::: "memory");
        }
    }
    __syncthreads();
}

namespace pg8 {
constexpr int BM = 256, BK = 64, HALF = 128, HTB = HALF * BK * 2, STAGE_BYTES = 8 * HTB, NXCD = 8, WGM = 8;
__host__ __device__ __forceinline__ int lds_byte(int r, int c) { const int st = (r >> 4) * 2 + (c >> 5), rr = r & 15, cc = c & 31, ob = rr * 64 + cc * 2; return st * 1024 + (ob ^ (((ob >> 9) & 1) << 5)); }
__host__ __device__ __forceinline__ void stage_rc(int b, int& R, int& C) { const int st = b / 1024, sb = b % 1024, swz = sb ^ (((sb >> 9) & 1) << 5); R = (st >> 1) * 16 + swz / 64; C = (st & 1) * 32 + (swz % 64) / 2; }
__host__ __device__ __forceinline__ int perm32(int rho) { const int n = rho >> 4, i = rho & 15; return 8 * (i >> 2) + 4 * n + (i & 3); }
struct Unit { int pm, pn; };
struct Gemm { const bf16_t* A; const bf16_t* Bt; int M, N, K, lda, ldb; };
struct StaticOrder {
    int nM, nN, nwg, G, c;
    __host__ __device__ void init(int M, int N, int G_, int c_) { nM = M / BM; nN = N / BM; nwg = nM * nN; G = G_; c = c_; }
    __host__ __device__ bool next(int i, Unit& u) const {
        const long L = (long)i * G + c; if (L >= nwg) return false;
        int wgid = (int)L; { const int q = nwg / NXCD, r = nwg % NXCD, xcd = wgid % NXCD, off = wgid / NXCD; wgid = (xcd < r ? xcd * (q + 1) : r * (q + 1) + (xcd - r) * q) + off; }
        const int nig = WGM * nN, gid = wgid / nig, fm = gid * WGM, gsz = (nM - fm) < WGM ? (nM - fm) : WGM;
        u.pm = fm + ((wgid % nig) % gsz); u.pn = (wgid % nig) / gsz; return true;
    }
};
__device__ __forceinline__ unsigned cvt_pk_bf16(float lo, float hi) { unsigned r; asm volatile("v_cvt_pk_bf16_f32 %0, %1, %2" : "=v"(r) : "v"(lo), "v"(hi)); return r; }

template <class Epi>
__device__ __forceinline__ void gemm_phase(LAS unsigned char* lds, const int tid, const Gemm g, const StaticOrder& S, const Epi& E) {
    const int wid = __builtin_amdgcn_readfirstlane(tid >> 6), lane = tid & 63, wr = wid >> 2, wc = wid & 3, fr = lane & 15, fq = lane >> 4;
    const int K = g.K, nt = K / BK;
    unsigned voffA[2], voffB[2];
#pragma unroll
    for (int i = 0; i < 2; ++i) { int R, C; stage_rc(tid * 16 + i * 8192, R, C); const int Rb = Epi::PERM ? ((R & ~31) + perm32(R & 31)) : R;
        voffA[i] = (unsigned)(R * g.lda + C) * 2u; voffB[i] = (unsigned)(Rb * g.ldb + C) * 2u; }
    const size_t kstep = (size_t)(BK * 2);
    const size_t hsA = (size_t)HALF * g.lda * 2, hsB = (size_t)HALF * g.ldb * 2;
    const size_t tsA = 2 * hsA, tsB = 2 * hsB;
    const unsigned ldsw = (unsigned)wid * 1024u;
    const int aoff = lds_byte(wr * 64 + fr, fq * 8), boff = lds_byte(wc * 32 + fr, fq * 8);
#define PG8_SA(b, h) (((b) * 2 + (h)) * HTB)
#define PG8_SB(b, h) ((4 + (b) * 2 + (h)) * HTB)
#define PG8_STAGE(bufoff, gbase, voff) do { _Pragma("unroll") for (int _i = 0; _i < 2; ++_i) \
        __builtin_amdgcn_global_load_lds((const unsigned*)((const char*)(gbase) + (voff)[_i]), (LAS unsigned*)(lds + (bufoff) + ldsw + _i * 8192), 16, 0, 0); } while (0)
#define PG8_LDA(dst, b, h) do { _Pragma("unroll") for (int m = 0; m < 4; ++m) _Pragma("unroll") for (int k = 0; k < 2; ++k) dst[m][k] = *(const LAS bf16x8*)(lds + PG8_SA(b, h) + aoff + m * 2048 + k * 1024); } while (0)
#define PG8_LDB(dst, b, h) do { _Pragma("unroll") for (int n = 0; n < 2; ++n) _Pragma("unroll") for (int k = 0; k < 2; ++k) dst[n][k] = *(const LAS bf16x8*)(lds + PG8_SB(b, h) + boff + n * 2048 + k * 1024); } while (0)
#define PG8_MMA(ai, bj, At, Bt) do { __builtin_amdgcn_s_setprio(1); _Pragma("unroll") for (int m = 0; m < 4; ++m) _Pragma("unroll") for (int n = 0; n < 2; ++n) _Pragma("unroll") for (int k = 0; k < 2; ++k) \
        acc[ai][bj][m][n] = __builtin_amdgcn_mfma_f32_16x16x32_bf16(Bt[n][k], At[m][k], acc[ai][bj][m][n], 0, 0, 0); __builtin_amdgcn_s_setprio(0); } while (0)
#define PG8_WAIT_V(n) asm volatile("s_waitcnt vmcnt(" #n ")" ::: "memory")
#define PG8_WAIT_L(n) asm volatile("s_waitcnt lgkmcnt(" #n ")" ::: "memory")
#define PG8_BAR __builtin_amdgcn_s_barrier()
#define PG8_SCHED __builtin_amdgcn_sched_barrier(0)
    Unit cur, nxt; int ui = 0;
    if (!S.next(0, cur)) return;
    f32x4 acc[2][2][4][2];
#pragma unroll
    for (int a = 0; a < 2; ++a)
#pragma unroll
        for (int b = 0; b < 2; ++b)
#pragma unroll
            for (int m = 0; m < 4; ++m)
#pragma unroll
                for (int n = 0; n < 2; ++n) acc[a][b][m][n] = (f32x4){0.f, 0.f, 0.f, 0.f};
    bf16x8 At[4][2], B0[2][2], B1[2][2];
    const char* cA = (const char*)g.A + (size_t)cur.pm * tsA; const char* cB = (const char*)g.Bt + (size_t)cur.pn * tsB;
    PG8_STAGE(PG8_SB(0, 0), cB, voffB); PG8_STAGE(PG8_SA(0, 0), cA, voffA); PG8_STAGE(PG8_SB(0, 1), cB + hsB, voffB); PG8_STAGE(PG8_SA(0, 1), cA + hsA, voffA);
    if (wr == 1) PG8_BAR;
    PG8_WAIT_V(4); PG8_BAR;
    PG8_STAGE(PG8_SB(1, 0), cB + kstep, voffB); PG8_STAGE(PG8_SA(1, 0), cA + kstep, voffA); PG8_STAGE(PG8_SB(1, 1), cB + hsB + kstep, voffB);
    PG8_WAIT_V(6); PG8_BAR;
    for (;;) {
        const bool has_next = S.next(ui + 1, nxt);
        const char* nA = has_next ? (const char*)g.A + (size_t)nxt.pm * tsA : cA; const char* nB = has_next ? (const char*)g.Bt + (size_t)nxt.pn * tsB : cB;
        for (int t = 0; t < nt; t += 2) {
            const bool last = (t == nt - 2);
            const char* a1 = cA + (size_t)(t + 1) * kstep;
            const char* a2 = last ? nA : cA + (size_t)(t + 2) * kstep; const char* b2 = last ? nB : cB + (size_t)(t + 2) * kstep;
            const char* a3 = a2 + kstep; const char* b3 = b2 + kstep;
            PG8_LDB(B0, 0, 0); PG8_SCHED; PG8_LDA(At, 0, 0); PG8_STAGE(PG8_SA(1, 1), a1 + hsA, voffA);
            PG8_WAIT_L(8); PG8_BAR; PG8_WAIT_L(0); PG8_MMA(0, 0, At, B0); PG8_BAR; PG8_SCHED;
            PG8_LDB(B1, 0, 1); PG8_STAGE(PG8_SB(0, 0), b2, voffB);
            PG8_BAR; PG8_WAIT_L(0); PG8_MMA(0, 1, At, B1); PG8_BAR;
            PG8_LDA(At, 0, 1); PG8_STAGE(PG8_SA(0, 0), a2, voffA);
            PG8_BAR; PG8_WAIT_L(0); PG8_MMA(1, 0, At, B0); PG8_BAR; PG8_SCHED;
            PG8_STAGE(PG8_SB(0, 1), b2 + hsB, voffB);
            PG8_WAIT_V(6); PG8_BAR; PG8_MMA(1, 1, At, B1); PG8_BAR;
            PG8_LDB(B0, 1, 0); PG8_SCHED; PG8_LDA(At, 1, 0); PG8_STAGE(PG8_SA(0, 1), a2 + hsA, voffA);
            PG8_WAIT_L(8); PG8_BAR; PG8_WAIT_L(0); PG8_MMA(0, 0, At, B0); PG8_BAR; PG8_SCHED;
            PG8_LDB(B1, 1, 1); PG8_STAGE(PG8_SB(1, 0), b3, voffB);
            PG8_BAR; PG8_WAIT_L(0); PG8_MMA(0, 1, At, B1); PG8_BAR;
            PG8_LDA(At, 1, 1); PG8_STAGE(PG8_SA(1, 0), a3, voffA);
            PG8_BAR; PG8_WAIT_L(0); PG8_MMA(1, 0, At, B0); PG8_BAR; PG8_SCHED;
            PG8_STAGE(PG8_SB(1, 1), b3 + hsB, voffB);
            PG8_WAIT_V(6); PG8_BAR; PG8_MMA(1, 1, At, B1); PG8_BAR;
        }
        E(acc, cur, wr, wc, fr, fq);
        if (!has_next) break;
#pragma unroll
        for (int a = 0; a < 2; ++a)
#pragma unroll
            for (int b = 0; b < 2; ++b)
#pragma unroll
                for (int m = 0; m < 4; ++m)
#pragma unroll
                    for (int n = 0; n < 2; ++n) acc[a][b][m][n] = (f32x4){0.f, 0.f, 0.f, 0.f};
        cur = nxt; cA = nA; cB = nB; ++ui;
    }
    PG8_WAIT_V(0);
    if (wr == 0) PG8_BAR;
    PG8_BAR;
#undef PG8_SA
#undef PG8_SB
#undef PG8_STAGE
#undef PG8_LDA
#undef PG8_LDB
#undef PG8_MMA
#undef PG8_WAIT_V
#undef PG8_WAIT_L
#undef PG8_BAR
#undef PG8_SCHED
}
}

#define EPI_ROWS_COLS_PERM \
    const int row0 = u.pm * 256 + wr * 64 + fr; const int col0 = u.pn * 256 + wc * 32 + 8 * fq;
struct EpiBf16Plain {
    static constexpr bool PERM = true;
    bf16_t* O; int ldc;
    __device__ __forceinline__ void operator()(const f32x4 (&acc)[2][2][4][2], const pg8::Unit& u, int wr, int wc, int fr, int fq) const {
        EPI_ROWS_COLS_PERM
#pragma unroll
        for (int ai = 0; ai < 2; ++ai)
#pragma unroll
            for (int m = 0; m < 4; ++m) { bf16_t* rowp = O + (size_t)(row0 + ai * 128 + m * 16) * ldc + col0;
#pragma unroll
                for (int bj = 0; bj < 2; ++bj) { const f32x4 v0 = acc[ai][bj][m][0], v1 = acc[ai][bj][m][1];
                    u32x4 w; w.x = pk2(v0[0], v0[1]); w.y = pk2(v0[2], v0[3]); w.z = pk2(v1[0], v1[1]); w.w = pk2(v1[2], v1[3]);
                    *(u32x4*)(rowp + bj * 128) = w; } }
    }
};
struct EpiBf16RowScale {
    static constexpr bool PERM = true;
    bf16_t* O; int ldc; const float* rs;
    __device__ __forceinline__ void operator()(const f32x4 (&acc)[2][2][4][2], const pg8::Unit& u, int wr, int wc, int fr, int fq) const {
        EPI_ROWS_COLS_PERM
#pragma unroll
        for (int ai = 0; ai < 2; ++ai)
#pragma unroll
            for (int m = 0; m < 4; ++m) { const int row = row0 + ai * 128 + m * 16; const float s = rs[row]; bf16_t* rowp = O + (size_t)row * ldc + col0;
#pragma unroll
                for (int bj = 0; bj < 2; ++bj) { const f32x4 v0 = acc[ai][bj][m][0] * s, v1 = acc[ai][bj][m][1] * s;
                    u32x4 w; w.x = pk2(v0[0], v0[1]); w.y = pk2(v0[2], v0[3]); w.z = pk2(v1[0], v1[1]); w.w = pk2(v1[2], v1[3]);
                    *(u32x4*)(rowp + bj * 128) = w; } }
    }
};
struct EpiRelu2 {
    static constexpr bool PERM = true;
    bf16_t* O; int ldc;
    __device__ __forceinline__ void operator()(const f32x4 (&acc)[2][2][4][2], const pg8::Unit& u, int wr, int wc, int fr, int fq) const {
        EPI_ROWS_COLS_PERM
#pragma unroll
        for (int ai = 0; ai < 2; ++ai)
#pragma unroll
            for (int m = 0; m < 4; ++m) { bf16_t* rowp = O + (size_t)(row0 + ai * 128 + m * 16) * ldc + col0;
#pragma unroll
                for (int bj = 0; bj < 2; ++bj) { f32x4 v0 = acc[ai][bj][m][0], v1 = acc[ai][bj][m][1];
#pragma unroll
                    for (int j = 0; j < 4; ++j) { const float a = fmaxf(v0[j], 0.f), b = fmaxf(v1[j], 0.f); v0[j] = a * a; v1[j] = b * b; }
                    u32x4 w; w.x = pk2(v0[0], v0[1]); w.y = pk2(v0[2], v0[3]); w.z = pk2(v1[0], v1[1]); w.w = pk2(v1[2], v1[3]);
                    *(u32x4*)(rowp + bj * 128) = w; } }
    }
};
struct EpiResid {
    static constexpr bool PERM = false;
    float* XS; const float* gate;
    __device__ __forceinline__ void operator()(const f32x4 (&acc)[2][2][4][2], const pg8::Unit& u, int wr, int wc, int fr, int fq) const {
        const int row0 = u.pm * 256 + wr * 64 + fr, col0 = u.pn * 256 + wc * 32 + 4 * fq;
        const int cond = (u.pm % 17 == 0) ? 2 : (u.pm / 17);
        const float* gp = gate + (size_t)cond * MODW + col0;
        f32x4 gv[2][2];
#pragma unroll
        for (int bj = 0; bj < 2; ++bj)
#pragma unroll
            for (int n = 0; n < 2; ++n) gv[bj][n] = *(const f32x4*)(gp + bj * 128 + n * 16);
#pragma unroll
        for (int ai = 0; ai < 2; ++ai)
#pragma unroll
            for (int m = 0; m < 4; ++m) { float* rowp = XS + (size_t)(row0 + ai * 128 + m * 16) * DM + col0;
#pragma unroll
                for (int bj = 0; bj < 2; ++bj)
#pragma unroll
                    for (int n = 0; n < 2; ++n) { f32x4* p = (f32x4*)(rowp + bj * 128 + n * 16); *p = *p + gv[bj][n] * acc[ai][bj][m][n]; } }
    }
};
struct EpiHG {
    static constexpr bool PERM = true;
    bf16_t* QVG; float* LOGF; const float* lb;
    __device__ __forceinline__ void operator()(const f32x4 (&acc)[2][2][4][2], const pg8::Unit& u, int wr, int wc, int fr, int fq) const {
        const int row0 = u.pm * 256 + wr * 64 + fr; const int seg = u.pn >> 3; const int col0 = (u.pn & 7) * 256 + wc * 32 + 8 * fq;
        if (seg == 1 || seg == 2) {
            float* base = LOGF + (size_t)(seg - 1) * MROWS * DM;
            f32x4 lbv[2][2];
#pragma unroll
            for (int bj = 0; bj < 2; ++bj)
#pragma unroll
                for (int n = 0; n < 2; ++n) lbv[bj][n] = *(const f32x4*)(lb + col0 + bj * 128 + 4 * n);
#pragma unroll
            for (int ai = 0; ai < 2; ++ai)
#pragma unroll
                for (int m = 0; m < 4; ++m) { float* rowp = base + (size_t)(row0 + ai * 128 + m * 16) * DM + col0;
#pragma unroll
                    for (int bj = 0; bj < 2; ++bj)
#pragma unroll
                        for (int n = 0; n < 2; ++n) { f32x4 v = acc[ai][bj][m][n];
#pragma unroll
                            for (int j = 0; j < 4; ++j) { const float l = lbv[bj][n][j]; v[j] = logf(l + (1.0f - l) * sigmoidf_(v[j])); }
                            *(f32x4*)(rowp + bj * 128 + 4 * n) = v; } }
        } else {
            const int bi = seg - 2 + (seg == 0 ? 2 : 0);
            bf16_t* base = QVG + (size_t)bi * MROWS * DM;
            const bool act = (seg != 3);
#pragma unroll
            for (int ai = 0; ai < 2; ++ai)
#pragma unroll
                for (int m = 0; m < 4; ++m) { bf16_t* rowp = base + (size_t)(row0 + ai * 128 + m * 16) * DM + col0;
#pragma unroll
                    for (int bj = 0; bj < 2; ++bj) { f32x4 v0 = acc[ai][bj][m][0], v1 = acc[ai][bj][m][1];
                        if (act) {
#pragma unroll
                            for (int j = 0; j < 4; ++j) { v0[j] = siluf_(v0[j]); v1[j] = siluf_(v1[j]); } }
                        u32x4 w; w.x = pk2(v0[0], v0[1]); w.y = pk2(v0[2], v0[3]); w.z = pk2(v1[0], v1[1]); w.w = pk2(v1[2], v1[3]);
                        *(u32x4*)(rowp + bj * 128) = w; } }
        }
    }
};


namespace att {
using s16x4  = __attribute__((ext_vector_type(4))) short;
using f32x16 = __attribute__((ext_vector_type(16))) float;
constexpr int NW = 8, QBLK = 32, KVBLK = 64;
constexpr float SCALE = ATTN_SCALE;
constexpr float THR = 8.f;
constexpr int SHM_V = KVBLK * 128 * 2, SHM_K = KVBLK * 128 * 2, SHM_KR = KVBLK * 64 * 2;
constexpr int OFF_V = 0, OFF_K = 2 * SHM_V, OFF_KR = OFF_K + 2 * SHM_K, OFF_WS = OFF_KR + 2 * SHM_KR, SHM_ATTN = OFF_WS + NW * 64 * 4;
constexpr int LDQ = QW, LDK = KVW, LDO = DM;
#define KSWZ(row, colB) ((row) * 256 + ((colB) ^ (((row) & 7) << 4)))
#define RSWZ(row, colB) ((row) * 128 + ((colB) ^ ((((row) >> 1) & 7) << 4)))
#define SBAR() __builtin_amdgcn_sched_barrier(0)
__device__ __forceinline__ int crow(int r, int hi) { return (r & 3) + 8 * (r >> 2) + 4 * hi; }
__device__ __forceinline__ unsigned cvtpk(float lo, float hi) { unsigned r; asm volatile("v_cvt_pk_bf16_f32 %0, %1, %2" : "=v"(r) : "v"(lo), "v"(hi)); return r; }
__device__ __forceinline__ bf16x8 ld8(const bf16_t* p) { return *reinterpret_cast<const bf16x8*>(p); }
__device__ __forceinline__ void partialSM(f32x16& p0, f32x16& p1, float& m_reg, float& mn, float& alpha) {
  constexpr float C = SCALE * 1.4426950408889634f;
  float pmax = p0[0];
#pragma unroll
  for (int r = 1; r < 16; ++r) pmax = fmaxf(pmax, p0[r]);
#pragma unroll
  for (int r = 0; r < 16; ++r) pmax = fmaxf(pmax, p1[r]);
  { auto rr = __builtin_amdgcn_permlane32_swap(__float_as_uint(pmax), __float_as_uint(pmax), false, false);
    pmax = fmaxf(__uint_as_float(rr[0]), __uint_as_float(rr[1])); }
  if (__builtin_expect(__all(pmax - m_reg <= THR / SCALE), 1)) { mn = m_reg; alpha = 1.f; }
  else { mn = fmaxf(m_reg, pmax); alpha = __builtin_amdgcn_exp2f((m_reg - mn) * C); m_reg = mn; }
  float mnC = -mn * C;
#pragma unroll
  for (int r = 0; r < 16; ++r) p0[r] = fmaf(p0[r], C, mnC);
#pragma unroll
  for (int r = 0; r < 16; ++r) p1[r] = fmaf(p1[r], C, mnC);
#pragma unroll
  for (int r = 0; r < 16; ++r) p0[r] = __builtin_amdgcn_exp2f(p0[r]);
}
__device__ __forceinline__ void finishSM(f32x16& p0, f32x16& p1, float alpha, float& l_reg, bf16x8& pa0, bf16x8& pa1, bf16x8& pa2, bf16x8& pa3) {
#pragma unroll
  for (int r = 0; r < 16; ++r) p1[r] = __builtin_amdgcn_exp2f(p1[r]);
  float ps = 0;
#pragma unroll
  for (int r = 0; r < 16; ++r) ps += p0[r];
#pragma unroll
  for (int r = 0; r < 16; ++r) ps += p1[r];
  { auto rr = __builtin_amdgcn_permlane32_swap(__float_as_uint(ps), __float_as_uint(ps), false, false);
    ps = __uint_as_float(rr[0]) + __uint_as_float(rr[1]); }
  l_reg = l_reg * alpha + ps;
#define PK4(P, BASE, OUT) do { unsigned a0 = cvtpk(P[BASE + 0], P[BASE + 1]), a1 = cvtpk(P[BASE + 2], P[BASE + 3]);   \
    unsigned b0 = cvtpk(P[BASE + 4], P[BASE + 5]), b1 = cvtpk(P[BASE + 6], P[BASE + 7]);                              \
    auto r0 = __builtin_amdgcn_permlane32_swap(a0, b0, false, false); auto r1 = __builtin_amdgcn_permlane32_swap(a1, b1, false, false); \
    u32x4 w = {r0[0], r1[0], r0[1], r1[1]}; OUT = *reinterpret_cast<bf16x8*>(&w); } while (0)
  PK4(p0, 0, pa0); PK4(p0, 8, pa1); PK4(p1, 0, pa2); PK4(p1, 8, pa3);
#undef PK4
}
__device__ __forceinline__ void qkt(f32x16& p0, f32x16& p1, const char* Ks, const char* Krs, const bf16x8* qr, int r32, int hi) {
  p0 = f32x16{}; p1 = f32x16{};
#pragma unroll
  for (int d0 = 0; d0 < 8; ++d0) { int cb = (d0 * 16 + hi * 8) * 2;
    bf16x8 b0 = *reinterpret_cast<const bf16x8*>(Ks + KSWZ(r32, cb));
    bf16x8 b1 = *reinterpret_cast<const bf16x8*>(Ks + KSWZ(32 + r32, cb));
    p0 = __builtin_amdgcn_mfma_f32_32x32x16_bf16(b0, qr[d0], p0, 0, 0, 0);
    p1 = __builtin_amdgcn_mfma_f32_32x32x16_bf16(b1, qr[d0], p1, 0, 0, 0); }
#pragma unroll
  for (int d0 = 0; d0 < 4; ++d0) { int cb = (d0 * 16 + hi * 8) * 2;
    bf16x8 b0 = *reinterpret_cast<const bf16x8*>(Krs + RSWZ(r32, cb));
    bf16x8 b1 = *reinterpret_cast<const bf16x8*>(Krs + RSWZ(32 + r32, cb));
    p0 = __builtin_amdgcn_mfma_f32_32x32x16_bf16(b0, qr[8 + d0], p0, 0, 0, 0);
    p1 = __builtin_amdgcn_mfma_f32_32x32x16_bf16(b1, qr[8 + d0], p1, 0, 0, 0); }
}
__device__ __forceinline__ int v_st(int k, int c) { const int kk = (k & ~0xC) | ((k & 4) << 1) | ((k & 8) >> 1); return ((kk >> 3) * 4 + (c >> 5)) * 512 + ((kk & 7) * 32 + (c & 31)) * 2; }
__device__ __forceinline__ int v_rd_base(int lane) { return ((lane & 3) << 3) | (((lane >> 2) & 3) << 6) | (((lane >> 4) & 1) << 5) | (((lane >> 5) & 1) << 8); }
constexpr int v_rd_off(int d0, int ks, int half) { return d0 * 512 + ks * 4096 + half * 2048; }
template <int OFF> __device__ __forceinline__ s16x4 tr_read(int vb) {
  s16x4 r; asm volatile("ds_read_b64_tr_b16 %0, %1 offset:%2" : "=&v"(r) : "v"(vb), "i"(OFF) : "memory"); return r;
}
template <int D0> __device__ __forceinline__ void pv_one(f32x16& od, int vb, bf16x8 pa0, bf16x8 pa1, bf16x8 pa2, bf16x8 pa3) {
  const s16x4 l0 = tr_read<v_rd_off(D0, 0, 0)>(vb), h0 = tr_read<v_rd_off(D0, 0, 1)>(vb), l1 = tr_read<v_rd_off(D0, 1, 0)>(vb), h1 = tr_read<v_rd_off(D0, 1, 1)>(vb);
  const s16x4 l2 = tr_read<v_rd_off(D0, 2, 0)>(vb), h2 = tr_read<v_rd_off(D0, 2, 1)>(vb), l3 = tr_read<v_rd_off(D0, 3, 0)>(vb), h3 = tr_read<v_rd_off(D0, 3, 1)>(vb);
  asm volatile("s_waitcnt lgkmcnt(0)" ::: "memory"); SBAR();
#define PK(L, H) (bf16x8){L[0], L[1], L[2], L[3], H[0], H[1], H[2], H[3]}
  od = __builtin_amdgcn_mfma_f32_32x32x16_bf16(pa0, PK(l0, h0), od, 0, 0, 0);
  od = __builtin_amdgcn_mfma_f32_32x32x16_bf16(pa1, PK(l1, h1), od, 0, 0, 0);
  od = __builtin_amdgcn_mfma_f32_32x32x16_bf16(pa2, PK(l2, h2), od, 0, 0, 0);
  od = __builtin_amdgcn_mfma_f32_32x32x16_bf16(pa3, PK(l3, h3), od, 0, 0, 0);
#undef PK
}
__device__ __forceinline__ void pv_d0(f32x16* o, int vb, bf16x8 pa0, bf16x8 pa1, bf16x8 pa2, bf16x8 pa3) {
  pv_one<0>(o[0], vb, pa0, pa1, pa2, pa3); pv_one<1>(o[1], vb, pa0, pa1, pa2, pa3); pv_one<2>(o[2], vb, pa0, pa1, pa2, pa3); pv_one<3>(o[3], vb, pa0, pa1, pa2, pa3);
}
__device__ __forceinline__ void attn_body(const bf16_t* __restrict__ Qb, const bf16_t* __restrict__ Kh, const bf16_t* __restrict__ KRb,
                                          bf16_t* __restrict__ Ob, int seq, int tq0, const float* __restrict__ RC, const float* __restrict__ RS, char* lds, int tid) {
  const bf16_t* Vh = Kh + 128;
  const int wid = tid >> 6, lane = tid & 63, r32 = lane & 31, hi = lane >> 5;
  char* V_lds = lds + OFF_V; char* K_lds = lds + OFF_K; char* KR_lds = lds + OFF_KR;
  float* ws = (float*)(lds + OFF_WS) + wid * 64; float* li_l = ws; float* al_l = ws + 32;
  float m_reg = -1e30f, l_reg = 0; f32x16 o[4] = {}; bf16x8 qr[12];
  const bf16_t* Qw = Qb + (long)(wid * QBLK + r32) * LDQ + hi * 8;
#pragma unroll
  for (int d0 = 0; d0 < 12; ++d0) qr[d0] = ld8(Qw + d0 * 16);
  if (tq0 >= 0) {
    const int t = tq0 + wid * QBLK + r32; const int pr = (t >> 6) * 16 + hi * 8, pc = (t & 63) * 16 + hi * 8;
#pragma unroll
    for (int j = 0; j < 8; ++j) {
      { const float c = RC[pr + j], sn = RS[pr + j]; const float x0 = bf2f((bf16_t)qr[8][j]), x1 = bf2f((bf16_t)qr[9][j]);
        qr[8][j] = (short)f2bf(x0 * c - x1 * sn); qr[9][j] = (short)f2bf(x1 * c + x0 * sn); }
      { const float c = RC[pc + j], sn = RS[pc + j]; const float x0 = bf2f((bf16_t)qr[10][j]), x1 = bf2f((bf16_t)qr[11][j]);
        qr[10][j] = (short)f2bf(x0 * c - x1 * sn); qr[11][j] = (short)f2bf(x1 * c + x0 * sn); }
    }
  }
  const int sr = tid >> 4, sc = (tid & 15) * 8, vst0 = v_st(sr, sc), vst1 = v_st(32 + sr, sc);
  const int rr = tid >> 3, rc = (tid & 7) * 8;
  const int vb0 = (int)(uintptr_t)V_lds + v_rd_base(lane);
  bf16x8 vs0, vs1, ks0, ks1, krs;
#define SLOAD(k0) do { vs0 = ld8(&Vh[(long)((k0) + sr) * LDK + sc]); vs1 = ld8(&Vh[(long)((k0) + 32 + sr) * LDK + sc]); \
    ks0 = ld8(&Kh[(long)((k0) + sr) * LDK + sc]); ks1 = ld8(&Kh[(long)((k0) + 32 + sr) * LDK + sc]); krs = ld8(&KRb[(long)((k0) + rr) * 64 + rc]); } while (0)
#define SWRITE(b) do { *(bf16x8*)(V_lds + (b) * SHM_V + vst0) = vs0; *(bf16x8*)(V_lds + (b) * SHM_V + vst1) = vs1; int kc = sc * 2;   \
    *(bf16x8*)(K_lds + (b) * SHM_K + KSWZ(sr, kc)) = ks0; *(bf16x8*)(K_lds + (b) * SHM_K + KSWZ(32 + sr, kc)) = ks1;                    \
    *(bf16x8*)(KR_lds + (b) * SHM_KR + RSWZ(rr, rc * 2)) = krs; } while (0)
#define SWAIT() asm volatile("s_waitcnt vmcnt(0)" ::: "memory")
#define RESC(a) do { if (__any((a) < 1.f)) { if (hi == 0) al_l[r32] = (a); asm volatile("s_waitcnt lgkmcnt(0)" ::: "memory"); \
    _Pragma("unroll") for (int d = 0; d < 4; ++d) _Pragma("unroll") for (int r = 0; r < 16; ++r) o[d][r] *= al_l[crow(r, hi)]; } } while (0)
  f32x16 p0, p1; float mn, al; bf16x8 pa0, pa1, pa2, pa3; const int NT = seq / KVBLK;
  SLOAD(0); SWAIT(); SWRITE(0); __syncthreads();
  SLOAD(KVBLK);
  for (int j = 0; j < NT; ++j) {
    const int buf = j & 1;
    SBAR(); qkt(p0, p1, K_lds + buf * SHM_K, KR_lds + buf * SHM_KR, qr, r32, hi);
    partialSM(p0, p1, m_reg, mn, al); RESC(al);
    finishSM(p0, p1, al, l_reg, pa0, pa1, pa2, pa3); SBAR();
    if (j + 1 < NT) { SWAIT(); SWRITE(buf ^ 1); }
    if (j + 2 < NT) SLOAD((j + 2) * KVBLK);
    SBAR();
    pv_d0(o, vb0 + buf * SHM_V, pa0, pa1, pa2, pa3);
    __syncthreads();
  }
  if (hi == 0) li_l[r32] = l_reg; asm volatile("s_waitcnt lgkmcnt(0)" ::: "memory");
  float rli[16];
#pragma unroll
  for (int r = 0; r < 16; ++r) rli[r] = __builtin_amdgcn_rcpf(li_l[crow(r, hi)]);
  bf16_t* Ow = Ob + (long)(wid * QBLK) * LDO;
#pragma unroll
  for (int r = 0; r < 16; ++r) { int orow = crow(r, hi);
#pragma unroll
    for (int d0 = 0; d0 < 4; ++d0) Ow[(long)orow * LDO + d0 * 32 + r32] = (bf16_t)f2bf(o[d0][r] * rli[r]); }
#undef SLOAD
#undef SWRITE
#undef SWAIT
#undef RESC
}
}

typedef const float* cfp_t;
typedef const __attribute__((address_space(4))) cfp_t* InPtr;
struct Ctx {
    LAS unsigned char* lds; int tid, lane, wave, gw, ngw, gtid, ngt;
    InPtr in; float* out; unsigned char* ws;
};
#define WSP(T, off) ((T*)(C.ws + (off)))

__device__ __forceinline__ void tr_item(const float* W, int K, int N, bf16_t* WT, const float* sck, LAS float* scr, int item, int lane) {
    const int nblk = N / 32, kb = item / nblk, nb = item % nblk, k0 = 64 * kb, n0 = 32 * nb;
#pragma unroll 8
    for (int i = 0; i < 32; ++i) { const int kk = 2 * i + (lane >> 5); float v = W[(size_t)(k0 + kk) * N + n0 + (lane & 31)]; if (sck) v *= sck[k0 + kk]; scr[kk * 33 + (lane & 31)] = v; }
    asm volatile("s_waitcnt lgkmcnt(0)" ::: "memory"); __builtin_amdgcn_wave_barrier();
    const int c = lane & 7;
#pragma unroll
    for (int j = 0; j < 4; ++j) { const int n = (lane >> 3) + 8 * j; const LAS float* s = scr + (8 * c) * 33 + n;
        u32x4 o; o.x = pk2(s[0 * 33], s[1 * 33]); o.y = pk2(s[2 * 33], s[3 * 33]); o.z = pk2(s[4 * 33], s[5 * 33]); o.w = pk2(s[6 * 33], s[7 * 33]);
        *(u32x4*)(WT + (size_t)(n0 + n) * K + k0 + 8 * c) = o; }
    asm volatile("s_waitcnt lgkmcnt(0)" ::: "memory"); __builtin_amdgcn_wave_barrier();
}
__device__ __forceinline__ void tr_matrix(const Ctx& C, const float* W, int K, int N, bf16_t* WT, const float* sck) {
    LAS float* scr = (LAS float*)(C.lds + C.wave * 16384);
    const int cnt = (K / 64) * (N / 32);
    for (int it = C.gw; it < cnt; it += C.ngw) tr_item(W, K, N, WT, sck, scr, it, C.lane);
}
__device__ __forceinline__ void sincos_d(double x, double& s, double& c) {
    const double twopi = 6.283185307179586476925286766559;
    const double k = __builtin_rint(x / twopi); const double y = x - k * twopi; const double y2 = y * y;
    double ts = y, ss = y, tc = 1.0, sc = 1.0;
#pragma unroll
    for (int n = 1; n <= 16; ++n) { tc *= -y2 / (double)((2 * n - 1) * (2 * n)); sc += tc; ts *= -y2 / (double)((2 * n) * (2 * n + 1)); ss += ts; }
    s = ss; c = sc;
}
__device__ __forceinline__ void phase_prologue(const Ctx& C) {
#pragma unroll 1
    for (int e = 0; e < 2; ++e) {
        tr_matrix(C, C.in[8] + (size_t)e * DM * ABN, DM, ABN, WSP(bf16_t, WS_WABIN) + (size_t)e * ABNP * DM, nullptr);
        tr_matrix(C, C.in[9] + (size_t)e * DM * DM, DM, DM, WSP(bf16_t, WS_WABOUT) + (size_t)e * DM * DM, nullptr);
        tr_matrix(C, C.in[18] + (size_t)e * 512 * QW, 512, QW, WSP(bf16_t, WS_WUQ) + (size_t)e * QW * 512, C.in[17] + e * 512);
        tr_matrix(C, C.in[20] + (size_t)e * 512 * KVW, 512, KVW, WSP(bf16_t, WS_WUKV) + (size_t)e * KVW * 512, C.in[19] + e * 512);
        tr_matrix(C, C.in[21] + (size_t)e * DM * HGN, DM, HGN, WSP(bf16_t, WS_WHGIN) + (size_t)e * HGN * DM, nullptr);
        tr_matrix(C, C.in[24] + (size_t)e * DM * DM, DM, DM, WSP(bf16_t, WS_WHGOUT) + (size_t)e * DM * DM, nullptr);
#pragma unroll 1
        for (int dg = 0; dg < 4; ++dg) { const int dir = dg >> 1, gate = dg & 1;
            tr_matrix(C, C.in[gate ? 14 : 12] + ((size_t)e * 2 + dir) * 8 * 128 * 128, 1024, 128, WSP(bf16_t, WS_WG) + ((size_t)e * 4 + dg) * 128 * 1024, nullptr); }
    }
#pragma unroll 1
    for (int l = 0; l < 4; ++l) {
        tr_matrix(C, C.in[25] + (size_t)l * DM * DFF, DM, DFF, WSP(bf16_t, WS_W1) + (size_t)l * DFF * DM, nullptr);
        tr_matrix(C, C.in[26] + (size_t)l * DFF * DM, DFF, DM, WSP(bf16_t, WS_W2) + (size_t)l * DM * DFF, nullptr);
    }
    for (int e = 0; e < 2; ++e) { u32x4* z = (u32x4*)(WSP(bf16_t, WS_WABIN) + (size_t)e * ABNP * DM + (size_t)ABN * DM);
        for (int i = C.gtid; i < (ABNP - ABN) * DM / 8; i += C.ngt) z[i] = (u32x4){0u, 0u, 0u, 0u}; }
    { float* XS = WSP(float, WS_XS);
      for (int i = C.gtid; i < MROWS * (DM / 4); i += C.ngt) { const int R = i / (DM / 4), c4 = i % (DM / 4); const int b = R / SROW, s = R % SROW;
          const float* src = s < CTX ? C.in[2] + ((size_t)(b * CTX + s)) * DM : C.in[0] + ((size_t)(b * SEQ + (s - CTX))) * DM;
          ((f32x4*)(XS + (size_t)R * DM))[c4] = ((const f32x4*)src)[c4]; } }
    { float* LB = WSP(float, WS_LB);
      for (int i = C.gtid; i < 2048; i += C.ngt) { float v[4], mx = -1e30f; for (int l = 0; l < 4; ++l) { v[l] = C.in[22][l * 2048 + i]; mx = fmaxf(mx, v[l]); }
          float sum = 0.f; for (int l = 0; l < 4; ++l) { v[l] = expf(v[l] - mx); sum += v[l]; }
          float cum = 0.f; const float p0 = v[0] / sum; for (int l = 0; l < 4; ++l) { cum += v[l] / sum; LB[l * 2048 + i] = cum - p0; } }
      float* RC = WSP(float, WS_ROPE); float* RS = RC + 1024;
      for (int i = C.gtid; i < 1024; i += C.ngt) { const int pos = i / 16, j = i % 16; double inv = 1.0; for (int q = 0; q < j; ++q) inv *= 0.56234132519034908;
          const float ang = (float)pos * (float)inv; double s, c; sincos_d((double)ang, s, c); RC[i] = (float)c; RS[i] = (float)s; } }
    { LAS float* sl = (LAS float*)C.lds;
      LAS float* red = sl + 3 * 2048;
      __syncthreads();
      for (int i = C.tid; i < 3 * 2048; i += 512) { const int r = i / 2048, d = i % 2048; const float v = r < 2 ? C.in[1][r * 2048 + d] : C.in[3][d]; sl[i] = siluf_(v); }
      __syncthreads();
      float* MOD = WSP(float, WS_MOD);
      const int kq = C.tid >> 4, cq = C.tid & 15;
      for (int u = blockIdx.x; u < 4 * (MODW / 64); u += gridDim.x) { const int l = u / (MODW / 64), e0 = (u % (MODW / 64)) * 64;
          const float* w = C.in[4] + (size_t)l * DM * MODW + e0 + 4 * cq;
          f32x4 a0 = {0, 0, 0, 0}, a1 = {0, 0, 0, 0}, a2 = {0, 0, 0, 0};
#pragma unroll 4
          for (int d = kq; d < DM; d += 32) { const f32x4 wv = *(const f32x4*)(w + (size_t)d * MODW); a0 += wv * sl[d]; a1 += wv * sl[2048 + d]; a2 += wv * sl[4096 + d]; }
#pragma unroll
          for (int j = 0; j < 4; ++j) { red[(kq * 3 + 0) * 64 + 4 * cq + j] = a0[j]; red[(kq * 3 + 1) * 64 + 4 * cq + j] = a1[j]; red[(kq * 3 + 2) * 64 + 4 * cq + j] = a2[j]; }
          __syncthreads();
          if (C.tid < 192) { const int r = C.tid / 64, c = C.tid % 64; float s = 0.f; for (int q = 0; q < 32; ++q) s += red[(q * 3 + r) * 64 + c];
              MOD[((size_t)l * 3 + r) * MODW + e0 + c] = s + C.in[5][l * MODW + e0 + c]; }
          __syncthreads(); } }
}

__device__ __forceinline__ void phase_norm_mod(const Ctx& C, const float* w, const float* mod, int sh_idx, int sc_idx) {
    const float* XS = WSP(float, WS_XS); bf16_t* H = WSP(bf16_t, WS_H);
    for (int R = C.gw; R < MROWS; R += C.ngw) {
        const int s = R % SROW, b = R / SROW, cond = s < CTX ? 2 : b;
        const float* shift = mod + (size_t)cond * MODW + sh_idx * DM; const float* scale = mod + (size_t)cond * MODW + sc_idx * DM;
        const f32x4* xr = (const f32x4*)(XS + (size_t)R * DM) + C.lane;
        f32x4 v[8]; float ss = 0.f;
#pragma unroll
        for (int j = 0; j < 8; ++j) { v[j] = xr[64 * j]; ss += (v[j].x * v[j].x + v[j].y * v[j].y) + (v[j].z * v[j].z + v[j].w * v[j].w); }
        const float rstd = 1.0f / sqrtf(wave_sum(ss) * (1.0f / DM) + EPS);
        u32x2* o = (u32x2*)(H + (size_t)R * DM) + C.lane;
#pragma unroll
        for (int j = 0; j < 8; ++j) { const int c = (C.lane + 64 * j) * 4; const f32x4 wv = *(const f32x4*)(w + c), sc = *(const f32x4*)(scale + c), sh = *(const f32x4*)(shift + c);
            const f32x4 y = (v[j] * rstd * wv) * (1.0f + sc) + sh; u32x2 pk; pk.x = pk2(y.x, y.y); pk.y = pk2(y.z, y.w); o[64 * j] = pk; }
    }
}

__device__ __forceinline__ void phase_rs_kr(const Ctx& C) {
    const bf16_t* P = WSP(bf16_t, WS_P);
    float* RSQ = WSP(float, WS_RSQ); float* RSKV = WSP(float, WS_RSKV);
    for (int R = C.gw; R < MROWS; R += C.ngw) {
        const u32x4 a = *(const u32x4*)(P + (size_t)R * ABNP + 2048 + 8 * C.lane), b = *(const u32x4*)(P + (size_t)R * ABNP + 2560 + 8 * C.lane);
        float sa = 0.f, sb = 0.f;
#pragma unroll
        for (int j = 0; j < 4; ++j) { const float a0 = __uint_as_float(a[j] << 16), a1 = __uint_as_float(a[j] & 0xffff0000u), b0 = __uint_as_float(b[j] << 16), b1 = __uint_as_float(b[j] & 0xffff0000u);
            sa += a0 * a0 + a1 * a1; sb += b0 * b0 + b1 * b1; }
        sa = wave_sum(sa); sb = wave_sum(sb);
        if (C.lane == 0) { RSQ[R] = 1.0f / sqrtf(sa * (1.0f / 512.0f) + EPS); RSKV[R] = 1.0f / sqrtf(sb * (1.0f / 512.0f) + EPS); } }
    bf16_t* KR = WSP(bf16_t, WS_KR); const float* RC = WSP(float, WS_ROPE); const float* RS = RC + 1024;
    for (int idx = C.gtid; idx < MROWS * 32; idx += C.ngt) { const int R = idx / 32, p = idx % 32, s = R % SROW; const int i0 = p < 16 ? p : 32 + (p - 16);
        const float x0 = bf2f(P[(size_t)R * ABNP + 3072 + i0]), x1 = bf2f(P[(size_t)R * ABNP + 3072 + i0 + 16]); float o0 = x0, o1 = x1;
        if (s >= CTX) { const int t = s - CTX, pos = p < 16 ? t / 64 : t % 64; const float c = RC[pos * 16 + (p & 15)], sn = RS[pos * 16 + (p & 15)]; o0 = x0 * c - x1 * sn; o1 = x1 * c + x0 * sn; }
        KR[(size_t)R * 64 + i0] = (bf16_t)f2bf(o0); KR[(size_t)R * 64 + i0 + 16] = (bf16_t)f2bf(o1); }
}

__device__ __forceinline__ void phase_attn(const Ctx& C) {
    const bf16_t* Q = WSP(bf16_t, WS_Q); const bf16_t* KV = WSP(bf16_t, WS_KV); const bf16_t* KR = WSP(bf16_t, WS_KR); bf16_t* Y = WSP(bf16_t, WS_Y);
    const float* RC = WSP(float, WS_ROPE); const float* RS = RC + 1024;
    const int G = gridDim.x, c = blockIdx.x;
    for (int u0 = c; u0 < 272; u0 += G) {
        int b, hh, s0, nk, tq0;
        if (u0 < 256) { int v = u0; if (G == 256) { const int x = c & 7, j = c >> 3; v = (x * 2 + (j >> 4)) * 16 + (j & 15); }
            const int p = v >> 4, qb = v & 15; b = p >> 3; hh = p & 7; s0 = CTX + qb * 256; nk = SROW; tq0 = qb * 256; }
        else { const int p = u0 - 256; b = p >> 3; hh = p & 7; s0 = 0; nk = CTX; tq0 = -1; }
        const size_t R0 = (size_t)b * SROW + s0, K0 = (size_t)b * SROW;
        __syncthreads();
        att::attn_body(Q + R0 * QW + hh * 192, KV + K0 * KVW + hh * 256, KR + K0 * 64, Y + R0 * DM + DLRU + hh * 128, nk, tq0, RC, RS, (char*)C.lds, C.tid);
    }
}
namespace hg {
using s16x4  = __attribute__((ext_vector_type(4))) short;
using f32x16 = __attribute__((ext_vector_type(16))) float;
constexpr int NCH = SROW / 64;
constexpr int NCHAIN = NBATCH * 16 * 2;
__device__ __forceinline__ unsigned off_b(unsigned row, unsigned ch) { return 256u * row + 16u * (ch ^ (((row & 3u) << 2) | ((row >> 2) & 3u))); }
__device__ __forceinline__ s16x4 trr(unsigned addr) { s16x4 r; asm volatile("ds_read_b64_tr_b16 %0, %1" : "=&v"(r) : "v"(addr) : "memory"); return r; }
__device__ __forceinline__ bf16x8 pk8(s16x4 L, s16x4 H) { return (bf16x8){L[0], L[1], L[2], L[3], H[0], H[1], H[2], H[3]}; }
__device__ __forceinline__ unsigned tr_nat(unsigned lane, unsigned c, unsigned ks, unsigned t) {
    const unsigned h = lane >> 5, blk = (lane >> 4) & 1, q = (lane & 15) >> 2, p = lane & 3;
    return off_b(16 * ks + 8 * h + 4 * t + q, 4 * c + 2 * blk + (p >> 1)) + 8 * (p & 1); }
__device__ __forceinline__ unsigned tr_perm(unsigned lane, unsigned c, unsigned rb, unsigned t) {
    const unsigned h = lane >> 5, blk = (lane >> 4) & 1, q = (lane & 15) >> 2, p = lane & 3;
    return off_b(rb + 4 * h + 8 * t + q, 4 * c + 2 * blk + (p >> 1)) + 8 * (p & 1); }
__device__ __forceinline__ unsigned row_rd(unsigned lane, unsigned rb, unsigned ks) { return off_b(rb + (lane & 31), 2 * ks + (lane >> 5)); }
__device__ __forceinline__ int crow(int r, int hi) { return (r & 3) + 8 * (r >> 2) + 4 * hi; }
#define HG_WAITL() do { asm volatile("s_waitcnt lgkmcnt(0)" ::: "memory"); __builtin_amdgcn_sched_barrier(0); } while (0)
}

__device__ __forceinline__ void phase_hg_ds(const Ctx& C) {
    using namespace hg;
    LAS unsigned char* L = C.lds; const unsigned Lb = (unsigned)(uintptr_t)L;
    constexpr unsigned VT = 0, KP = 16384, TOT = 32768;
    const float* LOGF = WSP(float, WS_LOGF); const bf16_t* VH = WSP(bf16_t, WS_VH); float* DS = WSP(float, WS_DS); float* DEC = WSP(float, WS_DEC);
    const int w = C.wave, lane = C.lane, tid = C.tid, h5 = lane >> 5, r32 = lane & 31;
    for (int u = blockIdx.x; u < NBATCH * 16 * NCH; u += gridDim.x) {
        const int b = u / (16 * NCH), hh = (u / NCH) % 16, ci = u % NCH; const size_t R0 = (size_t)b * SROW + ci * 64;
        __syncthreads();
#pragma unroll
        for (int p = 0; p < 2; ++p) { const int row = (tid >> 4) + 32 * p, ch = tid & 15; const u32x4 v = *(const u32x4*)(VH + (R0 + row) * DM + hh * 128 + ch * 8); *(LAS u32x4*)(L + VT + off_b(row, ch)) = v; }
#pragma unroll 1
        for (int dir = 0; dir < 2; ++dir) {
            const int chain = (b * 16 + hh) * 2 + dir;
            const float* lfp = LOGF + (size_t)dir * MROWS * DM + (R0 + 8 * w) * DM + hh * 128 + 2 * lane;
            f32x2 lf[8]; f32x2 T = {0.f, 0.f};
#pragma unroll
            for (int i = 0; i < 8; ++i) { lf[i] = *(const f32x2*)(lfp + (size_t)i * DM); T += lf[i]; }
            *(LAS f32x2*)(L + TOT + (w * 128 + 2 * lane) * 4) = T;
            __syncthreads();
            f32x2 off = {0.f, 0.f}, total = {0.f, 0.f};
#pragma unroll
            for (int ww = 0; ww < 8; ++ww) { const f32x2 t = *(const LAS f32x2*)(L + TOT + (ww * 128 + 2 * lane) * 4); total += t; if (dir == 0 ? (ww > w) : (ww < w)) off += t; }
            f32x2 E[8];
            if (dir == 0) { E[7] = off;
#pragma unroll
                for (int i = 6; i >= 0; --i) E[i] = E[i + 1] + lf[i + 1]; }
            else { E[0] = off;
#pragma unroll
                for (int i = 1; i < 8; ++i) E[i] = E[i - 1] + lf[i - 1]; }
#pragma unroll
            for (int i = 0; i < 8; ++i) { const float k0 = (1.0f - __expf(lf[i].x)) * __expf(E[i].x), k1 = (1.0f - __expf(lf[i].y)) * __expf(E[i].y);
                *(LAS unsigned*)(L + KP + off_b(8 * w + i, lane >> 2) + (lane & 3) * 4) = pk2(k0, k1); }
            if (w == 0) { f32x2 d; d.x = __expf(total.x); d.y = __expf(total.y); *(f32x2*)(DEC + ((size_t)chain * NCH + ci) * 128 + 2 * lane) = d; }
            __syncthreads();
            const unsigned dkt = w >> 1, c0 = (w & 1) * 2;
            s16x4 al[4], ah[4], b0l[4], b0h[4], b1l[4], b1h[4];
#pragma unroll
            for (int ks = 0; ks < 4; ++ks) { al[ks] = trr(Lb + KP + tr_nat(lane, dkt, ks, 0)); ah[ks] = trr(Lb + KP + tr_nat(lane, dkt, ks, 1));
                b0l[ks] = trr(Lb + VT + tr_nat(lane, c0, ks, 0)); b0h[ks] = trr(Lb + VT + tr_nat(lane, c0, ks, 1));
                b1l[ks] = trr(Lb + VT + tr_nat(lane, c0 + 1, ks, 0)); b1h[ks] = trr(Lb + VT + tr_nat(lane, c0 + 1, ks, 1)); }
            HG_WAITL();
            f32x16 a0 = {}, a1 = {};
#pragma unroll
            for (int ks = 0; ks < 4; ++ks) { const bf16x8 A = pk8(al[ks], ah[ks]);
                a0 = __builtin_amdgcn_mfma_f32_32x32x16_bf16(A, pk8(b0l[ks], b0h[ks]), a0, 0, 0, 0);
                a1 = __builtin_amdgcn_mfma_f32_32x32x16_bf16(A, pk8(b1l[ks], b1h[ks]), a1, 0, 0, 0); }
            float* dsp = DS + ((size_t)chain * NCH + ci) * 16384;
#pragma unroll
            for (int r = 0; r < 16; ++r) { const int dk = 32 * dkt + crow(r, h5); dsp[dk * 128 + 32 * c0 + r32] = a0[r]; dsp[dk * 128 + 32 * (c0 + 1) + r32] = a1[r]; }
        }
    }
}
__device__ __forceinline__ void phase_hg_scan(const Ctx& C) {
    using namespace hg;
    const float* DS = WSP(float, WS_DS); const float* DEC = WSP(float, WS_DEC); bf16_t* SS = WSP(bf16_t, WS_SS);
    for (int g = C.gtid; g < NCHAIN * 2048; g += C.ngt) { const int chain = g >> 11, within = g & 2047, dk = within >> 4, dv0 = (within & 15) * 8, dir = chain & 1;
        f32x4 s0 = {0.f, 0.f, 0.f, 0.f}, s1 = {0.f, 0.f, 0.f, 0.f};
#pragma unroll 4
        for (int j = 0; j < NCH; ++j) { const int ci = dir == 0 ? j : (j < 4 ? 3 - j : 71 - j); const size_t cb = (size_t)chain * NCH + ci; const size_t idx = (cb * 128 + dk) * 128 + dv0;
            u32x4 o; o.x = pk2(s0.x, s0.y); o.y = pk2(s0.z, s0.w); o.z = pk2(s1.x, s1.y); o.w = pk2(s1.z, s1.w); *(u32x4*)(SS + idx) = o;
            const float d = DEC[cb * 128 + dk]; const f32x4 d0 = *(const f32x4*)(DS + idx), d1 = *(const f32x4*)(DS + idx + 4);
            s0 = s0 * d + d0; s1 = s1 * d + d1; } }
}
__device__ __forceinline__ void phase_hg_out(const Ctx& C, int o_idx) {
    using namespace hg;
    LAS unsigned char* L = C.lds; const unsigned Lb = (unsigned)(uintptr_t)L;
    constexpr unsigned VT = 0, QP = 16384, QM = 32768, KM = 49152, ST = 65536, TOT = 98304, RED = 102400;
    const float* LOGF = WSP(float, WS_LOGF); const bf16_t* VH = WSP(bf16_t, WS_VH); const bf16_t* QH = WSP(bf16_t, WS_QH); const bf16_t* GH = WSP(bf16_t, WS_GH);
    const bf16_t* SS = WSP(bf16_t, WS_SS); bf16_t* Y = WSP(bf16_t, WS_Y); const float* nw = C.in[23] + o_idx * 128;
    const int w = C.wave, lane = C.lane, tid = C.tid, h5 = lane >> 5, r32 = lane & 31;
    const unsigned tt = w >> 2, dvt = w & 3;
    for (int u = blockIdx.x; u < NBATCH * 16 * NCH; u += gridDim.x) {
        const int b = u / (16 * NCH), hh = (u / NCH) % 16, ci = u % NCH; const size_t R0 = (size_t)b * SROW + ci * 64;
        __syncthreads();
#pragma unroll
        for (int p = 0; p < 2; ++p) { const int row = (tid >> 4) + 32 * p, ch = tid & 15; const u32x4 v = *(const u32x4*)(VH + (R0 + row) * DM + hh * 128 + ch * 8); *(LAS u32x4*)(L + VT + off_b(row, ch)) = v; }
        f32x16 acc = {};
#pragma unroll 1
        for (int dir = 0; dir < 2; ++dir) {
            const int chain = (b * 16 + hh) * 2 + dir;
            u32x4 sreg[4];
#pragma unroll
            for (int p = 0; p < 4; ++p) sreg[p] = *(const u32x4*)(SS + (((size_t)chain * NCH + ci) * 128 + (tid >> 4) + 32 * p) * 128 + (tid & 15) * 8);
            const float* lfp = LOGF + (size_t)dir * MROWS * DM + (R0 + 8 * w) * DM + hh * 128 + 2 * lane;
            const bf16_t* qp = QH + (R0 + 8 * w) * DM + hh * 128 + 2 * lane;
            f32x2 lf[8]; unsigned qv[8]; f32x2 T = {0.f, 0.f};
#pragma unroll
            for (int i = 0; i < 8; ++i) { lf[i] = *(const f32x2*)(lfp + (size_t)i * DM); qv[i] = *(const unsigned*)(qp + (size_t)i * DM); T += lf[i]; }
            *(LAS f32x2*)(L + TOT + (w * 128 + 2 * lane) * 4) = T;
            __syncthreads();
            f32x2 off = {0.f, 0.f}, mid = {0.f, 0.f};
#pragma unroll
            for (int ww = 0; ww < 8; ++ww) { const f32x2 t = *(const LAS f32x2*)(L + TOT + (ww * 128 + 2 * lane) * 4);
                if (dir == 0 ? (ww < w) : (ww > w)) off += t; if (dir == 0 ? (ww < 4) : (ww >= 4)) mid += t; }
            f32x2 B[8];
            if (dir == 0) { B[0] = off + lf[0];
#pragma unroll
                for (int i = 1; i < 8; ++i) B[i] = B[i - 1] + lf[i]; }
            else { B[7] = off + lf[7];
#pragma unroll
                for (int i = 6; i >= 0; --i) B[i] = B[i + 1] + lf[i]; }
#pragma unroll
            for (int i = 0; i < 8; ++i) { const float q0 = __uint_as_float(qv[i] << 16), q1 = __uint_as_float(qv[i] & 0xffff0000u);
                const float k0 = 1.0f - __expf(lf[i].x), k1 = 1.0f - __expf(lf[i].y);
                const unsigned a = off_b(8 * w + i, lane >> 2) + (lane & 3) * 4;
                *(LAS unsigned*)(L + QP + a) = pk2(q0 * __expf(B[i].x), q1 * __expf(B[i].y));
                *(LAS unsigned*)(L + QM + a) = pk2(q0 * __expf(B[i].x - mid.x), q1 * __expf(B[i].y - mid.y));
                *(LAS unsigned*)(L + KM + a) = pk2(k0 * __expf(mid.x - B[i].x), k1 * __expf(mid.y - B[i].y)); }
#pragma unroll
            for (int p = 0; p < 4; ++p) *(LAS u32x4*)(L + ST + off_b((tid >> 4) + 32 * p, tid & 15)) = sreg[p];
            __syncthreads();
            { bf16x8 a[8]; s16x4 bl[8], bh[8];
#pragma unroll
              for (int ks = 0; ks < 8; ++ks) { a[ks] = *(const LAS bf16x8*)(L + QP + row_rd(lane, 32 * tt, ks)); bl[ks] = trr(Lb + ST + tr_nat(lane, dvt, ks, 0)); bh[ks] = trr(Lb + ST + tr_nat(lane, dvt, ks, 1)); }
              HG_WAITL();
#pragma unroll
              for (int ks = 0; ks < 8; ++ks) acc = __builtin_amdgcn_mfma_f32_32x32x16_bf16(a[ks], pk8(bl[ks], bh[ks]), acc, 0, 0, 0); }
            { bf16x8 qb[8];
#pragma unroll
              for (int ks = 0; ks < 8; ++ks) qb[ks] = *(const LAS bf16x8*)(L + QM + row_rd(lane, 32 * tt, ks));
#pragma unroll
              for (unsigned st = 0; st < 2; ++st) { const bool valid = dir == 0 ? (st <= tt) : (st >= tt);
                if (valid) {
                  f32x16 x = {};
#pragma unroll
                  for (int ks = 0; ks < 8; ++ks) { const bf16x8 ka = *(const LAS bf16x8*)(L + KM + row_rd(lane, 32 * st, ks)); x = __builtin_amdgcn_mfma_f32_32x32x16_bf16(ka, qb[ks], x, 0, 0, 0); }
                  if (st == tt) {
#pragma unroll
                    for (int r = 0; r < 16; ++r) { const int kr = crow(r, h5); const bool keep = dir == 0 ? (kr <= r32) : (kr >= r32); x[r] = keep ? x[r] : 0.f; } }
                  const s16x4 v0l = trr(Lb + VT + tr_perm(lane, dvt, 32 * st, 0)), v0h = trr(Lb + VT + tr_perm(lane, dvt, 32 * st, 1));
                  const s16x4 v1l = trr(Lb + VT + tr_perm(lane, dvt, 32 * st + 16, 0)), v1h = trr(Lb + VT + tr_perm(lane, dvt, 32 * st + 16, 1));
                  u32x4 A0, A1; A0.x = pk2(x[0], x[1]); A0.y = pk2(x[2], x[3]); A0.z = pk2(x[4], x[5]); A0.w = pk2(x[6], x[7]);
                  A1.x = pk2(x[8], x[9]); A1.y = pk2(x[10], x[11]); A1.z = pk2(x[12], x[13]); A1.w = pk2(x[14], x[15]);
                  HG_WAITL();
                  acc = __builtin_amdgcn_mfma_f32_32x32x16_bf16(*reinterpret_cast<bf16x8*>(&A0), pk8(v0l, v0h), acc, 0, 0, 0);
                  acc = __builtin_amdgcn_mfma_f32_32x32x16_bf16(*reinterpret_cast<bf16x8*>(&A1), pk8(v1l, v1h), acc, 0, 0, 0);
                } } }
        }
        LAS float* red = (LAS float*)(L + RED);
#pragma unroll
        for (int r = 0; r < 16; ++r) { float s = acc[r] * acc[r]; s += __shfl_xor(s, 1); s += __shfl_xor(s, 2); s += __shfl_xor(s, 4); s += __shfl_xor(s, 8); s += __shfl_xor(s, 16);
            if (r32 == 0) red[(tt * 32 + crow(r, h5)) * 4 + dvt] = s; }
        __syncthreads();
        const int col = hh * 128 + 32 * dvt + r32; const float wv = nw[32 * dvt + r32];
#pragma unroll
        for (int r = 0; r < 16; ++r) { const int row = 32 * tt + crow(r, h5); const f32x4 p = *(const LAS f32x4*)(red + row * 4);
            const float rstd = 1.0f / sqrtf(((p.x + p.y) + (p.z + p.w)) * (1.0f / 128.0f) + EPS); const size_t o = (R0 + row) * DM + col;
            Y[o] = (bf16_t)f2bf(acc[r] * rstd * wv * bf2f(GH[o])); }
    }
}
template <bool FINAL>
__device__ __forceinline__ void phase_lru(const Ctx& C, int e) {
    using namespace hg;
    LAS unsigned char* L = C.lds;
    constexpr unsigned UCB = 0, UCF = 16384, AT = 49152, BT = 81920;
    const bf16_t* P = WSP(bf16_t, WS_P); float* AG = WSP(float, WS_AG); bf16_t* Y = WSP(bf16_t, WS_Y);
    const bf16_t* WG = WSP(bf16_t, WS_WG) + (size_t)e * 4 * 128 * 1024;
    const float* cw = C.in[10] + (size_t)e * 4 * DLRU; const float* cb = C.in[11] + (size_t)e * DLRU;
    const float* ba = C.in[13] + (size_t)e * 2 * DLRU; const float* bx = C.in[15] + (size_t)e * 2 * DLRU; const float* lam = C.in[16] + (size_t)e * 2 * DLRU;
    const int w = C.wave, lane = C.lane, tid = C.tid, h5 = lane >> 5, r32 = lane & 31;
    const unsigned rt = w >> 2, et = w & 3;
    for (int u = blockIdx.x; u < (MROWS / 64) * 8; u += gridDim.x) {
        const int ci2 = u >> 3, hd = u & 7; const int c = ci2 % NCH, bb = ci2 / NCH; const size_t R0 = (size_t)ci2 * 64;
        const int s0 = c * 64, lo = c < 4 ? 0 : CTX, hi = c < 4 ? CTX : SROW;
        __syncthreads();
        float cin = 0.f;
        if (FINAL && tid < 256) { const int dir = tid >> 7, ch = tid & 127; const int jpos = dir == 0 ? c : (c < 4 ? 3 - c : 71 - c);
            for (int j = 0; j < jpos; ++j) { const int cc = dir == 0 ? j : (j < 4 ? 3 - j : 71 - j); const float* ag = AG + ((size_t)((bb * NCH + cc) * 2 + dir) * 2) * DLRU + hd * 128 + ch;
                cin = cin * ag[0] + ag[DLRU]; } }
        { const int chn = hd * 128 + 2 * lane; const bf16_t* up = P + DLRU + chn;
          f32x2 uv[11];
#pragma unroll
          for (int i = 0; i < 11; ++i) { const int s = s0 + 8 * w + i - 2; unsigned raw = 0u; if (s >= lo && s < hi) raw = *(const unsigned*)(up + ((size_t)bb * SROW + s) * ABNP);
              uv[i].x = __uint_as_float(raw << 16); uv[i].y = __uint_as_float(raw & 0xffff0000u); }
          f32x2 wj[4];
#pragma unroll
          for (int j = 0; j < 4; ++j) wj[j] = *(const f32x2*)(cw + j * DLRU + chn);
          const f32x2 bias = *(const f32x2*)(cb + chn);
#pragma unroll
          for (int i = 0; i < 8; ++i) { f32x2 a = bias;
#pragma unroll
              for (int j = 0; j < 4; ++j) a += uv[i + j] * wj[j];
              *(LAS unsigned*)(L + UCB + off_b(8 * w + i, lane >> 2) + (lane & 3) * 4) = pk2(a.x, a.y);
              *(LAS f32x2*)(L + UCF + ((8 * w + i) * 128 + 2 * lane) * 4) = a; } }
        __syncthreads();
        bf16x8 af[8]; float ucr[16];
#pragma unroll
        for (int ks = 0; ks < 8; ++ks) af[ks] = *(const LAS bf16x8*)(L + UCB + row_rd(lane, 32 * rt, ks));
#pragma unroll
        for (int r = 0; r < 16; ++r) ucr[r] = *(const LAS float*)(L + UCF + ((32 * rt + crow(r, h5)) * 128 + 32 * et + r32) * 4);
        const int chl = hd * 128 + 32 * et + r32;
#pragma unroll 1
        for (int dir = 0; dir < 2; ++dir) {
            f32x16 ga = {}, gx = {};
            { const bf16_t* wa = WG + ((size_t)(dir * 2 + 0) * 128 + 32 * et + r32) * 1024 + hd * 128 + 8 * h5; const bf16_t* wx = wa + (size_t)128 * 1024;
              bf16x8 fa[8], fx[8];
#pragma unroll
              for (int ks = 0; ks < 8; ++ks) { fa[ks] = *(const bf16x8*)(wa + 16 * ks); fx[ks] = *(const bf16x8*)(wx + 16 * ks); }
#pragma unroll
              for (int ks = 0; ks < 8; ++ks) { ga = __builtin_amdgcn_mfma_f32_32x32x16_bf16(af[ks], fa[ks], ga, 0, 0, 0); gx = __builtin_amdgcn_mfma_f32_32x32x16_bf16(af[ks], fx[ks], gx, 0, 0, 0); } }
            const float bav = ba[dir * DLRU + chl], bxv = bx[dir * DLRU + chl], sp = log1pf(__expf(-lam[dir * DLRU + chl]));
            if (dir == 1) __syncthreads();
#pragma unroll
            for (int r = 0; r < 16; ++r) { const float rg = 1.0f / (1.0f + __expf(-(ga[r] + bav))), ig = 1.0f / (1.0f + __expf(-(gx[r] + bxv)));
                const float la = -8.0f * rg * sp; const unsigned o = ((32 * rt + crow(r, h5)) * 128 + 32 * et + r32) * 4;
                *(LAS float*)(L + AT + o) = __expf(la); *(LAS float*)(L + BT + o) = sqrtf(-expm1f(2.0f * la)) * (ig * ucr[r]); }
            __syncthreads();
            if ((tid >> 7) == dir) { const int ch = tid & 127; const LAS float* ap = (const LAS float*)(L + AT) + ch; const LAS float* bp = (const LAS float*)(L + BT) + ch;
                if (!FINAL) { float h = 0.f, ap_ = 1.f;
#pragma unroll 16
                    for (int i = 0; i < 64; ++i) { const int row = dir == 0 ? i : 63 - i; const float a = ap[row * 128]; h = a * h + bp[row * 128]; ap_ *= a; }
                    float* ag = AG + ((size_t)(ci2 * 2 + dir) * 2) * DLRU + hd * 128 + ch; ag[0] = ap_; ag[DLRU] = h; }
                else if (dir == 0) { float h = cin; LAS float* hp = (LAS float*)(L + UCF) + ch;
#pragma unroll 16
                    for (int i = 0; i < 64; ++i) { h = ap[i * 128] * h + bp[i * 128]; hp[i * 128] = h; } }
                else { float h = cin; const LAS float* hp = (const LAS float*)(L + UCF) + ch; const bf16_t* gp = P + R0 * ABNP + hd * 128 + ch; bf16_t* yp = Y + R0 * DM + hd * 128 + ch;
#pragma unroll 8
                    for (int i = 63; i >= 0; --i) { h = ap[i * 128] * h + bp[i * 128]; const float hs = hp[i * 128] + h; yp[(size_t)i * DM] = (bf16_t)f2bf(hs * gelu_tanh(bf2f(gp[(size_t)i * ABNP]))); } } }
        }
    }
}
__device__ __forceinline__ void phase_final(const Ctx& C) {
    const float* XS = WSP(float, WS_XS); const float* w = C.in[27];
    for (int r = C.gw; r < NBATCH * SEQ; r += C.ngw) { const int b = r / SEQ, t = r % SEQ; const size_t R = (size_t)b * SROW + CTX + t;
        const f32x4* xr = (const f32x4*)(XS + R * DM) + C.lane; f32x4 v[8]; float ss = 0.f;
#pragma unroll
        for (int j = 0; j < 8; ++j) { v[j] = xr[64 * j]; ss += (v[j].x * v[j].x + v[j].y * v[j].y) + (v[j].z * v[j].z + v[j].w * v[j].w); }
        const float rstd = 1.0f / sqrtf(wave_sum(ss) * (1.0f / DM) + EPS);
        f32x4* o = (f32x4*)(C.out + (size_t)r * DM) + C.lane;
#pragma unroll
        for (int j = 0; j < 8; ++j) { const f32x4 wv = *(const f32x4*)(w + (C.lane + 64 * j) * 4); o[64 * j] = v[j] * rstd * wv; } }
}

struct Args { const float* in[28]; float* out; unsigned char* ws; int ph_lo, ph_hi; };
constexpr int N_PHASES = 1 + 2 * 9 + 2 * 9 + 1;

__global__ void __launch_bounds__(512, 2) fwd_kernel(Args args) {
    extern __shared__ __attribute__((aligned(16))) unsigned char lds_raw[];
    LAS unsigned char* const lds0 = (LAS unsigned char*)lds_raw;
    const unsigned long long inaddr = (unsigned long long)__builtin_amdgcn_kernarg_segment_ptr();
    volatile LAS unsigned* misc = (volatile LAS unsigned*)(lds0 + LDS_MISC);
    if (threadIdx.x < 64) misc[threadIdx.x] = 0u;
    __syncthreads();
    const int lo = args.ph_lo, hi = args.ph_hi;
    const int wave0 = __builtin_amdgcn_readfirstlane(threadIdx.x >> 6);
    XcdBarrier bar; bar.bar = (unsigned*)(args.ws + WS_CTL) + 4096; bar.x = 0; bar.st = misc + 8;
    if (hi - lo > 1) bar = xcd_barrier_post((unsigned*)(args.ws + WS_CTL) + 4096, misc + 8);
    int pid = 0;
    const unsigned long long wsaddr = (unsigned long long)args.ws;
#define PH_BEGIN if (pid >= lo && pid < hi) { int l = l_; Ctx C; { unsigned long long a_ = inaddr, w_ = wsaddr; int t_; asm volatile("v_mbcnt_lo_u32_b32 %0, -1, 0\n\tv_mbcnt_hi_u32_b32 %0, -1, %0" : "=v"(t_)); t_ += wave0 * 64; asm volatile("" : "+s"(a_), "+s"(w_), "+s"(l)); \
        C.in = (InPtr)a_; C.ws = (unsigned char*)w_; C.out = args.out; C.lds = lds0; C.tid = t_; C.lane = t_ & 63; C.wave = __builtin_amdgcn_readfirstlane(t_ >> 6); \
        C.gw = blockIdx.x * 8 + C.wave; C.ngw = gridDim.x * 8; C.gtid = blockIdx.x * 512 + t_; C.ngt = gridDim.x * 512; } \
        const int e = l >> 1; const float* mod = WSP(float, WS_MOD) + (size_t)l * 3 * MODW; const int G = gridDim.x, cb = blockIdx.x; (void)e; (void)mod; (void)G; (void)cb;
#define PH_END } if (pid >= lo && pid + 1 < hi) xcd_barrier(bar); ++pid;
    int l_ = 0;
    PH_BEGIN
#ifndef SKIP_PRO
    phase_prologue(C);
#endif
    PH_END

    for (l_ = 0; l_ < DEPTH; ++l_) {
        PH_BEGIN phase_norm_mod(C, C.in[6] + l * DM, mod, 0, 1); PH_END
        if ((l_ & 1) == 0) {
            PH_BEGIN { pg8::Gemm g{WSP(bf16_t, WS_H), WSP(bf16_t, WS_WABIN) + (size_t)e * ABNP * DM, MROWS, ABNP, DM, DM, DM}; pg8::StaticOrder S; S.init(MROWS, ABNP, G, cb);
                       EpiBf16Plain E{WSP(bf16_t, WS_P), ABNP}; pg8::gemm_phase(C.lds, C.tid, g, S, E); } PH_END
            PH_BEGIN phase_lru<false>(C, e); phase_rs_kr(C); PH_END
            PH_BEGIN { pg8::Gemm g{WSP(bf16_t, WS_P) + 2048, WSP(bf16_t, WS_WUQ) + (size_t)e * QW * 512, MROWS, QW, 512, ABNP, 512}; pg8::StaticOrder S; S.init(MROWS, QW, G, cb);
                       EpiBf16RowScale E{WSP(bf16_t, WS_Q), QW, WSP(float, WS_RSQ)}; pg8::gemm_phase(C.lds, C.tid, g, S, E); }
                     { pg8::Gemm g{WSP(bf16_t, WS_P) + 2560, WSP(bf16_t, WS_WUKV) + (size_t)e * KVW * 512, MROWS, KVW, 512, ABNP, 512}; pg8::StaticOrder S; S.init(MROWS, KVW, G, cb);
                       EpiBf16RowScale E{WSP(bf16_t, WS_KV), KVW, WSP(float, WS_RSKV)}; pg8::gemm_phase(C.lds, C.tid, g, S, E); }
                     phase_lru<true>(C, e); PH_END
            PH_BEGIN phase_attn(C); PH_END
        } else {
            PH_BEGIN { pg8::Gemm g{WSP(bf16_t, WS_H), WSP(bf16_t, WS_WHGIN) + (size_t)e * HGN * DM, MROWS, HGN, DM, DM, DM}; pg8::StaticOrder S; S.init(MROWS, HGN, G, cb);
                       EpiHG E{WSP(bf16_t, WS_QH), WSP(float, WS_LOGF), WSP(float, WS_LB) + l * 2048}; pg8::gemm_phase(C.lds, C.tid, g, S, E); } PH_END
            PH_BEGIN phase_hg_ds(C); PH_END
            PH_BEGIN phase_hg_scan(C); PH_END
            PH_BEGIN phase_hg_out(C, e); PH_END
        }
        PH_BEGIN { const bf16_t* wout = (l & 1) ? WSP(bf16_t, WS_WHGOUT) + (size_t)e * DM * DM : WSP(bf16_t, WS_WABOUT) + (size_t)e * DM * DM;
                   pg8::Gemm g{WSP(bf16_t, WS_Y), wout, MROWS, DM, DM, DM, DM}; pg8::StaticOrder S; S.init(MROWS, DM, G, cb);
                   EpiResid E{WSP(float, WS_XS), mod + 2 * DM}; pg8::gemm_phase(C.lds, C.tid, g, S, E); } PH_END
        PH_BEGIN phase_norm_mod(C, C.in[7] + l * DM, mod, 3, 4); PH_END
        PH_BEGIN { pg8::Gemm g{WSP(bf16_t, WS_H), WSP(bf16_t, WS_W1) + (size_t)l * DFF * DM, MROWS, DFF, DM, DM, DM}; pg8::StaticOrder S; S.init(MROWS, DFF, G, cb);
                   EpiRelu2 E{WSP(bf16_t, WS_HID), DFF}; pg8::gemm_phase(C.lds, C.tid, g, S, E); } PH_END
        PH_BEGIN { pg8::Gemm g{WSP(bf16_t, WS_HID), WSP(bf16_t, WS_W2) + (size_t)l * DM * DFF, MROWS, DM, DFF, DFF, DFF}; pg8::StaticOrder S; S.init(MROWS, DM, G, cb);
                   EpiResid E{WSP(float, WS_XS), mod + 5 * DM}; pg8::gemm_phase(C.lds, C.tid, g, S, E); } PH_END
    }
    l_ = 0;
    PH_BEGIN phase_final(C); PH_END
}

#ifndef N_LAUNCH_MODE
#define N_LAUNCH_MODE 1
#endif
extern "C" void kernel_launch(void* const* d_in, const int* in_sizes, int n_in, void* d_out, int out_size, void* d_ws, size_t ws_size, hipStream_t stream) {
    static int grid = 0;
    if (grid == 0) {
        if (n_in != 28 || out_size != NBATCH * SEQ * DM || ws_size < WS_END) { fprintf(stderr, "kernel_launch: shape mismatch n_in %d out %d ws %zu (need %zu)\n", n_in, out_size, ws_size, (size_t)WS_END); grid = -1; return; }
        int dev = 0, cus = 0, per_cu = 0;
        if (hipGetDevice(&dev) != hipSuccess || hipDeviceGetAttribute(&cus, hipDeviceAttributeMultiprocessorCount, dev) != hipSuccess) { grid = -1; return; }
        if (hipFuncSetAttribute((const void*)fwd_kernel, hipFuncAttributeMaxDynamicSharedMemorySize, LDS_BYTES) != hipSuccess) { fprintf(stderr, "kernel_launch: hipFuncSetAttribute failed\n"); grid = -1; return; }
        if (hipOccupancyMaxActiveBlocksPerMultiprocessor(&per_cu, (const void*)fwd_kernel, 512, LDS_BYTES) != hipSuccess || per_cu < 1) fprintf(stderr, "kernel_launch: occupancy query says %d\n", per_cu);
        (void)hipGetLastError();
        grid = cus;
    }
    if (grid < 0) return;
    (void)hipMemsetAsync((char*)d_ws + WS_CTL, 0, CTL_BYTES, stream);
    Args a{};
    for (int i = 0; i < 28; ++i) a.in[i] = (const float*)d_in[i];
    a.out = (float*)d_out; a.ws = (unsigned char*)d_ws;
#if N_LAUNCH_MODE == 1
    a.ph_lo = 0; a.ph_hi = N_PHASES;
    hipLaunchKernelGGL(fwd_kernel, dim3(grid), dim3(512), LDS_BYTES, stream, a);
#else
    for (int p = 0; p < N_PHASES; ++p) { a.ph_lo = p; a.ph_hi = p + 1; hipLaunchKernelGGL(fwd_kernel, dim3(grid), dim3(512), LDS_BYTES, stream, a); }
#endif
    const hipError_t le = hipPeekAtLastError();
    if (le != hipSuccess) fprintf(stderr, "kernel_launch: launch failed: %s\n", hipGetErrorName(le));
}
```

```cpp
#include <hip/hip_runtime.h>
#include <cstdio>

#define LAS __attribute__((address_space(3)))
typedef unsigned short bf16_t;
typedef short bf16x8 __attribute__((ext_vector_type(8)));
typedef float f32x4 __attribute__((ext_vector_type(4)));
typedef float f32x2 __attribute__((ext_vector_type(2)));
typedef unsigned u32x4 __attribute__((ext_vector_type(4)));
typedef unsigned u32x2 __attribute__((ext_vector_type(2)));

constexpr int DM = 2048, NBATCH = 2, SEQ = 4096, DEPTH = 4, CTX = 256;
constexpr int SROW = CTX + SEQ;
constexpr int MROWS = NBATCH * SROW;
constexpr int DFF = 8192, MODW = 6 * DM;
constexpr int DLRU = 1024;
constexpr int ABN = 3136, ABNP = 3328;
constexpr int QW = 1536, KVW = 2048, HGN = 10240;
constexpr float EPS = 1e-6f;
constexpr float ATTN_SCALE = 0.07216878364870322f;

constexpr size_t al256(size_t x) { return (x + 255) & ~(size_t)255; }
constexpr size_t WS_CTL = 0, CTL_BYTES = 1u << 20;
constexpr size_t WS_MOD = WS_CTL + CTL_BYTES;
constexpr size_t WS_LB = WS_MOD + al256((size_t)DEPTH * 3 * MODW * 4);
constexpr size_t WS_ROPE = WS_LB + al256((size_t)DEPTH * 2048 * 4);
constexpr size_t WS_RSQ = WS_ROPE + al256(2 * 64 * 16 * 4);
constexpr size_t WS_RSKV = WS_RSQ + al256((size_t)MROWS * 4);
constexpr size_t WS_WABIN = WS_RSKV + al256((size_t)MROWS * 4);
constexpr size_t WS_WABOUT = WS_WABIN + (size_t)2 * ABNP * DM * 2;
constexpr size_t WS_WUQ = WS_WABOUT + (size_t)2 * DM * DM * 2;
constexpr size_t WS_WUKV = WS_WUQ + (size_t)2 * QW * 512 * 2;
constexpr size_t WS_WHGIN = WS_WUKV + (size_t)2 * KVW * 512 * 2;
constexpr size_t WS_WHGOUT = WS_WHGIN + (size_t)2 * HGN * DM * 2;
constexpr size_t WS_W1 = WS_WHGOUT + (size_t)2 * DM * DM * 2;
constexpr size_t WS_W2 = WS_W1 + (size_t)4 * DFF * DM * 2;
constexpr size_t WS_WG = WS_W2 + (size_t)4 * DFF * DM * 2;
constexpr size_t WS_XS = WS_WG + (size_t)2 * 4 * 128 * 1024 * 2;
constexpr size_t WS_H = WS_XS + (size_t)MROWS * DM * 4;
constexpr size_t WS_Y = WS_H + (size_t)MROWS * DM * 2;
constexpr size_t WS_BIG = WS_Y + (size_t)MROWS * DM * 2;
constexpr size_t WS_P = WS_BIG;
constexpr size_t WS_AG = WS_P + (size_t)MROWS * ABNP * 2;
constexpr size_t WS_Q = WS_AG + al256((size_t)(MROWS / 64) * 2 * 2 * DLRU * 4);
constexpr size_t WS_KV = WS_Q + (size_t)MROWS * QW * 2;
constexpr size_t WS_KR = WS_KV + (size_t)MROWS * KVW * 2;
constexpr size_t WS_AB_END = WS_KR + (size_t)MROWS * 64 * 2;
constexpr size_t WS_QH = WS_BIG;
constexpr size_t WS_VH = WS_QH + (size_t)MROWS * DM * 2;
constexpr size_t WS_GH = WS_VH + (size_t)MROWS * DM * 2;
constexpr size_t WS_LOGF = WS_GH + (size_t)MROWS * DM * 2;
constexpr size_t WS_DS = WS_LOGF + (size_t)2 * MROWS * DM * 4;
constexpr size_t WS_DEC = WS_DS + (size_t)64 * 68 * 16384 * 4;
constexpr size_t WS_SS = WS_DEC + (size_t)64 * 68 * 128 * 4;
constexpr size_t WS_HG_END = WS_SS + (size_t)64 * 68 * 16384 * 2;
constexpr size_t WS_HID = WS_BIG;
constexpr size_t WS_MLP_END = WS_HID + (size_t)MROWS * DFF * 2;
constexpr size_t cmax(size_t a, size_t b) { return a > b ? a : b; }
constexpr size_t WS_END = cmax(cmax(WS_AB_END, WS_HG_END), WS_MLP_END);

constexpr int LDS_BYTES = 147456;
constexpr int LDS_MISC = 131072;

__device__ __forceinline__ float bf2f(bf16_t v) { return __uint_as_float(((unsigned)v) << 16); }
__device__ __forceinline__ unsigned f2bf(float f) { unsigned u = __float_as_uint(f); return (u + 0x7fffu + ((u >> 16) & 1u)) >> 16; }
__device__ __forceinline__ unsigned pk2(float lo, float hi) { return f2bf(lo) | (f2bf(hi) << 16); }
__device__ __forceinline__ float wave_sum(float v) {
#pragma unroll
    for (int o = 1; o < 64; o <<= 1) v += __shfl_xor(v, o);
    return v;
}
__device__ __forceinline__ float wave_max(float v) {
#pragma unroll
    for (int o = 1; o < 64; o <<= 1) v = fmaxf(v, __shfl_xor(v, o));
    return v;
}
__device__ __forceinline__ float sigmoidf_(float x) { return 1.0f / (1.0f + expf(-x)); }
__device__ __forceinline__ float siluf_(float x) { return x / (1.0f + expf(-x)); }
__device__ __forceinline__ float gelu_tanh(float x) { const float u = 0.7978845608028654f * (x + 0.044715f * x * x * x); return 0.5f * x * (1.0f + tanhf(u)); }

#define XB_TMO      128
#define XB_XCNT(j)  (256  + 64 * (j))
#define XB_XSUB(j)  (1280 + 64 * (j))
#define XB_XGEN(j)  (2304 + 64 * (j))
#define XB_TOP      3328
#define XB_TOPGEN   3392
#define XCD_BAR_WORDS 3456
#define XB_SPIN_CAP (1u << 18)
__device__ __forceinline__ unsigned xb_ld(unsigned* p)              { return __hip_atomic_load(p, __ATOMIC_RELAXED, __HIP_MEMORY_SCOPE_AGENT); }
__device__ __forceinline__ unsigned xb_add(unsigned* p, unsigned v) { return __hip_atomic_fetch_add(p, v, __ATOMIC_RELAXED, __HIP_MEMORY_SCOPE_AGENT); }
__device__ __forceinline__ unsigned xb_xcc_id() { return (unsigned)__builtin_amdgcn_s_getreg((3 << 11) | 20) & 0xFu; }
#define XB_SPIN(cond, bar) do { unsigned _sp = 0; while (cond) { __builtin_amdgcn_s_sleep(1); \
    if ((++_sp & 255u) == 0u) { if (xb_ld(&(bar)[XB_TMO])) break; if (_sp > XB_SPIN_CAP) { atomicAdd(&(bar)[XB_TMO], 1u); break; } } } } while (0)
struct XcdBarrier { unsigned* bar; unsigned x; volatile LAS unsigned* st; };
__device__ __forceinline__ XcdBarrier xcd_barrier_post(unsigned* bar, volatile LAS unsigned* st) {
    XcdBarrier b; b.bar = bar; b.x = xb_xcc_id(); b.st = st;
    if (threadIdx.x == 0) (void)xb_add(&bar[XB_XCNT(b.x)], 1u);
    return b;
}
__device__ __forceinline__ void xcd_barrier_complete(unsigned* bar, unsigned x, unsigned& nloc, unsigned& nx) {
    const unsigned G = gridDim.x * gridDim.y * gridDim.z;
    unsigned sum, cnt, mine, sp = 0u;
    for (;;) {
        sum = 0u; cnt = 0u; mine = 0u;
#pragma unroll
        for (unsigned j = 0; j < 16; ++j) { const unsigned c = xb_ld(&bar[XB_XCNT(j)]); sum += c; cnt += (c > 0u) ? 1u : 0u; mine = (j == x) ? c : mine; }
        if (sum == G) break;
        __builtin_amdgcn_s_sleep(1);
        if ((++sp & 255u) == 0u) { if (xb_ld(&bar[XB_TMO])) break; if (sp > XB_SPIN_CAP) { atomicAdd(&bar[XB_TMO], 1u); break; } }
    }
    nloc = mine > 0u ? mine : 1u; nx = cnt > 0u ? cnt : 1u;
}
__device__ __forceinline__ void xcd_barrier(const XcdBarrier& b) {
    asm volatile("s_waitcnt vmcnt(0)" ::: "memory");
    __syncthreads();
    if (threadIdx.x == 0) {
        unsigned* bar = b.bar; asm volatile("" : "+s"(bar));
        __builtin_amdgcn_s_waitcnt(0);
        unsigned nloc = b.st[0], nx = b.st[1];
        if (nloc == 0u) { xcd_barrier_complete(bar, b.x, nloc, nx); b.st[0] = nloc; b.st[1] = nx; }
        const unsigned old = xb_add(&bar[XB_XSUB(b.x)], 1u);
        const unsigned gen = old / nloc;
        if (old + 1u == (gen + 1u) * nloc) {
            __builtin_amdgcn_fence(__ATOMIC_RELEASE, "agent");
            asm volatile("s_waitcnt vmcnt(0)" ::: "memory");
            const unsigned og = xb_add(&bar[XB_TOP], 1u);
            const unsigned tg = og / nx;
            if (og + 1u == (tg + 1u) * nx) xb_add(&bar[XB_TOPGEN], 1u);
            else XB_SPIN(xb_ld(&bar[XB_TOPGEN]) == tg, bar);
            __builtin_amdgcn_fence(__ATOMIC_ACQUIRE, "agent");
            xb_add(&bar[XB_XGEN(b.x)], 1u);
            asm volatile("s_waitcnt vmcnt(0)" ::: "memory");
        } else {
            XB_SPIN(xb_ld(&bar[XB_XGEN(b.x)]) == gen, bar);
            __builtin_amdgcn_fence(__ATOMIC_ACQUIRE, "agent");
            asm volatile("s_waitcnt vmcnt(0)" ::: "memory");
        }
    }
    __syncthreads();
}

namespace pg8 {
constexpr int BM = 256, BK = 64, HALF = 128, HTB = HALF * BK * 2, STAGE_BYTES = 8 * HTB, NXCD = 8, WGM = 8;
__host__ __device__ __forceinline__ int lds_byte(int r, int c) { const int st = (r >> 4) * 2 + (c >> 5), rr = r & 15, cc = c & 31, ob = rr * 64 + cc * 2; return st * 1024 + (ob ^ (((ob >> 9) & 1) << 5)); }
__host__ __device__ __forceinline__ void stage_rc(int b, int& R, int& C) { const int st = b / 1024, sb = b % 1024, swz = sb ^ (((sb >> 9) & 1) << 5); R = (st >> 1) * 16 + swz / 64; C = (st & 1) * 32 + (swz % 64) / 2; }
__host__ __device__ __forceinline__ int perm32(int rho) { const int n = rho >> 4, i = rho & 15; return 8 * (i >> 2) + 4 * n + (i & 3); }
struct Unit { int pm, pn; };
struct Gemm { const bf16_t* A; const bf16_t* Bt; int M, N, K, lda, ldb, lat; };
struct StaticOrder {
    int nM, nN, nwg, G, c;
    __host__ __device__ void init(int M, int N, int G_, int c_) { nM = M / BM; nN = N / BM; nwg = nM * nN; G = G_; c = c_; }
    __host__ __device__ bool next(int i, Unit& u) const {
        const long L = (long)i * G + c; if (L >= nwg) return false;
        int wgid = (int)L; { const int q = nwg / NXCD, r = nwg % NXCD, xcd = wgid % NXCD, off = wgid / NXCD; wgid = (xcd < r ? xcd * (q + 1) : r * (q + 1) + (xcd - r) * q) + off; }
        const int nig = WGM * nN, gid = wgid / nig, fm = gid * WGM, gsz = (nM - fm) < WGM ? (nM - fm) : WGM;
        u.pm = fm + ((wgid % nig) % gsz); u.pn = (wgid % nig) / gsz; return true;
    }
};
__device__ __forceinline__ unsigned cvt_pk_bf16(float lo, float hi) { unsigned r; asm volatile("v_cvt_pk_bf16_f32 %0, %1, %2" : "=v"(r) : "v"(lo), "v"(hi)); return r; }

template <class Epi>
__device__ __forceinline__ void gemm_phase(LAS unsigned char* lds, const int tid, const Gemm g, const StaticOrder& S, const Epi& E) {
    const int wid = __builtin_amdgcn_readfirstlane(tid >> 6), lane = tid & 63, wr = wid >> 2, wc = wid & 3, fr = lane & 15, fq = lane >> 4;
    const int K = g.K, nt = K / BK;
    unsigned voffA[2], voffB[2];
#pragma unroll
    for (int i = 0; i < 2; ++i) { int R, C; stage_rc(tid * 16 + i * 8192, R, C); const int Rb = Epi::PERM ? ((R & ~31) + perm32(R & 31)) : R;
        voffA[i] = (unsigned)(R * g.lda + C) * 2u; voffB[i] = (unsigned)(Rb * g.ldb + C) * 2u; }
    const size_t kstep = (size_t)(BK * 2);
    const size_t hsA = (size_t)HALF * g.lda * 2, hsB = (size_t)HALF * g.ldb * 2;
    const size_t tsA = 2 * hsA, tsB = 2 * hsB;
    const unsigned ldsw = (unsigned)wid * 1024u;
    const int aoff = lds_byte(wr * 64 + fr, fq * 8), boff = lds_byte(wc * 32 + fr, fq * 8);
#define PG8_SA(b, h) (((b) * 2 + (h)) * HTB)
#define PG8_SB(b, h) ((4 + (b) * 2 + (h)) * HTB)
#define PG8_STAGE(bufoff, gbase, voff) do { _Pragma("unroll") for (int _i = 0; _i < 2; ++_i) \
        __builtin_amdgcn_global_load_lds((const unsigned*)((const char*)(gbase) + (voff)[_i]), (LAS unsigned*)(lds + (bufoff) + ldsw + _i * 8192), 16, 0, 0); } while (0)
#define PG8_LDA(dst, b, h) do { _Pragma("unroll") for (int m = 0; m < 4; ++m) _Pragma("unroll") for (int k = 0; k < 2; ++k) dst[m][k] = *(const LAS bf16x8*)(lds + PG8_SA(b, h) + aoff + m * 2048 + k * 1024); } while (0)
#define PG8_LDB(dst, b, h) do { _Pragma("unroll") for (int n = 0; n < 2; ++n) _Pragma("unroll") for (int k = 0; k < 2; ++k) dst[n][k] = *(const LAS bf16x8*)(lds + PG8_SB(b, h) + boff + n * 2048 + k * 1024); } while (0)
#define PG8_MMA(ai, bj, At, Bt) do { __builtin_amdgcn_s_setprio(1); _Pragma("unroll") for (int m = 0; m < 4; ++m) _Pragma("unroll") for (int n = 0; n < 2; ++n) _Pragma("unroll") for (int k = 0; k < 2; ++k) \
        acc[ai][bj][m][n] = __builtin_amdgcn_mfma_f32_16x16x32_bf16(Bt[n][k], At[m][k], acc[ai][bj][m][n], 0, 0, 0); __builtin_amdgcn_s_setprio(0); } while (0)
#define PG8_WAIT_V(n) asm volatile("s_waitcnt vmcnt(" #n ")" ::: "memory")
#define PG8_WAIT_L(n) asm volatile("s_waitcnt lgkmcnt(" #n ")" ::: "memory")
#define PG8_BAR __builtin_amdgcn_s_barrier()
#define PG8_SCHED __builtin_amdgcn_sched_barrier(0)
    Unit cur, nxt; int ui = 0;
    if (!S.next(0, cur)) return;
    if (g.lat) cur.pm += (cur.pm >> 4) + 1;
    f32x4 acc[2][2][4][2];
#pragma unroll
    for (int a = 0; a < 2; ++a)
#pragma unroll
        for (int b = 0; b < 2; ++b)
#pragma unroll
            for (int m = 0; m < 4; ++m)
#pragma unroll
                for (int n = 0; n < 2; ++n) acc[a][b][m][n] = (f32x4){0.f, 0.f, 0.f, 0.f};
    bf16x8 At[4][2], B0[2][2], B1[2][2];
    const char* cA = (const char*)g.A + (size_t)cur.pm * tsA; const char* cB = (const char*)g.Bt + (size_t)cur.pn * tsB;
    PG8_STAGE(PG8_SB(0, 0), cB, voffB); PG8_STAGE(PG8_SA(0, 0), cA, voffA); PG8_STAGE(PG8_SB(0, 1), cB + hsB, voffB); PG8_STAGE(PG8_SA(0, 1), cA + hsA, voffA);
    if (wr == 1) PG8_BAR;
    PG8_WAIT_V(4); PG8_BAR;
    PG8_STAGE(PG8_SB(1, 0), cB + kstep, voffB); PG8_STAGE(PG8_SA(1, 0), cA + kstep, voffA); PG8_STAGE(PG8_SB(1, 1), cB + hsB + kstep, voffB);
    PG8_WAIT_V(6); PG8_BAR;
    for (;;) {
        const bool has_next = S.next(ui + 1, nxt);
        if (g.lat && has_next) nxt.pm += (nxt.pm >> 4) + 1;
        const char* nA = has_next ? (const char*)g.A + (size_t)nxt.pm * tsA : cA; const char* nB = has_next ? (const char*)g.Bt + (size_t)nxt.pn * tsB : cB;
        for (int t = 0; t < nt; t += 2) {
            const bool last = (t == nt - 2);
            const char* a1 = cA + (size_t)(t + 1) * kstep;
            const char* a2 = last ? nA : cA + (size_t)(t + 2) * kstep; const char* b2 = last ? nB : cB + (size_t)(t + 2) * kstep;
            const char* a3 = a2 + kstep; const char* b3 = b2 + kstep;
            PG8_LDB(B0, 0, 0); PG8_SCHED; PG8_LDA(At, 0, 0); PG8_STAGE(PG8_SA(1, 1), a1 + hsA, voffA);
            PG8_WAIT_L(8); PG8_BAR; PG8_WAIT_L(0); PG8_MMA(0, 0, At, B0); PG8_BAR; PG8_SCHED;
            PG8_LDB(B1, 0, 1); PG8_STAGE(PG8_SB(0, 0), b2, voffB);
            PG8_BAR; PG8_WAIT_L(0); PG8_MMA(0, 1, At, B1); PG8_BAR;
            PG8_LDA(At, 0, 1); PG8_STAGE(PG8_SA(0, 0), a2, voffA);
            PG8_BAR; PG8_WAIT_L(0); PG8_MMA(1, 0, At, B0); PG8_BAR; PG8_SCHED;
            PG8_STAGE(PG8_SB(0, 1), b2 + hsB, voffB);
            PG8_WAIT_V(6); PG8_BAR; PG8_MMA(1, 1, At, B1); PG8_BAR;
            PG8_LDB(B0, 1, 0); PG8_SCHED; PG8_LDA(At, 1, 0); PG8_STAGE(PG8_SA(0, 1), a2 + hsA, voffA);
            PG8_WAIT_L(8); PG8_BAR; PG8_WAIT_L(0); PG8_MMA(0, 0, At, B0); PG8_BAR; PG8_SCHED;
            PG8_LDB(B1, 1, 1); PG8_STAGE(PG8_SB(1, 0), b3, voffB);
            PG8_BAR; PG8_WAIT_L(0); PG8_MMA(0, 1, At, B1); PG8_BAR;
            PG8_LDA(At, 1, 1); PG8_STAGE(PG8_SA(1, 0), a3, voffA);
            PG8_BAR; PG8_WAIT_L(0); PG8_MMA(1, 0, At, B0); PG8_BAR; PG8_SCHED;
            PG8_STAGE(PG8_SB(1, 1), b3 + hsB, voffB);
            PG8_WAIT_V(6); PG8_BAR; PG8_MMA(1, 1, At, B1); PG8_BAR;
        }
        E(acc, cur, wr, wc, fr, fq);
        if (!has_next) break;
#pragma unroll
        for (int a = 0; a < 2; ++a)
#pragma unroll
            for (int b = 0; b < 2; ++b)
#pragma unroll
                for (int m = 0; m < 4; ++m)
#pragma unroll
                    for (int n = 0; n < 2; ++n) acc[a][b][m][n] = (f32x4){0.f, 0.f, 0.f, 0.f};
        cur = nxt; cA = nA; cB = nB; ++ui;
    }
    PG8_WAIT_V(0);
    if (wr == 0) PG8_BAR;
    PG8_BAR;
#undef PG8_SA
#undef PG8_SB
#undef PG8_STAGE
#undef PG8_LDA
#undef PG8_LDB
#undef PG8_MMA
#undef PG8_WAIT_V
#undef PG8_WAIT_L
#undef PG8_BAR
#undef PG8_SCHED
}
}

#define EPI_ROWS_COLS_PERM \
    const int row0 = u.pm * 256 + wr * 64 + fr; const int col0 = u.pn * 256 + wc * 32 + 8 * fq;
struct EpiBf16Plain {
    static constexpr bool PERM = true;
    bf16_t* O; int ldc;
    __device__ __forceinline__ void operator()(const f32x4 (&acc)[2][2][4][2], const pg8::Unit& u, int wr, int wc, int fr, int fq) const {
        EPI_ROWS_COLS_PERM
#pragma unroll
        for (int ai = 0; ai < 2; ++ai)
#pragma unroll
            for (int m = 0; m < 4; ++m) { bf16_t* rowp = O + (size_t)(row0 + ai * 128 + m * 16) * ldc + col0;
#pragma unroll
                for (int bj = 0; bj < 2; ++bj) { const f32x4 v0 = acc[ai][bj][m][0], v1 = acc[ai][bj][m][1];
                    u32x4 w; w.x = pk2(v0[0], v0[1]); w.y = pk2(v0[2], v0[3]); w.z = pk2(v1[0], v1[1]); w.w = pk2(v1[2], v1[3]);
                    *(u32x4*)(rowp + bj * 128) = w; } }
    }
};
struct EpiBf16RowScale {
    static constexpr bool PERM = true;
    bf16_t* O; int ldc; const float* rs;
    __device__ __forceinline__ void operator()(const f32x4 (&acc)[2][2][4][2], const pg8::Unit& u, int wr, int wc, int fr, int fq) const {
        EPI_ROWS_COLS_PERM
#pragma unroll
        for (int ai = 0; ai < 2; ++ai)
#pragma unroll
            for (int m = 0; m < 4; ++m) { const int row = row0 + ai * 128 + m * 16; const float s = rs[row]; bf16_t* rowp = O + (size_t)row * ldc + col0;
#pragma unroll
                for (int bj = 0; bj < 2; ++bj) { const f32x4 v0 = acc[ai][bj][m][0] * s, v1 = acc[ai][bj][m][1] * s;
                    u32x4 w; w.x = pk2(v0[0], v0[1]); w.y = pk2(v0[2], v0[3]); w.z = pk2(v1[0], v1[1]); w.w = pk2(v1[2], v1[3]);
                    *(u32x4*)(rowp + bj * 128) = w; } }
    }
};
struct EpiRelu2 {
    static constexpr bool PERM = true;
    bf16_t* O; int ldc;
    __device__ __forceinline__ void operator()(const f32x4 (&acc)[2][2][4][2], const pg8::Unit& u, int wr, int wc, int fr, int fq) const {
        EPI_ROWS_COLS_PERM
#pragma unroll
        for (int ai = 0; ai < 2; ++ai)
#pragma unroll
            for (int m = 0; m < 4; ++m) { bf16_t* rowp = O + (size_t)(row0 + ai * 128 + m * 16) * ldc + col0;
#pragma unroll
                for (int bj = 0; bj < 2; ++bj) { f32x4 v0 = acc[ai][bj][m][0], v1 = acc[ai][bj][m][1];
#pragma unroll
                    for (int j = 0; j < 4; ++j) { const float a = fmaxf(v0[j], 0.f), b = fmaxf(v1[j], 0.f); v0[j] = a * a; v1[j] = b * b; }
                    u32x4 w; w.x = pk2(v0[0], v0[1]); w.y = pk2(v0[2], v0[3]); w.z = pk2(v1[0], v1[1]); w.w = pk2(v1[2], v1[3]);
                    *(u32x4*)(rowp + bj * 128) = w; } }
    }
};
struct EpiResid {
    static constexpr bool PERM = false;
    float* XS; const float* gate;
    __device__ __forceinline__ void operator()(const f32x4 (&acc)[2][2][4][2], const pg8::Unit& u, int wr, int wc, int fr, int fq) const {
        const int row0 = u.pm * 256 + wr * 64 + fr, col0 = u.pn * 256 + wc * 32 + 4 * fq;
        const int cond = (u.pm % 17 == 0) ? 2 : (u.pm / 17);
        const float* gp = gate + (size_t)cond * MODW + col0;
        f32x4 gv[2][2];
#pragma unroll
        for (int bj = 0; bj < 2; ++bj)
#pragma unroll
            for (int n = 0; n < 2; ++n) gv[bj][n] = *(const f32x4*)(gp + bj * 128 + n * 16);
#pragma unroll
        for (int ai = 0; ai < 2; ++ai)
#pragma unroll
            for (int m = 0; m < 4; ++m) { float* rowp = XS + (size_t)(row0 + ai * 128 + m * 16) * DM + col0;
#pragma unroll
                for (int bj = 0; bj < 2; ++bj)
#pragma unroll
                    for (int n = 0; n < 2; ++n) { f32x4* p = (f32x4*)(rowp + bj * 128 + n * 16); *p = *p + gv[bj][n] * acc[ai][bj][m][n]; } }
    }
};
struct EpiHG {
    static constexpr bool PERM = true;
    bf16_t* QVG; float* LOGF; const float* lb;
    __device__ __forceinline__ void operator()(const f32x4 (&acc)[2][2][4][2], const pg8::Unit& u, int wr, int wc, int fr, int fq) const {
        const int row0 = u.pm * 256 + wr * 64 + fr; const int seg = u.pn >> 3; const int col0 = (u.pn & 7) * 256 + wc * 32 + 8 * fq;
        if (seg == 1 || seg == 2) {
            float* base = LOGF + (size_t)(seg - 1) * MROWS * DM;
            f32x4 lbv[2][2];
#pragma unroll
            for (int bj = 0; bj < 2; ++bj)
#pragma unroll
                for (int n = 0; n < 2; ++n) lbv[bj][n] = *(const f32x4*)(lb + col0 + bj * 128 + 4 * n);
#pragma unroll
            for (int ai = 0; ai < 2; ++ai)
#pragma unroll
                for (int m = 0; m < 4; ++m) { float* rowp = base + (size_t)(row0 + ai * 128 + m * 16) * DM + col0;
#pragma unroll
                    for (int bj = 0; bj < 2; ++bj)
#pragma unroll
                        for (int n = 0; n < 2; ++n) { f32x4 v = acc[ai][bj][m][n];
#pragma unroll
                            for (int j = 0; j < 4; ++j) { const float l = lbv[bj][n][j]; v[j] = logf(l + (1.0f - l) * sigmoidf_(v[j])); }
                            *(f32x4*)(rowp + bj * 128 + 4 * n) = v; } }
        } else {
            const int bi = seg - 2 + (seg == 0 ? 2 : 0);
            bf16_t* base = QVG + (size_t)bi * MROWS * DM;
            const bool act = (seg != 3);
#pragma unroll
            for (int ai = 0; ai < 2; ++ai)
#pragma unroll
                for (int m = 0; m < 4; ++m) { bf16_t* rowp = base + (size_t)(row0 + ai * 128 + m * 16) * DM + col0;
#pragma unroll
                    for (int bj = 0; bj < 2; ++bj) { f32x4 v0 = acc[ai][bj][m][0], v1 = acc[ai][bj][m][1];
                        if (act) {
#pragma unroll
                            for (int j = 0; j < 4; ++j) { v0[j] = siluf_(v0[j]); v1[j] = siluf_(v1[j]); } }
                        u32x4 w; w.x = pk2(v0[0], v0[1]); w.y = pk2(v0[2], v0[3]); w.z = pk2(v1[0], v1[1]); w.w = pk2(v1[2], v1[3]);
                        *(u32x4*)(rowp + bj * 128) = w; } }
        }
    }
};


namespace sg {
struct SGemm { const bf16_t* A; const bf16_t* Bt; int N, K, lda, ldb; };
__device__ __forceinline__ unsigned red_off(int w, int row, int col) { return (unsigned)(((w * 64 + row) * 64 + (col ^ (((row >> 2) & 1) << 4))) * 4); }
template <class Epi>
__device__ __forceinline__ void sgemm_unit(LAS unsigned char* lds, int tid, const SGemm& g, int mt, int nt, const Epi& E) {
    const int w = __builtin_amdgcn_readfirstlane(tid >> 6), lane = tid & 63, fr = lane & 15, fq = lane >> 4;
    const size_t Rg = (size_t)(mt >> 2) * SROW + (mt & 3) * 64;
    const int kw = g.K >> 3, nks = kw >> 5;
    const bf16_t* ap = g.A + (Rg + fr) * g.lda + w * kw + 8 * fq;
    const bf16_t* bp = g.Bt + ((size_t)nt * 64 + fr) * g.ldb + w * kw + 8 * fq;
    const size_t sa = (size_t)16 * g.lda, sb = (size_t)16 * g.ldb;
    f32x4 acc[4][4];
#pragma unroll
    for (int m = 0; m < 4; ++m)
#pragma unroll
        for (int n = 0; n < 4; ++n) acc[m][n] = (f32x4){0.f, 0.f, 0.f, 0.f};
    bf16x8 a0[4], b0[4], a1[4], b1[4];
#define SG_LOAD(a, b, ks) do { _Pragma("unroll") for (int i = 0; i < 4; ++i) { a[i] = *(const bf16x8*)(ap + i * sa + (ks) * 32); b[i] = *(const bf16x8*)(bp + i * sb + (ks) * 32); } } while (0)
#define SG_MMA(a, b) do { _Pragma("unroll") for (int m = 0; m < 4; ++m) _Pragma("unroll") for (int n = 0; n < 4; ++n) acc[m][n] = __builtin_amdgcn_mfma_f32_16x16x32_bf16(a[m], b[n], acc[m][n], 0, 0, 0); } while (0)
    SG_LOAD(a0, b0, 0);
    for (int ks = 0; ks < nks; ks += 2) {
        SG_LOAD(a1, b1, ks + 1);
        SG_MMA(a0, b0);
        if (ks + 2 < nks) SG_LOAD(a0, b0, ks + 2);
        SG_MMA(a1, b1);
    }
#undef SG_LOAD
#undef SG_MMA
    __syncthreads();
#pragma unroll
    for (int m = 0; m < 4; ++m)
#pragma unroll
        for (int n = 0; n < 4; ++n)
#pragma unroll
            for (int r = 0; r < 4; ++r) *(LAS float*)(lds + red_off(w, 16 * m + 4 * fq + r, 16 * n + fr)) = acc[m][n][r];
    __syncthreads();
    const int row = tid >> 3, c8 = (tid & 7) * 8;
    f32x4 s0 = {0.f, 0.f, 0.f, 0.f}, s1 = {0.f, 0.f, 0.f, 0.f};
#pragma unroll
    for (int ww = 0; ww < 8; ++ww) { s0 += *(const LAS f32x4*)(lds + red_off(ww, row, c8)); s1 += *(const LAS f32x4*)(lds + red_off(ww, row, c8 + 4)); }
    float v[8] = {s0.x, s0.y, s0.z, s0.w, s1.x, s1.y, s1.z, s1.w};
    E(Rg + row, nt * 64 + c8, v);
}
template <class Epi>
__device__ __forceinline__ void sgemm_phase(LAS unsigned char* lds, int tid, const SGemm& g, int nbig, const Epi& E) {
    const int G = gridDim.x, c = blockIdx.x, nsm = 8 * (g.N >> 6), r = nbig % G;
    int start, stride;
    if (r == 0) { start = (G % 8 == 0) ? (c % 8) * (G / 8) + c / 8 : c; stride = G; }
    else { start = c - r; stride = G - r; if (c < r) start = nsm; }
    for (int su = start; su < nsm; su += stride) sgemm_unit(lds, tid, g, su & 7, su >> 3, E);
    __syncthreads();
}
}
__device__ __forceinline__ void st_bf16x8(bf16_t* p, const float (&v)[8]) { u32x4 w; w.x = pk2(v[0], v[1]); w.y = pk2(v[2], v[3]); w.z = pk2(v[4], v[5]); w.w = pk2(v[6], v[7]); *(u32x4*)p = w; }
struct SEpiPlain { bf16_t* O; int ldc;
    __device__ __forceinline__ void operator()(size_t R, int col, const float (&v)[8]) const { st_bf16x8(O + R * ldc + col, v); } };
struct SEpiRowScale { bf16_t* O; int ldc; const float* rs;
    __device__ __forceinline__ void operator()(size_t R, int col, const float (&v)[8]) const { const float s = rs[R]; float o[8];
#pragma unroll
        for (int j = 0; j < 8; ++j) o[j] = v[j] * s;
        st_bf16x8(O + R * ldc + col, o); } };
struct SEpiRelu2 { bf16_t* O; int ldc;
    __device__ __forceinline__ void operator()(size_t R, int col, const float (&v)[8]) const { float o[8];
#pragma unroll
        for (int j = 0; j < 8; ++j) { const float a = fmaxf(v[j], 0.f); o[j] = a * a; }
        st_bf16x8(O + R * ldc + col, o); } };
struct SEpiResid { float* XS; const float* gate;
    __device__ __forceinline__ void operator()(size_t R, int col, const float (&v)[8]) const { const float* gp = gate + (size_t)2 * MODW + col; float* xp = XS + R * DM + col;
        const f32x4 g0 = *(const f32x4*)gp, g1 = *(const f32x4*)(gp + 4); f32x4 x0 = *(f32x4*)xp, x1 = *(f32x4*)(xp + 4);
        x0 += g0 * (f32x4){v[0], v[1], v[2], v[3]}; x1 += g1 * (f32x4){v[4], v[5], v[6], v[7]}; *(f32x4*)xp = x0; *(f32x4*)(xp + 4) = x1; } };
struct SEpiHG { bf16_t* QVG; float* LOGF; const float* lb;
    __device__ __forceinline__ void operator()(size_t R, int col, const float (&v)[8]) const { const int seg = col >> 11, cs = col & 2047;
        if (seg == 1 || seg == 2) { float* p = LOGF + (size_t)(seg - 1) * MROWS * DM + R * DM + cs; f32x4 o0, o1;
#pragma unroll
            for (int j = 0; j < 4; ++j) { const float l0 = lb[cs + j], l1 = lb[cs + 4 + j]; o0[j] = logf(l0 + (1.0f - l0) * sigmoidf_(v[j])); o1[j] = logf(l1 + (1.0f - l1) * sigmoidf_(v[4 + j])); }
            *(f32x4*)p = o0; *(f32x4*)(p + 4) = o1; }
        else { const int bi = seg - 2 + (seg == 0 ? 2 : 0); float o[8];
#pragma unroll
            for (int j = 0; j < 8; ++j) o[j] = seg == 3 ? v[j] : siluf_(v[j]);
            st_bf16x8(QVG + (size_t)bi * MROWS * DM + R * DM + cs, o); } } };

namespace att {
using s16x4  = __attribute__((ext_vector_type(4))) short;
using f32x16 = __attribute__((ext_vector_type(16))) float;
constexpr int NW = 8, QBLK = 32, KVBLK = 64;
constexpr float SCALE = ATTN_SCALE;
constexpr float THR = 8.f;
constexpr int SHM_V = KVBLK * 128 * 2, SHM_K = KVBLK * 128 * 2, SHM_KR = KVBLK * 64 * 2;
constexpr int OFF_V = 0, OFF_K = 2 * SHM_V, OFF_KR = OFF_K + 2 * SHM_K, OFF_WS = OFF_KR + 2 * SHM_KR, SHM_ATTN = OFF_WS + NW * 64 * 4;
constexpr int LDQ = QW, LDK = KVW, LDO = DM;
#define KSWZ(row, colB) ((row) * 256 + ((colB) ^ (((row) & 7) << 4)))
#define RSWZ(row, colB) ((row) * 128 + ((colB) ^ ((((row) >> 1) & 7) << 4)))
#define SBAR() __builtin_amdgcn_sched_barrier(0)
__device__ __forceinline__ int crow(int r, int hi) { return (r & 3) + 8 * (r >> 2) + 4 * hi; }
__device__ __forceinline__ unsigned cvtpk(float lo, float hi) { unsigned r; asm volatile("v_cvt_pk_bf16_f32 %0, %1, %2" : "=v"(r) : "v"(lo), "v"(hi)); return r; }
__device__ __forceinline__ bf16x8 ld8(const bf16_t* p) { return *reinterpret_cast<const bf16x8*>(p); }
__device__ __forceinline__ void partialSM(f32x16& p0, f32x16& p1, float& m_reg, float& mn, float& alpha) {
  constexpr float C = SCALE * 1.4426950408889634f;
  float pmax = p0[0];
#pragma unroll
  for (int r = 1; r < 16; ++r) pmax = fmaxf(pmax, p0[r]);
#pragma unroll
  for (int r = 0; r < 16; ++r) pmax = fmaxf(pmax, p1[r]);
  { auto rr = __builtin_amdgcn_permlane32_swap(__float_as_uint(pmax), __float_as_uint(pmax), false, false);
    pmax = fmaxf(__uint_as_float(rr[0]), __uint_as_float(rr[1])); }
  if (__builtin_expect(__all(pmax - m_reg <= THR / SCALE), 1)) { mn = m_reg; alpha = 1.f; }
  else { mn = fmaxf(m_reg, pmax); alpha = __builtin_amdgcn_exp2f((m_reg - mn) * C); m_reg = mn; }
  float mnC = -mn * C;
#pragma unroll
  for (int r = 0; r < 16; ++r) p0[r] = fmaf(p0[r], C, mnC);
#pragma unroll
  for (int r = 0; r < 16; ++r) p1[r] = fmaf(p1[r], C, mnC);
#pragma unroll
  for (int r = 0; r < 16; ++r) p0[r] = __builtin_amdgcn_exp2f(p0[r]);
}
__device__ __forceinline__ void finishSM(f32x16& p0, f32x16& p1, float alpha, float& l_reg, bf16x8& pa0, bf16x8& pa1, bf16x8& pa2, bf16x8& pa3) {
#pragma unroll
  for (int r = 0; r < 16; ++r) p1[r] = __builtin_amdgcn_exp2f(p1[r]);
  float ps = 0;
#pragma unroll
  for (int r = 0; r < 16; ++r) ps += p0[r];
#pragma unroll
  for (int r = 0; r < 16; ++r) ps += p1[r];
  { auto rr = __builtin_amdgcn_permlane32_swap(__float_as_uint(ps), __float_as_uint(ps), false, false);
    ps = __uint_as_float(rr[0]) + __uint_as_float(rr[1]); }
  l_reg = l_reg * alpha + ps;
#define PK4(P, BASE, OUT) do { unsigned a0 = cvtpk(P[BASE + 0], P[BASE + 1]), a1 = cvtpk(P[BASE + 2], P[BASE + 3]);   \
    unsigned b0 = cvtpk(P[BASE + 4], P[BASE + 5]), b1 = cvtpk(P[BASE + 6], P[BASE + 7]);                              \
    auto r0 = __builtin_amdgcn_permlane32_swap(a0, b0, false, false); auto r1 = __builtin_amdgcn_permlane32_swap(a1, b1, false, false); \
    u32x4 w = {r0[0], r1[0], r0[1], r1[1]}; OUT = *reinterpret_cast<bf16x8*>(&w); } while (0)
  PK4(p0, 0, pa0); PK4(p0, 8, pa1); PK4(p1, 0, pa2); PK4(p1, 8, pa3);
#undef PK4
}
__device__ __forceinline__ void qkt(f32x16& p0, f32x16& p1, const char* Ks, const char* Krs, const bf16x8* qr, int r32, int hi) {
  p0 = f32x16{}; p1 = f32x16{};
#pragma unroll
  for (int d0 = 0; d0 < 8; ++d0) { int cb = (d0 * 16 + hi * 8) * 2;
    bf16x8 b0 = *reinterpret_cast<const bf16x8*>(Ks + KSWZ(r32, cb));
    bf16x8 b1 = *reinterpret_cast<const bf16x8*>(Ks + KSWZ(32 + r32, cb));
    p0 = __builtin_amdgcn_mfma_f32_32x32x16_bf16(b0, qr[d0], p0, 0, 0, 0);
    p1 = __builtin_amdgcn_mfma_f32_32x32x16_bf16(b1, qr[d0], p1, 0, 0, 0); }
#pragma unroll
  for (int d0 = 0; d0 < 4; ++d0) { int cb = (d0 * 16 + hi * 8) * 2;
    bf16x8 b0 = *reinterpret_cast<const bf16x8*>(Krs + RSWZ(r32, cb));
    bf16x8 b1 = *reinterpret_cast<const bf16x8*>(Krs + RSWZ(32 + r32, cb));
    p0 = __builtin_amdgcn_mfma_f32_32x32x16_bf16(b0, qr[8 + d0], p0, 0, 0, 0);
    p1 = __builtin_amdgcn_mfma_f32_32x32x16_bf16(b1, qr[8 + d0], p1, 0, 0, 0); }
}
__device__ __forceinline__ int v_st(int k, int c) { const int kk = (k & ~0xC) | ((k & 4) << 1) | ((k & 8) >> 1); return ((kk >> 3) * 4 + (c >> 5)) * 512 + ((kk & 7) * 32 + (c & 31)) * 2; }
__device__ __forceinline__ int v_rd_base(int lane) { return ((lane & 3) << 3) | (((lane >> 2) & 3) << 6) | (((lane >> 4) & 1) << 5) | (((lane >> 5) & 1) << 8); }
constexpr int v_rd_off(int d0, int ks, int half) { return d0 * 512 + ks * 4096 + half * 2048; }
template <int OFF> __device__ __forceinline__ s16x4 tr_read(int vb) {
  s16x4 r; asm volatile("ds_read_b64_tr_b16 %0, %1 offset:%2" : "=&v"(r) : "v"(vb), "i"(OFF) : "memory"); return r;
}
template <int D0> __device__ __forceinline__ void pv_one(f32x16& od, int vb, bf16x8 pa0, bf16x8 pa1, bf16x8 pa2, bf16x8 pa3) {
  const s16x4 l0 = tr_read<v_rd_off(D0, 0, 0)>(vb), h0 = tr_read<v_rd_off(D0, 0, 1)>(vb), l1 = tr_read<v_rd_off(D0, 1, 0)>(vb), h1 = tr_read<v_rd_off(D0, 1, 1)>(vb);
  const s16x4 l2 = tr_read<v_rd_off(D0, 2, 0)>(vb), h2 = tr_read<v_rd_off(D0, 2, 1)>(vb), l3 = tr_read<v_rd_off(D0, 3, 0)>(vb), h3 = tr_read<v_rd_off(D0, 3, 1)>(vb);
  asm volatile("s_waitcnt lgkmcnt(0)" ::: "memory"); SBAR();
#define PK(L, H) (bf16x8){L[0], L[1], L[2], L[3], H[0], H[1], H[2], H[3]}
  od = __builtin_amdgcn_mfma_f32_32x32x16_bf16(pa0, PK(l0, h0), od, 0, 0, 0);
  od = __builtin_amdgcn_mfma_f32_32x32x16_bf16(pa1, PK(l1, h1), od, 0, 0, 0);
  od = __builtin_amdgcn_mfma_f32_32x32x16_bf16(pa2, PK(l2, h2), od, 0, 0, 0);
  od = __builtin_amdgcn_mfma_f32_32x32x16_bf16(pa3, PK(l3, h3), od, 0, 0, 0);
#undef PK
}
__device__ __forceinline__ void pv_d0(f32x16* o, int vb, bf16x8 pa0, bf16x8 pa1, bf16x8 pa2, bf16x8 pa3) {
  pv_one<0>(o[0], vb, pa0, pa1, pa2, pa3); pv_one<1>(o[1], vb, pa0, pa1, pa2, pa3); pv_one<2>(o[2], vb, pa0, pa1, pa2, pa3); pv_one<3>(o[3], vb, pa0, pa1, pa2, pa3);
}
__device__ __forceinline__ void attn_body(const bf16_t* __restrict__ Qb, const bf16_t* __restrict__ Kh, const bf16_t* __restrict__ KRb,
                                          bf16_t* __restrict__ Ob, int seq, int tq0, const float* __restrict__ RC, const float* __restrict__ RS, char* lds, int tid) {
  const bf16_t* Vh = Kh + 128;
  const int wid = tid >> 6, lane = tid & 63, r32 = lane & 31, hi = lane >> 5;
  char* V_lds = lds + OFF_V; char* K_lds = lds + OFF_K; char* KR_lds = lds + OFF_KR;
  float* ws = (float*)(lds + OFF_WS) + wid * 64; float* li_l = ws; float* al_l = ws + 32;
  float m_reg = -1e30f, l_reg = 0; f32x16 o[4] = {}; bf16x8 qr[12];
  const bf16_t* Qw = Qb + (long)(wid * QBLK + r32) * LDQ + hi * 8;
#pragma unroll
  for (int d0 = 0; d0 < 12; ++d0) qr[d0] = ld8(Qw + d0 * 16);
  if (tq0 >= 0) {
    const int t = tq0 + wid * QBLK + r32; const int pr = (t >> 6) * 16 + hi * 8, pc = (t & 63) * 16 + hi * 8;
#pragma unroll
    for (int j = 0; j < 8; ++j) {
      { const float c = RC[pr + j], sn = RS[pr + j]; const float x0 = bf2f((bf16_t)qr[8][j]), x1 = bf2f((bf16_t)qr[9][j]);
        qr[8][j] = (short)f2bf(x0 * c - x1 * sn); qr[9][j] = (short)f2bf(x1 * c + x0 * sn); }
      { const float c = RC[pc + j], sn = RS[pc + j]; const float x0 = bf2f((bf16_t)qr[10][j]), x1 = bf2f((bf16_t)qr[11][j]);
        qr[10][j] = (short)f2bf(x0 * c - x1 * sn); qr[11][j] = (short)f2bf(x1 * c + x0 * sn); }
    }
  }
  const int sr = tid >> 4, sc = (tid & 15) * 8, vst0 = v_st(sr, sc), vst1 = v_st(32 + sr, sc);
  const int rr = tid >> 3, rc = (tid & 7) * 8;
  const int vb0 = (int)(uintptr_t)V_lds + v_rd_base(lane);
  bf16x8 vs0, vs1, ks0, ks1, krs;
#define SLOAD(k0) do { vs0 = ld8(&Vh[(long)((k0) + sr) * LDK + sc]); vs1 = ld8(&Vh[(long)((k0) + 32 + sr) * LDK + sc]); \
    ks0 = ld8(&Kh[(long)((k0) + sr) * LDK + sc]); ks1 = ld8(&Kh[(long)((k0) + 32 + sr) * LDK + sc]); krs = ld8(&KRb[(long)((k0) + rr) * 64 + rc]); } while (0)
#define SWRITE(b) do { *(bf16x8*)(V_lds + (b) * SHM_V + vst0) = vs0; *(bf16x8*)(V_lds + (b) * SHM_V + vst1) = vs1; int kc = sc * 2;   \
    *(bf16x8*)(K_lds + (b) * SHM_K + KSWZ(sr, kc)) = ks0; *(bf16x8*)(K_lds + (b) * SHM_K + KSWZ(32 + sr, kc)) = ks1;                    \
    *(bf16x8*)(KR_lds + (b) * SHM_KR + RSWZ(rr, rc * 2)) = krs; } while (0)
#define SWAIT() asm volatile("s_waitcnt vmcnt(0)" ::: "memory")
#define RESC(a) do { if (__any((a) < 1.f)) { if (hi == 0) al_l[r32] = (a); asm volatile("s_waitcnt lgkmcnt(0)" ::: "memory"); \
    _Pragma("unroll") for (int d = 0; d < 4; ++d) _Pragma("unroll") for (int r = 0; r < 16; ++r) o[d][r] *= al_l[crow(r, hi)]; } } while (0)
  f32x16 p0, p1; float mn, al; bf16x8 pa0, pa1, pa2, pa3; const int NT = seq / KVBLK;
  SLOAD(0); SWAIT(); SWRITE(0); __syncthreads();
  SLOAD(KVBLK);
  for (int j = 0; j < NT; ++j) {
    const int buf = j & 1;
    SBAR(); qkt(p0, p1, K_lds + buf * SHM_K, KR_lds + buf * SHM_KR, qr, r32, hi);
    partialSM(p0, p1, m_reg, mn, al); RESC(al);
    finishSM(p0, p1, al, l_reg, pa0, pa1, pa2, pa3); SBAR();
    if (j + 1 < NT) { SWAIT(); SWRITE(buf ^ 1); }
    if (j + 2 < NT) SLOAD((j + 2) * KVBLK);
    SBAR();
    pv_d0(o, vb0 + buf * SHM_V, pa0, pa1, pa2, pa3);
    __syncthreads();
  }
  if (hi == 0) li_l[r32] = l_reg; asm volatile("s_waitcnt lgkmcnt(0)" ::: "memory");
  float rli[16];
#pragma unroll
  for (int r = 0; r < 16; ++r) rli[r] = __builtin_amdgcn_rcpf(li_l[crow(r, hi)]);
  bf16_t* Ow = Ob + (long)(wid * QBLK) * LDO;
#pragma unroll
  for (int r = 0; r < 16; ++r) { int orow = crow(r, hi);
#pragma unroll
    for (int d0 = 0; d0 < 4; ++d0) Ow[(long)orow * LDO + d0 * 32 + r32] = (bf16_t)f2bf(o[d0][r] * rli[r]); }
#undef SLOAD
#undef SWRITE
#undef SWAIT
#undef RESC
}
}

typedef const float* cfp_t;
typedef const __attribute__((address_space(4))) cfp_t* InPtr;
struct Ctx {
    LAS unsigned char* lds; int tid, lane, wave, gw, ngw, gtid, ngt;
    InPtr in; float* out; unsigned char* ws;
};
#define WSP(T, off) ((T*)(C.ws + (off)))

__device__ __forceinline__ void tr_item(const float* W, int K, int N, bf16_t* WT, const float* sck, LAS float* scr, int item, int lane) {
    const int nblk = N / 32, kb = item / nblk, nb = item % nblk, k0 = 64 * kb, n0 = 32 * nb;
#pragma unroll 8
    for (int i = 0; i < 32; ++i) { const int kk = 2 * i + (lane >> 5); float v = W[(size_t)(k0 + kk) * N + n0 + (lane & 31)]; if (sck) v *= sck[k0 + kk]; scr[kk * 33 + (lane & 31)] = v; }
    asm volatile("s_waitcnt lgkmcnt(0)" ::: "memory"); __builtin_amdgcn_wave_barrier();
    const int c = lane & 7;
#pragma unroll
    for (int j = 0; j < 4; ++j) { const int n = (lane >> 3) + 8 * j; const LAS float* s = scr + (8 * c) * 33 + n;
        u32x4 o; o.x = pk2(s[0 * 33], s[1 * 33]); o.y = pk2(s[2 * 33], s[3 * 33]); o.z = pk2(s[4 * 33], s[5 * 33]); o.w = pk2(s[6 * 33], s[7 * 33]);
        *(u32x4*)(WT + (size_t)(n0 + n) * K + k0 + 8 * c) = o; }
    asm volatile("s_waitcnt lgkmcnt(0)" ::: "memory"); __builtin_amdgcn_wave_barrier();
}
__device__ __forceinline__ void tr_matrix(const Ctx& C, const float* W, int K, int N, bf16_t* WT, const float* sck) {
    LAS float* scr = (LAS float*)(C.lds + C.wave * 16384);
    const int cnt = (K / 64) * (N / 32);
    for (int it = C.gw; it < cnt; it += C.ngw) tr_item(W, K, N, WT, sck, scr, it, C.lane);
}
__device__ __forceinline__ void sincos_d(double x, double& s, double& c) {
    const double twopi = 6.283185307179586476925286766559;
    const double k = __builtin_rint(x / twopi); const double y = x - k * twopi; const double y2 = y * y;
    double ts = y, ss = y, tc = 1.0, sc = 1.0;
#pragma unroll
    for (int n = 1; n <= 16; ++n) { tc *= -y2 / (double)((2 * n - 1) * (2 * n)); sc += tc; ts *= -y2 / (double)((2 * n) * (2 * n + 1)); ss += ts; }
    s = ss; c = sc;
}
__device__ __forceinline__ void phase_prologue(const Ctx& C) {
#pragma unroll 1
    for (int e = 0; e < 2; ++e) {
        tr_matrix(C, C.in[8] + (size_t)e * DM * ABN, DM, ABN, WSP(bf16_t, WS_WABIN) + (size_t)e * ABNP * DM, nullptr);
        tr_matrix(C, C.in[9] + (size_t)e * DM * DM, DM, DM, WSP(bf16_t, WS_WABOUT) + (size_t)e * DM * DM, nullptr);
        tr_matrix(C, C.in[18] + (size_t)e * 512 * QW, 512, QW, WSP(bf16_t, WS_WUQ) + (size_t)e * QW * 512, C.in[17] + e * 512);
        tr_matrix(C, C.in[20] + (size_t)e * 512 * KVW, 512, KVW, WSP(bf16_t, WS_WUKV) + (size_t)e * KVW * 512, C.in[19] + e * 512);
        tr_matrix(C, C.in[21] + (size_t)e * DM * HGN, DM, HGN, WSP(bf16_t, WS_WHGIN) + (size_t)e * HGN * DM, nullptr);
        tr_matrix(C, C.in[24] + (size_t)e * DM * DM, DM, DM, WSP(bf16_t, WS_WHGOUT) + (size_t)e * DM * DM, nullptr);
#pragma unroll 1
        for (int dg = 0; dg < 4; ++dg) { const int dir = dg >> 1, gate = dg & 1;
            tr_matrix(C, C.in[gate ? 14 : 12] + ((size_t)e * 2 + dir) * 8 * 128 * 128, 1024, 128, WSP(bf16_t, WS_WG) + ((size_t)e * 4 + dg) * 128 * 1024, nullptr); }
    }
#pragma unroll 1
    for (int l = 0; l < 4; ++l) {
        tr_matrix(C, C.in[25] + (size_t)l * DM * DFF, DM, DFF, WSP(bf16_t, WS_W1) + (size_t)l * DFF * DM, nullptr);
        tr_matrix(C, C.in[26] + (size_t)l * DFF * DM, DFF, DM, WSP(bf16_t, WS_W2) + (size_t)l * DM * DFF, nullptr);
    }
    for (int e = 0; e < 2; ++e) { u32x4* z = (u32x4*)(WSP(bf16_t, WS_WABIN) + (size_t)e * ABNP * DM + (size_t)ABN * DM);
        for (int i = C.gtid; i < (ABNP - ABN) * DM / 8; i += C.ngt) z[i] = (u32x4){0u, 0u, 0u, 0u}; }
    { float* XS = WSP(float, WS_XS);
      for (int i = C.gtid; i < MROWS * (DM / 4); i += C.ngt) { const int R = i / (DM / 4), c4 = i % (DM / 4); const int b = R / SROW, s = R % SROW;
          const float* src = s < CTX ? C.in[2] + ((size_t)(b * CTX + s)) * DM : C.in[0] + ((size_t)(b * SEQ + (s - CTX))) * DM;
          ((f32x4*)(XS + (size_t)R * DM))[c4] = ((const f32x4*)src)[c4]; } }
    { float* LB = WSP(float, WS_LB);
      for (int i = C.gtid; i < 2048; i += C.ngt) { float v[4], mx = -1e30f; for (int l = 0; l < 4; ++l) { v[l] = C.in[22][l * 2048 + i]; mx = fmaxf(mx, v[l]); }
          float sum = 0.f; for (int l = 0; l < 4; ++l) { v[l] = expf(v[l] - mx); sum += v[l]; }
          float cum = 0.f; const float p0 = v[0] / sum; for (int l = 0; l < 4; ++l) { cum += v[l] / sum; LB[l * 2048 + i] = cum - p0; } }
      float* RC = WSP(float, WS_ROPE); float* RS = RC + 1024;
      for (int i = C.gtid; i < 1024; i += C.ngt) { const int pos = i / 16, j = i % 16; double inv = 1.0; for (int q = 0; q < j; ++q) inv *= 0.56234132519034908;
          const float ang = (float)pos * (float)inv; double s, c; sincos_d((double)ang, s, c); RC[i] = (float)c; RS[i] = (float)s; } }
    { LAS float* sl = (LAS float*)C.lds;
      LAS float* red = sl + 3 * 2048;
      __syncthreads();
      for (int i = C.tid; i < 3 * 2048; i += 512) { const int r = i / 2048, d = i % 2048; const float v = r < 2 ? C.in[1][r * 2048 + d] : C.in[3][d]; sl[i] = siluf_(v); }
      __syncthreads();
      float* MOD = WSP(float, WS_MOD);
      const int kq = C.tid >> 4, cq = C.tid & 15;
      for (int u = blockIdx.x; u < 4 * (MODW / 64); u += gridDim.x) { const int l = u / (MODW / 64), e0 = (u % (MODW / 64)) * 64;
          const float* w = C.in[4] + (size_t)l * DM * MODW + e0 + 4 * cq;
          f32x4 a0 = {0, 0, 0, 0}, a1 = {0, 0, 0, 0}, a2 = {0, 0, 0, 0};
#pragma unroll 4
          for (int d = kq; d < DM; d += 32) { const f32x4 wv = *(const f32x4*)(w + (size_t)d * MODW); a0 += wv * sl[d]; a1 += wv * sl[2048 + d]; a2 += wv * sl[4096 + d]; }
#pragma unroll
          for (int j = 0; j < 4; ++j) { red[(kq * 3 + 0) * 64 + 4 * cq + j] = a0[j]; red[(kq * 3 + 1) * 64 + 4 * cq + j] = a1[j]; red[(kq * 3 + 2) * 64 + 4 * cq + j] = a2[j]; }
          __syncthreads();
          if (C.tid < 192) { const int r = C.tid / 64, c = C.tid % 64; float s = 0.f; for (int q = 0; q < 32; ++q) s += red[(q * 3 + r) * 64 + c];
              MOD[((size_t)l * 3 + r) * MODW + e0 + c] = s + C.in[5][l * MODW + e0 + c]; }
          __syncthreads(); } }
}

__device__ __forceinline__ void phase_norm_mod(const Ctx& C, const float* w, const float* mod, int sh_idx, int sc_idx) {
    const float* XS = WSP(float, WS_XS); bf16_t* H = WSP(bf16_t, WS_H);
    for (int R = C.gw; R < MROWS; R += C.ngw) {
        const int s = R % SROW, b = R / SROW, cond = s < CTX ? 2 : b;
        const float* shift = mod + (size_t)cond * MODW + sh_idx * DM; const float* scale = mod + (size_t)cond * MODW + sc_idx * DM;
        const f32x4* xr = (const f32x4*)(XS + (size_t)R * DM) + C.lane;
        f32x4 v[8]; float ss = 0.f;
#pragma unroll
        for (int j = 0; j < 8; ++j) { v[j] = xr[64 * j]; ss += (v[j].x * v[j].x + v[j].y * v[j].y) + (v[j].z * v[j].z + v[j].w * v[j].w); }
        const float rstd = 1.0f / sqrtf(wave_sum(ss) * (1.0f / DM) + EPS);
        u32x2* o = (u32x2*)(H + (size_t)R * DM) + C.lane;
#pragma unroll
        for (int j = 0; j < 8; ++j) { const int c = (C.lane + 64 * j) * 4; const f32x4 wv = *(const f32x4*)(w + c), sc = *(const f32x4*)(scale + c), sh = *(const f32x4*)(shift + c);
            const f32x4 y = (v[j] * rstd * wv) * (1.0f + sc) + sh; u32x2 pk; pk.x = pk2(y.x, y.y); pk.y = pk2(y.z, y.w); o[64 * j] = pk; }
    }
}

__device__ __forceinline__ void phase_rs_kr(const Ctx& C) {
    const bf16_t* P = WSP(bf16_t, WS_P);
    float* RSQ = WSP(float, WS_RSQ); float* RSKV = WSP(float, WS_RSKV);
    for (int R = C.gw; R < MROWS; R += C.ngw) {
        const u32x4 a = *(const u32x4*)(P + (size_t)R * ABNP + 2048 + 8 * C.lane), b = *(const u32x4*)(P + (size_t)R * ABNP + 2560 + 8 * C.lane);
        float sa = 0.f, sb = 0.f;
#pragma unroll
        for (int j = 0; j < 4; ++j) { const float a0 = __uint_as_float(a[j] << 16), a1 = __uint_as_float(a[j] & 0xffff0000u), b0 = __uint_as_float(b[j] << 16), b1 = __uint_as_float(b[j] & 0xffff0000u);
            sa += a0 * a0 + a1 * a1; sb += b0 * b0 + b1 * b1; }
        sa = wave_sum(sa); sb = wave_sum(sb);
        if (C.lane == 0) { RSQ[R] = 1.0f / sqrtf(sa * (1.0f / 512.0f) + EPS); RSKV[R] = 1.0f / sqrtf(sb * (1.0f / 512.0f) + EPS); } }
    bf16_t* KR = WSP(bf16_t, WS_KR); const float* RC = WSP(float, WS_ROPE); const float* RS = RC + 1024;
    for (int idx = C.gtid; idx < MROWS * 32; idx += C.ngt) { const int R = idx / 32, p = idx % 32, s = R % SROW; const int i0 = p < 16 ? p : 32 + (p - 16);
        const float x0 = bf2f(P[(size_t)R * ABNP + 3072 + i0]), x1 = bf2f(P[(size_t)R * ABNP + 3072 + i0 + 16]); float o0 = x0, o1 = x1;
        if (s >= CTX) { const int t = s - CTX, pos = p < 16 ? t / 64 : t % 64; const float c = RC[pos * 16 + (p & 15)], sn = RS[pos * 16 + (p & 15)]; o0 = x0 * c - x1 * sn; o1 = x1 * c + x0 * sn; }
        KR[(size_t)R * 64 + i0] = (bf16_t)f2bf(o0); KR[(size_t)R * 64 + i0 + 16] = (bf16_t)f2bf(o1); }
}

__device__ __forceinline__ void phase_attn(const Ctx& C) {
    const bf16_t* Q = WSP(bf16_t, WS_Q); const bf16_t* KV = WSP(bf16_t, WS_KV); const bf16_t* KR = WSP(bf16_t, WS_KR); bf16_t* Y = WSP(bf16_t, WS_Y);
    const float* RC = WSP(float, WS_ROPE); const float* RS = RC + 1024;
    const int G = gridDim.x, c = blockIdx.x;
    for (int u0 = c; u0 < 272; u0 += G) {
        int b, hh, s0, nk, tq0;
        if (u0 < 256) { int v = u0; if (G == 256) { const int x = c & 7, j = c >> 3; v = (x * 2 + (j >> 4)) * 16 + (j & 15); }
            const int p = v >> 4, qb = v & 15; b = p >> 3; hh = p & 7; s0 = CTX + qb * 256; nk = SROW; tq0 = qb * 256; }
        else { const int p = u0 - 256; b = p >> 3; hh = p & 7; s0 = 0; nk = CTX; tq0 = -1; }
        const size_t R0 = (size_t)b * SROW + s0, K0 = (size_t)b * SROW;
        __syncthreads();
        att::attn_body(Q + R0 * QW + hh * 192, KV + K0 * KVW + hh * 256, KR + K0 * 64, Y + R0 * DM + DLRU + hh * 128, nk, tq0, RC, RS, (char*)C.lds, C.tid);
    }
}
namespace hg {
using s16x4  = __attribute__((ext_vector_type(4))) short;
using f32x16 = __attribute__((ext_vector_type(16))) float;
constexpr int NCH = SROW / 64;
constexpr int NCHAIN = NBATCH * 16 * 2;
__device__ __forceinline__ unsigned off_b(unsigned row, unsigned ch) { return 256u * row + 16u * (ch ^ (((row & 3u) << 2) | ((row >> 2) & 3u))); }
__device__ __forceinline__ s16x4 trr(unsigned addr) { s16x4 r; asm volatile("ds_read_b64_tr_b16 %0, %1" : "=&v"(r) : "v"(addr) : "memory"); return r; }
__device__ __forceinline__ bf16x8 pk8(s16x4 L, s16x4 H) { return (bf16x8){L[0], L[1], L[2], L[3], H[0], H[1], H[2], H[3]}; }
__device__ __forceinline__ unsigned tr_nat(unsigned lane, unsigned c, unsigned ks, unsigned t) {
    const unsigned h = lane >> 5, blk = (lane >> 4) & 1, q = (lane & 15) >> 2, p = lane & 3;
    return off_b(16 * ks + 8 * h + 4 * t + q, 4 * c + 2 * blk + (p >> 1)) + 8 * (p & 1); }
__device__ __forceinline__ unsigned tr_perm(unsigned lane, unsigned c, unsigned rb, unsigned t) {
    const unsigned h = lane >> 5, blk = (lane >> 4) & 1, q = (lane & 15) >> 2, p = lane & 3;
    return off_b(rb + 4 * h + 8 * t + q, 4 * c + 2 * blk + (p >> 1)) + 8 * (p & 1); }
__device__ __forceinline__ unsigned row_rd(unsigned lane, unsigned rb, unsigned ks) { return off_b(rb + (lane & 31), 2 * ks + (lane >> 5)); }
__device__ __forceinline__ int crow(int r, int hi) { return (r & 3) + 8 * (r >> 2) + 4 * hi; }
#define HG_WAITL() do { asm volatile("s_waitcnt lgkmcnt(0)" ::: "memory"); __builtin_amdgcn_sched_barrier(0); } while (0)
}

__device__ __forceinline__ void phase_hg_ds(const Ctx& C) {
    using namespace hg;
    LAS unsigned char* L = C.lds; const unsigned Lb = (unsigned)(uintptr_t)L;
    constexpr unsigned VT = 0, KP = 16384, TOT = 32768;
    const float* LOGF = WSP(float, WS_LOGF); const bf16_t* VH = WSP(bf16_t, WS_VH); float* DS = WSP(float, WS_DS); float* DEC = WSP(float, WS_DEC);
    const int w = C.wave, lane = C.lane, tid = C.tid, h5 = lane >> 5, r32 = lane & 31;
    for (int u = blockIdx.x; u < NBATCH * 16 * NCH; u += gridDim.x) {
        const int b = u / (16 * NCH), hh = (u / NCH) % 16, ci = u % NCH; const size_t R0 = (size_t)b * SROW + ci * 64;
        __syncthreads();
#pragma unroll
        for (int p = 0; p < 2; ++p) { const int row = (tid >> 4) + 32 * p, ch = tid & 15; const u32x4 v = *(const u32x4*)(VH + (R0 + row) * DM + hh * 128 + ch * 8); *(LAS u32x4*)(L + VT + off_b(row, ch)) = v; }
#pragma unroll 1
        for (int dir = 0; dir < 2; ++dir) {
            const int chain = (b * 16 + hh) * 2 + dir;
            const float* lfp = LOGF + (size_t)dir * MROWS * DM + (R0 + 8 * w) * DM + hh * 128 + 2 * lane;
            f32x2 lf[8]; f32x2 T = {0.f, 0.f};
#pragma unroll
            for (int i = 0; i < 8; ++i) { lf[i] = *(const f32x2*)(lfp + (size_t)i * DM); T += lf[i]; }
            *(LAS f32x2*)(L + TOT + (w * 128 + 2 * lane) * 4) = T;
            __syncthreads();
            f32x2 off = {0.f, 0.f}, total = {0.f, 0.f};
#pragma unroll
            for (int ww = 0; ww < 8; ++ww) { const f32x2 t = *(const LAS f32x2*)(L + TOT + (ww * 128 + 2 * lane) * 4); total += t; if (dir == 0 ? (ww > w) : (ww < w)) off += t; }
            f32x2 E[8];
            if (dir == 0) { E[7] = off;
#pragma unroll
                for (int i = 6; i >= 0; --i) E[i] = E[i + 1] + lf[i + 1]; }
            else { E[0] = off;
#pragma unroll
                for (int i = 1; i < 8; ++i) E[i] = E[i - 1] + lf[i - 1]; }
#pragma unroll
            for (int i = 0; i < 8; ++i) { const float k0 = (1.0f - __expf(lf[i].x)) * __expf(E[i].x), k1 = (1.0f - __expf(lf[i].y)) * __expf(E[i].y);
                *(LAS unsigned*)(L + KP + off_b(8 * w + i, lane >> 2) + (lane & 3) * 4) = pk2(k0, k1); }
            if (w == 0) { f32x2 d; d.x = __expf(total.x); d.y = __expf(total.y); *(f32x2*)(DEC + ((size_t)chain * NCH + ci) * 128 + 2 * lane) = d; }
            __syncthreads();
            const unsigned dkt = w >> 1, c0 = (w & 1) * 2;
            s16x4 al[4], ah[4], b0l[4], b0h[4], b1l[4], b1h[4];
#pragma unroll
            for (int ks = 0; ks < 4; ++ks) { al[ks] = trr(Lb + KP + tr_nat(lane, dkt, ks, 0)); ah[ks] = trr(Lb + KP + tr_nat(lane, dkt, ks, 1));
                b0l[ks] = trr(Lb + VT + tr_nat(lane, c0, ks, 0)); b0h[ks] = trr(Lb + VT + tr_nat(lane, c0, ks, 1));
                b1l[ks] = trr(Lb + VT + tr_nat(lane, c0 + 1, ks, 0)); b1h[ks] = trr(Lb + VT + tr_nat(lane, c0 + 1, ks, 1)); }
            HG_WAITL();
            f32x16 a0 = {}, a1 = {};
#pragma unroll
            for (int ks = 0; ks < 4; ++ks) { const bf16x8 A = pk8(al[ks], ah[ks]);
                a0 = __builtin_amdgcn_mfma_f32_32x32x16_bf16(A, pk8(b0l[ks], b0h[ks]), a0, 0, 0, 0);
                a1 = __builtin_amdgcn_mfma_f32_32x32x16_bf16(A, pk8(b1l[ks], b1h[ks]), a1, 0, 0, 0); }
            float* dsp = DS + ((size_t)chain * NCH + ci) * 16384;
#pragma unroll
            for (int r = 0; r < 16; ++r) { const int dk = 32 * dkt + crow(r, h5); dsp[dk * 128 + 32 * c0 + r32] = a0[r]; dsp[dk * 128 + 32 * (c0 + 1) + r32] = a1[r]; }
        }
    }
}
__device__ __forceinline__ void phase_hg_scan(const Ctx& C) {
    using namespace hg;
    const float* DS = WSP(float, WS_DS); const float* DEC = WSP(float, WS_DEC); bf16_t* SS = WSP(bf16_t, WS_SS);
    for (int g = C.gtid; g < NCHAIN * 2048; g += C.ngt) { const int chain = g >> 11, within = g & 2047, dk = within >> 4, dv0 = (within & 15) * 8, dir = chain & 1;
        f32x4 s0 = {0.f, 0.f, 0.f, 0.f}, s1 = {0.f, 0.f, 0.f, 0.f};
#pragma unroll 4
        for (int j = 0; j < NCH; ++j) { const int ci = dir == 0 ? j : (j < 4 ? 3 - j : 71 - j); const size_t cb = (size_t)chain * NCH + ci; const size_t idx = (cb * 128 + dk) * 128 + dv0;
            u32x4 o; o.x = pk2(s0.x, s0.y); o.y = pk2(s0.z, s0.w); o.z = pk2(s1.x, s1.y); o.w = pk2(s1.z, s1.w); *(u32x4*)(SS + idx) = o;
            const float d = DEC[cb * 128 + dk]; const f32x4 d0 = *(const f32x4*)(DS + idx), d1 = *(const f32x4*)(DS + idx + 4);
            s0 = s0 * d + d0; s1 = s1 * d + d1; } }
}
__device__ __forceinline__ void phase_hg_out(const Ctx& C, int o_idx) {
    using namespace hg;
    LAS unsigned char* L = C.lds; const unsigned Lb = (unsigned)(uintptr_t)L;
    constexpr unsigned VT = 0, QP = 16384, QM = 32768, KM = 49152, ST = 65536, TOT = 98304, RED = 102400;
    const float* LOGF = WSP(float, WS_LOGF); const bf16_t* VH = WSP(bf16_t, WS_VH); const bf16_t* QH = WSP(bf16_t, WS_QH); const bf16_t* GH = WSP(bf16_t, WS_GH);
    const bf16_t* SS = WSP(bf16_t, WS_SS); bf16_t* Y = WSP(bf16_t, WS_Y); const float* nw = C.in[23] + o_idx * 128;
    const int w = C.wave, lane = C.lane, tid = C.tid, h5 = lane >> 5, r32 = lane & 31;
    const unsigned tt = w >> 2, dvt = w & 3;
    for (int u = blockIdx.x; u < NBATCH * 16 * NCH; u += gridDim.x) {
        const int b = u / (16 * NCH), hh = (u / NCH) % 16, ci = u % NCH; const size_t R0 = (size_t)b * SROW + ci * 64;
        __syncthreads();
#pragma unroll
        for (int p = 0; p < 2; ++p) { const int row = (tid >> 4) + 32 * p, ch = tid & 15; const u32x4 v = *(const u32x4*)(VH + (R0 + row) * DM + hh * 128 + ch * 8); *(LAS u32x4*)(L + VT + off_b(row, ch)) = v; }
        f32x16 acc = {};
#pragma unroll 1
        for (int dir = 0; dir < 2; ++dir) {
            const int chain = (b * 16 + hh) * 2 + dir;
            u32x4 sreg[4];
#pragma unroll
            for (int p = 0; p < 4; ++p) sreg[p] = *(const u32x4*)(SS + (((size_t)chain * NCH + ci) * 128 + (tid >> 4) + 32 * p) * 128 + (tid & 15) * 8);
            const float* lfp = LOGF + (size_t)dir * MROWS * DM + (R0 + 8 * w) * DM + hh * 128 + 2 * lane;
            const bf16_t* qp = QH + (R0 + 8 * w) * DM + hh * 128 + 2 * lane;
            f32x2 lf[8]; unsigned qv[8]; f32x2 T = {0.f, 0.f};
#pragma unroll
            for (int i = 0; i < 8; ++i) { lf[i] = *(const f32x2*)(lfp + (size_t)i * DM); qv[i] = *(const unsigned*)(qp + (size_t)i * DM); T += lf[i]; }
            *(LAS f32x2*)(L + TOT + (w * 128 + 2 * lane) * 4) = T;
            __syncthreads();
            f32x2 off = {0.f, 0.f}, mid = {0.f, 0.f};
#pragma unroll
            for (int ww = 0; ww < 8; ++ww) { const f32x2 t = *(const LAS f32x2*)(L + TOT + (ww * 128 + 2 * lane) * 4);
                if (dir == 0 ? (ww < w) : (ww > w)) off += t; if (dir == 0 ? (ww < 4) : (ww >= 4)) mid += t; }
            f32x2 B[8];
            if (dir == 0) { B[0] = off + lf[0];
#pragma unroll
                for (int i = 1; i < 8; ++i) B[i] = B[i - 1] + lf[i]; }
            else { B[7] = off + lf[7];
#pragma unroll
                for (int i = 6; i >= 0; --i) B[i] = B[i + 1] + lf[i]; }
#pragma unroll
            for (int i = 0; i < 8; ++i) { const float q0 = __uint_as_float(qv[i] << 16), q1 = __uint_as_float(qv[i] & 0xffff0000u);
                const float k0 = 1.0f - __expf(lf[i].x), k1 = 1.0f - __expf(lf[i].y);
                const unsigned a = off_b(8 * w + i, lane >> 2) + (lane & 3) * 4;
                *(LAS unsigned*)(L + QP + a) = pk2(q0 * __expf(B[i].x), q1 * __expf(B[i].y));
                *(LAS unsigned*)(L + QM + a) = pk2(q0 * __expf(B[i].x - mid.x), q1 * __expf(B[i].y - mid.y));
                *(LAS unsigned*)(L + KM + a) = pk2(k0 * __expf(mid.x - B[i].x), k1 * __expf(mid.y - B[i].y)); }
#pragma unroll
            for (int p = 0; p < 4; ++p) *(LAS u32x4*)(L + ST + off_b((tid >> 4) + 32 * p, tid & 15)) = sreg[p];
            __syncthreads();
            { bf16x8 a[8]; s16x4 bl[8], bh[8];
#pragma unroll
              for (int ks = 0; ks < 8; ++ks) { a[ks] = *(const LAS bf16x8*)(L + QP + row_rd(lane, 32 * tt, ks)); bl[ks] = trr(Lb + ST + tr_nat(lane, dvt, ks, 0)); bh[ks] = trr(Lb + ST + tr_nat(lane, dvt, ks, 1)); }
              HG_WAITL();
#pragma unroll
              for (int ks = 0; ks < 8; ++ks) acc = __builtin_amdgcn_mfma_f32_32x32x16_bf16(a[ks], pk8(bl[ks], bh[ks]), acc, 0, 0, 0); }
            { bf16x8 qb[8];
#pragma unroll
              for (int ks = 0; ks < 8; ++ks) qb[ks] = *(const LAS bf16x8*)(L + QM + row_rd(lane, 32 * tt, ks));
#pragma unroll
              for (unsigned st = 0; st < 2; ++st) { const bool valid = dir == 0 ? (st <= tt) : (st >= tt);
                if (valid) {
                  f32x16 x = {};
#pragma unroll
                  for (int ks = 0; ks < 8; ++ks) { const bf16x8 ka = *(const LAS bf16x8*)(L + KM + row_rd(lane, 32 * st, ks)); x = __builtin_amdgcn_mfma_f32_32x32x16_bf16(ka, qb[ks], x, 0, 0, 0); }
                  if (st == tt) {
#pragma unroll
                    for (int r = 0; r < 16; ++r) { const int kr = crow(r, h5); const bool keep = dir == 0 ? (kr <= r32) : (kr >= r32); x[r] = keep ? x[r] : 0.f; } }
                  const s16x4 v0l = trr(Lb + VT + tr_perm(lane, dvt, 32 * st, 0)), v0h = trr(Lb + VT + tr_perm(lane, dvt, 32 * st, 1));
                  const s16x4 v1l = trr(Lb + VT + tr_perm(lane, dvt, 32 * st + 16, 0)), v1h = trr(Lb + VT + tr_perm(lane, dvt, 32 * st + 16, 1));
                  u32x4 A0, A1; A0.x = pk2(x[0], x[1]); A0.y = pk2(x[2], x[3]); A0.z = pk2(x[4], x[5]); A0.w = pk2(x[6], x[7]);
                  A1.x = pk2(x[8], x[9]); A1.y = pk2(x[10], x[11]); A1.z = pk2(x[12], x[13]); A1.w = pk2(x[14], x[15]);
                  HG_WAITL();
                  acc = __builtin_amdgcn_mfma_f32_32x32x16_bf16(*reinterpret_cast<bf16x8*>(&A0), pk8(v0l, v0h), acc, 0, 0, 0);
                  acc = __builtin_amdgcn_mfma_f32_32x32x16_bf16(*reinterpret_cast<bf16x8*>(&A1), pk8(v1l, v1h), acc, 0, 0, 0);
                } } }
        }
        LAS float* red = (LAS float*)(L + RED);
#pragma unroll
        for (int r = 0; r < 16; ++r) { float s = acc[r] * acc[r]; s += __shfl_xor(s, 1); s += __shfl_xor(s, 2); s += __shfl_xor(s, 4); s += __shfl_xor(s, 8); s += __shfl_xor(s, 16);
            if (r32 == 0) red[(tt * 32 + crow(r, h5)) * 4 + dvt] = s; }
        __syncthreads();
        const int col = hh * 128 + 32 * dvt + r32; const float wv = nw[32 * dvt + r32];
#pragma unroll
        for (int r = 0; r < 16; ++r) { const int row = 32 * tt + crow(r, h5); const f32x4 p = *(const LAS f32x4*)(red + row * 4);
            const float rstd = 1.0f / sqrtf(((p.x + p.y) + (p.z + p.w)) * (1.0f / 128.0f) + EPS); const size_t o = (R0 + row) * DM + col;
            Y[o] = (bf16_t)f2bf(acc[r] * rstd * wv * bf2f(GH[o])); }
    }
}
template <bool FINAL>
__device__ __forceinline__ void phase_lru(const Ctx& C, int e) {
    using namespace hg;
    LAS unsigned char* L = C.lds;
    constexpr unsigned UCB = 0, UCF = 16384, AT = 49152, BT = 81920;
    const bf16_t* P = WSP(bf16_t, WS_P); float* AG = WSP(float, WS_AG); bf16_t* Y = WSP(bf16_t, WS_Y);
    const bf16_t* WG = WSP(bf16_t, WS_WG) + (size_t)e * 4 * 128 * 1024;
    const float* cw = C.in[10] + (size_t)e * 4 * DLRU; const float* cb = C.in[11] + (size_t)e * DLRU;
    const float* ba = C.in[13] + (size_t)e * 2 * DLRU; const float* bx = C.in[15] + (size_t)e * 2 * DLRU; const float* lam = C.in[16] + (size_t)e * 2 * DLRU;
    const int w = C.wave, lane = C.lane, tid = C.tid, h5 = lane >> 5, r32 = lane & 31;
    const unsigned rt = w >> 2, et = w & 3;
    for (int u = blockIdx.x; u < (MROWS / 64) * 8; u += gridDim.x) {
        const int ci2 = u >> 3, hd = u & 7; const int c = ci2 % NCH, bb = ci2 / NCH; const size_t R0 = (size_t)ci2 * 64;
        const int s0 = c * 64, lo = c < 4 ? 0 : CTX, hi = c < 4 ? CTX : SROW;
        __syncthreads();
        float cin = 0.f;
        if (FINAL && tid < 256) { const int dir = tid >> 7, ch = tid & 127; const int jpos = dir == 0 ? c : (c < 4 ? 3 - c : 71 - c);
            for (int j = 0; j < jpos; ++j) { const int cc = dir == 0 ? j : (j < 4 ? 3 - j : 71 - j); const float* ag = AG + ((size_t)((bb * NCH + cc) * 2 + dir) * 2) * DLRU + hd * 128 + ch;
                cin = cin * ag[0] + ag[DLRU]; } }
        { const int chn = hd * 128 + 2 * lane; const bf16_t* up = P + DLRU + chn;
          f32x2 uv[11];
#pragma unroll
          for (int i = 0; i < 11; ++i) { const int s = s0 + 8 * w + i - 2; unsigned raw = 0u; if (s >= lo && s < hi) raw = *(const unsigned*)(up + ((size_t)bb * SROW + s) * ABNP);
              uv[i].x = __uint_as_float(raw << 16); uv[i].y = __uint_as_float(raw & 0xffff0000u); }
          f32x2 wj[4];
#pragma unroll
          for (int j = 0; j < 4; ++j) wj[j] = *(const f32x2*)(cw + j * DLRU + chn);
          const f32x2 bias = *(const f32x2*)(cb + chn);
#pragma unroll
          for (int i = 0; i < 8; ++i) { f32x2 a = bias;
#pragma unroll
              for (int j = 0; j < 4; ++j) a += uv[i + j] * wj[j];
              *(LAS unsigned*)(L + UCB + off_b(8 * w + i, lane >> 2) + (lane & 3) * 4) = pk2(a.x, a.y);
              *(LAS f32x2*)(L + UCF + ((8 * w + i) * 128 + 2 * lane) * 4) = a; } }
        __syncthreads();
        bf16x8 af[8]; float ucr[16];
#pragma unroll
        for (int ks = 0; ks < 8; ++ks) af[ks] = *(const LAS bf16x8*)(L + UCB + row_rd(lane, 32 * rt, ks));
#pragma unroll
        for (int r = 0; r < 16; ++r) ucr[r] = *(const LAS float*)(L + UCF + ((32 * rt + crow(r, h5)) * 128 + 32 * et + r32) * 4);
        const int chl = hd * 128 + 32 * et + r32;
#pragma unroll 1
        for (int dir = 0; dir < 2; ++dir) {
            f32x16 ga = {}, gx = {};
            { const bf16_t* wa = WG + ((size_t)(dir * 2 + 0) * 128 + 32 * et + r32) * 1024 + hd * 128 + 8 * h5; const bf16_t* wx = wa + (size_t)128 * 1024;
              bf16x8 fa[8], fx[8];
#pragma unroll
              for (int ks = 0; ks < 8; ++ks) { fa[ks] = *(const bf16x8*)(wa + 16 * ks); fx[ks] = *(const bf16x8*)(wx + 16 * ks); }
#pragma unroll
              for (int ks = 0; ks < 8; ++ks) { ga = __builtin_amdgcn_mfma_f32_32x32x16_bf16(af[ks], fa[ks], ga, 0, 0, 0); gx = __builtin_amdgcn_mfma_f32_32x32x16_bf16(af[ks], fx[ks], gx, 0, 0, 0); } }
            const float bav = ba[dir * DLRU + chl], bxv = bx[dir * DLRU + chl], sp = log1pf(__expf(-lam[dir * DLRU + chl]));
            if (dir == 1) __syncthreads();
#pragma unroll
            for (int r = 0; r < 16; ++r) { const float rg = 1.0f / (1.0f + __expf(-(ga[r] + bav))), ig = 1.0f / (1.0f + __expf(-(gx[r] + bxv)));
                const float la = -8.0f * rg * sp; const unsigned o = ((32 * rt + crow(r, h5)) * 128 + 32 * et + r32) * 4;
                *(LAS float*)(L + AT + o) = __expf(la); *(LAS float*)(L + BT + o) = sqrtf(-expm1f(2.0f * la)) * (ig * ucr[r]); }
            __syncthreads();
            if ((tid >> 7) == dir) { const int ch = tid & 127; const LAS float* ap = (const LAS float*)(L + AT) + ch; const LAS float* bp = (const LAS float*)(L + BT) + ch;
                if (!FINAL) { float h = 0.f, ap_ = 1.f;
#pragma unroll 16
                    for (int i = 0; i < 64; ++i) { const int row = dir == 0 ? i : 63 - i; const float a = ap[row * 128]; h = a * h + bp[row * 128]; ap_ *= a; }
                    float* ag = AG + ((size_t)(ci2 * 2 + dir) * 2) * DLRU + hd * 128 + ch; ag[0] = ap_; ag[DLRU] = h; }
                else if (dir == 0) { float h = cin; LAS float* hp = (LAS float*)(L + UCF) + ch;
#pragma unroll 16
                    for (int i = 0; i < 64; ++i) { h = ap[i * 128] * h + bp[i * 128]; hp[i * 128] = h; } }
                else { float h = cin; const LAS float* hp = (const LAS float*)(L + UCF) + ch; const bf16_t* gp = P + R0 * ABNP + hd * 128 + ch; bf16_t* yp = Y + R0 * DM + hd * 128 + ch;
#pragma unroll 8
                    for (int i = 63; i >= 0; --i) { h = ap[i * 128] * h + bp[i * 128]; const float hs = hp[i * 128] + h; yp[(size_t)i * DM] = (bf16_t)f2bf(hs * gelu_tanh(bf2f(gp[(size_t)i * ABNP]))); } } }
        }
    }
}
__device__ __forceinline__ void phase_final(const Ctx& C) {
    const float* XS = WSP(float, WS_XS); const float* w = C.in[27];
    for (int r = C.gw; r < NBATCH * SEQ; r += C.ngw) { const int b = r / SEQ, t = r % SEQ; const size_t R = (size_t)b * SROW + CTX + t;
        const f32x4* xr = (const f32x4*)(XS + R * DM) + C.lane; f32x4 v[8]; float ss = 0.f;
#pragma unroll
        for (int j = 0; j < 8; ++j) { v[j] = xr[64 * j]; ss += (v[j].x * v[j].x + v[j].y * v[j].y) + (v[j].z * v[j].z + v[j].w * v[j].w); }
        const float rstd = 1.0f / sqrtf(wave_sum(ss) * (1.0f / DM) + EPS);
        f32x4* o = (f32x4*)(C.out + (size_t)r * DM) + C.lane;
#pragma unroll
        for (int j = 0; j < 8; ++j) { const f32x4 wv = *(const f32x4*)(w + (C.lane + 64 * j) * 4); o[64 * j] = v[j] * rstd * wv; } }
}

struct Args { const float* in[28]; float* out; unsigned char* ws; int ph_lo, ph_hi; };
constexpr int N_PHASES = 1 + 2 * 9 + 2 * 9 + 1;

__global__ void __launch_bounds__(512, 2) fwd_kernel(Args args) {
    extern __shared__ __attribute__((aligned(16))) unsigned char lds_raw[];
    LAS unsigned char* const lds0 = (LAS unsigned char*)lds_raw;
    const unsigned long long inaddr = (unsigned long long)__builtin_amdgcn_kernarg_segment_ptr();
    volatile LAS unsigned* misc = (volatile LAS unsigned*)(lds0 + LDS_MISC);
    if (threadIdx.x < 64) misc[threadIdx.x] = 0u;
    __syncthreads();
    const int lo = args.ph_lo, hi = args.ph_hi;
    const int wave0 = __builtin_amdgcn_readfirstlane(threadIdx.x >> 6);
    XcdBarrier bar; bar.bar = (unsigned*)(args.ws + WS_CTL) + 4096; bar.x = 0; bar.st = misc + 8;
    if (hi - lo > 1) bar = xcd_barrier_post((unsigned*)(args.ws + WS_CTL) + 4096, misc + 8);
    int pid = 0;
    const unsigned long long wsaddr = (unsigned long long)args.ws;
#define PH_BEGIN if (pid >= lo && pid < hi) { int l = l_; Ctx C; { unsigned long long a_ = inaddr, w_ = wsaddr; int t_; asm volatile("v_mbcnt_lo_u32_b32 %0, -1, 0\n\tv_mbcnt_hi_u32_b32 %0, -1, %0" : "=v"(t_)); t_ += wave0 * 64; asm volatile("" : "+s"(a_), "+s"(w_), "+s"(l)); \
        C.in = (InPtr)a_; C.ws = (unsigned char*)w_; C.out = args.out; C.lds = lds0; C.tid = t_; C.lane = t_ & 63; C.wave = __builtin_amdgcn_readfirstlane(t_ >> 6); \
        C.gw = blockIdx.x * 8 + C.wave; C.ngw = gridDim.x * 8; C.gtid = blockIdx.x * 512 + t_; C.ngt = gridDim.x * 512; } \
        const int e = l >> 1; const float* mod = WSP(float, WS_MOD) + (size_t)l * 3 * MODW; const int G = gridDim.x, cb = blockIdx.x; (void)e; (void)mod; (void)G; (void)cb;
#define PH_END } if (pid >= lo && pid + 1 < hi) xcd_barrier(bar); ++pid;
    int l_ = 0;
    PH_BEGIN
#ifndef SKIP_PRO
    phase_prologue(C);
#endif
    PH_END

    constexpr int MLAT = NBATCH * SEQ;
    for (l_ = 0; l_ < DEPTH; ++l_) {
        PH_BEGIN phase_norm_mod(C, C.in[6] + l * DM, mod, 0, 1); PH_END
        if ((l_ & 1) == 0) {
            PH_BEGIN { const bf16_t* wt = WSP(bf16_t, WS_WABIN) + (size_t)e * ABNP * DM;
                       { pg8::Gemm g{WSP(bf16_t, WS_H), wt, MLAT, ABNP, DM, DM, DM, 1}; pg8::StaticOrder S; S.init(MLAT, ABNP, G, cb); EpiBf16Plain E{WSP(bf16_t, WS_P), ABNP}; pg8::gemm_phase(C.lds, C.tid, g, S, E); }
                       { sg::SGemm g{WSP(bf16_t, WS_H), wt, ABNP, DM, DM, DM}; SEpiPlain E{WSP(bf16_t, WS_P), ABNP}; sg::sgemm_phase(C.lds, C.tid, g, 32 * (ABNP / 256), E); } } PH_END
            PH_BEGIN phase_lru<false>(C, e); phase_rs_kr(C); PH_END
            PH_BEGIN { const bf16_t* wq = WSP(bf16_t, WS_WUQ) + (size_t)e * QW * 512; const bf16_t* wkv = WSP(bf16_t, WS_WUKV) + (size_t)e * KVW * 512;
                       { pg8::Gemm g{WSP(bf16_t, WS_P) + 2048, wq, MLAT, QW, 512, ABNP, 512, 1}; pg8::StaticOrder S; S.init(MLAT, QW, G, cb); EpiBf16RowScale E{WSP(bf16_t, WS_Q), QW, WSP(float, WS_RSQ)}; pg8::gemm_phase(C.lds, C.tid, g, S, E); }
                       { pg8::Gemm g{WSP(bf16_t, WS_P) + 2560, wkv, MLAT, KVW, 512, ABNP, 512, 1}; pg8::StaticOrder S; S.init(MLAT, KVW, G, cb); EpiBf16RowScale E{WSP(bf16_t, WS_KV), KVW, WSP(float, WS_RSKV)}; pg8::gemm_phase(C.lds, C.tid, g, S, E); }
                       { sg::SGemm g{WSP(bf16_t, WS_P) + 2048, wq, QW, 512, ABNP, 512}; SEpiRowScale E{WSP(bf16_t, WS_Q), QW, WSP(float, WS_RSQ)}; sg::sgemm_phase(C.lds, C.tid, g, 32 * (QW / 256), E); }
                       { sg::SGemm g{WSP(bf16_t, WS_P) + 2560, wkv, KVW, 512, ABNP, 512}; SEpiRowScale E{WSP(bf16_t, WS_KV), KVW, WSP(float, WS_RSKV)}; sg::sgemm_phase(C.lds, C.tid, g, 0, E); } }
                     phase_lru<true>(C, e); PH_END
            PH_BEGIN phase_attn(C); PH_END
        } else {
            PH_BEGIN { const bf16_t* wt = WSP(bf16_t, WS_WHGIN) + (size_t)e * HGN * DM;
                       { pg8::Gemm g{WSP(bf16_t, WS_H), wt, MLAT, HGN, DM, DM, DM, 1}; pg8::StaticOrder S; S.init(MLAT, HGN, G, cb); EpiHG E{WSP(bf16_t, WS_QH), WSP(float, WS_LOGF), WSP(float, WS_LB) + l * 2048}; pg8::gemm_phase(C.lds, C.tid, g, S, E); }
                       { sg::SGemm g{WSP(bf16_t, WS_H), wt, HGN, DM, DM, DM}; SEpiHG E{WSP(bf16_t, WS_QH), WSP(float, WS_LOGF), WSP(float, WS_LB) + l * 2048}; sg::sgemm_phase(C.lds, C.tid, g, 32 * (HGN / 256), E); } } PH_END
            PH_BEGIN phase_hg_ds(C); PH_END
            PH_BEGIN phase_hg_scan(C); PH_END
            PH_BEGIN phase_hg_out(C, e); PH_END
        }
        PH_BEGIN { const bf16_t* wout = (l & 1) ? WSP(bf16_t, WS_WHGOUT) + (size_t)e * DM * DM : WSP(bf16_t, WS_WABOUT) + (size_t)e * DM * DM;
                   { pg8::Gemm g{WSP(bf16_t, WS_Y), wout, MLAT, DM, DM, DM, DM, 1}; pg8::StaticOrder S; S.init(MLAT, DM, G, cb); EpiResid E{WSP(float, WS_XS), mod + 2 * DM}; pg8::gemm_phase(C.lds, C.tid, g, S, E); }
                   if (l != DEPTH - 1) { sg::SGemm g{WSP(bf16_t, WS_Y), wout, DM, DM, DM, DM}; SEpiResid E{WSP(float, WS_XS), mod + 2 * DM}; sg::sgemm_phase(C.lds, C.tid, g, 32 * (DM / 256), E); } } PH_END
        PH_BEGIN phase_norm_mod(C, C.in[7] + l * DM, mod, 3, 4); PH_END
        PH_BEGIN { const bf16_t* wt = WSP(bf16_t, WS_W1) + (size_t)l * DFF * DM;
                   { pg8::Gemm g{WSP(bf16_t, WS_H), wt, MLAT, DFF, DM, DM, DM, 1}; pg8::StaticOrder S; S.init(MLAT, DFF, G, cb); EpiRelu2 E{WSP(bf16_t, WS_HID), DFF}; pg8::gemm_phase(C.lds, C.tid, g, S, E); }
                   if (l != DEPTH - 1) { sg::SGemm g{WSP(bf16_t, WS_H), wt, DFF, DM, DM, DM}; SEpiRelu2 E{WSP(bf16_t, WS_HID), DFF}; sg::sgemm_phase(C.lds, C.tid, g, 32 * (DFF / 256), E); } } PH_END
        PH_BEGIN { const bf16_t* wt = WSP(bf16_t, WS_W2) + (size_t)l * DM * DFF;
                   { pg8::Gemm g{WSP(bf16_t, WS_HID), wt, MLAT, DM, DFF, DFF, DFF, 1}; pg8::StaticOrder S; S.init(MLAT, DM, G, cb); EpiResid E{WSP(float, WS_XS), mod + 5 * DM}; pg8::gemm_phase(C.lds, C.tid, g, S, E); }
                   if (l != DEPTH - 1) { sg::SGemm g{WSP(bf16_t, WS_HID), wt, DM, DFF, DFF, DFF}; SEpiResid E{WSP(float, WS_XS), mod + 5 * DM}; sg::sgemm_phase(C.lds, C.tid, g, 32 * (DM / 256), E); } } PH_END
    }
    l_ = 0;
    PH_BEGIN phase_final(C); PH_END
}

#ifndef N_LAUNCH_MODE
#define N_LAUNCH_MODE 1
#endif
extern "C" void kernel_launch(void* const* d_in, const int* in_sizes, int n_in, void* d_out, int out_size, void* d_ws, size_t ws_size, hipStream_t stream) {
    static int grid = 0;
    if (grid == 0) {
        if (n_in != 28 || out_size != NBATCH * SEQ * DM || ws_size < WS_END) { fprintf(stderr, "kernel_launch: shape mismatch n_in %d out %d ws %zu (need %zu)\n", n_in, out_size, ws_size, (size_t)WS_END); grid = -1; return; }
        int dev = 0, cus = 0, per_cu = 0;
        if (hipGetDevice(&dev) != hipSuccess || hipDeviceGetAttribute(&cus, hipDeviceAttributeMultiprocessorCount, dev) != hipSuccess) { grid = -1; return; }
        if (hipFuncSetAttribute((const void*)fwd_kernel, hipFuncAttributeMaxDynamicSharedMemorySize, LDS_BYTES) != hipSuccess) { fprintf(stderr, "kernel_launch: hipFuncSetAttribute failed\n"); grid = -1; return; }
        if (hipOccupancyMaxActiveBlocksPerMultiprocessor(&per_cu, (const void*)fwd_kernel, 512, LDS_BYTES) != hipSuccess || per_cu < 1) fprintf(stderr, "kernel_launch: occupancy query says %d\n", per_cu);
        (void)hipGetLastError();
        grid = cus;
    }
    if (grid < 0) return;
    (void)hipMemsetAsync((char*)d_ws + WS_CTL, 0, CTL_BYTES, stream);
    Args a{};
    for (int i = 0; i < 28; ++i) a.in[i] = (const float*)d_in[i];
    a.out = (float*)d_out; a.ws = (unsigned char*)d_ws;
#if N_LAUNCH_MODE == 1
    a.ph_lo = 0; a.ph_hi = N_PHASES;
    hipLaunchKernelGGL(fwd_kernel, dim3(grid), dim3(512), LDS_BYTES, stream, a);
#else
    for (int p = 0; p < N_PHASES; ++p) { a.ph_lo = p; a.ph_hi = p + 1; hipLaunchKernelGGL(fwd_kernel, dim3(grid), dim3(512), LDS_BYTES, stream, a); }
#endif
    const hipError_t le = hipPeekAtLastError();
    if (le != hipSuccess) fprintf(stderr, "kernel_launch: launch failed: %s\n", hipGetErrorName(le));
}
```

```cpp
#include <hip/hip_runtime.h>
#include <cstdio>

#define LAS __attribute__((address_space(3)))
typedef unsigned short bf16_t;
typedef short bf16x8 __attribute__((ext_vector_type(8)));
typedef float f32x4 __attribute__((ext_vector_type(4)));
typedef float f32x2 __attribute__((ext_vector_type(2)));
typedef unsigned u32x4 __attribute__((ext_vector_type(4)));
typedef unsigned u32x2 __attribute__((ext_vector_type(2)));

constexpr int DM = 2048, NBATCH = 2, SEQ = 4096, DEPTH = 4, CTX = 256;
constexpr int SROW = CTX + SEQ;
constexpr int MROWS = NBATCH * SROW;
constexpr int DFF = 8192, MODW = 6 * DM;
constexpr int DLRU = 1024;
constexpr int ABN = 3136, ABNP = 3328;
constexpr int QW = 1536, KVW = 2048, HGN = 10240;
constexpr float EPS = 1e-6f;
constexpr float ATTN_SCALE = 0.07216878364870322f;

constexpr size_t al256(size_t x) { return (x + 255) & ~(size_t)255; }
constexpr size_t WS_CTL = 0, CTL_BYTES = 1u << 20;
constexpr size_t WS_MOD = WS_CTL + CTL_BYTES;
constexpr size_t WS_LB = WS_MOD + al256((size_t)DEPTH * 3 * MODW * 4);
constexpr size_t WS_ROPE = WS_LB + al256((size_t)DEPTH * 2048 * 4);
constexpr size_t WS_RSQ = WS_ROPE + al256(2 * 64 * 16 * 4);
constexpr size_t WS_RSKV = WS_RSQ + al256((size_t)MROWS * 4);
constexpr size_t WS_WABIN = WS_RSKV + al256((size_t)MROWS * 4);
constexpr size_t WS_WABOUT = WS_WABIN + (size_t)2 * ABNP * DM * 2;
constexpr size_t WS_WUQ = WS_WABOUT + (size_t)2 * DM * DM * 2;
constexpr size_t WS_WUKV = WS_WUQ + (size_t)2 * QW * 512 * 2;
constexpr size_t WS_WHGIN = WS_WUKV + (size_t)2 * KVW * 512 * 2;
constexpr size_t WS_WHGOUT = WS_WHGIN + (size_t)2 * HGN * DM * 2;
constexpr size_t WS_W1 = WS_WHGOUT + (size_t)2 * DM * DM * 2;
constexpr size_t WS_W2 = WS_W1 + (size_t)4 * DFF * DM * 2;
constexpr size_t WS_WG = WS_W2 + (size_t)4 * DFF * DM * 2;
constexpr size_t WS_XS = WS_WG + (size_t)2 * 4 * 128 * 1024 * 2;
constexpr size_t WS_H = WS_XS + (size_t)MROWS * DM * 4;
constexpr size_t WS_Y = WS_H + (size_t)MROWS * DM * 2;
constexpr size_t WS_BIG = WS_Y + (size_t)MROWS * DM * 2;
constexpr size_t WS_P = WS_BIG;
constexpr size_t WS_AG = WS_P + (size_t)MROWS * ABNP * 2;
constexpr size_t WS_CARRY = WS_AG + al256((size_t)(MROWS / 64) * 2 * 2 * DLRU * 4);
constexpr size_t WS_Q = WS_CARRY + al256((size_t)(MROWS / 64) * 2 * DLRU * 4);
constexpr size_t WS_KV = WS_Q + (size_t)MROWS * QW * 2;
constexpr size_t WS_KR = WS_KV + (size_t)MROWS * KVW * 2;
constexpr size_t WS_AB_END = WS_KR + (size_t)MROWS * 64 * 2;
constexpr size_t WS_QH = WS_BIG;
constexpr size_t WS_VH = WS_QH + (size_t)MROWS * DM * 2;
constexpr size_t WS_GH = WS_VH + (size_t)MROWS * DM * 2;
constexpr size_t WS_LOGF = WS_GH + (size_t)MROWS * DM * 2;
constexpr size_t WS_DS = WS_LOGF + (size_t)2 * MROWS * DM * 4;
constexpr size_t WS_DEC = WS_DS + (size_t)64 * 68 * 16384 * 4;
constexpr size_t WS_SS = WS_DEC + (size_t)64 * 68 * 128 * 4;
constexpr size_t WS_HG_END = WS_SS + (size_t)64 * 68 * 16384 * 2;
constexpr size_t WS_HID = WS_BIG;
constexpr size_t WS_MLP_END = WS_HID + (size_t)MROWS * DFF * 2;
constexpr size_t cmax(size_t a, size_t b) { return a > b ? a : b; }
constexpr size_t WS_END = cmax(cmax(WS_AB_END, WS_HG_END), WS_MLP_END);

constexpr int LDS_BYTES = 147456;
constexpr int LDS_MISC = 131072;

__device__ __forceinline__ float bf2f(bf16_t v) { return __uint_as_float(((unsigned)v) << 16); }
__device__ __forceinline__ unsigned f2bf(float f) { unsigned u = __float_as_uint(f); return (u + 0x7fffu + ((u >> 16) & 1u)) >> 16; }
__device__ __forceinline__ unsigned pk2(float lo, float hi) { return f2bf(lo) | (f2bf(hi) << 16); }
__device__ __forceinline__ float wave_sum(float v) {
#pragma unroll
    for (int o = 1; o < 64; o <<= 1) v += __shfl_xor(v, o);
    return v;
}
__device__ __forceinline__ float wave_max(float v) {
#pragma unroll
    for (int o = 1; o < 64; o <<= 1) v = fmaxf(v, __shfl_xor(v, o));
    return v;
}
__device__ __forceinline__ float sigmoidf_(float x) { return 1.0f / (1.0f + expf(-x)); }
__device__ __forceinline__ float siluf_(float x) { return x / (1.0f + expf(-x)); }
__device__ __forceinline__ float gelu_tanh(float x) { const float u = 0.7978845608028654f * (x + 0.044715f * x * x * x); return 0.5f * x * (1.0f + tanhf(u)); }

#define XB_TMO      128
#define XB_XCNT(j)  (256  + 64 * (j))
#define XB_XSUB(j)  (1280 + 64 * (j))
#define XB_XGEN(j)  (2304 + 64 * (j))
#define XB_TOP      3328
#define XB_TOPGEN   3392
#define XCD_BAR_WORDS 3456
#define XB_SPIN_CAP (1u << 18)
__device__ __forceinline__ unsigned xb_ld(unsigned* p)              { return __hip_atomic_load(p, __ATOMIC_RELAXED, __HIP_MEMORY_SCOPE_AGENT); }
__device__ __forceinline__ unsigned xb_add(unsigned* p, unsigned v) { return __hip_atomic_fetch_add(p, v, __ATOMIC_RELAXED, __HIP_MEMORY_SCOPE_AGENT); }
__device__ __forceinline__ unsigned xb_xcc_id() { return (unsigned)__builtin_amdgcn_s_getreg((3 << 11) | 20) & 0xFu; }
#define XB_SPIN(cond, bar) do { unsigned _sp = 0; while (cond) { __builtin_amdgcn_s_sleep(1); \
    if ((++_sp & 255u) == 0u) { if (xb_ld(&(bar)[XB_TMO])) break; if (_sp > XB_SPIN_CAP) { atomicAdd(&(bar)[XB_TMO], 1u); break; } } } } while (0)
struct XcdBarrier { unsigned* bar; unsigned x; volatile LAS unsigned* st; };
__device__ __forceinline__ XcdBarrier xcd_barrier_post(unsigned* bar, volatile LAS unsigned* st) {
    XcdBarrier b; b.bar = bar; b.x = xb_xcc_id(); b.st = st;
    if (threadIdx.x == 0) (void)xb_add(&bar[XB_XCNT(b.x)], 1u);
    return b;
}
__device__ __forceinline__ void xcd_barrier_complete(unsigned* bar, unsigned x, unsigned& nloc, unsigned& nx) {
    const unsigned G = gridDim.x * gridDim.y * gridDim.z;
    unsigned sum, cnt, mine, sp = 0u;
    for (;;) {
        sum = 0u; cnt = 0u; mine = 0u;
#pragma unroll
        for (unsigned j = 0; j < 16; ++j) { const unsigned c = xb_ld(&bar[XB_XCNT(j)]); sum += c; cnt += (c > 0u) ? 1u : 0u; mine = (j == x) ? c : mine; }
        if (sum == G) break;
        __builtin_amdgcn_s_sleep(1);
        if ((++sp & 255u) == 0u) { if (xb_ld(&bar[XB_TMO])) break; if (sp > XB_SPIN_CAP) { atomicAdd(&bar[XB_TMO], 1u); break; } }
    }
    nloc = mine > 0u ? mine : 1u; nx = cnt > 0u ? cnt : 1u;
}
__device__ __forceinline__ void xcd_barrier(const XcdBarrier& b) {
    asm volatile("s_waitcnt vmcnt(0)" ::: "memory");
    __syncthreads();
    if (threadIdx.x == 0) {
        unsigned* bar = b.bar; asm volatile("" : "+s"(bar));
        __builtin_amdgcn_s_waitcnt(0);
        unsigned nloc = b.st[0], nx = b.st[1];
        if (nloc == 0u) { xcd_barrier_complete(bar, b.x, nloc, nx); b.st[0] = nloc; b.st[1] = nx; }
        const unsigned old = xb_add(&bar[XB_XSUB(b.x)], 1u);
        const unsigned gen = old / nloc;
        if (old + 1u == (gen + 1u) * nloc) {
            __builtin_amdgcn_fence(__ATOMIC_RELEASE, "agent");
            asm volatile("s_waitcnt vmcnt(0)" ::: "memory");
            const unsigned og = xb_add(&bar[XB_TOP], 1u);
            const unsigned tg = og / nx;
            if (og + 1u == (tg + 1u) * nx) xb_add(&bar[XB_TOPGEN], 1u);
            else XB_SPIN(xb_ld(&bar[XB_TOPGEN]) == tg, bar);
            __builtin_amdgcn_fence(__ATOMIC_ACQUIRE, "agent");
            xb_add(&bar[XB_XGEN(b.x)], 1u);
            asm volatile("s_waitcnt vmcnt(0)" ::: "memory");
        } else {
            XB_SPIN(xb_ld(&bar[XB_XGEN(b.x)]) == gen, bar);
            __builtin_amdgcn_fence(__ATOMIC_ACQUIRE, "agent");
            asm volatile("s_waitcnt vmcnt(0)" ::: "memory");
        }
    }
    __syncthreads();
}

namespace pg8 {
constexpr int BM = 256, BK = 64, HALF = 128, HTB = HALF * BK * 2, STAGE_BYTES = 8 * HTB, NXCD = 8, WGM = 8;
__host__ __device__ __forceinline__ int lds_byte(int r, int c) { const int st = (r >> 4) * 2 + (c >> 5), rr = r & 15, cc = c & 31, ob = rr * 64 + cc * 2; return st * 1024 + (ob ^ (((ob >> 9) & 1) << 5)); }
__host__ __device__ __forceinline__ void stage_rc(int b, int& R, int& C) { const int st = b / 1024, sb = b % 1024, swz = sb ^ (((sb >> 9) & 1) << 5); R = (st >> 1) * 16 + swz / 64; C = (st & 1) * 32 + (swz % 64) / 2; }
__host__ __device__ __forceinline__ int perm32(int rho) { const int n = rho >> 4, i = rho & 15; return 8 * (i >> 2) + 4 * n + (i & 3); }
struct Unit { int pm, pn; };
struct Gemm { const bf16_t* A; const bf16_t* Bt; int M, N, K, lda, ldb, lat; };
struct StaticOrder {
    int nM, nN, nwg, G, c;
    __host__ __device__ void init(int M, int N, int G_, int c_) { nM = M / BM; nN = N / BM; nwg = nM * nN; G = G_; c = c_; }
    __host__ __device__ bool next(int i, Unit& u) const {
        const long L = (long)i * G + c; if (L >= nwg) return false;
        int wgid = (int)L; { const int q = nwg / NXCD, r = nwg % NXCD, xcd = wgid % NXCD, off = wgid / NXCD; wgid = (xcd < r ? xcd * (q + 1) : r * (q + 1) + (xcd - r) * q) + off; }
        const int nig = WGM * nN, gid = wgid / nig, fm = gid * WGM, gsz = (nM - fm) < WGM ? (nM - fm) : WGM;
        u.pm = fm + ((wgid % nig) % gsz); u.pn = (wgid % nig) / gsz; return true;
    }
};
__device__ __forceinline__ unsigned cvt_pk_bf16(float lo, float hi) { unsigned r; asm volatile("v_cvt_pk_bf16_f32 %0, %1, %2" : "=v"(r) : "v"(lo), "v"(hi)); return r; }

template <class Epi>
__device__ __forceinline__ void gemm_phase(LAS unsigned char* lds, const int tid, const Gemm g, const StaticOrder& S, const Epi& E) {
    const int wid = __builtin_amdgcn_readfirstlane(tid >> 6), lane = tid & 63, wr = wid >> 2, wc = wid & 3, fr = lane & 15, fq = lane >> 4;
    const int K = g.K, nt = K / BK;
    unsigned voffA[2], voffB[2];
#pragma unroll
    for (int i = 0; i < 2; ++i) { int R, C; stage_rc(tid * 16 + i * 8192, R, C); const int Rb = Epi::PERM ? ((R & ~31) + perm32(R & 31)) : R;
        voffA[i] = (unsigned)(R * g.lda + C) * 2u; voffB[i] = (unsigned)(Rb * g.ldb + C) * 2u; }
    const size_t kstep = (size_t)(BK * 2);
    const size_t hsA = (size_t)HALF * g.lda * 2, hsB = (size_t)HALF * g.ldb * 2;
    const size_t tsA = 2 * hsA, tsB = 2 * hsB;
    const unsigned ldsw = (unsigned)wid * 1024u;
    const int aoff = lds_byte(wr * 64 + fr, fq * 8), boff = lds_byte(wc * 32 + fr, fq * 8);
#define PG8_SA(b, h) (((b) * 2 + (h)) * HTB)
#define PG8_SB(b, h) ((4 + (b) * 2 + (h)) * HTB)
#define PG8_STAGE(bufoff, gbase, voff) do { _Pragma("unroll") for (int _i = 0; _i < 2; ++_i) \
        __builtin_amdgcn_global_load_lds((const unsigned*)((const char*)(gbase) + (voff)[_i]), (LAS unsigned*)(lds + (bufoff) + ldsw + _i * 8192), 16, 0, 0); } while (0)
#define PG8_LDA(dst, b, h) do { _Pragma("unroll") for (int m = 0; m < 4; ++m) _Pragma("unroll") for (int k = 0; k < 2; ++k) dst[m][k] = *(const LAS bf16x8*)(lds + PG8_SA(b, h) + aoff + m * 2048 + k * 1024); } while (0)
#define PG8_LDB(dst, b, h) do { _Pragma("unroll") for (int n = 0; n < 2; ++n) _Pragma("unroll") for (int k = 0; k < 2; ++k) dst[n][k] = *(const LAS bf16x8*)(lds + PG8_SB(b, h) + boff + n * 2048 + k * 1024); } while (0)
#define PG8_MMA(ai, bj, At, Bt) do { __builtin_amdgcn_s_setprio(1); _Pragma("unroll") for (int m = 0; m < 4; ++m) _Pragma("unroll") for (int n = 0; n < 2; ++n) _Pragma("unroll") for (int k = 0; k < 2; ++k) \
        acc[ai][bj][m][n] = __builtin_amdgcn_mfma_f32_16x16x32_bf16(Bt[n][k], At[m][k], acc[ai][bj][m][n], 0, 0, 0); __builtin_amdgcn_s_setprio(0); } while (0)
#define PG8_WAIT_V(n) asm volatile("s_waitcnt vmcnt(" #n ")" ::: "memory")
#define PG8_WAIT_L(n) asm volatile("s_waitcnt lgkmcnt(" #n ")" ::: "memory")
#define PG8_BAR __builtin_amdgcn_s_barrier()
#define PG8_SCHED __builtin_amdgcn_sched_barrier(0)
    Unit cur, nxt; int ui = 0;
    if (!S.next(0, cur)) return;
    if (g.lat) cur.pm += (cur.pm >> 4) + 1;
    f32x4 acc[2][2][4][2];
#pragma unroll
    for (int a = 0; a < 2; ++a)
#pragma unroll
        for (int b = 0; b < 2; ++b)
#pragma unroll
            for (int m = 0; m < 4; ++m)
#pragma unroll
                for (int n = 0; n < 2; ++n) acc[a][b][m][n] = (f32x4){0.f, 0.f, 0.f, 0.f};
    bf16x8 At[4][2], B0[2][2], B1[2][2];
    const char* cA = (const char*)g.A + (size_t)cur.pm * tsA; const char* cB = (const char*)g.Bt + (size_t)cur.pn * tsB;
    PG8_STAGE(PG8_SB(0, 0), cB, voffB); PG8_STAGE(PG8_SA(0, 0), cA, voffA); PG8_STAGE(PG8_SB(0, 1), cB + hsB, voffB); PG8_STAGE(PG8_SA(0, 1), cA + hsA, voffA);
    if (wr == 1) PG8_BAR;
    PG8_WAIT_V(4); PG8_BAR;
    PG8_STAGE(PG8_SB(1, 0), cB + kstep, voffB); PG8_STAGE(PG8_SA(1, 0), cA + kstep, voffA); PG8_STAGE(PG8_SB(1, 1), cB + hsB + kstep, voffB);
    PG8_WAIT_V(6); PG8_BAR;
    for (;;) {
        const bool has_next = S.next(ui + 1, nxt);
        if (g.lat && has_next) nxt.pm += (nxt.pm >> 4) + 1;
        const char* nA = has_next ? (const char*)g.A + (size_t)nxt.pm * tsA : cA; const char* nB = has_next ? (const char*)g.Bt + (size_t)nxt.pn * tsB : cB;
        for (int t = 0; t < nt; t += 2) {
            const bool last = (t == nt - 2);
            const char* a1 = cA + (size_t)(t + 1) * kstep;
            const char* a2 = last ? nA : cA + (size_t)(t + 2) * kstep; const char* b2 = last ? nB : cB + (size_t)(t + 2) * kstep;
            const char* a3 = a2 + kstep; const char* b3 = b2 + kstep;
            PG8_LDB(B0, 0, 0); PG8_SCHED; PG8_LDA(At, 0, 0); PG8_STAGE(PG8_SA(1, 1), a1 + hsA, voffA);
            PG8_WAIT_L(8); PG8_BAR; PG8_WAIT_L(0); PG8_MMA(0, 0, At, B0); PG8_BAR; PG8_SCHED;
            PG8_LDB(B1, 0, 1); PG8_STAGE(PG8_SB(0, 0), b2, voffB);
            PG8_BAR; PG8_WAIT_L(0); PG8_MMA(0, 1, At, B1); PG8_BAR;
            PG8_LDA(At, 0, 1); PG8_STAGE(PG8_SA(0, 0), a2, voffA);
            PG8_BAR; PG8_WAIT_L(0); PG8_MMA(1, 0, At, B0); PG8_BAR; PG8_SCHED;
            PG8_STAGE(PG8_SB(0, 1), b2 + hsB, voffB);
            PG8_WAIT_V(6); PG8_BAR; PG8_MMA(1, 1, At, B1); PG8_BAR;
            PG8_LDB(B0, 1, 0); PG8_SCHED; PG8_LDA(At, 1, 0); PG8_STAGE(PG8_SA(0, 1), a2 + hsA, voffA);
            PG8_WAIT_L(8); PG8_BAR; PG8_WAIT_L(0); PG8_MMA(0, 0, At, B0); PG8_BAR; PG8_SCHED;
            PG8_LDB(B1, 1, 1); PG8_STAGE(PG8_SB(1, 0), b3, voffB);
            PG8_BAR; PG8_WAIT_L(0); PG8_MMA(0, 1, At, B1); PG8_BAR;
            PG8_LDA(At, 1, 1); PG8_STAGE(PG8_SA(1, 0), a3, voffA);
            PG8_BAR; PG8_WAIT_L(0); PG8_MMA(1, 0, At, B0); PG8_BAR; PG8_SCHED;
            PG8_STAGE(PG8_SB(1, 1), b3 + hsB, voffB);
            PG8_WAIT_V(6); PG8_BAR; PG8_MMA(1, 1, At, B1); PG8_BAR;
        }
        E(acc, cur, wr, wc, fr, fq);
        if (!has_next) break;
#pragma unroll
        for (int a = 0; a < 2; ++a)
#pragma unroll
            for (int b = 0; b < 2; ++b)
#pragma unroll
                for (int m = 0; m < 4; ++m)
#pragma unroll
                    for (int n = 0; n < 2; ++n) acc[a][b][m][n] = (f32x4){0.f, 0.f, 0.f, 0.f};
        cur = nxt; cA = nA; cB = nB; ++ui;
    }
    PG8_WAIT_V(0);
    if (wr == 0) PG8_BAR;
    PG8_BAR;
#undef PG8_SA
#undef PG8_SB
#undef PG8_STAGE
#undef PG8_LDA
#undef PG8_LDB
#undef PG8_MMA
#undef PG8_WAIT_V
#undef PG8_WAIT_L
#undef PG8_BAR
#undef PG8_SCHED
}
}

#define EPI_ROWS_COLS_PERM \
    const int row0 = u.pm * 256 + wr * 64 + fr; const int col0 = u.pn * 256 + wc * 32 + 8 * fq;
struct EpiBf16Plain {
    static constexpr bool PERM = true;
    bf16_t* O; int ldc;
    __device__ __forceinline__ void operator()(const f32x4 (&acc)[2][2][4][2], const pg8::Unit& u, int wr, int wc, int fr, int fq) const {
        EPI_ROWS_COLS_PERM
#pragma unroll
        for (int ai = 0; ai < 2; ++ai)
#pragma unroll
            for (int m = 0; m < 4; ++m) { bf16_t* rowp = O + (size_t)(row0 + ai * 128 + m * 16) * ldc + col0;
#pragma unroll
                for (int bj = 0; bj < 2; ++bj) { const f32x4 v0 = acc[ai][bj][m][0], v1 = acc[ai][bj][m][1];
                    u32x4 w; w.x = pk2(v0[0], v0[1]); w.y = pk2(v0[2], v0[3]); w.z = pk2(v1[0], v1[1]); w.w = pk2(v1[2], v1[3]);
                    *(u32x4*)(rowp + bj * 128) = w; } }
    }
};
struct EpiBf16RowScale {
    static constexpr bool PERM = true;
    bf16_t* O; int ldc; const float* rs;
    __device__ __forceinline__ void operator()(const f32x4 (&acc)[2][2][4][2], const pg8::Unit& u, int wr, int wc, int fr, int fq) const {
        EPI_ROWS_COLS_PERM
#pragma unroll
        for (int ai = 0; ai < 2; ++ai)
#pragma unroll
            for (int m = 0; m < 4; ++m) { const int row = row0 + ai * 128 + m * 16; const float s = rs[row]; bf16_t* rowp = O + (size_t)row * ldc + col0;
#pragma unroll
                for (int bj = 0; bj < 2; ++bj) { const f32x4 v0 = acc[ai][bj][m][0] * s, v1 = acc[ai][bj][m][1] * s;
                    u32x4 w; w.x = pk2(v0[0], v0[1]); w.y = pk2(v0[2], v0[3]); w.z = pk2(v1[0], v1[1]); w.w = pk2(v1[2], v1[3]);
                    *(u32x4*)(rowp + bj * 128) = w; } }
    }
};
struct EpiRelu2 {
    static constexpr bool PERM = true;
    bf16_t* O; int ldc;
    __device__ __forceinline__ void operator()(const f32x4 (&acc)[2][2][4][2], const pg8::Unit& u, int wr, int wc, int fr, int fq) const {
        EPI_ROWS_COLS_PERM
#pragma unroll
        for (int ai = 0; ai < 2; ++ai)
#pragma unroll
            for (int m = 0; m < 4; ++m) { bf16_t* rowp = O + (size_t)(row0 + ai * 128 + m * 16) * ldc + col0;
#pragma unroll
                for (int bj = 0; bj < 2; ++bj) { f32x4 v0 = acc[ai][bj][m][0], v1 = acc[ai][bj][m][1];
#pragma unroll
                    for (int j = 0; j < 4; ++j) { const float a = fmaxf(v0[j], 0.f), b = fmaxf(v1[j], 0.f); v0[j] = a * a; v1[j] = b * b; }
                    u32x4 w; w.x = pk2(v0[0], v0[1]); w.y = pk2(v0[2], v0[3]); w.z = pk2(v1[0], v1[1]); w.w = pk2(v1[2], v1[3]);
                    *(u32x4*)(rowp + bj * 128) = w; } }
    }
};
struct EpiResid {
    static constexpr bool PERM = false;
    float* XS; const float* gate; float scale;
    __device__ __forceinline__ void operator()(const f32x4 (&acc)[2][2][4][2], const pg8::Unit& u, int wr, int wc, int fr, int fq) const {
        const int row0 = u.pm * 256 + wr * 64 + fr, col0 = u.pn * 256 + wc * 32 + 4 * fq;
        const int cond = (u.pm % 17 == 0) ? 2 : (u.pm / 17);
        const float* gp = gate + (size_t)cond * MODW + col0;
        f32x4 gv[2][2];
#pragma unroll
        for (int bj = 0; bj < 2; ++bj)
#pragma unroll
            for (int n = 0; n < 2; ++n) gv[bj][n] = *(const f32x4*)(gp + bj * 128 + n * 16) * scale;
#pragma unroll
        for (int ai = 0; ai < 2; ++ai)
#pragma unroll
            for (int m = 0; m < 4; ++m) { float* rowp = XS + (size_t)(row0 + ai * 128 + m * 16) * DM + col0;
#pragma unroll
                for (int bj = 0; bj < 2; ++bj)
#pragma unroll
                    for (int n = 0; n < 2; ++n) { f32x4* p = (f32x4*)(rowp + bj * 128 + n * 16); *p = *p + gv[bj][n] * acc[ai][bj][m][n]; } }
    }
};
struct EpiHG {
    static constexpr bool PERM = true;
    bf16_t* QVG; float* LOGF; const float* lb;
    __device__ __forceinline__ void operator()(const f32x4 (&acc)[2][2][4][2], const pg8::Unit& u, int wr, int wc, int fr, int fq) const {
        const int row0 = u.pm * 256 + wr * 64 + fr; const int seg = u.pn >> 3; const int col0 = (u.pn & 7) * 256 + wc * 32 + 8 * fq;
        if (seg == 1 || seg == 2) {
            float* base = LOGF + (size_t)(seg - 1) * MROWS * DM;
            f32x4 lbv[2][2];
#pragma unroll
            for (int bj = 0; bj < 2; ++bj)
#pragma unroll
                for (int n = 0; n < 2; ++n) lbv[bj][n] = *(const f32x4*)(lb + col0 + bj * 128 + 4 * n);
#pragma unroll
            for (int ai = 0; ai < 2; ++ai)
#pragma unroll
                for (int m = 0; m < 4; ++m) { float* rowp = base + (size_t)(row0 + ai * 128 + m * 16) * DM + col0;
#pragma unroll
                    for (int bj = 0; bj < 2; ++bj)
#pragma unroll
                        for (int n = 0; n < 2; ++n) { f32x4 v = acc[ai][bj][m][n];
#pragma unroll
                            for (int j = 0; j < 4; ++j) { const float l = lbv[bj][n][j]; v[j] = logf(l + (1.0f - l) * sigmoidf_(v[j])); }
                            *(f32x4*)(rowp + bj * 128 + 4 * n) = v; } }
        } else {
            const int bi = seg - 2 + (seg == 0 ? 2 : 0);
            bf16_t* base = QVG + (size_t)bi * MROWS * DM;
            const bool act = (seg != 3);
#pragma unroll
            for (int ai = 0; ai < 2; ++ai)
#pragma unroll
                for (int m = 0; m < 4; ++m) { bf16_t* rowp = base + (size_t)(row0 + ai * 128 + m * 16) * DM + col0;
#pragma unroll
                    for (int bj = 0; bj < 2; ++bj) { f32x4 v0 = acc[ai][bj][m][0], v1 = acc[ai][bj][m][1];
                        if (act) {
#pragma unroll
                            for (int j = 0; j < 4; ++j) { v0[j] = siluf_(v0[j]); v1[j] = siluf_(v1[j]); } }
                        u32x4 w; w.x = pk2(v0[0], v0[1]); w.y = pk2(v0[2], v0[3]); w.z = pk2(v1[0], v1[1]); w.w = pk2(v1[2], v1[3]);
                        *(u32x4*)(rowp + bj * 128) = w; } }
        }
    }
};


namespace sg {
struct SGemm { const bf16_t* A; const bf16_t* Bt; int N, K, lda, ldb; };
__device__ __forceinline__ unsigned red_off(int w, int row, int col) { return (unsigned)(((w * 64 + row) * 64 + (col ^ (((row >> 2) & 1) << 4))) * 4); }
template <class Epi>
__device__ __forceinline__ void sgemm_unit(LAS unsigned char* lds, int tid, const SGemm& g, int mt, int nt, const Epi& E) {
    const int w = __builtin_amdgcn_readfirstlane(tid >> 6), lane = tid & 63, fr = lane & 15, fq = lane >> 4;
    const size_t Rg = (size_t)(mt >> 2) * SROW + (mt & 3) * 64;
    const int kw = g.K >> 3, nks = kw >> 5;
    const bf16_t* ap = g.A + (Rg + fr) * g.lda + w * kw + 8 * fq;
    const bf16_t* bp = g.Bt + ((size_t)nt * 64 + fr) * g.ldb + w * kw + 8 * fq;
    const size_t sa = (size_t)16 * g.lda, sb = (size_t)16 * g.ldb;
    f32x4 acc[4][4];
#pragma unroll
    for (int m = 0; m < 4; ++m)
#pragma unroll
        for (int n = 0; n < 4; ++n) acc[m][n] = (f32x4){0.f, 0.f, 0.f, 0.f};
    bf16x8 a0[4], b0[4], a1[4], b1[4];
#define SG_LOAD(a, b, ks) do { _Pragma("unroll") for (int i = 0; i < 4; ++i) { a[i] = *(const bf16x8*)(ap + i * sa + (ks) * 32); b[i] = *(const bf16x8*)(bp + i * sb + (ks) * 32); } } while (0)
#define SG_MMA(a, b) do { _Pragma("unroll") for (int m = 0; m < 4; ++m) _Pragma("unroll") for (int n = 0; n < 4; ++n) acc[m][n] = __builtin_amdgcn_mfma_f32_16x16x32_bf16(a[m], b[n], acc[m][n], 0, 0, 0); } while (0)
    SG_LOAD(a0, b0, 0);
    for (int ks = 0; ks < nks; ks += 2) {
        SG_LOAD(a1, b1, ks + 1);
        SG_MMA(a0, b0);
        if (ks + 2 < nks) SG_LOAD(a0, b0, ks + 2);
        SG_MMA(a1, b1);
    }
#undef SG_LOAD
#undef SG_MMA
    __syncthreads();
#pragma unroll
    for (int m = 0; m < 4; ++m)
#pragma unroll
        for (int n = 0; n < 4; ++n)
#pragma unroll
            for (int r = 0; r < 4; ++r) *(LAS float*)(lds + red_off(w, 16 * m + 4 * fq + r, 16 * n + fr)) = acc[m][n][r];
    __syncthreads();
    const int row = tid >> 3, c8 = (tid & 7) * 8;
    f32x4 s0 = {0.f, 0.f, 0.f, 0.f}, s1 = {0.f, 0.f, 0.f, 0.f};
#pragma unroll
    for (int ww = 0; ww < 8; ++ww) { s0 += *(const LAS f32x4*)(lds + red_off(ww, row, c8)); s1 += *(const LAS f32x4*)(lds + red_off(ww, row, c8 + 4)); }
    float v[8] = {s0.x, s0.y, s0.z, s0.w, s1.x, s1.y, s1.z, s1.w};
    E(Rg + row, nt * 64 + c8, v);
}
template <class Epi>
__device__ __forceinline__ void sgemm_phase(LAS unsigned char* lds, int tid, const SGemm& g, int nbig, const Epi& E) {
    const int G = gridDim.x, c = blockIdx.x, nsm = 8 * (g.N >> 6), r = nbig % G;
    int start, stride;
    if (r == 0) { start = (G % 8 == 0) ? (c % 8) * (G / 8) + c / 8 : c; stride = G; }
    else { start = c - r; stride = G - r; if (c < r) start = nsm; }
    for (int su = start; su < nsm; su += stride) sgemm_unit(lds, tid, g, su & 7, su >> 3, E);
    __syncthreads();
}
}
__device__ __forceinline__ void st_bf16x8(bf16_t* p, const float (&v)[8]) { u32x4 w; w.x = pk2(v[0], v[1]); w.y = pk2(v[2], v[3]); w.z = pk2(v[4], v[5]); w.w = pk2(v[6], v[7]); *(u32x4*)p = w; }
struct SEpiPlain { bf16_t* O; int ldc;
    __device__ __forceinline__ void operator()(size_t R, int col, const float (&v)[8]) const { st_bf16x8(O + R * ldc + col, v); } };
struct SEpiRowScale { bf16_t* O; int ldc; const float* rs;
    __device__ __forceinline__ void operator()(size_t R, int col, const float (&v)[8]) const { const float s = rs[R]; float o[8];
#pragma unroll
        for (int j = 0; j < 8; ++j) o[j] = v[j] * s;
        st_bf16x8(O + R * ldc + col, o); } };
struct SEpiRelu2 { bf16_t* O; int ldc;
    __device__ __forceinline__ void operator()(size_t R, int col, const float (&v)[8]) const { float o[8];
#pragma unroll
        for (int j = 0; j < 8; ++j) { const float a = fmaxf(v[j], 0.f); o[j] = a * a; }
        st_bf16x8(O + R * ldc + col, o); } };
struct SEpiResid { float* XS; const float* gate; float scale;
    __device__ __forceinline__ void operator()(size_t R, int col, const float (&v)[8]) const { const float* gp = gate + (size_t)2 * MODW + col; float* xp = XS + R * DM + col;
        const f32x4 g0 = *(const f32x4*)gp * scale, g1 = *(const f32x4*)(gp + 4) * scale; f32x4 x0 = *(f32x4*)xp, x1 = *(f32x4*)(xp + 4);
        x0 += g0 * (f32x4){v[0], v[1], v[2], v[3]}; x1 += g1 * (f32x4){v[4], v[5], v[6], v[7]}; *(f32x4*)xp = x0; *(f32x4*)(xp + 4) = x1; } };
struct SEpiHG { bf16_t* QVG; float* LOGF; const float* lb;
    __device__ __forceinline__ void operator()(size_t R, int col, const float (&v)[8]) const { const int seg = col >> 11, cs = col & 2047;
        if (seg == 1 || seg == 2) { float* p = LOGF + (size_t)(seg - 1) * MROWS * DM + R * DM + cs; f32x4 o0, o1;
#pragma unroll
            for (int j = 0; j < 4; ++j) { const float l0 = lb[cs + j], l1 = lb[cs + 4 + j]; o0[j] = logf(l0 + (1.0f - l0) * sigmoidf_(v[j])); o1[j] = logf(l1 + (1.0f - l1) * sigmoidf_(v[4 + j])); }
            *(f32x4*)p = o0; *(f32x4*)(p + 4) = o1; }
        else { const int bi = seg - 2 + (seg == 0 ? 2 : 0); float o[8];
#pragma unroll
            for (int j = 0; j < 8; ++j) o[j] = seg == 3 ? v[j] : siluf_(v[j]);
            st_bf16x8(QVG + (size_t)bi * MROWS * DM + R * DM + cs, o); } } };

namespace att {
using s16x4  = __attribute__((ext_vector_type(4))) short;
using f32x16 = __attribute__((ext_vector_type(16))) float;
constexpr int NW = 8, QBLK = 32, KVBLK = 64;
constexpr float SCALE = ATTN_SCALE;
constexpr float THR = 8.f;
constexpr int SHM_V = KVBLK * 128 * 2, SHM_K = KVBLK * 128 * 2, SHM_KR = KVBLK * 64 * 2;
constexpr int OFF_V = 0, OFF_K = 2 * SHM_V, OFF_KR = OFF_K + 2 * SHM_K, OFF_WS = OFF_KR + 2 * SHM_KR, SHM_ATTN = OFF_WS + NW * 64 * 4;
constexpr int LDQ = QW, LDK = KVW, LDO = DM;
#define KSWZ(row, colB) ((row) * 256 + ((colB) ^ (((row) & 7) << 4)))
#define RSWZ(row, colB) ((row) * 128 + ((colB) ^ ((((row) >> 1) & 7) << 4)))
#define SBAR() __builtin_amdgcn_sched_barrier(0)
__device__ __forceinline__ int crow(int r, int hi) { return (r & 3) + 8 * (r >> 2) + 4 * hi; }
__device__ __forceinline__ unsigned cvtpk(float lo, float hi) { unsigned r; asm volatile("v_cvt_pk_bf16_f32 %0, %1, %2" : "=v"(r) : "v"(lo), "v"(hi)); return r; }
__device__ __forceinline__ bf16x8 ld8(const bf16_t* p) { return *reinterpret_cast<const bf16x8*>(p); }
__device__ __forceinline__ void partialSM(f32x16& p0, f32x16& p1, float& m_reg, float& mn, float& alpha) {
  constexpr float C = SCALE * 1.4426950408889634f;
  float pmax = p0[0];
#pragma unroll
  for (int r = 1; r < 16; ++r) pmax = fmaxf(pmax, p0[r]);
#pragma unroll
  for (int r = 0; r < 16; ++r) pmax = fmaxf(pmax, p1[r]);
  { auto rr = __builtin_amdgcn_permlane32_swap(__float_as_uint(pmax), __float_as_uint(pmax), false, false);
    pmax = fmaxf(__uint_as_float(rr[0]), __uint_as_float(rr[1])); }
  if (__builtin_expect(__all(pmax - m_reg <= THR / SCALE), 1)) { mn = m_reg; alpha = 1.f; }
  else { mn = fmaxf(m_reg, pmax); alpha = __builtin_amdgcn_exp2f((m_reg - mn) * C); m_reg = mn; }
  float mnC = -mn * C;
#pragma unroll
  for (int r = 0; r < 16; ++r) p0[r] = fmaf(p0[r], C, mnC);
#pragma unroll
  for (int r = 0; r < 16; ++r) p1[r] = fmaf(p1[r], C, mnC);
#pragma unroll
  for (int r = 0; r < 16; ++r) p0[r] = __builtin_amdgcn_exp2f(p0[r]);
}
__device__ __forceinline__ void finishSM(f32x16& p0, f32x16& p1, float alpha, float& l_reg, bf16x8& pa0, bf16x8& pa1, bf16x8& pa2, bf16x8& pa3) {
#pragma unroll
  for (int r = 0; r < 16; ++r) p1[r] = __builtin_amdgcn_exp2f(p1[r]);
  float ps = 0;
#pragma unroll
  for (int r = 0; r < 16; ++r) ps += p0[r];
#pragma unroll
  for (int r = 0; r < 16; ++r) ps += p1[r];
  { auto rr = __builtin_amdgcn_permlane32_swap(__float_as_uint(ps), __float_as_uint(ps), false, false);
    ps = __uint_as_float(rr[0]) + __uint_as_float(rr[1]); }
  l_reg = l_reg * alpha + ps;
#define PK4(P, BASE, OUT) do { unsigned a0 = cvtpk(P[BASE + 0], P[BASE + 1]), a1 = cvtpk(P[BASE + 2], P[BASE + 3]);   \
    unsigned b0 = cvtpk(P[BASE + 4], P[BASE + 5]), b1 = cvtpk(P[BASE + 6], P[BASE + 7]);                              \
    auto r0 = __builtin_amdgcn_permlane32_swap(a0, b0, false, false); auto r1 = __builtin_amdgcn_permlane32_swap(a1, b1, false, false); \
    u32x4 w = {r0[0], r1[0], r0[1], r1[1]}; OUT = *reinterpret_cast<bf16x8*>(&w); } while (0)
  PK4(p0, 0, pa0); PK4(p0, 8, pa1); PK4(p1, 0, pa2); PK4(p1, 8, pa3);
#undef PK4
}
__device__ __forceinline__ void qkt(f32x16& p0, f32x16& p1, const char* Ks, const char* Krs, const bf16x8* qr, int r32, int hi) {
  p0 = f32x16{}; p1 = f32x16{};
#pragma unroll
  for (int d0 = 0; d0 < 8; ++d0) { int cb = (d0 * 16 + hi * 8) * 2;
    bf16x8 b0 = *reinterpret_cast<const bf16x8*>(Ks + KSWZ(r32, cb));
    bf16x8 b1 = *reinterpret_cast<const bf16x8*>(Ks + KSWZ(32 + r32, cb));
    p0 = __builtin_amdgcn_mfma_f32_32x32x16_bf16(b0, qr[d0], p0, 0, 0, 0);
    p1 = __builtin_amdgcn_mfma_f32_32x32x16_bf16(b1, qr[d0], p1, 0, 0, 0); }
#pragma unroll
  for (int d0 = 0; d0 < 4; ++d0) { int cb = (d0 * 16 + hi * 8) * 2;
    bf16x8 b0 = *reinterpret_cast<const bf16x8*>(Krs + RSWZ(r32, cb));
    bf16x8 b1 = *reinterpret_cast<const bf16x8*>(Krs + RSWZ(32 + r32, cb));
    p0 = __builtin_amdgcn_mfma_f32_32x32x16_bf16(b0, qr[8 + d0], p0, 0, 0, 0);
    p1 = __builtin_amdgcn_mfma_f32_32x32x16_bf16(b1, qr[8 + d0], p1, 0, 0, 0); }
}
__device__ __forceinline__ int v_st(int k, int c) { const int kk = (k & ~0xC) | ((k & 4) << 1) | ((k & 8) >> 1); return ((kk >> 3) * 4 + (c >> 5)) * 512 + ((kk & 7) * 32 + (c & 31)) * 2; }
__device__ __forceinline__ int v_rd_base(int lane) { return ((lane & 3) << 3) | (((lane >> 2) & 3) << 6) | (((lane >> 4) & 1) << 5) | (((lane >> 5) & 1) << 8); }
constexpr int v_rd_off(int d0, int ks, int half) { return d0 * 512 + ks * 4096 + half * 2048; }
template <int OFF> __device__ __forceinline__ s16x4 tr_read(int vb) {
  s16x4 r; asm volatile("ds_read_b64_tr_b16 %0, %1 offset:%2" : "=&v"(r) : "v"(vb), "i"(OFF) : "memory"); return r;
}
template <int D0> __device__ __forceinline__ void pv_one(f32x16& od, int vb, bf16x8 pa0, bf16x8 pa1, bf16x8 pa2, bf16x8 pa3) {
  const s16x4 l0 = tr_read<v_rd_off(D0, 0, 0)>(vb), h0 = tr_read<v_rd_off(D0, 0, 1)>(vb), l1 = tr_read<v_rd_off(D0, 1, 0)>(vb), h1 = tr_read<v_rd_off(D0, 1, 1)>(vb);
  const s16x4 l2 = tr_read<v_rd_off(D0, 2, 0)>(vb), h2 = tr_read<v_rd_off(D0, 2, 1)>(vb), l3 = tr_read<v_rd_off(D0, 3, 0)>(vb), h3 = tr_read<v_rd_off(D0, 3, 1)>(vb);
  asm volatile("s_waitcnt lgkmcnt(0)" ::: "memory"); SBAR();
#define PK(L, H) (bf16x8){L[0], L[1], L[2], L[3], H[0], H[1], H[2], H[3]}
  od = __builtin_amdgcn_mfma_f32_32x32x16_bf16(pa0, PK(l0, h0), od, 0, 0, 0);
  od = __builtin_amdgcn_mfma_f32_32x32x16_bf16(pa1, PK(l1, h1), od, 0, 0, 0);
  od = __builtin_amdgcn_mfma_f32_32x32x16_bf16(pa2, PK(l2, h2), od, 0, 0, 0);
  od = __builtin_amdgcn_mfma_f32_32x32x16_bf16(pa3, PK(l3, h3), od, 0, 0, 0);
#undef PK
}
__device__ __forceinline__ void pv_d0(f32x16* o, int vb, bf16x8 pa0, bf16x8 pa1, bf16x8 pa2, bf16x8 pa3) {
  pv_one<0>(o[0], vb, pa0, pa1, pa2, pa3); pv_one<1>(o[1], vb, pa0, pa1, pa2, pa3); pv_one<2>(o[2], vb, pa0, pa1, pa2, pa3); pv_one<3>(o[3], vb, pa0, pa1, pa2, pa3);
}
__device__ __forceinline__ void attn_body(const bf16_t* __restrict__ Qb, const bf16_t* __restrict__ Kh, const bf16_t* __restrict__ KRb,
                                          bf16_t* __restrict__ Ob, int seq, int tq0, const float* __restrict__ RC, const float* __restrict__ RS, char* lds, int tid) {
  const bf16_t* Vh = Kh + 128;
  const int wid = tid >> 6, lane = tid & 63, r32 = lane & 31, hi = lane >> 5;
  char* V_lds = lds + OFF_V; char* K_lds = lds + OFF_K; char* KR_lds = lds + OFF_KR;
  float* ws = (float*)(lds + OFF_WS) + wid * 64; float* li_l = ws; float* al_l = ws + 32;
  float m_reg = -1e30f, l_reg = 0; f32x16 o[4] = {}; bf16x8 qr[12];
  const bf16_t* Qw = Qb + (long)(wid * QBLK + r32) * LDQ + hi * 8;
#pragma unroll
  for (int d0 = 0; d0 < 12; ++d0) qr[d0] = ld8(Qw + d0 * 16);
  if (tq0 >= 0) {
    const int t = tq0 + wid * QBLK + r32; const int pr = (t >> 6) * 16 + hi * 8, pc = (t & 63) * 16 + hi * 8;
#pragma unroll
    for (int j = 0; j < 8; ++j) {
      { const float c = RC[pr + j], sn = RS[pr + j]; const float x0 = bf2f((bf16_t)qr[8][j]), x1 = bf2f((bf16_t)qr[9][j]);
        qr[8][j] = (short)f2bf(x0 * c - x1 * sn); qr[9][j] = (short)f2bf(x1 * c + x0 * sn); }
      { const float c = RC[pc + j], sn = RS[pc + j]; const float x0 = bf2f((bf16_t)qr[10][j]), x1 = bf2f((bf16_t)qr[11][j]);
        qr[10][j] = (short)f2bf(x0 * c - x1 * sn); qr[11][j] = (short)f2bf(x1 * c + x0 * sn); }
    }
  }
  const int sr = tid >> 4, sc = (tid & 15) * 8, vst0 = v_st(sr, sc), vst1 = v_st(32 + sr, sc);
  const int rr = tid >> 3, rc = (tid & 7) * 8;
  const int vb0 = (int)(uintptr_t)V_lds + v_rd_base(lane);
  bf16x8 vs0, vs1, ks0, ks1, krs;
#define SLOAD(k0) do { vs0 = ld8(&Vh[(long)((k0) + sr) * LDK + sc]); vs1 = ld8(&Vh[(long)((k0) + 32 + sr) * LDK + sc]); \
    ks0 = ld8(&Kh[(long)((k0) + sr) * LDK + sc]); ks1 = ld8(&Kh[(long)((k0) + 32 + sr) * LDK + sc]); krs = ld8(&KRb[(long)((k0) + rr) * 64 + rc]); } while (0)
#define SWRITE(b) do { *(bf16x8*)(V_lds + (b) * SHM_V + vst0) = vs0; *(bf16x8*)(V_lds + (b) * SHM_V + vst1) = vs1; int kc = sc * 2;   \
    *(bf16x8*)(K_lds + (b) * SHM_K + KSWZ(sr, kc)) = ks0; *(bf16x8*)(K_lds + (b) * SHM_K + KSWZ(32 + sr, kc)) = ks1;                    \
    *(bf16x8*)(KR_lds + (b) * SHM_KR + RSWZ(rr, rc * 2)) = krs; } while (0)
#define SWAIT() asm volatile("s_waitcnt vmcnt(0)" ::: "memory")
#define RESC(a) do { if (__any((a) < 1.f)) { if (hi == 0) al_l[r32] = (a); asm volatile("s_waitcnt lgkmcnt(0)" ::: "memory"); \
    _Pragma("unroll") for (int d = 0; d < 4; ++d) _Pragma("unroll") for (int r = 0; r < 16; ++r) o[d][r] *= al_l[crow(r, hi)]; } } while (0)
  f32x16 p0, p1; float mn, al; bf16x8 pa0, pa1, pa2, pa3; const int NT = seq / KVBLK;
  SLOAD(0); SWAIT(); SWRITE(0); __syncthreads();
  SLOAD(KVBLK);
  for (int j = 0; j < NT; ++j) {
    const int buf = j & 1;
    SBAR(); qkt(p0, p1, K_lds + buf * SHM_K, KR_lds + buf * SHM_KR, qr, r32, hi);
    partialSM(p0, p1, m_reg, mn, al); RESC(al);
    finishSM(p0, p1, al, l_reg, pa0, pa1, pa2, pa3); SBAR();
    if (j + 1 < NT) { SWAIT(); SWRITE(buf ^ 1); }
    if (j + 2 < NT) SLOAD((j + 2) * KVBLK);
    SBAR();
    pv_d0(o, vb0 + buf * SHM_V, pa0, pa1, pa2, pa3);
    __syncthreads();
  }
  if (hi == 0) li_l[r32] = l_reg; asm volatile("s_waitcnt lgkmcnt(0)" ::: "memory");
  float rli[16];
#pragma unroll
  for (int r = 0; r < 16; ++r) rli[r] = __builtin_amdgcn_rcpf(li_l[crow(r, hi)]);
  bf16_t* Ow = Ob + (long)(wid * QBLK) * LDO;
#pragma unroll
  for (int r = 0; r < 16; ++r) { int orow = crow(r, hi);
#pragma unroll
    for (int d0 = 0; d0 < 4; ++d0) Ow[(long)orow * LDO + d0 * 32 + r32] = (bf16_t)f2bf(o[d0][r] * rli[r]); }
#undef SLOAD
#undef SWRITE
#undef SWAIT
#undef RESC
}
}

typedef const float* cfp_t;
typedef const __attribute__((address_space(4))) cfp_t* InPtr;
struct Ctx {
    LAS unsigned char* lds; int tid, lane, wave, gw, ngw, gtid, ngt;
    InPtr in; float* out; unsigned char* ws;
};
#define WSP(T, off) ((T*)(C.ws + (off)))

__device__ __forceinline__ void tr_item(const float* W, int K, int N, bf16_t* WT, const float* sck, LAS float* scr, int item, int lane) {
    const int nblk = N / 32, kb = item / nblk, nb = item % nblk, k0 = 64 * kb, n0 = 32 * nb;
#pragma unroll 8
    for (int i = 0; i < 32; ++i) { const int kk = 2 * i + (lane >> 5); float v = W[(size_t)(k0 + kk) * N + n0 + (lane & 31)]; if (sck) v *= sck[k0 + kk]; scr[kk * 33 + (lane & 31)] = v; }
    asm volatile("s_waitcnt lgkmcnt(0)" ::: "memory"); __builtin_amdgcn_wave_barrier();
    const int c = lane & 7;
#pragma unroll
    for (int j = 0; j < 4; ++j) { const int n = (lane >> 3) + 8 * j; const LAS float* s = scr + (8 * c) * 33 + n;
        u32x4 o; o.x = pk2(s[0 * 33], s[1 * 33]); o.y = pk2(s[2 * 33], s[3 * 33]); o.z = pk2(s[4 * 33], s[5 * 33]); o.w = pk2(s[6 * 33], s[7 * 33]);
        *(u32x4*)(WT + (size_t)(n0 + n) * K + k0 + 8 * c) = o; }
    asm volatile("s_waitcnt lgkmcnt(0)" ::: "memory"); __builtin_amdgcn_wave_barrier();
}
__device__ __forceinline__ void tr_matrix(const Ctx& C, const float* W, int K, int N, bf16_t* WT, const float* sck) {
    LAS float* scr = (LAS float*)(C.lds + C.wave * 16384);
    const int cnt = (K / 64) * (N / 32);
    for (int it = C.gw; it < cnt; it += C.ngw) tr_item(W, K, N, WT, sck, scr, it, C.lane);
}
__device__ __forceinline__ void sincos_d(double x, double& s, double& c) {
    const double twopi = 6.283185307179586476925286766559;
    const double k = __builtin_rint(x / twopi); const double y = x - k * twopi; const double y2 = y * y;
    double ts = y, ss = y, tc = 1.0, sc = 1.0;
#pragma unroll
    for (int n = 1; n <= 16; ++n) { tc *= -y2 / (double)((2 * n - 1) * (2 * n)); sc += tc; ts *= -y2 / (double)((2 * n) * (2 * n + 1)); ss += ts; }
    s = ss; c = sc;
}
__device__ __forceinline__ void phase_prologue(const Ctx& C) {
#pragma unroll 1
    for (int e = 0; e < 2; ++e) {
        tr_matrix(C, C.in[8] + (size_t)e * DM * ABN, DM, ABN, WSP(bf16_t, WS_WABIN) + (size_t)e * ABNP * DM, nullptr);
        tr_matrix(C, C.in[9] + (size_t)e * DM * DM, DM, DM, WSP(bf16_t, WS_WABOUT) + (size_t)e * DM * DM, nullptr);
        tr_matrix(C, C.in[18] + (size_t)e * 512 * QW, 512, QW, WSP(bf16_t, WS_WUQ) + (size_t)e * QW * 512, C.in[17] + e * 512);
        tr_matrix(C, C.in[20] + (size_t)e * 512 * KVW, 512, KVW, WSP(bf16_t, WS_WUKV) + (size_t)e * KVW * 512, C.in[19] + e * 512);
        tr_matrix(C, C.in[21] + (size_t)e * DM * HGN, DM, HGN, WSP(bf16_t, WS_WHGIN) + (size_t)e * HGN * DM, nullptr);
        tr_matrix(C, C.in[24] + (size_t)e * DM * DM, DM, DM, WSP(bf16_t, WS_WHGOUT) + (size_t)e * DM * DM, nullptr);
#pragma unroll 1
        for (int dg = 0; dg < 4; ++dg) { const int dir = dg >> 1, gate = dg & 1;
            tr_matrix(C, C.in[gate ? 14 : 12] + ((size_t)e * 2 + dir) * 8 * 128 * 128, 1024, 128, WSP(bf16_t, WS_WG) + ((size_t)e * 4 + dg) * 128 * 1024, nullptr); }
    }
#pragma unroll 1
    for (int l = 0; l < 4; ++l) {
        tr_matrix(C, C.in[25] + (size_t)l * DM * DFF, DM, DFF, WSP(bf16_t, WS_W1) + (size_t)l * DFF * DM, nullptr);
        tr_matrix(C, C.in[26] + (size_t)l * DFF * DM, DFF, DM, WSP(bf16_t, WS_W2) + (size_t)l * DM * DFF, nullptr);
    }
    for (int e = 0; e < 2; ++e) { u32x4* z = (u32x4*)(WSP(bf16_t, WS_WABIN) + (size_t)e * ABNP * DM + (size_t)ABN * DM);
        for (int i = C.gtid; i < (ABNP - ABN) * DM / 8; i += C.ngt) z[i] = (u32x4){0u, 0u, 0u, 0u}; }
    { float* XS = WSP(float, WS_XS);
      for (int i = C.gtid; i < MROWS * (DM / 4); i += C.ngt) { const int R = i / (DM / 4), c4 = i % (DM / 4); const int b = R / SROW, s = R % SROW;
          const float* src = s < CTX ? C.in[2] + ((size_t)(b * CTX + s)) * DM : C.in[0] + ((size_t)(b * SEQ + (s - CTX))) * DM;
          ((f32x4*)(XS + (size_t)R * DM))[c4] = ((const f32x4*)src)[c4]; } }
    { float* LB = WSP(float, WS_LB);
      for (int i = C.gtid; i < 2048; i += C.ngt) { float v[4], mx = -1e30f; for (int l = 0; l < 4; ++l) { v[l] = C.in[22][l * 2048 + i]; mx = fmaxf(mx, v[l]); }
          float sum = 0.f; for (int l = 0; l < 4; ++l) { v[l] = expf(v[l] - mx); sum += v[l]; }
          float cum = 0.f; const float p0 = v[0] / sum; for (int l = 0; l < 4; ++l) { cum += v[l] / sum; LB[l * 2048 + i] = cum - p0; } }
      float* RC = WSP(float, WS_ROPE); float* RS = RC + 1024;
      for (int i = C.gtid; i < 1024; i += C.ngt) { const int pos = i / 16, j = i % 16; double inv = 1.0; for (int q = 0; q < j; ++q) inv *= 0.56234132519034908;
          const float ang = (float)pos * (float)inv; double s, c; sincos_d((double)ang, s, c); RC[i] = (float)c; RS[i] = (float)s; } }
    { LAS float* sl = (LAS float*)C.lds;
      LAS float* red = sl + 3 * 2048;
      __syncthreads();
      for (int i = C.tid; i < 3 * 2048; i += 512) { const int r = i / 2048, d = i % 2048; const float v = r < 2 ? C.in[1][r * 2048 + d] : C.in[3][d]; sl[i] = siluf_(v); }
      __syncthreads();
      float* MOD = WSP(float, WS_MOD);
      const int kq = C.tid >> 4, cq = C.tid & 15;
      for (int u = blockIdx.x; u < 4 * (MODW / 64); u += gridDim.x) { const int l = u / (MODW / 64), e0 = (u % (MODW / 64)) * 64;
          const float* w = C.in[4] + (size_t)l * DM * MODW + e0 + 4 * cq;
          f32x4 a0 = {0, 0, 0, 0}, a1 = {0, 0, 0, 0}, a2 = {0, 0, 0, 0};
#pragma unroll 4
          for (int d = kq; d < DM; d += 32) { const f32x4 wv = *(const f32x4*)(w + (size_t)d * MODW); a0 += wv * sl[d]; a1 += wv * sl[2048 + d]; a2 += wv * sl[4096 + d]; }
#pragma unroll
          for (int j = 0; j < 4; ++j) { red[(kq * 3 + 0) * 64 + 4 * cq + j] = a0[j]; red[(kq * 3 + 1) * 64 + 4 * cq + j] = a1[j]; red[(kq * 3 + 2) * 64 + 4 * cq + j] = a2[j]; }
          __syncthreads();
          if (C.tid < 192) { const int r = C.tid / 64, c = C.tid % 64; float s = 0.f; for (int q = 0; q < 32; ++q) s += red[(q * 3 + r) * 64 + c];
              MOD[((size_t)l * 3 + r) * MODW + e0 + c] = s + C.in[5][l * MODW + e0 + c]; }
          __syncthreads(); } }
}

__device__ __forceinline__ void phase_norm_mod(const Ctx& C, const float* w, const float* mod, int sh_idx, int sc_idx) {
    const float* XS = WSP(float, WS_XS); bf16_t* H = WSP(bf16_t, WS_H);
    for (int R = C.gw; R < MROWS; R += C.ngw) {
        const int s = R % SROW, b = R / SROW, cond = s < CTX ? 2 : b;
        const float* shift = mod + (size_t)cond * MODW + sh_idx * DM; const float* scale = mod + (size_t)cond * MODW + sc_idx * DM;
        const f32x4* xr = (const f32x4*)(XS + (size_t)R * DM) + C.lane;
        f32x4 v[8]; float ss = 0.f;
#pragma unroll
        for (int j = 0; j < 8; ++j) { v[j] = xr[64 * j]; ss += (v[j].x * v[j].x + v[j].y * v[j].y) + (v[j].z * v[j].z + v[j].w * v[j].w); }
        const float rstd = 1.0f / sqrtf(wave_sum(ss) * (1.0f / DM) + EPS);
        u32x2* o = (u32x2*)(H + (size_t)R * DM) + C.lane;
#pragma unroll
        for (int j = 0; j < 8; ++j) { const int c = (C.lane + 64 * j) * 4; const f32x4 wv = *(const f32x4*)(w + c), sc = *(const f32x4*)(scale + c), sh = *(const f32x4*)(shift + c);
            const f32x4 y = (v[j] * rstd * wv) * (1.0f + sc) + sh; u32x2 pk; pk.x = pk2(y.x, y.y); pk.y = pk2(y.z, y.w); o[64 * j] = pk; }
    }
}

__device__ __forceinline__ void phase_rs_kr(const Ctx& C) {
    const bf16_t* P = WSP(bf16_t, WS_P);
    float* RSQ = WSP(float, WS_RSQ); float* RSKV = WSP(float, WS_RSKV);
    for (int R = C.gw; R < MROWS; R += C.ngw) {
        const u32x4 a = *(const u32x4*)(P + (size_t)R * ABNP + 2048 + 8 * C.lane), b = *(const u32x4*)(P + (size_t)R * ABNP + 2560 + 8 * C.lane);
        float sa = 0.f, sb = 0.f;
#pragma unroll
        for (int j = 0; j < 4; ++j) { const float a0 = __uint_as_float(a[j] << 16), a1 = __uint_as_float(a[j] & 0xffff0000u), b0 = __uint_as_float(b[j] << 16), b1 = __uint_as_float(b[j] & 0xffff0000u);
            sa += a0 * a0 + a1 * a1; sb += b0 * b0 + b1 * b1; }
        sa = wave_sum(sa); sb = wave_sum(sb);
        if (C.lane == 0) { RSQ[R] = 1.0f / sqrtf(sa * (1.0f / 512.0f) + EPS); RSKV[R] = 1.0f / sqrtf(sb * (1.0f / 512.0f) + EPS); } }
    bf16_t* KR = WSP(bf16_t, WS_KR); const float* RC = WSP(float, WS_ROPE); const float* RS = RC + 1024;
    for (int idx = C.gtid; idx < MROWS * 32; idx += C.ngt) { const int R = idx / 32, p = idx % 32, s = R % SROW; const int i0 = p < 16 ? p : 32 + (p - 16);
        const float x0 = bf2f(P[(size_t)R * ABNP + 3072 + i0]), x1 = bf2f(P[(size_t)R * ABNP + 3072 + i0 + 16]); float o0 = x0, o1 = x1;
        if (s >= CTX) { const int t = s - CTX, pos = p < 16 ? t / 64 : t % 64; const float c = RC[pos * 16 + (p & 15)], sn = RS[pos * 16 + (p & 15)]; o0 = x0 * c - x1 * sn; o1 = x1 * c + x0 * sn; }
        KR[(size_t)R * 64 + i0] = (bf16_t)f2bf(o0); KR[(size_t)R * 64 + i0 + 16] = (bf16_t)f2bf(o1); }
}

__device__ __forceinline__ void phase_attn(const Ctx& C) {
    const bf16_t* Q = WSP(bf16_t, WS_Q); const bf16_t* KV = WSP(bf16_t, WS_KV); const bf16_t* KR = WSP(bf16_t, WS_KR); bf16_t* Y = WSP(bf16_t, WS_Y);
    const float* RC = WSP(float, WS_ROPE); const float* RS = RC + 1024;
    const int G = gridDim.x, c = blockIdx.x;
    for (int u0 = c; u0 < 272; u0 += G) {
        int b, hh, s0, nk, tq0;
        if (u0 < 256) { int v = u0; if (G == 256) { const int x = c & 7, j = c >> 3; v = (x * 2 + (j >> 4)) * 16 + (j & 15); }
            const int p = v >> 4, qb = v & 15; b = p >> 3; hh = p & 7; s0 = CTX + qb * 256; nk = SROW; tq0 = qb * 256; }
        else { const int p = u0 - 256; b = p >> 3; hh = p & 7; s0 = 0; nk = CTX; tq0 = -1; }
        const size_t R0 = (size_t)b * SROW + s0, K0 = (size_t)b * SROW;
        __syncthreads();
        att::attn_body(Q + R0 * QW + hh * 192, KV + K0 * KVW + hh * 256, KR + K0 * 64, Y + R0 * DM + DLRU + hh * 128, nk, tq0, RC, RS, (char*)C.lds, C.tid);
    }
}
namespace hg {
using s16x4  = __attribute__((ext_vector_type(4))) short;
using f32x16 = __attribute__((ext_vector_type(16))) float;
constexpr int NCH = SROW / 64;
constexpr int NCHAIN = NBATCH * 16 * 2;
__device__ __forceinline__ unsigned off_b(unsigned row, unsigned ch) { return 256u * row + 16u * (ch ^ (((row & 3u) << 2) | ((row >> 2) & 3u))); }
__device__ __forceinline__ s16x4 trr(unsigned addr) { s16x4 r; asm volatile("ds_read_b64_tr_b16 %0, %1" : "=&v"(r) : "v"(addr) : "memory"); return r; }
__device__ __forceinline__ bf16x8 pk8(s16x4 L, s16x4 H) { return (bf16x8){L[0], L[1], L[2], L[3], H[0], H[1], H[2], H[3]}; }
__device__ __forceinline__ unsigned tr_nat(unsigned lane, unsigned c, unsigned ks, unsigned t) {
    const unsigned h = lane >> 5, blk = (lane >> 4) & 1, q = (lane & 15) >> 2, p = lane & 3;
    return off_b(16 * ks + 8 * h + 4 * t + q, 4 * c + 2 * blk + (p >> 1)) + 8 * (p & 1); }
__device__ __forceinline__ unsigned tr_perm(unsigned lane, unsigned c, unsigned rb, unsigned t) {
    const unsigned h = lane >> 5, blk = (lane >> 4) & 1, q = (lane & 15) >> 2, p = lane & 3;
    return off_b(rb + 4 * h + 8 * t + q, 4 * c + 2 * blk + (p >> 1)) + 8 * (p & 1); }
__device__ __forceinline__ unsigned row_rd(unsigned lane, unsigned rb, unsigned ks) { return off_b(rb + (lane & 31), 2 * ks + (lane >> 5)); }
__device__ __forceinline__ int crow(int r, int hi) { return (r & 3) + 8 * (r >> 2) + 4 * hi; }
#define HG_WAITL() do { asm volatile("s_waitcnt lgkmcnt(0)" ::: "memory"); __builtin_amdgcn_sched_barrier(0); } while (0)
}

__device__ __forceinline__ void phase_hg_ds(const Ctx& C) {
    using namespace hg;
    LAS unsigned char* L = C.lds; const unsigned Lb = (unsigned)(uintptr_t)L;
    constexpr unsigned VT = 0, KP = 16384, TOT = 32768;
    const float* LOGF = WSP(float, WS_LOGF); const bf16_t* VH = WSP(bf16_t, WS_VH); float* DS = WSP(float, WS_DS); float* DEC = WSP(float, WS_DEC);
    const int w = C.wave, lane = C.lane, tid = C.tid, h5 = lane >> 5, r32 = lane & 31;
    for (int u = blockIdx.x; u < NBATCH * 16 * NCH; u += gridDim.x) {
        const int b = u / (16 * NCH), hh = (u / NCH) % 16, ci = u % NCH; const size_t R0 = (size_t)b * SROW + ci * 64;
        __syncthreads();
#pragma unroll
        for (int p = 0; p < 2; ++p) { const int row = (tid >> 4) + 32 * p, ch = tid & 15; const u32x4 v = *(const u32x4*)(VH + (R0 + row) * DM + hh * 128 + ch * 8); *(LAS u32x4*)(L + VT + off_b(row, ch)) = v; }
#pragma unroll 1
        for (int dir = 0; dir < 2; ++dir) {
            const int chain = (b * 16 + hh) * 2 + dir;
            const float* lfp = LOGF + (size_t)dir * MROWS * DM + (R0 + 8 * w) * DM + hh * 128 + 2 * lane;
            f32x2 lf[8]; f32x2 T = {0.f, 0.f};
#pragma unroll
            for (int i = 0; i < 8; ++i) { lf[i] = *(const f32x2*)(lfp + (size_t)i * DM); T += lf[i]; }
            *(LAS f32x2*)(L + TOT + (w * 128 + 2 * lane) * 4) = T;
            __syncthreads();
            f32x2 off = {0.f, 0.f}, total = {0.f, 0.f};
#pragma unroll
            for (int ww = 0; ww < 8; ++ww) { const f32x2 t = *(const LAS f32x2*)(L + TOT + (ww * 128 + 2 * lane) * 4); total += t; if (dir == 0 ? (ww > w) : (ww < w)) off += t; }
            f32x2 E[8];
            if (dir == 0) { E[7] = off;
#pragma unroll
                for (int i = 6; i >= 0; --i) E[i] = E[i + 1] + lf[i + 1]; }
            else { E[0] = off;
#pragma unroll
                for (int i = 1; i < 8; ++i) E[i] = E[i - 1] + lf[i - 1]; }
#pragma unroll
            for (int i = 0; i < 8; ++i) { const float k0 = (1.0f - __expf(lf[i].x)) * __expf(E[i].x), k1 = (1.0f - __expf(lf[i].y)) * __expf(E[i].y);
                *(LAS unsigned*)(L + KP + off_b(8 * w + i, lane >> 2) + (lane & 3) * 4) = pk2(k0, k1); }
            if (w == 0) { f32x2 d; d.x = __expf(total.x); d.y = __expf(total.y); *(f32x2*)(DEC + ((size_t)chain * NCH + ci) * 128 + 2 * lane) = d; }
            __syncthreads();
            const unsigned dkt = w >> 1, c0 = (w & 1) * 2;
            s16x4 al[4], ah[4], b0l[4], b0h[4], b1l[4], b1h[4];
#pragma unroll
            for (int ks = 0; ks < 4; ++ks) { al[ks] = trr(Lb + KP + tr_nat(lane, dkt, ks, 0)); ah[ks] = trr(Lb + KP + tr_nat(lane, dkt, ks, 1));
                b0l[ks] = trr(Lb + VT + tr_nat(lane, c0, ks, 0)); b0h[ks] = trr(Lb + VT + tr_nat(lane, c0, ks, 1));
                b1l[ks] = trr(Lb + VT + tr_nat(lane, c0 + 1, ks, 0)); b1h[ks] = trr(Lb + VT + tr_nat(lane, c0 + 1, ks, 1)); }
            HG_WAITL();
            f32x16 a0 = {}, a1 = {};
#pragma unroll
            for (int ks = 0; ks < 4; ++ks) { const bf16x8 A = pk8(al[ks], ah[ks]);
                a0 = __builtin_amdgcn_mfma_f32_32x32x16_bf16(A, pk8(b0l[ks], b0h[ks]), a0, 0, 0, 0);
                a1 = __builtin_amdgcn_mfma_f32_32x32x16_bf16(A, pk8(b1l[ks], b1h[ks]), a1, 0, 0, 0); }
            float* dsp = DS + ((size_t)chain * NCH + ci) * 16384;
#pragma unroll
            for (int r = 0; r < 16; ++r) { const int dk = 32 * dkt + crow(r, h5); dsp[dk * 128 + 32 * c0 + r32] = a0[r]; dsp[dk * 128 + 32 * (c0 + 1) + r32] = a1[r]; }
        }
    }
}
__device__ __forceinline__ void phase_hg_scan(const Ctx& C) {
    using namespace hg;
    const float* DS = WSP(float, WS_DS); const float* DEC = WSP(float, WS_DEC); bf16_t* SS = WSP(bf16_t, WS_SS);
    for (int g = C.gtid; g < NCHAIN * 2048; g += C.ngt) { const int chain = g >> 11, within = g & 2047, dk = within >> 4, dv0 = (within & 15) * 8, dir = chain & 1;
        f32x4 s0 = {0.f, 0.f, 0.f, 0.f}, s1 = {0.f, 0.f, 0.f, 0.f};
#pragma unroll 4
        for (int j = 0; j < NCH; ++j) { const int ci = dir == 0 ? j : (j < 4 ? 3 - j : 71 - j); const size_t cb = (size_t)chain * NCH + ci; const size_t idx = (cb * 128 + dk) * 128 + dv0;
            u32x4 o; o.x = pk2(s0.x, s0.y); o.y = pk2(s0.z, s0.w); o.z = pk2(s1.x, s1.y); o.w = pk2(s1.z, s1.w); *(u32x4*)(SS + idx) = o;
            const float d = DEC[cb * 128 + dk]; const f32x4 d0 = *(const f32x4*)(DS + idx), d1 = *(const f32x4*)(DS + idx + 4);
            s0 = s0 * d + d0; s1 = s1 * d + d1; } }
}
__device__ __forceinline__ void phase_hg_out(const Ctx& C, int o_idx) {
    using namespace hg;
    LAS unsigned char* L = C.lds; const unsigned Lb = (unsigned)(uintptr_t)L;
    constexpr unsigned VT = 0, QP = 16384, QM = 32768, KM = 49152, ST = 65536, TOT = 98304, RED = 102400;
    const float* LOGF = WSP(float, WS_LOGF); const bf16_t* VH = WSP(bf16_t, WS_VH); const bf16_t* QH = WSP(bf16_t, WS_QH); const bf16_t* GH = WSP(bf16_t, WS_GH);
    const bf16_t* SS = WSP(bf16_t, WS_SS); bf16_t* Y = WSP(bf16_t, WS_Y); const float* nw = C.in[23] + o_idx * 128;
    const int w = C.wave, lane = C.lane, tid = C.tid, h5 = lane >> 5, r32 = lane & 31;
    const unsigned tt = w >> 2, dvt = w & 3;
    for (int u = blockIdx.x; u < NBATCH * 16 * NCH; u += gridDim.x) {
        const int b = u / (16 * NCH), hh = (u / NCH) % 16, ci = u % NCH; const size_t R0 = (size_t)b * SROW + ci * 64;
        __syncthreads();
#pragma unroll
        for (int p = 0; p < 2; ++p) { const int row = (tid >> 4) + 32 * p, ch = tid & 15; const u32x4 v = *(const u32x4*)(VH + (R0 + row) * DM + hh * 128 + ch * 8); *(LAS u32x4*)(L + VT + off_b(row, ch)) = v; }
        f32x16 acc = {};
#pragma unroll 1
        for (int dir = 0; dir < 2; ++dir) {
            const int chain = (b * 16 + hh) * 2 + dir;
            u32x4 sreg[4];
#pragma unroll
            for (int p = 0; p < 4; ++p) sreg[p] = *(const u32x4*)(SS + (((size_t)chain * NCH + ci) * 128 + (tid >> 4) + 32 * p) * 128 + (tid & 15) * 8);
            const float* lfp = LOGF + (size_t)dir * MROWS * DM + (R0 + 8 * w) * DM + hh * 128 + 2 * lane;
            const bf16_t* qp = QH + (R0 + 8 * w) * DM + hh * 128 + 2 * lane;
            f32x2 lf[8]; unsigned qv[8]; f32x2 T = {0.f, 0.f};
#pragma unroll
            for (int i = 0; i < 8; ++i) { lf[i] = *(const f32x2*)(lfp + (size_t)i * DM); qv[i] = *(const unsigned*)(qp + (size_t)i * DM); T += lf[i]; }
            *(LAS f32x2*)(L + TOT + (w * 128 + 2 * lane) * 4) = T;
            __syncthreads();
            f32x2 off = {0.f, 0.f}, mid = {0.f, 0.f};
#pragma unroll
            for (int ww = 0; ww < 8; ++ww) { const f32x2 t = *(const LAS f32x2*)(L + TOT + (ww * 128 + 2 * lane) * 4);
                if (dir == 0 ? (ww < w) : (ww > w)) off += t; if (dir == 0 ? (ww < 4) : (ww >= 4)) mid += t; }
            f32x2 B[8];
            if (dir == 0) { B[0] = off + lf[0];
#pragma unroll
                for (int i = 1; i < 8; ++i) B[i] = B[i - 1] + lf[i]; }
            else { B[7] = off + lf[7];
#pragma unroll
                for (int i = 6; i >= 0; --i) B[i] = B[i + 1] + lf[i]; }
#pragma unroll
            for (int i = 0; i < 8; ++i) { const float q0 = __uint_as_float(qv[i] << 16), q1 = __uint_as_float(qv[i] & 0xffff0000u);
                const float k0 = 1.0f - __expf(lf[i].x), k1 = 1.0f - __expf(lf[i].y);
                const unsigned a = off_b(8 * w + i, lane >> 2) + (lane & 3) * 4;
                *(LAS unsigned*)(L + QP + a) = pk2(q0 * __expf(B[i].x), q1 * __expf(B[i].y));
                *(LAS unsigned*)(L + QM + a) = pk2(q0 * __expf(B[i].x - mid.x), q1 * __expf(B[i].y - mid.y));
                *(LAS unsigned*)(L + KM + a) = pk2(k0 * __expf(mid.x - B[i].x), k1 * __expf(mid.y - B[i].y)); }
#pragma unroll
            for (int p = 0; p < 4; ++p) *(LAS u32x4*)(L + ST + off_b((tid >> 4) + 32 * p, tid & 15)) = sreg[p];
            __syncthreads();
            { bf16x8 a[8]; s16x4 bl[8], bh[8];
#pragma unroll
              for (int ks = 0; ks < 8; ++ks) { a[ks] = *(const LAS bf16x8*)(L + QP + row_rd(lane, 32 * tt, ks)); bl[ks] = trr(Lb + ST + tr_nat(lane, dvt, ks, 0)); bh[ks] = trr(Lb + ST + tr_nat(lane, dvt, ks, 1)); }
              HG_WAITL();
#pragma unroll
              for (int ks = 0; ks < 8; ++ks) acc = __builtin_amdgcn_mfma_f32_32x32x16_bf16(a[ks], pk8(bl[ks], bh[ks]), acc, 0, 0, 0); }
            { bf16x8 qb[8];
#pragma unroll
              for (int ks = 0; ks < 8; ++ks) qb[ks] = *(const LAS bf16x8*)(L + QM + row_rd(lane, 32 * tt, ks));
#pragma unroll
              for (unsigned st = 0; st < 2; ++st) { const bool valid = dir == 0 ? (st <= tt) : (st >= tt);
                if (valid) {
                  f32x16 x = {};
#pragma unroll
                  for (int ks = 0; ks < 8; ++ks) { const bf16x8 ka = *(const LAS bf16x8*)(L + KM + row_rd(lane, 32 * st, ks)); x = __builtin_amdgcn_mfma_f32_32x32x16_bf16(ka, qb[ks], x, 0, 0, 0); }
                  if (st == tt) {
#pragma unroll
                    for (int r = 0; r < 16; ++r) { const int kr = crow(r, h5); const bool keep = dir == 0 ? (kr <= r32) : (kr >= r32); x[r] = keep ? x[r] : 0.f; } }
                  const s16x4 v0l = trr(Lb + VT + tr_perm(lane, dvt, 32 * st, 0)), v0h = trr(Lb + VT + tr_perm(lane, dvt, 32 * st, 1));
                  const s16x4 v1l = trr(Lb + VT + tr_perm(lane, dvt, 32 * st + 16, 0)), v1h = trr(Lb + VT + tr_perm(lane, dvt, 32 * st + 16, 1));
                  u32x4 A0, A1; A0.x = pk2(x[0], x[1]); A0.y = pk2(x[2], x[3]); A0.z = pk2(x[4], x[5]); A0.w = pk2(x[6], x[7]);
                  A1.x = pk2(x[8], x[9]); A1.y = pk2(x[10], x[11]); A1.z = pk2(x[12], x[13]); A1.w = pk2(x[14], x[15]);
                  HG_WAITL();
                  acc = __builtin_amdgcn_mfma_f32_32x32x16_bf16(*reinterpret_cast<bf16x8*>(&A0), pk8(v0l, v0h), acc, 0, 0, 0);
                  acc = __builtin_amdgcn_mfma_f32_32x32x16_bf16(*reinterpret_cast<bf16x8*>(&A1), pk8(v1l, v1h), acc, 0, 0, 0);
                } } }
        }
        LAS float* red = (LAS float*)(L + RED);
#pragma unroll
        for (int r = 0; r < 16; ++r) { float s = acc[r] * acc[r]; s += __shfl_xor(s, 1); s += __shfl_xor(s, 2); s += __shfl_xor(s, 4); s += __shfl_xor(s, 8); s += __shfl_xor(s, 16);
            if (r32 == 0) red[(tt * 32 + crow(r, h5)) * 4 + dvt] = s; }
        __syncthreads();
        const int col = hh * 128 + 32 * dvt + r32; const float wv = nw[32 * dvt + r32];
#pragma unroll
        for (int r = 0; r < 16; ++r) { const int row = 32 * tt + crow(r, h5); const f32x4 p = *(const LAS f32x4*)(red + row * 4);
            const float rstd = 1.0f / sqrtf(((p.x + p.y) + (p.z + p.w)) * (1.0f / 128.0f) + EPS); const size_t o = (R0 + row) * DM + col;
            Y[o] = (bf16_t)f2bf(acc[r] * rstd * wv * bf2f(GH[o])); }
    }
}
template <bool FINAL>
__device__ __forceinline__ void phase_lru(const Ctx& C, int e) {
    using namespace hg;
    LAS unsigned char* L = C.lds;
    constexpr unsigned UCB = 0, UCF = 16384, AT = 49152, BT = 81920;
    const bf16_t* P = WSP(bf16_t, WS_P); float* AG = WSP(float, WS_AG); const float* CARRY = WSP(float, WS_CARRY); bf16_t* Y = WSP(bf16_t, WS_Y);
    const bf16_t* WG = WSP(bf16_t, WS_WG) + (size_t)e * 4 * 128 * 1024;
    const float* cw = C.in[10] + (size_t)e * 4 * DLRU; const float* cb = C.in[11] + (size_t)e * DLRU;
    const float* ba = C.in[13] + (size_t)e * 2 * DLRU; const float* bx = C.in[15] + (size_t)e * 2 * DLRU; const float* lam = C.in[16] + (size_t)e * 2 * DLRU;
    const int w = C.wave, lane = C.lane, tid = C.tid, h5 = lane >> 5, r32 = lane & 31;
    const unsigned rt = w >> 2, et = w & 3;
    for (int u = gridDim.x - 1 - blockIdx.x; u < (MROWS / 64) * 8; u += gridDim.x) {
        const int ci2 = u >> 3, hd = u & 7; const int c = ci2 % NCH, bb = ci2 / NCH; const size_t R0 = (size_t)ci2 * 64;
        const int s0 = c * 64, lo = c < 4 ? 0 : CTX, hi = c < 4 ? CTX : SROW;
        __syncthreads();
        float cin = 0.f;
        if (FINAL && tid < 256) { const int dir = tid >> 7, ch = tid & 127; cin = CARRY[(size_t)(ci2 * 2 + dir) * DLRU + hd * 128 + ch]; }
        { const int chn = hd * 128 + 2 * lane; const bf16_t* up = P + DLRU + chn;
          f32x2 uv[11];
#pragma unroll
          for (int i = 0; i < 11; ++i) { const int s = s0 + 8 * w + i - 2; unsigned raw = 0u; if (s >= lo && s < hi) raw = *(const unsigned*)(up + ((size_t)bb * SROW + s) * ABNP);
              uv[i].x = __uint_as_float(raw << 16); uv[i].y = __uint_as_float(raw & 0xffff0000u); }
          f32x2 wj[4];
#pragma unroll
          for (int j = 0; j < 4; ++j) wj[j] = *(const f32x2*)(cw + j * DLRU + chn);
          const f32x2 bias = *(const f32x2*)(cb + chn);
#pragma unroll
          for (int i = 0; i < 8; ++i) { f32x2 a = bias;
#pragma unroll
              for (int j = 0; j < 4; ++j) a += uv[i + j] * wj[j];
              *(LAS unsigned*)(L + UCB + off_b(8 * w + i, lane >> 2) + (lane & 3) * 4) = pk2(a.x, a.y);
              *(LAS f32x2*)(L + UCF + ((8 * w + i) * 128 + 2 * lane) * 4) = a; } }
        __syncthreads();
        bf16x8 af[8]; float ucr[16];
#pragma unroll
        for (int ks = 0; ks < 8; ++ks) af[ks] = *(const LAS bf16x8*)(L + UCB + row_rd(lane, 32 * rt, ks));
#pragma unroll
        for (int r = 0; r < 16; ++r) ucr[r] = *(const LAS float*)(L + UCF + ((32 * rt + crow(r, h5)) * 128 + 32 * et + r32) * 4);
        const int chl = hd * 128 + 32 * et + r32;
#pragma unroll 1
        for (int dir = 0; dir < 2; ++dir) {
            f32x16 ga = {}, gx = {};
            { const bf16_t* wa = WG + ((size_t)(dir * 2 + 0) * 128 + 32 * et + r32) * 1024 + hd * 128 + 8 * h5; const bf16_t* wx = wa + (size_t)128 * 1024;
              bf16x8 fa[8], fx[8];
#pragma unroll
              for (int ks = 0; ks < 8; ++ks) { fa[ks] = *(const bf16x8*)(wa + 16 * ks); fx[ks] = *(const bf16x8*)(wx + 16 * ks); }
#pragma unroll
              for (int ks = 0; ks < 8; ++ks) { ga = __builtin_amdgcn_mfma_f32_32x32x16_bf16(af[ks], fa[ks], ga, 0, 0, 0); gx = __builtin_amdgcn_mfma_f32_32x32x16_bf16(af[ks], fx[ks], gx, 0, 0, 0); } }
            const float bav = ba[dir * DLRU + chl], bxv = bx[dir * DLRU + chl], sp = log1pf(__expf(-lam[dir * DLRU + chl]));
            if (dir == 1) __syncthreads();
#pragma unroll
            for (int r = 0; r < 16; ++r) { const float rg = __builtin_amdgcn_rcpf(1.0f + __expf(-(ga[r] + bav))), ig = __builtin_amdgcn_rcpf(1.0f + __expf(-(gx[r] + bxv)));
                const float la = -8.0f * rg * sp; const unsigned o = ((32 * rt + crow(r, h5)) * 128 + 32 * et + r32) * 4;
                *(LAS float*)(L + AT + o) = __expf(la); *(LAS float*)(L + BT + o) = __builtin_amdgcn_sqrtf(1.0f - __expf(2.0f * la)) * (ig * ucr[r]); }
            __syncthreads();
            if ((tid >> 7) == dir) { const int ch = tid & 127; const LAS float* ap = (const LAS float*)(L + AT) + ch; const LAS float* bp = (const LAS float*)(L + BT) + ch;
                if (!FINAL) { float h = 0.f, ap_ = 1.f;
#pragma unroll 16
                    for (int i = 0; i < 64; ++i) { const int row = dir == 0 ? i : 63 - i; const float a = ap[row * 128]; h = a * h + bp[row * 128]; ap_ *= a; }
                    float* ag = AG + ((size_t)(ci2 * 2 + dir) * 2) * DLRU + hd * 128 + ch; ag[0] = ap_; ag[DLRU] = h; }
                else if (dir == 0) { float h = cin; LAS float* hp = (LAS float*)(L + UCF) + ch;
#pragma unroll 16
                    for (int i = 0; i < 64; ++i) { h = ap[i * 128] * h + bp[i * 128]; hp[i * 128] = h; } }
                else { float h = cin; const LAS float* hp = (const LAS float*)(L + UCF) + ch; const bf16_t* gp = P + R0 * ABNP + hd * 128 + ch; bf16_t* yp = Y + R0 * DM + hd * 128 + ch;
#pragma unroll 8
                    for (int i = 63; i >= 0; --i) { h = ap[i * 128] * h + bp[i * 128]; const float hs = hp[i * 128] + h; yp[(size_t)i * DM] = (bf16_t)f2bf(hs * gelu_tanh(bf2f(gp[(size_t)i * ABNP]))); } } }
        }
    }
}
__device__ __forceinline__ void phase_lru_carry(const Ctx& C) {
    using namespace hg;
    const float* AG = WSP(float, WS_AG); float* CARRY = WSP(float, WS_CARRY);
    const int G = gridDim.x, first = G >= 8 ? G - 8 : 0;
    if ((int)blockIdx.x < first) return;
    for (int id = ((int)blockIdx.x - first) * 512 + C.tid; id < NBATCH * 2 * DLRU; id += (G - first) * 512) { const int b = id >> 11, dir = (id >> 10) & 1, ch = id & 1023;
        float carry = 0.f;
#pragma unroll 4
        for (int j = 0; j < NCH; ++j) { const int cc = dir == 0 ? j : (j < 4 ? 3 - j : 71 - j); const size_t ci2 = (size_t)b * NCH + cc;
            CARRY[(ci2 * 2 + dir) * DLRU + ch] = carry; const float* ag = AG + ((ci2 * 2 + dir) * 2) * DLRU + ch; carry = carry * ag[0] + ag[DLRU]; } }
}
__device__ __forceinline__ void phase_final(const Ctx& C) {
    const float* XS = WSP(float, WS_XS); const float* w = C.in[27];
    for (int r = C.gw; r < NBATCH * SEQ; r += C.ngw) { const int b = r / SEQ, t = r % SEQ; const size_t R = (size_t)b * SROW + CTX + t;
        const f32x4* xr = (const f32x4*)(XS + R * DM) + C.lane; f32x4 v[8]; float ss = 0.f;
#pragma unroll
        for (int j = 0; j < 8; ++j) { v[j] = xr[64 * j]; ss += (v[j].x * v[j].x + v[j].y * v[j].y) + (v[j].z * v[j].z + v[j].w * v[j].w); }
        const float rstd = 1.0f / sqrtf(wave_sum(ss) * (1.0f / DM) + EPS);
        f32x4* o = (f32x4*)(C.out + (size_t)r * DM) + C.lane;
#pragma unroll
        for (int j = 0; j < 8; ++j) { const f32x4 wv = *(const f32x4*)(w + (C.lane + 64 * j) * 4); o[64 * j] = v[j] * rstd * wv; } }
}

struct Args { const float* in[28]; float* out; unsigned char* ws; int ph_lo, ph_hi; };
constexpr int N_PHASES = 1 + 2 * 9 + 2 * 9 + 1;

__global__ void __launch_bounds__(512, 2) fwd_kernel(Args args) {
    extern __shared__ __attribute__((aligned(16))) unsigned char lds_raw[];
    LAS unsigned char* const lds0 = (LAS unsigned char*)lds_raw;
    const unsigned long long inaddr = (unsigned long long)__builtin_amdgcn_kernarg_segment_ptr();
    volatile LAS unsigned* misc = (volatile LAS unsigned*)(lds0 + LDS_MISC);
    if (threadIdx.x < 64) misc[threadIdx.x] = 0u;
    __syncthreads();
    const int lo = args.ph_lo, hi = args.ph_hi;
    const int wave0 = __builtin_amdgcn_readfirstlane(threadIdx.x >> 6);
    XcdBarrier bar; bar.bar = (unsigned*)(args.ws + WS_CTL) + 4096; bar.x = 0; bar.st = misc + 8;
    if (hi - lo > 1) bar = xcd_barrier_post((unsigned*)(args.ws + WS_CTL) + 4096, misc + 8);
    int pid = 0;
    const unsigned long long wsaddr = (unsigned long long)args.ws;
#define PH_BEGIN if (pid >= lo && pid < hi) { int l = l_; Ctx C; { unsigned long long a_ = inaddr, w_ = wsaddr; int t_; asm volatile("v_mbcnt_lo_u32_b32 %0, -1, 0\n\tv_mbcnt_hi_u32_b32 %0, -1, %0" : "=v"(t_)); t_ += wave0 * 64; asm volatile("" : "+s"(a_), "+s"(w_), "+s"(l)); \
        C.in = (InPtr)a_; C.ws = (unsigned char*)w_; C.out = args.out; C.lds = lds0; C.tid = t_; C.lane = t_ & 63; C.wave = __builtin_amdgcn_readfirstlane(t_ >> 6); \
        C.gw = blockIdx.x * 8 + C.wave; C.ngw = gridDim.x * 8; C.gtid = blockIdx.x * 512 + t_; C.ngt = gridDim.x * 512; } \
        const int e = l >> 1; const float* mod = WSP(float, WS_MOD) + (size_t)l * 3 * MODW; const int G = gridDim.x, cb = blockIdx.x; (void)e; (void)mod; (void)G; (void)cb;
#define PH_END } if (pid >= lo && pid + 1 < hi) xcd_barrier(bar); ++pid;
#ifndef PROBE_CAT
#define PROBE_CAT -1
#endif
#define DUP(cat, ...) { if (PROBE_CAT == (cat)) { const float SC_ = 0.f; (void)SC_; __VA_ARGS__ } { const float SC_ = 1.f; (void)SC_; __VA_ARGS__ } }
    int l_ = 0;
    PH_BEGIN
#ifndef SKIP_PRO
    DUP(0, phase_prologue(C);)
#endif
    PH_END

    constexpr int MLAT = NBATCH * SEQ;
    for (l_ = 0; l_ < DEPTH; ++l_) {
        PH_BEGIN DUP(1, phase_norm_mod(C, C.in[6] + l * DM, mod, 0, 1);) PH_END
        if ((l_ & 1) == 0) {
            PH_BEGIN DUP(2, { const bf16_t* wt = WSP(bf16_t, WS_WABIN) + (size_t)e * ABNP * DM;
                       { pg8::Gemm g{WSP(bf16_t, WS_H), wt, MLAT, ABNP, DM, DM, DM, 1}; pg8::StaticOrder S; S.init(MLAT, ABNP, G, cb); EpiBf16Plain E{WSP(bf16_t, WS_P), ABNP}; pg8::gemm_phase(C.lds, C.tid, g, S, E); }
                       { sg::SGemm g{WSP(bf16_t, WS_H), wt, ABNP, DM, DM, DM}; SEpiPlain E{WSP(bf16_t, WS_P), ABNP}; sg::sgemm_phase(C.lds, C.tid, g, 32 * (ABNP / 256), E); } }) PH_END
            PH_BEGIN DUP(3, { phase_lru<false>(C, e); phase_rs_kr(C); }) PH_END
            PH_BEGIN phase_lru_carry(C); DUP(4, { const bf16_t* wq = WSP(bf16_t, WS_WUQ) + (size_t)e * QW * 512; const bf16_t* wkv = WSP(bf16_t, WS_WUKV) + (size_t)e * KVW * 512;
                       { pg8::Gemm g{WSP(bf16_t, WS_P) + 2048, wq, MLAT, QW, 512, ABNP, 512, 1}; pg8::StaticOrder S; S.init(MLAT, QW, G, cb); EpiBf16RowScale E{WSP(bf16_t, WS_Q), QW, WSP(float, WS_RSQ)}; pg8::gemm_phase(C.lds, C.tid, g, S, E); }
                       { pg8::Gemm g{WSP(bf16_t, WS_P) + 2560, wkv, MLAT, KVW, 512, ABNP, 512, 1}; pg8::StaticOrder S; S.init(MLAT, KVW, G, cb); EpiBf16RowScale E{WSP(bf16_t, WS_KV), KVW, WSP(float, WS_RSKV)}; pg8::gemm_phase(C.lds, C.tid, g, S, E); }
                       { sg::SGemm g{WSP(bf16_t, WS_P) + 2048, wq, QW, 512, ABNP, 512}; SEpiRowScale E{WSP(bf16_t, WS_Q), QW, WSP(float, WS_RSQ)}; sg::sgemm_phase(C.lds, C.tid, g, 32 * (QW / 256), E); }
                       { sg::SGemm g{WSP(bf16_t, WS_P) + 2560, wkv, KVW, 512, ABNP, 512}; SEpiRowScale E{WSP(bf16_t, WS_KV), KVW, WSP(float, WS_RSKV)}; sg::sgemm_phase(C.lds, C.tid, g, 0, E); } })
            PH_END
            PH_BEGIN DUP(5, phase_lru<true>(C, e);) DUP(6, phase_attn(C);) PH_END
        } else {
            PH_BEGIN DUP(7, { const bf16_t* wt = WSP(bf16_t, WS_WHGIN) + (size_t)e * HGN * DM;
                       { pg8::Gemm g{WSP(bf16_t, WS_H), wt, MLAT, HGN, DM, DM, DM, 1}; pg8::StaticOrder S; S.init(MLAT, HGN, G, cb); EpiHG E{WSP(bf16_t, WS_QH), WSP(float, WS_LOGF), WSP(float, WS_LB) + l * 2048}; pg8::gemm_phase(C.lds, C.tid, g, S, E); }
                       { sg::SGemm g{WSP(bf16_t, WS_H), wt, HGN, DM, DM, DM}; SEpiHG E{WSP(bf16_t, WS_QH), WSP(float, WS_LOGF), WSP(float, WS_LB) + l * 2048}; sg::sgemm_phase(C.lds, C.tid, g, 32 * (HGN / 256), E); } }) PH_END
            PH_BEGIN DUP(8, phase_hg_ds(C);) PH_END
            PH_BEGIN DUP(9, phase_hg_scan(C);) PH_END
            PH_BEGIN DUP(10, phase_hg_out(C, e);) PH_END
        }
        PH_BEGIN DUP(11, { const bf16_t* wout = (l & 1) ? WSP(bf16_t, WS_WHGOUT) + (size_t)e * DM * DM : WSP(bf16_t, WS_WABOUT) + (size_t)e * DM * DM;
                   { pg8::Gemm g{WSP(bf16_t, WS_Y), wout, MLAT, DM, DM, DM, DM, 1}; pg8::StaticOrder S; S.init(MLAT, DM, G, cb); EpiResid E{WSP(float, WS_XS), mod + 2 * DM, SC_}; pg8::gemm_phase(C.lds, C.tid, g, S, E); }
                   if (l != DEPTH - 1) { sg::SGemm g{WSP(bf16_t, WS_Y), wout, DM, DM, DM, DM}; SEpiResid E{WSP(float, WS_XS), mod + 2 * DM, SC_}; sg::sgemm_phase(C.lds, C.tid, g, 32 * (DM / 256), E); } }) PH_END
        PH_BEGIN DUP(1, phase_norm_mod(C, C.in[7] + l * DM, mod, 3, 4);) PH_END
        PH_BEGIN DUP(12, { const bf16_t* wt = WSP(bf16_t, WS_W1) + (size_t)l * DFF * DM;
                   { pg8::Gemm g{WSP(bf16_t, WS_H), wt, MLAT, DFF, DM, DM, DM, 1}; pg8::StaticOrder S; S.init(MLAT, DFF, G, cb); EpiRelu2 E{WSP(bf16_t, WS_HID), DFF}; pg8::gemm_phase(C.lds, C.tid, g, S, E); }
                   if (l != DEPTH - 1) { sg::SGemm g{WSP(bf16_t, WS_H), wt, DFF, DM, DM, DM}; SEpiRelu2 E{WSP(bf16_t, WS_HID), DFF}; sg::sgemm_phase(C.lds, C.tid, g, 32 * (DFF / 256), E); } }) PH_END
        PH_BEGIN DUP(13, { const bf16_t* wt = WSP(bf16_t, WS_W2) + (size_t)l * DM * DFF;
                   { pg8::Gemm g{WSP(bf16_t, WS_HID), wt, MLAT, DM, DFF, DFF, DFF, 1}; pg8::StaticOrder S; S.init(MLAT, DM, G, cb); EpiResid E{WSP(float, WS_XS), mod + 5 * DM, SC_}; pg8::gemm_phase(C.lds, C.tid, g, S, E); }
                   if (l != DEPTH - 1) { sg::SGemm g{WSP(bf16_t, WS_HID), wt, DM, DFF, DFF, DFF}; SEpiResid E{WSP(float, WS_XS), mod + 5 * DM, SC_}; sg::sgemm_phase(C.lds, C.tid, g, 32 * (DM / 256), E); } }) PH_END
    }
    l_ = 0;
    PH_BEGIN phase_final(C); PH_END
}

#ifndef N_LAUNCH_MODE
#define N_LAUNCH_MODE 1
#endif
extern "C" void kernel_launch(void* const* d_in, const int* in_sizes, int n_in, void* d_out, int out_size, void* d_ws, size_t ws_size, hipStream_t stream) {
    static int grid = 0;
    if (grid == 0) {
        if (n_in != 28 || out_size != NBATCH * SEQ * DM || ws_size < WS_END) { fprintf(stderr, "kernel_launch: shape mismatch n_in %d out %d ws %zu (need %zu)\n", n_in, out_size, ws_size, (size_t)WS_END); grid = -1; return; }
        int dev = 0, cus = 0, per_cu = 0;
        if (hipGetDevice(&dev) != hipSuccess || hipDeviceGetAttribute(&cus, hipDeviceAttributeMultiprocessorCount, dev) != hipSuccess) { grid = -1; return; }
        if (hipFuncSetAttribute((const void*)fwd_kernel, hipFuncAttributeMaxDynamicSharedMemorySize, LDS_BYTES) != hipSuccess) { fprintf(stderr, "kernel_launch: hipFuncSetAttribute failed\n"); grid = -1; return; }
        if (hipOccupancyMaxActiveBlocksPerMultiprocessor(&per_cu, (const void*)fwd_kernel, 512, LDS_BYTES) != hipSuccess || per_cu < 1) fprintf(stderr, "kernel_launch: occupancy query says %d\n", per_cu);
        (void)hipGetLastError();
        grid = cus;
    }
    if (grid < 0) return;
    (void)hipMemsetAsync((char*)d_ws + WS_CTL, 0, CTL_BYTES, stream);
    Args a{};
    for (int i = 0; i < 28; ++i) a.in[i] = (const float*)d_in[i];
    a.out = (float*)d_out; a.ws = (unsigned char*)d_ws;
#if N_LAUNCH_MODE == 1
    a.ph_lo = 0; a.ph_hi = N_PHASES;
    hipLaunchKernelGGL(fwd_kernel, dim3(grid), dim3(512), LDS_BYTES, stream, a);
#else
    for (int p = 0; p < N_PHASES; ++p) { a.ph_lo = p; a.ph_hi = p + 1; hipLaunchKernelGGL(fwd_kernel, dim3(grid), dim3(512), LDS_BYTES, stream, a); }
#endif
    const hipError_t le = hipPeekAtLastError();
    if (le != hipSuccess) fprintf(stderr, "kernel_launch: launch failed: %s\n", hipGetErrorName(le));
}
```

```cpp
#include <hip/hip_runtime.h>
#include <cstdio>

#define LAS __attribute__((address_space(3)))
#define GAS __attribute__((address_space(1)))
typedef unsigned short bf16_t;
typedef short bf16x8 __attribute__((ext_vector_type(8)));
typedef float f32x4 __attribute__((ext_vector_type(4)));
typedef float f32x2 __attribute__((ext_vector_type(2)));
typedef unsigned u32x4 __attribute__((ext_vector_type(4)));
typedef unsigned u32x2 __attribute__((ext_vector_type(2)));

constexpr int DM = 2048, NBATCH = 2, SEQ = 4096, DEPTH = 4, CTX = 256;
constexpr int SROW = CTX + SEQ;
constexpr int MROWS = NBATCH * SROW;
constexpr int DFF = 8192, MODW = 6 * DM;
constexpr int DLRU = 1024;
constexpr int ABN = 3136, ABNP = 3328;
constexpr int QW = 1536, KVW = 2048, HGN = 10240;
constexpr float EPS = 1e-6f;
constexpr float ATTN_SCALE = 0.07216878364870322f;

constexpr size_t al256(size_t x) { return (x + 255) & ~(size_t)255; }
constexpr size_t WS_CTL = 0, CTL_BYTES = 1u << 20;
constexpr size_t WS_MOD = WS_CTL + CTL_BYTES;
constexpr size_t WS_LB = WS_MOD + al256((size_t)DEPTH * 3 * MODW * 4);
constexpr size_t WS_ROPE = WS_LB + al256((size_t)DEPTH * 2048 * 4);
constexpr size_t WS_RSQ = WS_ROPE + al256(2 * 64 * 16 * 4);
constexpr size_t WS_RSKV = WS_RSQ + al256((size_t)MROWS * 4);
constexpr size_t WS_WABIN = WS_RSKV + al256((size_t)MROWS * 4);
constexpr size_t WS_WABOUT = WS_WABIN + (size_t)2 * ABNP * DM * 2;
constexpr size_t WS_WUQ = WS_WABOUT + (size_t)2 * DM * DM * 2;
constexpr size_t WS_WUKV = WS_WUQ + (size_t)2 * QW * 512 * 2;
constexpr size_t WS_WHGIN = WS_WUKV + (size_t)2 * KVW * 512 * 2;
constexpr size_t WS_WHGOUT = WS_WHGIN + (size_t)2 * HGN * DM * 2;
constexpr size_t WS_W1 = WS_WHGOUT + (size_t)2 * DM * DM * 2;
constexpr size_t WS_W2 = WS_W1 + (size_t)4 * DFF * DM * 2;
constexpr size_t WS_WG = WS_W2 + (size_t)4 * DFF * DM * 2;
constexpr size_t WS_XS = WS_WG + (size_t)2 * 4 * 128 * 1024 * 2;
constexpr size_t WS_H = WS_XS + (size_t)MROWS * DM * 4;
constexpr size_t WS_Y = WS_H + (size_t)MROWS * DM * 2;
constexpr size_t WS_BIG = WS_Y + (size_t)MROWS * DM * 2;
constexpr size_t WS_P = WS_BIG;
constexpr size_t WS_AG = WS_P + (size_t)MROWS * ABNP * 2;
constexpr size_t WS_CARRY = WS_AG + al256((size_t)(MROWS / 64) * 2 * 2 * DLRU * 4);
constexpr size_t WS_Q = WS_CARRY + al256((size_t)(MROWS / 64) * 2 * DLRU * 4);
constexpr size_t WS_KV = WS_Q + (size_t)MROWS * QW * 2;
constexpr size_t WS_KR = WS_KV + (size_t)MROWS * KVW * 2;
constexpr size_t WS_AB_END = WS_KR + (size_t)MROWS * 64 * 2;
constexpr size_t WS_QH = WS_BIG;
constexpr size_t WS_VH = WS_QH + (size_t)MROWS * DM * 2;
constexpr size_t WS_GH = WS_VH + (size_t)MROWS * DM * 2;
constexpr size_t WS_LOGF = WS_GH + (size_t)MROWS * DM * 2;
constexpr size_t WS_DS = WS_LOGF + (size_t)2 * MROWS * DM * 4;
constexpr size_t WS_DEC = WS_DS + (size_t)64 * 68 * 16384 * 4;
constexpr size_t WS_SS = WS_DEC + (size_t)64 * 68 * 128 * 4;
constexpr size_t WS_HG_END = WS_SS + (size_t)64 * 68 * 16384 * 2;
constexpr size_t WS_HID = WS_BIG;
constexpr size_t WS_MLP_END = WS_HID + (size_t)MROWS * DFF * 2;
constexpr size_t cmax(size_t a, size_t b) { return a > b ? a : b; }
constexpr size_t WS_END = cmax(cmax(WS_AB_END, WS_HG_END), WS_MLP_END);

constexpr int LDS_BYTES = 147456;
constexpr int LDS_MISC = 131072;

__device__ __forceinline__ float bf2f(bf16_t v) { return __uint_as_float(((unsigned)v) << 16); }
__device__ __forceinline__ unsigned f2bf(float f) { unsigned u = __float_as_uint(f); return (u + 0x7fffu + ((u >> 16) & 1u)) >> 16; }
__device__ __forceinline__ unsigned pk2(float lo, float hi) { return f2bf(lo) | (f2bf(hi) << 16); }
__device__ __forceinline__ float wave_sum(float v) {
#pragma unroll
    for (int o = 1; o < 64; o <<= 1) v += __shfl_xor(v, o);
    return v;
}
__device__ __forceinline__ float wave_max(float v) {
#pragma unroll
    for (int o = 1; o < 64; o <<= 1) v = fmaxf(v, __shfl_xor(v, o));
    return v;
}
__device__ __forceinline__ float sigmoidf_(float x) { return 1.0f / (1.0f + expf(-x)); }
__device__ __forceinline__ float siluf_(float x) { return x / (1.0f + expf(-x)); }
__device__ __forceinline__ float gelu_tanh(float x) { const float u = 0.7978845608028654f * (x + 0.044715f * x * x * x); return 0.5f * x * (1.0f + tanhf(u)); }

#define XB_TMO      128
#define XB_XCNT(j)  (256  + 64 * (j))
#define XB_XSUB(j)  (1280 + 64 * (j))
#define XB_XGEN(j)  (2304 + 64 * (j))
#define XB_TOP      3328
#define XB_TOPGEN   3392
#define XCD_BAR_WORDS 3456
#define XB_SPIN_CAP (1u << 18)
__device__ __forceinline__ unsigned xb_ld(unsigned* p)              { return __hip_atomic_load(p, __ATOMIC_RELAXED, __HIP_MEMORY_SCOPE_AGENT); }
__device__ __forceinline__ unsigned xb_add(unsigned* p, unsigned v) { return __hip_atomic_fetch_add(p, v, __ATOMIC_RELAXED, __HIP_MEMORY_SCOPE_AGENT); }
__device__ __forceinline__ unsigned xb_xcc_id() { return (unsigned)__builtin_amdgcn_s_getreg((3 << 11) | 20) & 0xFu; }
#define XB_SPIN(cond, bar) do { unsigned _sp = 0; while (cond) { __builtin_amdgcn_s_sleep(1); \
    if ((++_sp & 255u) == 0u) { if (xb_ld(&(bar)[XB_TMO])) break; if (_sp > XB_SPIN_CAP) { atomicAdd(&(bar)[XB_TMO], 1u); break; } } } } while (0)
struct XcdBarrier { unsigned* bar; unsigned x; volatile LAS unsigned* st; };
__device__ __forceinline__ XcdBarrier xcd_barrier_post(unsigned* bar, volatile LAS unsigned* st) {
    XcdBarrier b; b.bar = bar; b.x = xb_xcc_id(); b.st = st;
    if (threadIdx.x == 0) (void)xb_add(&bar[XB_XCNT(b.x)], 1u);
    return b;
}
__device__ __forceinline__ void xcd_barrier_complete(unsigned* bar, unsigned x, unsigned& nloc, unsigned& nx) {
    const unsigned G = gridDim.x * gridDim.y * gridDim.z;
    unsigned sum, cnt, mine, sp = 0u;
    for (;;) {
        sum = 0u; cnt = 0u; mine = 0u;
#pragma unroll
        for (unsigned j = 0; j < 16; ++j) { const unsigned c = xb_ld(&bar[XB_XCNT(j)]); sum += c; cnt += (c > 0u) ? 1u : 0u; mine = (j == x) ? c : mine; }
        if (sum == G) break;
        __builtin_amdgcn_s_sleep(1);
        if ((++sp & 255u) == 0u) { if (xb_ld(&bar[XB_TMO])) break; if (sp > XB_SPIN_CAP) { atomicAdd(&bar[XB_TMO], 1u); break; } }
    }
    nloc = mine > 0u ? mine : 1u; nx = cnt > 0u ? cnt : 1u;
}
__device__ __forceinline__ void xcd_barrier(const XcdBarrier& b) {
    asm volatile("s_waitcnt vmcnt(0)" ::: "memory");
    __syncthreads();
    if (threadIdx.x == 0) {
        unsigned* bar = b.bar; asm volatile("" : "+s"(bar)); bar = (unsigned*)(GAS unsigned*)bar;
        __builtin_amdgcn_s_waitcnt(0);
        unsigned nloc = b.st[0], nx = b.st[1];
        if (nloc == 0u) { xcd_barrier_complete(bar, b.x, nloc, nx); b.st[0] = nloc; b.st[1] = nx; }
        const unsigned old = xb_add(&bar[XB_XSUB(b.x)], 1u);
        const unsigned gen = old / nloc;
        if (old + 1u == (gen + 1u) * nloc) {
            __builtin_amdgcn_fence(__ATOMIC_RELEASE, "agent");
            asm volatile("s_waitcnt vmcnt(0)" ::: "memory");
            const unsigned og = xb_add(&bar[XB_TOP], 1u);
            const unsigned tg = og / nx;
            if (og + 1u == (tg + 1u) * nx) xb_add(&bar[XB_TOPGEN], 1u);
            else XB_SPIN(xb_ld(&bar[XB_TOPGEN]) == tg, bar);
            __builtin_amdgcn_fence(__ATOMIC_ACQUIRE, "agent");
            xb_add(&bar[XB_XGEN(b.x)], 1u);
            asm volatile("s_waitcnt vmcnt(0)" ::: "memory");
        } else {
            XB_SPIN(xb_ld(&bar[XB_XGEN(b.x)]) == gen, bar);
            __builtin_amdgcn_fence(__ATOMIC_ACQUIRE, "agent");
            asm volatile("s_waitcnt vmcnt(0)" ::: "memory");
        }
    }
    __syncthreads();
}

namespace pg8 {
constexpr int BM = 256, BK = 64, HALF = 128, HTB = HALF * BK * 2, STAGE_BYTES = 8 * HTB, NXCD = 8, WGM = 8;
__host__ __device__ __forceinline__ int lds_byte(int r, int c) { const int st = (r >> 4) * 2 + (c >> 5), rr = r & 15, cc = c & 31, ob = rr * 64 + cc * 2; return st * 1024 + (ob ^ (((ob >> 9) & 1) << 5)); }
__host__ __device__ __forceinline__ void stage_rc(int b, int& R, int& C) { const int st = b / 1024, sb = b % 1024, swz = sb ^ (((sb >> 9) & 1) << 5); R = (st >> 1) * 16 + swz / 64; C = (st & 1) * 32 + (swz % 64) / 2; }
__host__ __device__ __forceinline__ int perm32(int rho) { const int n = rho >> 4, i = rho & 15; return 8 * (i >> 2) + 4 * n + (i & 3); }
struct Unit { int pm, pn; };
struct Gemm { const bf16_t* A; const bf16_t* Bt; int M, N, K, lda, ldb, lat; };
struct StaticOrder {
    int nM, nN, nwg, G, c;
    __host__ __device__ void init(int M, int N, int G_, int c_) { nM = M / BM; nN = N / BM; nwg = nM * nN; G = G_; c = c_; }
    __host__ __device__ bool next(int i, Unit& u) const {
        const long L = (long)i * G + c; if (L >= nwg) return false;
        int wgid = (int)L; { const int q = nwg / NXCD, r = nwg % NXCD, xcd = wgid % NXCD, off = wgid / NXCD; wgid = (xcd < r ? xcd * (q + 1) : r * (q + 1) + (xcd - r) * q) + off; }
        const int nig = WGM * nN, gid = wgid / nig, fm = gid * WGM, gsz = (nM - fm) < WGM ? (nM - fm) : WGM;
        u.pm = fm + ((wgid % nig) % gsz); u.pn = (wgid % nig) / gsz; return true;
    }
};
__device__ __forceinline__ unsigned cvt_pk_bf16(float lo, float hi) { unsigned r; asm volatile("v_cvt_pk_bf16_f32 %0, %1, %2" : "=v"(r) : "v"(lo), "v"(hi)); return r; }

template <class Epi>
__device__ __forceinline__ void gemm_phase(LAS unsigned char* lds, const int tid, const Gemm g, const StaticOrder& S, const Epi& E) {
    const int wid = __builtin_amdgcn_readfirstlane(tid >> 6), lane = tid & 63, wr = wid >> 2, wc = wid & 3, fr = lane & 15, fq = lane >> 4;
    const int K = g.K, nt = K / BK;
    unsigned voffA[2], voffB[2];
#pragma unroll
    for (int i = 0; i < 2; ++i) { int R, C; stage_rc(tid * 16 + i * 8192, R, C); const int Rb = Epi::PERM ? ((R & ~31) + perm32(R & 31)) : R;
        voffA[i] = (unsigned)(R * g.lda + C) * 2u; voffB[i] = (unsigned)(Rb * g.ldb + C) * 2u; }
    const size_t kstep = (size_t)(BK * 2);
    const size_t hsA = (size_t)HALF * g.lda * 2, hsB = (size_t)HALF * g.ldb * 2;
    const size_t tsA = 2 * hsA, tsB = 2 * hsB;
    const unsigned ldsw = (unsigned)wid * 1024u;
    const int aoff = lds_byte(wr * 64 + fr, fq * 8), boff = lds_byte(wc * 32 + fr, fq * 8);
#define PG8_SA(b, h) (((b) * 2 + (h)) * HTB)
#define PG8_SB(b, h) ((4 + (b) * 2 + (h)) * HTB)
#define PG8_STAGE(bufoff, gbase, voff) do { _Pragma("unroll") for (int _i = 0; _i < 2; ++_i) \
        __builtin_amdgcn_global_load_lds((const unsigned*)((const char*)(gbase) + (voff)[_i]), (LAS unsigned*)(lds + (bufoff) + ldsw + _i * 8192), 16, 0, 0); } while (0)
#define PG8_LDA(dst, b, h) do { _Pragma("unroll") for (int m = 0; m < 4; ++m) _Pragma("unroll") for (int k = 0; k < 2; ++k) dst[m][k] = *(const LAS bf16x8*)(lds + PG8_SA(b, h) + aoff + m * 2048 + k * 1024); } while (0)
#define PG8_LDB(dst, b, h) do { _Pragma("unroll") for (int n = 0; n < 2; ++n) _Pragma("unroll") for (int k = 0; k < 2; ++k) dst[n][k] = *(const LAS bf16x8*)(lds + PG8_SB(b, h) + boff + n * 2048 + k * 1024); } while (0)
#define PG8_MMA(ai, bj, At, Bt) do { __builtin_amdgcn_s_setprio(1); _Pragma("unroll") for (int m = 0; m < 4; ++m) _Pragma("unroll") for (int n = 0; n < 2; ++n) _Pragma("unroll") for (int k = 0; k < 2; ++k) \
        acc[ai][bj][m][n] = __builtin_amdgcn_mfma_f32_16x16x32_bf16(Bt[n][k], At[m][k], acc[ai][bj][m][n], 0, 0, 0); __builtin_amdgcn_s_setprio(0); } while (0)
#define PG8_WAIT_V(n) asm volatile("s_waitcnt vmcnt(" #n ")" ::: "memory")
#define PG8_WAIT_L(n) asm volatile("s_waitcnt lgkmcnt(" #n ")" ::: "memory")
#define PG8_BAR __builtin_amdgcn_s_barrier()
#define PG8_SCHED __builtin_amdgcn_sched_barrier(0)
    Unit cur, nxt; int ui = 0;
    if (!S.next(0, cur)) return;
    if (g.lat) cur.pm += (cur.pm >> 4) + 1;
    f32x4 acc[2][2][4][2];
#pragma unroll
    for (int a = 0; a < 2; ++a)
#pragma unroll
        for (int b = 0; b < 2; ++b)
#pragma unroll
            for (int m = 0; m < 4; ++m)
#pragma unroll
                for (int n = 0; n < 2; ++n) acc[a][b][m][n] = (f32x4){0.f, 0.f, 0.f, 0.f};
    bf16x8 At[4][2], B0[2][2], B1[2][2];
    const char* cA = (const char*)g.A + (size_t)cur.pm * tsA; const char* cB = (const char*)g.Bt + (size_t)cur.pn * tsB;
    PG8_STAGE(PG8_SB(0, 0), cB, voffB); PG8_STAGE(PG8_SA(0, 0), cA, voffA); PG8_STAGE(PG8_SB(0, 1), cB + hsB, voffB); PG8_STAGE(PG8_SA(0, 1), cA + hsA, voffA);
    if (wr == 1) PG8_BAR;
    PG8_WAIT_V(4); PG8_BAR;
    PG8_STAGE(PG8_SB(1, 0), cB + kstep, voffB); PG8_STAGE(PG8_SA(1, 0), cA + kstep, voffA); PG8_STAGE(PG8_SB(1, 1), cB + hsB + kstep, voffB);
    PG8_WAIT_V(6); PG8_BAR;
    for (;;) {
        const bool has_next = S.next(ui + 1, nxt);
        if (g.lat && has_next) nxt.pm += (nxt.pm >> 4) + 1;
        const char* nA = has_next ? (const char*)g.A + (size_t)nxt.pm * tsA : cA; const char* nB = has_next ? (const char*)g.Bt + (size_t)nxt.pn * tsB : cB;
        for (int t = 0; t < nt; t += 2) {
            const bool last = (t == nt - 2);
            const char* a1 = cA + (size_t)(t + 1) * kstep;
            const char* a2 = last ? nA : cA + (size_t)(t + 2) * kstep; const char* b2 = last ? nB : cB + (size_t)(t + 2) * kstep;
            const char* a3 = a2 + kstep; const char* b3 = b2 + kstep;
            PG8_LDB(B0, 0, 0); PG8_SCHED; PG8_LDA(At, 0, 0); PG8_STAGE(PG8_SA(1, 1), a1 + hsA, voffA);
            PG8_WAIT_L(8); PG8_BAR; PG8_WAIT_L(0); PG8_MMA(0, 0, At, B0); PG8_BAR; PG8_SCHED;
            PG8_LDB(B1, 0, 1); PG8_STAGE(PG8_SB(0, 0), b2, voffB);
            PG8_BAR; PG8_WAIT_L(0); PG8_MMA(0, 1, At, B1); PG8_BAR;
            PG8_LDA(At, 0, 1); PG8_STAGE(PG8_SA(0, 0), a2, voffA);
            PG8_BAR; PG8_WAIT_L(0); PG8_MMA(1, 0, At, B0); PG8_BAR; PG8_SCHED;
            PG8_STAGE(PG8_SB(0, 1), b2 + hsB, voffB);
            PG8_WAIT_V(6); PG8_BAR; PG8_MMA(1, 1, At, B1); PG8_BAR;
            PG8_LDB(B0, 1, 0); PG8_SCHED; PG8_LDA(At, 1, 0); PG8_STAGE(PG8_SA(0, 1), a2 + hsA, voffA);
            PG8_WAIT_L(8); PG8_BAR; PG8_WAIT_L(0); PG8_MMA(0, 0, At, B0); PG8_BAR; PG8_SCHED;
            PG8_LDB(B1, 1, 1); PG8_STAGE(PG8_SB(1, 0), b3, voffB);
            PG8_BAR; PG8_WAIT_L(0); PG8_MMA(0, 1, At, B1); PG8_BAR;
            PG8_LDA(At, 1, 1); PG8_STAGE(PG8_SA(1, 0), a3, voffA);
            PG8_BAR; PG8_WAIT_L(0); PG8_MMA(1, 0, At, B0); PG8_BAR; PG8_SCHED;
            PG8_STAGE(PG8_SB(1, 1), b3 + hsB, voffB);
            PG8_WAIT_V(6); PG8_BAR; PG8_MMA(1, 1, At, B1); PG8_BAR;
        }
        E(acc, cur, wr, wc, fr, fq);
        if (!has_next) break;
#pragma unroll
        for (int a = 0; a < 2; ++a)
#pragma unroll
            for (int b = 0; b < 2; ++b)
#pragma unroll
                for (int m = 0; m < 4; ++m)
#pragma unroll
                    for (int n = 0; n < 2; ++n) acc[a][b][m][n] = (f32x4){0.f, 0.f, 0.f, 0.f};
        cur = nxt; cA = nA; cB = nB; ++ui;
    }
    PG8_WAIT_V(0);
    if (wr == 0) PG8_BAR;
    PG8_BAR;
#undef PG8_SA
#undef PG8_SB
#undef PG8_STAGE
#undef PG8_LDA
#undef PG8_LDB
#undef PG8_MMA
#undef PG8_WAIT_V
#undef PG8_WAIT_L
#undef PG8_BAR
#undef PG8_SCHED
}
}

#define EPI_ROWS_COLS_PERM \
    const int row0 = u.pm * 256 + wr * 64 + fr; const int col0 = u.pn * 256 + wc * 32 + 8 * fq;
struct EpiBf16Plain {
    static constexpr bool PERM = true;
    bf16_t* O; int ldc;
    __device__ __forceinline__ void operator()(const f32x4 (&acc)[2][2][4][2], const pg8::Unit& u, int wr, int wc, int fr, int fq) const {
        EPI_ROWS_COLS_PERM
#pragma unroll
        for (int ai = 0; ai < 2; ++ai)
#pragma unroll
            for (int m = 0; m < 4; ++m) { bf16_t* rowp = O + (size_t)(row0 + ai * 128 + m * 16) * ldc + col0;
#pragma unroll
                for (int bj = 0; bj < 2; ++bj) { const f32x4 v0 = acc[ai][bj][m][0], v1 = acc[ai][bj][m][1];
                    u32x4 w; w.x = pk2(v0[0], v0[1]); w.y = pk2(v0[2], v0[3]); w.z = pk2(v1[0], v1[1]); w.w = pk2(v1[2], v1[3]);
                    *(u32x4*)(rowp + bj * 128) = w; } }
    }
};
struct EpiBf16RowScale {
    static constexpr bool PERM = true;
    bf16_t* O; int ldc; const float* rs;
    __device__ __forceinline__ void operator()(const f32x4 (&acc)[2][2][4][2], const pg8::Unit& u, int wr, int wc, int fr, int fq) const {
        EPI_ROWS_COLS_PERM
#pragma unroll
        for (int ai = 0; ai < 2; ++ai)
#pragma unroll
            for (int m = 0; m < 4; ++m) { const int row = row0 + ai * 128 + m * 16; const float s = rs[row]; bf16_t* rowp = O + (size_t)row * ldc + col0;
#pragma unroll
                for (int bj = 0; bj < 2; ++bj) { const f32x4 v0 = acc[ai][bj][m][0] * s, v1 = acc[ai][bj][m][1] * s;
                    u32x4 w; w.x = pk2(v0[0], v0[1]); w.y = pk2(v0[2], v0[3]); w.z = pk2(v1[0], v1[1]); w.w = pk2(v1[2], v1[3]);
                    *(u32x4*)(rowp + bj * 128) = w; } }
    }
};
struct EpiRelu2 {
    static constexpr bool PERM = true;
    bf16_t* O; int ldc;
    __device__ __forceinline__ void operator()(const f32x4 (&acc)[2][2][4][2], const pg8::Unit& u, int wr, int wc, int fr, int fq) const {
        EPI_ROWS_COLS_PERM
#pragma unroll
        for (int ai = 0; ai < 2; ++ai)
#pragma unroll
            for (int m = 0; m < 4; ++m) { bf16_t* rowp = O + (size_t)(row0 + ai * 128 + m * 16) * ldc + col0;
#pragma unroll
                for (int bj = 0; bj < 2; ++bj) { f32x4 v0 = acc[ai][bj][m][0], v1 = acc[ai][bj][m][1];
#pragma unroll
                    for (int j = 0; j < 4; ++j) { const float a = fmaxf(v0[j], 0.f), b = fmaxf(v1[j], 0.f); v0[j] = a * a; v1[j] = b * b; }
                    u32x4 w; w.x = pk2(v0[0], v0[1]); w.y = pk2(v0[2], v0[3]); w.z = pk2(v1[0], v1[1]); w.w = pk2(v1[2], v1[3]);
                    *(u32x4*)(rowp + bj * 128) = w; } }
    }
};
struct EpiResid {
    static constexpr bool PERM = false;
    float* XS; const float* gate; float scale;
    __device__ __forceinline__ void operator()(const f32x4 (&acc)[2][2][4][2], const pg8::Unit& u, int wr, int wc, int fr, int fq) const {
        const int row0 = u.pm * 256 + wr * 64 + fr, col0 = u.pn * 256 + wc * 32 + 4 * fq;
        const int cond = (u.pm % 17 == 0) ? 2 : (u.pm / 17);
        const float* gp = gate + (size_t)cond * MODW + col0;
        f32x4 gv[2][2];
#pragma unroll
        for (int bj = 0; bj < 2; ++bj)
#pragma unroll
            for (int n = 0; n < 2; ++n) gv[bj][n] = *(const f32x4*)(gp + bj * 128 + n * 16) * scale;
#pragma unroll
        for (int ai = 0; ai < 2; ++ai)
#pragma unroll
            for (int m = 0; m < 4; ++m) { float* rowp = XS + (size_t)(row0 + ai * 128 + m * 16) * DM + col0;
#pragma unroll
                for (int bj = 0; bj < 2; ++bj)
#pragma unroll
                    for (int n = 0; n < 2; ++n) { f32x4* p = (f32x4*)(rowp + bj * 128 + n * 16); *p = *p + gv[bj][n] * acc[ai][bj][m][n]; } }
    }
};
struct EpiHG {
    static constexpr bool PERM = true;
    bf16_t* QVG; float* LOGF; const float* lb;
    __device__ __forceinline__ void operator()(const f32x4 (&acc)[2][2][4][2], const pg8::Unit& u, int wr, int wc, int fr, int fq) const {
        const int row0 = u.pm * 256 + wr * 64 + fr; const int seg = u.pn >> 3; const int col0 = (u.pn & 7) * 256 + wc * 32 + 8 * fq;
        if (seg == 1 || seg == 2) {
            float* base = LOGF + (size_t)(seg - 1) * MROWS * DM;
            f32x4 lbv[2][2];
#pragma unroll
            for (int bj = 0; bj < 2; ++bj)
#pragma unroll
                for (int n = 0; n < 2; ++n) lbv[bj][n] = *(const f32x4*)(lb + col0 + bj * 128 + 4 * n);
#pragma unroll
            for (int ai = 0; ai < 2; ++ai)
#pragma unroll
                for (int m = 0; m < 4; ++m) { float* rowp = base + (size_t)(row0 + ai * 128 + m * 16) * DM + col0;
#pragma unroll
                    for (int bj = 0; bj < 2; ++bj)
#pragma unroll
                        for (int n = 0; n < 2; ++n) { f32x4 v = acc[ai][bj][m][n];
#pragma unroll
                            for (int j = 0; j < 4; ++j) { const float l = lbv[bj][n][j]; v[j] = logf(l + (1.0f - l) * sigmoidf_(v[j])); }
                            *(f32x4*)(rowp + bj * 128 + 4 * n) = v; } }
        } else {
            const int bi = seg - 2 + (seg == 0 ? 2 : 0);
            bf16_t* base = QVG + (size_t)bi * MROWS * DM;
            const bool act = (seg != 3);
#pragma unroll
            for (int ai = 0; ai < 2; ++ai)
#pragma unroll
                for (int m = 0; m < 4; ++m) { bf16_t* rowp = base + (size_t)(row0 + ai * 128 + m * 16) * DM + col0;
#pragma unroll
                    for (int bj = 0; bj < 2; ++bj) { f32x4 v0 = acc[ai][bj][m][0], v1 = acc[ai][bj][m][1];
                        if (act) {
#pragma unroll
                            for (int j = 0; j < 4; ++j) { v0[j] = siluf_(v0[j]); v1[j] = siluf_(v1[j]); } }
                        u32x4 w; w.x = pk2(v0[0], v0[1]); w.y = pk2(v0[2], v0[3]); w.z = pk2(v1[0], v1[1]); w.w = pk2(v1[2], v1[3]);
                        *(u32x4*)(rowp + bj * 128) = w; } }
        }
    }
};


namespace sg {
struct SGemm { const bf16_t* A; const bf16_t* Bt; int N, K, lda, ldb; };
__device__ __forceinline__ unsigned red_off(int w, int row, int col) { return (unsigned)((((w * 64 + row) * 16) + ((col >> 2) ^ (row & 15))) * 16); }
template <class Epi>
__device__ __forceinline__ void sgemm_phase(LAS unsigned char* lds, int tid, const SGemm& g, int nbig, const Epi& E) {
    const int G = gridDim.x, c = blockIdx.x, nsm = 8 * (g.N >> 6), r = nbig % G;
    int start, stride;
    if (r == 0) { start = (G % 8 == 0) ? (c % 8) * (G / 8) + c / 8 : c; stride = G; }
    else { start = c - r; stride = G - r; if (c < r) start = nsm; }
    const int w = __builtin_amdgcn_readfirstlane(tid >> 6), lane = tid & 63, fr = lane & 15, fq = lane >> 4;
    const int kw = g.K >> 3, nk2 = kw >> 6;
    bf16x8 xa[4][2], xb[4][2], ya[4][2], yb[4][2];
    const int voA = (fr * g.lda + w * kw + 16 * fq) * 2, voB = (fr * g.ldb + w * kw + 16 * fq) * 2;
    const int sAb = 16 * g.lda * 2, sBb = 16 * g.ldb * 2;
    __amdgpu_buffer_rsrc_t rA, rB;
#define SG_PTRS(su) do { const int mt_ = (su) & 7, nt_ = (su) >> 3; \
        rA = __builtin_amdgcn_make_buffer_rsrc((void*)(g.A + ((size_t)(mt_ >> 2) * SROW + (mt_ & 3) * 64) * g.lda), 0, 64 * g.lda * 2, 0x00020000); \
        rB = __builtin_amdgcn_make_buffer_rsrc((void*)(g.Bt + (size_t)nt_ * 64 * g.ldb), 0, 64 * g.ldb * 2, 0x00020000); } while (0)
#define SG_LD1(r, vo, so) __builtin_bit_cast(bf16x8, __builtin_amdgcn_raw_buffer_load_b128(r, vo, so, 0))
#define SG_LOAD(a, b, k2) do { _Pragma("unroll") for (int i = 0; i < 4; ++i) { a[i][0] = SG_LD1(rA, voA, i * sAb + (k2) * 128); a[i][1] = SG_LD1(rA, voA, i * sAb + (k2) * 128 + 16); \
        b[i][0] = SG_LD1(rB, voB, i * sBb + (k2) * 128); b[i][1] = SG_LD1(rB, voB, i * sBb + (k2) * 128 + 16); } } while (0)
#define SG_MMA(a, b) do { _Pragma("unroll") for (int hh = 0; hh < 2; ++hh) _Pragma("unroll") for (int m = 0; m < 4; ++m) _Pragma("unroll") for (int n = 0; n < 4; ++n) \
        acc[m][n] = __builtin_amdgcn_mfma_f32_16x16x32_bf16(b[n][hh], a[m][hh], acc[m][n], 0, 0, 0); } while (0)
#define SG_SB __builtin_amdgcn_sched_barrier(0)
    if (start < nsm) { SG_PTRS(start); SG_LOAD(xa, xb, 0); }
    for (int su = start; su < nsm; su += stride) {
        f32x4 acc[4][4];
#pragma unroll
        for (int m = 0; m < 4; ++m)
#pragma unroll
            for (int n = 0; n < 4; ++n) acc[m][n] = (f32x4){0.f, 0.f, 0.f, 0.f};
        if (nk2 > 1) SG_LOAD(ya, yb, 1);
        SG_SB;
        for (int k2 = 0; k2 < nk2; k2 += 2) {
            SG_MMA(xa, xb); SG_SB; if (k2 + 2 < nk2) SG_LOAD(xa, xb, k2 + 2); SG_SB;
            if (k2 + 1 < nk2) { SG_MMA(ya, yb); SG_SB; if (k2 + 3 < nk2) SG_LOAD(ya, yb, k2 + 3); SG_SB; }
        }
        if (su + stride < nsm) { SG_PTRS(su + stride); SG_LOAD(xa, xb, 0); }
        SG_SB;
        __syncthreads();
#pragma unroll
        for (int m = 0; m < 4; ++m)
#pragma unroll
            for (int n = 0; n < 4; ++n) *(LAS f32x4*)(lds + red_off(w, 16 * m + fr, 16 * n + 4 * fq)) = acc[m][n];
        __syncthreads();
        const int row = tid >> 3, c8 = (tid & 7) * 8;
        f32x4 s0 = {0.f, 0.f, 0.f, 0.f}, s1 = {0.f, 0.f, 0.f, 0.f};
#pragma unroll
        for (int ww = 0; ww < 8; ++ww) { s0 += *(const LAS f32x4*)(lds + red_off(ww, row, c8)); s1 += *(const LAS f32x4*)(lds + red_off(ww, row, c8 + 4)); }
        float v[8] = {s0.x, s0.y, s0.z, s0.w, s1.x, s1.y, s1.z, s1.w};
        const int mt = su & 7, nt = su >> 3;
        E((size_t)(mt >> 2) * SROW + (mt & 3) * 64 + row, nt * 64 + c8, v);
    }
#undef SG_SB
#undef SG_LOAD
#undef SG_MMA
#undef SG_PTRS
#undef SG_LD1
    __syncthreads();
}
}
__device__ __forceinline__ void st_bf16x8(bf16_t* p, const float (&v)[8]) { u32x4 w; w.x = pk2(v[0], v[1]); w.y = pk2(v[2], v[3]); w.z = pk2(v[4], v[5]); w.w = pk2(v[6], v[7]); *(u32x4*)p = w; }
struct SEpiPlain { bf16_t* O; int ldc;
    __device__ __forceinline__ void operator()(size_t R, int col, const float (&v)[8]) const { st_bf16x8(O + R * ldc + col, v); } };
struct SEpiRowScale { bf16_t* O; int ldc; const float* rs;
    __device__ __forceinline__ void operator()(size_t R, int col, const float (&v)[8]) const { const float s = rs[R]; float o[8];
#pragma unroll
        for (int j = 0; j < 8; ++j) o[j] = v[j] * s;
        st_bf16x8(O + R * ldc + col, o); } };
struct SEpiRelu2 { bf16_t* O; int ldc;
    __device__ __forceinline__ void operator()(size_t R, int col, const float (&v)[8]) const { float o[8];
#pragma unroll
        for (int j = 0; j < 8; ++j) { const float a = fmaxf(v[j], 0.f); o[j] = a * a; }
        st_bf16x8(O + R * ldc + col, o); } };
struct SEpiResid { float* XS; const float* gate; float scale;
    __device__ __forceinline__ void operator()(size_t R, int col, const float (&v)[8]) const { const float* gp = gate + (size_t)2 * MODW + col; float* xp = XS + R * DM + col;
        const f32x4 g0 = *(const f32x4*)gp * scale, g1 = *(const f32x4*)(gp + 4) * scale; f32x4 x0 = *(f32x4*)xp, x1 = *(f32x4*)(xp + 4);
        x0 += g0 * (f32x4){v[0], v[1], v[2], v[3]}; x1 += g1 * (f32x4){v[4], v[5], v[6], v[7]}; *(f32x4*)xp = x0; *(f32x4*)(xp + 4) = x1; } };
struct SEpiHG { bf16_t* QVG; float* LOGF; const float* lb;
    __device__ __forceinline__ void operator()(size_t R, int col, const float (&v)[8]) const { const int seg = col >> 11, cs = col & 2047;
        if (seg == 1 || seg == 2) { float* p = LOGF + (size_t)(seg - 1) * MROWS * DM + R * DM + cs; f32x4 o0, o1;
#pragma unroll
            for (int j = 0; j < 4; ++j) { const float l0 = lb[cs + j], l1 = lb[cs + 4 + j]; o0[j] = logf(l0 + (1.0f - l0) * sigmoidf_(v[j])); o1[j] = logf(l1 + (1.0f - l1) * sigmoidf_(v[4 + j])); }
            *(f32x4*)p = o0; *(f32x4*)(p + 4) = o1; }
        else { const int bi = seg - 2 + (seg == 0 ? 2 : 0); float o[8];
#pragma unroll
            for (int j = 0; j < 8; ++j) o[j] = seg == 3 ? v[j] : siluf_(v[j]);
            st_bf16x8(QVG + (size_t)bi * MROWS * DM + R * DM + cs, o); } } };

namespace att {
using s16x4  = __attribute__((ext_vector_type(4))) short;
using f32x16 = __attribute__((ext_vector_type(16))) float;
constexpr int NW = 8, QBLK = 32, KVBLK = 64;
constexpr float SCALE = ATTN_SCALE;
constexpr float THR = 8.f;
constexpr int SHM_V = KVBLK * 128 * 2, SHM_K = KVBLK * 128 * 2, SHM_KR = KVBLK * 64 * 2;
constexpr int OFF_V = 0, OFF_K = 2 * SHM_V, OFF_KR = OFF_K + 2 * SHM_K, OFF_WS = OFF_KR + 2 * SHM_KR, SHM_ATTN = OFF_WS + NW * 64 * 4;
constexpr int LDQ = QW, LDK = KVW, LDO = DM;
#define KSWZ(row, colB) ((row) * 256 + ((colB) ^ (((row) & 7) << 4)))
#define RSWZ(row, colB) ((row) * 128 + ((colB) ^ ((((row) >> 1) & 7) << 4)))
#define SBAR() __builtin_amdgcn_sched_barrier(0)
__device__ __forceinline__ int crow(int r, int hi) { return (r & 3) + 8 * (r >> 2) + 4 * hi; }
__device__ __forceinline__ unsigned cvtpk(float lo, float hi) { unsigned r; asm volatile("v_cvt_pk_bf16_f32 %0, %1, %2" : "=v"(r) : "v"(lo), "v"(hi)); return r; }
__device__ __forceinline__ bf16x8 ld8(const bf16_t* p) { return *reinterpret_cast<const bf16x8*>(p); }
__device__ __forceinline__ void partialSM(f32x16& p0, f32x16& p1, float& m_reg, float& mn, float& alpha) {
  constexpr float C = SCALE * 1.4426950408889634f;
  float pmax = p0[0];
#pragma unroll
  for (int r = 1; r < 16; ++r) pmax = fmaxf(pmax, p0[r]);
#pragma unroll
  for (int r = 0; r < 16; ++r) pmax = fmaxf(pmax, p1[r]);
  { auto rr = __builtin_amdgcn_permlane32_swap(__float_as_uint(pmax), __float_as_uint(pmax), false, false);
    pmax = fmaxf(__uint_as_float(rr[0]), __uint_as_float(rr[1])); }
  if (__builtin_expect(__all(pmax - m_reg <= THR / SCALE), 1)) { mn = m_reg; alpha = 1.f; }
  else { mn = fmaxf(m_reg, pmax); alpha = __builtin_amdgcn_exp2f((m_reg - mn) * C); m_reg = mn; }
  float mnC = -mn * C;
#pragma unroll
  for (int r = 0; r < 16; ++r) p0[r] = fmaf(p0[r], C, mnC);
#pragma unroll
  for (int r = 0; r < 16; ++r) p1[r] = fmaf(p1[r], C, mnC);
#pragma unroll
  for (int r = 0; r < 16; ++r) p0[r] = __builtin_amdgcn_exp2f(p0[r]);
}
__device__ __forceinline__ void finishSM(f32x16& p0, f32x16& p1, float alpha, float& l_reg, bf16x8& pa0, bf16x8& pa1, bf16x8& pa2, bf16x8& pa3) {
#pragma unroll
  for (int r = 0; r < 16; ++r) p1[r] = __builtin_amdgcn_exp2f(p1[r]);
  float ps = 0;
#pragma unroll
  for (int r = 0; r < 16; ++r) ps += p0[r];
#pragma unroll
  for (int r = 0; r < 16; ++r) ps += p1[r];
  { auto rr = __builtin_amdgcn_permlane32_swap(__float_as_uint(ps), __float_as_uint(ps), false, false);
    ps = __uint_as_float(rr[0]) + __uint_as_float(rr[1]); }
  l_reg = l_reg * alpha + ps;
#define PK4(P, BASE, OUT) do { unsigned a0 = cvtpk(P[BASE + 0], P[BASE + 1]), a1 = cvtpk(P[BASE + 2], P[BASE + 3]);   \
    unsigned b0 = cvtpk(P[BASE + 4], P[BASE + 5]), b1 = cvtpk(P[BASE + 6], P[BASE + 7]);                              \
    auto r0 = __builtin_amdgcn_permlane32_swap(a0, b0, false, false); auto r1 = __builtin_amdgcn_permlane32_swap(a1, b1, false, false); \
    u32x4 w = {r0[0], r1[0], r0[1], r1[1]}; OUT = *reinterpret_cast<bf16x8*>(&w); } while (0)
  PK4(p0, 0, pa0); PK4(p0, 8, pa1); PK4(p1, 0, pa2); PK4(p1, 8, pa3);
#undef PK4
}
__device__ __forceinline__ void qkt(f32x16& p0, f32x16& p1, const char* Ks, const char* Krs, const bf16x8* qr, int r32, int hi) {
  p0 = f32x16{}; p1 = f32x16{};
#pragma unroll
  for (int d0 = 0; d0 < 8; ++d0) { int cb = (d0 * 16 + hi * 8) * 2;
    bf16x8 b0 = *reinterpret_cast<const bf16x8*>(Ks + KSWZ(r32, cb));
    bf16x8 b1 = *reinterpret_cast<const bf16x8*>(Ks + KSWZ(32 + r32, cb));
    p0 = __builtin_amdgcn_mfma_f32_32x32x16_bf16(b0, qr[d0], p0, 0, 0, 0);
    p1 = __builtin_amdgcn_mfma_f32_32x32x16_bf16(b1, qr[d0], p1, 0, 0, 0); }
#pragma unroll
  for (int d0 = 0; d0 < 4; ++d0) { int cb = (d0 * 16 + hi * 8) * 2;
    bf16x8 b0 = *reinterpret_cast<const bf16x8*>(Krs + RSWZ(r32, cb));
    bf16x8 b1 = *reinterpret_cast<const bf16x8*>(Krs + RSWZ(32 + r32, cb));
    p0 = __builtin_amdgcn_mfma_f32_32x32x16_bf16(b0, qr[8 + d0], p0, 0, 0, 0);
    p1 = __builtin_amdgcn_mfma_f32_32x32x16_bf16(b1, qr[8 + d0], p1, 0, 0, 0); }
}
__device__ __forceinline__ int v_st(int k, int c) { const int kk = (k & ~0xC) | ((k & 4) << 1) | ((k & 8) >> 1); return ((kk >> 3) * 4 + (c >> 5)) * 512 + ((kk & 7) * 32 + (c & 31)) * 2; }
__device__ __forceinline__ int v_rd_base(int lane) { return ((lane & 3) << 3) | (((lane >> 2) & 3) << 6) | (((lane >> 4) & 1) << 5) | (((lane >> 5) & 1) << 8); }
constexpr int v_rd_off(int d0, int ks, int half) { return d0 * 512 + ks * 4096 + half * 2048; }
template <int OFF> __device__ __forceinline__ s16x4 tr_read(int vb) {
  s16x4 r; asm volatile("ds_read_b64_tr_b16 %0, %1 offset:%2" : "=&v"(r) : "v"(vb), "i"(OFF) : "memory"); return r;
}
template <int D0> __device__ __forceinline__ void pv_one(f32x16& od, int vb, bf16x8 pa0, bf16x8 pa1, bf16x8 pa2, bf16x8 pa3) {
  const s16x4 l0 = tr_read<v_rd_off(D0, 0, 0)>(vb), h0 = tr_read<v_rd_off(D0, 0, 1)>(vb), l1 = tr_read<v_rd_off(D0, 1, 0)>(vb), h1 = tr_read<v_rd_off(D0, 1, 1)>(vb);
  const s16x4 l2 = tr_read<v_rd_off(D0, 2, 0)>(vb), h2 = tr_read<v_rd_off(D0, 2, 1)>(vb), l3 = tr_read<v_rd_off(D0, 3, 0)>(vb), h3 = tr_read<v_rd_off(D0, 3, 1)>(vb);
  asm volatile("s_waitcnt lgkmcnt(0)" ::: "memory"); SBAR();
#define PK(L, H) (bf16x8){L[0], L[1], L[2], L[3], H[0], H[1], H[2], H[3]}
  od = __builtin_amdgcn_mfma_f32_32x32x16_bf16(pa0, PK(l0, h0), od, 0, 0, 0);
  od = __builtin_amdgcn_mfma_f32_32x32x16_bf16(pa1, PK(l1, h1), od, 0, 0, 0);
  od = __builtin_amdgcn_mfma_f32_32x32x16_bf16(pa2, PK(l2, h2), od, 0, 0, 0);
  od = __builtin_amdgcn_mfma_f32_32x32x16_bf16(pa3, PK(l3, h3), od, 0, 0, 0);
#undef PK
}
__device__ __forceinline__ void pv_d0(f32x16* o, int vb, bf16x8 pa0, bf16x8 pa1, bf16x8 pa2, bf16x8 pa3) {
  pv_one<0>(o[0], vb, pa0, pa1, pa2, pa3); pv_one<1>(o[1], vb, pa0, pa1, pa2, pa3); pv_one<2>(o[2], vb, pa0, pa1, pa2, pa3); pv_one<3>(o[3], vb, pa0, pa1, pa2, pa3);
}
__device__ __forceinline__ void attn_body(const bf16_t* __restrict__ Qb, const bf16_t* __restrict__ Kh, const bf16_t* __restrict__ KRb,
                                          bf16_t* __restrict__ Ob, int seq, int tq0, const float* __restrict__ RC, const float* __restrict__ RS, char* lds, int tid) {
  const bf16_t* Vh = Kh + 128;
  const int wid = tid >> 6, lane = tid & 63, r32 = lane & 31, hi = lane >> 5;
  char* V_lds = lds + OFF_V; char* K_lds = lds + OFF_K; char* KR_lds = lds + OFF_KR;
  float* ws = (float*)(lds + OFF_WS) + wid * 64; float* li_l = ws; float* al_l = ws + 32;
  float m_reg = -1e30f, l_reg = 0; f32x16 o[4] = {}; bf16x8 qr[12];
  const bf16_t* Qw = Qb + (long)(wid * QBLK + r32) * LDQ + hi * 8;
#pragma unroll
  for (int d0 = 0; d0 < 12; ++d0) qr[d0] = ld8(Qw + d0 * 16);
  if (tq0 >= 0) {
    const int t = tq0 + wid * QBLK + r32; const int pr = (t >> 6) * 16 + hi * 8, pc = (t & 63) * 16 + hi * 8;
#pragma unroll
    for (int j = 0; j < 8; ++j) {
      { const float c = RC[pr + j], sn = RS[pr + j]; const float x0 = bf2f((bf16_t)qr[8][j]), x1 = bf2f((bf16_t)qr[9][j]);
        qr[8][j] = (short)f2bf(x0 * c - x1 * sn); qr[9][j] = (short)f2bf(x1 * c + x0 * sn); }
      { const float c = RC[pc + j], sn = RS[pc + j]; const float x0 = bf2f((bf16_t)qr[10][j]), x1 = bf2f((bf16_t)qr[11][j]);
        qr[10][j] = (short)f2bf(x0 * c - x1 * sn); qr[11][j] = (short)f2bf(x1 * c + x0 * sn); }
    }
  }
  const int sr = tid >> 4, sc = (tid & 15) * 8, vst0 = v_st(sr, sc), vst1 = v_st(32 + sr, sc);
  const int rr = tid >> 3, rc = (tid & 7) * 8;
  const int vb0 = (int)(uintptr_t)V_lds + v_rd_base(lane);
  bf16x8 vs0, vs1, ks0, ks1, krs;
#define SLOAD(k0) do { vs0 = ld8(&Vh[(long)((k0) + sr) * LDK + sc]); vs1 = ld8(&Vh[(long)((k0) + 32 + sr) * LDK + sc]); \
    ks0 = ld8(&Kh[(long)((k0) + sr) * LDK + sc]); ks1 = ld8(&Kh[(long)((k0) + 32 + sr) * LDK + sc]); krs = ld8(&KRb[(long)((k0) + rr) * 64 + rc]); } while (0)
#define SWRITE(b) do { *(bf16x8*)(V_lds + (b) * SHM_V + vst0) = vs0; *(bf16x8*)(V_lds + (b) * SHM_V + vst1) = vs1; int kc = sc * 2;   \
    *(bf16x8*)(K_lds + (b) * SHM_K + KSWZ(sr, kc)) = ks0; *(bf16x8*)(K_lds + (b) * SHM_K + KSWZ(32 + sr, kc)) = ks1;                    \
    *(bf16x8*)(KR_lds + (b) * SHM_KR + RSWZ(rr, rc * 2)) = krs; } while (0)
#define SWAIT() asm volatile("s_waitcnt vmcnt(0)" ::: "memory")
#define RESC(a) do { if (__any((a) < 1.f)) { if (hi == 0) al_l[r32] = (a); asm volatile("s_waitcnt lgkmcnt(0)" ::: "memory"); \
    _Pragma("unroll") for (int d = 0; d < 4; ++d) _Pragma("unroll") for (int r = 0; r < 16; ++r) o[d][r] *= al_l[crow(r, hi)]; } } while (0)
  f32x16 p0, p1; float mn, al; bf16x8 pa0, pa1, pa2, pa3; const int NT = seq / KVBLK;
  SLOAD(0); SWAIT(); SWRITE(0); __syncthreads();
  SLOAD(KVBLK);
  for (int j = 0; j < NT; ++j) {
    const int buf = j & 1;
    SBAR(); qkt(p0, p1, K_lds + buf * SHM_K, KR_lds + buf * SHM_KR, qr, r32, hi);
    partialSM(p0, p1, m_reg, mn, al); RESC(al);
    finishSM(p0, p1, al, l_reg, pa0, pa1, pa2, pa3); SBAR();
    if (j + 1 < NT) { SWAIT(); SWRITE(buf ^ 1); }
    if (j + 2 < NT) SLOAD((j + 2) * KVBLK);
    SBAR();
    pv_d0(o, vb0 + buf * SHM_V, pa0, pa1, pa2, pa3);
    __syncthreads();
  }
  if (hi == 0) li_l[r32] = l_reg; asm volatile("s_waitcnt lgkmcnt(0)" ::: "memory");
  float rli[16];
#pragma unroll
  for (int r = 0; r < 16; ++r) rli[r] = __builtin_amdgcn_rcpf(li_l[crow(r, hi)]);
  bf16_t* Ow = Ob + (long)(wid * QBLK) * LDO;
#pragma unroll
  for (int r = 0; r < 16; ++r) { int orow = crow(r, hi);
#pragma unroll
    for (int d0 = 0; d0 < 4; ++d0) Ow[(long)orow * LDO + d0 * 32 + r32] = (bf16_t)f2bf(o[d0][r] * rli[r]); }
#undef SLOAD
#undef SWRITE
#undef SWAIT
#undef RESC
}
}

typedef const float* cfp_t;
typedef const __attribute__((address_space(4))) cfp_t* InPtr;
struct Ctx {
    LAS unsigned char* lds; int tid, lane, wave, gw, ngw, gtid, ngt;
    InPtr in; float* out; unsigned char* ws;
    __device__ __forceinline__ const float* inp(int i) const { return (const float*)(const GAS float*)in[i]; }
};
#define WSP(T, off) ((T*)(C.ws + (off)))

__device__ __forceinline__ void tr_item(const float* W, int K, int N, bf16_t* WT, const float* sck, LAS float* scr, int item, int lane) {
    const int nblk = N / 32, kb = item / nblk, nb = item % nblk, k0 = 64 * kb, n0 = 32 * nb;
#pragma unroll 8
    for (int i = 0; i < 32; ++i) { const int kk = 2 * i + (lane >> 5); float v = W[(size_t)(k0 + kk) * N + n0 + (lane & 31)]; if (sck) v *= sck[k0 + kk]; scr[kk * 33 + (lane & 31)] = v; }
    asm volatile("s_waitcnt lgkmcnt(0)" ::: "memory"); __builtin_amdgcn_wave_barrier();
    const int c = lane & 7;
#pragma unroll
    for (int j = 0; j < 4; ++j) { const int n = (lane >> 3) + 8 * j; const LAS float* s = scr + (8 * c) * 33 + n;
        u32x4 o; o.x = pk2(s[0 * 33], s[1 * 33]); o.y = pk2(s[2 * 33], s[3 * 33]); o.z = pk2(s[4 * 33], s[5 * 33]); o.w = pk2(s[6 * 33], s[7 * 33]);
        *(u32x4*)(WT + (size_t)(n0 + n) * K + k0 + 8 * c) = o; }
    asm volatile("s_waitcnt lgkmcnt(0)" ::: "memory"); __builtin_amdgcn_wave_barrier();
}
__device__ __forceinline__ void tr_matrix(const Ctx& C, const float* W, int K, int N, bf16_t* WT, const float* sck) {
    LAS float* scr = (LAS float*)(C.lds + C.wave * 16384);
    const int cnt = (K / 64) * (N / 32);
    for (int it = C.gw; it < cnt; it += C.ngw) tr_item(W, K, N, WT, sck, scr, it, C.lane);
}
__device__ __forceinline__ void sincos_d(double x, double& s, double& c) {
    const double twopi = 6.283185307179586476925286766559;
    const double k = __builtin_rint(x / twopi); const double y = x - k * twopi; const double y2 = y * y;
    double ts = y, ss = y, tc = 1.0, sc = 1.0;
#pragma unroll
    for (int n = 1; n <= 16; ++n) { tc *= -y2 / (double)((2 * n - 1) * (2 * n)); sc += tc; ts *= -y2 / (double)((2 * n) * (2 * n + 1)); ss += ts; }
    s = ss; c = sc;
}
__device__ __forceinline__ void phase_prologue(const Ctx& C) {
#pragma unroll 1
    for (int e = 0; e < 2; ++e) {
        tr_matrix(C, C.inp(8) + (size_t)e * DM * ABN, DM, ABN, WSP(bf16_t, WS_WABIN) + (size_t)e * ABNP * DM, nullptr);
        tr_matrix(C, C.inp(9) + (size_t)e * DM * DM, DM, DM, WSP(bf16_t, WS_WABOUT) + (size_t)e * DM * DM, nullptr);
        tr_matrix(C, C.inp(18) + (size_t)e * 512 * QW, 512, QW, WSP(bf16_t, WS_WUQ) + (size_t)e * QW * 512, C.inp(17) + e * 512);
        tr_matrix(C, C.inp(20) + (size_t)e * 512 * KVW, 512, KVW, WSP(bf16_t, WS_WUKV) + (size_t)e * KVW * 512, C.inp(19) + e * 512);
        tr_matrix(C, C.inp(21) + (size_t)e * DM * HGN, DM, HGN, WSP(bf16_t, WS_WHGIN) + (size_t)e * HGN * DM, nullptr);
        tr_matrix(C, C.inp(24) + (size_t)e * DM * DM, DM, DM, WSP(bf16_t, WS_WHGOUT) + (size_t)e * DM * DM, nullptr);
#pragma unroll 1
        for (int dg = 0; dg < 4; ++dg) { const int dir = dg >> 1, gate = dg & 1;
            tr_matrix(C, C.inp(gate ? 14 : 12) + ((size_t)e * 2 + dir) * 8 * 128 * 128, 1024, 128, WSP(bf16_t, WS_WG) + ((size_t)e * 4 + dg) * 128 * 1024, nullptr); }
    }
#pragma unroll 1
    for (int l = 0; l < 4; ++l) {
        tr_matrix(C, C.inp(25) + (size_t)l * DM * DFF, DM, DFF, WSP(bf16_t, WS_W1) + (size_t)l * DFF * DM, nullptr);
        tr_matrix(C, C.inp(26) + (size_t)l * DFF * DM, DFF, DM, WSP(bf16_t, WS_W2) + (size_t)l * DM * DFF, nullptr);
    }
    for (int e = 0; e < 2; ++e) { u32x4* z = (u32x4*)(WSP(bf16_t, WS_WABIN) + (size_t)e * ABNP * DM + (size_t)ABN * DM);
        for (int i = C.gtid; i < (ABNP - ABN) * DM / 8; i += C.ngt) z[i] = (u32x4){0u, 0u, 0u, 0u}; }
    { float* XS = WSP(float, WS_XS);
      for (int i = C.gtid; i < MROWS * (DM / 4); i += C.ngt) { const int R = i / (DM / 4), c4 = i % (DM / 4); const int b = R / SROW, s = R % SROW;
          const float* src = s < CTX ? C.inp(2) + ((size_t)(b * CTX + s)) * DM : C.inp(0) + ((size_t)(b * SEQ + (s - CTX))) * DM;
          ((f32x4*)(XS + (size_t)R * DM))[c4] = ((const f32x4*)src)[c4]; } }
    { float* LB = WSP(float, WS_LB);
      for (int i = C.gtid; i < 2048; i += C.ngt) { float v[4], mx = -1e30f; for (int l = 0; l < 4; ++l) { v[l] = C.inp(22)[l * 2048 + i]; mx = fmaxf(mx, v[l]); }
          float sum = 0.f; for (int l = 0; l < 4; ++l) { v[l] = expf(v[l] - mx); sum += v[l]; }
          float cum = 0.f; const float p0 = v[0] / sum; for (int l = 0; l < 4; ++l) { cum += v[l] / sum; LB[l * 2048 + i] = cum - p0; } }
      float* RC = WSP(float, WS_ROPE); float* RS = RC + 1024;
      for (int i = C.gtid; i < 1024; i += C.ngt) { const int pos = i / 16, j = i % 16; double inv = 1.0; for (int q = 0; q < j; ++q) inv *= 0.56234132519034908;
          const float ang = (float)pos * (float)inv; double s, c; sincos_d((double)ang, s, c); RC[i] = (float)c; RS[i] = (float)s; } }
    { LAS float* sl = (LAS float*)C.lds;
      LAS float* red = sl + 3 * 2048;
      __syncthreads();
      for (int i = C.tid; i < 3 * 2048; i += 512) { const int r = i / 2048, d = i % 2048; const float v = r < 2 ? C.inp(1)[r * 2048 + d] : C.inp(3)[d]; sl[i] = siluf_(v); }
      __syncthreads();
      float* MOD = WSP(float, WS_MOD);
      const int kq = C.tid >> 4, cq = C.tid & 15;
      for (int u = blockIdx.x; u < 4 * (MODW / 64); u += gridDim.x) { const int l = u / (MODW / 64), e0 = (u % (MODW / 64)) * 64;
          const float* w = C.inp(4) + (size_t)l * DM * MODW + e0 + 4 * cq;
          f32x4 a0 = {0, 0, 0, 0}, a1 = {0, 0, 0, 0}, a2 = {0, 0, 0, 0};
#pragma unroll 4
          for (int d = kq; d < DM; d += 32) { const f32x4 wv = *(const f32x4*)(w + (size_t)d * MODW); a0 += wv * sl[d]; a1 += wv * sl[2048 + d]; a2 += wv * sl[4096 + d]; }
#pragma unroll
          for (int j = 0; j < 4; ++j) { red[(kq * 3 + 0) * 64 + 4 * cq + j] = a0[j]; red[(kq * 3 + 1) * 64 + 4 * cq + j] = a1[j]; red[(kq * 3 + 2) * 64 + 4 * cq + j] = a2[j]; }
          __syncthreads();
          if (C.tid < 192) { const int r = C.tid / 64, c = C.tid % 64; float s = 0.f; for (int q = 0; q < 32; ++q) s += red[(q * 3 + r) * 64 + c];
              MOD[((size_t)l * 3 + r) * MODW + e0 + c] = s + C.inp(5)[l * MODW + e0 + c]; }
          __syncthreads(); } }
}

__device__ __forceinline__ void phase_norm_mod(const Ctx& C, const float* w, const float* mod, int sh_idx, int sc_idx) {
    const float* XS = WSP(float, WS_XS); bf16_t* H = WSP(bf16_t, WS_H);
    for (int R = C.gw; R < MROWS; R += C.ngw) {
        const int s = R % SROW, b = R / SROW, cond = s < CTX ? 2 : b;
        const float* shift = mod + (size_t)cond * MODW + sh_idx * DM; const float* scale = mod + (size_t)cond * MODW + sc_idx * DM;
        const f32x4* xr = (const f32x4*)(XS + (size_t)R * DM) + C.lane;
        f32x4 v[8]; float ss = 0.f;
#pragma unroll
        for (int j = 0; j < 8; ++j) { v[j] = xr[64 * j]; ss += (v[j].x * v[j].x + v[j].y * v[j].y) + (v[j].z * v[j].z + v[j].w * v[j].w); }
        const float rstd = 1.0f / sqrtf(wave_sum(ss) * (1.0f / DM) + EPS);
        u32x2* o = (u32x2*)(H + (size_t)R * DM) + C.lane;
#pragma unroll
        for (int j = 0; j < 8; ++j) { const int c = (C.lane + 64 * j) * 4; const f32x4 wv = *(const f32x4*)(w + c), sc = *(const f32x4*)(scale + c), sh = *(const f32x4*)(shift + c);
            const f32x4 y = (v[j] * rstd * wv) * (1.0f + sc) + sh; u32x2 pk; pk.x = pk2(y.x, y.y); pk.y = pk2(y.z, y.w); o[64 * j] = pk; }
    }
}

__device__ __forceinline__ void phase_rs_kr(const Ctx& C) {
    const bf16_t* P = WSP(bf16_t, WS_P);
    float* RSQ = WSP(float, WS_RSQ); float* RSKV = WSP(float, WS_RSKV);
    for (int R = C.gw; R < MROWS; R += C.ngw) {
        const u32x4 a = *(const u32x4*)(P + (size_t)R * ABNP + 2048 + 8 * C.lane), b = *(const u32x4*)(P + (size_t)R * ABNP + 2560 + 8 * C.lane);
        float sa = 0.f, sb = 0.f;
#pragma unroll
        for (int j = 0; j < 4; ++j) { const float a0 = __uint_as_float(a[j] << 16), a1 = __uint_as_float(a[j] & 0xffff0000u), b0 = __uint_as_float(b[j] << 16), b1 = __uint_as_float(b[j] & 0xffff0000u);
            sa += a0 * a0 + a1 * a1; sb += b0 * b0 + b1 * b1; }
        sa = wave_sum(sa); sb = wave_sum(sb);
        if (C.lane == 0) { RSQ[R] = 1.0f / sqrtf(sa * (1.0f / 512.0f) + EPS); RSKV[R] = 1.0f / sqrtf(sb * (1.0f / 512.0f) + EPS); } }
    bf16_t* KR = WSP(bf16_t, WS_KR); const float* RC = WSP(float, WS_ROPE); const float* RS = RC + 1024;
    for (int idx = C.gtid; idx < MROWS * 32; idx += C.ngt) { const int R = idx / 32, p = idx % 32, s = R % SROW; const int i0 = p < 16 ? p : 32 + (p - 16);
        const float x0 = bf2f(P[(size_t)R * ABNP + 3072 + i0]), x1 = bf2f(P[(size_t)R * ABNP + 3072 + i0 + 16]); float o0 = x0, o1 = x1;
        if (s >= CTX) { const int t = s - CTX, pos = p < 16 ? t / 64 : t % 64; const float c = RC[pos * 16 + (p & 15)], sn = RS[pos * 16 + (p & 15)]; o0 = x0 * c - x1 * sn; o1 = x1 * c + x0 * sn; }
        KR[(size_t)R * 64 + i0] = (bf16_t)f2bf(o0); KR[(size_t)R * 64 + i0 + 16] = (bf16_t)f2bf(o1); }
}

__device__ __forceinline__ void phase_attn(const Ctx& C) {
    const bf16_t* Q = WSP(bf16_t, WS_Q); const bf16_t* KV = WSP(bf16_t, WS_KV); const bf16_t* KR = WSP(bf16_t, WS_KR); bf16_t* Y = WSP(bf16_t, WS_Y);
    const float* RC = WSP(float, WS_ROPE); const float* RS = RC + 1024;
    const int G = gridDim.x, c = blockIdx.x;
    for (int u0 = c; u0 < 272; u0 += G) {
        int b, hh, s0, nk, tq0;
        if (u0 < 256) { int v = u0; if (G == 256) { const int x = c & 7, j = c >> 3; v = (x * 2 + (j >> 4)) * 16 + (j & 15); }
            const int p = v >> 4, qb = v & 15; b = p >> 3; hh = p & 7; s0 = CTX + qb * 256; nk = SROW; tq0 = qb * 256; }
        else { const int p = u0 - 256; b = p >> 3; hh = p & 7; s0 = 0; nk = CTX; tq0 = -1; }
        const size_t R0 = (size_t)b * SROW + s0, K0 = (size_t)b * SROW;
        __syncthreads();
        att::attn_body(Q + R0 * QW + hh * 192, KV + K0 * KVW + hh * 256, KR + K0 * 64, Y + R0 * DM + DLRU + hh * 128, nk, tq0, RC, RS, (char*)C.lds, C.tid);
    }
}
namespace hg {
using s16x4  = __attribute__((ext_vector_type(4))) short;
using f32x16 = __attribute__((ext_vector_type(16))) float;
constexpr int NCH = SROW / 64;
constexpr int NCHAIN = NBATCH * 16 * 2;
__device__ __forceinline__ unsigned off_b(unsigned row, unsigned ch) { return 256u * row + 16u * (ch ^ (((row & 3u) << 2) | ((row >> 2) & 3u))); }
__device__ __forceinline__ s16x4 trr(unsigned addr) { s16x4 r; asm volatile("ds_read_b64_tr_b16 %0, %1" : "=&v"(r) : "v"(addr) : "memory"); return r; }
__device__ __forceinline__ bf16x8 pk8(s16x4 L, s16x4 H) { return (bf16x8){L[0], L[1], L[2], L[3], H[0], H[1], H[2], H[3]}; }
__device__ __forceinline__ unsigned tr_nat(unsigned lane, unsigned c, unsigned ks, unsigned t) {
    const unsigned h = lane >> 5, blk = (lane >> 4) & 1, q = (lane & 15) >> 2, p = lane & 3;
    return off_b(16 * ks + 8 * h + 4 * t + q, 4 * c + 2 * blk + (p >> 1)) + 8 * (p & 1); }
__device__ __forceinline__ unsigned tr_perm(unsigned lane, unsigned c, unsigned rb, unsigned t) {
    const unsigned h = lane >> 5, blk = (lane >> 4) & 1, q = (lane & 15) >> 2, p = lane & 3;
    return off_b(rb + 4 * h + 8 * t + q, 4 * c + 2 * blk + (p >> 1)) + 8 * (p & 1); }
__device__ __forceinline__ unsigned row_rd(unsigned lane, unsigned rb, unsigned ks) { return off_b(rb + (lane & 31), 2 * ks + (lane >> 5)); }
__device__ __forceinline__ int crow(int r, int hi) { return (r & 3) + 8 * (r >> 2) + 4 * hi; }
#define HG_WAITL() do { asm volatile("s_waitcnt lgkmcnt(0)" ::: "memory"); __builtin_amdgcn_sched_barrier(0); } while (0)
}

__device__ __forceinline__ void phase_hg_ds(const Ctx& C) {
    using namespace hg;
    LAS unsigned char* L = C.lds; const unsigned Lb = (unsigned)(uintptr_t)L;
    constexpr unsigned VT = 0, KP = 16384, TOT = 32768;
    const float* LOGF = WSP(float, WS_LOGF); const bf16_t* VH = WSP(bf16_t, WS_VH); float* DS = WSP(float, WS_DS); float* DEC = WSP(float, WS_DEC);
    const int w = C.wave, lane = C.lane, tid = C.tid, h5 = lane >> 5, r32 = lane & 31;
    for (int u = blockIdx.x; u < NBATCH * 16 * NCH; u += gridDim.x) {
        const int b = u / (16 * NCH), hh = (u / NCH) % 16, ci = u % NCH; const size_t R0 = (size_t)b * SROW + ci * 64;
        __syncthreads();
#pragma unroll
        for (int p = 0; p < 2; ++p) { const int row = (tid >> 4) + 32 * p, ch = tid & 15; const u32x4 v = *(const u32x4*)(VH + (R0 + row) * DM + hh * 128 + ch * 8); *(LAS u32x4*)(L + VT + off_b(row, ch)) = v; }
#pragma unroll 1
        for (int dir = 0; dir < 2; ++dir) {
            const int chain = (b * 16 + hh) * 2 + dir;
            const float* lfp = LOGF + (size_t)dir * MROWS * DM + (R0 + 8 * w) * DM + hh * 128 + 2 * lane;
            f32x2 lf[8]; f32x2 T = {0.f, 0.f};
#pragma unroll
            for (int i = 0; i < 8; ++i) { lf[i] = *(const f32x2*)(lfp + (size_t)i * DM); T += lf[i]; }
            *(LAS f32x2*)(L + TOT + (w * 128 + 2 * lane) * 4) = T;
            __syncthreads();
            f32x2 off = {0.f, 0.f}, total = {0.f, 0.f};
#pragma unroll
            for (int ww = 0; ww < 8; ++ww) { const f32x2 t = *(const LAS f32x2*)(L + TOT + (ww * 128 + 2 * lane) * 4); total += t; if (dir == 0 ? (ww > w) : (ww < w)) off += t; }
            f32x2 E[8];
            if (dir == 0) { E[7] = off;
#pragma unroll
                for (int i = 6; i >= 0; --i) E[i] = E[i + 1] + lf[i + 1]; }
            else { E[0] = off;
#pragma unroll
                for (int i = 1; i < 8; ++i) E[i] = E[i - 1] + lf[i - 1]; }
#pragma unroll
            for (int i = 0; i < 8; ++i) { const float k0 = (1.0f - __expf(lf[i].x)) * __expf(E[i].x), k1 = (1.0f - __expf(lf[i].y)) * __expf(E[i].y);
                *(LAS unsigned*)(L + KP + off_b(8 * w + i, lane >> 2) + (lane & 3) * 4) = pk2(k0, k1); }
            if (w == 0) { f32x2 d; d.x = __expf(total.x); d.y = __expf(total.y); *(f32x2*)(DEC + ((size_t)chain * NCH + ci) * 128 + 2 * lane) = d; }
            __syncthreads();
            const unsigned dkt = w >> 1, c0 = (w & 1) * 2;
            s16x4 al[4], ah[4], b0l[4], b0h[4], b1l[4], b1h[4];
#pragma unroll
            for (int ks = 0; ks < 4; ++ks) { al[ks] = trr(Lb + KP + tr_nat(lane, dkt, ks, 0)); ah[ks] = trr(Lb + KP + tr_nat(lane, dkt, ks, 1));
                b0l[ks] = trr(Lb + VT + tr_nat(lane, c0, ks, 0)); b0h[ks] = trr(Lb + VT + tr_nat(lane, c0, ks, 1));
                b1l[ks] = trr(Lb + VT + tr_nat(lane, c0 + 1, ks, 0)); b1h[ks] = trr(Lb + VT + tr_nat(lane, c0 + 1, ks, 1)); }
            HG_WAITL();
            f32x16 a0 = {}, a1 = {};
#pragma unroll
            for (int ks = 0; ks < 4; ++ks) { const bf16x8 A = pk8(al[ks], ah[ks]);
                a0 = __builtin_amdgcn_mfma_f32_32x32x16_bf16(A, pk8(b0l[ks], b0h[ks]), a0, 0, 0, 0);
                a1 = __builtin_amdgcn_mfma_f32_32x32x16_bf16(A, pk8(b1l[ks], b1h[ks]), a1, 0, 0, 0); }
            float* dsp = DS + ((size_t)chain * NCH + ci) * 16384;
#pragma unroll
            for (int r = 0; r < 16; ++r) { const int dk = 32 * dkt + crow(r, h5); dsp[dk * 128 + 32 * c0 + r32] = a0[r]; dsp[dk * 128 + 32 * (c0 + 1) + r32] = a1[r]; }
        }
    }
}
__device__ __forceinline__ void phase_hg_scan(const Ctx& C) {
    using namespace hg;
    const float* DS = WSP(float, WS_DS); const float* DEC = WSP(float, WS_DEC); bf16_t* SS = WSP(bf16_t, WS_SS);
    for (int g = C.gtid; g < NCHAIN * 2048; g += C.ngt) { const int chain = g >> 11, within = g & 2047, dk = within >> 4, dv0 = (within & 15) * 8, dir = chain & 1;
        f32x4 s0 = {0.f, 0.f, 0.f, 0.f}, s1 = {0.f, 0.f, 0.f, 0.f};
#pragma unroll 4
        for (int j = 0; j < NCH; ++j) { const int ci = dir == 0 ? j : (j < 4 ? 3 - j : 71 - j); const size_t cb = (size_t)chain * NCH + ci; const size_t idx = (cb * 128 + dk) * 128 + dv0;
            u32x4 o; o.x = pk2(s0.x, s0.y); o.y = pk2(s0.z, s0.w); o.z = pk2(s1.x, s1.y); o.w = pk2(s1.z, s1.w); *(u32x4*)(SS + idx) = o;
            const float d = DEC[cb * 128 + dk]; const f32x4 d0 = *(const f32x4*)(DS + idx), d1 = *(const f32x4*)(DS + idx + 4);
            s0 = s0 * d + d0; s1 = s1 * d + d1; } }
}
__device__ __forceinline__ void phase_hg_out(const Ctx& C, int o_idx) {
    using namespace hg;
    LAS unsigned char* L = C.lds; const unsigned Lb = (unsigned)(uintptr_t)L;
    constexpr unsigned VT = 0, QP = 16384, QM = 32768, KM = 49152, ST = 65536, TOT = 98304, RED = 102400;
    const float* LOGF = WSP(float, WS_LOGF); const bf16_t* VH = WSP(bf16_t, WS_VH); const bf16_t* QH = WSP(bf16_t, WS_QH); const bf16_t* GH = WSP(bf16_t, WS_GH);
    const bf16_t* SS = WSP(bf16_t, WS_SS); bf16_t* Y = WSP(bf16_t, WS_Y); const float* nw = C.inp(23) + o_idx * 128;
    const int w = C.wave, lane = C.lane, tid = C.tid, h5 = lane >> 5, r32 = lane & 31;
    const unsigned tt = w >> 2, dvt = w & 3;
    for (int u = blockIdx.x; u < NBATCH * 16 * NCH; u += gridDim.x) {
        const int b = u / (16 * NCH), hh = (u / NCH) % 16, ci = u % NCH; const size_t R0 = (size_t)b * SROW + ci * 64;
        __syncthreads();
#pragma unroll
        for (int p = 0; p < 2; ++p) { const int row = (tid >> 4) + 32 * p, ch = tid & 15; const u32x4 v = *(const u32x4*)(VH + (R0 + row) * DM + hh * 128 + ch * 8); *(LAS u32x4*)(L + VT + off_b(row, ch)) = v; }
        f32x16 acc = {};
#pragma unroll 1
        for (int dir = 0; dir < 2; ++dir) {
            const int chain = (b * 16 + hh) * 2 + dir;
            u32x4 sreg[4];
#pragma unroll
            for (int p = 0; p < 4; ++p) sreg[p] = *(const u32x4*)(SS + (((size_t)chain * NCH + ci) * 128 + (tid >> 4) + 32 * p) * 128 + (tid & 15) * 8);
            const float* lfp = LOGF + (size_t)dir * MROWS * DM + (R0 + 8 * w) * DM + hh * 128 + 2 * lane;
            const bf16_t* qp = QH + (R0 + 8 * w) * DM + hh * 128 + 2 * lane;
            f32x2 lf[8]; unsigned qv[8]; f32x2 T = {0.f, 0.f};
#pragma unroll
            for (int i = 0; i < 8; ++i) { lf[i] = *(const f32x2*)(lfp + (size_t)i * DM); qv[i] = *(const unsigned*)(qp + (size_t)i * DM); T += lf[i]; }
            *(LAS f32x2*)(L + TOT + (w * 128 + 2 * lane) * 4) = T;
            __syncthreads();
            f32x2 off = {0.f, 0.f}, mid = {0.f, 0.f};
#pragma unroll
            for (int ww = 0; ww < 8; ++ww) { const f32x2 t = *(const LAS f32x2*)(L + TOT + (ww * 128 + 2 * lane) * 4);
                if (dir == 0 ? (ww < w) : (ww > w)) off += t; if (dir == 0 ? (ww < 4) : (ww >= 4)) mid += t; }
            f32x2 B[8];
            if (dir == 0) { B[0] = off + lf[0];
#pragma unroll
                for (int i = 1; i < 8; ++i) B[i] = B[i - 1] + lf[i]; }
            else { B[7] = off + lf[7];
#pragma unroll
                for (int i = 6; i >= 0; --i) B[i] = B[i + 1] + lf[i]; }
#pragma unroll
            for (int i = 0; i < 8; ++i) { const float q0 = __uint_as_float(qv[i] << 16), q1 = __uint_as_float(qv[i] & 0xffff0000u);
                const float k0 = 1.0f - __expf(lf[i].x), k1 = 1.0f - __expf(lf[i].y);
                const unsigned a = off_b(8 * w + i, lane >> 2) + (lane & 3) * 4;
                *(LAS unsigned*)(L + QP + a) = pk2(q0 * __expf(B[i].x), q1 * __expf(B[i].y));
                *(LAS unsigned*)(L + QM + a) = pk2(q0 * __expf(B[i].x - mid.x), q1 * __expf(B[i].y - mid.y));
                *(LAS unsigned*)(L + KM + a) = pk2(k0 * __expf(mid.x - B[i].x), k1 * __expf(mid.y - B[i].y)); }
#pragma unroll
            for (int p = 0; p < 4; ++p) *(LAS u32x4*)(L + ST + off_b((tid >> 4) + 32 * p, tid & 15)) = sreg[p];
            __syncthreads();
            { bf16x8 a[8]; s16x4 bl[8], bh[8];
#pragma unroll
              for (int ks = 0; ks < 8; ++ks) { a[ks] = *(const LAS bf16x8*)(L + QP + row_rd(lane, 32 * tt, ks)); bl[ks] = trr(Lb + ST + tr_nat(lane, dvt, ks, 0)); bh[ks] = trr(Lb + ST + tr_nat(lane, dvt, ks, 1)); }
              HG_WAITL();
#pragma unroll
              for (int ks = 0; ks < 8; ++ks) acc = __builtin_amdgcn_mfma_f32_32x32x16_bf16(a[ks], pk8(bl[ks], bh[ks]), acc, 0, 0, 0); }
            { bf16x8 qb[8];
#pragma unroll
              for (int ks = 0; ks < 8; ++ks) qb[ks] = *(const LAS bf16x8*)(L + QM + row_rd(lane, 32 * tt, ks));
#pragma unroll
              for (unsigned st = 0; st < 2; ++st) { const bool valid = dir == 0 ? (st <= tt) : (st >= tt);
                if (valid) {
                  f32x16 x = {};
#pragma unroll
                  for (int ks = 0; ks < 8; ++ks) { const bf16x8 ka = *(const LAS bf16x8*)(L + KM + row_rd(lane, 32 * st, ks)); x = __builtin_amdgcn_mfma_f32_32x32x16_bf16(ka, qb[ks], x, 0, 0, 0); }
                  if (st == tt) {
#pragma unroll
                    for (int r = 0; r < 16; ++r) { const int kr = crow(r, h5); const bool keep = dir == 0 ? (kr <= r32) : (kr >= r32); x[r] = keep ? x[r] : 0.f; } }
                  const s16x4 v0l = trr(Lb + VT + tr_perm(lane, dvt, 32 * st, 0)), v0h = trr(Lb + VT + tr_perm(lane, dvt, 32 * st, 1));
                  const s16x4 v1l = trr(Lb + VT + tr_perm(lane, dvt, 32 * st + 16, 0)), v1h = trr(Lb + VT + tr_perm(lane, dvt, 32 * st + 16, 1));
                  u32x4 A0, A1; A0.x = pk2(x[0], x[1]); A0.y = pk2(x[2], x[3]); A0.z = pk2(x[4], x[5]); A0.w = pk2(x[6], x[7]);
                  A1.x = pk2(x[8], x[9]); A1.y = pk2(x[10], x[11]); A1.z = pk2(x[12], x[13]); A1.w = pk2(x[14], x[15]);
                  HG_WAITL();
                  acc = __builtin_amdgcn_mfma_f32_32x32x16_bf16(*reinterpret_cast<bf16x8*>(&A0), pk8(v0l, v0h), acc, 0, 0, 0);
                  acc = __builtin_amdgcn_mfma_f32_32x32x16_bf16(*reinterpret_cast<bf16x8*>(&A1), pk8(v1l, v1h), acc, 0, 0, 0);
                } } }
        }
        LAS float* red = (LAS float*)(L + RED);
#pragma unroll
        for (int r = 0; r < 16; ++r) { float s = acc[r] * acc[r]; s += __shfl_xor(s, 1); s += __shfl_xor(s, 2); s += __shfl_xor(s, 4); s += __shfl_xor(s, 8); s += __shfl_xor(s, 16);
            if (r32 == 0) red[(tt * 32 + crow(r, h5)) * 4 + dvt] = s; }
        __syncthreads();
        const int col = hh * 128 + 32 * dvt + r32; const float wv = nw[32 * dvt + r32];
#pragma unroll
        for (int r = 0; r < 16; ++r) { const int row = 32 * tt + crow(r, h5); const f32x4 p = *(const LAS f32x4*)(red + row * 4);
            const float rstd = 1.0f / sqrtf(((p.x + p.y) + (p.z + p.w)) * (1.0f / 128.0f) + EPS); const size_t o = (R0 + row) * DM + col;
            Y[o] = (bf16_t)f2bf(acc[r] * rstd * wv * bf2f(GH[o])); }
    }
}
template <bool FINAL>
__device__ __forceinline__ void phase_lru(const Ctx& C, int e) {
    using namespace hg;
    LAS unsigned char* L = C.lds;
    constexpr unsigned UCB = 0, UCF = 16384, AT = 49152, BT = 81920;
    const bf16_t* P = WSP(bf16_t, WS_P); float* AG = WSP(float, WS_AG); const float* CARRY = WSP(float, WS_CARRY); bf16_t* Y = WSP(bf16_t, WS_Y);
    const bf16_t* WG = WSP(bf16_t, WS_WG) + (size_t)e * 4 * 128 * 1024;
    const float* cw = C.inp(10) + (size_t)e * 4 * DLRU; const float* cb = C.inp(11) + (size_t)e * DLRU;
    const float* ba = C.inp(13) + (size_t)e * 2 * DLRU; const float* bx = C.inp(15) + (size_t)e * 2 * DLRU; const float* lam = C.inp(16) + (size_t)e * 2 * DLRU;
    const int w = C.wave, lane = C.lane, tid = C.tid, h5 = lane >> 5, r32 = lane & 31;
    const unsigned rt = w >> 2, et = w & 3;
    for (int u = gridDim.x - 1 - blockIdx.x; u < (MROWS / 64) * 8; u += gridDim.x) {
        const int ci2 = u >> 3, hd = u & 7; const int c = ci2 % NCH, bb = ci2 / NCH; const size_t R0 = (size_t)ci2 * 64;
        const int s0 = c * 64, lo = c < 4 ? 0 : CTX, hi = c < 4 ? CTX : SROW;
        __syncthreads();
        float cin = 0.f;
        if (FINAL && tid < 256) { const int dir = tid >> 7, ch = tid & 127; cin = CARRY[(size_t)(ci2 * 2 + dir) * DLRU + hd * 128 + ch]; }
        { const int chn = hd * 128 + 2 * lane; const bf16_t* up = P + DLRU + chn;
          f32x2 uv[11];
#pragma unroll
          for (int i = 0; i < 11; ++i) { const int s = s0 + 8 * w + i - 2; unsigned raw = 0u; if (s >= lo && s < hi) raw = *(const unsigned*)(up + ((size_t)bb * SROW + s) * ABNP);
              uv[i].x = __uint_as_float(raw << 16); uv[i].y = __uint_as_float(raw & 0xffff0000u); }
          f32x2 wj[4];
#pragma unroll
          for (int j = 0; j < 4; ++j) wj[j] = *(const f32x2*)(cw + j * DLRU + chn);
          const f32x2 bias = *(const f32x2*)(cb + chn);
#pragma unroll
          for (int i = 0; i < 8; ++i) { f32x2 a = bias;
#pragma unroll
              for (int j = 0; j < 4; ++j) a += uv[i + j] * wj[j];
              *(LAS unsigned*)(L + UCB + off_b(8 * w + i, lane >> 2) + (lane & 3) * 4) = pk2(a.x, a.y);
              *(LAS f32x2*)(L + UCF + ((8 * w + i) * 128 + 2 * lane) * 4) = a; } }
        __syncthreads();
        bf16x8 af[8]; float ucr[16];
#pragma unroll
        for (int ks = 0; ks < 8; ++ks) af[ks] = *(const LAS bf16x8*)(L + UCB + row_rd(lane, 32 * rt, ks));
#pragma unroll
        for (int r = 0; r < 16; ++r) ucr[r] = *(const LAS float*)(L + UCF + ((32 * rt + crow(r, h5)) * 128 + 32 * et + r32) * 4);
        const int chl = hd * 128 + 32 * et + r32;
#pragma unroll 1
        for (int dir = 0; dir < 2; ++dir) {
            f32x16 ga = {}, gx = {};
            { const bf16_t* wa = WG + ((size_t)(dir * 2 + 0) * 128 + 32 * et + r32) * 1024 + hd * 128 + 8 * h5; const bf16_t* wx = wa + (size_t)128 * 1024;
              bf16x8 fa[8], fx[8];
#pragma unroll
              for (int ks = 0; ks < 8; ++ks) { fa[ks] = *(const bf16x8*)(wa + 16 * ks); fx[ks] = *(const bf16x8*)(wx + 16 * ks); }
#pragma unroll
              for (int ks = 0; ks < 8; ++ks) { ga = __builtin_amdgcn_mfma_f32_32x32x16_bf16(af[ks], fa[ks], ga, 0, 0, 0); gx = __builtin_amdgcn_mfma_f32_32x32x16_bf16(af[ks], fx[ks], gx, 0, 0, 0); } }
            const float bav = ba[dir * DLRU + chl], bxv = bx[dir * DLRU + chl], sp = log1pf(__expf(-lam[dir * DLRU + chl]));
            if (dir == 1) __syncthreads();
#pragma unroll
            for (int r = 0; r < 16; ++r) { const float rg = __builtin_amdgcn_rcpf(1.0f + __expf(-(ga[r] + bav))), ig = __builtin_amdgcn_rcpf(1.0f + __expf(-(gx[r] + bxv)));
                const float la = -8.0f * rg * sp; const unsigned o = ((32 * rt + crow(r, h5)) * 128 + 32 * et + r32) * 4;
                *(LAS float*)(L + AT + o) = __expf(la); *(LAS float*)(L + BT + o) = __builtin_amdgcn_sqrtf(1.0f - __expf(2.0f * la)) * (ig * ucr[r]); }
            __syncthreads();
            if ((tid >> 7) == dir) { const int ch = tid & 127; const LAS float* ap = (const LAS float*)(L + AT) + ch; const LAS float* bp = (const LAS float*)(L + BT) + ch;
                if (!FINAL) { float h = 0.f, ap_ = 1.f;
#pragma unroll 16
                    for (int i = 0; i < 64; ++i) { const int row = dir == 0 ? i : 63 - i; const float a = ap[row * 128]; h = a * h + bp[row * 128]; ap_ *= a; }
                    float* ag = AG + ((size_t)(ci2 * 2 + dir) * 2) * DLRU + hd * 128 + ch; ag[0] = ap_; ag[DLRU] = h; }
                else if (dir == 0) { float h = cin; LAS float* hp = (LAS float*)(L + UCF) + ch;
#pragma unroll 16
                    for (int i = 0; i < 64; ++i) { h = ap[i * 128] * h + bp[i * 128]; hp[i * 128] = h; } }
                else { float h = cin; const LAS float* hp = (const LAS float*)(L + UCF) + ch; const bf16_t* gp = P + R0 * ABNP + hd * 128 + ch; bf16_t* yp = Y + R0 * DM + hd * 128 + ch;
#pragma unroll 8
                    for (int i = 63; i >= 0; --i) { h = ap[i * 128] * h + bp[i * 128]; const float hs = hp[i * 128] + h; yp[(size_t)i * DM] = (bf16_t)f2bf(hs * gelu_tanh(bf2f(gp[(size_t)i * ABNP]))); } } }
        }
    }
}
__device__ __forceinline__ void phase_lru_carry(const Ctx& C) {
    using namespace hg;
    const float* AG = WSP(float, WS_AG); float* CARRY = WSP(float, WS_CARRY);
    const int G = gridDim.x, first = G >= 8 ? G - 8 : 0;
    if ((int)blockIdx.x < first) return;
    for (int id = ((int)blockIdx.x - first) * 512 + C.tid; id < NBATCH * 2 * DLRU; id += (G - first) * 512) { const int b = id >> 11, dir = (id >> 10) & 1, ch = id & 1023;
        float carry = 0.f;
#pragma unroll 4
        for (int j = 0; j < NCH; ++j) { const int cc = dir == 0 ? j : (j < 4 ? 3 - j : 71 - j); const size_t ci2 = (size_t)b * NCH + cc;
            CARRY[(ci2 * 2 + dir) * DLRU + ch] = carry; const float* ag = AG + ((ci2 * 2 + dir) * 2) * DLRU + ch; carry = carry * ag[0] + ag[DLRU]; } }
}
__device__ __forceinline__ void phase_final(const Ctx& C) {
    const float* XS = WSP(float, WS_XS); const float* w = C.inp(27);
    for (int r = C.gw; r < NBATCH * SEQ; r += C.ngw) { const int b = r / SEQ, t = r % SEQ; const size_t R = (size_t)b * SROW + CTX + t;
        const f32x4* xr = (const f32x4*)(XS + R * DM) + C.lane; f32x4 v[8]; float ss = 0.f;
#pragma unroll
        for (int j = 0; j < 8; ++j) { v[j] = xr[64 * j]; ss += (v[j].x * v[j].x + v[j].y * v[j].y) + (v[j].z * v[j].z + v[j].w * v[j].w); }
        const float rstd = 1.0f / sqrtf(wave_sum(ss) * (1.0f / DM) + EPS);
        f32x4* o = (f32x4*)(C.out + (size_t)r * DM) + C.lane;
#pragma unroll
        for (int j = 0; j < 8; ++j) { const f32x4 wv = *(const f32x4*)(w + (C.lane + 64 * j) * 4); o[64 * j] = v[j] * rstd * wv; } }
}

struct Args { const float* in[28]; float* out; unsigned char* ws; int ph_lo, ph_hi; };
constexpr int N_PHASES = 1 + 2 * 9 + 2 * 9 + 1;

__global__ void __launch_bounds__(512, 2) fwd_kernel(Args args) {
    extern __shared__ __attribute__((aligned(16))) unsigned char lds_raw[];
    LAS unsigned char* const lds0 = (LAS unsigned char*)lds_raw;
    const unsigned long long inaddr = (unsigned long long)__builtin_amdgcn_kernarg_segment_ptr();
    volatile LAS unsigned* misc = (volatile LAS unsigned*)(lds0 + LDS_MISC);
    if (threadIdx.x < 64) misc[threadIdx.x] = 0u;
    __syncthreads();
    const int lo = args.ph_lo, hi = args.ph_hi;
    const int wave0 = __builtin_amdgcn_readfirstlane(threadIdx.x >> 6);
    XcdBarrier bar; bar.bar = (unsigned*)(args.ws + WS_CTL) + 4096; bar.x = 0; bar.st = misc + 8;
    if (hi - lo > 1) bar = xcd_barrier_post((unsigned*)(args.ws + WS_CTL) + 4096, misc + 8);
    int pid = 0;
    const unsigned long long wsaddr = (unsigned long long)args.ws;
#define PH_BEGIN if (pid >= lo && pid < hi) { int l = l_; Ctx C; { unsigned long long a_ = inaddr, w_ = wsaddr; int t_; asm volatile("v_mbcnt_lo_u32_b32 %0, -1, 0\n\tv_mbcnt_hi_u32_b32 %0, -1, %0" : "=v"(t_)); t_ += wave0 * 64; asm volatile("" : "+s"(a_), "+s"(w_), "+s"(l)); \
        C.in = (InPtr)a_; C.ws = (unsigned char*)(GAS unsigned char*)w_; C.out = (float*)(GAS float*)args.out; C.lds = lds0; C.tid = t_; C.lane = t_ & 63; C.wave = __builtin_amdgcn_readfirstlane(t_ >> 6); \
        C.gw = blockIdx.x * 8 + C.wave; C.ngw = gridDim.x * 8; C.gtid = blockIdx.x * 512 + t_; C.ngt = gridDim.x * 512; } \
        const int e = l >> 1; const float* mod = WSP(float, WS_MOD) + (size_t)l * 3 * MODW; const int G = gridDim.x, cb = blockIdx.x; (void)e; (void)mod; (void)G; (void)cb;
#define PH_END } if (pid >= lo && pid + 1 < hi) xcd_barrier(bar); ++pid;
#ifndef PROBE_CAT
#define PROBE_CAT -1
#endif
#define DUP(cat, ...) { if (PROBE_CAT == (cat)) { const float SC_ = 0.f; (void)SC_; __VA_ARGS__ } { const float SC_ = 1.f; (void)SC_; __VA_ARGS__ } }
    int l_ = 0;
    PH_BEGIN
#ifndef SKIP_PRO
    DUP(0, phase_prologue(C);)
#endif
    PH_END

    constexpr int MLAT = NBATCH * SEQ;
    for (l_ = 0; l_ < DEPTH; ++l_) {
        PH_BEGIN DUP(1, phase_norm_mod(C, C.inp(6) + l * DM, mod, 0, 1);) PH_END
        if ((l_ & 1) == 0) {
            PH_BEGIN DUP(2, { const bf16_t* wt = WSP(bf16_t, WS_WABIN) + (size_t)e * ABNP * DM;
                       { pg8::Gemm g{WSP(bf16_t, WS_H), wt, MLAT, ABNP, DM, DM, DM, 1}; pg8::StaticOrder S; S.init(MLAT, ABNP, G, cb); EpiBf16Plain E{WSP(bf16_t, WS_P), ABNP}; pg8::gemm_phase(C.lds, C.tid, g, S, E); }
                       DUP(14, { sg::SGemm g{WSP(bf16_t, WS_H), wt, ABNP, DM, DM, DM}; SEpiPlain E{WSP(bf16_t, WS_P), ABNP}; sg::sgemm_phase(C.lds, C.tid, g, 32 * (ABNP / 256), E); }) }) PH_END
            PH_BEGIN DUP(3, { phase_lru<false>(C, e); phase_rs_kr(C); }) PH_END
            PH_BEGIN phase_lru_carry(C); DUP(4, { const bf16_t* wq = WSP(bf16_t, WS_WUQ) + (size_t)e * QW * 512; const bf16_t* wkv = WSP(bf16_t, WS_WUKV) + (size_t)e * KVW * 512;
                       { pg8::Gemm g{WSP(bf16_t, WS_P) + 2048, wq, MLAT, QW, 512, ABNP, 512, 1}; pg8::StaticOrder S; S.init(MLAT, QW, G, cb); EpiBf16RowScale E{WSP(bf16_t, WS_Q), QW, WSP(float, WS_RSQ)}; pg8::gemm_phase(C.lds, C.tid, g, S, E); }
                       { pg8::Gemm g{WSP(bf16_t, WS_P) + 2560, wkv, MLAT, KVW, 512, ABNP, 512, 1}; pg8::StaticOrder S; S.init(MLAT, KVW, G, cb); EpiBf16RowScale E{WSP(bf16_t, WS_KV), KVW, WSP(float, WS_RSKV)}; pg8::gemm_phase(C.lds, C.tid, g, S, E); }
                       DUP(14, { sg::SGemm g{WSP(bf16_t, WS_P) + 2048, wq, QW, 512, ABNP, 512}; SEpiRowScale E{WSP(bf16_t, WS_Q), QW, WSP(float, WS_RSQ)}; sg::sgemm_phase(C.lds, C.tid, g, 32 * (QW / 256), E); })
                       DUP(14, { sg::SGemm g{WSP(bf16_t, WS_P) + 2560, wkv, KVW, 512, ABNP, 512}; SEpiRowScale E{WSP(bf16_t, WS_KV), KVW, WSP(float, WS_RSKV)}; sg::sgemm_phase(C.lds, C.tid, g, 0, E); }) })
            PH_END
            PH_BEGIN DUP(5, phase_lru<true>(C, e);) DUP(6, phase_attn(C);) PH_END
        } else {
            PH_BEGIN DUP(7, { const bf16_t* wt = WSP(bf16_t, WS_WHGIN) + (size_t)e * HGN * DM;
                       { pg8::Gemm g{WSP(bf16_t, WS_H), wt, MLAT, HGN, DM, DM, DM, 1}; pg8::StaticOrder S; S.init(MLAT, HGN, G, cb); EpiHG E{WSP(bf16_t, WS_QH), WSP(float, WS_LOGF), WSP(float, WS_LB) + l * 2048}; pg8::gemm_phase(C.lds, C.tid, g, S, E); }
                       DUP(14, { sg::SGemm g{WSP(bf16_t, WS_H), wt, HGN, DM, DM, DM}; SEpiHG E{WSP(bf16_t, WS_QH), WSP(float, WS_LOGF), WSP(float, WS_LB) + l * 2048}; sg::sgemm_phase(C.lds, C.tid, g, 32 * (HGN / 256), E); }) }) PH_END
            PH_BEGIN DUP(8, phase_hg_ds(C);) PH_END
            PH_BEGIN DUP(9, phase_hg_scan(C);) PH_END
            PH_BEGIN DUP(10, phase_hg_out(C, e);) PH_END
        }
        PH_BEGIN DUP(11, { const bf16_t* wout = (l & 1) ? WSP(bf16_t, WS_WHGOUT) + (size_t)e * DM * DM : WSP(bf16_t, WS_WABOUT) + (size_t)e * DM * DM;
                   { pg8::Gemm g{WSP(bf16_t, WS_Y), wout, MLAT, DM, DM, DM, DM, 1}; pg8::StaticOrder S; S.init(MLAT, DM, G, cb); EpiResid E{WSP(float, WS_XS), mod + 2 * DM, SC_}; pg8::gemm_phase(C.lds, C.tid, g, S, E); }
                   if (l != DEPTH - 1) DUP(14, { sg::SGemm g{WSP(bf16_t, WS_Y), wout, DM, DM, DM, DM}; SEpiResid E{WSP(float, WS_XS), mod + 2 * DM, SC_}; sg::sgemm_phase(C.lds, C.tid, g, 32 * (DM / 256), E); }) }) PH_END
        PH_BEGIN DUP(1, phase_norm_mod(C, C.inp(7) + l * DM, mod, 3, 4);) PH_END
        PH_BEGIN DUP(12, { const bf16_t* wt = WSP(bf16_t, WS_W1) + (size_t)l * DFF * DM;
                   { pg8::Gemm g{WSP(bf16_t, WS_H), wt, MLAT, DFF, DM, DM, DM, 1}; pg8::StaticOrder S; S.init(MLAT, DFF, G, cb); EpiRelu2 E{WSP(bf16_t, WS_HID), DFF}; pg8::gemm_phase(C.lds, C.tid, g, S, E); }
                   if (l != DEPTH - 1) DUP(16, { sg::SGemm g{WSP(bf16_t, WS_H), wt, DFF, DM, DM, DM}; SEpiRelu2 E{WSP(bf16_t, WS_HID), DFF}; sg::sgemm_phase(C.lds, C.tid, g, 32 * (DFF / 256), E); }) }) PH_END
        PH_BEGIN DUP(13, { const bf16_t* wt = WSP(bf16_t, WS_W2) + (size_t)l * DM * DFF;
                   { pg8::Gemm g{WSP(bf16_t, WS_HID), wt, MLAT, DM, DFF, DFF, DFF, 1}; pg8::StaticOrder S; S.init(MLAT, DM, G, cb); EpiResid E{WSP(float, WS_XS), mod + 5 * DM, SC_}; pg8::gemm_phase(C.lds, C.tid, g, S, E); }
                   if (l != DEPTH - 1) DUP(15, { sg::SGemm g{WSP(bf16_t, WS_HID), wt, DM, DFF, DFF, DFF}; SEpiResid E{WSP(float, WS_XS), mod + 5 * DM, SC_}; sg::sgemm_phase(C.lds, C.tid, g, 32 * (DM / 256), E); }) }) PH_END
    }
    l_ = 0;
    PH_BEGIN phase_final(C); PH_END
}

#ifndef N_LAUNCH_MODE
#define N_LAUNCH_MODE 1
#endif
extern "C" void kernel_launch(void* const* d_in, const int* in_sizes, int n_in, void* d_out, int out_size, void* d_ws, size_t ws_size, hipStream_t stream) {
    static int grid = 0;
    if (grid == 0) {
        if (n_in != 28 || out_size != NBATCH * SEQ * DM || ws_size < WS_END) { fprintf(stderr, "kernel_launch: shape mismatch n_in %d out %d ws %zu (need %zu)\n", n_in, out_size, ws_size, (size_t)WS_END); grid = -1; return; }
        int dev = 0, cus = 0, per_cu = 0;
        if (hipGetDevice(&dev) != hipSuccess || hipDeviceGetAttribute(&cus, hipDeviceAttributeMultiprocessorCount, dev) != hipSuccess) { grid = -1; return; }
        if (hipFuncSetAttribute((const void*)fwd_kernel, hipFuncAttributeMaxDynamicSharedMemorySize, LDS_BYTES) != hipSuccess) { fprintf(stderr, "kernel_launch: hipFuncSetAttribute failed\n"); grid = -1; return; }
        if (hipOccupancyMaxActiveBlocksPerMultiprocessor(&per_cu, (const void*)fwd_kernel, 512, LDS_BYTES) != hipSuccess || per_cu < 1) fprintf(stderr, "kernel_launch: occupancy query says %d\n", per_cu);
        (void)hipGetLastError();
        grid = cus;
    }
    if (grid < 0) return;
    (void)hipMemsetAsync((char*)d_ws + WS_CTL, 0, CTL_BYTES, stream);
    Args a{};
    for (int i = 0; i < 28; ++i) a.in[i] = (const float*)d_in[i];
    a.out = (float*)d_out; a.ws = (unsigned char*)d_ws;
#if N_LAUNCH_MODE == 1
    a.ph_lo = 0; a.ph_hi = N_PHASES;
    hipLaunchKernelGGL(fwd_kernel, dim3(grid), dim3(512), LDS_BYTES, stream, a);
#else
    for (int p = 0; p < N_PHASES; ++p) { a.ph_lo = p; a.ph_hi = p + 1; hipLaunchKernelGGL(fwd_kernel, dim3(grid), dim3(512), LDS_BYTES, stream, a); }
#endif
    const hipError_t le = hipPeekAtLastError();
    if (le != hipSuccess) fprintf(stderr, "kernel_launch: launch failed: %s\n", hipGetErrorName(le));
}
```

```cpp
#include <hip/hip_runtime.h>
#include <cstdio>

#define LAS __attribute__((address_space(3)))
#define GAS __attribute__((address_space(1)))
typedef unsigned short bf16_t;
typedef short bf16x8 __attribute__((ext_vector_type(8)));
typedef float f32x4 __attribute__((ext_vector_type(4)));
typedef float f32x2 __attribute__((ext_vector_type(2)));
typedef unsigned u32x4 __attribute__((ext_vector_type(4)));
typedef unsigned u32x2 __attribute__((ext_vector_type(2)));

constexpr int DM = 2048, NBATCH = 2, SEQ = 4096, DEPTH = 4, CTX = 256;
constexpr int SROW = CTX + SEQ;
constexpr int MROWS = NBATCH * SROW;
constexpr int DFF = 8192, MODW = 6 * DM;
constexpr int DLRU = 1024;
constexpr int ABN = 3136, ABNP = 3328;
constexpr int QW = 1536, KVW = 2048, HGN = 10240;
constexpr float EPS = 1e-6f;
constexpr float ATTN_SCALE = 0.07216878364870322f;

constexpr size_t al256(size_t x) { return (x + 255) & ~(size_t)255; }
constexpr size_t WS_CTL = 0, CTL_BYTES = 1u << 20;
constexpr size_t WS_MOD = WS_CTL + CTL_BYTES;
constexpr size_t WS_LB = WS_MOD + al256((size_t)DEPTH * 3 * MODW * 4);
constexpr size_t WS_ROPE = WS_LB + al256((size_t)DEPTH * 2048 * 4);
constexpr size_t WS_RSQ = WS_ROPE + al256(2 * 64 * 16 * 4);
constexpr size_t WS_RSKV = WS_RSQ + al256((size_t)MROWS * 4);
constexpr size_t WS_WABIN = WS_RSKV + al256((size_t)MROWS * 4);
constexpr size_t WS_WABOUT = WS_WABIN + (size_t)2 * ABNP * DM * 2;
constexpr size_t WS_WUQ = WS_WABOUT + (size_t)2 * DM * DM * 2;
constexpr size_t WS_WUKV = WS_WUQ + (size_t)2 * QW * 512 * 2;
constexpr size_t WS_WHGIN = WS_WUKV + (size_t)2 * KVW * 512 * 2;
constexpr size_t WS_WHGOUT = WS_WHGIN + (size_t)2 * HGN * DM * 2;
constexpr size_t WS_W1 = WS_WHGOUT + (size_t)2 * DM * DM * 2;
constexpr size_t WS_W2 = WS_W1 + (size_t)4 * DFF * DM * 2;
constexpr size_t WS_WG = WS_W2 + (size_t)4 * DFF * DM * 2;
constexpr size_t WS_XS = WS_WG + (size_t)2 * 4 * 128 * 1024 * 2;
constexpr size_t WS_H = WS_XS + (size_t)MROWS * DM * 4;
constexpr size_t WS_Y = WS_H + (size_t)MROWS * DM * 2;
constexpr size_t WS_BIG = WS_Y + (size_t)MROWS * DM * 2;
constexpr size_t WS_P = WS_BIG;
constexpr size_t WS_AG = WS_P + (size_t)MROWS * ABNP * 2;
constexpr size_t WS_CARRY = WS_AG + al256((size_t)(MROWS / 64) * 2 * 2 * DLRU * 4);
constexpr size_t WS_Q = WS_CARRY + al256((size_t)(MROWS / 64) * 2 * DLRU * 4);
constexpr size_t WS_KV = WS_Q + (size_t)MROWS * QW * 2;
constexpr size_t WS_KR = WS_KV + (size_t)MROWS * KVW * 2;
constexpr size_t WS_AB_END = WS_KR + (size_t)MROWS * 64 * 2;
constexpr size_t WS_QH = WS_BIG;
constexpr size_t WS_VH = WS_QH + (size_t)MROWS * DM * 2;
constexpr size_t WS_GH = WS_VH + (size_t)MROWS * DM * 2;
constexpr size_t WS_LOGF = WS_GH + (size_t)MROWS * DM * 2;
constexpr size_t WS_DS = WS_LOGF + (size_t)2 * MROWS * DM * 4;
constexpr size_t WS_DEC = WS_DS + (size_t)64 * 68 * 16384 * 4;
constexpr size_t WS_SS = WS_DEC + (size_t)64 * 68 * 128 * 4;
constexpr size_t WS_HG_END = WS_SS + (size_t)64 * 68 * 16384 * 2;
constexpr size_t WS_HID = WS_BIG;
constexpr size_t WS_MLP_END = WS_HID + (size_t)MROWS * DFF * 2;
constexpr size_t cmax(size_t a, size_t b) { return a > b ? a : b; }
constexpr size_t WS_END = cmax(cmax(WS_AB_END, WS_HG_END), WS_MLP_END);

constexpr int LDS_BYTES = 147456;
constexpr int LDS_MISC = 139264;

__device__ __forceinline__ float bf2f(bf16_t v) { return __uint_as_float(((unsigned)v) << 16); }
__device__ __forceinline__ unsigned f2bf(float f) { unsigned u = __float_as_uint(f); return (u + 0x7fffu + ((u >> 16) & 1u)) >> 16; }
__device__ __forceinline__ unsigned pk2(float lo, float hi) { return f2bf(lo) | (f2bf(hi) << 16); }
__device__ __forceinline__ float wave_sum(float v) {
#pragma unroll
    for (int o = 1; o < 64; o <<= 1) v += __shfl_xor(v, o);
    return v;
}
__device__ __forceinline__ float wave_max(float v) {
#pragma unroll
    for (int o = 1; o < 64; o <<= 1) v = fmaxf(v, __shfl_xor(v, o));
    return v;
}
__device__ __forceinline__ float sigmoidf_(float x) { return 1.0f / (1.0f + expf(-x)); }
__device__ __forceinline__ float siluf_(float x) { return x / (1.0f + expf(-x)); }
__device__ __forceinline__ float fsigmoid(float x) { return __builtin_amdgcn_rcpf(1.0f + __expf(-x)); }
__device__ __forceinline__ float gelu_tanh(float x) { const float u = 0.7978845608028654f * (x + 0.044715f * x * x * x); return 0.5f * x * (1.0f + tanhf(u)); }

#define XB_TMO      128
#define XB_XCNT(j)  (256  + 64 * (j))
#define XB_XSUB(j)  (1280 + 64 * (j))
#define XB_XGEN(j)  (2304 + 64 * (j))
#define XB_TOP      3328
#define XB_TOPGEN   3392
#define XCD_BAR_WORDS 3456
#define XB_SPIN_CAP (1u << 18)
__device__ __forceinline__ unsigned xb_ld(unsigned* p)              { return __hip_atomic_load(p, __ATOMIC_RELAXED, __HIP_MEMORY_SCOPE_AGENT); }
__device__ __forceinline__ unsigned xb_add(unsigned* p, unsigned v) { return __hip_atomic_fetch_add(p, v, __ATOMIC_RELAXED, __HIP_MEMORY_SCOPE_AGENT); }
__device__ __forceinline__ unsigned xb_xcc_id() { return (unsigned)__builtin_amdgcn_s_getreg((3 << 11) | 20) & 0xFu; }
#define XB_SPIN(cond, bar) do { unsigned _sp = 0; while (cond) { __builtin_amdgcn_s_sleep(1); \
    if ((++_sp & 255u) == 0u) { if (xb_ld(&(bar)[XB_TMO])) break; if (_sp > XB_SPIN_CAP) { atomicAdd(&(bar)[XB_TMO], 1u); break; } } } } while (0)
struct XcdBarrier { unsigned* bar; unsigned x; volatile LAS unsigned* st; };
__device__ __forceinline__ XcdBarrier xcd_barrier_post(unsigned* bar, volatile LAS unsigned* st) {
    XcdBarrier b; b.bar = bar; b.x = xb_xcc_id(); b.st = st;
    if (threadIdx.x == 0) (void)xb_add(&bar[XB_XCNT(b.x)], 1u);
    return b;
}
__device__ __forceinline__ void xcd_barrier_complete(unsigned* bar, unsigned x, unsigned& nloc, unsigned& nx) {
    const unsigned G = gridDim.x * gridDim.y * gridDim.z;
    unsigned sum, cnt, mine, sp = 0u;
    for (;;) {
        sum = 0u; cnt = 0u; mine = 0u;
#pragma unroll
        for (unsigned j = 0; j < 16; ++j) { const unsigned c = xb_ld(&bar[XB_XCNT(j)]); sum += c; cnt += (c > 0u) ? 1u : 0u; mine = (j == x) ? c : mine; }
        if (sum == G) break;
        __builtin_amdgcn_s_sleep(1);
        if ((++sp & 255u) == 0u) { if (xb_ld(&bar[XB_TMO])) break; if (sp > XB_SPIN_CAP) { atomicAdd(&bar[XB_TMO], 1u); break; } }
    }
    nloc = mine > 0u ? mine : 1u; nx = cnt > 0u ? cnt : 1u;
}
__device__ __forceinline__ void xcd_barrier(const XcdBarrier& b) {
    asm volatile("s_waitcnt vmcnt(0)" ::: "memory");
    __syncthreads();
    if (threadIdx.x == 0) {
        unsigned* bar = b.bar; asm volatile("" : "+s"(bar)); bar = (unsigned*)(GAS unsigned*)bar;
        __builtin_amdgcn_s_waitcnt(0);
        unsigned nloc = b.st[0], nx = b.st[1];
        if (nloc == 0u) { xcd_barrier_complete(bar, b.x, nloc, nx); b.st[0] = nloc; b.st[1] = nx; }
        const unsigned old = xb_add(&bar[XB_XSUB(b.x)], 1u);
        const unsigned gen = old / nloc;
        if (old + 1u == (gen + 1u) * nloc) {
            __builtin_amdgcn_fence(__ATOMIC_RELEASE, "agent");
            asm volatile("s_waitcnt vmcnt(0)" ::: "memory");
            const unsigned og = xb_add(&bar[XB_TOP], 1u);
            const unsigned tg = og / nx;
            if (og + 1u == (tg + 1u) * nx) xb_add(&bar[XB_TOPGEN], 1u);
            else XB_SPIN(xb_ld(&bar[XB_TOPGEN]) == tg, bar);
            __builtin_amdgcn_fence(__ATOMIC_ACQUIRE, "agent");
            xb_add(&bar[XB_XGEN(b.x)], 1u);
            asm volatile("s_waitcnt vmcnt(0)" ::: "memory");
        } else {
            XB_SPIN(xb_ld(&bar[XB_XGEN(b.x)]) == gen, bar);
            __builtin_amdgcn_fence(__ATOMIC_ACQUIRE, "agent");
            asm volatile("s_waitcnt vmcnt(0)" ::: "memory");
        }
    }
    __syncthreads();
}

namespace pg8 {
constexpr int BM = 256, BK = 64, HALF = 128, HTB = HALF * BK * 2, STAGE_BYTES = 8 * HTB, NXCD = 8, WGM = 8;
__host__ __device__ __forceinline__ int lds_byte(int r, int c) { const int st = (r >> 4) * 2 + (c >> 5), rr = r & 15, cc = c & 31, ob = rr * 64 + cc * 2; return st * 1024 + (ob ^ (((ob >> 9) & 1) << 5)); }
__host__ __device__ __forceinline__ void stage_rc(int b, int& R, int& C) { const int st = b / 1024, sb = b % 1024, swz = sb ^ (((sb >> 9) & 1) << 5); R = (st >> 1) * 16 + swz / 64; C = (st & 1) * 32 + (swz % 64) / 2; }
__host__ __device__ __forceinline__ int perm32(int rho) { const int n = rho >> 4, i = rho & 15; return 8 * (i >> 2) + 4 * n + (i & 3); }
struct Unit { int pm, pn; };
struct Gemm { const bf16_t* A; const bf16_t* Bt; int M, N, K, lda, ldb, lat; };
struct StaticOrder {
    int nM, nN, nwg, G, c;
    __host__ __device__ void init(int M, int N, int G_, int c_) { nM = M / BM; nN = N / BM; nwg = nM * nN; G = G_; c = c_; }
    __host__ __device__ bool next(int i, Unit& u) const {
        const long L = (long)i * G + c; if (L >= nwg) return false;
        int wgid = (int)L; { const int q = nwg / NXCD, r = nwg % NXCD, xcd = wgid % NXCD, off = wgid / NXCD; wgid = (xcd < r ? xcd * (q + 1) : r * (q + 1) + (xcd - r) * q) + off; }
        const int nig = WGM * nN, gid = wgid / nig, fm = gid * WGM, gsz = (nM - fm) < WGM ? (nM - fm) : WGM;
        u.pm = fm + ((wgid % nig) % gsz); u.pn = (wgid % nig) / gsz; return true;
    }
};
__device__ __forceinline__ unsigned cvt_pk_bf16(float lo, float hi) { unsigned r; asm volatile("v_cvt_pk_bf16_f32 %0, %1, %2" : "=v"(r) : "v"(lo), "v"(hi)); return r; }

template <class Epi>
__device__ __forceinline__ void gemm_phase(LAS unsigned char* lds, const int tid, const Gemm g, const StaticOrder& S, const Epi& E) {
    const int wid = __builtin_amdgcn_readfirstlane(tid >> 6), lane = tid & 63, wr = wid >> 2, wc = wid & 3, fr = lane & 15, fq = lane >> 4;
    const int K = g.K, nt = K / BK;
    unsigned voffA[2], voffB[2];
#pragma unroll
    for (int i = 0; i < 2; ++i) { int R, C; stage_rc(tid * 16 + i * 8192, R, C); const int Rb = Epi::PERM ? ((R & ~31) + perm32(R & 31)) : R;
        voffA[i] = (unsigned)(R * g.lda + C) * 2u; voffB[i] = (unsigned)(Rb * g.ldb + C) * 2u; }
    const size_t kstep = (size_t)(BK * 2);
    const size_t hsA = (size_t)HALF * g.lda * 2, hsB = (size_t)HALF * g.ldb * 2;
    const size_t tsA = 2 * hsA, tsB = 2 * hsB;
    const unsigned ldsw = (unsigned)wid * 1024u;
    const int aoff = lds_byte(wr * 64 + fr, fq * 8), boff = lds_byte(wc * 32 + fr, fq * 8);
#define PG8_SA(b, h) (((b) * 2 + (h)) * HTB)
#define PG8_SB(b, h) ((4 + (b) * 2 + (h)) * HTB)
#define PG8_STAGE(bufoff, gbase, voff) do { _Pragma("unroll") for (int _i = 0; _i < 2; ++_i) \
        __builtin_amdgcn_global_load_lds((const unsigned*)((const char*)(gbase) + (voff)[_i]), (LAS unsigned*)(lds + (bufoff) + ldsw + _i * 8192), 16, 0, 0); } while (0)
#define PG8_LDA(dst, b, h) do { _Pragma("unroll") for (int m = 0; m < 4; ++m) _Pragma("unroll") for (int k = 0; k < 2; ++k) dst[m][k] = *(const LAS bf16x8*)(lds + PG8_SA(b, h) + aoff + m * 2048 + k * 1024); } while (0)
#define PG8_LDB(dst, b, h) do { _Pragma("unroll") for (int n = 0; n < 2; ++n) _Pragma("unroll") for (int k = 0; k < 2; ++k) dst[n][k] = *(const LAS bf16x8*)(lds + PG8_SB(b, h) + boff + n * 2048 + k * 1024); } while (0)
#define PG8_MMA(ai, bj, At, Bt) do { __builtin_amdgcn_s_setprio(1); _Pragma("unroll") for (int m = 0; m < 4; ++m) _Pragma("unroll") for (int n = 0; n < 2; ++n) _Pragma("unroll") for (int k = 0; k < 2; ++k) \
        acc[ai][bj][m][n] = __builtin_amdgcn_mfma_f32_16x16x32_bf16(Bt[n][k], At[m][k], acc[ai][bj][m][n], 0, 0, 0); __builtin_amdgcn_s_setprio(0); } while (0)
#define PG8_WAIT_V(n) asm volatile("s_waitcnt vmcnt(" #n ")" ::: "memory")
#define PG8_WAIT_L(n) asm volatile("s_waitcnt lgkmcnt(" #n ")" ::: "memory")
#define PG8_BAR __builtin_amdgcn_s_barrier()
#define PG8_SCHED __builtin_amdgcn_sched_barrier(0)
    Unit cur, nxt; int ui = 0;
    if (!S.next(0, cur)) return;
    if (g.lat) cur.pm += (cur.pm >> 4) + 1;
    f32x4 acc[2][2][4][2];
#pragma unroll
    for (int a = 0; a < 2; ++a)
#pragma unroll
        for (int b = 0; b < 2; ++b)
#pragma unroll
            for (int m = 0; m < 4; ++m)
#pragma unroll
                for (int n = 0; n < 2; ++n) acc[a][b][m][n] = (f32x4){0.f, 0.f, 0.f, 0.f};
    bf16x8 At[4][2], B0[2][2], B1[2][2];
    const char* cA = (const char*)g.A + (size_t)cur.pm * tsA; const char* cB = (const char*)g.Bt + (size_t)cur.pn * tsB;
    PG8_STAGE(PG8_SB(0, 0), cB, voffB); PG8_STAGE(PG8_SA(0, 0), cA, voffA); PG8_STAGE(PG8_SB(0, 1), cB + hsB, voffB); PG8_STAGE(PG8_SA(0, 1), cA + hsA, voffA);
    if (wr == 1) PG8_BAR;
    PG8_WAIT_V(4); PG8_BAR;
    PG8_STAGE(PG8_SB(1, 0), cB + kstep, voffB); PG8_STAGE(PG8_SA(1, 0), cA + kstep, voffA); PG8_STAGE(PG8_SB(1, 1), cB + hsB + kstep, voffB);
    PG8_WAIT_V(6); PG8_BAR;
    for (;;) {
        const bool has_next = S.next(ui + 1, nxt);
        if (g.lat && has_next) nxt.pm += (nxt.pm >> 4) + 1;
        const char* nA = has_next ? (const char*)g.A + (size_t)nxt.pm * tsA : cA; const char* nB = has_next ? (const char*)g.Bt + (size_t)nxt.pn * tsB : cB;
        for (int t = 0; t < nt; t += 2) {
            const bool last = (t == nt - 2);
            const char* a1 = cA + (size_t)(t + 1) * kstep;
            const char* a2 = last ? nA : cA + (size_t)(t + 2) * kstep; const char* b2 = last ? nB : cB + (size_t)(t + 2) * kstep;
            const char* a3 = a2 + kstep; const char* b3 = b2 + kstep;
            PG8_LDB(B0, 0, 0); PG8_SCHED; PG8_LDA(At, 0, 0); PG8_STAGE(PG8_SA(1, 1), a1 + hsA, voffA);
            PG8_WAIT_L(8); PG8_BAR; PG8_WAIT_L(0); PG8_MMA(0, 0, At, B0); PG8_BAR; PG8_SCHED;
            PG8_LDB(B1, 0, 1); PG8_STAGE(PG8_SB(0, 0), b2, voffB);
            PG8_BAR; PG8_WAIT_L(0); PG8_MMA(0, 1, At, B1); PG8_BAR;
            PG8_LDA(At, 0, 1); PG8_STAGE(PG8_SA(0, 0), a2, voffA);
            PG8_BAR; PG8_WAIT_L(0); PG8_MMA(1, 0, At, B0); PG8_BAR; PG8_SCHED;
            PG8_STAGE(PG8_SB(0, 1), b2 + hsB, voffB);
            PG8_WAIT_V(6); PG8_BAR; PG8_MMA(1, 1, At, B1); PG8_BAR;
            PG8_LDB(B0, 1, 0); PG8_SCHED; PG8_LDA(At, 1, 0); PG8_STAGE(PG8_SA(0, 1), a2 + hsA, voffA);
            PG8_WAIT_L(8); PG8_BAR; PG8_WAIT_L(0); PG8_MMA(0, 0, At, B0); PG8_BAR; PG8_SCHED;
            PG8_LDB(B1, 1, 1); PG8_STAGE(PG8_SB(1, 0), b3, voffB);
            PG8_BAR; PG8_WAIT_L(0); PG8_MMA(0, 1, At, B1); PG8_BAR;
            PG8_LDA(At, 1, 1); PG8_STAGE(PG8_SA(1, 0), a3, voffA);
            PG8_BAR; PG8_WAIT_L(0); PG8_MMA(1, 0, At, B0); PG8_BAR; PG8_SCHED;
            PG8_STAGE(PG8_SB(1, 1), b3 + hsB, voffB);
            PG8_WAIT_V(6); PG8_BAR; PG8_MMA(1, 1, At, B1); PG8_BAR;
        }
        E(acc, cur, wr, wc, fr, fq);
        if (!has_next) break;
#pragma unroll
        for (int a = 0; a < 2; ++a)
#pragma unroll
            for (int b = 0; b < 2; ++b)
#pragma unroll
                for (int m = 0; m < 4; ++m)
#pragma unroll
                    for (int n = 0; n < 2; ++n) acc[a][b][m][n] = (f32x4){0.f, 0.f, 0.f, 0.f};
        cur = nxt; cA = nA; cB = nB; ++ui;
    }
    PG8_WAIT_V(0);
    if (wr == 0) PG8_BAR;
    PG8_BAR;
#undef PG8_SA
#undef PG8_SB
#undef PG8_STAGE
#undef PG8_LDA
#undef PG8_LDB
#undef PG8_MMA
#undef PG8_WAIT_V
#undef PG8_WAIT_L
#undef PG8_BAR
#undef PG8_SCHED
}
}

#define EPI_ROWS_COLS_PERM \
    const int row0 = u.pm * 256 + wr * 64 + fr; const int col0 = u.pn * 256 + wc * 32 + 8 * fq;
struct EpiBf16Plain {
    static constexpr bool PERM = true;
    bf16_t* O; int ldc;
    __device__ __forceinline__ void operator()(const f32x4 (&acc)[2][2][4][2], const pg8::Unit& u, int wr, int wc, int fr, int fq) const {
        EPI_ROWS_COLS_PERM
#pragma unroll
        for (int ai = 0; ai < 2; ++ai)
#pragma unroll
            for (int m = 0; m < 4; ++m) { bf16_t* rowp = O + (size_t)(row0 + ai * 128 + m * 16) * ldc + col0;
#pragma unroll
                for (int bj = 0; bj < 2; ++bj) { const f32x4 v0 = acc[ai][bj][m][0], v1 = acc[ai][bj][m][1];
                    u32x4 w; w.x = pk2(v0[0], v0[1]); w.y = pk2(v0[2], v0[3]); w.z = pk2(v1[0], v1[1]); w.w = pk2(v1[2], v1[3]);
                    *(u32x4*)(rowp + bj * 128) = w; } }
    }
};
struct EpiBf16RowScale {
    static constexpr bool PERM = true;
    bf16_t* O; int ldc; const float* rs;
    __device__ __forceinline__ void operator()(const f32x4 (&acc)[2][2][4][2], const pg8::Unit& u, int wr, int wc, int fr, int fq) const {
        EPI_ROWS_COLS_PERM
#pragma unroll
        for (int ai = 0; ai < 2; ++ai)
#pragma unroll
            for (int m = 0; m < 4; ++m) { const int row = row0 + ai * 128 + m * 16; const float s = rs[row]; bf16_t* rowp = O + (size_t)row * ldc + col0;
#pragma unroll
                for (int bj = 0; bj < 2; ++bj) { const f32x4 v0 = acc[ai][bj][m][0] * s, v1 = acc[ai][bj][m][1] * s;
                    u32x4 w; w.x = pk2(v0[0], v0[1]); w.y = pk2(v0[2], v0[3]); w.z = pk2(v1[0], v1[1]); w.w = pk2(v1[2], v1[3]);
                    *(u32x4*)(rowp + bj * 128) = w; } }
    }
};
struct EpiRelu2 {
    static constexpr bool PERM = true;
    bf16_t* O; int ldc;
    __device__ __forceinline__ void operator()(const f32x4 (&acc)[2][2][4][2], const pg8::Unit& u, int wr, int wc, int fr, int fq) const {
        EPI_ROWS_COLS_PERM
#pragma unroll
        for (int ai = 0; ai < 2; ++ai)
#pragma unroll
            for (int m = 0; m < 4; ++m) { bf16_t* rowp = O + (size_t)(row0 + ai * 128 + m * 16) * ldc + col0;
#pragma unroll
                for (int bj = 0; bj < 2; ++bj) { f32x4 v0 = acc[ai][bj][m][0], v1 = acc[ai][bj][m][1];
#pragma unroll
                    for (int j = 0; j < 4; ++j) { const float a = fmaxf(v0[j], 0.f), b = fmaxf(v1[j], 0.f); v0[j] = a * a; v1[j] = b * b; }
                    u32x4 w; w.x = pk2(v0[0], v0[1]); w.y = pk2(v0[2], v0[3]); w.z = pk2(v1[0], v1[1]); w.w = pk2(v1[2], v1[3]);
                    *(u32x4*)(rowp + bj * 128) = w; } }
    }
};
struct EpiResid {
    static constexpr bool PERM = false;
    float* XS; const float* gate; float scale;
    __device__ __forceinline__ void operator()(const f32x4 (&acc)[2][2][4][2], const pg8::Unit& u, int wr, int wc, int fr, int fq) const {
        const int row0 = u.pm * 256 + wr * 64 + fr, col0 = u.pn * 256 + wc * 32 + 4 * fq;
        const int cond = (u.pm % 17 == 0) ? 2 : (u.pm / 17);
        const float* gp = gate + (size_t)cond * MODW + col0;
        f32x4 gv[2][2];
#pragma unroll
        for (int bj = 0; bj < 2; ++bj)
#pragma unroll
            for (int n = 0; n < 2; ++n) gv[bj][n] = *(const f32x4*)(gp + bj * 128 + n * 16) * scale;
#pragma unroll
        for (int ai = 0; ai < 2; ++ai)
#pragma unroll
            for (int m = 0; m < 4; ++m) { float* rowp = XS + (size_t)(row0 + ai * 128 + m * 16) * DM + col0;
#pragma unroll
                for (int bj = 0; bj < 2; ++bj)
#pragma unroll
                    for (int n = 0; n < 2; ++n) { f32x4* p = (f32x4*)(rowp + bj * 128 + n * 16); *p = *p + gv[bj][n] * acc[ai][bj][m][n]; } }
    }
};
struct EpiHG {
    static constexpr bool PERM = true;
    bf16_t* QVG; float* LOGF; const float* lb;
    __device__ __forceinline__ void operator()(const f32x4 (&acc)[2][2][4][2], const pg8::Unit& u, int wr, int wc, int fr, int fq) const {
        const int row0 = u.pm * 256 + wr * 64 + fr; const int seg = u.pn >> 3; const int col0 = (u.pn & 7) * 256 + wc * 32 + 8 * fq;
        if (seg == 1 || seg == 2) {
            float* base = LOGF + (size_t)(seg - 1) * MROWS * DM;
            f32x4 lbv[2][2];
#pragma unroll
            for (int bj = 0; bj < 2; ++bj)
#pragma unroll
                for (int n = 0; n < 2; ++n) lbv[bj][n] = *(const f32x4*)(lb + col0 + bj * 128 + 4 * n);
#pragma unroll
            for (int ai = 0; ai < 2; ++ai)
#pragma unroll
                for (int m = 0; m < 4; ++m) { float* rowp = base + (size_t)(row0 + ai * 128 + m * 16) * DM + col0;
#pragma unroll
                    for (int bj = 0; bj < 2; ++bj)
#pragma unroll
                        for (int n = 0; n < 2; ++n) { f32x4 v = acc[ai][bj][m][n];
#pragma unroll
                            for (int j = 0; j < 4; ++j) { const float l = lbv[bj][n][j]; v[j] = __logf(l + (1.0f - l) * fsigmoid(v[j])); }
                            *(f32x4*)(rowp + bj * 128 + 4 * n) = v; } }
        } else {
            const int bi = seg - 2 + (seg == 0 ? 2 : 0);
            bf16_t* base = QVG + (size_t)bi * MROWS * DM;
            const bool act = (seg != 3);
#pragma unroll
            for (int ai = 0; ai < 2; ++ai)
#pragma unroll
                for (int m = 0; m < 4; ++m) { bf16_t* rowp = base + (size_t)(row0 + ai * 128 + m * 16) * DM + col0;
#pragma unroll
                    for (int bj = 0; bj < 2; ++bj) { f32x4 v0 = acc[ai][bj][m][0], v1 = acc[ai][bj][m][1];
                        if (act) {
#pragma unroll
                            for (int j = 0; j < 4; ++j) { v0[j] = v0[j] * fsigmoid(v0[j]); v1[j] = v1[j] * fsigmoid(v1[j]); } }
                        u32x4 w; w.x = pk2(v0[0], v0[1]); w.y = pk2(v0[2], v0[3]); w.z = pk2(v1[0], v1[1]); w.w = pk2(v1[2], v1[3]);
                        *(u32x4*)(rowp + bj * 128) = w; } }
        }
    }
};


namespace sg {
struct SGemm { const bf16_t* A; const bf16_t* Bt; int N, K, lda, ldb; };
__device__ __forceinline__ unsigned red_off(int w, int row, int col) { return (unsigned)((((w * 64 + row) * 16) + ((col >> 2) ^ (row & 15))) * 16); }
template <class Epi>
__device__ __forceinline__ void sgemm_phase(LAS unsigned char* lds, int tid, const SGemm& g, int nbig, const Epi& E) {
    const int G = gridDim.x, c = blockIdx.x, nsm = 8 * (g.N >> 6), r = nbig % G;
    int start, stride;
    if (r == 0) { start = (G % 8 == 0) ? (c % 8) * (G / 8) + c / 8 : c; stride = G; }
    else { start = c - r; stride = G - r; if (c < r) start = nsm; }
    const int w = __builtin_amdgcn_readfirstlane(tid >> 6), lane = tid & 63, fr = lane & 15, fq = lane >> 4;
    const int kw = g.K >> 3, nk2 = kw >> 6;
    bf16x8 xa[4][2], xb[4][2], ya[4][2], yb[4][2];
    const int voA = (fr * g.lda + w * kw + 16 * fq) * 2, voB = (fr * g.ldb + w * kw + 16 * fq) * 2;
    const int sAb = 16 * g.lda * 2, sBb = 16 * g.ldb * 2;
    __amdgpu_buffer_rsrc_t rA, rB;
#define SG_PTRS(su) do { const int mt_ = (su) & 7, nt_ = (su) >> 3; \
        rA = __builtin_amdgcn_make_buffer_rsrc((void*)(g.A + ((size_t)(mt_ >> 2) * SROW + (mt_ & 3) * 64) * g.lda), 0, 64 * g.lda * 2, 0x00020000); \
        rB = __builtin_amdgcn_make_buffer_rsrc((void*)(g.Bt + (size_t)nt_ * 64 * g.ldb), 0, 64 * g.ldb * 2, 0x00020000); } while (0)
#define SG_LD1(r, vo, so) __builtin_bit_cast(bf16x8, __builtin_amdgcn_raw_buffer_load_b128(r, vo, so, 0))
#define SG_LOAD(a, b, k2) do { _Pragma("unroll") for (int i = 0; i < 4; ++i) { a[i][0] = SG_LD1(rA, voA, i * sAb + (k2) * 128); a[i][1] = SG_LD1(rA, voA, i * sAb + (k2) * 128 + 16); \
        b[i][0] = SG_LD1(rB, voB, i * sBb + (k2) * 128); b[i][1] = SG_LD1(rB, voB, i * sBb + (k2) * 128 + 16); } } while (0)
#define SG_MMA(a, b) do { _Pragma("unroll") for (int hh = 0; hh < 2; ++hh) _Pragma("unroll") for (int m = 0; m < 4; ++m) _Pragma("unroll") for (int n = 0; n < 4; ++n) \
        acc[m][n] = __builtin_amdgcn_mfma_f32_16x16x32_bf16(b[n][hh], a[m][hh], acc[m][n], 0, 0, 0); } while (0)
#define SG_SB __builtin_amdgcn_sched_barrier(0)
    if (start < nsm) { SG_PTRS(start); SG_LOAD(xa, xb, 0); }
    for (int su = start; su < nsm; su += stride) {
        f32x4 acc[4][4];
#pragma unroll
        for (int m = 0; m < 4; ++m)
#pragma unroll
            for (int n = 0; n < 4; ++n) acc[m][n] = (f32x4){0.f, 0.f, 0.f, 0.f};
        if (nk2 > 1) SG_LOAD(ya, yb, 1);
        SG_SB;
        for (int k2 = 0; k2 < nk2; k2 += 2) {
            SG_MMA(xa, xb); SG_SB; if (k2 + 2 < nk2) SG_LOAD(xa, xb, k2 + 2); SG_SB;
            if (k2 + 1 < nk2) { SG_MMA(ya, yb); SG_SB; if (k2 + 3 < nk2) SG_LOAD(ya, yb, k2 + 3); SG_SB; }
        }
        if (su + stride < nsm) { SG_PTRS(su + stride); SG_LOAD(xa, xb, 0); }
        SG_SB;
        __syncthreads();
#pragma unroll
        for (int m = 0; m < 4; ++m)
#pragma unroll
            for (int n = 0; n < 4; ++n) *(LAS f32x4*)(lds + red_off(w, 16 * m + fr, 16 * n + 4 * fq)) = acc[m][n];
        __syncthreads();
        const int row = tid >> 3, c8 = (tid & 7) * 8;
        f32x4 s0 = {0.f, 0.f, 0.f, 0.f}, s1 = {0.f, 0.f, 0.f, 0.f};
#pragma unroll
        for (int ww = 0; ww < 8; ++ww) { s0 += *(const LAS f32x4*)(lds + red_off(ww, row, c8)); s1 += *(const LAS f32x4*)(lds + red_off(ww, row, c8 + 4)); }
        float v[8] = {s0.x, s0.y, s0.z, s0.w, s1.x, s1.y, s1.z, s1.w};
        const int mt = su & 7, nt = su >> 3;
        E((size_t)(mt >> 2) * SROW + (mt & 3) * 64 + row, nt * 64 + c8, v);
    }
#undef SG_SB
#undef SG_LOAD
#undef SG_MMA
#undef SG_PTRS
#undef SG_LD1
    __syncthreads();
}
}
__device__ __forceinline__ void st_bf16x8(bf16_t* p, const float (&v)[8]) { u32x4 w; w.x = pk2(v[0], v[1]); w.y = pk2(v[2], v[3]); w.z = pk2(v[4], v[5]); w.w = pk2(v[6], v[7]); *(u32x4*)p = w; }
struct SEpiPlain { bf16_t* O; int ldc;
    __device__ __forceinline__ void operator()(size_t R, int col, const float (&v)[8]) const { st_bf16x8(O + R * ldc + col, v); } };
struct SEpiRowScale { bf16_t* O; int ldc; const float* rs;
    __device__ __forceinline__ void operator()(size_t R, int col, const float (&v)[8]) const { const float s = rs[R]; float o[8];
#pragma unroll
        for (int j = 0; j < 8; ++j) o[j] = v[j] * s;
        st_bf16x8(O + R * ldc + col, o); } };
struct SEpiRelu2 { bf16_t* O; int ldc;
    __device__ __forceinline__ void operator()(size_t R, int col, const float (&v)[8]) const { float o[8];
#pragma unroll
        for (int j = 0; j < 8; ++j) { const float a = fmaxf(v[j], 0.f); o[j] = a * a; }
        st_bf16x8(O + R * ldc + col, o); } };
struct SEpiResid { float* XS; const float* gate; float scale;
    __device__ __forceinline__ void operator()(size_t R, int col, const float (&v)[8]) const { const float* gp = gate + (size_t)2 * MODW + col; float* xp = XS + R * DM + col;
        const f32x4 g0 = *(const f32x4*)gp * scale, g1 = *(const f32x4*)(gp + 4) * scale; f32x4 x0 = *(f32x4*)xp, x1 = *(f32x4*)(xp + 4);
        x0 += g0 * (f32x4){v[0], v[1], v[2], v[3]}; x1 += g1 * (f32x4){v[4], v[5], v[6], v[7]}; *(f32x4*)xp = x0; *(f32x4*)(xp + 4) = x1; } };
struct SEpiHG { bf16_t* QVG; float* LOGF; const float* lb;
    __device__ __forceinline__ void operator()(size_t R, int col, const float (&v)[8]) const { const int seg = col >> 11, cs = col & 2047;
        if (seg == 1 || seg == 2) { float* p = LOGF + (size_t)(seg - 1) * MROWS * DM + R * DM + cs; f32x4 o0, o1;
#pragma unroll
            for (int j = 0; j < 4; ++j) { const float l0 = lb[cs + j], l1 = lb[cs + 4 + j]; o0[j] = __logf(l0 + (1.0f - l0) * fsigmoid(v[j])); o1[j] = __logf(l1 + (1.0f - l1) * fsigmoid(v[4 + j])); }
            *(f32x4*)p = o0; *(f32x4*)(p + 4) = o1; }
        else { const int bi = seg - 2 + (seg == 0 ? 2 : 0); float o[8];
#pragma unroll
            for (int j = 0; j < 8; ++j) o[j] = seg == 3 ? v[j] : v[j] * fsigmoid(v[j]);
            st_bf16x8(QVG + (size_t)bi * MROWS * DM + R * DM + cs, o); } } };

namespace att {
using s16x4  = __attribute__((ext_vector_type(4))) short;
using f32x16 = __attribute__((ext_vector_type(16))) float;
constexpr int NW = 8, QBLK = 32, KVBLK = 64;
constexpr float SCALE = ATTN_SCALE;
constexpr float THR = 8.f;
constexpr int SHM_V = KVBLK * 128 * 2, SHM_K = KVBLK * 128 * 2, SHM_KR = KVBLK * 64 * 2;
constexpr int OFF_V = 0, OFF_K = 2 * SHM_V, OFF_KR = OFF_K + 2 * SHM_K, OFF_WS = OFF_KR + 2 * SHM_KR, SHM_ATTN = OFF_WS + NW * 64 * 4;
constexpr int LDQ = QW, LDK = KVW, LDO = DM;
#define KSWZ(row, colB) ((row) * 256 + ((colB) ^ (((row) & 7) << 4)))
#define RSWZ(row, colB) ((row) * 128 + ((colB) ^ ((((row) >> 1) & 7) << 4)))
#define SBAR() __builtin_amdgcn_sched_barrier(0)
__device__ __forceinline__ int crow(int r, int hi) { return (r & 3) + 8 * (r >> 2) + 4 * hi; }
__device__ __forceinline__ unsigned cvtpk(float lo, float hi) { unsigned r; asm volatile("v_cvt_pk_bf16_f32 %0, %1, %2" : "=v"(r) : "v"(lo), "v"(hi)); return r; }
__device__ __forceinline__ bf16x8 ld8(const bf16_t* p) { return *reinterpret_cast<const bf16x8*>(p); }
__device__ __forceinline__ void partialSM(f32x16& p0, f32x16& p1, float& m_reg, float& mn, float& alpha) {
  constexpr float C = SCALE * 1.4426950408889634f;
  float pmax = p0[0];
#pragma unroll
  for (int r = 1; r < 16; ++r) pmax = fmaxf(pmax, p0[r]);
#pragma unroll
  for (int r = 0; r < 16; ++r) pmax = fmaxf(pmax, p1[r]);
  { auto rr = __builtin_amdgcn_permlane32_swap(__float_as_uint(pmax), __float_as_uint(pmax), false, false);
    pmax = fmaxf(__uint_as_float(rr[0]), __uint_as_float(rr[1])); }
  if (__builtin_expect(__all(pmax - m_reg <= THR / SCALE), 1)) { mn = m_reg; alpha = 1.f; }
  else { mn = fmaxf(m_reg, pmax); alpha = __builtin_amdgcn_exp2f((m_reg - mn) * C); m_reg = mn; }
  float mnC = -mn * C;
#pragma unroll
  for (int r = 0; r < 16; ++r) p0[r] = fmaf(p0[r], C, mnC);
#pragma unroll
  for (int r = 0; r < 16; ++r) p1[r] = fmaf(p1[r], C, mnC);
#pragma unroll
  for (int r = 0; r < 16; ++r) p0[r] = __builtin_amdgcn_exp2f(p0[r]);
}
__device__ __forceinline__ void finishSM(f32x16& p0, f32x16& p1, float alpha, float& l_reg, bf16x8& pa0, bf16x8& pa1, bf16x8& pa2, bf16x8& pa3) {
#pragma unroll
  for (int r = 0; r < 16; ++r) p1[r] = __builtin_amdgcn_exp2f(p1[r]);
  float ps = 0;
#pragma unroll
  for (int r = 0; r < 16; ++r) ps += p0[r];
#pragma unroll
  for (int r = 0; r < 16; ++r) ps += p1[r];
  { auto rr = __builtin_amdgcn_permlane32_swap(__float_as_uint(ps), __float_as_uint(ps), false, false);
    ps = __uint_as_float(rr[0]) + __uint_as_float(rr[1]); }
  l_reg = l_reg * alpha + ps;
#define PK4(P, BASE, OUT) do { unsigned a0 = cvtpk(P[BASE + 0], P[BASE + 1]), a1 = cvtpk(P[BASE + 2], P[BASE + 3]);   \
    unsigned b0 = cvtpk(P[BASE + 4], P[BASE + 5]), b1 = cvtpk(P[BASE + 6], P[BASE + 7]);                              \
    auto r0 = __builtin_amdgcn_permlane32_swap(a0, b0, false, false); auto r1 = __builtin_amdgcn_permlane32_swap(a1, b1, false, false); \
    u32x4 w = {r0[0], r1[0], r0[1], r1[1]}; OUT = *reinterpret_cast<bf16x8*>(&w); } while (0)
  PK4(p0, 0, pa0); PK4(p0, 8, pa1); PK4(p1, 0, pa2); PK4(p1, 8, pa3);
#undef PK4
}
__device__ __forceinline__ void qkt(f32x16& p0, f32x16& p1, const char* Ks, const char* Krs, const bf16x8* qr, int r32, int hi) {
  p0 = f32x16{}; p1 = f32x16{};
#pragma unroll
  for (int d0 = 0; d0 < 8; ++d0) { int cb = (d0 * 16 + hi * 8) * 2;
    bf16x8 b0 = *reinterpret_cast<const bf16x8*>(Ks + KSWZ(r32, cb));
    bf16x8 b1 = *reinterpret_cast<const bf16x8*>(Ks + KSWZ(32 + r32, cb));
    p0 = __builtin_amdgcn_mfma_f32_32x32x16_bf16(b0, qr[d0], p0, 0, 0, 0);
    p1 = __builtin_amdgcn_mfma_f32_32x32x16_bf16(b1, qr[d0], p1, 0, 0, 0); }
#pragma unroll
  for (int d0 = 0; d0 < 4; ++d0) { int cb = (d0 * 16 + hi * 8) * 2;
    bf16x8 b0 = *reinterpret_cast<const bf16x8*>(Krs + RSWZ(r32, cb));
    bf16x8 b1 = *reinterpret_cast<const bf16x8*>(Krs + RSWZ(32 + r32, cb));
    p0 = __builtin_amdgcn_mfma_f32_32x32x16_bf16(b0, qr[8 + d0], p0, 0, 0, 0);
    p1 = __builtin_amdgcn_mfma_f32_32x32x16_bf16(b1, qr[8 + d0], p1, 0, 0, 0); }
}
__device__ __forceinline__ int v_st(int k, int c) { const int kk = (k & ~0xC) | ((k & 4) << 1) | ((k & 8) >> 1); return ((kk >> 3) * 4 + (c >> 5)) * 512 + ((kk & 7) * 32 + (c & 31)) * 2; }
__device__ __forceinline__ int v_rd_base(int lane) { return ((lane & 3) << 3) | (((lane >> 2) & 3) << 6) | (((lane >> 4) & 1) << 5) | (((lane >> 5) & 1) << 8); }
constexpr int v_rd_off(int d0, int ks, int half) { return d0 * 512 + ks * 4096 + half * 2048; }
template <int OFF> __device__ __forceinline__ s16x4 tr_read(int vb) {
  s16x4 r; asm volatile("ds_read_b64_tr_b16 %0, %1 offset:%2" : "=&v"(r) : "v"(vb), "i"(OFF) : "memory"); return r;
}
template <int D0> __device__ __forceinline__ void pv_one(f32x16& od, int vb, bf16x8 pa0, bf16x8 pa1, bf16x8 pa2, bf16x8 pa3) {
  const s16x4 l0 = tr_read<v_rd_off(D0, 0, 0)>(vb), h0 = tr_read<v_rd_off(D0, 0, 1)>(vb), l1 = tr_read<v_rd_off(D0, 1, 0)>(vb), h1 = tr_read<v_rd_off(D0, 1, 1)>(vb);
  const s16x4 l2 = tr_read<v_rd_off(D0, 2, 0)>(vb), h2 = tr_read<v_rd_off(D0, 2, 1)>(vb), l3 = tr_read<v_rd_off(D0, 3, 0)>(vb), h3 = tr_read<v_rd_off(D0, 3, 1)>(vb);
  asm volatile("s_waitcnt lgkmcnt(0)" ::: "memory"); SBAR();
#define PK(L, H) (bf16x8){L[0], L[1], L[2], L[3], H[0], H[1], H[2], H[3]}
  od = __builtin_amdgcn_mfma_f32_32x32x16_bf16(pa0, PK(l0, h0), od, 0, 0, 0);
  od = __builtin_amdgcn_mfma_f32_32x32x16_bf16(pa1, PK(l1, h1), od, 0, 0, 0);
  od = __builtin_amdgcn_mfma_f32_32x32x16_bf16(pa2, PK(l2, h2), od, 0, 0, 0);
  od = __builtin_amdgcn_mfma_f32_32x32x16_bf16(pa3, PK(l3, h3), od, 0, 0, 0);
#undef PK
}
__device__ __forceinline__ void pv_d0(f32x16* o, int vb, bf16x8 pa0, bf16x8 pa1, bf16x8 pa2, bf16x8 pa3) {
  pv_one<0>(o[0], vb, pa0, pa1, pa2, pa3); pv_one<1>(o[1], vb, pa0, pa1, pa2, pa3); pv_one<2>(o[2], vb, pa0, pa1, pa2, pa3); pv_one<3>(o[3], vb, pa0, pa1, pa2, pa3);
}
__device__ __forceinline__ void attn_body(const bf16_t* __restrict__ Qb, const bf16_t* __restrict__ Kh, const bf16_t* __restrict__ KRb,
                                          bf16_t* __restrict__ Ob, int seq, int tq0, const float* __restrict__ RC, const float* __restrict__ RS, char* lds, int tid) {
  const bf16_t* Vh = Kh + 128;
  const int wid = tid >> 6, lane = tid & 63, r32 = lane & 31, hi = lane >> 5;
  char* V_lds = lds + OFF_V; char* K_lds = lds + OFF_K; char* KR_lds = lds + OFF_KR;
  float* ws = (float*)(lds + OFF_WS) + wid * 64; float* li_l = ws; float* al_l = ws + 32;
  float m_reg = -1e30f, l_reg = 0; f32x16 o[4] = {}; bf16x8 qr[12];
  const bf16_t* Qw = Qb + (long)(wid * QBLK + r32) * LDQ + hi * 8;
#pragma unroll
  for (int d0 = 0; d0 < 12; ++d0) qr[d0] = ld8(Qw + d0 * 16);
  if (tq0 >= 0) {
    const int t = tq0 + wid * QBLK + r32; const int pr = (t >> 6) * 16 + hi * 8, pc = (t & 63) * 16 + hi * 8;
#pragma unroll
    for (int j = 0; j < 8; ++j) {
      { const float c = RC[pr + j], sn = RS[pr + j]; const float x0 = bf2f((bf16_t)qr[8][j]), x1 = bf2f((bf16_t)qr[9][j]);
        qr[8][j] = (short)f2bf(x0 * c - x1 * sn); qr[9][j] = (short)f2bf(x1 * c + x0 * sn); }
      { const float c = RC[pc + j], sn = RS[pc + j]; const float x0 = bf2f((bf16_t)qr[10][j]), x1 = bf2f((bf16_t)qr[11][j]);
        qr[10][j] = (short)f2bf(x0 * c - x1 * sn); qr[11][j] = (short)f2bf(x1 * c + x0 * sn); }
    }
  }
  const int sr = tid >> 4, sc = (tid & 15) * 8, vst0 = v_st(sr, sc), vst1 = v_st(32 + sr, sc);
  const int rr = tid >> 3, rc = (tid & 7) * 8;
  const int vb0 = (int)(uintptr_t)V_lds + v_rd_base(lane);
  bf16x8 vs0, vs1, ks0, ks1, krs;
#define SLOAD(k0) do { vs0 = ld8(&Vh[(long)((k0) + sr) * LDK + sc]); vs1 = ld8(&Vh[(long)((k0) + 32 + sr) * LDK + sc]); \
    ks0 = ld8(&Kh[(long)((k0) + sr) * LDK + sc]); ks1 = ld8(&Kh[(long)((k0) + 32 + sr) * LDK + sc]); krs = ld8(&KRb[(long)((k0) + rr) * 64 + rc]); } while (0)
#define SWRITE(b) do { *(bf16x8*)(V_lds + (b) * SHM_V + vst0) = vs0; *(bf16x8*)(V_lds + (b) * SHM_V + vst1) = vs1; int kc = sc * 2;   \
    *(bf16x8*)(K_lds + (b) * SHM_K + KSWZ(sr, kc)) = ks0; *(bf16x8*)(K_lds + (b) * SHM_K + KSWZ(32 + sr, kc)) = ks1;                    \
    *(bf16x8*)(KR_lds + (b) * SHM_KR + RSWZ(rr, rc * 2)) = krs; } while (0)
#define SWAIT() asm volatile("s_waitcnt vmcnt(0)" ::: "memory")
#define RESC(a) do { if (__any((a) < 1.f)) { if (hi == 0) al_l[r32] = (a); asm volatile("s_waitcnt lgkmcnt(0)" ::: "memory"); \
    _Pragma("unroll") for (int d = 0; d < 4; ++d) _Pragma("unroll") for (int r = 0; r < 16; ++r) o[d][r] *= al_l[crow(r, hi)]; } } while (0)
  f32x16 p0, p1; float mn, al; bf16x8 pa0, pa1, pa2, pa3; const int NT = seq / KVBLK;
  SLOAD(0); SWAIT(); SWRITE(0); __syncthreads();
  SLOAD(KVBLK);
  for (int j = 0; j < NT; ++j) {
    const int buf = j & 1;
    SBAR(); qkt(p0, p1, K_lds + buf * SHM_K, KR_lds + buf * SHM_KR, qr, r32, hi);
    partialSM(p0, p1, m_reg, mn, al); RESC(al);
    finishSM(p0, p1, al, l_reg, pa0, pa1, pa2, pa3); SBAR();
    if (j + 1 < NT) { SWAIT(); SWRITE(buf ^ 1); }
    if (j + 2 < NT) SLOAD((j + 2) * KVBLK);
    SBAR();
    pv_d0(o, vb0 + buf * SHM_V, pa0, pa1, pa2, pa3);
    __syncthreads();
  }
  if (hi == 0) li_l[r32] = l_reg; asm volatile("s_waitcnt lgkmcnt(0)" ::: "memory");
  float rli[16];
#pragma unroll
  for (int r = 0; r < 16; ++r) rli[r] = __builtin_amdgcn_rcpf(li_l[crow(r, hi)]);
  bf16_t* Ow = Ob + (long)(wid * QBLK) * LDO;
#pragma unroll
  for (int r = 0; r < 16; ++r) { int orow = crow(r, hi);
#pragma unroll
    for (int d0 = 0; d0 < 4; ++d0) Ow[(long)orow * LDO + d0 * 32 + r32] = (bf16_t)f2bf(o[d0][r] * rli[r]); }
#undef SLOAD
#undef SWRITE
#undef SWAIT
#undef RESC
}
}

typedef const float* cfp_t;
typedef const __attribute__((address_space(4))) cfp_t* InPtr;
struct Ctx {
    LAS unsigned char* lds; int tid, lane, wave, gw, ngw, gtid, ngt;
    InPtr in; float* out; unsigned char* ws;
    __device__ __forceinline__ const float* inp(int i) const { return (const float*)(const GAS float*)in[i]; }
};
#define WSP(T, off) ((T*)(C.ws + (off)))

__device__ __forceinline__ void tr_item(const float* W, int K, int N, bf16_t* WT, const float* sck, LAS float* scr, int item, int lane) {
    const int nblk = N / 64, kb = item / nblk, nb = item % nblk, k0 = 64 * kb, n0 = 64 * nb;
    f32x4 v[16];
#pragma unroll
    for (int i = 0; i < 16; ++i) v[i] = *(const f32x4*)(W + (size_t)(k0 + 4 * i + (lane >> 4)) * N + n0 + 4 * (lane & 15));
#pragma unroll
    for (int i = 0; i < 16; ++i) { const int kk = 4 * i + (lane >> 4); f32x4 x = v[i]; if (sck) x *= sck[k0 + kk]; LAS float* d = scr + kk * 65 + 4 * (lane & 15); d[0] = x.x; d[1] = x.y; d[2] = x.z; d[3] = x.w; }
    asm volatile("s_waitcnt lgkmcnt(0)" ::: "memory"); __builtin_amdgcn_wave_barrier();
    const int nl = lane & 7, kc = lane >> 3;
#pragma unroll
    for (int j = 0; j < 8; ++j) { const int n = 8 * j + nl; const LAS float* sp = scr + (8 * kc) * 65 + n;
        u32x4 o; o.x = pk2(sp[0 * 65], sp[1 * 65]); o.y = pk2(sp[2 * 65], sp[3 * 65]); o.z = pk2(sp[4 * 65], sp[5 * 65]); o.w = pk2(sp[6 * 65], sp[7 * 65]);
        *(u32x4*)(WT + (size_t)(n0 + n) * K + k0 + 8 * kc) = o; }
    asm volatile("s_waitcnt lgkmcnt(0)" ::: "memory"); __builtin_amdgcn_wave_barrier();
}
__device__ __forceinline__ void tr_matrix(const Ctx& C, const float* W, int K, int N, bf16_t* WT, const float* sck) {
    LAS float* scr = (LAS float*)(C.lds + C.wave * 16640);
    const int cnt = (K / 64) * (N / 64);
    for (int it = C.gw; it < cnt; it += C.ngw) tr_item(W, K, N, WT, sck, scr, it, C.lane);
}
__device__ __forceinline__ void sincos_d(double x, double& s, double& c) {
    const double twopi = 6.283185307179586476925286766559;
    const double k = __builtin_rint(x / twopi); const double y = x - k * twopi; const double y2 = y * y;
    double ts = y, ss = y, tc = 1.0, sc = 1.0;
#pragma unroll
    for (int n = 1; n <= 16; ++n) { tc *= -y2 / (double)((2 * n - 1) * (2 * n)); sc += tc; ts *= -y2 / (double)((2 * n) * (2 * n + 1)); ss += ts; }
    s = ss; c = sc;
}
__device__ __forceinline__ void phase_prologue(const Ctx& C) {
#pragma unroll 1
    for (int e = 0; e < 2; ++e) {
        tr_matrix(C, C.inp(8) + (size_t)e * DM * ABN, DM, ABN, WSP(bf16_t, WS_WABIN) + (size_t)e * ABNP * DM, nullptr);
        tr_matrix(C, C.inp(9) + (size_t)e * DM * DM, DM, DM, WSP(bf16_t, WS_WABOUT) + (size_t)e * DM * DM, nullptr);
        tr_matrix(C, C.inp(18) + (size_t)e * 512 * QW, 512, QW, WSP(bf16_t, WS_WUQ) + (size_t)e * QW * 512, C.inp(17) + e * 512);
        tr_matrix(C, C.inp(20) + (size_t)e * 512 * KVW, 512, KVW, WSP(bf16_t, WS_WUKV) + (size_t)e * KVW * 512, C.inp(19) + e * 512);
        tr_matrix(C, C.inp(21) + (size_t)e * DM * HGN, DM, HGN, WSP(bf16_t, WS_WHGIN) + (size_t)e * HGN * DM, nullptr);
        tr_matrix(C, C.inp(24) + (size_t)e * DM * DM, DM, DM, WSP(bf16_t, WS_WHGOUT) + (size_t)e * DM * DM, nullptr);
#pragma unroll 1
        for (int dg = 0; dg < 4; ++dg) { const int dir = dg >> 1, gate = dg & 1;
            tr_matrix(C, C.inp(gate ? 14 : 12) + ((size_t)e * 2 + dir) * 8 * 128 * 128, 1024, 128, WSP(bf16_t, WS_WG) + ((size_t)e * 4 + dg) * 128 * 1024, nullptr); }
    }
#pragma unroll 1
    for (int l = 0; l < 4; ++l) {
        tr_matrix(C, C.inp(25) + (size_t)l * DM * DFF, DM, DFF, WSP(bf16_t, WS_W1) + (size_t)l * DFF * DM, nullptr);
        tr_matrix(C, C.inp(26) + (size_t)l * DFF * DM, DFF, DM, WSP(bf16_t, WS_W2) + (size_t)l * DM * DFF, nullptr);
    }
    for (int e = 0; e < 2; ++e) { u32x4* z = (u32x4*)(WSP(bf16_t, WS_WABIN) + (size_t)e * ABNP * DM + (size_t)ABN * DM);
        for (int i = C.gtid; i < (ABNP - ABN) * DM / 8; i += C.ngt) z[i] = (u32x4){0u, 0u, 0u, 0u}; }
    { float* XS = WSP(float, WS_XS);
      for (int i = C.gtid; i < MROWS * (DM / 4); i += C.ngt) { const int R = i / (DM / 4), c4 = i % (DM / 4); const int b = R / SROW, s = R % SROW;
          const float* src = s < CTX ? C.inp(2) + ((size_t)(b * CTX + s)) * DM : C.inp(0) + ((size_t)(b * SEQ + (s - CTX))) * DM;
          ((f32x4*)(XS + (size_t)R * DM))[c4] = ((const f32x4*)src)[c4]; } }
    { float* LB = WSP(float, WS_LB);
      for (int i = C.gtid; i < 2048; i += C.ngt) { float v[4], mx = -1e30f; for (int l = 0; l < 4; ++l) { v[l] = C.inp(22)[l * 2048 + i]; mx = fmaxf(mx, v[l]); }
          float sum = 0.f; for (int l = 0; l < 4; ++l) { v[l] = expf(v[l] - mx); sum += v[l]; }
          float cum = 0.f; const float p0 = v[0] / sum; for (int l = 0; l < 4; ++l) { cum += v[l] / sum; LB[l * 2048 + i] = cum - p0; } }
      float* RC = WSP(float, WS_ROPE); float* RS = RC + 1024;
      for (int i = C.gtid; i < 1024; i += C.ngt) { const int pos = i / 16, j = i % 16; double inv = 1.0; for (int q = 0; q < j; ++q) inv *= 0.56234132519034908;
          const float ang = (float)pos * (float)inv; double s, c; sincos_d((double)ang, s, c); RC[i] = (float)c; RS[i] = (float)s; } }
    { LAS float* sl = (LAS float*)C.lds;
      LAS float* red = sl + 3 * 2048;
      __syncthreads();
      for (int i = C.tid; i < 3 * 2048; i += 512) { const int r = i / 2048, d = i % 2048; const float v = r < 2 ? C.inp(1)[r * 2048 + d] : C.inp(3)[d]; sl[i] = siluf_(v); }
      __syncthreads();
      float* MOD = WSP(float, WS_MOD);
      const int kq = C.tid >> 4, cq = C.tid & 15;
      for (int u = blockIdx.x; u < 4 * (MODW / 64); u += gridDim.x) { const int l = u / (MODW / 64), e0 = (u % (MODW / 64)) * 64;
          const float* w = C.inp(4) + (size_t)l * DM * MODW + e0 + 4 * cq;
          f32x4 a0 = {0, 0, 0, 0}, a1 = {0, 0, 0, 0}, a2 = {0, 0, 0, 0};
#pragma unroll 8
          for (int d = kq; d < DM; d += 32) { const f32x4 wv = *(const f32x4*)(w + (size_t)d * MODW); a0 += wv * sl[d]; a1 += wv * sl[2048 + d]; a2 += wv * sl[4096 + d]; }
#pragma unroll
          for (int j = 0; j < 4; ++j) { red[(kq * 3 + 0) * 64 + 4 * cq + j] = a0[j]; red[(kq * 3 + 1) * 64 + 4 * cq + j] = a1[j]; red[(kq * 3 + 2) * 64 + 4 * cq + j] = a2[j]; }
          __syncthreads();
          if (C.tid < 192) { const int r = C.tid / 64, c = C.tid % 64; float s = 0.f; for (int q = 0; q < 32; ++q) s += red[(q * 3 + r) * 64 + c];
              MOD[((size_t)l * 3 + r) * MODW + e0 + c] = s + C.inp(5)[l * MODW + e0 + c]; }
          __syncthreads(); } }
}

__device__ __forceinline__ void phase_norm_mod(const Ctx& C, const float* w, const float* mod, int sh_idx, int sc_idx) {
    const float* XS = WSP(float, WS_XS); bf16_t* H = WSP(bf16_t, WS_H);
    for (int R = C.gw; R < MROWS; R += C.ngw) {
        const int s = R % SROW, b = R / SROW, cond = s < CTX ? 2 : b;
        const float* shift = mod + (size_t)cond * MODW + sh_idx * DM; const float* scale = mod + (size_t)cond * MODW + sc_idx * DM;
        const f32x4* xr = (const f32x4*)(XS + (size_t)R * DM) + C.lane;
        f32x4 v[8]; float ss = 0.f;
#pragma unroll
        for (int j = 0; j < 8; ++j) { v[j] = xr[64 * j]; ss += (v[j].x * v[j].x + v[j].y * v[j].y) + (v[j].z * v[j].z + v[j].w * v[j].w); }
        const float rstd = 1.0f / sqrtf(wave_sum(ss) * (1.0f / DM) + EPS);
        u32x2* o = (u32x2*)(H + (size_t)R * DM) + C.lane;
#pragma unroll
        for (int j = 0; j < 8; ++j) { const int c = (C.lane + 64 * j) * 4; const f32x4 wv = *(const f32x4*)(w + c), sc = *(const f32x4*)(scale + c), sh = *(const f32x4*)(shift + c);
            const f32x4 y = (v[j] * rstd * wv) * (1.0f + sc) + sh; u32x2 pk; pk.x = pk2(y.x, y.y); pk.y = pk2(y.z, y.w); o[64 * j] = pk; }
    }
}

__device__ __forceinline__ void phase_rs_kr(const Ctx& C) {
    const bf16_t* P = WSP(bf16_t, WS_P);
    float* RSQ = WSP(float, WS_RSQ); float* RSKV = WSP(float, WS_RSKV);
    for (int R = C.gw; R < MROWS; R += C.ngw) {
        const u32x4 a = *(const u32x4*)(P + (size_t)R * ABNP + 2048 + 8 * C.lane), b = *(const u32x4*)(P + (size_t)R * ABNP + 2560 + 8 * C.lane);
        float sa = 0.f, sb = 0.f;
#pragma unroll
        for (int j = 0; j < 4; ++j) { const float a0 = __uint_as_float(a[j] << 16), a1 = __uint_as_float(a[j] & 0xffff0000u), b0 = __uint_as_float(b[j] << 16), b1 = __uint_as_float(b[j] & 0xffff0000u);
            sa += a0 * a0 + a1 * a1; sb += b0 * b0 + b1 * b1; }
        sa = wave_sum(sa); sb = wave_sum(sb);
        if (C.lane == 0) { RSQ[R] = 1.0f / sqrtf(sa * (1.0f / 512.0f) + EPS); RSKV[R] = 1.0f / sqrtf(sb * (1.0f / 512.0f) + EPS); } }
    bf16_t* KR = WSP(bf16_t, WS_KR); const float* RC = WSP(float, WS_ROPE); const float* RS = RC + 1024;
    for (int idx = C.gtid; idx < MROWS * 32; idx += C.ngt) { const int R = idx / 32, p = idx % 32, s = R % SROW; const int i0 = p < 16 ? p : 32 + (p - 16);
        const float x0 = bf2f(P[(size_t)R * ABNP + 3072 + i0]), x1 = bf2f(P[(size_t)R * ABNP + 3072 + i0 + 16]); float o0 = x0, o1 = x1;
        if (s >= CTX) { const int t = s - CTX, pos = p < 16 ? t / 64 : t % 64; const float c = RC[pos * 16 + (p & 15)], sn = RS[pos * 16 + (p & 15)]; o0 = x0 * c - x1 * sn; o1 = x1 * c + x0 * sn; }
        KR[(size_t)R * 64 + i0] = (bf16_t)f2bf(o0); KR[(size_t)R * 64 + i0 + 16] = (bf16_t)f2bf(o1); }
}

__device__ __forceinline__ void phase_attn(const Ctx& C) {
    const bf16_t* Q = WSP(bf16_t, WS_Q); const bf16_t* KV = WSP(bf16_t, WS_KV); const bf16_t* KR = WSP(bf16_t, WS_KR); bf16_t* Y = WSP(bf16_t, WS_Y);
    const float* RC = WSP(float, WS_ROPE); const float* RS = RC + 1024;
    const int G = gridDim.x, c = blockIdx.x;
    for (int u0 = c; u0 < 272; u0 += G) {
        int b, hh, s0, nk, tq0;
        if (u0 < 256) { int v = u0; if (G == 256) { const int x = c & 7, j = c >> 3; v = (x * 2 + (j >> 4)) * 16 + (j & 15); }
            const int p = v >> 4, qb = v & 15; b = p >> 3; hh = p & 7; s0 = CTX + qb * 256; nk = SROW; tq0 = qb * 256; }
        else { const int p = u0 - 256; b = p >> 3; hh = p & 7; s0 = 0; nk = CTX; tq0 = -1; }
        const size_t R0 = (size_t)b * SROW + s0, K0 = (size_t)b * SROW;
        __syncthreads();
        att::attn_body(Q + R0 * QW + hh * 192, KV + K0 * KVW + hh * 256, KR + K0 * 64, Y + R0 * DM + DLRU + hh * 128, nk, tq0, RC, RS, (char*)C.lds, C.tid);
    }
}
namespace hg {
using s16x4  = __attribute__((ext_vector_type(4))) short;
using f32x16 = __attribute__((ext_vector_type(16))) float;
constexpr int NCH = SROW / 64;
constexpr int NCHAIN = NBATCH * 16 * 2;
__device__ __forceinline__ unsigned off_b(unsigned row, unsigned ch) { return 256u * row + 16u * (ch ^ (((row & 3u) << 2) | ((row >> 2) & 3u))); }
__device__ __forceinline__ s16x4 trr(unsigned addr) { s16x4 r; asm volatile("ds_read_b64_tr_b16 %0, %1" : "=&v"(r) : "v"(addr) : "memory"); return r; }
__device__ __forceinline__ bf16x8 pk8(s16x4 L, s16x4 H) { return (bf16x8){L[0], L[1], L[2], L[3], H[0], H[1], H[2], H[3]}; }
__device__ __forceinline__ unsigned tr_nat(unsigned lane, unsigned c, unsigned ks, unsigned t) {
    const unsigned h = lane >> 5, blk = (lane >> 4) & 1, q = (lane & 15) >> 2, p = lane & 3;
    return off_b(16 * ks + 8 * h + 4 * t + q, 4 * c + 2 * blk + (p >> 1)) + 8 * (p & 1); }
__device__ __forceinline__ unsigned tr_perm(unsigned lane, unsigned c, unsigned rb, unsigned t) {
    const unsigned h = lane >> 5, blk = (lane >> 4) & 1, q = (lane & 15) >> 2, p = lane & 3;
    return off_b(rb + 4 * h + 8 * t + q, 4 * c + 2 * blk + (p >> 1)) + 8 * (p & 1); }
__device__ __forceinline__ unsigned row_rd(unsigned lane, unsigned rb, unsigned ks) { return off_b(rb + (lane & 31), 2 * ks + (lane >> 5)); }
__device__ __forceinline__ int crow(int r, int hi) { return (r & 3) + 8 * (r >> 2) + 4 * hi; }
#define HG_WAITL() do { asm volatile("s_waitcnt lgkmcnt(0)" ::: "memory"); __builtin_amdgcn_sched_barrier(0); } while (0)
}

__device__ __forceinline__ void phase_hg_ds(const Ctx& C) {
    using namespace hg;
    LAS unsigned char* L = C.lds; const unsigned Lb = (unsigned)(uintptr_t)L;
    constexpr unsigned VT = 0, KP = 16384, TOT = 32768;
    const float* LOGF = WSP(float, WS_LOGF); const bf16_t* VH = WSP(bf16_t, WS_VH); float* DS = WSP(float, WS_DS); float* DEC = WSP(float, WS_DEC);
    const int w = C.wave, lane = C.lane, tid = C.tid, h5 = lane >> 5, r32 = lane & 31;
    for (int u = blockIdx.x; u < NBATCH * 16 * NCH; u += gridDim.x) {
        const int b = u / (16 * NCH), hh = (u / NCH) % 16, ci = u % NCH; const size_t R0 = (size_t)b * SROW + ci * 64;
        __syncthreads();
#pragma unroll
        for (int p = 0; p < 2; ++p) { const int row = (tid >> 4) + 32 * p, ch = tid & 15; const u32x4 v = *(const u32x4*)(VH + (R0 + row) * DM + hh * 128 + ch * 8); *(LAS u32x4*)(L + VT + off_b(row, ch)) = v; }
#pragma unroll 1
        for (int dir = 0; dir < 2; ++dir) {
            const int chain = (b * 16 + hh) * 2 + dir;
            const float* lfp = LOGF + (size_t)dir * MROWS * DM + (R0 + 8 * w) * DM + hh * 128 + 2 * lane;
            f32x2 lf[8]; f32x2 T = {0.f, 0.f};
#pragma unroll
            for (int i = 0; i < 8; ++i) { lf[i] = *(const f32x2*)(lfp + (size_t)i * DM); T += lf[i]; }
            *(LAS f32x2*)(L + TOT + (w * 128 + 2 * lane) * 4) = T;
            __syncthreads();
            f32x2 off = {0.f, 0.f}, total = {0.f, 0.f};
#pragma unroll
            for (int ww = 0; ww < 8; ++ww) { const f32x2 t = *(const LAS f32x2*)(L + TOT + (ww * 128 + 2 * lane) * 4); total += t; if (dir == 0 ? (ww > w) : (ww < w)) off += t; }
            f32x2 E[8];
            if (dir == 0) { E[7] = off;
#pragma unroll
                for (int i = 6; i >= 0; --i) E[i] = E[i + 1] + lf[i + 1]; }
            else { E[0] = off;
#pragma unroll
                for (int i = 1; i < 8; ++i) E[i] = E[i - 1] + lf[i - 1]; }
#pragma unroll
            for (int i = 0; i < 8; ++i) { const float k0 = (1.0f - __expf(lf[i].x)) * __expf(E[i].x), k1 = (1.0f - __expf(lf[i].y)) * __expf(E[i].y);
                *(LAS unsigned*)(L + KP + off_b(8 * w + i, lane >> 2) + (lane & 3) * 4) = pk2(k0, k1); }
            if (w == 0) { f32x2 d; d.x = __expf(total.x); d.y = __expf(total.y); *(f32x2*)(DEC + ((size_t)chain * NCH + ci) * 128 + 2 * lane) = d; }
            __syncthreads();
            const unsigned dkt = w >> 1, c0 = (w & 1) * 2;
            s16x4 al[4], ah[4], b0l[4], b0h[4], b1l[4], b1h[4];
#pragma unroll
            for (int ks = 0; ks < 4; ++ks) { al[ks] = trr(Lb + KP + tr_nat(lane, dkt, ks, 0)); ah[ks] = trr(Lb + KP + tr_nat(lane, dkt, ks, 1));
                b0l[ks] = trr(Lb + VT + tr_nat(lane, c0, ks, 0)); b0h[ks] = trr(Lb + VT + tr_nat(lane, c0, ks, 1));
                b1l[ks] = trr(Lb + VT + tr_nat(lane, c0 + 1, ks, 0)); b1h[ks] = trr(Lb + VT + tr_nat(lane, c0 + 1, ks, 1)); }
            HG_WAITL();
            f32x16 a0 = {}, a1 = {};
#pragma unroll
            for (int ks = 0; ks < 4; ++ks) { const bf16x8 A = pk8(al[ks], ah[ks]);
                a0 = __builtin_amdgcn_mfma_f32_32x32x16_bf16(A, pk8(b0l[ks], b0h[ks]), a0, 0, 0, 0);
                a1 = __builtin_amdgcn_mfma_f32_32x32x16_bf16(A, pk8(b1l[ks], b1h[ks]), a1, 0, 0, 0); }
            float* dsp = DS + ((size_t)chain * NCH + ci) * 16384;
#pragma unroll
            for (int r = 0; r < 16; ++r) { const int dk = 32 * dkt + crow(r, h5); dsp[dk * 128 + 32 * c0 + r32] = a0[r]; dsp[dk * 128 + 32 * (c0 + 1) + r32] = a1[r]; }
        }
    }
}
__device__ __forceinline__ void phase_hg_scan(const Ctx& C) {
    using namespace hg;
    const float* DS = WSP(float, WS_DS); const float* DEC = WSP(float, WS_DEC); bf16_t* SS = WSP(bf16_t, WS_SS);
    for (int g = C.gtid; g < NCHAIN * 2048; g += C.ngt) { const int chain = g >> 11, within = g & 2047, dk = within >> 4, dv0 = (within & 15) * 8, dir = chain & 1;
        f32x4 s0 = {0.f, 0.f, 0.f, 0.f}, s1 = {0.f, 0.f, 0.f, 0.f};
#pragma unroll 4
        for (int j = 0; j < NCH; ++j) { const int ci = dir == 0 ? j : (j < 4 ? 3 - j : 71 - j); const size_t cb = (size_t)chain * NCH + ci; const size_t idx = (cb * 128 + dk) * 128 + dv0;
            u32x4 o; o.x = pk2(s0.x, s0.y); o.y = pk2(s0.z, s0.w); o.z = pk2(s1.x, s1.y); o.w = pk2(s1.z, s1.w); *(u32x4*)(SS + idx) = o;
            const float d = DEC[cb * 128 + dk]; const f32x4 d0 = *(const f32x4*)(DS + idx), d1 = *(const f32x4*)(DS + idx + 4);
            s0 = s0 * d + d0; s1 = s1 * d + d1; } }
}
__device__ __forceinline__ void phase_hg_out(const Ctx& C, int o_idx) {
    using namespace hg;
    LAS unsigned char* L = C.lds; const unsigned Lb = (unsigned)(uintptr_t)L;
    constexpr unsigned VT = 0, QP = 16384, QM = 32768, KM = 49152, ST = 65536, TOT = 98304, RED = 102400;
    const float* LOGF = WSP(float, WS_LOGF); const bf16_t* VH = WSP(bf16_t, WS_VH); const bf16_t* QH = WSP(bf16_t, WS_QH); const bf16_t* GH = WSP(bf16_t, WS_GH);
    const bf16_t* SS = WSP(bf16_t, WS_SS); bf16_t* Y = WSP(bf16_t, WS_Y); const float* nw = C.inp(23) + o_idx * 128;
    const int w = C.wave, lane = C.lane, tid = C.tid, h5 = lane >> 5, r32 = lane & 31;
    const unsigned tt = w >> 2, dvt = w & 3;
    for (int u = blockIdx.x; u < NBATCH * 16 * NCH; u += gridDim.x) {
        const int b = u / (16 * NCH), hh = (u / NCH) % 16, ci = u % NCH; const size_t R0 = (size_t)b * SROW + ci * 64;
        __syncthreads();
#pragma unroll
        for (int p = 0; p < 2; ++p) { const int row = (tid >> 4) + 32 * p, ch = tid & 15; const u32x4 v = *(const u32x4*)(VH + (R0 + row) * DM + hh * 128 + ch * 8); *(LAS u32x4*)(L + VT + off_b(row, ch)) = v; }
        f32x16 acc = {};
#pragma unroll 1
        for (int dir = 0; dir < 2; ++dir) {
            const int chain = (b * 16 + hh) * 2 + dir;
            u32x4 sreg[4];
#pragma unroll
            for (int p = 0; p < 4; ++p) sreg[p] = *(const u32x4*)(SS + (((size_t)chain * NCH + ci) * 128 + (tid >> 4) + 32 * p) * 128 + (tid & 15) * 8);
            const float* lfp = LOGF + (size_t)dir * MROWS * DM + (R0 + 8 * w) * DM + hh * 128 + 2 * lane;
            const bf16_t* qp = QH + (R0 + 8 * w) * DM + hh * 128 + 2 * lane;
            f32x2 lf[8]; unsigned qv[8]; f32x2 T = {0.f, 0.f};
#pragma unroll
            for (int i = 0; i < 8; ++i) { lf[i] = *(const f32x2*)(lfp + (size_t)i * DM); qv[i] = *(const unsigned*)(qp + (size_t)i * DM); T += lf[i]; }
            *(LAS f32x2*)(L + TOT + (w * 128 + 2 * lane) * 4) = T;
            __syncthreads();
            f32x2 off = {0.f, 0.f}, mid = {0.f, 0.f};
#pragma unroll
            for (int ww = 0; ww < 8; ++ww) { const f32x2 t = *(const LAS f32x2*)(L + TOT + (ww * 128 + 2 * lane) * 4);
                if (dir == 0 ? (ww < w) : (ww > w)) off += t; if (dir == 0 ? (ww < 4) : (ww >= 4)) mid += t; }
            f32x2 B[8];
            if (dir == 0) { B[0] = off + lf[0];
#pragma unroll
                for (int i = 1; i < 8; ++i) B[i] = B[i - 1] + lf[i]; }
            else { B[7] = off + lf[7];
#pragma unroll
                for (int i = 6; i >= 0; --i) B[i] = B[i + 1] + lf[i]; }
#pragma unroll
            for (int i = 0; i < 8; ++i) { const float q0 = __uint_as_float(qv[i] << 16), q1 = __uint_as_float(qv[i] & 0xffff0000u);
                const float k0 = 1.0f - __expf(lf[i].x), k1 = 1.0f - __expf(lf[i].y);
                const unsigned a = off_b(8 * w + i, lane >> 2) + (lane & 3) * 4;
                *(LAS unsigned*)(L + QP + a) = pk2(q0 * __expf(B[i].x), q1 * __expf(B[i].y));
                *(LAS unsigned*)(L + QM + a) = pk2(q0 * __expf(B[i].x - mid.x), q1 * __expf(B[i].y - mid.y));
                *(LAS unsigned*)(L + KM + a) = pk2(k0 * __expf(mid.x - B[i].x), k1 * __expf(mid.y - B[i].y)); }
#pragma unroll
            for (int p = 0; p < 4; ++p) *(LAS u32x4*)(L + ST + off_b((tid >> 4) + 32 * p, tid & 15)) = sreg[p];
            __syncthreads();
            { bf16x8 a[8]; s16x4 bl[8], bh[8];
#pragma unroll
              for (int ks = 0; ks < 8; ++ks) { a[ks] = *(const LAS bf16x8*)(L + QP + row_rd(lane, 32 * tt, ks)); bl[ks] = trr(Lb + ST + tr_nat(lane, dvt, ks, 0)); bh[ks] = trr(Lb + ST + tr_nat(lane, dvt, ks, 1)); }
              HG_WAITL();
#pragma unroll
              for (int ks = 0; ks < 8; ++ks) acc = __builtin_amdgcn_mfma_f32_32x32x16_bf16(a[ks], pk8(bl[ks], bh[ks]), acc, 0, 0, 0); }
            { bf16x8 qb[8];
#pragma unroll
              for (int ks = 0; ks < 8; ++ks) qb[ks] = *(const LAS bf16x8*)(L + QM + row_rd(lane, 32 * tt, ks));
#pragma unroll
              for (unsigned st = 0; st < 2; ++st) { const bool valid = dir == 0 ? (st <= tt) : (st >= tt);
                if (valid) {
                  f32x16 x = {};
#pragma unroll
                  for (int ks = 0; ks < 8; ++ks) { const bf16x8 ka = *(const LAS bf16x8*)(L + KM + row_rd(lane, 32 * st, ks)); x = __builtin_amdgcn_mfma_f32_32x32x16_bf16(ka, qb[ks], x, 0, 0, 0); }
                  if (st == tt) {
#pragma unroll
                    for (int r = 0; r < 16; ++r) { const int kr = crow(r, h5); const bool keep = dir == 0 ? (kr <= r32) : (kr >= r32); x[r] = keep ? x[r] : 0.f; } }
                  const s16x4 v0l = trr(Lb + VT + tr_perm(lane, dvt, 32 * st, 0)), v0h = trr(Lb + VT + tr_perm(lane, dvt, 32 * st, 1));
                  const s16x4 v1l = trr(Lb + VT + tr_perm(lane, dvt, 32 * st + 16, 0)), v1h = trr(Lb + VT + tr_perm(lane, dvt, 32 * st + 16, 1));
                  u32x4 A0, A1; A0.x = pk2(x[0], x[1]); A0.y = pk2(x[2], x[3]); A0.z = pk2(x[4], x[5]); A0.w = pk2(x[6], x[7]);
                  A1.x = pk2(x[8], x[9]); A1.y = pk2(x[10], x[11]); A1.z = pk2(x[12], x[13]); A1.w = pk2(x[14], x[15]);
                  HG_WAITL();
                  acc = __builtin_amdgcn_mfma_f32_32x32x16_bf16(*reinterpret_cast<bf16x8*>(&A0), pk8(v0l, v0h), acc, 0, 0, 0);
                  acc = __builtin_amdgcn_mfma_f32_32x32x16_bf16(*reinterpret_cast<bf16x8*>(&A1), pk8(v1l, v1h), acc, 0, 0, 0);
                } } }
        }
        LAS float* red = (LAS float*)(L + RED);
#pragma unroll
        for (int r = 0; r < 16; ++r) { float s = acc[r] * acc[r]; s += __shfl_xor(s, 1); s += __shfl_xor(s, 2); s += __shfl_xor(s, 4); s += __shfl_xor(s, 8); s += __shfl_xor(s, 16);
            if (r32 == 0) red[(tt * 32 + crow(r, h5)) * 4 + dvt] = s; }
        __syncthreads();
        const int col = hh * 128 + 32 * dvt + r32; const float wv = nw[32 * dvt + r32];
#pragma unroll
        for (int r = 0; r < 16; ++r) { const int row = 32 * tt + crow(r, h5); const f32x4 p = *(const LAS f32x4*)(red + row * 4);
            const float rstd = 1.0f / sqrtf(((p.x + p.y) + (p.z + p.w)) * (1.0f / 128.0f) + EPS); const size_t o = (R0 + row) * DM + col;
            Y[o] = (bf16_t)f2bf(acc[r] * rstd * wv * bf2f(GH[o])); }
    }
}
template <bool FINAL>
__device__ __forceinline__ void phase_lru(const Ctx& C, int e) {
    using namespace hg;
    LAS unsigned char* L = C.lds;
    constexpr unsigned UCB = 0, UCF = 16384, AT = 49152, BT = 81920;
    const bf16_t* P = WSP(bf16_t, WS_P); float* AG = WSP(float, WS_AG); const float* CARRY = WSP(float, WS_CARRY); bf16_t* Y = WSP(bf16_t, WS_Y);
    const bf16_t* WG = WSP(bf16_t, WS_WG) + (size_t)e * 4 * 128 * 1024;
    const float* cw = C.inp(10) + (size_t)e * 4 * DLRU; const float* cb = C.inp(11) + (size_t)e * DLRU;
    const float* ba = C.inp(13) + (size_t)e * 2 * DLRU; const float* bx = C.inp(15) + (size_t)e * 2 * DLRU; const float* lam = C.inp(16) + (size_t)e * 2 * DLRU;
    const int w = C.wave, lane = C.lane, tid = C.tid, h5 = lane >> 5, r32 = lane & 31;
    const unsigned rt = w >> 2, et = w & 3;
    for (int u = gridDim.x - 1 - blockIdx.x; u < (MROWS / 64) * 8; u += gridDim.x) {
        const int ci2 = u >> 3, hd = u & 7; const int c = ci2 % NCH, bb = ci2 / NCH; const size_t R0 = (size_t)ci2 * 64;
        const int s0 = c * 64, lo = c < 4 ? 0 : CTX, hi = c < 4 ? CTX : SROW;
        __syncthreads();
        float cin = 0.f;
        if (FINAL && tid < 256) { const int dir = tid >> 7, ch = tid & 127; cin = CARRY[(size_t)(ci2 * 2 + dir) * DLRU + hd * 128 + ch]; }
        { const int chn = hd * 128 + 2 * lane; const bf16_t* up = P + DLRU + chn;
          f32x2 uv[11];
#pragma unroll
          for (int i = 0; i < 11; ++i) { const int s = s0 + 8 * w + i - 2; unsigned raw = 0u; if (s >= lo && s < hi) raw = *(const unsigned*)(up + ((size_t)bb * SROW + s) * ABNP);
              uv[i].x = __uint_as_float(raw << 16); uv[i].y = __uint_as_float(raw & 0xffff0000u); }
          f32x2 wj[4];
#pragma unroll
          for (int j = 0; j < 4; ++j) wj[j] = *(const f32x2*)(cw + j * DLRU + chn);
          const f32x2 bias = *(const f32x2*)(cb + chn);
#pragma unroll
          for (int i = 0; i < 8; ++i) { f32x2 a = bias;
#pragma unroll
              for (int j = 0; j < 4; ++j) a += uv[i + j] * wj[j];
              *(LAS unsigned*)(L + UCB + off_b(8 * w + i, lane >> 2) + (lane & 3) * 4) = pk2(a.x, a.y);
              *(LAS f32x2*)(L + UCF + ((8 * w + i) * 128 + 2 * lane) * 4) = a; } }
        __syncthreads();
        bf16x8 af[8]; float ucr[16];
#pragma unroll
        for (int ks = 0; ks < 8; ++ks) af[ks] = *(const LAS bf16x8*)(L + UCB + row_rd(lane, 32 * rt, ks));
#pragma unroll
        for (int r = 0; r < 16; ++r) ucr[r] = *(const LAS float*)(L + UCF + ((32 * rt + crow(r, h5)) * 128 + 32 * et + r32) * 4);
        const int chl = hd * 128 + 32 * et + r32;
#pragma unroll 1
        for (int dir = 0; dir < 2; ++dir) {
            f32x16 ga = {}, gx = {};
            { const bf16_t* wa = WG + ((size_t)(dir * 2 + 0) * 128 + 32 * et + r32) * 1024 + hd * 128 + 8 * h5; const bf16_t* wx = wa + (size_t)128 * 1024;
              bf16x8 fa[8], fx[8];
#pragma unroll
              for (int ks = 0; ks < 8; ++ks) { fa[ks] = *(const bf16x8*)(wa + 16 * ks); fx[ks] = *(const bf16x8*)(wx + 16 * ks); }
#pragma unroll
              for (int ks = 0; ks < 8; ++ks) { ga = __builtin_amdgcn_mfma_f32_32x32x16_bf16(af[ks], fa[ks], ga, 0, 0, 0); gx = __builtin_amdgcn_mfma_f32_32x32x16_bf16(af[ks], fx[ks], gx, 0, 0, 0); } }
            const float bav = ba[dir * DLRU + chl], bxv = bx[dir * DLRU + chl], sp = log1pf(__expf(-lam[dir * DLRU + chl]));
            if (dir == 1) __syncthreads();
#pragma unroll
            for (int r = 0; r < 16; ++r) { const float rg = __builtin_amdgcn_rcpf(1.0f + __expf(-(ga[r] + bav))), ig = __builtin_amdgcn_rcpf(1.0f + __expf(-(gx[r] + bxv)));
                const float la = -8.0f * rg * sp; const unsigned o = ((32 * rt + crow(r, h5)) * 128 + 32 * et + r32) * 4;
                *(LAS float*)(L + AT + o) = __expf(la); *(LAS float*)(L + BT + o) = __builtin_amdgcn_sqrtf(1.0f - __expf(2.0f * la)) * (ig * ucr[r]); }
            __syncthreads();
            if ((tid >> 7) == dir) { const int ch = tid & 127; const LAS float* ap = (const LAS float*)(L + AT) + ch; const LAS float* bp = (const LAS float*)(L + BT) + ch;
                if (!FINAL) { float h = 0.f, ap_ = 1.f;
#pragma unroll 16
                    for (int i = 0; i < 64; ++i) { const int row = dir == 0 ? i : 63 - i; const float a = ap[row * 128]; h = a * h + bp[row * 128]; ap_ *= a; }
                    float* ag = AG + ((size_t)(ci2 * 2 + dir) * 2) * DLRU + hd * 128 + ch; ag[0] = ap_; ag[DLRU] = h; }
                else if (dir == 0) { float h = cin; LAS float* hp = (LAS float*)(L + UCF) + ch;
#pragma unroll 16
                    for (int i = 0; i < 64; ++i) { h = ap[i * 128] * h + bp[i * 128]; hp[i * 128] = h; } }
                else { float h = cin; const LAS float* hp = (const LAS float*)(L + UCF) + ch; const bf16_t* gp = P + R0 * ABNP + hd * 128 + ch; bf16_t* yp = Y + R0 * DM + hd * 128 + ch;
#pragma unroll 8
                    for (int i = 63; i >= 0; --i) { h = ap[i * 128] * h + bp[i * 128]; const float hs = hp[i * 128] + h; yp[(size_t)i * DM] = (bf16_t)f2bf(hs * gelu_tanh(bf2f(gp[(size_t)i * ABNP]))); } } }
        }
    }
}
__device__ __forceinline__ void phase_lru_carry(const Ctx& C) {
    using namespace hg;
    const float* AG = WSP(float, WS_AG); float* CARRY = WSP(float, WS_CARRY);
    const int G = gridDim.x, first = G >= 8 ? G - 8 : 0;
    if ((int)blockIdx.x < first) return;
    for (int id = ((int)blockIdx.x - first) * 512 + C.tid; id < NBATCH * 2 * DLRU; id += (G - first) * 512) { const int b = id >> 11, dir = (id >> 10) & 1, ch = id & 1023;
        float carry = 0.f;
#pragma unroll 4
        for (int j = 0; j < NCH; ++j) { const int cc = dir == 0 ? j : (j < 4 ? 3 - j : 71 - j); const size_t ci2 = (size_t)b * NCH + cc;
            CARRY[(ci2 * 2 + dir) * DLRU + ch] = carry; const float* ag = AG + ((ci2 * 2 + dir) * 2) * DLRU + ch; carry = carry * ag[0] + ag[DLRU]; } }
}
__device__ __forceinline__ void phase_final(const Ctx& C) {
    const float* XS = WSP(float, WS_XS); const float* w = C.inp(27);
    for (int r = C.gw; r < NBATCH * SEQ; r += C.ngw) { const int b = r / SEQ, t = r % SEQ; const size_t R = (size_t)b * SROW + CTX + t;
        const f32x4* xr = (const f32x4*)(XS + R * DM) + C.lane; f32x4 v[8]; float ss = 0.f;
#pragma unroll
        for (int j = 0; j < 8; ++j) { v[j] = xr[64 * j]; ss += (v[j].x * v[j].x + v[j].y * v[j].y) + (v[j].z * v[j].z + v[j].w * v[j].w); }
        const float rstd = 1.0f / sqrtf(wave_sum(ss) * (1.0f / DM) + EPS);
        f32x4* o = (f32x4*)(C.out + (size_t)r * DM) + C.lane;
#pragma unroll
        for (int j = 0; j < 8; ++j) { const f32x4 wv = *(const f32x4*)(w + (C.lane + 64 * j) * 4); o[64 * j] = v[j] * rstd * wv; } }
}

struct Args { const float* in[28]; float* out; unsigned char* ws; int ph_lo, ph_hi; };
constexpr int N_PHASES = 1 + 2 * 9 + 2 * 9 + 1;

__global__ void __launch_bounds__(512, 2) fwd_kernel(Args args) {
    extern __shared__ __attribute__((aligned(16))) unsigned char lds_raw[];
    LAS unsigned char* const lds0 = (LAS unsigned char*)lds_raw;
    const unsigned long long inaddr = (unsigned long long)__builtin_amdgcn_kernarg_segment_ptr();
    volatile LAS unsigned* misc = (volatile LAS unsigned*)(lds0 + LDS_MISC);
    if (threadIdx.x < 64) misc[threadIdx.x] = 0u;
    __syncthreads();
    const int lo = args.ph_lo, hi = args.ph_hi;
    const int wave0 = __builtin_amdgcn_readfirstlane(threadIdx.x >> 6);
    XcdBarrier bar; bar.bar = (unsigned*)(args.ws + WS_CTL) + 4096; bar.x = 0; bar.st = misc + 8;
    if (hi - lo > 1) bar = xcd_barrier_post((unsigned*)(args.ws + WS_CTL) + 4096, misc + 8);
    int pid = 0;
    const unsigned long long wsaddr = (unsigned long long)args.ws;
#define PH_BEGIN if (pid >= lo && pid < hi) { int l = l_; Ctx C; { unsigned long long a_ = inaddr, w_ = wsaddr; int t_; asm volatile("v_mbcnt_lo_u32_b32 %0, -1, 0\n\tv_mbcnt_hi_u32_b32 %0, -1, %0" : "=v"(t_)); t_ += wave0 * 64; asm volatile("" : "+s"(a_), "+s"(w_), "+s"(l)); \
        C.in = (InPtr)a_; C.ws = (unsigned char*)(GAS unsigned char*)w_; C.out = (float*)(GAS float*)args.out; C.lds = lds0; C.tid = t_; C.lane = t_ & 63; C.wave = __builtin_amdgcn_readfirstlane(t_ >> 6); \
        C.gw = blockIdx.x * 8 + C.wave; C.ngw = gridDim.x * 8; C.gtid = blockIdx.x * 512 + t_; C.ngt = gridDim.x * 512; } \
        const int e = l >> 1; const float* mod = WSP(float, WS_MOD) + (size_t)l * 3 * MODW; const int G = gridDim.x, cb = blockIdx.x; (void)e; (void)mod; (void)G; (void)cb;
#define PH_END } if (pid >= lo && pid + 1 < hi) xcd_barrier(bar); ++pid;
#ifndef PROBE_CAT
#define PROBE_CAT -1
#endif
#define DUP(cat, ...) { if (PROBE_CAT == (cat)) { const float SC_ = 0.f; (void)SC_; __VA_ARGS__ } { const float SC_ = 1.f; (void)SC_; __VA_ARGS__ } }
    int l_ = 0;
    PH_BEGIN
#ifndef SKIP_PRO
    DUP(0, phase_prologue(C);)
#endif
    PH_END

    constexpr int MLAT = NBATCH * SEQ;
    for (l_ = 0; l_ < DEPTH; ++l_) {
        PH_BEGIN DUP(1, phase_norm_mod(C, C.inp(6) + l * DM, mod, 0, 1);) PH_END
        if ((l_ & 1) == 0) {
            PH_BEGIN DUP(2, { const bf16_t* wt = WSP(bf16_t, WS_WABIN) + (size_t)e * ABNP * DM;
                       { pg8::Gemm g{WSP(bf16_t, WS_H), wt, MLAT, ABNP, DM, DM, DM, 1}; pg8::StaticOrder S; S.init(MLAT, ABNP, G, cb); EpiBf16Plain E{WSP(bf16_t, WS_P), ABNP}; pg8::gemm_phase(C.lds, C.tid, g, S, E); }
                       DUP(14, { sg::SGemm g{WSP(bf16_t, WS_H), wt, ABNP, DM, DM, DM}; SEpiPlain E{WSP(bf16_t, WS_P), ABNP}; sg::sgemm_phase(C.lds, C.tid, g, 32 * (ABNP / 256), E); }) }) PH_END
            PH_BEGIN DUP(3, { phase_lru<false>(C, e); phase_rs_kr(C); }) PH_END
            PH_BEGIN phase_lru_carry(C); DUP(4, { const bf16_t* wq = WSP(bf16_t, WS_WUQ) + (size_t)e * QW * 512; const bf16_t* wkv = WSP(bf16_t, WS_WUKV) + (size_t)e * KVW * 512;
                       { pg8::Gemm g{WSP(bf16_t, WS_P) + 2048, wq, MLAT, QW, 512, ABNP, 512, 1}; pg8::StaticOrder S; S.init(MLAT, QW, G, cb); EpiBf16RowScale E{WSP(bf16_t, WS_Q), QW, WSP(float, WS_RSQ)}; pg8::gemm_phase(C.lds, C.tid, g, S, E); }
                       { pg8::Gemm g{WSP(bf16_t, WS_P) + 2560, wkv, MLAT, KVW, 512, ABNP, 512, 1}; pg8::StaticOrder S; S.init(MLAT, KVW, G, cb); EpiBf16RowScale E{WSP(bf16_t, WS_KV), KVW, WSP(float, WS_RSKV)}; pg8::gemm_phase(C.lds, C.tid, g, S, E); }
                       DUP(14, { sg::SGemm g{WSP(bf16_t, WS_P) + 2048, wq, QW, 512, ABNP, 512}; SEpiRowScale E{WSP(bf16_t, WS_Q), QW, WSP(float, WS_RSQ)}; sg::sgemm_phase(C.lds, C.tid, g, 32 * (QW / 256), E); })
                       DUP(14, { sg::SGemm g{WSP(bf16_t, WS_P) + 2560, wkv, KVW, 512, ABNP, 512}; SEpiRowScale E{WSP(bf16_t, WS_KV), KVW, WSP(float, WS_RSKV)}; sg::sgemm_phase(C.lds, C.tid, g, 0, E); }) })
            PH_END
            PH_BEGIN DUP(5, phase_lru<true>(C, e);) DUP(6, phase_attn(C);) PH_END
        } else {
            PH_BEGIN DUP(7, { const bf16_t* wt = WSP(bf16_t, WS_WHGIN) + (size_t)e * HGN * DM;
                       { pg8::Gemm g{WSP(bf16_t, WS_H), wt, MLAT, HGN, DM, DM, DM, 1}; pg8::StaticOrder S; S.init(MLAT, HGN, G, cb); EpiHG E{WSP(bf16_t, WS_QH), WSP(float, WS_LOGF), WSP(float, WS_LB) + l * 2048}; pg8::gemm_phase(C.lds, C.tid, g, S, E); }
                       DUP(14, { sg::SGemm g{WSP(bf16_t, WS_H), wt, HGN, DM, DM, DM}; SEpiHG E{WSP(bf16_t, WS_QH), WSP(float, WS_LOGF), WSP(float, WS_LB) + l * 2048}; sg::sgemm_phase(C.lds, C.tid, g, 32 * (HGN / 256), E); }) }) PH_END
            PH_BEGIN DUP(8, phase_hg_ds(C);) PH_END
            PH_BEGIN DUP(9, phase_hg_scan(C);) PH_END
            PH_BEGIN DUP(10, phase_hg_out(C, e);) PH_END
        }
        PH_BEGIN DUP(11, { const bf16_t* wout = (l & 1) ? WSP(bf16_t, WS_WHGOUT) + (size_t)e * DM * DM : WSP(bf16_t, WS_WABOUT) + (size_t)e * DM * DM;
                   { pg8::Gemm g{WSP(bf16_t, WS_Y), wout, MLAT, DM, DM, DM, DM, 1}; pg8::StaticOrder S; S.init(MLAT, DM, G, cb); EpiResid E{WSP(float, WS_XS), mod + 2 * DM, SC_}; pg8::gemm_phase(C.lds, C.tid, g, S, E); }
                   if (l != DEPTH - 1) DUP(14, { sg::SGemm g{WSP(bf16_t, WS_Y), wout, DM, DM, DM, DM}; SEpiResid E{WSP(float, WS_XS), mod + 2 * DM, SC_}; sg::sgemm_phase(C.lds, C.tid, g, 32 * (DM / 256), E); }) }) PH_END
        PH_BEGIN DUP(1, phase_norm_mod(C, C.inp(7) + l * DM, mod, 3, 4);) PH_END
        PH_BEGIN DUP(12, { const bf16_t* wt = WSP(bf16_t, WS_W1) + (size_t)l * DFF * DM;
                   { pg8::Gemm g{WSP(bf16_t, WS_H), wt, MLAT, DFF, DM, DM, DM, 1}; pg8::StaticOrder S; S.init(MLAT, DFF, G, cb); EpiRelu2 E{WSP(bf16_t, WS_HID), DFF}; pg8::gemm_phase(C.lds, C.tid, g, S, E); }
                   if (l != DEPTH - 1) DUP(16, { sg::SGemm g{WSP(bf16_t, WS_H), wt, DFF, DM, DM, DM}; SEpiRelu2 E{WSP(bf16_t, WS_HID), DFF}; sg::sgemm_phase(C.lds, C.tid, g, 32 * (DFF / 256), E); }) }) PH_END
        PH_BEGIN DUP(13, { const bf16_t* wt = WSP(bf16_t, WS_W2) + (size_t)l * DM * DFF;
                   { pg8::Gemm g{WSP(bf16_t, WS_HID), wt, MLAT, DM, DFF, DFF, DFF, 1}; pg8::StaticOrder S; S.init(MLAT, DM, G, cb); EpiResid E{WSP(float, WS_XS), mod + 5 * DM, SC_}; pg8::gemm_phase(C.lds, C.tid, g, S, E); }
                   if (l != DEPTH - 1) DUP(15, { sg::SGemm g{WSP(bf16_t, WS_HID), wt, DM, DFF, DFF, DFF}; SEpiResid E{WSP(float, WS_XS), mod + 5 * DM, SC_}; sg::sgemm_phase(C.lds, C.tid, g, 32 * (DM / 256), E); }) }) PH_END
    }
    l_ = 0;
    PH_BEGIN phase_final(C); PH_END
}

#ifndef N_LAUNCH_MODE
#define N_LAUNCH_MODE 1
#endif
extern "C" void kernel_launch(void* const* d_in, const int* in_sizes, int n_in, void* d_out, int out_size, void* d_ws, size_t ws_size, hipStream_t stream) {
    static int grid = 0;
    if (grid == 0) {
        if (n_in != 28 || out_size != NBATCH * SEQ * DM || ws_size < WS_END) { fprintf(stderr, "kernel_launch: shape mismatch n_in %d out %d ws %zu (need %zu)\n", n_in, out_size, ws_size, (size_t)WS_END); grid = -1; return; }
        int dev = 0, cus = 0, per_cu = 0;
        if (hipGetDevice(&dev) != hipSuccess || hipDeviceGetAttribute(&cus, hipDeviceAttributeMultiprocessorCount, dev) != hipSuccess) { grid = -1; return; }
        if (hipFuncSetAttribute((const void*)fwd_kernel, hipFuncAttributeMaxDynamicSharedMemorySize, LDS_BYTES) != hipSuccess) { fprintf(stderr, "kernel_launch: hipFuncSetAttribute failed\n"); grid = -1; return; }
        if (hipOccupancyMaxActiveBlocksPerMultiprocessor(&per_cu, (const void*)fwd_kernel, 512, LDS_BYTES) != hipSuccess || per_cu < 1) fprintf(stderr, "kernel_launch: occupancy query says %d\n", per_cu);
        (void)hipGetLastError();
        grid = cus;
    }
    if (grid < 0) return;
    (void)hipMemsetAsync((char*)d_ws + WS_CTL, 0, CTL_BYTES, stream);
    Args a{};
    for (int i = 0; i < 28; ++i) a.in[i] = (const float*)d_in[i];
    a.out = (float*)d_out; a.ws = (unsigned char*)d_ws;
#if N_LAUNCH_MODE == 1
    a.ph_lo = 0; a.ph_hi = N_PHASES;
    hipLaunchKernelGGL(fwd_kernel, dim3(grid), dim3(512), LDS_BYTES, stream, a);
#else
    for (int p = 0; p < N_PHASES; ++p) { a.ph_lo = p; a.ph_hi = p + 1; hipLaunchKernelGGL(fwd_kernel, dim3(grid), dim3(512), LDS_BYTES, stream, a); }
#endif
    const hipError_t le = hipPeekAtLastError();
    if (le != hipSuccess) fprintf(stderr, "kernel_launch: launch failed: %s\n", hipGetErrorName(le));
}
```

```cpp
#include <hip/hip_runtime.h>
#include <cstdio>

#define LAS __attribute__((address_space(3)))
#define GAS __attribute__((address_space(1)))
typedef unsigned short bf16_t;
typedef short bf16x8 __attribute__((ext_vector_type(8)));
typedef float f32x4 __attribute__((ext_vector_type(4)));
typedef float f32x2 __attribute__((ext_vector_type(2)));
typedef unsigned u32x4 __attribute__((ext_vector_type(4)));
typedef unsigned u32x2 __attribute__((ext_vector_type(2)));

constexpr int DM = 2048, NBATCH = 2, SEQ = 4096, DEPTH = 4, CTX = 256;
constexpr int SROW = CTX + SEQ;
constexpr int MROWS = NBATCH * SROW;
constexpr int DFF = 8192, MODW = 6 * DM;
constexpr int DLRU = 1024;
constexpr int ABN = 3136, ABNP = 3328;
constexpr int QW = 1536, KVW = 2048, HGN = 10240;
constexpr float EPS = 1e-6f;
constexpr float ATTN_SCALE = 0.07216878364870322f;

constexpr size_t al256(size_t x) { return (x + 255) & ~(size_t)255; }
constexpr size_t WS_CTL = 0, CTL_BYTES = 1u << 20;
constexpr size_t WS_MOD = WS_CTL + CTL_BYTES;
constexpr size_t WS_LB = WS_MOD + al256((size_t)DEPTH * 3 * MODW * 4);
constexpr size_t WS_ROPE = WS_LB + al256((size_t)DEPTH * 2048 * 4);
constexpr size_t WS_RSQ = WS_ROPE + al256(2 * 64 * 16 * 4);
constexpr size_t WS_RSKV = WS_RSQ + al256((size_t)MROWS * 4);
constexpr size_t WS_WABIN = WS_RSKV + al256((size_t)MROWS * 4);
constexpr size_t WS_WABOUT = WS_WABIN + (size_t)2 * ABNP * DM * 2;
constexpr size_t WS_WUQ = WS_WABOUT + (size_t)2 * DM * DM * 2;
constexpr size_t WS_WUKV = WS_WUQ + (size_t)2 * QW * 512 * 2;
constexpr size_t WS_WHGIN = WS_WUKV + (size_t)2 * KVW * 512 * 2;
constexpr size_t WS_WHGOUT = WS_WHGIN + (size_t)2 * HGN * DM * 2;
constexpr size_t WS_W1 = WS_WHGOUT + (size_t)2 * DM * DM * 2;
constexpr size_t WS_W2 = WS_W1 + (size_t)4 * DFF * DM * 2;
constexpr size_t WS_WG = WS_W2 + (size_t)4 * DFF * DM * 2;
constexpr size_t WS_XS = WS_WG + (size_t)2 * 4 * 128 * 1024 * 2;
constexpr size_t WS_H = WS_XS + (size_t)MROWS * DM * 4;
constexpr size_t WS_Y = WS_H + (size_t)MROWS * DM * 2;
constexpr size_t WS_BIG = WS_Y + (size_t)MROWS * DM * 2;
constexpr size_t WS_P = WS_BIG;
constexpr size_t WS_AG = WS_P + (size_t)MROWS * ABNP * 2;
constexpr size_t WS_CARRY = WS_AG + al256((size_t)(MROWS / 64) * 2 * 2 * DLRU * 4);
constexpr size_t WS_Q = WS_CARRY + al256((size_t)(MROWS / 64) * 2 * DLRU * 4);
constexpr size_t WS_KV = WS_Q + (size_t)MROWS * QW * 2;
constexpr size_t WS_KR = WS_KV + (size_t)MROWS * KVW * 2;
constexpr size_t WS_AB_END = WS_KR + (size_t)MROWS * 64 * 2;
constexpr size_t WS_QH = WS_BIG;
constexpr size_t WS_VH = WS_QH + (size_t)MROWS * DM * 2;
constexpr size_t WS_GH = WS_VH + (size_t)MROWS * DM * 2;
constexpr size_t WS_LOGF = WS_GH + (size_t)MROWS * DM * 2;
constexpr size_t WS_SS = WS_LOGF + (size_t)2 * MROWS * DM * 4;
constexpr size_t WS_HG_END = WS_SS + (size_t)64 * 68 * 16384 * 2;
constexpr size_t WS_HID = WS_BIG;
constexpr size_t WS_MLP_END = WS_HID + (size_t)MROWS * DFF * 2;
constexpr size_t cmax(size_t a, size_t b) { return a > b ? a : b; }
constexpr size_t WS_END = cmax(cmax(WS_AB_END, WS_HG_END), WS_MLP_END);

constexpr int LDS_BYTES = 147456;
constexpr int LDS_MISC = 139264;

__device__ __forceinline__ float bf2f(bf16_t v) { return __uint_as_float(((unsigned)v) << 16); }
__device__ __forceinline__ unsigned f2bf(float f) { unsigned u = __float_as_uint(f); return (u + 0x7fffu + ((u >> 16) & 1u)) >> 16; }
__device__ __forceinline__ unsigned pk2(float lo, float hi) { return f2bf(lo) | (f2bf(hi) << 16); }
__device__ __forceinline__ float wave_sum(float v) {
#pragma unroll
    for (int o = 1; o < 64; o <<= 1) v += __shfl_xor(v, o);
    return v;
}
__device__ __forceinline__ float wave_max(float v) {
#pragma unroll
    for (int o = 1; o < 64; o <<= 1) v = fmaxf(v, __shfl_xor(v, o));
    return v;
}
__device__ __forceinline__ float sigmoidf_(float x) { return 1.0f / (1.0f + expf(-x)); }
__device__ __forceinline__ float siluf_(float x) { return x / (1.0f + expf(-x)); }
__device__ __forceinline__ float fsigmoid(float x) { return __builtin_amdgcn_rcpf(1.0f + __expf(-x)); }
__device__ __forceinline__ float gelu_tanh(float x) { const float u = 0.7978845608028654f * (x + 0.044715f * x * x * x); return 0.5f * x * (1.0f + tanhf(u)); }

#define XB_TMO      128
#define XB_XCNT(j)  (256  + 64 * (j))
#define XB_XSUB(j)  (1280 + 64 * (j))
#define XB_XGEN(j)  (2304 + 64 * (j))
#define XB_TOP      3328
#define XB_TOPGEN   3392
#define XCD_BAR_WORDS 3456
#define XB_SPIN_CAP (1u << 18)
__device__ __forceinline__ unsigned xb_ld(unsigned* p)              { return __hip_atomic_load(p, __ATOMIC_RELAXED, __HIP_MEMORY_SCOPE_AGENT); }
__device__ __forceinline__ unsigned xb_add(unsigned* p, unsigned v) { return __hip_atomic_fetch_add(p, v, __ATOMIC_RELAXED, __HIP_MEMORY_SCOPE_AGENT); }
__device__ __forceinline__ unsigned xb_xcc_id() { return (unsigned)__builtin_amdgcn_s_getreg((3 << 11) | 20) & 0xFu; }
#define XB_SPIN(cond, bar) do { unsigned _sp = 0; while (cond) { __builtin_amdgcn_s_sleep(1); \
    if ((++_sp & 255u) == 0u) { if (xb_ld(&(bar)[XB_TMO])) break; if (_sp > XB_SPIN_CAP) { atomicAdd(&(bar)[XB_TMO], 1u); break; } } } } while (0)
struct XcdBarrier { unsigned* bar; unsigned x; volatile LAS unsigned* st; };
__device__ __forceinline__ XcdBarrier xcd_barrier_post(unsigned* bar, volatile LAS unsigned* st) {
    XcdBarrier b; b.bar = bar; b.x = xb_xcc_id(); b.st = st;
    if (threadIdx.x == 0) (void)xb_add(&bar[XB_XCNT(b.x)], 1u);
    return b;
}
__device__ __forceinline__ void xcd_barrier_complete(unsigned* bar, unsigned x, unsigned& nloc, unsigned& nx) {
    const unsigned G = gridDim.x * gridDim.y * gridDim.z;
    unsigned sum, cnt, mine, sp = 0u;
    for (;;) {
        sum = 0u; cnt = 0u; mine = 0u;
#pragma unroll
        for (unsigned j = 0; j < 16; ++j) { const unsigned c = xb_ld(&bar[XB_XCNT(j)]); sum += c; cnt += (c > 0u) ? 1u : 0u; mine = (j == x) ? c : mine; }
        if (sum == G) break;
        __builtin_amdgcn_s_sleep(1);
        if ((++sp & 255u) == 0u) { if (xb_ld(&bar[XB_TMO])) break; if (sp > XB_SPIN_CAP) { atomicAdd(&bar[XB_TMO], 1u); break; } }
    }
    nloc = mine > 0u ? mine : 1u; nx = cnt > 0u ? cnt : 1u;
}
__device__ __forceinline__ void xcd_barrier(const XcdBarrier& b) {
    asm volatile("s_waitcnt vmcnt(0)" ::: "memory");
    __syncthreads();
    if (threadIdx.x == 0) {
        unsigned* bar = b.bar; asm volatile("" : "+s"(bar)); bar = (unsigned*)(GAS unsigned*)bar;
        __builtin_amdgcn_s_waitcnt(0);
        unsigned nloc = b.st[0], nx = b.st[1];
        if (nloc == 0u) { xcd_barrier_complete(bar, b.x, nloc, nx); b.st[0] = nloc; b.st[1] = nx; }
        const unsigned old = xb_add(&bar[XB_XSUB(b.x)], 1u);
        const unsigned gen = old / nloc;
        if (old + 1u == (gen + 1u) * nloc) {
            __builtin_amdgcn_fence(__ATOMIC_RELEASE, "agent");
            asm volatile("s_waitcnt vmcnt(0)" ::: "memory");
            const unsigned og = xb_add(&bar[XB_TOP], 1u);
            const unsigned tg = og / nx;
            if (og + 1u == (tg + 1u) * nx) xb_add(&bar[XB_TOPGEN], 1u);
            else XB_SPIN(xb_ld(&bar[XB_TOPGEN]) == tg, bar);
            __builtin_amdgcn_fence(__ATOMIC_ACQUIRE, "agent");
            xb_add(&bar[XB_XGEN(b.x)], 1u);
            asm volatile("s_waitcnt vmcnt(0)" ::: "memory");
        } else {
            XB_SPIN(xb_ld(&bar[XB_XGEN(b.x)]) == gen, bar);
            __builtin_amdgcn_fence(__ATOMIC_ACQUIRE, "agent");
            asm volatile("s_waitcnt vmcnt(0)" ::: "memory");
        }
    }
    __syncthreads();
}

namespace pg8 {
constexpr int BM = 256, BK = 64, HALF = 128, HTB = HALF * BK * 2, STAGE_BYTES = 8 * HTB, NXCD = 8, WGM = 8;
__host__ __device__ __forceinline__ int lds_byte(int r, int c) { const int st = (r >> 4) * 2 + (c >> 5), rr = r & 15, cc = c & 31, ob = rr * 64 + cc * 2; return st * 1024 + (ob ^ (((ob >> 9) & 1) << 5)); }
__host__ __device__ __forceinline__ void stage_rc(int b, int& R, int& C) { const int st = b / 1024, sb = b % 1024, swz = sb ^ (((sb >> 9) & 1) << 5); R = (st >> 1) * 16 + swz / 64; C = (st & 1) * 32 + (swz % 64) / 2; }
__host__ __device__ __forceinline__ int perm32(int rho) { const int n = rho >> 4, i = rho & 15; return 8 * (i >> 2) + 4 * n + (i & 3); }
struct Unit { int pm, pn; };
struct Gemm { const bf16_t* A; const bf16_t* Bt; int M, N, K, lda, ldb, lat; };
struct StaticOrder {
    int nM, nN, nwg, G, c;
    __host__ __device__ void init(int M, int N, int G_, int c_) { nM = M / BM; nN = N / BM; nwg = nM * nN; G = G_; c = c_; }
    __host__ __device__ bool next(int i, Unit& u) const {
        const long L = (long)i * G + c; if (L >= nwg) return false;
        int wgid = (int)L; { const int q = nwg / NXCD, r = nwg % NXCD, xcd = wgid % NXCD, off = wgid / NXCD; wgid = (xcd < r ? xcd * (q + 1) : r * (q + 1) + (xcd - r) * q) + off; }
        const int nig = WGM * nN, gid = wgid / nig, fm = gid * WGM, gsz = (nM - fm) < WGM ? (nM - fm) : WGM;
        u.pm = fm + ((wgid % nig) % gsz); u.pn = (wgid % nig) / gsz; return true;
    }
};
__device__ __forceinline__ unsigned cvt_pk_bf16(float lo, float hi) { unsigned r; asm volatile("v_cvt_pk_bf16_f32 %0, %1, %2" : "=v"(r) : "v"(lo), "v"(hi)); return r; }

template <class Epi>
__device__ __forceinline__ void gemm_phase(LAS unsigned char* lds, const int tid, const Gemm g, const StaticOrder& S, const Epi& E) {
    const int wid = __builtin_amdgcn_readfirstlane(tid >> 6), lane = tid & 63, wr = wid >> 2, wc = wid & 3, fr = lane & 15, fq = lane >> 4;
    const int K = g.K, nt = K / BK;
    unsigned voffA[2], voffB[2];
#pragma unroll
    for (int i = 0; i < 2; ++i) { int R, C; stage_rc(tid * 16 + i * 8192, R, C); const int Rb = Epi::PERM ? ((R & ~31) + perm32(R & 31)) : R;
        voffA[i] = (unsigned)(R * g.lda + C) * 2u; voffB[i] = (unsigned)(Rb * g.ldb + C) * 2u; }
    const size_t kstep = (size_t)(BK * 2);
    const size_t hsA = (size_t)HALF * g.lda * 2, hsB = (size_t)HALF * g.ldb * 2;
    const size_t tsA = 2 * hsA, tsB = 2 * hsB;
    const unsigned ldsw = (unsigned)wid * 1024u;
    const int aoff = lds_byte(wr * 64 + fr, fq * 8), boff = lds_byte(wc * 32 + fr, fq * 8);
#define PG8_SA(b, h) (((b) * 2 + (h)) * HTB)
#define PG8_SB(b, h) ((4 + (b) * 2 + (h)) * HTB)
#define PG8_STAGE(bufoff, gbase, voff) do { _Pragma("unroll") for (int _i = 0; _i < 2; ++_i) \
        __builtin_amdgcn_global_load_lds((const unsigned*)((const char*)(gbase) + (voff)[_i]), (LAS unsigned*)(lds + (bufoff) + ldsw + _i * 8192), 16, 0, 0); } while (0)
#define PG8_LDA(dst, b, h) do { _Pragma("unroll") for (int m = 0; m < 4; ++m) _Pragma("unroll") for (int k = 0; k < 2; ++k) dst[m][k] = *(const LAS bf16x8*)(lds + PG8_SA(b, h) + aoff + m * 2048 + k * 1024); } while (0)
#define PG8_LDB(dst, b, h) do { _Pragma("unroll") for (int n = 0; n < 2; ++n) _Pragma("unroll") for (int k = 0; k < 2; ++k) dst[n][k] = *(const LAS bf16x8*)(lds + PG8_SB(b, h) + boff + n * 2048 + k * 1024); } while (0)
#define PG8_MMA(ai, bj, At, Bt) do { __builtin_amdgcn_s_setprio(1); _Pragma("unroll") for (int m = 0; m < 4; ++m) _Pragma("unroll") for (int n = 0; n < 2; ++n) _Pragma("unroll") for (int k = 0; k < 2; ++k) \
        acc[ai][bj][m][n] = __builtin_amdgcn_mfma_f32_16x16x32_bf16(Bt[n][k], At[m][k], acc[ai][bj][m][n], 0, 0, 0); __builtin_amdgcn_s_setprio(0); } while (0)
#define PG8_WAIT_V(n) asm volatile("s_waitcnt vmcnt(" #n ")" ::: "memory")
#define PG8_WAIT_L(n) asm volatile("s_waitcnt lgkmcnt(" #n ")" ::: "memory")
#define PG8_BAR __builtin_amdgcn_s_barrier()
#define PG8_SCHED __builtin_amdgcn_sched_barrier(0)
    Unit cur, nxt; int ui = 0;
    if (!S.next(0, cur)) return;
    if (g.lat) cur.pm += (cur.pm >> 4) + 1;
    f32x4 acc[2][2][4][2];
#pragma unroll
    for (int a = 0; a < 2; ++a)
#pragma unroll
        for (int b = 0; b < 2; ++b)
#pragma unroll
            for (int m = 0; m < 4; ++m)
#pragma unroll
                for (int n = 0; n < 2; ++n) acc[a][b][m][n] = (f32x4){0.f, 0.f, 0.f, 0.f};
    bf16x8 At[4][2], B0[2][2], B1[2][2];
    const char* cA = (const char*)g.A + (size_t)cur.pm * tsA; const char* cB = (const char*)g.Bt + (size_t)cur.pn * tsB;
    PG8_STAGE(PG8_SB(0, 0), cB, voffB); PG8_STAGE(PG8_SA(0, 0), cA, voffA); PG8_STAGE(PG8_SB(0, 1), cB + hsB, voffB); PG8_STAGE(PG8_SA(0, 1), cA + hsA, voffA);
    if (wr == 1) PG8_BAR;
    PG8_WAIT_V(4); PG8_BAR;
    PG8_STAGE(PG8_SB(1, 0), cB + kstep, voffB); PG8_STAGE(PG8_SA(1, 0), cA + kstep, voffA); PG8_STAGE(PG8_SB(1, 1), cB + hsB + kstep, voffB);
    PG8_WAIT_V(6); PG8_BAR;
    for (;;) {
        const bool has_next = S.next(ui + 1, nxt);
        if (g.lat && has_next) nxt.pm += (nxt.pm >> 4) + 1;
        const char* nA = has_next ? (const char*)g.A + (size_t)nxt.pm * tsA : cA; const char* nB = has_next ? (const char*)g.Bt + (size_t)nxt.pn * tsB : cB;
        for (int t = 0; t < nt; t += 2) {
            const bool last = (t == nt - 2);
            const char* a1 = cA + (size_t)(t + 1) * kstep;
            const char* a2 = last ? nA : cA + (size_t)(t + 2) * kstep; const char* b2 = last ? nB : cB + (size_t)(t + 2) * kstep;
            const char* a3 = a2 + kstep; const char* b3 = b2 + kstep;
            PG8_LDB(B0, 0, 0); PG8_SCHED; PG8_LDA(At, 0, 0); PG8_STAGE(PG8_SA(1, 1), a1 + hsA, voffA);
            PG8_WAIT_L(8); PG8_BAR; PG8_WAIT_L(0); PG8_MMA(0, 0, At, B0); PG8_BAR; PG8_SCHED;
            PG8_LDB(B1, 0, 1); PG8_STAGE(PG8_SB(0, 0), b2, voffB);
            PG8_BAR; PG8_WAIT_L(0); PG8_MMA(0, 1, At, B1); PG8_BAR;
            PG8_LDA(At, 0, 1); PG8_STAGE(PG8_SA(0, 0), a2, voffA);
            PG8_BAR; PG8_WAIT_L(0); PG8_MMA(1, 0, At, B0); PG8_BAR; PG8_SCHED;
            PG8_STAGE(PG8_SB(0, 1), b2 + hsB, voffB);
            PG8_WAIT_V(6); PG8_BAR; PG8_MMA(1, 1, At, B1); PG8_BAR;
            PG8_LDB(B0, 1, 0); PG8_SCHED; PG8_LDA(At, 1, 0); PG8_STAGE(PG8_SA(0, 1), a2 + hsA, voffA);
            PG8_WAIT_L(8); PG8_BAR; PG8_WAIT_L(0); PG8_MMA(0, 0, At, B0); PG8_BAR; PG8_SCHED;
            PG8_LDB(B1, 1, 1); PG8_STAGE(PG8_SB(1, 0), b3, voffB);
            PG8_BAR; PG8_WAIT_L(0); PG8_MMA(0, 1, At, B1); PG8_BAR;
            PG8_LDA(At, 1, 1); PG8_STAGE(PG8_SA(1, 0), a3, voffA);
            PG8_BAR; PG8_WAIT_L(0); PG8_MMA(1, 0, At, B0); PG8_BAR; PG8_SCHED;
            PG8_STAGE(PG8_SB(1, 1), b3 + hsB, voffB);
            PG8_WAIT_V(6); PG8_BAR; PG8_MMA(1, 1, At, B1); PG8_BAR;
        }
        E(acc, cur, wr, wc, fr, fq);
        if (!has_next) break;
#pragma unroll
        for (int a = 0; a < 2; ++a)
#pragma unroll
            for (int b = 0; b < 2; ++b)
#pragma unroll
                for (int m = 0; m < 4; ++m)
#pragma unroll
                    for (int n = 0; n < 2; ++n) acc[a][b][m][n] = (f32x4){0.f, 0.f, 0.f, 0.f};
        cur = nxt; cA = nA; cB = nB; ++ui;
    }
    PG8_WAIT_V(0);
    if (wr == 0) PG8_BAR;
    PG8_BAR;
#undef PG8_SA
#undef PG8_SB
#undef PG8_STAGE
#undef PG8_LDA
#undef PG8_LDB
#undef PG8_MMA
#undef PG8_WAIT_V
#undef PG8_WAIT_L
#undef PG8_BAR
#undef PG8_SCHED
}
}

#define EPI_ROWS_COLS_PERM \
    const int row0 = u.pm * 256 + wr * 64 + fr; const int col0 = u.pn * 256 + wc * 32 + 8 * fq;
struct EpiBf16Plain {
    static constexpr bool PERM = true;
    bf16_t* O; int ldc;
    __device__ __forceinline__ void operator()(const f32x4 (&acc)[2][2][4][2], const pg8::Unit& u, int wr, int wc, int fr, int fq) const {
        EPI_ROWS_COLS_PERM
#pragma unroll
        for (int ai = 0; ai < 2; ++ai)
#pragma unroll
            for (int m = 0; m < 4; ++m) { bf16_t* rowp = O + (size_t)(row0 + ai * 128 + m * 16) * ldc + col0;
#pragma unroll
                for (int bj = 0; bj < 2; ++bj) { const f32x4 v0 = acc[ai][bj][m][0], v1 = acc[ai][bj][m][1];
                    u32x4 w; w.x = pk2(v0[0], v0[1]); w.y = pk2(v0[2], v0[3]); w.z = pk2(v1[0], v1[1]); w.w = pk2(v1[2], v1[3]);
                    *(u32x4*)(rowp + bj * 128) = w; } }
    }
};
struct EpiBf16RowScale {
    static constexpr bool PERM = true;
    bf16_t* O; int ldc; const float* rs;
    __device__ __forceinline__ void operator()(const f32x4 (&acc)[2][2][4][2], const pg8::Unit& u, int wr, int wc, int fr, int fq) const {
        EPI_ROWS_COLS_PERM
#pragma unroll
        for (int ai = 0; ai < 2; ++ai)
#pragma unroll
            for (int m = 0; m < 4; ++m) { const int row = row0 + ai * 128 + m * 16; const float s = rs[row]; bf16_t* rowp = O + (size_t)row * ldc + col0;
#pragma unroll
                for (int bj = 0; bj < 2; ++bj) { const f32x4 v0 = acc[ai][bj][m][0] * s, v1 = acc[ai][bj][m][1] * s;
                    u32x4 w; w.x = pk2(v0[0], v0[1]); w.y = pk2(v0[2], v0[3]); w.z = pk2(v1[0], v1[1]); w.w = pk2(v1[2], v1[3]);
                    *(u32x4*)(rowp + bj * 128) = w; } }
    }
};
struct EpiRelu2 {
    static constexpr bool PERM = true;
    bf16_t* O; int ldc;
    __device__ __forceinline__ void operator()(const f32x4 (&acc)[2][2][4][2], const pg8::Unit& u, int wr, int wc, int fr, int fq) const {
        EPI_ROWS_COLS_PERM
#pragma unroll
        for (int ai = 0; ai < 2; ++ai)
#pragma unroll
            for (int m = 0; m < 4; ++m) { bf16_t* rowp = O + (size_t)(row0 + ai * 128 + m * 16) * ldc + col0;
#pragma unroll
                for (int bj = 0; bj < 2; ++bj) { f32x4 v0 = acc[ai][bj][m][0], v1 = acc[ai][bj][m][1];
#pragma unroll
                    for (int j = 0; j < 4; ++j) { const float a = fmaxf(v0[j], 0.f), b = fmaxf(v1[j], 0.f); v0[j] = a * a; v1[j] = b * b; }
                    u32x4 w; w.x = pk2(v0[0], v0[1]); w.y = pk2(v0[2], v0[3]); w.z = pk2(v1[0], v1[1]); w.w = pk2(v1[2], v1[3]);
                    *(u32x4*)(rowp + bj * 128) = w; } }
    }
};
struct EpiResid {
    static constexpr bool PERM = false;
    float* XS; const float* gate; float scale;
    __device__ __forceinline__ void operator()(const f32x4 (&acc)[2][2][4][2], const pg8::Unit& u, int wr, int wc, int fr, int fq) const {
        const int row0 = u.pm * 256 + wr * 64 + fr, col0 = u.pn * 256 + wc * 32 + 4 * fq;
        const int cond = (u.pm % 17 == 0) ? 2 : (u.pm / 17);
        const float* gp = gate + (size_t)cond * MODW + col0;
        f32x4 gv[2][2];
#pragma unroll
        for (int bj = 0; bj < 2; ++bj)
#pragma unroll
            for (int n = 0; n < 2; ++n) gv[bj][n] = *(const f32x4*)(gp + bj * 128 + n * 16) * scale;
#pragma unroll
        for (int ai = 0; ai < 2; ++ai)
#pragma unroll
            for (int m = 0; m < 4; ++m) { float* rowp = XS + (size_t)(row0 + ai * 128 + m * 16) * DM + col0;
#pragma unroll
                for (int bj = 0; bj < 2; ++bj)
#pragma unroll
                    for (int n = 0; n < 2; ++n) { f32x4* p = (f32x4*)(rowp + bj * 128 + n * 16); *p = *p + gv[bj][n] * acc[ai][bj][m][n]; } }
    }
};
struct EpiHG {
    static constexpr bool PERM = true;
    bf16_t* QVG; float* LOGF; const float* lb;
    __device__ __forceinline__ void operator()(const f32x4 (&acc)[2][2][4][2], const pg8::Unit& u, int wr, int wc, int fr, int fq) const {
        const int row0 = u.pm * 256 + wr * 64 + fr; const int seg = u.pn >> 3; const int col0 = (u.pn & 7) * 256 + wc * 32 + 8 * fq;
        if (seg == 1 || seg == 2) {
            float* base = LOGF + (size_t)(seg - 1) * MROWS * DM;
            f32x4 lbv[2][2];
#pragma unroll
            for (int bj = 0; bj < 2; ++bj)
#pragma unroll
                for (int n = 0; n < 2; ++n) lbv[bj][n] = *(const f32x4*)(lb + col0 + bj * 128 + 4 * n);
#pragma unroll
            for (int ai = 0; ai < 2; ++ai)
#pragma unroll
                for (int m = 0; m < 4; ++m) { float* rowp = base + (size_t)(row0 + ai * 128 + m * 16) * DM + col0;
#pragma unroll
                    for (int bj = 0; bj < 2; ++bj)
#pragma unroll
                        for (int n = 0; n < 2; ++n) { f32x4 v = acc[ai][bj][m][n];
#pragma unroll
                            for (int j = 0; j < 4; ++j) { const float l = lbv[bj][n][j]; v[j] = __logf(l + (1.0f - l) * fsigmoid(v[j])); }
                            *(f32x4*)(rowp + bj * 128 + 4 * n) = v; } }
        } else {
            const int bi = seg - 2 + (seg == 0 ? 2 : 0);
            bf16_t* base = QVG + (size_t)bi * MROWS * DM;
            const bool act = (seg != 3);
#pragma unroll
            for (int ai = 0; ai < 2; ++ai)
#pragma unroll
                for (int m = 0; m < 4; ++m) { bf16_t* rowp = base + (size_t)(row0 + ai * 128 + m * 16) * DM + col0;
#pragma unroll
                    for (int bj = 0; bj < 2; ++bj) { f32x4 v0 = acc[ai][bj][m][0], v1 = acc[ai][bj][m][1];
                        if (act) {
#pragma unroll
                            for (int j = 0; j < 4; ++j) { v0[j] = v0[j] * fsigmoid(v0[j]); v1[j] = v1[j] * fsigmoid(v1[j]); } }
                        u32x4 w; w.x = pk2(v0[0], v0[1]); w.y = pk2(v0[2], v0[3]); w.z = pk2(v1[0], v1[1]); w.w = pk2(v1[2], v1[3]);
                        *(u32x4*)(rowp + bj * 128) = w; } }
        }
    }
};


namespace sg {
struct SGemm { const bf16_t* A; const bf16_t* Bt; int N, K, lda, ldb; };
__device__ __forceinline__ unsigned red_off(int w, int row, int col) { return (unsigned)((((w * 64 + row) * 16) + ((col >> 2) ^ (row & 15))) * 16); }
template <class Epi>
__device__ __forceinline__ void sgemm_phase(LAS unsigned char* lds, int tid, const SGemm& g, int nbig, const Epi& E) {
    const int G = gridDim.x, c = blockIdx.x, nsm = 8 * (g.N >> 6), r = nbig % G;
    int start, stride;
    if (r == 0) { start = (G % 8 == 0) ? (c % 8) * (G / 8) + c / 8 : c; stride = G; }
    else { start = c - r; stride = G - r; if (c < r) start = nsm; }
    const int w = __builtin_amdgcn_readfirstlane(tid >> 6), lane = tid & 63, fr = lane & 15, fq = lane >> 4;
    const int kw = g.K >> 3, nk2 = kw >> 6;
    bf16x8 xa[4][2], xb[4][2], ya[4][2], yb[4][2];
    const int voA = (fr * g.lda + w * kw + 16 * fq) * 2, voB = (fr * g.ldb + w * kw + 16 * fq) * 2;
    const int sAb = 16 * g.lda * 2, sBb = 16 * g.ldb * 2;
    __amdgpu_buffer_rsrc_t rA, rB;
#define SG_PTRS(su) do { const int mt_ = (su) & 7, nt_ = (su) >> 3; \
        rA = __builtin_amdgcn_make_buffer_rsrc((void*)(g.A + ((size_t)(mt_ >> 2) * SROW + (mt_ & 3) * 64) * g.lda), 0, 64 * g.lda * 2, 0x00020000); \
        rB = __builtin_amdgcn_make_buffer_rsrc((void*)(g.Bt + (size_t)nt_ * 64 * g.ldb), 0, 64 * g.ldb * 2, 0x00020000); } while (0)
#define SG_LD1(r, vo, so) __builtin_bit_cast(bf16x8, __builtin_amdgcn_raw_buffer_load_b128(r, vo, so, 0))
#define SG_LOAD(a, b, k2) do { _Pragma("unroll") for (int i = 0; i < 4; ++i) { a[i][0] = SG_LD1(rA, voA, i * sAb + (k2) * 128); a[i][1] = SG_LD1(rA, voA, i * sAb + (k2) * 128 + 16); \
        b[i][0] = SG_LD1(rB, voB, i * sBb + (k2) * 128); b[i][1] = SG_LD1(rB, voB, i * sBb + (k2) * 128 + 16); } } while (0)
#define SG_MMA(a, b) do { _Pragma("unroll") for (int hh = 0; hh < 2; ++hh) _Pragma("unroll") for (int m = 0; m < 4; ++m) _Pragma("unroll") for (int n = 0; n < 4; ++n) \
        acc[m][n] = __builtin_amdgcn_mfma_f32_16x16x32_bf16(b[n][hh], a[m][hh], acc[m][n], 0, 0, 0); } while (0)
#define SG_SB __builtin_amdgcn_sched_barrier(0)
    if (start < nsm) { SG_PTRS(start); SG_LOAD(xa, xb, 0); }
    for (int su = start; su < nsm; su += stride) {
        f32x4 acc[4][4];
#pragma unroll
        for (int m = 0; m < 4; ++m)
#pragma unroll
            for (int n = 0; n < 4; ++n) acc[m][n] = (f32x4){0.f, 0.f, 0.f, 0.f};
        if (nk2 > 1) SG_LOAD(ya, yb, 1);
        SG_SB;
        for (int k2 = 0; k2 < nk2; k2 += 2) {
            SG_MMA(xa, xb); SG_SB; if (k2 + 2 < nk2) SG_LOAD(xa, xb, k2 + 2); SG_SB;
            if (k2 + 1 < nk2) { SG_MMA(ya, yb); SG_SB; if (k2 + 3 < nk2) SG_LOAD(ya, yb, k2 + 3); SG_SB; }
        }
        if (su + stride < nsm) { SG_PTRS(su + stride); SG_LOAD(xa, xb, 0); }
        SG_SB;
        __syncthreads();
#pragma unroll
        for (int m = 0; m < 4; ++m)
#pragma unroll
            for (int n = 0; n < 4; ++n) *(LAS f32x4*)(lds + red_off(w, 16 * m + fr, 16 * n + 4 * fq)) = acc[m][n];
        __syncthreads();
        const int row = tid >> 3, c8 = (tid & 7) * 8;
        f32x4 s0 = {0.f, 0.f, 0.f, 0.f}, s1 = {0.f, 0.f, 0.f, 0.f};
#pragma unroll
        for (int ww = 0; ww < 8; ++ww) { s0 += *(const LAS f32x4*)(lds + red_off(ww, row, c8)); s1 += *(const LAS f32x4*)(lds + red_off(ww, row, c8 + 4)); }
        float v[8] = {s0.x, s0.y, s0.z, s0.w, s1.x, s1.y, s1.z, s1.w};
        const int mt = su & 7, nt = su >> 3;
        E((size_t)(mt >> 2) * SROW + (mt & 3) * 64 + row, nt * 64 + c8, v);
    }
#undef SG_SB
#undef SG_LOAD
#undef SG_MMA
#undef SG_PTRS
#undef SG_LD1
    __syncthreads();
}
}
__device__ __forceinline__ void st_bf16x8(bf16_t* p, const float (&v)[8]) { u32x4 w; w.x = pk2(v[0], v[1]); w.y = pk2(v[2], v[3]); w.z = pk2(v[4], v[5]); w.w = pk2(v[6], v[7]); *(u32x4*)p = w; }
struct SEpiPlain { bf16_t* O; int ldc;
    __device__ __forceinline__ void operator()(size_t R, int col, const float (&v)[8]) const { st_bf16x8(O + R * ldc + col, v); } };
struct SEpiRowScale { bf16_t* O; int ldc; const float* rs;
    __device__ __forceinline__ void operator()(size_t R, int col, const float (&v)[8]) const { const float s = rs[R]; float o[8];
#pragma unroll
        for (int j = 0; j < 8; ++j) o[j] = v[j] * s;
        st_bf16x8(O + R * ldc + col, o); } };
struct SEpiRelu2 { bf16_t* O; int ldc;
    __device__ __forceinline__ void operator()(size_t R, int col, const float (&v)[8]) const { float o[8];
#pragma unroll
        for (int j = 0; j < 8; ++j) { const float a = fmaxf(v[j], 0.f); o[j] = a * a; }
        st_bf16x8(O + R * ldc + col, o); } };
struct SEpiResid { float* XS; const float* gate; float scale;
    __device__ __forceinline__ void operator()(size_t R, int col, const float (&v)[8]) const { const float* gp = gate + (size_t)2 * MODW + col; float* xp = XS + R * DM + col;
        const f32x4 g0 = *(const f32x4*)gp * scale, g1 = *(const f32x4*)(gp + 4) * scale; f32x4 x0 = *(f32x4*)xp, x1 = *(f32x4*)(xp + 4);
        x0 += g0 * (f32x4){v[0], v[1], v[2], v[3]}; x1 += g1 * (f32x4){v[4], v[5], v[6], v[7]}; *(f32x4*)xp = x0; *(f32x4*)(xp + 4) = x1; } };
struct SEpiHG { bf16_t* QVG; float* LOGF; const float* lb;
    __device__ __forceinline__ void operator()(size_t R, int col, const float (&v)[8]) const { const int seg = col >> 11, cs = col & 2047;
        if (seg == 1 || seg == 2) { float* p = LOGF + (size_t)(seg - 1) * MROWS * DM + R * DM + cs; f32x4 o0, o1;
#pragma unroll
            for (int j = 0; j < 4; ++j) { const float l0 = lb[cs + j], l1 = lb[cs + 4 + j]; o0[j] = __logf(l0 + (1.0f - l0) * fsigmoid(v[j])); o1[j] = __logf(l1 + (1.0f - l1) * fsigmoid(v[4 + j])); }
            *(f32x4*)p = o0; *(f32x4*)(p + 4) = o1; }
        else { const int bi = seg - 2 + (seg == 0 ? 2 : 0); float o[8];
#pragma unroll
            for (int j = 0; j < 8; ++j) o[j] = seg == 3 ? v[j] : v[j] * fsigmoid(v[j]);
            st_bf16x8(QVG + (size_t)bi * MROWS * DM + R * DM + cs, o); } } };

namespace att {
using s16x4  = __attribute__((ext_vector_type(4))) short;
using f32x16 = __attribute__((ext_vector_type(16))) float;
constexpr int NW = 8, QBLK = 32, KVBLK = 64;
constexpr float SCALE = ATTN_SCALE;
constexpr float THR = 8.f;
constexpr int SHM_V = KVBLK * 128 * 2, SHM_K = KVBLK * 128 * 2, SHM_KR = KVBLK * 64 * 2;
constexpr int OFF_V = 0, OFF_K = 2 * SHM_V, OFF_KR = OFF_K + 2 * SHM_K, OFF_WS = OFF_KR + 2 * SHM_KR, SHM_ATTN = OFF_WS + NW * 64 * 4;
constexpr int LDQ = QW, LDK = KVW, LDO = DM;
#define KSWZ(row, colB) ((row) * 256 + ((colB) ^ (((row) & 7) << 4)))
#define RSWZ(row, colB) ((row) * 128 + ((colB) ^ ((((row) >> 1) & 7) << 4)))
#define SBAR() __builtin_amdgcn_sched_barrier(0)
__device__ __forceinline__ int crow(int r, int hi) { return (r & 3) + 8 * (r >> 2) + 4 * hi; }
__device__ __forceinline__ unsigned cvtpk(float lo, float hi) { unsigned r; asm volatile("v_cvt_pk_bf16_f32 %0, %1, %2" : "=v"(r) : "v"(lo), "v"(hi)); return r; }
__device__ __forceinline__ bf16x8 ld8(const bf16_t* p) { return *reinterpret_cast<const bf16x8*>(p); }
__device__ __forceinline__ void partialSM(f32x16& p0, f32x16& p1, float& m_reg, float& mn, float& alpha) {
  constexpr float C = SCALE * 1.4426950408889634f;
  float pmax = p0[0];
#pragma unroll
  for (int r = 1; r < 16; ++r) pmax = fmaxf(pmax, p0[r]);
#pragma unroll
  for (int r = 0; r < 16; ++r) pmax = fmaxf(pmax, p1[r]);
  { auto rr = __builtin_amdgcn_permlane32_swap(__float_as_uint(pmax), __float_as_uint(pmax), false, false);
    pmax = fmaxf(__uint_as_float(rr[0]), __uint_as_float(rr[1])); }
  if (__builtin_expect(__all(pmax - m_reg <= THR / SCALE), 1)) { mn = m_reg; alpha = 1.f; }
  else { mn = fmaxf(m_reg, pmax); alpha = __builtin_amdgcn_exp2f((m_reg - mn) * C); m_reg = mn; }
  float mnC = -mn * C;
#pragma unroll
  for (int r = 0; r < 16; ++r) p0[r] = fmaf(p0[r], C, mnC);
#pragma unroll
  for (int r = 0; r < 16; ++r) p1[r] = fmaf(p1[r], C, mnC);
#pragma unroll
  for (int r = 0; r < 16; ++r) p0[r] = __builtin_amdgcn_exp2f(p0[r]);
}
__device__ __forceinline__ void finishSM(f32x16& p0, f32x16& p1, float alpha, float& l_reg, bf16x8& pa0, bf16x8& pa1, bf16x8& pa2, bf16x8& pa3) {
#pragma unroll
  for (int r = 0; r < 16; ++r) p1[r] = __builtin_amdgcn_exp2f(p1[r]);
  float ps = 0;
#pragma unroll
  for (int r = 0; r < 16; ++r) ps += p0[r];
#pragma unroll
  for (int r = 0; r < 16; ++r) ps += p1[r];
  { auto rr = __builtin_amdgcn_permlane32_swap(__float_as_uint(ps), __float_as_uint(ps), false, false);
    ps = __uint_as_float(rr[0]) + __uint_as_float(rr[1]); }
  l_reg = l_reg * alpha + ps;
#define PK4(P, BASE, OUT) do { unsigned a0 = cvtpk(P[BASE + 0], P[BASE + 1]), a1 = cvtpk(P[BASE + 2], P[BASE + 3]);   \
    unsigned b0 = cvtpk(P[BASE + 4], P[BASE + 5]), b1 = cvtpk(P[BASE + 6], P[BASE + 7]);                              \
    auto r0 = __builtin_amdgcn_permlane32_swap(a0, b0, false, false); auto r1 = __builtin_amdgcn_permlane32_swap(a1, b1, false, false); \
    u32x4 w = {r0[0], r1[0], r0[1], r1[1]}; OUT = *reinterpret_cast<bf16x8*>(&w); } while (0)
  PK4(p0, 0, pa0); PK4(p0, 8, pa1); PK4(p1, 0, pa2); PK4(p1, 8, pa3);
#undef PK4
}
__device__ __forceinline__ void qkt(f32x16& p0, f32x16& p1, const char* Ks, const char* Krs, const bf16x8* qr, int r32, int hi) {
  p0 = f32x16{}; p1 = f32x16{};
#pragma unroll
  for (int d0 = 0; d0 < 8; ++d0) { int cb = (d0 * 16 + hi * 8) * 2;
    bf16x8 b0 = *reinterpret_cast<const bf16x8*>(Ks + KSWZ(r32, cb));
    bf16x8 b1 = *reinterpret_cast<const bf16x8*>(Ks + KSWZ(32 + r32, cb));
    p0 = __builtin_amdgcn_mfma_f32_32x32x16_bf16(b0, qr[d0], p0, 0, 0, 0);
    p1 = __builtin_amdgcn_mfma_f32_32x32x16_bf16(b1, qr[d0], p1, 0, 0, 0); }
#pragma unroll
  for (int d0 = 0; d0 < 4; ++d0) { int cb = (d0 * 16 + hi * 8) * 2;
    bf16x8 b0 = *reinterpret_cast<const bf16x8*>(Krs + RSWZ(r32, cb));
    bf16x8 b1 = *reinterpret_cast<const bf16x8*>(Krs + RSWZ(32 + r32, cb));
    p0 = __builtin_amdgcn_mfma_f32_32x32x16_bf16(b0, qr[8 + d0], p0, 0, 0, 0);
    p1 = __builtin_amdgcn_mfma_f32_32x32x16_bf16(b1, qr[8 + d0], p1, 0, 0, 0); }
}
__device__ __forceinline__ int v_st(int k, int c) { const int kk = (k & ~0xC) | ((k & 4) << 1) | ((k & 8) >> 1); return ((kk >> 3) * 4 + (c >> 5)) * 512 + ((kk & 7) * 32 + (c & 31)) * 2; }
__device__ __forceinline__ int v_rd_base(int lane) { return ((lane & 3) << 3) | (((lane >> 2) & 3) << 6) | (((lane >> 4) & 1) << 5) | (((lane >> 5) & 1) << 8); }
constexpr int v_rd_off(int d0, int ks, int half) { return d0 * 512 + ks * 4096 + half * 2048; }
template <int OFF> __device__ __forceinline__ s16x4 tr_read(int vb) {
  s16x4 r; asm volatile("ds_read_b64_tr_b16 %0, %1 offset:%2" : "=&v"(r) : "v"(vb), "i"(OFF) : "memory"); return r;
}
template <int D0> __device__ __forceinline__ void pv_one(f32x16& od, int vb, bf16x8 pa0, bf16x8 pa1, bf16x8 pa2, bf16x8 pa3) {
  const s16x4 l0 = tr_read<v_rd_off(D0, 0, 0)>(vb), h0 = tr_read<v_rd_off(D0, 0, 1)>(vb), l1 = tr_read<v_rd_off(D0, 1, 0)>(vb), h1 = tr_read<v_rd_off(D0, 1, 1)>(vb);
  const s16x4 l2 = tr_read<v_rd_off(D0, 2, 0)>(vb), h2 = tr_read<v_rd_off(D0, 2, 1)>(vb), l3 = tr_read<v_rd_off(D0, 3, 0)>(vb), h3 = tr_read<v_rd_off(D0, 3, 1)>(vb);
  asm volatile("s_waitcnt lgkmcnt(0)" ::: "memory"); SBAR();
#define PK(L, H) (bf16x8){L[0], L[1], L[2], L[3], H[0], H[1], H[2], H[3]}
  od = __builtin_amdgcn_mfma_f32_32x32x16_bf16(pa0, PK(l0, h0), od, 0, 0, 0);
  od = __builtin_amdgcn_mfma_f32_32x32x16_bf16(pa1, PK(l1, h1), od, 0, 0, 0);
  od = __builtin_amdgcn_mfma_f32_32x32x16_bf16(pa2, PK(l2, h2), od, 0, 0, 0);
  od = __builtin_amdgcn_mfma_f32_32x32x16_bf16(pa3, PK(l3, h3), od, 0, 0, 0);
#undef PK
}
__device__ __forceinline__ void pv_d0(f32x16* o, int vb, bf16x8 pa0, bf16x8 pa1, bf16x8 pa2, bf16x8 pa3) {
  pv_one<0>(o[0], vb, pa0, pa1, pa2, pa3); pv_one<1>(o[1], vb, pa0, pa1, pa2, pa3); pv_one<2>(o[2], vb, pa0, pa1, pa2, pa3); pv_one<3>(o[3], vb, pa0, pa1, pa2, pa3);
}
__device__ __forceinline__ void attn_body(const bf16_t* __restrict__ Qb, const bf16_t* __restrict__ Kh, const bf16_t* __restrict__ KRb,
                                          bf16_t* __restrict__ Ob, int seq, int tq0, const float* __restrict__ RC, const float* __restrict__ RS, char* lds, int tid) {
  const bf16_t* Vh = Kh + 128;
  const int wid = tid >> 6, lane = tid & 63, r32 = lane & 31, hi = lane >> 5;
  char* V_lds = lds + OFF_V; char* K_lds = lds + OFF_K; char* KR_lds = lds + OFF_KR;
  float* ws = (float*)(lds + OFF_WS) + wid * 64; float* li_l = ws; float* al_l = ws + 32;
  float m_reg = -1e30f, l_reg = 0; f32x16 o[4] = {}; bf16x8 qr[12];
  const bf16_t* Qw = Qb + (long)(wid * QBLK + r32) * LDQ + hi * 8;
#pragma unroll
  for (int d0 = 0; d0 < 12; ++d0) qr[d0] = ld8(Qw + d0 * 16);
  if (tq0 >= 0) {
    const int t = tq0 + wid * QBLK + r32; const int pr = (t >> 6) * 16 + hi * 8, pc = (t & 63) * 16 + hi * 8;
#pragma unroll
    for (int j = 0; j < 8; ++j) {
      { const float c = RC[pr + j], sn = RS[pr + j]; const float x0 = bf2f((bf16_t)qr[8][j]), x1 = bf2f((bf16_t)qr[9][j]);
        qr[8][j] = (short)f2bf(x0 * c - x1 * sn); qr[9][j] = (short)f2bf(x1 * c + x0 * sn); }
      { const float c = RC[pc + j], sn = RS[pc + j]; const float x0 = bf2f((bf16_t)qr[10][j]), x1 = bf2f((bf16_t)qr[11][j]);
        qr[10][j] = (short)f2bf(x0 * c - x1 * sn); qr[11][j] = (short)f2bf(x1 * c + x0 * sn); }
    }
  }
  const int sr = tid >> 4, sc = (tid & 15) * 8, vst0 = v_st(sr, sc), vst1 = v_st(32 + sr, sc);
  const int rr = tid >> 3, rc = (tid & 7) * 8;
  const int vb0 = (int)(uintptr_t)V_lds + v_rd_base(lane);
  bf16x8 vs0, vs1, ks0, ks1, krs;
#define SLOAD(k0) do { vs0 = ld8(&Vh[(long)((k0) + sr) * LDK + sc]); vs1 = ld8(&Vh[(long)((k0) + 32 + sr) * LDK + sc]); \
    ks0 = ld8(&Kh[(long)((k0) + sr) * LDK + sc]); ks1 = ld8(&Kh[(long)((k0) + 32 + sr) * LDK + sc]); krs = ld8(&KRb[(long)((k0) + rr) * 64 + rc]); } while (0)
#define SWRITE(b) do { *(bf16x8*)(V_lds + (b) * SHM_V + vst0) = vs0; *(bf16x8*)(V_lds + (b) * SHM_V + vst1) = vs1; int kc = sc * 2;   \
    *(bf16x8*)(K_lds + (b) * SHM_K + KSWZ(sr, kc)) = ks0; *(bf16x8*)(K_lds + (b) * SHM_K + KSWZ(32 + sr, kc)) = ks1;                    \
    *(bf16x8*)(KR_lds + (b) * SHM_KR + RSWZ(rr, rc * 2)) = krs; } while (0)
#define SWAIT() asm volatile("s_waitcnt vmcnt(0)" ::: "memory")
#define RESC(a) do { if (__any((a) < 1.f)) { if (hi == 0) al_l[r32] = (a); asm volatile("s_waitcnt lgkmcnt(0)" ::: "memory"); \
    _Pragma("unroll") for (int d = 0; d < 4; ++d) _Pragma("unroll") for (int r = 0; r < 16; ++r) o[d][r] *= al_l[crow(r, hi)]; } } while (0)
  f32x16 p0, p1; float mn, al; bf16x8 pa0, pa1, pa2, pa3; const int NT = seq / KVBLK;
  SLOAD(0); SWAIT(); SWRITE(0); __syncthreads();
  SLOAD(KVBLK);
  for (int j = 0; j < NT; ++j) {
    const int buf = j & 1;
    SBAR(); qkt(p0, p1, K_lds + buf * SHM_K, KR_lds + buf * SHM_KR, qr, r32, hi);
    partialSM(p0, p1, m_reg, mn, al); RESC(al);
    finishSM(p0, p1, al, l_reg, pa0, pa1, pa2, pa3); SBAR();
    if (j + 1 < NT) { SWAIT(); SWRITE(buf ^ 1); }
    if (j + 2 < NT) SLOAD((j + 2) * KVBLK);
    SBAR();
    pv_d0(o, vb0 + buf * SHM_V, pa0, pa1, pa2, pa3);
    __syncthreads();
  }
  if (hi == 0) li_l[r32] = l_reg; asm volatile("s_waitcnt lgkmcnt(0)" ::: "memory");
  float rli[16];
#pragma unroll
  for (int r = 0; r < 16; ++r) rli[r] = __builtin_amdgcn_rcpf(li_l[crow(r, hi)]);
  bf16_t* Ow = Ob + (long)(wid * QBLK) * LDO;
#pragma unroll
  for (int r = 0; r < 16; ++r) { int orow = crow(r, hi);
#pragma unroll
    for (int d0 = 0; d0 < 4; ++d0) Ow[(long)orow * LDO + d0 * 32 + r32] = (bf16_t)f2bf(o[d0][r] * rli[r]); }
#undef SLOAD
#undef SWRITE
#undef SWAIT
#undef RESC
}
}

typedef const float* cfp_t;
typedef const __attribute__((address_space(4))) cfp_t* InPtr;
struct Ctx {
    LAS unsigned char* lds; int tid, lane, wave, gw, ngw, gtid, ngt;
    InPtr in; float* out; unsigned char* ws;
    __device__ __forceinline__ const float* inp(int i) const { return (const float*)(const GAS float*)in[i]; }
};
#define WSP(T, off) ((T*)(C.ws + (off)))

__device__ __forceinline__ void tr_item(const float* W, int K, int N, bf16_t* WT, const float* sck, LAS float* scr, int item, int lane) {
    const int nblk = N / 64, kb = item / nblk, nb = item % nblk, k0 = 64 * kb, n0 = 64 * nb;
    f32x4 v[16];
#pragma unroll
    for (int i = 0; i < 16; ++i) v[i] = *(const f32x4*)(W + (size_t)(k0 + 4 * i + (lane >> 4)) * N + n0 + 4 * (lane & 15));
#pragma unroll
    for (int i = 0; i < 16; ++i) { const int kk = 4 * i + (lane >> 4); f32x4 x = v[i]; if (sck) x *= sck[k0 + kk]; LAS float* d = scr + kk * 65 + 4 * (lane & 15); d[0] = x.x; d[1] = x.y; d[2] = x.z; d[3] = x.w; }
    asm volatile("s_waitcnt lgkmcnt(0)" ::: "memory"); __builtin_amdgcn_wave_barrier();
    const int nl = lane & 7, kc = lane >> 3;
#pragma unroll
    for (int j = 0; j < 8; ++j) { const int n = 8 * j + nl; const LAS float* sp = scr + (8 * kc) * 65 + n;
        u32x4 o; o.x = pk2(sp[0 * 65], sp[1 * 65]); o.y = pk2(sp[2 * 65], sp[3 * 65]); o.z = pk2(sp[4 * 65], sp[5 * 65]); o.w = pk2(sp[6 * 65], sp[7 * 65]);
        *(u32x4*)(WT + (size_t)(n0 + n) * K + k0 + 8 * kc) = o; }
    asm volatile("s_waitcnt lgkmcnt(0)" ::: "memory"); __builtin_amdgcn_wave_barrier();
}
__device__ __forceinline__ void tr_matrix(const Ctx& C, const float* W, int K, int N, bf16_t* WT, const float* sck) {
    LAS float* scr = (LAS float*)(C.lds + C.wave * 16640);
    const int cnt = (K / 64) * (N / 64);
    for (int it = C.gw; it < cnt; it += C.ngw) tr_item(W, K, N, WT, sck, scr, it, C.lane);
}
__device__ __forceinline__ void sincos_d(double x, double& s, double& c) {
    const double twopi = 6.283185307179586476925286766559;
    const double k = __builtin_rint(x / twopi); const double y = x - k * twopi; const double y2 = y * y;
    double ts = y, ss = y, tc = 1.0, sc = 1.0;
#pragma unroll
    for (int n = 1; n <= 16; ++n) { tc *= -y2 / (double)((2 * n - 1) * (2 * n)); sc += tc; ts *= -y2 / (double)((2 * n) * (2 * n + 1)); ss += ts; }
    s = ss; c = sc;
}
__device__ __forceinline__ void phase_prologue(const Ctx& C) {
#pragma unroll 1
    for (int e = 0; e < 2; ++e) {
        tr_matrix(C, C.inp(8) + (size_t)e * DM * ABN, DM, ABN, WSP(bf16_t, WS_WABIN) + (size_t)e * ABNP * DM, nullptr);
        tr_matrix(C, C.inp(9) + (size_t)e * DM * DM, DM, DM, WSP(bf16_t, WS_WABOUT) + (size_t)e * DM * DM, nullptr);
        tr_matrix(C, C.inp(18) + (size_t)e * 512 * QW, 512, QW, WSP(bf16_t, WS_WUQ) + (size_t)e * QW * 512, C.inp(17) + e * 512);
        tr_matrix(C, C.inp(20) + (size_t)e * 512 * KVW, 512, KVW, WSP(bf16_t, WS_WUKV) + (size_t)e * KVW * 512, C.inp(19) + e * 512);
        tr_matrix(C, C.inp(21) + (size_t)e * DM * HGN, DM, HGN, WSP(bf16_t, WS_WHGIN) + (size_t)e * HGN * DM, nullptr);
        tr_matrix(C, C.inp(24) + (size_t)e * DM * DM, DM, DM, WSP(bf16_t, WS_WHGOUT) + (size_t)e * DM * DM, nullptr);
#pragma unroll 1
        for (int dg = 0; dg < 4; ++dg) { const int dir = dg >> 1, gate = dg & 1;
            tr_matrix(C, C.inp(gate ? 14 : 12) + ((size_t)e * 2 + dir) * 8 * 128 * 128, 1024, 128, WSP(bf16_t, WS_WG) + ((size_t)e * 4 + dg) * 128 * 1024, nullptr); }
    }
#pragma unroll 1
    for (int l = 0; l < 4; ++l) {
        tr_matrix(C, C.inp(25) + (size_t)l * DM * DFF, DM, DFF, WSP(bf16_t, WS_W1) + (size_t)l * DFF * DM, nullptr);
        tr_matrix(C, C.inp(26) + (size_t)l * DFF * DM, DFF, DM, WSP(bf16_t, WS_W2) + (size_t)l * DM * DFF, nullptr);
    }
    for (int e = 0; e < 2; ++e) { u32x4* z = (u32x4*)(WSP(bf16_t, WS_WABIN) + (size_t)e * ABNP * DM + (size_t)ABN * DM);
        for (int i = C.gtid; i < (ABNP - ABN) * DM / 8; i += C.ngt) z[i] = (u32x4){0u, 0u, 0u, 0u}; }
    { float* XS = WSP(float, WS_XS);
      for (int i = C.gtid; i < MROWS * (DM / 4); i += C.ngt) { const int R = i / (DM / 4), c4 = i % (DM / 4); const int b = R / SROW, s = R % SROW;
          const float* src = s < CTX ? C.inp(2) + ((size_t)(b * CTX + s)) * DM : C.inp(0) + ((size_t)(b * SEQ + (s - CTX))) * DM;
          ((f32x4*)(XS + (size_t)R * DM))[c4] = ((const f32x4*)src)[c4]; } }
    { float* LB = WSP(float, WS_LB);
      for (int i = C.gtid; i < 2048; i += C.ngt) { float v[4], mx = -1e30f; for (int l = 0; l < 4; ++l) { v[l] = C.inp(22)[l * 2048 + i]; mx = fmaxf(mx, v[l]); }
          float sum = 0.f; for (int l = 0; l < 4; ++l) { v[l] = expf(v[l] - mx); sum += v[l]; }
          float cum = 0.f; const float p0 = v[0] / sum; for (int l = 0; l < 4; ++l) { cum += v[l] / sum; LB[l * 2048 + i] = cum - p0; } }
      float* RC = WSP(float, WS_ROPE); float* RS = RC + 1024;
      for (int i = C.gtid; i < 1024; i += C.ngt) { const int pos = i / 16, j = i % 16; double inv = 1.0; for (int q = 0; q < j; ++q) inv *= 0.56234132519034908;
          const float ang = (float)pos * (float)inv; double s, c; sincos_d((double)ang, s, c); RC[i] = (float)c; RS[i] = (float)s; } }
    { LAS float* sl = (LAS float*)C.lds;
      LAS float* red = sl + 3 * 2048;
      __syncthreads();
      for (int i = C.tid; i < 3 * 2048; i += 512) { const int r = i / 2048, d = i % 2048; const float v = r < 2 ? C.inp(1)[r * 2048 + d] : C.inp(3)[d]; sl[i] = siluf_(v); }
      __syncthreads();
      float* MOD = WSP(float, WS_MOD);
      const int kq = C.tid >> 4, cq = C.tid & 15;
      for (int u = blockIdx.x; u < 4 * (MODW / 64); u += gridDim.x) { const int l = u / (MODW / 64), e0 = (u % (MODW / 64)) * 64;
          const float* w = C.inp(4) + (size_t)l * DM * MODW + e0 + 4 * cq;
          f32x4 a0 = {0, 0, 0, 0}, a1 = {0, 0, 0, 0}, a2 = {0, 0, 0, 0};
#pragma unroll 8
          for (int d = kq; d < DM; d += 32) { const f32x4 wv = *(const f32x4*)(w + (size_t)d * MODW); a0 += wv * sl[d]; a1 += wv * sl[2048 + d]; a2 += wv * sl[4096 + d]; }
#pragma unroll
          for (int j = 0; j < 4; ++j) { red[(kq * 3 + 0) * 64 + 4 * cq + j] = a0[j]; red[(kq * 3 + 1) * 64 + 4 * cq + j] = a1[j]; red[(kq * 3 + 2) * 64 + 4 * cq + j] = a2[j]; }
          __syncthreads();
          if (C.tid < 192) { const int r = C.tid / 64, c = C.tid % 64; float s = 0.f; for (int q = 0; q < 32; ++q) s += red[(q * 3 + r) * 64 + c];
              MOD[((size_t)l * 3 + r) * MODW + e0 + c] = s + C.inp(5)[l * MODW + e0 + c]; }
          __syncthreads(); } }
}

__device__ __forceinline__ void phase_norm_mod(const Ctx& C, const float* w, const float* mod, int sh_idx, int sc_idx) {
    const float* XS = WSP(float, WS_XS); bf16_t* H = WSP(bf16_t, WS_H);
    for (int R = C.gw; R < MROWS; R += C.ngw) {
        const int s = R % SROW, b = R / SROW, cond = s < CTX ? 2 : b;
        const float* shift = mod + (size_t)cond * MODW + sh_idx * DM; const float* scale = mod + (size_t)cond * MODW + sc_idx * DM;
        const f32x4* xr = (const f32x4*)(XS + (size_t)R * DM) + C.lane;
        f32x4 v[8]; float ss = 0.f;
#pragma unroll
        for (int j = 0; j < 8; ++j) { v[j] = xr[64 * j]; ss += (v[j].x * v[j].x + v[j].y * v[j].y) + (v[j].z * v[j].z + v[j].w * v[j].w); }
        const float rstd = 1.0f / sqrtf(wave_sum(ss) * (1.0f / DM) + EPS);
        u32x2* o = (u32x2*)(H + (size_t)R * DM) + C.lane;
#pragma unroll
        for (int j = 0; j < 8; ++j) { const int c = (C.lane + 64 * j) * 4; const f32x4 wv = *(const f32x4*)(w + c), sc = *(const f32x4*)(scale + c), sh = *(const f32x4*)(shift + c);
            const f32x4 y = (v[j] * rstd * wv) * (1.0f + sc) + sh; u32x2 pk; pk.x = pk2(y.x, y.y); pk.y = pk2(y.z, y.w); o[64 * j] = pk; }
    }
}

__device__ __forceinline__ void phase_rs_kr(const Ctx& C) {
    const bf16_t* P = WSP(bf16_t, WS_P);
    float* RSQ = WSP(float, WS_RSQ); float* RSKV = WSP(float, WS_RSKV);
    for (int R = C.gw; R < MROWS; R += C.ngw) {
        const u32x4 a = *(const u32x4*)(P + (size_t)R * ABNP + 2048 + 8 * C.lane), b = *(const u32x4*)(P + (size_t)R * ABNP + 2560 + 8 * C.lane);
        float sa = 0.f, sb = 0.f;
#pragma unroll
        for (int j = 0; j < 4; ++j) { const float a0 = __uint_as_float(a[j] << 16), a1 = __uint_as_float(a[j] & 0xffff0000u), b0 = __uint_as_float(b[j] << 16), b1 = __uint_as_float(b[j] & 0xffff0000u);
            sa += a0 * a0 + a1 * a1; sb += b0 * b0 + b1 * b1; }
        sa = wave_sum(sa); sb = wave_sum(sb);
        if (C.lane == 0) { RSQ[R] = 1.0f / sqrtf(sa * (1.0f / 512.0f) + EPS); RSKV[R] = 1.0f / sqrtf(sb * (1.0f / 512.0f) + EPS); } }
    bf16_t* KR = WSP(bf16_t, WS_KR); const float* RC = WSP(float, WS_ROPE); const float* RS = RC + 1024;
    for (int idx = C.gtid; idx < MROWS * 32; idx += C.ngt) { const int R = idx / 32, p = idx % 32, s = R % SROW; const int i0 = p < 16 ? p : 32 + (p - 16);
        const float x0 = bf2f(P[(size_t)R * ABNP + 3072 + i0]), x1 = bf2f(P[(size_t)R * ABNP + 3072 + i0 + 16]); float o0 = x0, o1 = x1;
        if (s >= CTX) { const int t = s - CTX, pos = p < 16 ? t / 64 : t % 64; const float c = RC[pos * 16 + (p & 15)], sn = RS[pos * 16 + (p & 15)]; o0 = x0 * c - x1 * sn; o1 = x1 * c + x0 * sn; }
        KR[(size_t)R * 64 + i0] = (bf16_t)f2bf(o0); KR[(size_t)R * 64 + i0 + 16] = (bf16_t)f2bf(o1); }
}

__device__ __forceinline__ void phase_attn(const Ctx& C) {
    const bf16_t* Q = WSP(bf16_t, WS_Q); const bf16_t* KV = WSP(bf16_t, WS_KV); const bf16_t* KR = WSP(bf16_t, WS_KR); bf16_t* Y = WSP(bf16_t, WS_Y);
    const float* RC = WSP(float, WS_ROPE); const float* RS = RC + 1024;
    const int G = gridDim.x, c = blockIdx.x;
    for (int u0 = c; u0 < 272; u0 += G) {
        int b, hh, s0, nk, tq0;
        if (u0 < 256) { int v = u0; if (G == 256) { const int x = c & 7, j = c >> 3; v = (x * 2 + (j >> 4)) * 16 + (j & 15); }
            const int p = v >> 4, qb = v & 15; b = p >> 3; hh = p & 7; s0 = CTX + qb * 256; nk = SROW; tq0 = qb * 256; }
        else { const int p = u0 - 256; b = p >> 3; hh = p & 7; s0 = 0; nk = CTX; tq0 = -1; }
        const size_t R0 = (size_t)b * SROW + s0, K0 = (size_t)b * SROW;
        __syncthreads();
        att::attn_body(Q + R0 * QW + hh * 192, KV + K0 * KVW + hh * 256, KR + K0 * 64, Y + R0 * DM + DLRU + hh * 128, nk, tq0, RC, RS, (char*)C.lds, C.tid);
    }
}
namespace hg {
using s16x4  = __attribute__((ext_vector_type(4))) short;
using f32x16 = __attribute__((ext_vector_type(16))) float;
constexpr int NCH = SROW / 64;
constexpr int NCHAIN = NBATCH * 16 * 2;
__device__ __forceinline__ unsigned off_b(unsigned row, unsigned ch) { return 256u * row + 16u * (ch ^ (((row & 3u) << 2) | ((row >> 2) & 3u))); }
__device__ __forceinline__ s16x4 trr(unsigned addr) { s16x4 r; asm volatile("ds_read_b64_tr_b16 %0, %1" : "=&v"(r) : "v"(addr) : "memory"); return r; }
__device__ __forceinline__ bf16x8 pk8(s16x4 L, s16x4 H) { return (bf16x8){L[0], L[1], L[2], L[3], H[0], H[1], H[2], H[3]}; }
__device__ __forceinline__ unsigned tr_nat(unsigned lane, unsigned c, unsigned ks, unsigned t) {
    const unsigned h = lane >> 5, blk = (lane >> 4) & 1, q = (lane & 15) >> 2, p = lane & 3;
    return off_b(16 * ks + 8 * h + 4 * t + q, 4 * c + 2 * blk + (p >> 1)) + 8 * (p & 1); }
__device__ __forceinline__ unsigned tr_perm(unsigned lane, unsigned c, unsigned rb, unsigned t) {
    const unsigned h = lane >> 5, blk = (lane >> 4) & 1, q = (lane & 15) >> 2, p = lane & 3;
    return off_b(rb + 4 * h + 8 * t + q, 4 * c + 2 * blk + (p >> 1)) + 8 * (p & 1); }
__device__ __forceinline__ unsigned row_rd(unsigned lane, unsigned rb, unsigned ks) { return off_b(rb + (lane & 31), 2 * ks + (lane >> 5)); }
__device__ __forceinline__ int crow(int r, int hi) { return (r & 3) + 8 * (r >> 2) + 4 * hi; }
#define HG_WAITL() do { asm volatile("s_waitcnt lgkmcnt(0)" ::: "memory"); __builtin_amdgcn_sched_barrier(0); } while (0)
}

__device__ __forceinline__ void phase_hg_state(const Ctx& C) {
    using namespace hg;
    LAS unsigned char* L = C.lds; const unsigned Lb = (unsigned)(uintptr_t)L;
    constexpr unsigned VT = 0, KP = 16384, TOT = 32768, DECV = 36864;
    const float* LOGF = WSP(float, WS_LOGF); const bf16_t* VH = WSP(bf16_t, WS_VH); bf16_t* SS = WSP(bf16_t, WS_SS);
    const int w = C.wave, lane = C.lane, tid = C.tid, h5 = lane >> 5, r32 = lane & 31;
    const int G = gridDim.x, c = blockIdx.x, v0 = (G % 8 == 0) ? (c % 8) * (G / 8) + c / 8 : c;
    for (int u = v0; u < NCHAIN * 4; u += G) {
        const int chain = u >> 2, sl = u & 3, dir = chain & 1, hh = (chain >> 1) & 15, b = chain >> 5;
        const float* lfb = LOGF + (size_t)dir * MROWS * DM + ((size_t)b * SROW + 8 * w) * DM + hh * 128 + 2 * lane;
        const bf16_t* vb = VH + ((size_t)b * SROW + (tid >> 2)) * DM + hh * 128 + 32 * sl + 8 * (tid & 3);
        f32x16 S = {};
        f32x2 lfA[8], lfB[8]; u32x4 vA = {0u, 0u, 0u, 0u}, vB = {0u, 0u, 0u, 0u};
#define HS_CI(j) (dir == 0 ? (j) : ((j) < 4 ? 3 - (j) : 71 - (j)))
#define HS_LOAD(lf, vr, j) do { const int cn_ = HS_CI(j); _Pragma("unroll") for (int i = 0; i < 8; ++i) lf[i] = *(const f32x2*)(lfb + (size_t)(cn_ * 64 + i) * DM); \
        if (tid < 256) vr = *(const u32x4*)(vb + (size_t)cn_ * 64 * DM); } while (0)
#define HS_STEP(lf, vr, j) do { const int ci = HS_CI(j); \
            f32x2 T = {0.f, 0.f}; \
            _Pragma("unroll") for (int i = 0; i < 8; ++i) T += lf[i]; \
            *(LAS f32x2*)(L + TOT + (w * 128 + 2 * lane) * 4) = T; \
            __syncthreads();                                          \
            if (tid < 256) *(LAS u32x4*)(L + VT + off_b(tid >> 2, 4 * sl + (tid & 3))) = vr; \
            f32x2 off = {0.f, 0.f}, total = {0.f, 0.f}; \
            _Pragma("unroll") for (int ww = 0; ww < 8; ++ww) { const f32x2 t = *(const LAS f32x2*)(L + TOT + (ww * 128 + 2 * lane) * 4); total += t; if (dir == 0 ? (ww > w) : (ww < w)) off += t; } \
            f32x2 E[8]; \
            if (dir == 0) { E[7] = off; _Pragma("unroll") for (int i = 6; i >= 0; --i) E[i] = E[i + 1] + lf[i + 1]; } \
            else { E[0] = off; _Pragma("unroll") for (int i = 1; i < 8; ++i) E[i] = E[i - 1] + lf[i - 1]; } \
            _Pragma("unroll") for (int i = 0; i < 8; ++i) { const float k0 = (1.0f - __expf(lf[i].x)) * __expf(E[i].x), k1 = (1.0f - __expf(lf[i].y)) * __expf(E[i].y); \
                *(LAS unsigned*)(L + KP + off_b(8 * w + i, lane >> 2) + (lane & 3) * 4) = pk2(k0, k1); } \
            if (w == 0) { f32x2 d; d.x = __expf(total.x); d.y = __expf(total.y); *(LAS f32x2*)(L + DECV + 2 * lane * 4) = d; } \
            if ((j) + 2 < NCH) HS_LOAD(lf, vr, (j) + 2); \
            __syncthreads(); \
            if (w < 4) {     \
                bf16_t* sp = SS + ((size_t)chain * NCH + ci) * 16384 + 32 * sl + r32; \
                s16x4 al[4], ah[4], bl[4], bh[4]; \
                _Pragma("unroll") for (int ks = 0; ks < 4; ++ks) { al[ks] = trr(Lb + KP + tr_nat(lane, w, ks, 0)); ah[ks] = trr(Lb + KP + tr_nat(lane, w, ks, 1)); \
                    bl[ks] = trr(Lb + VT + tr_nat(lane, sl, ks, 0)); bh[ks] = trr(Lb + VT + tr_nat(lane, sl, ks, 1)); } \
                _Pragma("unroll") for (int r = 0; r < 16; ++r) { const int dk = 32 * w + crow(r, h5); sp[dk * 128] = (bf16_t)f2bf(S[r]); S[r] *= *(const LAS float*)(L + DECV + dk * 4); } \
                HG_WAITL(); \
                _Pragma("unroll") for (int ks = 0; ks < 4; ++ks) S = __builtin_amdgcn_mfma_f32_32x32x16_bf16(pk8(al[ks], ah[ks]), pk8(bl[ks], bh[ks]), S, 0, 0, 0); \
            } } while (0)
        HS_LOAD(lfA, vA, 0); HS_LOAD(lfB, vB, 1);
        __syncthreads();
#pragma unroll 1
        for (int j = 0; j < NCH; j += 2) { HS_STEP(lfA, vA, j); HS_STEP(lfB, vB, j + 1); }
#undef HS_STEP
#undef HS_LOAD
#undef HS_CI
        __syncthreads();
    }
}
__device__ __forceinline__ void phase_hg_out(const Ctx& C, int o_idx) {
    using namespace hg;
    LAS unsigned char* L = C.lds; const unsigned Lb = (unsigned)(uintptr_t)L;
    constexpr unsigned VT = 0, QP = 16384, QM = 32768, KM = 49152, ST = 65536, TOT = 98304, RED = 102400;
    const float* LOGF = WSP(float, WS_LOGF); const bf16_t* VH = WSP(bf16_t, WS_VH); const bf16_t* QH = WSP(bf16_t, WS_QH); const bf16_t* GH = WSP(bf16_t, WS_GH);
    const bf16_t* SS = WSP(bf16_t, WS_SS); bf16_t* Y = WSP(bf16_t, WS_Y); const float* nw = C.inp(23) + o_idx * 128;
    const int w = C.wave, lane = C.lane, tid = C.tid, h5 = lane >> 5, r32 = lane & 31;
    const unsigned tt = w >> 2, dvt = w & 3;
    for (int u = blockIdx.x; u < NBATCH * 16 * NCH; u += gridDim.x) {
        const int b = u / (16 * NCH), hh = (u / NCH) % 16, ci = u % NCH; const size_t R0 = (size_t)b * SROW + ci * 64;
        __syncthreads();
#pragma unroll
        for (int p = 0; p < 2; ++p) { const int row = (tid >> 4) + 32 * p, ch = tid & 15; const u32x4 v = *(const u32x4*)(VH + (R0 + row) * DM + hh * 128 + ch * 8); *(LAS u32x4*)(L + VT + off_b(row, ch)) = v; }
        f32x16 acc = {};
#pragma unroll 1
        for (int dir = 0; dir < 2; ++dir) {
            const int chain = (b * 16 + hh) * 2 + dir;
            u32x4 sreg[4];
#pragma unroll
            for (int p = 0; p < 4; ++p) sreg[p] = *(const u32x4*)(SS + (((size_t)chain * NCH + ci) * 128 + (tid >> 4) + 32 * p) * 128 + (tid & 15) * 8);
            const float* lfp = LOGF + (size_t)dir * MROWS * DM + (R0 + 8 * w) * DM + hh * 128 + 2 * lane;
            const bf16_t* qp = QH + (R0 + 8 * w) * DM + hh * 128 + 2 * lane;
            f32x2 lf[8]; unsigned qv[8]; f32x2 T = {0.f, 0.f};
#pragma unroll
            for (int i = 0; i < 8; ++i) { lf[i] = *(const f32x2*)(lfp + (size_t)i * DM); qv[i] = *(const unsigned*)(qp + (size_t)i * DM); T += lf[i]; }
            *(LAS f32x2*)(L + TOT + (w * 128 + 2 * lane) * 4) = T;
            __syncthreads();
            f32x2 off = {0.f, 0.f}, mid = {0.f, 0.f};
#pragma unroll
            for (int ww = 0; ww < 8; ++ww) { const f32x2 t = *(const LAS f32x2*)(L + TOT + (ww * 128 + 2 * lane) * 4);
                if (dir == 0 ? (ww < w) : (ww > w)) off += t; if (dir == 0 ? (ww < 4) : (ww >= 4)) mid += t; }
            f32x2 B[8];
            if (dir == 0) { B[0] = off + lf[0];
#pragma unroll
                for (int i = 1; i < 8; ++i) B[i] = B[i - 1] + lf[i]; }
            else { B[7] = off + lf[7];
#pragma unroll
                for (int i = 6; i >= 0; --i) B[i] = B[i + 1] + lf[i]; }
#pragma unroll
            for (int i = 0; i < 8; ++i) { const float q0 = __uint_as_float(qv[i] << 16), q1 = __uint_as_float(qv[i] & 0xffff0000u);
                const float k0 = 1.0f - __expf(lf[i].x), k1 = 1.0f - __expf(lf[i].y);
                const unsigned a = off_b(8 * w + i, lane >> 2) + (lane & 3) * 4;
                *(LAS unsigned*)(L + QP + a) = pk2(q0 * __expf(B[i].x), q1 * __expf(B[i].y));
                *(LAS unsigned*)(L + QM + a) = pk2(q0 * __expf(B[i].x - mid.x), q1 * __expf(B[i].y - mid.y));
                *(LAS unsigned*)(L + KM + a) = pk2(k0 * __expf(mid.x - B[i].x), k1 * __expf(mid.y - B[i].y)); }
#pragma unroll
            for (int p = 0; p < 4; ++p) *(LAS u32x4*)(L + ST + off_b((tid >> 4) + 32 * p, tid & 15)) = sreg[p];
            __syncthreads();
            { bf16x8 a[8]; s16x4 bl[8], bh[8];
#pragma unroll
              for (int ks = 0; ks < 8; ++ks) { a[ks] = *(const LAS bf16x8*)(L + QP + row_rd(lane, 32 * tt, ks)); bl[ks] = trr(Lb + ST + tr_nat(lane, dvt, ks, 0)); bh[ks] = trr(Lb + ST + tr_nat(lane, dvt, ks, 1)); }
              HG_WAITL();
#pragma unroll
              for (int ks = 0; ks < 8; ++ks) acc = __builtin_amdgcn_mfma_f32_32x32x16_bf16(a[ks], pk8(bl[ks], bh[ks]), acc, 0, 0, 0); }
            { bf16x8 qb[8];
#pragma unroll
              for (int ks = 0; ks < 8; ++ks) qb[ks] = *(const LAS bf16x8*)(L + QM + row_rd(lane, 32 * tt, ks));
#pragma unroll
              for (unsigned st = 0; st < 2; ++st) { const bool valid = dir == 0 ? (st <= tt) : (st >= tt);
                if (valid) {
                  f32x16 x = {};
#pragma unroll
                  for (int ks = 0; ks < 8; ++ks) { const bf16x8 ka = *(const LAS bf16x8*)(L + KM + row_rd(lane, 32 * st, ks)); x = __builtin_amdgcn_mfma_f32_32x32x16_bf16(ka, qb[ks], x, 0, 0, 0); }
                  if (st == tt) {
#pragma unroll
                    for (int r = 0; r < 16; ++r) { const int kr = crow(r, h5); const bool keep = dir == 0 ? (kr <= r32) : (kr >= r32); x[r] = keep ? x[r] : 0.f; } }
                  const s16x4 v0l = trr(Lb + VT + tr_perm(lane, dvt, 32 * st, 0)), v0h = trr(Lb + VT + tr_perm(lane, dvt, 32 * st, 1));
                  const s16x4 v1l = trr(Lb + VT + tr_perm(lane, dvt, 32 * st + 16, 0)), v1h = trr(Lb + VT + tr_perm(lane, dvt, 32 * st + 16, 1));
                  u32x4 A0, A1; A0.x = pk2(x[0], x[1]); A0.y = pk2(x[2], x[3]); A0.z = pk2(x[4], x[5]); A0.w = pk2(x[6], x[7]);
                  A1.x = pk2(x[8], x[9]); A1.y = pk2(x[10], x[11]); A1.z = pk2(x[12], x[13]); A1.w = pk2(x[14], x[15]);
                  HG_WAITL();
                  acc = __builtin_amdgcn_mfma_f32_32x32x16_bf16(*reinterpret_cast<bf16x8*>(&A0), pk8(v0l, v0h), acc, 0, 0, 0);
                  acc = __builtin_amdgcn_mfma_f32_32x32x16_bf16(*reinterpret_cast<bf16x8*>(&A1), pk8(v1l, v1h), acc, 0, 0, 0);
                } } }
        }
        LAS float* red = (LAS float*)(L + RED);
#pragma unroll
        for (int r = 0; r < 16; ++r) { float s = acc[r] * acc[r]; s += __shfl_xor(s, 1); s += __shfl_xor(s, 2); s += __shfl_xor(s, 4); s += __shfl_xor(s, 8); s += __shfl_xor(s, 16);
            if (r32 == 0) red[(tt * 32 + crow(r, h5)) * 4 + dvt] = s; }
        __syncthreads();
        const int col = hh * 128 + 32 * dvt + r32; const float wv = nw[32 * dvt + r32];
#pragma unroll
        for (int r = 0; r < 16; ++r) { const int row = 32 * tt + crow(r, h5); const f32x4 p = *(const LAS f32x4*)(red + row * 4);
            const float rstd = 1.0f / sqrtf(((p.x + p.y) + (p.z + p.w)) * (1.0f / 128.0f) + EPS); const size_t o = (R0 + row) * DM + col;
            Y[o] = (bf16_t)f2bf(acc[r] * rstd * wv * bf2f(GH[o])); }
    }
}
template <bool FINAL>
__device__ __forceinline__ void phase_lru(const Ctx& C, int e) {
    using namespace hg;
    LAS unsigned char* L = C.lds;
    constexpr unsigned UCB = 0, UCF = 16384, AT = 49152, BT = 81920;
    const bf16_t* P = WSP(bf16_t, WS_P); float* AG = WSP(float, WS_AG); const float* CARRY = WSP(float, WS_CARRY); bf16_t* Y = WSP(bf16_t, WS_Y);
    const bf16_t* WG = WSP(bf16_t, WS_WG) + (size_t)e * 4 * 128 * 1024;
    const float* cw = C.inp(10) + (size_t)e * 4 * DLRU; const float* cb = C.inp(11) + (size_t)e * DLRU;
    const float* ba = C.inp(13) + (size_t)e * 2 * DLRU; const float* bx = C.inp(15) + (size_t)e * 2 * DLRU; const float* lam = C.inp(16) + (size_t)e * 2 * DLRU;
    const int w = C.wave, lane = C.lane, tid = C.tid, h5 = lane >> 5, r32 = lane & 31;
    const unsigned rt = w >> 2, et = w & 3;
    for (int u = gridDim.x - 1 - blockIdx.x; u < (MROWS / 64) * 8; u += gridDim.x) {
        const int ci2 = u >> 3, hd = u & 7; const int c = ci2 % NCH, bb = ci2 / NCH; const size_t R0 = (size_t)ci2 * 64;
        const int s0 = c * 64, lo = c < 4 ? 0 : CTX, hi = c < 4 ? CTX : SROW;
        __syncthreads();
        float cin = 0.f;
        if (FINAL && tid < 256) { const int dir = tid >> 7, ch = tid & 127; cin = CARRY[(size_t)(ci2 * 2 + dir) * DLRU + hd * 128 + ch]; }
        { const int chn = hd * 128 + 2 * lane; const bf16_t* up = P + DLRU + chn;
          f32x2 uv[11];
#pragma unroll
          for (int i = 0; i < 11; ++i) { const int s = s0 + 8 * w + i - 2; unsigned raw = 0u; if (s >= lo && s < hi) raw = *(const unsigned*)(up + ((size_t)bb * SROW + s) * ABNP);
              uv[i].x = __uint_as_float(raw << 16); uv[i].y = __uint_as_float(raw & 0xffff0000u); }
          f32x2 wj[4];
#pragma unroll
          for (int j = 0; j < 4; ++j) wj[j] = *(const f32x2*)(cw + j * DLRU + chn);
          const f32x2 bias = *(const f32x2*)(cb + chn);
#pragma unroll
          for (int i = 0; i < 8; ++i) { f32x2 a = bias;
#pragma unroll
              for (int j = 0; j < 4; ++j) a += uv[i + j] * wj[j];
              *(LAS unsigned*)(L + UCB + off_b(8 * w + i, lane >> 2) + (lane & 3) * 4) = pk2(a.x, a.y);
              *(LAS f32x2*)(L + UCF + ((8 * w + i) * 128 + 2 * lane) * 4) = a; } }
        __syncthreads();
        bf16x8 af[8]; float ucr[16];
#pragma unroll
        for (int ks = 0; ks < 8; ++ks) af[ks] = *(const LAS bf16x8*)(L + UCB + row_rd(lane, 32 * rt, ks));
#pragma unroll
        for (int r = 0; r < 16; ++r) ucr[r] = *(const LAS float*)(L + UCF + ((32 * rt + crow(r, h5)) * 128 + 32 * et + r32) * 4);
        const int chl = hd * 128 + 32 * et + r32;
#pragma unroll 1
        for (int dir = 0; dir < 2; ++dir) {
            f32x16 ga = {}, gx = {};
            { const bf16_t* wa = WG + ((size_t)(dir * 2 + 0) * 128 + 32 * et + r32) * 1024 + hd * 128 + 8 * h5; const bf16_t* wx = wa + (size_t)128 * 1024;
              bf16x8 fa[8], fx[8];
#pragma unroll
              for (int ks = 0; ks < 8; ++ks) { fa[ks] = *(const bf16x8*)(wa + 16 * ks); fx[ks] = *(const bf16x8*)(wx + 16 * ks); }
#pragma unroll
              for (int ks = 0; ks < 8; ++ks) { ga = __builtin_amdgcn_mfma_f32_32x32x16_bf16(af[ks], fa[ks], ga, 0, 0, 0); gx = __builtin_amdgcn_mfma_f32_32x32x16_bf16(af[ks], fx[ks], gx, 0, 0, 0); } }
            const float bav = ba[dir * DLRU + chl], bxv = bx[dir * DLRU + chl], sp = log1pf(__expf(-lam[dir * DLRU + chl]));
            if (dir == 1) __syncthreads();
#pragma unroll
            for (int r = 0; r < 16; ++r) { const float rg = __builtin_amdgcn_rcpf(1.0f + __expf(-(ga[r] + bav))), ig = __builtin_amdgcn_rcpf(1.0f + __expf(-(gx[r] + bxv)));
                const float la = -8.0f * rg * sp; const unsigned o = ((32 * rt + crow(r, h5)) * 128 + 32 * et + r32) * 4;
                *(LAS float*)(L + AT + o) = __expf(la); *(LAS float*)(L + BT + o) = __builtin_amdgcn_sqrtf(1.0f - __expf(2.0f * la)) * (ig * ucr[r]); }
            __syncthreads();
            if ((tid >> 7) == dir) { const int ch = tid & 127; const LAS float* ap = (const LAS float*)(L + AT) + ch; const LAS float* bp = (const LAS float*)(L + BT) + ch;
                if (!FINAL) { float h = 0.f, ap_ = 1.f;
#pragma unroll 16
                    for (int i = 0; i < 64; ++i) { const int row = dir == 0 ? i : 63 - i; const float a = ap[row * 128]; h = a * h + bp[row * 128]; ap_ *= a; }
                    float* ag = AG + ((size_t)(ci2 * 2 + dir) * 2) * DLRU + hd * 128 + ch; ag[0] = ap_; ag[DLRU] = h; }
                else if (dir == 0) { float h = cin; LAS float* hp = (LAS float*)(L + UCF) + ch;
#pragma unroll 16
                    for (int i = 0; i < 64; ++i) { h = ap[i * 128] * h + bp[i * 128]; hp[i * 128] = h; } }
                else { float h = cin; const LAS float* hp = (const LAS float*)(L + UCF) + ch; const bf16_t* gp = P + R0 * ABNP + hd * 128 + ch; bf16_t* yp = Y + R0 * DM + hd * 128 + ch;
#pragma unroll 8
                    for (int i = 63; i >= 0; --i) { h = ap[i * 128] * h + bp[i * 128]; const float hs = hp[i * 128] + h; yp[(size_t)i * DM] = (bf16_t)f2bf(hs * gelu_tanh(bf2f(gp[(size_t)i * ABNP]))); } } }
        }
    }
}
__device__ __forceinline__ void phase_lru_carry(const Ctx& C) {
    using namespace hg;
    const float* AG = WSP(float, WS_AG); float* CARRY = WSP(float, WS_CARRY);
    const int G = gridDim.x, first = G >= 8 ? G - 8 : 0;
    if ((int)blockIdx.x < first) return;
    for (int id = ((int)blockIdx.x - first) * 512 + C.tid; id < NBATCH * 2 * DLRU; id += (G - first) * 512) { const int b = id >> 11, dir = (id >> 10) & 1, ch = id & 1023;
        float carry = 0.f;
#pragma unroll 4
        for (int j = 0; j < NCH; ++j) { const int cc = dir == 0 ? j : (j < 4 ? 3 - j : 71 - j); const size_t ci2 = (size_t)b * NCH + cc;
            CARRY[(ci2 * 2 + dir) * DLRU + ch] = carry; const float* ag = AG + ((ci2 * 2 + dir) * 2) * DLRU + ch; carry = carry * ag[0] + ag[DLRU]; } }
}
__device__ __forceinline__ void phase_final(const Ctx& C) {
    const float* XS = WSP(float, WS_XS); const float* w = C.inp(27);
    for (int r = C.gw; r < NBATCH * SEQ; r += C.ngw) { const int b = r / SEQ, t = r % SEQ; const size_t R = (size_t)b * SROW + CTX + t;
        const f32x4* xr = (const f32x4*)(XS + R * DM) + C.lane; f32x4 v[8]; float ss = 0.f;
#pragma unroll
        for (int j = 0; j < 8; ++j) { v[j] = xr[64 * j]; ss += (v[j].x * v[j].x + v[j].y * v[j].y) + (v[j].z * v[j].z + v[j].w * v[j].w); }
        const float rstd = 1.0f / sqrtf(wave_sum(ss) * (1.0f / DM) + EPS);
        f32x4* o = (f32x4*)(C.out + (size_t)r * DM) + C.lane;
#pragma unroll
        for (int j = 0; j < 8; ++j) { const f32x4 wv = *(const f32x4*)(w + (C.lane + 64 * j) * 4); o[64 * j] = v[j] * rstd * wv; } }
}

struct Args { const float* in[28]; float* out; unsigned char* ws; int ph_lo, ph_hi; };
constexpr int N_PHASES = 1 + 2 * 9 + 2 * 8 + 1;

__global__ void __launch_bounds__(512, 2) fwd_kernel(Args args) {
    extern __shared__ __attribute__((aligned(16))) unsigned char lds_raw[];
    LAS unsigned char* const lds0 = (LAS unsigned char*)lds_raw;
    const unsigned long long inaddr = (unsigned long long)__builtin_amdgcn_kernarg_segment_ptr();
    volatile LAS unsigned* misc = (volatile LAS unsigned*)(lds0 + LDS_MISC);
    if (threadIdx.x < 64) misc[threadIdx.x] = 0u;
    __syncthreads();
    const int lo = args.ph_lo, hi = args.ph_hi;
    const int wave0 = __builtin_amdgcn_readfirstlane(threadIdx.x >> 6);
    XcdBarrier bar; bar.bar = (unsigned*)(args.ws + WS_CTL) + 4096; bar.x = 0; bar.st = misc + 8;
    if (hi - lo > 1) bar = xcd_barrier_post((unsigned*)(args.ws + WS_CTL) + 4096, misc + 8);
    int pid = 0;
    const unsigned long long wsaddr = (unsigned long long)args.ws;
#define PH_BEGIN if (pid >= lo && pid < hi) { int l = l_; Ctx C; { unsigned long long a_ = inaddr, w_ = wsaddr; int t_; asm volatile("v_mbcnt_lo_u32_b32 %0, -1, 0\n\tv_mbcnt_hi_u32_b32 %0, -1, %0" : "=v"(t_)); t_ += wave0 * 64; asm volatile("" : "+s"(a_), "+s"(w_), "+s"(l)); \
        C.in = (InPtr)a_; C.ws = (unsigned char*)(GAS unsigned char*)w_; C.out = (float*)(GAS float*)args.out; C.lds = lds0; C.tid = t_; C.lane = t_ & 63; C.wave = __builtin_amdgcn_readfirstlane(t_ >> 6); \
        C.gw = blockIdx.x * 8 + C.wave; C.ngw = gridDim.x * 8; C.gtid = blockIdx.x * 512 + t_; C.ngt = gridDim.x * 512; } \
        const int e = l >> 1; const float* mod = WSP(float, WS_MOD) + (size_t)l * 3 * MODW; const int G = gridDim.x, cb = blockIdx.x; (void)e; (void)mod; (void)G; (void)cb;
#define PH_END } if (pid >= lo && pid + 1 < hi) xcd_barrier(bar); ++pid;
#ifndef PROBE_CAT
#define PROBE_CAT -1
#endif
#define DUP(cat, ...) { if (PROBE_CAT == (cat)) { const float SC_ = 0.f; (void)SC_; __VA_ARGS__ } { const float SC_ = 1.f; (void)SC_; __VA_ARGS__ } }
    int l_ = 0;
    PH_BEGIN
#ifndef SKIP_PRO
    DUP(0, phase_prologue(C);)
#endif
    PH_END

    constexpr int MLAT = NBATCH * SEQ;
    for (l_ = 0; l_ < DEPTH; ++l_) {
        PH_BEGIN DUP(1, phase_norm_mod(C, C.inp(6) + l * DM, mod, 0, 1);) PH_END
        if ((l_ & 1) == 0) {
            PH_BEGIN DUP(2, { const bf16_t* wt = WSP(bf16_t, WS_WABIN) + (size_t)e * ABNP * DM;
                       { pg8::Gemm g{WSP(bf16_t, WS_H), wt, MLAT, ABNP, DM, DM, DM, 1}; pg8::StaticOrder S; S.init(MLAT, ABNP, G, cb); EpiBf16Plain E{WSP(bf16_t, WS_P), ABNP}; pg8::gemm_phase(C.lds, C.tid, g, S, E); }
                       DUP(14, { sg::SGemm g{WSP(bf16_t, WS_H), wt, ABNP, DM, DM, DM}; SEpiPlain E{WSP(bf16_t, WS_P), ABNP}; sg::sgemm_phase(C.lds, C.tid, g, 32 * (ABNP / 256), E); }) }) PH_END
            PH_BEGIN DUP(3, { phase_lru<false>(C, e); phase_rs_kr(C); }) PH_END
            PH_BEGIN phase_lru_carry(C); DUP(4, { const bf16_t* wq = WSP(bf16_t, WS_WUQ) + (size_t)e * QW * 512; const bf16_t* wkv = WSP(bf16_t, WS_WUKV) + (size_t)e * KVW * 512;
                       { pg8::Gemm g{WSP(bf16_t, WS_P) + 2048, wq, MLAT, QW, 512, ABNP, 512, 1}; pg8::StaticOrder S; S.init(MLAT, QW, G, cb); EpiBf16RowScale E{WSP(bf16_t, WS_Q), QW, WSP(float, WS_RSQ)}; pg8::gemm_phase(C.lds, C.tid, g, S, E); }
                       { pg8::Gemm g{WSP(bf16_t, WS_P) + 2560, wkv, MLAT, KVW, 512, ABNP, 512, 1}; pg8::StaticOrder S; S.init(MLAT, KVW, G, cb); EpiBf16RowScale E{WSP(bf16_t, WS_KV), KVW, WSP(float, WS_RSKV)}; pg8::gemm_phase(C.lds, C.tid, g, S, E); }
                       DUP(14, { sg::SGemm g{WSP(bf16_t, WS_P) + 2048, wq, QW, 512, ABNP, 512}; SEpiRowScale E{WSP(bf16_t, WS_Q), QW, WSP(float, WS_RSQ)}; sg::sgemm_phase(C.lds, C.tid, g, 32 * (QW / 256), E); })
                       DUP(14, { sg::SGemm g{WSP(bf16_t, WS_P) + 2560, wkv, KVW, 512, ABNP, 512}; SEpiRowScale E{WSP(bf16_t, WS_KV), KVW, WSP(float, WS_RSKV)}; sg::sgemm_phase(C.lds, C.tid, g, 0, E); }) })
            PH_END
            PH_BEGIN DUP(5, phase_lru<true>(C, e);) DUP(6, phase_attn(C);) PH_END
        } else {
            PH_BEGIN DUP(7, { const bf16_t* wt = WSP(bf16_t, WS_WHGIN) + (size_t)e * HGN * DM;
                       { pg8::Gemm g{WSP(bf16_t, WS_H), wt, MLAT, HGN, DM, DM, DM, 1}; pg8::StaticOrder S; S.init(MLAT, HGN, G, cb); EpiHG E{WSP(bf16_t, WS_QH), WSP(float, WS_LOGF), WSP(float, WS_LB) + l * 2048}; pg8::gemm_phase(C.lds, C.tid, g, S, E); }
                       DUP(14, { sg::SGemm g{WSP(bf16_t, WS_H), wt, HGN, DM, DM, DM}; SEpiHG E{WSP(bf16_t, WS_QH), WSP(float, WS_LOGF), WSP(float, WS_LB) + l * 2048}; sg::sgemm_phase(C.lds, C.tid, g, 32 * (HGN / 256), E); }) }) PH_END
            PH_BEGIN DUP(8, phase_hg_state(C);) PH_END
            PH_BEGIN DUP(10, phase_hg_out(C, e);) PH_END
        }
        PH_BEGIN DUP(11, { const bf16_t* wout = (l & 1) ? WSP(bf16_t, WS_WHGOUT) + (size_t)e * DM * DM : WSP(bf16_t, WS_WABOUT) + (size_t)e * DM * DM;
                   { pg8::Gemm g{WSP(bf16_t, WS_Y), wout, MLAT, DM, DM, DM, DM, 1}; pg8::StaticOrder S; S.init(MLAT, DM, G, cb); EpiResid E{WSP(float, WS_XS), mod + 2 * DM, SC_}; pg8::gemm_phase(C.lds, C.tid, g, S, E); }
                   if (l != DEPTH - 1) DUP(14, { sg::SGemm g{WSP(bf16_t, WS_Y), wout, DM, DM, DM, DM}; SEpiResid E{WSP(float, WS_XS), mod + 2 * DM, SC_}; sg::sgemm_phase(C.lds, C.tid, g, 32 * (DM / 256), E); }) }) PH_END
        PH_BEGIN DUP(1, phase_norm_mod(C, C.inp(7) + l * DM, mod, 3, 4);) PH_END
        PH_BEGIN DUP(12, { const bf16_t* wt = WSP(bf16_t, WS_W1) + (size_t)l * DFF * DM;
                   { pg8::Gemm g{WSP(bf16_t, WS_H), wt, MLAT, DFF, DM, DM, DM, 1}; pg8::StaticOrder S; S.init(MLAT, DFF, G, cb); EpiRelu2 E{WSP(bf16_t, WS_HID), DFF}; pg8::gemm_phase(C.lds, C.tid, g, S, E); }
                   if (l != DEPTH - 1) DUP(16, { sg::SGemm g{WSP(bf16_t, WS_H), wt, DFF, DM, DM, DM}; SEpiRelu2 E{WSP(bf16_t, WS_HID), DFF}; sg::sgemm_phase(C.lds, C.tid, g, 32 * (DFF / 256), E); }) }) PH_END
        PH_BEGIN DUP(13, { const bf16_t* wt = WSP(bf16_t, WS_W2) + (size_t)l * DM * DFF;
                   { pg8::Gemm g{WSP(bf16_t, WS_HID), wt, MLAT, DM, DFF, DFF, DFF, 1}; pg8::StaticOrder S; S.init(MLAT, DM, G, cb); EpiResid E{WSP(float, WS_XS), mod + 5 * DM, SC_}; pg8::gemm_phase(C.lds, C.tid, g, S, E); }
                   if (l != DEPTH - 1) DUP(15, { sg::SGemm g{WSP(bf16_t, WS_HID), wt, DM, DFF, DFF, DFF}; SEpiResid E{WSP(float, WS_XS), mod + 5 * DM, SC_}; sg::sgemm_phase(C.lds, C.tid, g, 32 * (DM / 256), E); }) }) PH_END
    }
    l_ = 0;
    PH_BEGIN phase_final(C); PH_END
}

#ifndef N_LAUNCH_MODE
#define N_LAUNCH_MODE 1
#endif
extern "C" void kernel_launch(void* const* d_in, const int* in_sizes, int n_in, void* d_out, int out_size, void* d_ws, size_t ws_size, hipStream_t stream) {
    static int grid = 0;
    if (grid == 0) {
        if (n_in != 28 || out_size != NBATCH * SEQ * DM || ws_size < WS_END) { fprintf(stderr, "kernel_launch: shape mismatch n_in %d out %d ws %zu (need %zu)\n", n_in, out_size, ws_size, (size_t)WS_END); grid = -1; return; }
        int dev = 0, cus = 0, per_cu = 0;
        if (hipGetDevice(&dev) != hipSuccess || hipDeviceGetAttribute(&cus, hipDeviceAttributeMultiprocessorCount, dev) != hipSuccess) { grid = -1; return; }
        if (hipFuncSetAttribute((const void*)fwd_kernel, hipFuncAttributeMaxDynamicSharedMemorySize, LDS_BYTES) != hipSuccess) { fprintf(stderr, "kernel_launch: hipFuncSetAttribute failed\n"); grid = -1; return; }
        if (hipOccupancyMaxActiveBlocksPerMultiprocessor(&per_cu, (const void*)fwd_kernel, 512, LDS_BYTES) != hipSuccess || per_cu < 1) fprintf(stderr, "kernel_launch: occupancy query says %d\n", per_cu);
        (void)hipGetLastError();
        grid = cus;
    }
    if (grid < 0) return;
    (void)hipMemsetAsync((char*)d_ws + WS_CTL, 0, CTL_BYTES, stream);
    Args a{};
    for (int i = 0; i < 28; ++i) a.in[i] = (const float*)d_in[i];
    a.out = (float*)d_out; a.ws = (unsigned char*)d_ws;
#if N_LAUNCH_MODE == 1
    a.ph_lo = 0; a.ph_hi = N_PHASES;
    hipLaunchKernelGGL(fwd_kernel, dim3(grid), dim3(512), LDS_BYTES, stream, a);
#else
    for (int p = 0; p < N_PHASES; ++p) { a.ph_lo = p; a.ph_hi = p + 1; hipLaunchKernelGGL(fwd_kernel, dim3(grid), dim3(512), LDS_BYTES, stream, a); }
#endif
    const hipError_t le = hipPeekAtLastError();
    if (le != hipSuccess) fprintf(stderr, "kernel_launch: launch failed: %s\n", hipGetErrorName(le));
}
```

```cpp
#include <hip/hip_runtime.h>
#include <cstdio>

#define LAS __attribute__((address_space(3)))
#define GAS __attribute__((address_space(1)))
typedef unsigned short bf16_t;
typedef short bf16x8 __attribute__((ext_vector_type(8)));
typedef float f32x4 __attribute__((ext_vector_type(4)));
typedef float f32x2 __attribute__((ext_vector_type(2)));
typedef unsigned u32x4 __attribute__((ext_vector_type(4)));
typedef unsigned u32x2 __attribute__((ext_vector_type(2)));

constexpr int DM = 2048, NBATCH = 2, SEQ = 4096, DEPTH = 4, CTX = 256;
constexpr int SROW = CTX + SEQ;
constexpr int MROWS = NBATCH * SROW;
constexpr int DFF = 8192, MODW = 6 * DM;
constexpr int DLRU = 1024;
constexpr int ABN = 3136, ABNP = 3328;
constexpr int QW = 1536, KVW = 2048, HGN = 10240;
constexpr float EPS = 1e-6f;
constexpr float ATTN_SCALE = 0.07216878364870322f;

constexpr size_t al256(size_t x) { return (x + 255) & ~(size_t)255; }
constexpr size_t WS_CTL = 0, CTL_BYTES = 1u << 20;
constexpr size_t WS_MOD = WS_CTL + CTL_BYTES;
constexpr size_t WS_LB = WS_MOD + al256((size_t)DEPTH * 3 * MODW * 4);
constexpr size_t WS_ROPE = WS_LB + al256((size_t)DEPTH * 2048 * 4);
constexpr size_t WS_RSQ = WS_ROPE + al256(2 * 64 * 16 * 4);
constexpr size_t WS_RSKV = WS_RSQ + al256((size_t)MROWS * 4);
constexpr size_t WS_WABIN = WS_RSKV + al256((size_t)MROWS * 4);
constexpr size_t WS_WABOUT = WS_WABIN + (size_t)2 * ABNP * DM * 2;
constexpr size_t WS_WUQ = WS_WABOUT + (size_t)2 * DM * DM * 2;
constexpr size_t WS_WUKV = WS_WUQ + (size_t)2 * QW * 512 * 2;
constexpr size_t WS_WHGIN = WS_WUKV + (size_t)2 * KVW * 512 * 2;
constexpr size_t WS_WHGOUT = WS_WHGIN + (size_t)2 * HGN * DM * 2;
constexpr size_t WS_W1 = WS_WHGOUT + (size_t)2 * DM * DM * 2;
constexpr size_t WS_W2 = WS_W1 + (size_t)4 * DFF * DM * 2;
constexpr size_t WS_WG = WS_W2 + (size_t)4 * DFF * DM * 2;
constexpr size_t WS_XS = WS_WG + (size_t)2 * 4 * 128 * 1024 * 2;
constexpr size_t WS_H = WS_XS + (size_t)MROWS * DM * 4;
constexpr size_t WS_Y = WS_H + (size_t)MROWS * DM * 2;
constexpr size_t WS_BIG = WS_Y + (size_t)MROWS * DM * 2;
constexpr size_t WS_P = WS_BIG;
constexpr size_t WS_AG = WS_P + (size_t)MROWS * ABNP * 2;
constexpr size_t WS_CARRY = WS_AG + al256((size_t)(MROWS / 64) * 2 * 2 * DLRU * 4);
constexpr size_t WS_Q = WS_CARRY + al256((size_t)(MROWS / 64) * 2 * DLRU * 4);
constexpr size_t WS_KV = WS_Q + (size_t)MROWS * QW * 2;
constexpr size_t WS_KR = WS_KV + (size_t)MROWS * KVW * 2;
constexpr size_t WS_AB_END = WS_KR + (size_t)MROWS * 64 * 2;
constexpr size_t WS_QH = WS_BIG;
constexpr size_t WS_VH = WS_QH + (size_t)MROWS * DM * 2;
constexpr size_t WS_GH = WS_VH + (size_t)MROWS * DM * 2;
constexpr size_t WS_LOGF = WS_GH + (size_t)MROWS * DM * 2;
constexpr size_t WS_SS = WS_LOGF + (size_t)2 * MROWS * DM * 4;
constexpr size_t WS_HG_END = WS_SS + (size_t)64 * 68 * 16384 * 2;
constexpr size_t WS_HID = WS_BIG;
constexpr size_t WS_MLP_END = WS_HID + (size_t)MROWS * DFF * 2;
constexpr size_t cmax(size_t a, size_t b) { return a > b ? a : b; }
constexpr size_t WS_END = cmax(cmax(WS_AB_END, WS_HG_END), WS_MLP_END);

constexpr int LDS_BYTES = 147456;
constexpr int LDS_MISC = 139264;

__device__ __forceinline__ float bf2f(bf16_t v) { return __uint_as_float(((unsigned)v) << 16); }
__device__ __forceinline__ unsigned f2bf(float f) { unsigned u = __float_as_uint(f); return (u + 0x7fffu + ((u >> 16) & 1u)) >> 16; }
__device__ __forceinline__ unsigned pk2(float lo, float hi) { return f2bf(lo) | (f2bf(hi) << 16); }
__device__ __forceinline__ float wave_sum(float v) {
#pragma unroll
    for (int o = 1; o < 64; o <<= 1) v += __shfl_xor(v, o);
    return v;
}
__device__ __forceinline__ float wave_max(float v) {
#pragma unroll
    for (int o = 1; o < 64; o <<= 1) v = fmaxf(v, __shfl_xor(v, o));
    return v;
}
__device__ __forceinline__ float sigmoidf_(float x) { return 1.0f / (1.0f + expf(-x)); }
__device__ __forceinline__ float siluf_(float x) { return x / (1.0f + expf(-x)); }
__device__ __forceinline__ float fsigmoid(float x) { return __builtin_amdgcn_rcpf(1.0f + __expf(-x)); }
__device__ __forceinline__ float gelu_tanh(float x) { const float u = 0.7978845608028654f * (x + 0.044715f * x * x * x); return x * fsigmoid(2.0f * u); }

#define XB_TMO      128
#define XB_XCNT(j)  (256  + 64 * (j))
#define XB_XSUB(j)  (1280 + 64 * (j))
#define XB_XGEN(j)  (2304 + 64 * (j))
#define XB_TOP      3328
#define XB_TOPGEN   3392
#define XCD_BAR_WORDS 3456
#define XB_SPIN_CAP (1u << 18)
__device__ __forceinline__ unsigned xb_ld(unsigned* p)              { return __hip_atomic_load(p, __ATOMIC_RELAXED, __HIP_MEMORY_SCOPE_AGENT); }
__device__ __forceinline__ unsigned xb_add(unsigned* p, unsigned v) { return __hip_atomic_fetch_add(p, v, __ATOMIC_RELAXED, __HIP_MEMORY_SCOPE_AGENT); }
__device__ __forceinline__ unsigned xb_xcc_id() { return (unsigned)__builtin_amdgcn_s_getreg((3 << 11) | 20) & 0xFu; }
#define XB_SPIN(cond, bar) do { unsigned _sp = 0; while (cond) { __builtin_amdgcn_s_sleep(1); \
    if ((++_sp & 255u) == 0u) { if (xb_ld(&(bar)[XB_TMO])) break; if (_sp > XB_SPIN_CAP) { atomicAdd(&(bar)[XB_TMO], 1u); break; } } } } while (0)
struct XcdBarrier { unsigned* bar; unsigned x; volatile LAS unsigned* st; };
__device__ __forceinline__ XcdBarrier xcd_barrier_post(unsigned* bar, volatile LAS unsigned* st) {
    XcdBarrier b; b.bar = bar; b.x = xb_xcc_id(); b.st = st;
    if (threadIdx.x == 0) (void)xb_add(&bar[XB_XCNT(b.x)], 1u);
    return b;
}
__device__ __forceinline__ void xcd_barrier_complete(unsigned* bar, unsigned x, unsigned& nloc, unsigned& nx) {
    const unsigned G = gridDim.x * gridDim.y * gridDim.z;
    unsigned sum, cnt, mine, sp = 0u;
    for (;;) {
        sum = 0u; cnt = 0u; mine = 0u;
#pragma unroll
        for (unsigned j = 0; j < 16; ++j) { const unsigned c = xb_ld(&bar[XB_XCNT(j)]); sum += c; cnt += (c > 0u) ? 1u : 0u; mine = (j == x) ? c : mine; }
        if (sum == G) break;
        __builtin_amdgcn_s_sleep(1);
        if ((++sp & 255u) == 0u) { if (xb_ld(&bar[XB_TMO])) break; if (sp > XB_SPIN_CAP) { atomicAdd(&bar[XB_TMO], 1u); break; } }
    }
    nloc = mine > 0u ? mine : 1u; nx = cnt > 0u ? cnt : 1u;
}
__device__ __forceinline__ void xcd_barrier(const XcdBarrier& b) {
    asm volatile("s_waitcnt vmcnt(0)" ::: "memory");
    __syncthreads();
    if (threadIdx.x == 0) {
        unsigned* bar = b.bar; asm volatile("" : "+s"(bar)); bar = (unsigned*)(GAS unsigned*)bar;
        __builtin_amdgcn_s_waitcnt(0);
        unsigned nloc = b.st[0], nx = b.st[1];
        if (nloc == 0u) { xcd_barrier_complete(bar, b.x, nloc, nx); b.st[0] = nloc; b.st[1] = nx; }
        const unsigned old = xb_add(&bar[XB_XSUB(b.x)], 1u);
        const unsigned gen = old / nloc;
        if (old + 1u == (gen + 1u) * nloc) {
            __builtin_amdgcn_fence(__ATOMIC_RELEASE, "agent");
            asm volatile("s_waitcnt vmcnt(0)" ::: "memory");
            const unsigned og = xb_add(&bar[XB_TOP], 1u);
            const unsigned tg = og / nx;
            if (og + 1u == (tg + 1u) * nx) xb_add(&bar[XB_TOPGEN], 1u);
            else XB_SPIN(xb_ld(&bar[XB_TOPGEN]) == tg, bar);
            __builtin_amdgcn_fence(__ATOMIC_ACQUIRE, "agent");
            xb_add(&bar[XB_XGEN(b.x)], 1u);
            asm volatile("s_waitcnt vmcnt(0)" ::: "memory");
        } else {
            XB_SPIN(xb_ld(&bar[XB_XGEN(b.x)]) == gen, bar);
            __builtin_amdgcn_fence(__ATOMIC_ACQUIRE, "agent");
            asm volatile("s_waitcnt vmcnt(0)" ::: "memory");
        }
    }
    __syncthreads();
}

namespace pg8 {
constexpr int BM = 256, BK = 64, HALF = 128, HTB = HALF * BK * 2, STAGE_BYTES = 8 * HTB, NXCD = 8, WGM = 8;
__host__ __device__ __forceinline__ int lds_byte(int r, int c) { const int st = (r >> 4) * 2 + (c >> 5), rr = r & 15, cc = c & 31, ob = rr * 64 + cc * 2; return st * 1024 + (ob ^ (((ob >> 9) & 1) << 5)); }
__host__ __device__ __forceinline__ void stage_rc(int b, int& R, int& C) { const int st = b / 1024, sb = b % 1024, swz = sb ^ (((sb >> 9) & 1) << 5); R = (st >> 1) * 16 + swz / 64; C = (st & 1) * 32 + (swz % 64) / 2; }
__host__ __device__ __forceinline__ int perm32(int rho) { const int n = rho >> 4, i = rho & 15; return 8 * (i >> 2) + 4 * n + (i & 3); }
struct Unit { int pm, pn; };
struct Gemm { const bf16_t* A; const bf16_t* Bt; int M, N, K, lda, ldb, lat; };
struct StaticOrder {
    int nM, nN, nwg, G, c;
    __host__ __device__ void init(int M, int N, int G_, int c_) { nM = M / BM; nN = N / BM; nwg = nM * nN; G = G_; c = c_; }
    __host__ __device__ bool next(int i, Unit& u) const {
        const long L = (long)i * G + c; if (L >= nwg) return false;
        int wgid = (int)L; { const int q = nwg / NXCD, r = nwg % NXCD, xcd = wgid % NXCD, off = wgid / NXCD; wgid = (xcd < r ? xcd * (q + 1) : r * (q + 1) + (xcd - r) * q) + off; }
        const int nig = WGM * nN, gid = wgid / nig, fm = gid * WGM, gsz = (nM - fm) < WGM ? (nM - fm) : WGM;
        u.pm = fm + ((wgid % nig) % gsz); u.pn = (wgid % nig) / gsz; return true;
    }
};
__device__ __forceinline__ unsigned cvt_pk_bf16(float lo, float hi) { unsigned r; asm volatile("v_cvt_pk_bf16_f32 %0, %1, %2" : "=v"(r) : "v"(lo), "v"(hi)); return r; }

template <class Epi>
__device__ __forceinline__ void gemm_phase(LAS unsigned char* lds, const int tid, const Gemm g, const StaticOrder& S, const Epi& E) {
    const int wid = __builtin_amdgcn_readfirstlane(tid >> 6), lane = tid & 63, wr = wid >> 2, wc = wid & 3, fr = lane & 15, fq = lane >> 4;
    const int K = g.K, nt = K / BK;
    unsigned voffA[2], voffB[2];
#pragma unroll
    for (int i = 0; i < 2; ++i) { int R, C; stage_rc(tid * 16 + i * 8192, R, C); const int Rb = Epi::PERM ? ((R & ~31) + perm32(R & 31)) : R;
        voffA[i] = (unsigned)(R * g.lda + C) * 2u; voffB[i] = (unsigned)(Rb * g.ldb + C) * 2u; }
    const size_t kstep = (size_t)(BK * 2);
    const size_t hsA = (size_t)HALF * g.lda * 2, hsB = (size_t)HALF * g.ldb * 2;
    const size_t tsA = 2 * hsA, tsB = 2 * hsB;
    const unsigned ldsw = (unsigned)wid * 1024u;
    const int aoff = lds_byte(wr * 64 + fr, fq * 8), boff = lds_byte(wc * 32 + fr, fq * 8);
#define PG8_SA(b, h) (((b) * 2 + (h)) * HTB)
#define PG8_SB(b, h) ((4 + (b) * 2 + (h)) * HTB)
#define PG8_STAGE(bufoff, gbase, voff) do { _Pragma("unroll") for (int _i = 0; _i < 2; ++_i) \
        __builtin_amdgcn_global_load_lds((const unsigned*)((const char*)(gbase) + (voff)[_i]), (LAS unsigned*)(lds + (bufoff) + ldsw + _i * 8192), 16, 0, 0); } while (0)
#define PG8_LDA(dst, b, h) do { _Pragma("unroll") for (int m = 0; m < 4; ++m) _Pragma("unroll") for (int k = 0; k < 2; ++k) dst[m][k] = *(const LAS bf16x8*)(lds + PG8_SA(b, h) + aoff + m * 2048 + k * 1024); } while (0)
#define PG8_LDB(dst, b, h) do { _Pragma("unroll") for (int n = 0; n < 2; ++n) _Pragma("unroll") for (int k = 0; k < 2; ++k) dst[n][k] = *(const LAS bf16x8*)(lds + PG8_SB(b, h) + boff + n * 2048 + k * 1024); } while (0)
#define PG8_MMA(ai, bj, At, Bt) do { __builtin_amdgcn_s_setprio(1); _Pragma("unroll") for (int m = 0; m < 4; ++m) _Pragma("unroll") for (int n = 0; n < 2; ++n) _Pragma("unroll") for (int k = 0; k < 2; ++k) \
        acc[ai][bj][m][n] = __builtin_amdgcn_mfma_f32_16x16x32_bf16(Bt[n][k], At[m][k], acc[ai][bj][m][n], 0, 0, 0); __builtin_amdgcn_s_setprio(0); } while (0)
#define PG8_WAIT_V(n) asm volatile("s_waitcnt vmcnt(" #n ")" ::: "memory")
#define PG8_WAIT_L(n) asm volatile("s_waitcnt lgkmcnt(" #n ")" ::: "memory")
#define PG8_BAR __builtin_amdgcn_s_barrier()
#define PG8_SCHED __builtin_amdgcn_sched_barrier(0)
    Unit cur, nxt; int ui = 0;
    if (!S.next(0, cur)) return;
    if (g.lat) cur.pm += (cur.pm >> 4) + 1;
    f32x4 acc[2][2][4][2];
#pragma unroll
    for (int a = 0; a < 2; ++a)
#pragma unroll
        for (int b = 0; b < 2; ++b)
#pragma unroll
            for (int m = 0; m < 4; ++m)
#pragma unroll
                for (int n = 0; n < 2; ++n) acc[a][b][m][n] = (f32x4){0.f, 0.f, 0.f, 0.f};
    bf16x8 At[4][2], B0[2][2], B1[2][2];
    const char* cA = (const char*)g.A + (size_t)cur.pm * tsA; const char* cB = (const char*)g.Bt + (size_t)cur.pn * tsB;
    PG8_STAGE(PG8_SB(0, 0), cB, voffB); PG8_STAGE(PG8_SA(0, 0), cA, voffA); PG8_STAGE(PG8_SB(0, 1), cB + hsB, voffB); PG8_STAGE(PG8_SA(0, 1), cA + hsA, voffA);
    if (wr == 1) PG8_BAR;
    PG8_WAIT_V(4); PG8_BAR;
    PG8_STAGE(PG8_SB(1, 0), cB + kstep, voffB); PG8_STAGE(PG8_SA(1, 0), cA + kstep, voffA); PG8_STAGE(PG8_SB(1, 1), cB + hsB + kstep, voffB);
    PG8_WAIT_V(6); PG8_BAR;
    for (;;) {
        const bool has_next = S.next(ui + 1, nxt);
        if (g.lat && has_next) nxt.pm += (nxt.pm >> 4) + 1;
        const char* nA = has_next ? (const char*)g.A + (size_t)nxt.pm * tsA : cA; const char* nB = has_next ? (const char*)g.Bt + (size_t)nxt.pn * tsB : cB;
        for (int t = 0; t < nt; t += 2) {
            const bool last = (t == nt - 2);
            const char* a1 = cA + (size_t)(t + 1) * kstep;
            const char* a2 = last ? nA : cA + (size_t)(t + 2) * kstep; const char* b2 = last ? nB : cB + (size_t)(t + 2) * kstep;
            const char* a3 = a2 + kstep; const char* b3 = b2 + kstep;
            PG8_LDB(B0, 0, 0); PG8_SCHED; PG8_LDA(At, 0, 0); PG8_STAGE(PG8_SA(1, 1), a1 + hsA, voffA);
            PG8_WAIT_L(8); PG8_BAR; PG8_WAIT_L(0); PG8_MMA(0, 0, At, B0); PG8_BAR; PG8_SCHED;
            PG8_LDB(B1, 0, 1); PG8_STAGE(PG8_SB(0, 0), b2, voffB);
            PG8_BAR; PG8_WAIT_L(0); PG8_MMA(0, 1, At, B1); PG8_BAR;
            PG8_LDA(At, 0, 1); PG8_STAGE(PG8_SA(0, 0), a2, voffA);
            PG8_BAR; PG8_WAIT_L(0); PG8_MMA(1, 0, At, B0); PG8_BAR; PG8_SCHED;
            PG8_STAGE(PG8_SB(0, 1), b2 + hsB, voffB);
            PG8_WAIT_V(6); PG8_BAR; PG8_MMA(1, 1, At, B1); PG8_BAR;
            PG8_LDB(B0, 1, 0); PG8_SCHED; PG8_LDA(At, 1, 0); PG8_STAGE(PG8_SA(0, 1), a2 + hsA, voffA);
            PG8_WAIT_L(8); PG8_BAR; PG8_WAIT_L(0); PG8_MMA(0, 0, At, B0); PG8_BAR; PG8_SCHED;
            PG8_LDB(B1, 1, 1); PG8_STAGE(PG8_SB(1, 0), b3, voffB);
            PG8_BAR; PG8_WAIT_L(0); PG8_MMA(0, 1, At, B1); PG8_BAR;
            PG8_LDA(At, 1, 1); PG8_STAGE(PG8_SA(1, 0), a3, voffA);
            PG8_BAR; PG8_WAIT_L(0); PG8_MMA(1, 0, At, B0); PG8_BAR; PG8_SCHED;
            PG8_STAGE(PG8_SB(1, 1), b3 + hsB, voffB);
            PG8_WAIT_V(6); PG8_BAR; PG8_MMA(1, 1, At, B1); PG8_BAR;
        }
        E(acc, cur, wr, wc, fr, fq);
        if (!has_next) break;
#pragma unroll
        for (int a = 0; a < 2; ++a)
#pragma unroll
            for (int b = 0; b < 2; ++b)
#pragma unroll
                for (int m = 0; m < 4; ++m)
#pragma unroll
                    for (int n = 0; n < 2; ++n) acc[a][b][m][n] = (f32x4){0.f, 0.f, 0.f, 0.f};
        cur = nxt; cA = nA; cB = nB; ++ui;
    }
    PG8_WAIT_V(0);
    if (wr == 0) PG8_BAR;
    PG8_BAR;
#undef PG8_SA
#undef PG8_SB
#undef PG8_STAGE
#undef PG8_LDA
#undef PG8_LDB
#undef PG8_MMA
#undef PG8_WAIT_V
#undef PG8_WAIT_L
#undef PG8_BAR
#undef PG8_SCHED
}
}

#define EPI_ROWS_COLS_PERM \
    const int row0 = u.pm * 256 + wr * 64 + fr; const int col0 = u.pn * 256 + wc * 32 + 8 * fq;
struct EpiBf16Plain {
    static constexpr bool PERM = true;
    bf16_t* O; int ldc;
    __device__ __forceinline__ void operator()(const f32x4 (&acc)[2][2][4][2], const pg8::Unit& u, int wr, int wc, int fr, int fq) const {
        EPI_ROWS_COLS_PERM
#pragma unroll
        for (int ai = 0; ai < 2; ++ai)
#pragma unroll
            for (int m = 0; m < 4; ++m) { bf16_t* rowp = O + (size_t)(row0 + ai * 128 + m * 16) * ldc + col0;
#pragma unroll
                for (int bj = 0; bj < 2; ++bj) { const f32x4 v0 = acc[ai][bj][m][0], v1 = acc[ai][bj][m][1];
                    u32x4 w; w.x = pk2(v0[0], v0[1]); w.y = pk2(v0[2], v0[3]); w.z = pk2(v1[0], v1[1]); w.w = pk2(v1[2], v1[3]);
                    *(u32x4*)(rowp + bj * 128) = w; } }
    }
};
struct EpiBf16RowScale {
    static constexpr bool PERM = true;
    bf16_t* O; int ldc; const float* rs;
    __device__ __forceinline__ void operator()(const f32x4 (&acc)[2][2][4][2], const pg8::Unit& u, int wr, int wc, int fr, int fq) const {
        EPI_ROWS_COLS_PERM
#pragma unroll
        for (int ai = 0; ai < 2; ++ai)
#pragma unroll
            for (int m = 0; m < 4; ++m) { const int row = row0 + ai * 128 + m * 16; const float s = rs[row]; bf16_t* rowp = O + (size_t)row * ldc + col0;
#pragma unroll
                for (int bj = 0; bj < 2; ++bj) { const f32x4 v0 = acc[ai][bj][m][0] * s, v1 = acc[ai][bj][m][1] * s;
                    u32x4 w; w.x = pk2(v0[0], v0[1]); w.y = pk2(v0[2], v0[3]); w.z = pk2(v1[0], v1[1]); w.w = pk2(v1[2], v1[3]);
                    *(u32x4*)(rowp + bj * 128) = w; } }
    }
};
struct EpiRelu2 {
    static constexpr bool PERM = true;
    bf16_t* O; int ldc;
    __device__ __forceinline__ void operator()(const f32x4 (&acc)[2][2][4][2], const pg8::Unit& u, int wr, int wc, int fr, int fq) const {
        EPI_ROWS_COLS_PERM
#pragma unroll
        for (int ai = 0; ai < 2; ++ai)
#pragma unroll
            for (int m = 0; m < 4; ++m) { bf16_t* rowp = O + (size_t)(row0 + ai * 128 + m * 16) * ldc + col0;
#pragma unroll
                for (int bj = 0; bj < 2; ++bj) { f32x4 v0 = acc[ai][bj][m][0], v1 = acc[ai][bj][m][1];
#pragma unroll
                    for (int j = 0; j < 4; ++j) { const float a = fmaxf(v0[j], 0.f), b = fmaxf(v1[j], 0.f); v0[j] = a * a; v1[j] = b * b; }
                    u32x4 w; w.x = pk2(v0[0], v0[1]); w.y = pk2(v0[2], v0[3]); w.z = pk2(v1[0], v1[1]); w.w = pk2(v1[2], v1[3]);
                    *(u32x4*)(rowp + bj * 128) = w; } }
    }
};
struct EpiResid {
    static constexpr bool PERM = false;
    float* XS; const float* gate; float scale;
    __device__ __forceinline__ void operator()(const f32x4 (&acc)[2][2][4][2], const pg8::Unit& u, int wr, int wc, int fr, int fq) const {
        const int row0 = u.pm * 256 + wr * 64 + fr, col0 = u.pn * 256 + wc * 32 + 4 * fq;
        const int cond = (u.pm % 17 == 0) ? 2 : (u.pm / 17);
        const float* gp = gate + (size_t)cond * MODW + col0;
        f32x4 gv[2][2];
#pragma unroll
        for (int bj = 0; bj < 2; ++bj)
#pragma unroll
            for (int n = 0; n < 2; ++n) gv[bj][n] = *(const f32x4*)(gp + bj * 128 + n * 16) * scale;
#pragma unroll
        for (int ai = 0; ai < 2; ++ai)
#pragma unroll
            for (int m = 0; m < 4; ++m) { float* rowp = XS + (size_t)(row0 + ai * 128 + m * 16) * DM + col0;
#pragma unroll
                for (int bj = 0; bj < 2; ++bj)
#pragma unroll
                    for (int n = 0; n < 2; ++n) { f32x4* p = (f32x4*)(rowp + bj * 128 + n * 16); *p = *p + gv[bj][n] * acc[ai][bj][m][n]; } }
    }
};
struct EpiHG {
    static constexpr bool PERM = true;
    bf16_t* QVG; float* LOGF; const float* lb;
    __device__ __forceinline__ void operator()(const f32x4 (&acc)[2][2][4][2], const pg8::Unit& u, int wr, int wc, int fr, int fq) const {
        const int row0 = u.pm * 256 + wr * 64 + fr; const int seg = u.pn >> 3; const int col0 = (u.pn & 7) * 256 + wc * 32 + 8 * fq;
        if (seg == 1 || seg == 2) {
            float* base = LOGF + (size_t)(seg - 1) * MROWS * DM;
            f32x4 lbv[2][2];
#pragma unroll
            for (int bj = 0; bj < 2; ++bj)
#pragma unroll
                for (int n = 0; n < 2; ++n) lbv[bj][n] = *(const f32x4*)(lb + col0 + bj * 128 + 4 * n);
#pragma unroll
            for (int ai = 0; ai < 2; ++ai)
#pragma unroll
                for (int m = 0; m < 4; ++m) { float* rowp = base + (size_t)(row0 + ai * 128 + m * 16) * DM + col0;
#pragma unroll
                    for (int bj = 0; bj < 2; ++bj)
#pragma unroll
                        for (int n = 0; n < 2; ++n) { f32x4 v = acc[ai][bj][m][n];
#pragma unroll
                            for (int j = 0; j < 4; ++j) { const float l = lbv[bj][n][j]; v[j] = __logf(l + (1.0f - l) * fsigmoid(v[j])); }
                            *(f32x4*)(rowp + bj * 128 + 4 * n) = v; } }
        } else {
            const int bi = seg - 2 + (seg == 0 ? 2 : 0);
            bf16_t* base = QVG + (size_t)bi * MROWS * DM;
            const bool act = (seg != 3);
#pragma unroll
            for (int ai = 0; ai < 2; ++ai)
#pragma unroll
                for (int m = 0; m < 4; ++m) { bf16_t* rowp = base + (size_t)(row0 + ai * 128 + m * 16) * DM + col0;
#pragma unroll
                    for (int bj = 0; bj < 2; ++bj) { f32x4 v0 = acc[ai][bj][m][0], v1 = acc[ai][bj][m][1];
                        if (act) {
#pragma unroll
                            for (int j = 0; j < 4; ++j) { v0[j] = v0[j] * fsigmoid(v0[j]); v1[j] = v1[j] * fsigmoid(v1[j]); } }
                        u32x4 w; w.x = pk2(v0[0], v0[1]); w.y = pk2(v0[2], v0[3]); w.z = pk2(v1[0], v1[1]); w.w = pk2(v1[2], v1[3]);
                        *(u32x4*)(rowp + bj * 128) = w; } }
        }
    }
};


namespace sg {
struct SGemm { const bf16_t* A; const bf16_t* Bt; int N, K, lda, ldb; };
__device__ __forceinline__ unsigned red_off(int w, int row, int col) { return (unsigned)((((w * 64 + row) * 16) + ((col >> 2) ^ (row & 15))) * 16); }
template <class Epi>
__device__ __forceinline__ void sgemm_phase(LAS unsigned char* lds, int tid, const SGemm& g, int nbig, const Epi& E) {
    const int G = gridDim.x, c = blockIdx.x, nsm = 8 * (g.N >> 6), r = nbig % G;
    int start, stride;
    if (r == 0) { start = (G % 8 == 0) ? (c % 8) * (G / 8) + c / 8 : c; stride = G; }
    else { start = c - r; stride = G - r; if (c < r) start = nsm; }
    const int w = __builtin_amdgcn_readfirstlane(tid >> 6), lane = tid & 63, fr = lane & 15, fq = lane >> 4;
    const int kw = g.K >> 3, nk2 = kw >> 6;
    bf16x8 xa[4][2], xb[4][2], ya[4][2], yb[4][2];
    const int voA = (fr * g.lda + w * kw + 16 * fq) * 2, voB = (fr * g.ldb + w * kw + 16 * fq) * 2;
    const int sAb = 16 * g.lda * 2, sBb = 16 * g.ldb * 2;
    __amdgpu_buffer_rsrc_t rA, rB;
#define SG_PTRS(su) do { const int mt_ = (su) & 7, nt_ = (su) >> 3; \
        rA = __builtin_amdgcn_make_buffer_rsrc((void*)(g.A + ((size_t)(mt_ >> 2) * SROW + (mt_ & 3) * 64) * g.lda), 0, 64 * g.lda * 2, 0x00020000); \
        rB = __builtin_amdgcn_make_buffer_rsrc((void*)(g.Bt + (size_t)nt_ * 64 * g.ldb), 0, 64 * g.ldb * 2, 0x00020000); } while (0)
#define SG_LD1(r, vo, so) __builtin_bit_cast(bf16x8, __builtin_amdgcn_raw_buffer_load_b128(r, vo, so, 0))
#define SG_LOAD(a, b, k2) do { _Pragma("unroll") for (int i = 0; i < 4; ++i) { a[i][0] = SG_LD1(rA, voA, i * sAb + (k2) * 128); a[i][1] = SG_LD1(rA, voA, i * sAb + (k2) * 128 + 16); \
        b[i][0] = SG_LD1(rB, voB, i * sBb + (k2) * 128); b[i][1] = SG_LD1(rB, voB, i * sBb + (k2) * 128 + 16); } } while (0)
#define SG_MMA(a, b) do { _Pragma("unroll") for (int hh = 0; hh < 2; ++hh) _Pragma("unroll") for (int m = 0; m < 4; ++m) _Pragma("unroll") for (int n = 0; n < 4; ++n) \
        acc[m][n] = __builtin_amdgcn_mfma_f32_16x16x32_bf16(b[n][hh], a[m][hh], acc[m][n], 0, 0, 0); } while (0)
#define SG_SB __builtin_amdgcn_sched_barrier(0)
    if (start < nsm) { SG_PTRS(start); SG_LOAD(xa, xb, 0); }
    for (int su = start; su < nsm; su += stride) {
        f32x4 acc[4][4];
#pragma unroll
        for (int m = 0; m < 4; ++m)
#pragma unroll
            for (int n = 0; n < 4; ++n) acc[m][n] = (f32x4){0.f, 0.f, 0.f, 0.f};
        if (nk2 > 1) SG_LOAD(ya, yb, 1);
        SG_SB;
        for (int k2 = 0; k2 < nk2; k2 += 2) {
            SG_MMA(xa, xb); SG_SB; if (k2 + 2 < nk2) SG_LOAD(xa, xb, k2 + 2); SG_SB;
            if (k2 + 1 < nk2) { SG_MMA(ya, yb); SG_SB; if (k2 + 3 < nk2) SG_LOAD(ya, yb, k2 + 3); SG_SB; }
        }
        if (su + stride < nsm) { SG_PTRS(su + stride); SG_LOAD(xa, xb, 0); }
        SG_SB;
        __syncthreads();
#pragma unroll
        for (int m = 0; m < 4; ++m)
#pragma unroll
            for (int n = 0; n < 4; ++n) *(LAS f32x4*)(lds + red_off(w, 16 * m + fr, 16 * n + 4 * fq)) = acc[m][n];
        __syncthreads();
        const int row = tid >> 3, c8 = (tid & 7) * 8;
        f32x4 s0 = {0.f, 0.f, 0.f, 0.f}, s1 = {0.f, 0.f, 0.f, 0.f};
#pragma unroll
        for (int ww = 0; ww < 8; ++ww) { s0 += *(const LAS f32x4*)(lds + red_off(ww, row, c8)); s1 += *(const LAS f32x4*)(lds + red_off(ww, row, c8 + 4)); }
        float v[8] = {s0.x, s0.y, s0.z, s0.w, s1.x, s1.y, s1.z, s1.w};
        const int mt = su & 7, nt = su >> 3;
        E((size_t)(mt >> 2) * SROW + (mt & 3) * 64 + row, nt * 64 + c8, v);
    }
#undef SG_SB
#undef SG_LOAD
#undef SG_MMA
#undef SG_PTRS
#undef SG_LD1
    __syncthreads();
}
}
__device__ __forceinline__ void st_bf16x8(bf16_t* p, const float (&v)[8]) { u32x4 w; w.x = pk2(v[0], v[1]); w.y = pk2(v[2], v[3]); w.z = pk2(v[4], v[5]); w.w = pk2(v[6], v[7]); *(u32x4*)p = w; }
struct SEpiPlain { bf16_t* O; int ldc;
    __device__ __forceinline__ void operator()(size_t R, int col, const float (&v)[8]) const { st_bf16x8(O + R * ldc + col, v); } };
struct SEpiRowScale { bf16_t* O; int ldc; const float* rs;
    __device__ __forceinline__ void operator()(size_t R, int col, const float (&v)[8]) const { const float s = rs[R]; float o[8];
#pragma unroll
        for (int j = 0; j < 8; ++j) o[j] = v[j] * s;
        st_bf16x8(O + R * ldc + col, o); } };
struct SEpiRelu2 { bf16_t* O; int ldc;
    __device__ __forceinline__ void operator()(size_t R, int col, const float (&v)[8]) const { float o[8];
#pragma unroll
        for (int j = 0; j < 8; ++j) { const float a = fmaxf(v[j], 0.f); o[j] = a * a; }
        st_bf16x8(O + R * ldc + col, o); } };
struct SEpiResid { float* XS; const float* gate; float scale;
    __device__ __forceinline__ void operator()(size_t R, int col, const float (&v)[8]) const { const float* gp = gate + (size_t)2 * MODW + col; float* xp = XS + R * DM + col;
        const f32x4 g0 = *(const f32x4*)gp * scale, g1 = *(const f32x4*)(gp + 4) * scale; f32x4 x0 = *(f32x4*)xp, x1 = *(f32x4*)(xp + 4);
        x0 += g0 * (f32x4){v[0], v[1], v[2], v[3]}; x1 += g1 * (f32x4){v[4], v[5], v[6], v[7]}; *(f32x4*)xp = x0; *(f32x4*)(xp + 4) = x1; } };
struct SEpiHG { bf16_t* QVG; float* LOGF; const float* lb;
    __device__ __forceinline__ void operator()(size_t R, int col, const float (&v)[8]) const { const int seg = col >> 11, cs = col & 2047;
        if (seg == 1 || seg == 2) { float* p = LOGF + (size_t)(seg - 1) * MROWS * DM + R * DM + cs; f32x4 o0, o1;
#pragma unroll
            for (int j = 0; j < 4; ++j) { const float l0 = lb[cs + j], l1 = lb[cs + 4 + j]; o0[j] = __logf(l0 + (1.0f - l0) * fsigmoid(v[j])); o1[j] = __logf(l1 + (1.0f - l1) * fsigmoid(v[4 + j])); }
            *(f32x4*)p = o0; *(f32x4*)(p + 4) = o1; }
        else { const int bi = seg - 2 + (seg == 0 ? 2 : 0); float o[8];
#pragma unroll
            for (int j = 0; j < 8; ++j) o[j] = seg == 3 ? v[j] : v[j] * fsigmoid(v[j]);
            st_bf16x8(QVG + (size_t)bi * MROWS * DM + R * DM + cs, o); } } };

namespace att {
using s16x4  = __attribute__((ext_vector_type(4))) short;
using f32x16 = __attribute__((ext_vector_type(16))) float;
constexpr int NW = 8, QBLK = 32, KVBLK = 64;
constexpr float SCALE = ATTN_SCALE;
constexpr float THR = 8.f;
constexpr int SHM_V = KVBLK * 128 * 2, SHM_K = KVBLK * 128 * 2, SHM_KR = KVBLK * 64 * 2;
constexpr int OFF_V = 0, OFF_K = 2 * SHM_V, OFF_KR = OFF_K + 2 * SHM_K, OFF_WS = OFF_KR + 2 * SHM_KR, SHM_ATTN = OFF_WS + NW * 64 * 4;
constexpr int LDQ = QW, LDK = KVW, LDO = DM;
#define KSWZ(row, colB) ((row) * 256 + ((colB) ^ (((row) & 7) << 4)))
#define RSWZ(row, colB) ((row) * 128 + ((colB) ^ ((((row) >> 1) & 7) << 4)))
#define SBAR() __builtin_amdgcn_sched_barrier(0)
__device__ __forceinline__ int crow(int r, int hi) { return (r & 3) + 8 * (r >> 2) + 4 * hi; }
__device__ __forceinline__ unsigned cvtpk(float lo, float hi) { unsigned r; asm volatile("v_cvt_pk_bf16_f32 %0, %1, %2" : "=v"(r) : "v"(lo), "v"(hi)); return r; }
__device__ __forceinline__ bf16x8 ld8(const bf16_t* p) { return *reinterpret_cast<const bf16x8*>(p); }
__device__ __forceinline__ void partialSM(f32x16& p0, f32x16& p1, float& m_reg, float& mn, float& alpha) {
  constexpr float C = SCALE * 1.4426950408889634f;
  float pmax = p0[0];
#pragma unroll
  for (int r = 1; r < 16; ++r) pmax = fmaxf(pmax, p0[r]);
#pragma unroll
  for (int r = 0; r < 16; ++r) pmax = fmaxf(pmax, p1[r]);
  { auto rr = __builtin_amdgcn_permlane32_swap(__float_as_uint(pmax), __float_as_uint(pmax), false, false);
    pmax = fmaxf(__uint_as_float(rr[0]), __uint_as_float(rr[1])); }
  if (__builtin_expect(__all(pmax - m_reg <= THR / SCALE), 1)) { mn = m_reg; alpha = 1.f; }
  else { mn = fmaxf(m_reg, pmax); alpha = __builtin_amdgcn_exp2f((m_reg - mn) * C); m_reg = mn; }
  float mnC = -mn * C;
#pragma unroll
  for (int r = 0; r < 16; ++r) p0[r] = fmaf(p0[r], C, mnC);
#pragma unroll
  for (int r = 0; r < 16; ++r) p1[r] = fmaf(p1[r], C, mnC);
#pragma unroll
  for (int r = 0; r < 16; ++r) p0[r] = __builtin_amdgcn_exp2f(p0[r]);
}
__device__ __forceinline__ void finishSM(f32x16& p0, f32x16& p1, float alpha, float& l_reg, bf16x8& pa0, bf16x8& pa1, bf16x8& pa2, bf16x8& pa3) {
#pragma unroll
  for (int r = 0; r < 16; ++r) p1[r] = __builtin_amdgcn_exp2f(p1[r]);
  float ps = 0;
#pragma unroll
  for (int r = 0; r < 16; ++r) ps += p0[r];
#pragma unroll
  for (int r = 0; r < 16; ++r) ps += p1[r];
  { auto rr = __builtin_amdgcn_permlane32_swap(__float_as_uint(ps), __float_as_uint(ps), false, false);
    ps = __uint_as_float(rr[0]) + __uint_as_float(rr[1]); }
  l_reg = l_reg * alpha + ps;
#define PK4(P, BASE, OUT) do { unsigned a0 = cvtpk(P[BASE + 0], P[BASE + 1]), a1 = cvtpk(P[BASE + 2], P[BASE + 3]);   \
    unsigned b0 = cvtpk(P[BASE + 4], P[BASE + 5]), b1 = cvtpk(P[BASE + 6], P[BASE + 7]);                              \
    auto r0 = __builtin_amdgcn_permlane32_swap(a0, b0, false, false); auto r1 = __builtin_amdgcn_permlane32_swap(a1, b1, false, false); \
    u32x4 w = {r0[0], r1[0], r0[1], r1[1]}; OUT = *reinterpret_cast<bf16x8*>(&w); } while (0)
  PK4(p0, 0, pa0); PK4(p0, 8, pa1); PK4(p1, 0, pa2); PK4(p1, 8, pa3);
#undef PK4
}
__device__ __forceinline__ void qkt(f32x16& p0, f32x16& p1, const char* Ks, const char* Krs, const bf16x8* qr, int r32, int hi) {
  p0 = f32x16{}; p1 = f32x16{};
#pragma unroll
  for (int d0 = 0; d0 < 8; ++d0) { int cb = (d0 * 16 + hi * 8) * 2;
    bf16x8 b0 = *reinterpret_cast<const bf16x8*>(Ks + KSWZ(r32, cb));
    bf16x8 b1 = *reinterpret_cast<const bf16x8*>(Ks + KSWZ(32 + r32, cb));
    p0 = __builtin_amdgcn_mfma_f32_32x32x16_bf16(b0, qr[d0], p0, 0, 0, 0);
    p1 = __builtin_amdgcn_mfma_f32_32x32x16_bf16(b1, qr[d0], p1, 0, 0, 0); }
#pragma unroll
  for (int d0 = 0; d0 < 4; ++d0) { int cb = (d0 * 16 + hi * 8) * 2;
    bf16x8 b0 = *reinterpret_cast<const bf16x8*>(Krs + RSWZ(r32, cb));
    bf16x8 b1 = *reinterpret_cast<const bf16x8*>(Krs + RSWZ(32 + r32, cb));
    p0 = __builtin_amdgcn_mfma_f32_32x32x16_bf16(b0, qr[8 + d0], p0, 0, 0, 0);
    p1 = __builtin_amdgcn_mfma_f32_32x32x16_bf16(b1, qr[8 + d0], p1, 0, 0, 0); }
}
__device__ __forceinline__ int v_st(int k, int c) { const int kk = (k & ~0xC) | ((k & 4) << 1) | ((k & 8) >> 1); return ((kk >> 3) * 4 + (c >> 5)) * 512 + ((kk & 7) * 32 + (c & 31)) * 2; }
__device__ __forceinline__ int v_rd_base(int lane) { return ((lane & 3) << 3) | (((lane >> 2) & 3) << 6) | (((lane >> 4) & 1) << 5) | (((lane >> 5) & 1) << 8); }
constexpr int v_rd_off(int d0, int ks, int half) { return d0 * 512 + ks * 4096 + half * 2048; }
template <int OFF> __device__ __forceinline__ s16x4 tr_read(int vb) {
  s16x4 r; asm volatile("ds_read_b64_tr_b16 %0, %1 offset:%2" : "=&v"(r) : "v"(vb), "i"(OFF) : "memory"); return r;
}
template <int D0> __device__ __forceinline__ void pv_one(f32x16& od, int vb, bf16x8 pa0, bf16x8 pa1, bf16x8 pa2, bf16x8 pa3) {
  const s16x4 l0 = tr_read<v_rd_off(D0, 0, 0)>(vb), h0 = tr_read<v_rd_off(D0, 0, 1)>(vb), l1 = tr_read<v_rd_off(D0, 1, 0)>(vb), h1 = tr_read<v_rd_off(D0, 1, 1)>(vb);
  const s16x4 l2 = tr_read<v_rd_off(D0, 2, 0)>(vb), h2 = tr_read<v_rd_off(D0, 2, 1)>(vb), l3 = tr_read<v_rd_off(D0, 3, 0)>(vb), h3 = tr_read<v_rd_off(D0, 3, 1)>(vb);
  asm volatile("s_waitcnt lgkmcnt(0)" ::: "memory"); SBAR();
#define PK(L, H) (bf16x8){L[0], L[1], L[2], L[3], H[0], H[1], H[2], H[3]}
  od = __builtin_amdgcn_mfma_f32_32x32x16_bf16(pa0, PK(l0, h0), od, 0, 0, 0);
  od = __builtin_amdgcn_mfma_f32_32x32x16_bf16(pa1, PK(l1, h1), od, 0, 0, 0);
  od = __builtin_amdgcn_mfma_f32_32x32x16_bf16(pa2, PK(l2, h2), od, 0, 0, 0);
  od = __builtin_amdgcn_mfma_f32_32x32x16_bf16(pa3, PK(l3, h3), od, 0, 0, 0);
#undef PK
}
__device__ __forceinline__ void pv_d0(f32x16* o, int vb, bf16x8 pa0, bf16x8 pa1, bf16x8 pa2, bf16x8 pa3) {
  pv_one<0>(o[0], vb, pa0, pa1, pa2, pa3); pv_one<1>(o[1], vb, pa0, pa1, pa2, pa3); pv_one<2>(o[2], vb, pa0, pa1, pa2, pa3); pv_one<3>(o[3], vb, pa0, pa1, pa2, pa3);
}
__device__ __forceinline__ void attn_body(const bf16_t* __restrict__ Qb, const bf16_t* __restrict__ Kh, const bf16_t* __restrict__ KRb,
                                          bf16_t* __restrict__ Ob, int seq, int tq0, const float* __restrict__ RC, const float* __restrict__ RS, char* lds, int tid) {
  const bf16_t* Vh = Kh + 128;
  const int wid = tid >> 6, lane = tid & 63, r32 = lane & 31, hi = lane >> 5;
  char* V_lds = lds + OFF_V; char* K_lds = lds + OFF_K; char* KR_lds = lds + OFF_KR;
  float* ws = (float*)(lds + OFF_WS) + wid * 64; float* li_l = ws; float* al_l = ws + 32;
  float m_reg = -1e30f, l_reg = 0; f32x16 o[4] = {}; bf16x8 qr[12];
  const bf16_t* Qw = Qb + (long)(wid * QBLK + r32) * LDQ + hi * 8;
#pragma unroll
  for (int d0 = 0; d0 < 12; ++d0) qr[d0] = ld8(Qw + d0 * 16);
  if (tq0 >= 0) {
    const int t = tq0 + wid * QBLK + r32; const int pr = (t >> 6) * 16 + hi * 8, pc = (t & 63) * 16 + hi * 8;
#pragma unroll
    for (int j = 0; j < 8; ++j) {
      { const float c = RC[pr + j], sn = RS[pr + j]; const float x0 = bf2f((bf16_t)qr[8][j]), x1 = bf2f((bf16_t)qr[9][j]);
        qr[8][j] = (short)f2bf(x0 * c - x1 * sn); qr[9][j] = (short)f2bf(x1 * c + x0 * sn); }
      { const float c = RC[pc + j], sn = RS[pc + j]; const float x0 = bf2f((bf16_t)qr[10][j]), x1 = bf2f((bf16_t)qr[11][j]);
        qr[10][j] = (short)f2bf(x0 * c - x1 * sn); qr[11][j] = (short)f2bf(x1 * c + x0 * sn); }
    }
  }
  const int sr = tid >> 4, sc = (tid & 15) * 8, vst0 = v_st(sr, sc), vst1 = v_st(32 + sr, sc);
  const int rr = tid >> 3, rc = (tid & 7) * 8;
  const int vb0 = (int)(uintptr_t)V_lds + v_rd_base(lane);
  bf16x8 vs0, vs1, ks0, ks1, krs;
#define SLOAD(k0) do { vs0 = ld8(&Vh[(long)((k0) + sr) * LDK + sc]); vs1 = ld8(&Vh[(long)((k0) + 32 + sr) * LDK + sc]); \
    ks0 = ld8(&Kh[(long)((k0) + sr) * LDK + sc]); ks1 = ld8(&Kh[(long)((k0) + 32 + sr) * LDK + sc]); krs = ld8(&KRb[(long)((k0) + rr) * 64 + rc]); } while (0)
#define SWRITE(b) do { *(bf16x8*)(V_lds + (b) * SHM_V + vst0) = vs0; *(bf16x8*)(V_lds + (b) * SHM_V + vst1) = vs1; int kc = sc * 2;   \
    *(bf16x8*)(K_lds + (b) * SHM_K + KSWZ(sr, kc)) = ks0; *(bf16x8*)(K_lds + (b) * SHM_K + KSWZ(32 + sr, kc)) = ks1;                    \
    *(bf16x8*)(KR_lds + (b) * SHM_KR + RSWZ(rr, rc * 2)) = krs; } while (0)
#define SWAIT() asm volatile("s_waitcnt vmcnt(0)" ::: "memory")
#define RESC(a) do { if (__any((a) < 1.f)) { if (hi == 0) al_l[r32] = (a); asm volatile("s_waitcnt lgkmcnt(0)" ::: "memory"); \
    _Pragma("unroll") for (int d = 0; d < 4; ++d) _Pragma("unroll") for (int r = 0; r < 16; ++r) o[d][r] *= al_l[crow(r, hi)]; } } while (0)
  f32x16 p0, p1; float mn, al; bf16x8 pa0, pa1, pa2, pa3; const int NT = seq / KVBLK;
  SLOAD(0); SWAIT(); SWRITE(0); __syncthreads();
  SLOAD(KVBLK);
  for (int j = 0; j < NT; ++j) {
    const int buf = j & 1;
    SBAR(); qkt(p0, p1, K_lds + buf * SHM_K, KR_lds + buf * SHM_KR, qr, r32, hi);
    partialSM(p0, p1, m_reg, mn, al); RESC(al);
    finishSM(p0, p1, al, l_reg, pa0, pa1, pa2, pa3); SBAR();
    if (j + 1 < NT) { SWAIT(); SWRITE(buf ^ 1); }
    if (j + 2 < NT) SLOAD((j + 2) * KVBLK);
    SBAR();
    pv_d0(o, vb0 + buf * SHM_V, pa0, pa1, pa2, pa3);
    __syncthreads();
  }
  if (hi == 0) li_l[r32] = l_reg; asm volatile("s_waitcnt lgkmcnt(0)" ::: "memory");
  float rli[16];
#pragma unroll
  for (int r = 0; r < 16; ++r) rli[r] = __builtin_amdgcn_rcpf(li_l[crow(r, hi)]);
  bf16_t* Ow = Ob + (long)(wid * QBLK) * LDO;
#pragma unroll
  for (int r = 0; r < 16; ++r) { int orow = crow(r, hi);
#pragma unroll
    for (int d0 = 0; d0 < 4; ++d0) Ow[(long)orow * LDO + d0 * 32 + r32] = (bf16_t)f2bf(o[d0][r] * rli[r]); }
#undef SLOAD
#undef SWRITE
#undef SWAIT
#undef RESC
}
}

typedef const float* cfp_t;
typedef const __attribute__((address_space(4))) cfp_t* InPtr;
struct Ctx {
    LAS unsigned char* lds; int tid, lane, wave, gw, ngw, gtid, ngt;
    InPtr in; float* out; unsigned char* ws;
    __device__ __forceinline__ const float* inp(int i) const { return (const float*)(const GAS float*)in[i]; }
};
#define WSP(T, off) ((T*)(C.ws + (off)))

__device__ __forceinline__ void tr_item(const float* W, int K, int N, bf16_t* WT, const float* sck, LAS float* scr, int item, int lane) {
    const int nblk = N / 64, kb = item / nblk, nb = item % nblk, k0 = 64 * kb, n0 = 64 * nb;
    f32x4 v[16];
#pragma unroll
    for (int i = 0; i < 16; ++i) v[i] = *(const f32x4*)(W + (size_t)(k0 + 4 * i + (lane >> 4)) * N + n0 + 4 * (lane & 15));
#pragma unroll
    for (int i = 0; i < 16; ++i) { const int kk = 4 * i + (lane >> 4); f32x4 x = v[i]; if (sck) x *= sck[k0 + kk]; LAS float* d = scr + kk * 65 + 4 * (lane & 15); d[0] = x.x; d[1] = x.y; d[2] = x.z; d[3] = x.w; }
    asm volatile("s_waitcnt lgkmcnt(0)" ::: "memory"); __builtin_amdgcn_wave_barrier();
    const int nl = lane & 7, kc = lane >> 3;
#pragma unroll
    for (int j = 0; j < 8; ++j) { const int n = 8 * j + nl; const LAS float* sp = scr + (8 * kc) * 65 + n;
        u32x4 o; o.x = pk2(sp[0 * 65], sp[1 * 65]); o.y = pk2(sp[2 * 65], sp[3 * 65]); o.z = pk2(sp[4 * 65], sp[5 * 65]); o.w = pk2(sp[6 * 65], sp[7 * 65]);
        *(u32x4*)(WT + (size_t)(n0 + n) * K + k0 + 8 * kc) = o; }
    asm volatile("s_waitcnt lgkmcnt(0)" ::: "memory"); __builtin_amdgcn_wave_barrier();
}
__device__ __forceinline__ void tr_matrix(const Ctx& C, const float* W, int K, int N, bf16_t* WT, const float* sck) {
    LAS float* scr = (LAS float*)(C.lds + C.wave * 16640);
    const int cnt = (K / 64) * (N / 64);
    for (int it = C.gw; it < cnt; it += C.ngw) tr_item(W, K, N, WT, sck, scr, it, C.lane);
}
__device__ __forceinline__ void sincos_d(double x, double& s, double& c) {
    const double twopi = 6.283185307179586476925286766559;
    const double k = __builtin_rint(x / twopi); const double y = x - k * twopi; const double y2 = y * y;
    double ts = y, ss = y, tc = 1.0, sc = 1.0;
#pragma unroll
    for (int n = 1; n <= 16; ++n) { tc *= -y2 / (double)((2 * n - 1) * (2 * n)); sc += tc; ts *= -y2 / (double)((2 * n) * (2 * n + 1)); ss += ts; }
    s = ss; c = sc;
}
__device__ __forceinline__ void phase_prologue(const Ctx& C) {
#pragma unroll 1
    for (int e = 0; e < 2; ++e) {
        tr_matrix(C, C.inp(8) + (size_t)e * DM * ABN, DM, ABN, WSP(bf16_t, WS_WABIN) + (size_t)e * ABNP * DM, nullptr);
        tr_matrix(C, C.inp(9) + (size_t)e * DM * DM, DM, DM, WSP(bf16_t, WS_WABOUT) + (size_t)e * DM * DM, nullptr);
        tr_matrix(C, C.inp(18) + (size_t)e * 512 * QW, 512, QW, WSP(bf16_t, WS_WUQ) + (size_t)e * QW * 512, C.inp(17) + e * 512);
        tr_matrix(C, C.inp(20) + (size_t)e * 512 * KVW, 512, KVW, WSP(bf16_t, WS_WUKV) + (size_t)e * KVW * 512, C.inp(19) + e * 512);
        tr_matrix(C, C.inp(21) + (size_t)e * DM * HGN, DM, HGN, WSP(bf16_t, WS_WHGIN) + (size_t)e * HGN * DM, nullptr);
        tr_matrix(C, C.inp(24) + (size_t)e * DM * DM, DM, DM, WSP(bf16_t, WS_WHGOUT) + (size_t)e * DM * DM, nullptr);
#pragma unroll 1
        for (int dg = 0; dg < 4; ++dg) { const int dir = dg >> 1, gate = dg & 1;
            tr_matrix(C, C.inp(gate ? 14 : 12) + ((size_t)e * 2 + dir) * 8 * 128 * 128, 1024, 128, WSP(bf16_t, WS_WG) + ((size_t)e * 4 + dg) * 128 * 1024, nullptr); }
    }
#pragma unroll 1
    for (int l = 0; l < 4; ++l) {
        tr_matrix(C, C.inp(25) + (size_t)l * DM * DFF, DM, DFF, WSP(bf16_t, WS_W1) + (size_t)l * DFF * DM, nullptr);
        tr_matrix(C, C.inp(26) + (size_t)l * DFF * DM, DFF, DM, WSP(bf16_t, WS_W2) + (size_t)l * DM * DFF, nullptr);
    }
    for (int e = 0; e < 2; ++e) { u32x4* z = (u32x4*)(WSP(bf16_t, WS_WABIN) + (size_t)e * ABNP * DM + (size_t)ABN * DM);
        for (int i = C.gtid; i < (ABNP - ABN) * DM / 8; i += C.ngt) z[i] = (u32x4){0u, 0u, 0u, 0u}; }
    { float* XS = WSP(float, WS_XS);
      for (int i = C.gtid; i < MROWS * (DM / 4); i += C.ngt) { const int R = i / (DM / 4), c4 = i % (DM / 4); const int b = R / SROW, s = R % SROW;
          const float* src = s < CTX ? C.inp(2) + ((size_t)(b * CTX + s)) * DM : C.inp(0) + ((size_t)(b * SEQ + (s - CTX))) * DM;
          ((f32x4*)(XS + (size_t)R * DM))[c4] = ((const f32x4*)src)[c4]; } }
    { float* LB = WSP(float, WS_LB);
      for (int i = C.gtid; i < 2048; i += C.ngt) { float v[4], mx = -1e30f; for (int l = 0; l < 4; ++l) { v[l] = C.inp(22)[l * 2048 + i]; mx = fmaxf(mx, v[l]); }
          float sum = 0.f; for (int l = 0; l < 4; ++l) { v[l] = expf(v[l] - mx); sum += v[l]; }
          float cum = 0.f; const float p0 = v[0] / sum; for (int l = 0; l < 4; ++l) { cum += v[l] / sum; LB[l * 2048 + i] = cum - p0; } }
      float* RC = WSP(float, WS_ROPE); float* RS = RC + 1024;
      for (int i = C.gtid; i < 1024; i += C.ngt) { const int pos = i / 16, j = i % 16; double inv = 1.0; for (int q = 0; q < j; ++q) inv *= 0.56234132519034908;
          const float ang = (float)pos * (float)inv; double s, c; sincos_d((double)ang, s, c); RC[i] = (float)c; RS[i] = (float)s; } }
    { LAS float* sl = (LAS float*)C.lds;
      LAS float* red = sl + 3 * 2048;
      __syncthreads();
      for (int i = C.tid; i < 3 * 2048; i += 512) { const int r = i / 2048, d = i % 2048; const float v = r < 2 ? C.inp(1)[r * 2048 + d] : C.inp(3)[d]; sl[i] = siluf_(v); }
      __syncthreads();
      float* MOD = WSP(float, WS_MOD);
      const int kq = C.tid >> 4, cq = C.tid & 15;
      for (int u = blockIdx.x; u < 4 * (MODW / 64); u += gridDim.x) { const int l = u / (MODW / 64), e0 = (u % (MODW / 64)) * 64;
          const float* w = C.inp(4) + (size_t)l * DM * MODW + e0 + 4 * cq;
          f32x4 a0 = {0, 0, 0, 0}, a1 = {0, 0, 0, 0}, a2 = {0, 0, 0, 0};
#pragma unroll 8
          for (int d = kq; d < DM; d += 32) { const f32x4 wv = *(const f32x4*)(w + (size_t)d * MODW); a0 += wv * sl[d]; a1 += wv * sl[2048 + d]; a2 += wv * sl[4096 + d]; }
#pragma unroll
          for (int j = 0; j < 4; ++j) { red[(kq * 3 + 0) * 64 + 4 * cq + j] = a0[j]; red[(kq * 3 + 1) * 64 + 4 * cq + j] = a1[j]; red[(kq * 3 + 2) * 64 + 4 * cq + j] = a2[j]; }
          __syncthreads();
          if (C.tid < 192) { const int r = C.tid / 64, c = C.tid % 64; float s = 0.f; for (int q = 0; q < 32; ++q) s += red[(q * 3 + r) * 64 + c];
              MOD[((size_t)l * 3 + r) * MODW + e0 + c] = s + C.inp(5)[l * MODW + e0 + c]; }
          __syncthreads(); } }
}

__device__ __forceinline__ void phase_norm_mod(const Ctx& C, const float* w, const float* mod, int sh_idx, int sc_idx) {
    const float* XS = WSP(float, WS_XS); bf16_t* H = WSP(bf16_t, WS_H);
    for (int R = C.gw; R < MROWS; R += C.ngw) {
        const int s = R % SROW, b = R / SROW, cond = s < CTX ? 2 : b;
        const float* shift = mod + (size_t)cond * MODW + sh_idx * DM; const float* scale = mod + (size_t)cond * MODW + sc_idx * DM;
        const f32x4* xr = (const f32x4*)(XS + (size_t)R * DM) + C.lane;
        f32x4 v[8]; float ss = 0.f;
#pragma unroll
        for (int j = 0; j < 8; ++j) { v[j] = xr[64 * j]; ss += (v[j].x * v[j].x + v[j].y * v[j].y) + (v[j].z * v[j].z + v[j].w * v[j].w); }
        const float rstd = 1.0f / sqrtf(wave_sum(ss) * (1.0f / DM) + EPS);
        u32x2* o = (u32x2*)(H + (size_t)R * DM) + C.lane;
#pragma unroll
        for (int j = 0; j < 8; ++j) { const int c = (C.lane + 64 * j) * 4; const f32x4 wv = *(const f32x4*)(w + c), sc = *(const f32x4*)(scale + c), sh = *(const f32x4*)(shift + c);
            const f32x4 y = (v[j] * rstd * wv) * (1.0f + sc) + sh; u32x2 pk; pk.x = pk2(y.x, y.y); pk.y = pk2(y.z, y.w); o[64 * j] = pk; }
    }
}

__device__ __forceinline__ void phase_rs_kr(const Ctx& C) {
    const bf16_t* P = WSP(bf16_t, WS_P);
    float* RSQ = WSP(float, WS_RSQ); float* RSKV = WSP(float, WS_RSKV);
    for (int R = C.gw; R < MROWS; R += C.ngw) {
        const u32x4 a = *(const u32x4*)(P + (size_t)R * ABNP + 2048 + 8 * C.lane), b = *(const u32x4*)(P + (size_t)R * ABNP + 2560 + 8 * C.lane);
        float sa = 0.f, sb = 0.f;
#pragma unroll
        for (int j = 0; j < 4; ++j) { const float a0 = __uint_as_float(a[j] << 16), a1 = __uint_as_float(a[j] & 0xffff0000u), b0 = __uint_as_float(b[j] << 16), b1 = __uint_as_float(b[j] & 0xffff0000u);
            sa += a0 * a0 + a1 * a1; sb += b0 * b0 + b1 * b1; }
        sa = wave_sum(sa); sb = wave_sum(sb);
        if (C.lane == 0) { RSQ[R] = 1.0f / sqrtf(sa * (1.0f / 512.0f) + EPS); RSKV[R] = 1.0f / sqrtf(sb * (1.0f / 512.0f) + EPS); } }
    bf16_t* KR = WSP(bf16_t, WS_KR); const float* RC = WSP(float, WS_ROPE); const float* RS = RC + 1024;
    for (int idx = C.gtid; idx < MROWS * 32; idx += C.ngt) { const int R = idx / 32, p = idx % 32, s = R % SROW; const int i0 = p < 16 ? p : 32 + (p - 16);
        const float x0 = bf2f(P[(size_t)R * ABNP + 3072 + i0]), x1 = bf2f(P[(size_t)R * ABNP + 3072 + i0 + 16]); float o0 = x0, o1 = x1;
        if (s >= CTX) { const int t = s - CTX, pos = p < 16 ? t / 64 : t % 64; const float c = RC[pos * 16 + (p & 15)], sn = RS[pos * 16 + (p & 15)]; o0 = x0 * c - x1 * sn; o1 = x1 * c + x0 * sn; }
        KR[(size_t)R * 64 + i0] = (bf16_t)f2bf(o0); KR[(size_t)R * 64 + i0 + 16] = (bf16_t)f2bf(o1); }
}

__device__ __forceinline__ void phase_attn(const Ctx& C) {
    const bf16_t* Q = WSP(bf16_t, WS_Q); const bf16_t* KV = WSP(bf16_t, WS_KV); const bf16_t* KR = WSP(bf16_t, WS_KR); bf16_t* Y = WSP(bf16_t, WS_Y);
    const float* RC = WSP(float, WS_ROPE); const float* RS = RC + 1024;
    const int G = gridDim.x, c = blockIdx.x;
    for (int u0 = c; u0 < 272; u0 += G) {
        int b, hh, s0, nk, tq0;
        if (u0 < 256) { int v = u0; if (G == 256) { const int x = c & 7, j = c >> 3; v = (x * 2 + (j >> 4)) * 16 + (j & 15); }
            const int p = v >> 4, qb = v & 15; b = p >> 3; hh = p & 7; s0 = CTX + qb * 256; nk = SROW; tq0 = qb * 256; }
        else { const int p = u0 - 256; b = p >> 3; hh = p & 7; s0 = 0; nk = CTX; tq0 = -1; }
        const size_t R0 = (size_t)b * SROW + s0, K0 = (size_t)b * SROW;
        __syncthreads();
        att::attn_body(Q + R0 * QW + hh * 192, KV + K0 * KVW + hh * 256, KR + K0 * 64, Y + R0 * DM + DLRU + hh * 128, nk, tq0, RC, RS, (char*)C.lds, C.tid);
    }
}
namespace hg {
using s16x4  = __attribute__((ext_vector_type(4))) short;
using f32x16 = __attribute__((ext_vector_type(16))) float;
constexpr int NCH = SROW / 64;
constexpr int NCHAIN = NBATCH * 16 * 2;
__device__ __forceinline__ unsigned off_b(unsigned row, unsigned ch) { return 256u * row + 16u * (ch ^ (((row & 3u) << 2) | ((row >> 2) & 3u))); }
__device__ __forceinline__ s16x4 trr(unsigned addr) { s16x4 r; asm volatile("ds_read_b64_tr_b16 %0, %1" : "=&v"(r) : "v"(addr) : "memory"); return r; }
__device__ __forceinline__ bf16x8 pk8(s16x4 L, s16x4 H) { return (bf16x8){L[0], L[1], L[2], L[3], H[0], H[1], H[2], H[3]}; }
__device__ __forceinline__ unsigned tr_nat(unsigned lane, unsigned c, unsigned ks, unsigned t) {
    const unsigned h = lane >> 5, blk = (lane >> 4) & 1, q = (lane & 15) >> 2, p = lane & 3;
    return off_b(16 * ks + 8 * h + 4 * t + q, 4 * c + 2 * blk + (p >> 1)) + 8 * (p & 1); }
__device__ __forceinline__ unsigned tr_perm(unsigned lane, unsigned c, unsigned rb, unsigned t) {
    const unsigned h = lane >> 5, blk = (lane >> 4) & 1, q = (lane & 15) >> 2, p = lane & 3;
    return off_b(rb + 4 * h + 8 * t + q, 4 * c + 2 * blk + (p >> 1)) + 8 * (p & 1); }
__device__ __forceinline__ unsigned row_rd(unsigned lane, unsigned rb, unsigned ks) { return off_b(rb + (lane & 31), 2 * ks + (lane >> 5)); }
__device__ __forceinline__ int crow(int r, int hi) { return (r & 3) + 8 * (r >> 2) + 4 * hi; }
#define HG_WAITL() do { asm volatile("s_waitcnt lgkmcnt(0)" ::: "memory"); __builtin_amdgcn_sched_barrier(0); } while (0)
}

__device__ __forceinline__ void phase_hg_state(const Ctx& C) {
    using namespace hg;
    LAS unsigned char* L = C.lds; const unsigned Lb = (unsigned)(uintptr_t)L;
    constexpr unsigned VT = 0, KP = 16384, TOT = 32768, DECV = 36864;
    const float* LOGF = WSP(float, WS_LOGF); const bf16_t* VH = WSP(bf16_t, WS_VH); bf16_t* SS = WSP(bf16_t, WS_SS);
    const int w = C.wave, lane = C.lane, tid = C.tid, h5 = lane >> 5, r32 = lane & 31;
    const int G = gridDim.x, c = blockIdx.x, v0 = (G % 8 == 0) ? (c % 8) * (G / 8) + c / 8 : c;
    for (int u = v0; u < NCHAIN * 4; u += G) {
        const int chain = u >> 2, sl = u & 3, dir = chain & 1, hh = (chain >> 1) & 15, b = chain >> 5;
        const float* lfb = LOGF + (size_t)dir * MROWS * DM + ((size_t)b * SROW + 8 * w) * DM + hh * 128 + 2 * lane;
        const bf16_t* vb = VH + ((size_t)b * SROW + (tid >> 2)) * DM + hh * 128 + 32 * sl + 8 * (tid & 3);
        f32x16 S = {};
        f32x2 lfA[8], lfB[8]; u32x4 vA = {0u, 0u, 0u, 0u}, vB = {0u, 0u, 0u, 0u};
#define HS_CI(j) (dir == 0 ? (j) : ((j) < 4 ? 3 - (j) : 71 - (j)))
#define HS_LOAD(lf, vr, j) do { const int cn_ = HS_CI(j); _Pragma("unroll") for (int i = 0; i < 8; ++i) lf[i] = *(const f32x2*)(lfb + (size_t)(cn_ * 64 + i) * DM); \
        if (tid < 256) vr = *(const u32x4*)(vb + (size_t)cn_ * 64 * DM); } while (0)
#define HS_STEP(lf, vr, j) do { const int ci = HS_CI(j); \
            f32x2 T = {0.f, 0.f}; \
            _Pragma("unroll") for (int i = 0; i < 8; ++i) T += lf[i]; \
            *(LAS f32x2*)(L + TOT + (w * 128 + 2 * lane) * 4) = T; \
            __syncthreads();                                          \
            if (tid < 256) *(LAS u32x4*)(L + VT + off_b(tid >> 2, 4 * sl + (tid & 3))) = vr; \
            f32x2 off = {0.f, 0.f}, total = {0.f, 0.f}; \
            _Pragma("unroll") for (int ww = 0; ww < 8; ++ww) { const f32x2 t = *(const LAS f32x2*)(L + TOT + (ww * 128 + 2 * lane) * 4); total += t; if (dir == 0 ? (ww > w) : (ww < w)) off += t; } \
            f32x2 E[8]; \
            if (dir == 0) { E[7] = off; _Pragma("unroll") for (int i = 6; i >= 0; --i) E[i] = E[i + 1] + lf[i + 1]; } \
            else { E[0] = off; _Pragma("unroll") for (int i = 1; i < 8; ++i) E[i] = E[i - 1] + lf[i - 1]; } \
            _Pragma("unroll") for (int i = 0; i < 8; ++i) { const float k0 = (1.0f - __expf(lf[i].x)) * __expf(E[i].x), k1 = (1.0f - __expf(lf[i].y)) * __expf(E[i].y); \
                *(LAS unsigned*)(L + KP + off_b(8 * w + i, lane >> 2) + (lane & 3) * 4) = pk2(k0, k1); } \
            if (w == 0) { f32x2 d; d.x = __expf(total.x); d.y = __expf(total.y); *(LAS f32x2*)(L + DECV + 2 * lane * 4) = d; } \
            if ((j) + 2 < NCH) HS_LOAD(lf, vr, (j) + 2); \
            __syncthreads(); \
            if (w < 4) {     \
                bf16_t* sp = SS + ((size_t)chain * NCH + ci) * 16384 + 32 * sl + r32; \
                s16x4 al[4], ah[4], bl[4], bh[4]; \
                _Pragma("unroll") for (int ks = 0; ks < 4; ++ks) { al[ks] = trr(Lb + KP + tr_nat(lane, w, ks, 0)); ah[ks] = trr(Lb + KP + tr_nat(lane, w, ks, 1)); \
                    bl[ks] = trr(Lb + VT + tr_nat(lane, sl, ks, 0)); bh[ks] = trr(Lb + VT + tr_nat(lane, sl, ks, 1)); } \
                _Pragma("unroll") for (int r = 0; r < 16; ++r) { const int dk = 32 * w + crow(r, h5); sp[dk * 128] = (bf16_t)f2bf(S[r]); S[r] *= *(const LAS float*)(L + DECV + dk * 4); } \
                HG_WAITL(); \
                _Pragma("unroll") for (int ks = 0; ks < 4; ++ks) S = __builtin_amdgcn_mfma_f32_32x32x16_bf16(pk8(al[ks], ah[ks]), pk8(bl[ks], bh[ks]), S, 0, 0, 0); \
            } } while (0)
        HS_LOAD(lfA, vA, 0); HS_LOAD(lfB, vB, 1);
        __syncthreads();
#pragma unroll 1
        for (int j = 0; j < NCH; j += 2) { HS_STEP(lfA, vA, j); HS_STEP(lfB, vB, j + 1); }
#undef HS_STEP
#undef HS_LOAD
#undef HS_CI
        __syncthreads();
    }
}
__device__ __forceinline__ void phase_hg_out(const Ctx& C, int o_idx) {
    using namespace hg;
    LAS unsigned char* L = C.lds; const unsigned Lb = (unsigned)(uintptr_t)L;
    constexpr unsigned VT = 0, QP = 16384, QM = 32768, KM = 49152, ST = 65536, TOT = 98304, RED = 102400;
    const float* LOGF = WSP(float, WS_LOGF); const bf16_t* VH = WSP(bf16_t, WS_VH); const bf16_t* QH = WSP(bf16_t, WS_QH); const bf16_t* GH = WSP(bf16_t, WS_GH);
    const bf16_t* SS = WSP(bf16_t, WS_SS); bf16_t* Y = WSP(bf16_t, WS_Y); const float* nw = C.inp(23) + o_idx * 128;
    const int w = C.wave, lane = C.lane, tid = C.tid, h5 = lane >> 5, r32 = lane & 31;
    const unsigned tt = w >> 2, dvt = w & 3;
    for (int u = blockIdx.x; u < NBATCH * 16 * NCH; u += gridDim.x) {
        const int b = u / (16 * NCH), hh = (u / NCH) % 16, ci = u % NCH; const size_t R0 = (size_t)b * SROW + ci * 64;
        __syncthreads();
#pragma unroll
        for (int p = 0; p < 2; ++p) { const int row = (tid >> 4) + 32 * p, ch = tid & 15; const u32x4 v = *(const u32x4*)(VH + (R0 + row) * DM + hh * 128 + ch * 8); *(LAS u32x4*)(L + VT + off_b(row, ch)) = v; }
        f32x16 acc = {};
#pragma unroll 1
        for (int dir = 0; dir < 2; ++dir) {
            const int chain = (b * 16 + hh) * 2 + dir;
            u32x4 sreg[4];
#pragma unroll
            for (int p = 0; p < 4; ++p) sreg[p] = *(const u32x4*)(SS + (((size_t)chain * NCH + ci) * 128 + (tid >> 4) + 32 * p) * 128 + (tid & 15) * 8);
            const float* lfp = LOGF + (size_t)dir * MROWS * DM + (R0 + 8 * w) * DM + hh * 128 + 2 * lane;
            const bf16_t* qp = QH + (R0 + 8 * w) * DM + hh * 128 + 2 * lane;
            f32x2 lf[8]; unsigned qv[8]; f32x2 T = {0.f, 0.f};
#pragma unroll
            for (int i = 0; i < 8; ++i) { lf[i] = *(const f32x2*)(lfp + (size_t)i * DM); qv[i] = *(const unsigned*)(qp + (size_t)i * DM); T += lf[i]; }
            *(LAS f32x2*)(L + TOT + (w * 128 + 2 * lane) * 4) = T;
            __syncthreads();
            f32x2 off = {0.f, 0.f}, mid = {0.f, 0.f};
#pragma unroll
            for (int ww = 0; ww < 8; ++ww) { const f32x2 t = *(const LAS f32x2*)(L + TOT + (ww * 128 + 2 * lane) * 4);
                if (dir == 0 ? (ww < w) : (ww > w)) off += t; if (dir == 0 ? (ww < 4) : (ww >= 4)) mid += t; }
            f32x2 B[8];
            if (dir == 0) { B[0] = off + lf[0];
#pragma unroll
                for (int i = 1; i < 8; ++i) B[i] = B[i - 1] + lf[i]; }
            else { B[7] = off + lf[7];
#pragma unroll
                for (int i = 6; i >= 0; --i) B[i] = B[i + 1] + lf[i]; }
#pragma unroll
            for (int i = 0; i < 8; ++i) { const float q0 = __uint_as_float(qv[i] << 16), q1 = __uint_as_float(qv[i] & 0xffff0000u);
                const float k0 = 1.0f - __expf(lf[i].x), k1 = 1.0f - __expf(lf[i].y);
                const unsigned a = off_b(8 * w + i, lane >> 2) + (lane & 3) * 4;
                *(LAS unsigned*)(L + QP + a) = pk2(q0 * __expf(B[i].x), q1 * __expf(B[i].y));
                *(LAS unsigned*)(L + QM + a) = pk2(q0 * __expf(B[i].x - mid.x), q1 * __expf(B[i].y - mid.y));
                *(LAS unsigned*)(L + KM + a) = pk2(k0 * __expf(mid.x - B[i].x), k1 * __expf(mid.y - B[i].y)); }
#pragma unroll
            for (int p = 0; p < 4; ++p) *(LAS u32x4*)(L + ST + off_b((tid >> 4) + 32 * p, tid & 15)) = sreg[p];
            __syncthreads();
            { bf16x8 a[8]; s16x4 bl[8], bh[8];
#pragma unroll
              for (int ks = 0; ks < 8; ++ks) { a[ks] = *(const LAS bf16x8*)(L + QP + row_rd(lane, 32 * tt, ks)); bl[ks] = trr(Lb + ST + tr_nat(lane, dvt, ks, 0)); bh[ks] = trr(Lb + ST + tr_nat(lane, dvt, ks, 1)); }
              HG_WAITL();
#pragma unroll
              for (int ks = 0; ks < 8; ++ks) acc = __builtin_amdgcn_mfma_f32_32x32x16_bf16(a[ks], pk8(bl[ks], bh[ks]), acc, 0, 0, 0); }
            { bf16x8 qb[8];
#pragma unroll
              for (int ks = 0; ks < 8; ++ks) qb[ks] = *(const LAS bf16x8*)(L + QM + row_rd(lane, 32 * tt, ks));
#pragma unroll
              for (unsigned st = 0; st < 2; ++st) { const bool valid = dir == 0 ? (st <= tt) : (st >= tt);
                if (valid) {
                  f32x16 x = {};
#pragma unroll
                  for (int ks = 0; ks < 8; ++ks) { const bf16x8 ka = *(const LAS bf16x8*)(L + KM + row_rd(lane, 32 * st, ks)); x = __builtin_amdgcn_mfma_f32_32x32x16_bf16(ka, qb[ks], x, 0, 0, 0); }
                  if (st == tt) {
#pragma unroll
                    for (int r = 0; r < 16; ++r) { const int kr = crow(r, h5); const bool keep = dir == 0 ? (kr <= r32) : (kr >= r32); x[r] = keep ? x[r] : 0.f; } }
                  const s16x4 v0l = trr(Lb + VT + tr_perm(lane, dvt, 32 * st, 0)), v0h = trr(Lb + VT + tr_perm(lane, dvt, 32 * st, 1));
                  const s16x4 v1l = trr(Lb + VT + tr_perm(lane, dvt, 32 * st + 16, 0)), v1h = trr(Lb + VT + tr_perm(lane, dvt, 32 * st + 16, 1));
                  u32x4 A0, A1; A0.x = pk2(x[0], x[1]); A0.y = pk2(x[2], x[3]); A0.z = pk2(x[4], x[5]); A0.w = pk2(x[6], x[7]);
                  A1.x = pk2(x[8], x[9]); A1.y = pk2(x[10], x[11]); A1.z = pk2(x[12], x[13]); A1.w = pk2(x[14], x[15]);
                  HG_WAITL();
                  acc = __builtin_amdgcn_mfma_f32_32x32x16_bf16(*reinterpret_cast<bf16x8*>(&A0), pk8(v0l, v0h), acc, 0, 0, 0);
                  acc = __builtin_amdgcn_mfma_f32_32x32x16_bf16(*reinterpret_cast<bf16x8*>(&A1), pk8(v1l, v1h), acc, 0, 0, 0);
                } } }
        }
        LAS float* red = (LAS float*)(L + RED);
#pragma unroll
        for (int r = 0; r < 16; ++r) { float s = acc[r] * acc[r]; s += __shfl_xor(s, 1); s += __shfl_xor(s, 2); s += __shfl_xor(s, 4); s += __shfl_xor(s, 8); s += __shfl_xor(s, 16);
            if (r32 == 0) red[(tt * 32 + crow(r, h5)) * 4 + dvt] = s; }
        __syncthreads();
        const int col = hh * 128 + 32 * dvt + r32; const float wv = nw[32 * dvt + r32];
#pragma unroll
        for (int r = 0; r < 16; ++r) { const int row = 32 * tt + crow(r, h5); const f32x4 p = *(const LAS f32x4*)(red + row * 4);
            const float rstd = 1.0f / sqrtf(((p.x + p.y) + (p.z + p.w)) * (1.0f / 128.0f) + EPS); const size_t o = (R0 + row) * DM + col;
            Y[o] = (bf16_t)f2bf(acc[r] * rstd * wv * bf2f(GH[o])); }
    }
}
template <bool FINAL>
__device__ __forceinline__ void phase_lru(const Ctx& C, int e) {
    using namespace hg;
    LAS unsigned char* L = C.lds;
    constexpr unsigned UCB = 0, UCF = 16384, AT = 49152, BT = 81920, SEGB = 114688;
    const bf16_t* P = WSP(bf16_t, WS_P); float* AG = WSP(float, WS_AG); const float* CARRY = WSP(float, WS_CARRY); bf16_t* Y = WSP(bf16_t, WS_Y);
    const bf16_t* WG = WSP(bf16_t, WS_WG) + (size_t)e * 4 * 128 * 1024;
    const float* cw = C.inp(10) + (size_t)e * 4 * DLRU; const float* cb = C.inp(11) + (size_t)e * DLRU;
    const float* ba = C.inp(13) + (size_t)e * 2 * DLRU; const float* bx = C.inp(15) + (size_t)e * 2 * DLRU; const float* lam = C.inp(16) + (size_t)e * 2 * DLRU;
    const int w = C.wave, lane = C.lane, tid = C.tid, h5 = lane >> 5, r32 = lane & 31;
    const unsigned rt = w >> 2, et = w & 3;
    for (int u = gridDim.x - 1 - blockIdx.x; u < (MROWS / 64) * 8; u += gridDim.x) {
        const int ci2 = u >> 3, hd = u & 7; const int c = ci2 % NCH, bb = ci2 / NCH; const size_t R0 = (size_t)ci2 * 64;
        const int s0 = c * 64, lo = c < 4 ? 0 : CTX, hi = c < 4 ? CTX : SROW;
        __syncthreads();
        float cin0 = 0.f, cin1 = 0.f;
        if (FINAL) { const int ch = tid & 127; cin0 = CARRY[(size_t)(ci2 * 2 + 0) * DLRU + hd * 128 + ch]; cin1 = CARRY[(size_t)(ci2 * 2 + 1) * DLRU + hd * 128 + ch]; }
        { const int chn = hd * 128 + 2 * lane; const bf16_t* up = P + DLRU + chn;
          f32x2 uv[11];
#pragma unroll
          for (int i = 0; i < 11; ++i) { const int s = s0 + 8 * w + i - 2; unsigned raw = 0u; if (s >= lo && s < hi) raw = *(const unsigned*)(up + ((size_t)bb * SROW + s) * ABNP);
              uv[i].x = __uint_as_float(raw << 16); uv[i].y = __uint_as_float(raw & 0xffff0000u); }
          f32x2 wj[4];
#pragma unroll
          for (int j = 0; j < 4; ++j) wj[j] = *(const f32x2*)(cw + j * DLRU + chn);
          const f32x2 bias = *(const f32x2*)(cb + chn);
#pragma unroll
          for (int i = 0; i < 8; ++i) { f32x2 a = bias;
#pragma unroll
              for (int j = 0; j < 4; ++j) a += uv[i + j] * wj[j];
              *(LAS unsigned*)(L + UCB + off_b(8 * w + i, lane >> 2) + (lane & 3) * 4) = pk2(a.x, a.y);
              *(LAS f32x2*)(L + UCF + ((8 * w + i) * 128 + 2 * lane) * 4) = a; } }
        __syncthreads();
        bf16x8 af[8]; float ucr[16];
#pragma unroll
        for (int ks = 0; ks < 8; ++ks) af[ks] = *(const LAS bf16x8*)(L + UCB + row_rd(lane, 32 * rt, ks));
#pragma unroll
        for (int r = 0; r < 16; ++r) ucr[r] = *(const LAS float*)(L + UCF + ((32 * rt + crow(r, h5)) * 128 + 32 * et + r32) * 4);
        const int chl = hd * 128 + 32 * et + r32;
#pragma unroll 1
        for (int dir = 0; dir < 2; ++dir) {
            f32x16 ga = {}, gx = {};
            { const bf16_t* wa = WG + ((size_t)(dir * 2 + 0) * 128 + 32 * et + r32) * 1024 + hd * 128 + 8 * h5; const bf16_t* wx = wa + (size_t)128 * 1024;
              bf16x8 fa[8], fx[8];
#pragma unroll
              for (int ks = 0; ks < 8; ++ks) { fa[ks] = *(const bf16x8*)(wa + 16 * ks); fx[ks] = *(const bf16x8*)(wx + 16 * ks); }
#pragma unroll
              for (int ks = 0; ks < 8; ++ks) { ga = __builtin_amdgcn_mfma_f32_32x32x16_bf16(af[ks], fa[ks], ga, 0, 0, 0); gx = __builtin_amdgcn_mfma_f32_32x32x16_bf16(af[ks], fx[ks], gx, 0, 0, 0); } }
            const float bav = ba[dir * DLRU + chl], bxv = bx[dir * DLRU + chl], sp = log1pf(__expf(-lam[dir * DLRU + chl]));
            if (dir == 1) __syncthreads();
#pragma unroll
            for (int r = 0; r < 16; ++r) { const float rg = __builtin_amdgcn_rcpf(1.0f + __expf(-(ga[r] + bav))), ig = __builtin_amdgcn_rcpf(1.0f + __expf(-(gx[r] + bxv)));
                const float la = -8.0f * rg * sp; const unsigned o = ((32 * rt + crow(r, h5)) * 128 + 32 * et + r32) * 4;
                *(LAS float*)(L + AT + o) = __expf(la); *(LAS float*)(L + BT + o) = __builtin_amdgcn_sqrtf(1.0f - __expf(2.0f * la)) * (ig * ucr[r]); }
            __syncthreads();
            { const int seg = tid >> 7, ch = tid & 127; const LAS float* ap = (const LAS float*)(L + AT) + ch; const LAS float* bp = (const LAS float*)(L + BT) + ch;
              LAS f32x2* sg4 = (LAS f32x2*)(L + SEGB);
              float h = 0.f, pr = 1.f;
#pragma unroll
              for (int i = 0; i < 16; ++i) { const int row = dir == 0 ? 16 * seg + i : 63 - 16 * seg - i; const float a = ap[row * 128]; h = a * h + bp[row * 128]; pr *= a; }
              sg4[seg * 128 + ch] = (f32x2){pr, h};
              __syncthreads();
              float cs = FINAL ? (dir == 0 ? cin0 : cin1) : 0.f, pa = 1.f;
#pragma unroll
              for (int q = 0; q < 3; ++q) if (q < seg) { const f32x2 t = sg4[q * 128 + ch]; cs = cs * t.x + t.y; pa *= t.x; }
              if (!FINAL) { if (seg == 3) { float* ag = AG + ((size_t)(ci2 * 2 + dir) * 2) * DLRU + hd * 128 + ch; ag[0] = pa * pr; ag[DLRU] = cs * pr + h; } }
              else { LAS float* hp = (LAS float*)(L + (dir == 0 ? UCF : AT)) + ch;
                  h = cs;
#pragma unroll
                  for (int i = 0; i < 16; ++i) { const int row = dir == 0 ? 16 * seg + i : 63 - 16 * seg - i; h = ap[row * 128] * h + bp[row * 128]; hp[row * 128] = h; } } }
        }
        if (FINAL) {
            __syncthreads();
            const int row = tid >> 3, c16 = (tid & 7) * 16; const bf16_t* gp = P + (R0 + row) * ABNP + hd * 128 + c16; bf16_t* yp = Y + (R0 + row) * DM + hd * 128 + c16;
            const u32x4 g0 = *(const u32x4*)gp, g1 = *(const u32x4*)(gp + 8); u32x4 o0, o1;
            const LAS f32x4* hf = (const LAS f32x4*)(L + UCF + (row * 128 + c16) * 4); const LAS f32x4* hb = (const LAS f32x4*)(L + AT + (row * 128 + c16) * 4);
#pragma unroll
            for (int q = 0; q < 4; ++q) { const f32x4 hs = hf[q] + hb[q]; const unsigned ga = q < 2 ? g0[2 * q] : g1[2 * q - 4], gb = q < 2 ? g0[2 * q + 1] : g1[2 * q - 3];
                const float y0 = hs.x * gelu_tanh(__uint_as_float(ga << 16)), y1 = hs.y * gelu_tanh(__uint_as_float(ga & 0xffff0000u)), y2 = hs.z * gelu_tanh(__uint_as_float(gb << 16)), y3 = hs.w * gelu_tanh(__uint_as_float(gb & 0xffff0000u));
                if (q < 2) { o0[2 * q] = pk2(y0, y1); o0[2 * q + 1] = pk2(y2, y3); } else { o1[2 * q - 4] = pk2(y0, y1); o1[2 * q - 3] = pk2(y2, y3); } }
            *(u32x4*)yp = o0; *(u32x4*)(yp + 8) = o1;
        }
    }
}
__device__ __forceinline__ void phase_lru_carry(const Ctx& C) {
    using namespace hg;
    const float* AG = WSP(float, WS_AG); float* CARRY = WSP(float, WS_CARRY);
    const int G = gridDim.x, first = G >= 8 ? G - 8 : 0;
    if ((int)blockIdx.x < first) return;
    for (int id = ((int)blockIdx.x - first) * 512 + C.tid; id < NBATCH * 2 * DLRU; id += (G - first) * 512) { const int b = id >> 11, dir = (id >> 10) & 1, ch = id & 1023;
        float carry = 0.f;
#pragma unroll 4
        for (int j = 0; j < NCH; ++j) { const int cc = dir == 0 ? j : (j < 4 ? 3 - j : 71 - j); const size_t ci2 = (size_t)b * NCH + cc;
            CARRY[(ci2 * 2 + dir) * DLRU + ch] = carry; const float* ag = AG + ((ci2 * 2 + dir) * 2) * DLRU + ch; carry = carry * ag[0] + ag[DLRU]; } }
}
__device__ __forceinline__ void phase_final(const Ctx& C) {
    const float* XS = WSP(float, WS_XS); const float* w = C.inp(27);
    for (int r = C.gw; r < NBATCH * SEQ; r += C.ngw) { const int b = r / SEQ, t = r % SEQ; const size_t R = (size_t)b * SROW + CTX + t;
        const f32x4* xr = (const f32x4*)(XS + R * DM) + C.lane; f32x4 v[8]; float ss = 0.f;
#pragma unroll
        for (int j = 0; j < 8; ++j) { v[j] = xr[64 * j]; ss += (v[j].x * v[j].x + v[j].y * v[j].y) + (v[j].z * v[j].z + v[j].w * v[j].w); }
        const float rstd = 1.0f / sqrtf(wave_sum(ss) * (1.0f / DM) + EPS);
        f32x4* o = (f32x4*)(C.out + (size_t)r * DM) + C.lane;
#pragma unroll
        for (int j = 0; j < 8; ++j) { const f32x4 wv = *(const f32x4*)(w + (C.lane + 64 * j) * 4); o[64 * j] = v[j] * rstd * wv; } }
}

struct Args { const float* in[28]; float* out; unsigned char* ws; int ph_lo, ph_hi; };
constexpr int N_PHASES = 1 + 2 * 9 + 2 * 8 + 1;

__global__ void __launch_bounds__(512, 2) fwd_kernel(Args args) {
    extern __shared__ __attribute__((aligned(16))) unsigned char lds_raw[];
    LAS unsigned char* const lds0 = (LAS unsigned char*)lds_raw;
    const unsigned long long inaddr = (unsigned long long)__builtin_amdgcn_kernarg_segment_ptr();
    volatile LAS unsigned* misc = (volatile LAS unsigned*)(lds0 + LDS_MISC);
    if (threadIdx.x < 64) misc[threadIdx.x] = 0u;
    __syncthreads();
    const int lo = args.ph_lo, hi = args.ph_hi;
    const int wave0 = __builtin_amdgcn_readfirstlane(threadIdx.x >> 6);
    XcdBarrier bar; bar.bar = (unsigned*)(args.ws + WS_CTL) + 4096; bar.x = 0; bar.st = misc + 8;
    if (hi - lo > 1) bar = xcd_barrier_post((unsigned*)(args.ws + WS_CTL) + 4096, misc + 8);
    int pid = 0;
    const unsigned long long wsaddr = (unsigned long long)args.ws;
#define PH_BEGIN if (pid >= lo && pid < hi) { int l = l_; Ctx C; { unsigned long long a_ = inaddr, w_ = wsaddr; int t_; asm volatile("v_mbcnt_lo_u32_b32 %0, -1, 0\n\tv_mbcnt_hi_u32_b32 %0, -1, %0" : "=v"(t_)); t_ += wave0 * 64; asm volatile("" : "+s"(a_), "+s"(w_), "+s"(l)); \
        C.in = (InPtr)a_; C.ws = (unsigned char*)(GAS unsigned char*)w_; C.out = (float*)(GAS float*)args.out; C.lds = lds0; C.tid = t_; C.lane = t_ & 63; C.wave = __builtin_amdgcn_readfirstlane(t_ >> 6); \
        C.gw = blockIdx.x * 8 + C.wave; C.ngw = gridDim.x * 8; C.gtid = blockIdx.x * 512 + t_; C.ngt = gridDim.x * 512; } \
        const int e = l >> 1; const float* mod = WSP(float, WS_MOD) + (size_t)l * 3 * MODW; const int G = gridDim.x, cb = blockIdx.x; (void)e; (void)mod; (void)G; (void)cb;
#define PH_END } if (pid >= lo && pid + 1 < hi) xcd_barrier(bar); ++pid;
#ifndef PROBE_CAT
#define PROBE_CAT -1
#endif
#define DUP(cat, ...) { if (PROBE_CAT == (cat)) { const float SC_ = 0.f; (void)SC_; __VA_ARGS__ } { const float SC_ = 1.f; (void)SC_; __VA_ARGS__ } }
    int l_ = 0;
    PH_BEGIN
#ifndef SKIP_PRO
    DUP(0, phase_prologue(C);)
#endif
    PH_END

    constexpr int MLAT = NBATCH * SEQ;
    for (l_ = 0; l_ < DEPTH; ++l_) {
        PH_BEGIN DUP(1, phase_norm_mod(C, C.inp(6) + l * DM, mod, 0, 1);) PH_END
        if ((l_ & 1) == 0) {
            PH_BEGIN DUP(2, { const bf16_t* wt = WSP(bf16_t, WS_WABIN) + (size_t)e * ABNP * DM;
                       { pg8::Gemm g{WSP(bf16_t, WS_H), wt, MLAT, ABNP, DM, DM, DM, 1}; pg8::StaticOrder S; S.init(MLAT, ABNP, G, cb); EpiBf16Plain E{WSP(bf16_t, WS_P), ABNP}; pg8::gemm_phase(C.lds, C.tid, g, S, E); }
                       DUP(14, { sg::SGemm g{WSP(bf16_t, WS_H), wt, ABNP, DM, DM, DM}; SEpiPlain E{WSP(bf16_t, WS_P), ABNP}; sg::sgemm_phase(C.lds, C.tid, g, 32 * (ABNP / 256), E); }) }) PH_END
            PH_BEGIN DUP(3, { phase_lru<false>(C, e); phase_rs_kr(C); }) PH_END
            PH_BEGIN phase_lru_carry(C); DUP(4, { const bf16_t* wq = WSP(bf16_t, WS_WUQ) + (size_t)e * QW * 512; const bf16_t* wkv = WSP(bf16_t, WS_WUKV) + (size_t)e * KVW * 512;
                       { pg8::Gemm g{WSP(bf16_t, WS_P) + 2048, wq, MLAT, QW, 512, ABNP, 512, 1}; pg8::StaticOrder S; S.init(MLAT, QW, G, cb); EpiBf16RowScale E{WSP(bf16_t, WS_Q), QW, WSP(float, WS_RSQ)}; pg8::gemm_phase(C.lds, C.tid, g, S, E); }
                       { pg8::Gemm g{WSP(bf16_t, WS_P) + 2560, wkv, MLAT, KVW, 512, ABNP, 512, 1}; pg8::StaticOrder S; S.init(MLAT, KVW, G, cb); EpiBf16RowScale E{WSP(bf16_t, WS_KV), KVW, WSP(float, WS_RSKV)}; pg8::gemm_phase(C.lds, C.tid, g, S, E); }
                       DUP(14, { sg::SGemm g{WSP(bf16_t, WS_P) + 2048, wq, QW, 512, ABNP, 512}; SEpiRowScale E{WSP(bf16_t, WS_Q), QW, WSP(float, WS_RSQ)}; sg::sgemm_phase(C.lds, C.tid, g, 32 * (QW / 256), E); })
                       DUP(14, { sg::SGemm g{WSP(bf16_t, WS_P) + 2560, wkv, KVW, 512, ABNP, 512}; SEpiRowScale E{WSP(bf16_t, WS_KV), KVW, WSP(float, WS_RSKV)}; sg::sgemm_phase(C.lds, C.tid, g, 0, E); }) })
            PH_END
            PH_BEGIN DUP(5, phase_lru<true>(C, e);) DUP(6, phase_attn(C);) PH_END
        } else {
            PH_BEGIN DUP(7, { const bf16_t* wt = WSP(bf16_t, WS_WHGIN) + (size_t)e * HGN * DM;
                       { pg8::Gemm g{WSP(bf16_t, WS_H), wt, MLAT, HGN, DM, DM, DM, 1}; pg8::StaticOrder S; S.init(MLAT, HGN, G, cb); EpiHG E{WSP(bf16_t, WS_QH), WSP(float, WS_LOGF), WSP(float, WS_LB) + l * 2048}; pg8::gemm_phase(C.lds, C.tid, g, S, E); }
                       DUP(14, { sg::SGemm g{WSP(bf16_t, WS_H), wt, HGN, DM, DM, DM}; SEpiHG E{WSP(bf16_t, WS_QH), WSP(float, WS_LOGF), WSP(float, WS_LB) + l * 2048}; sg::sgemm_phase(C.lds, C.tid, g, 32 * (HGN / 256), E); }) }) PH_END
            PH_BEGIN DUP(8, phase_hg_state(C);) PH_END
            PH_BEGIN DUP(10, phase_hg_out(C, e);) PH_END
        }
        PH_BEGIN DUP(11, { const bf16_t* wout = (l & 1) ? WSP(bf16_t, WS_WHGOUT) + (size_t)e * DM * DM : WSP(bf16_t, WS_WABOUT) + (size_t)e * DM * DM;
                   { pg8::Gemm g{WSP(bf16_t, WS_Y), wout, MLAT, DM, DM, DM, DM, 1}; pg8::StaticOrder S; S.init(MLAT, DM, G, cb); EpiResid E{WSP(float, WS_XS), mod + 2 * DM, SC_}; pg8::gemm_phase(C.lds, C.tid, g, S, E); }
                   if (l != DEPTH - 1) DUP(14, { sg::SGemm g{WSP(bf16_t, WS_Y), wout, DM, DM, DM, DM}; SEpiResid E{WSP(float, WS_XS), mod + 2 * DM, SC_}; sg::sgemm_phase(C.lds, C.tid, g, 32 * (DM / 256), E); }) }) PH_END
        PH_BEGIN DUP(1, phase_norm_mod(C, C.inp(7) + l * DM, mod, 3, 4);) PH_END
        PH_BEGIN DUP(12, { const bf16_t* wt = WSP(bf16_t, WS_W1) + (size_t)l * DFF * DM;
                   { pg8::Gemm g{WSP(bf16_t, WS_H), wt, MLAT, DFF, DM, DM, DM, 1}; pg8::StaticOrder S; S.init(MLAT, DFF, G, cb); EpiRelu2 E{WSP(bf16_t, WS_HID), DFF}; pg8::gemm_phase(C.lds, C.tid, g, S, E); }
                   if (l != DEPTH - 1) DUP(16, { sg::SGemm g{WSP(bf16_t, WS_H), wt, DFF, DM, DM, DM}; SEpiRelu2 E{WSP(bf16_t, WS_HID), DFF}; sg::sgemm_phase(C.lds, C.tid, g, 32 * (DFF / 256), E); }) }) PH_END
        PH_BEGIN DUP(13, { const bf16_t* wt = WSP(bf16_t, WS_W2) + (size_t)l * DM * DFF;
                   { pg8::Gemm g{WSP(bf16_t, WS_HID), wt, MLAT, DM, DFF, DFF, DFF, 1}; pg8::StaticOrder S; S.init(MLAT, DM, G, cb); EpiResid E{WSP(float, WS_XS), mod + 5 * DM, SC_}; pg8::gemm_phase(C.lds, C.tid, g, S, E); }
                   if (l != DEPTH - 1) DUP(15, { sg::SGemm g{WSP(bf16_t, WS_HID), wt, DM, DFF, DFF, DFF}; SEpiResid E{WSP(float, WS_XS), mod + 5 * DM, SC_}; sg::sgemm_phase(C.lds, C.tid, g, 32 * (DM / 256), E); }) }) PH_END
    }
    l_ = 0;
    PH_BEGIN phase_final(C); PH_END
}

#ifndef N_LAUNCH_MODE
#define N_LAUNCH_MODE 1
#endif
extern "C" void kernel_launch(void* const* d_in, const int* in_sizes, int n_in, void* d_out, int out_size, void* d_ws, size_t ws_size, hipStream_t stream) {
    static int grid = 0;
    if (grid == 0) {
        if (n_in != 28 || out_size != NBATCH * SEQ * DM || ws_size < WS_END) { fprintf(stderr, "kernel_launch: shape mismatch n_in %d out %d ws %zu (need %zu)\n", n_in, out_size, ws_size, (size_t)WS_END); grid = -1; return; }
        int dev = 0, cus = 0, per_cu = 0;
        if (hipGetDevice(&dev) != hipSuccess || hipDeviceGetAttribute(&cus, hipDeviceAttributeMultiprocessorCount, dev) != hipSuccess) { grid = -1; return; }
        if (hipFuncSetAttribute((const void*)fwd_kernel, hipFuncAttributeMaxDynamicSharedMemorySize, LDS_BYTES) != hipSuccess) { fprintf(stderr, "kernel_launch: hipFuncSetAttribute failed\n"); grid = -1; return; }
        if (hipOccupancyMaxActiveBlocksPerMultiprocessor(&per_cu, (const void*)fwd_kernel, 512, LDS_BYTES) != hipSuccess || per_cu < 1) fprintf(stderr, "kernel_launch: occupancy query says %d\n", per_cu);
        (void)hipGetLastError();
        grid = cus;
    }
    if (grid < 0) return;
    (void)hipMemsetAsync((char*)d_ws + WS_CTL, 0, CTL_BYTES, stream);
    Args a{};
    for (int i = 0; i < 28; ++i) a.in[i] = (const float*)d_in[i];
    a.out = (float*)d_out; a.ws = (unsigned char*)d_ws;
#if N_LAUNCH_MODE == 1
    a.ph_lo = 0; a.ph_hi = N_PHASES;
    hipLaunchKernelGGL(fwd_kernel, dim3(grid), dim3(512), LDS_BYTES, stream, a);
#else
    for (int p = 0; p < N_PHASES; ++p) { a.ph_lo = p; a.ph_hi = p + 1; hipLaunchKernelGGL(fwd_kernel, dim3(grid), dim3(512), LDS_BYTES, stream, a); }
#endif
    const hipError_t le = hipPeekAtLastError();
    if (le != hipSuccess) fprintf(stderr, "kernel_launch: launch failed: %s\n", hipGetErrorName(le));
}
```

```cpp
#include <hip/hip_runtime.h>
#include <cstdio>

#define LAS __attribute__((address_space(3)))
#define GAS __attribute__((address_space(1)))
typedef unsigned short bf16_t;
typedef short bf16x8 __attribute__((ext_vector_type(8)));
typedef float f32x4 __attribute__((ext_vector_type(4)));
typedef float f32x2 __attribute__((ext_vector_type(2)));
typedef unsigned u32x4 __attribute__((ext_vector_type(4)));
typedef unsigned u32x2 __attribute__((ext_vector_type(2)));
typedef _Float16 f16_t;
typedef _Float16 f16x2 __attribute__((ext_vector_type(2)));
typedef _Float16 f16x8 __attribute__((ext_vector_type(8)));

constexpr int DM = 2048, NBATCH = 2, SEQ = 4096, DEPTH = 4, CTX = 256;
constexpr int SROW = CTX + SEQ;
constexpr int MROWS = NBATCH * SROW;
constexpr int DFF = 8192, MODW = 6 * DM;
constexpr int DLRU = 1024;
constexpr int ABN = 3136, ABNP = 3328;
constexpr int QW = 1536, KVW = 2048, HGN = 10240;
constexpr float EPS = 1e-6f;
constexpr float ATTN_SCALE = 0.07216878364870322f;

constexpr size_t al256(size_t x) { return (x + 255) & ~(size_t)255; }
constexpr size_t WS_CTL = 0, CTL_BYTES = 1u << 20;
constexpr size_t WS_MOD = WS_CTL + CTL_BYTES;
constexpr size_t WS_LB = WS_MOD + al256((size_t)DEPTH * 3 * MODW * 4);
constexpr size_t WS_ROPE = WS_LB + al256((size_t)DEPTH * 2048 * 4);
constexpr size_t WS_RSQ = WS_ROPE + al256(2 * 64 * 16 * 4);
constexpr size_t WS_RSKV = WS_RSQ + al256((size_t)MROWS * 4);
constexpr size_t WS_WABIN = WS_RSKV + al256((size_t)MROWS * 4);
constexpr size_t WS_WABOUT = WS_WABIN + (size_t)2 * ABNP * DM * 2;
constexpr size_t WS_WUQ = WS_WABOUT + (size_t)2 * DM * DM * 2;
constexpr size_t WS_WUKV = WS_WUQ + (size_t)2 * QW * 512 * 2;
constexpr size_t WS_WHGIN = WS_WUKV + (size_t)2 * KVW * 512 * 2;
constexpr size_t WS_WHGOUT = WS_WHGIN + (size_t)2 * HGN * DM * 2;
constexpr size_t WS_W1 = WS_WHGOUT + (size_t)2 * DM * DM * 2;
constexpr size_t WS_W2 = WS_W1 + (size_t)4 * DFF * DM * 2;
constexpr size_t WS_WG = WS_W2 + (size_t)4 * DFF * DM * 2;
constexpr size_t WS_XS = WS_WG + (size_t)2 * 4 * 128 * 1024 * 2;
constexpr size_t WS_H = WS_XS + (size_t)MROWS * DM * 4;
constexpr size_t WS_Y = WS_H + (size_t)MROWS * DM * 2;
constexpr size_t WS_BIG = WS_Y + (size_t)MROWS * DM * 2;
constexpr size_t WS_P = WS_BIG;
constexpr size_t WS_AG = WS_P + (size_t)MROWS * ABNP * 2;
constexpr size_t WS_CARRY = WS_AG + al256((size_t)(MROWS / 64) * 2 * 2 * DLRU * 4);
constexpr size_t WS_Q = WS_CARRY + al256((size_t)(MROWS / 64) * 2 * DLRU * 4);
constexpr size_t WS_KV = WS_Q + (size_t)MROWS * QW * 2;
constexpr size_t WS_KR = WS_KV + (size_t)MROWS * KVW * 2;
constexpr size_t WS_AB_END = WS_KR + (size_t)MROWS * 64 * 2;
constexpr size_t WS_QH = WS_BIG;
constexpr size_t WS_VH = WS_QH + (size_t)MROWS * DM * 2;
constexpr size_t WS_GH = WS_VH + (size_t)MROWS * DM * 2;
constexpr size_t WS_LOGF = WS_GH + (size_t)MROWS * DM * 2;
constexpr size_t WS_SS = WS_LOGF + (size_t)2 * MROWS * DM * 2;
constexpr size_t WS_HG_END = WS_SS + (size_t)64 * 68 * 16384 * 2;
constexpr size_t WS_HID = WS_BIG;
constexpr size_t WS_MLP_END = WS_HID + (size_t)MROWS * DFF * 2;
constexpr size_t cmax(size_t a, size_t b) { return a > b ? a : b; }
constexpr size_t WS_END = cmax(cmax(WS_AB_END, WS_HG_END), WS_MLP_END);

constexpr int LDS_BYTES = 147456;
constexpr int LDS_MISC = 139264;

__device__ __forceinline__ float bf2f(bf16_t v) { return __uint_as_float(((unsigned)v) << 16); }
__device__ __forceinline__ unsigned f2bf(float f) { unsigned u = __float_as_uint(f); return (u + 0x7fffu + ((u >> 16) & 1u)) >> 16; }
__device__ __forceinline__ unsigned pk2(float lo, float hi) { return f2bf(lo) | (f2bf(hi) << 16); }
__device__ __forceinline__ float wave_sum(float v) {
#pragma unroll
    for (int o = 1; o < 64; o <<= 1) v += __shfl_xor(v, o);
    return v;
}
__device__ __forceinline__ float wave_max(float v) {
#pragma unroll
    for (int o = 1; o < 64; o <<= 1) v = fmaxf(v, __shfl_xor(v, o));
    return v;
}
__device__ __forceinline__ float sigmoidf_(float x) { return 1.0f / (1.0f + expf(-x)); }
__device__ __forceinline__ float siluf_(float x) { return x / (1.0f + expf(-x)); }
__device__ __forceinline__ float fsigmoid(float x) { return __builtin_amdgcn_rcpf(1.0f + __expf(-x)); }
__device__ __forceinline__ float gelu_tanh(float x) { const float u = 0.7978845608028654f * (x + 0.044715f * x * x * x); return x * fsigmoid(2.0f * u); }

#define XB_TMO      128
#define XB_XCNT(j)  (256  + 64 * (j))
#define XB_XSUB(j)  (1280 + 64 * (j))
#define XB_XGEN(j)  (2304 + 64 * (j))
#define XB_TOP      3328
#define XB_TOPGEN   3392
#define XCD_BAR_WORDS 3456
#define XB_SPIN_CAP (1u << 18)
__device__ __forceinline__ unsigned xb_ld(unsigned* p)              { return __hip_atomic_load(p, __ATOMIC_RELAXED, __HIP_MEMORY_SCOPE_AGENT); }
__device__ __forceinline__ unsigned xb_add(unsigned* p, unsigned v) { return __hip_atomic_fetch_add(p, v, __ATOMIC_RELAXED, __HIP_MEMORY_SCOPE_AGENT); }
__device__ __forceinline__ unsigned xb_xcc_id() { return (unsigned)__builtin_amdgcn_s_getreg((3 << 11) | 20) & 0xFu; }
#define XB_SPIN(cond, bar) do { unsigned _sp = 0; while (cond) { __builtin_amdgcn_s_sleep(1); \
    if ((++_sp & 255u) == 0u) { if (xb_ld(&(bar)[XB_TMO])) break; if (_sp > XB_SPIN_CAP) { atomicAdd(&(bar)[XB_TMO], 1u); break; } } } } while (0)
struct XcdBarrier { unsigned* bar; unsigned x; volatile LAS unsigned* st; };
__device__ __forceinline__ XcdBarrier xcd_barrier_post(unsigned* bar, volatile LAS unsigned* st) {
    XcdBarrier b; b.bar = bar; b.x = xb_xcc_id(); b.st = st;
    if (threadIdx.x == 0) (void)xb_add(&bar[XB_XCNT(b.x)], 1u);
    return b;
}
__device__ __forceinline__ void xcd_barrier_complete(unsigned* bar, unsigned x, unsigned& nloc, unsigned& nx) {
    const unsigned G = gridDim.x * gridDim.y * gridDim.z;
    unsigned sum, cnt, mine, sp = 0u;
    for (;;) {
        sum = 0u; cnt = 0u; mine = 0u;
#pragma unroll
        for (unsigned j = 0; j < 16; ++j) { const unsigned c = xb_ld(&bar[XB_XCNT(j)]); sum += c; cnt += (c > 0u) ? 1u : 0u; mine = (j == x) ? c : mine; }
        if (sum == G) break;
        __builtin_amdgcn_s_sleep(1);
        if ((++sp & 255u) == 0u) { if (xb_ld(&bar[XB_TMO])) break; if (sp > XB_SPIN_CAP) { atomicAdd(&bar[XB_TMO], 1u); break; } }
    }
    nloc = mine > 0u ? mine : 1u; nx = cnt > 0u ? cnt : 1u;
}
__device__ __forceinline__ void xcd_barrier(const XcdBarrier& b) {
    asm volatile("s_waitcnt vmcnt(0)" ::: "memory");
    __syncthreads();
    if (threadIdx.x == 0) {
        unsigned* bar = b.bar; asm volatile("" : "+s"(bar)); bar = (unsigned*)(GAS unsigned*)bar;
        __builtin_amdgcn_s_waitcnt(0);
        unsigned nloc = b.st[0], nx = b.st[1];
        if (nloc == 0u) { xcd_barrier_complete(bar, b.x, nloc, nx); b.st[0] = nloc; b.st[1] = nx; }
        const unsigned old = xb_add(&bar[XB_XSUB(b.x)], 1u);
        const unsigned gen = old / nloc;
        if (old + 1u == (gen + 1u) * nloc) {
            __builtin_amdgcn_fence(__ATOMIC_RELEASE, "agent");
            asm volatile("s_waitcnt vmcnt(0)" ::: "memory");
            const unsigned og = xb_add(&bar[XB_TOP], 1u);
            const unsigned tg = og / nx;
            if (og + 1u == (tg + 1u) * nx) xb_add(&bar[XB_TOPGEN], 1u);
            else XB_SPIN(xb_ld(&bar[XB_TOPGEN]) == tg, bar);
            __builtin_amdgcn_fence(__ATOMIC_ACQUIRE, "agent");
            xb_add(&bar[XB_XGEN(b.x)], 1u);
            asm volatile("s_waitcnt vmcnt(0)" ::: "memory");
        } else {
            XB_SPIN(xb_ld(&bar[XB_XGEN(b.x)]) == gen, bar);
            __builtin_amdgcn_fence(__ATOMIC_ACQUIRE, "agent");
            asm volatile("s_waitcnt vmcnt(0)" ::: "memory");
        }
    }
    __syncthreads();
}

namespace pg8 {
constexpr int BM = 256, BK = 64, HALF = 128, HTB = HALF * BK * 2, STAGE_BYTES = 8 * HTB, NXCD = 8, WGM = 8;
__host__ __device__ __forceinline__ int lds_byte(int r, int c) { const int st = (r >> 4) * 2 + (c >> 5), rr = r & 15, cc = c & 31, ob = rr * 64 + cc * 2; return st * 1024 + (ob ^ (((ob >> 9) & 1) << 5)); }
__host__ __device__ __forceinline__ void stage_rc(int b, int& R, int& C) { const int st = b / 1024, sb = b % 1024, swz = sb ^ (((sb >> 9) & 1) << 5); R = (st >> 1) * 16 + swz / 64; C = (st & 1) * 32 + (swz % 64) / 2; }
__host__ __device__ __forceinline__ int perm32(int rho) { const int n = rho >> 4, i = rho & 15; return 8 * (i >> 2) + 4 * n + (i & 3); }
struct Unit { int pm, pn; };
struct Gemm { const bf16_t* A; const bf16_t* Bt; int M, N, K, lda, ldb, lat; };
struct StaticOrder {
    int nM, nN, nwg, G, c;
    __host__ __device__ void init(int M, int N, int G_, int c_) { nM = M / BM; nN = N / BM; nwg = nM * nN; G = G_; c = c_; }
    __host__ __device__ bool next(int i, Unit& u) const {
        const long L = (long)i * G + c; if (L >= nwg) return false;
        int wgid = (int)L; { const int q = nwg / NXCD, r = nwg % NXCD, xcd = wgid % NXCD, off = wgid / NXCD; wgid = (xcd < r ? xcd * (q + 1) : r * (q + 1) + (xcd - r) * q) + off; }
        const int nig = WGM * nN, gid = wgid / nig, fm = gid * WGM, gsz = (nM - fm) < WGM ? (nM - fm) : WGM;
        u.pm = fm + ((wgid % nig) % gsz); u.pn = (wgid % nig) / gsz; return true;
    }
};
__device__ __forceinline__ unsigned cvt_pk_bf16(float lo, float hi) { unsigned r; asm volatile("v_cvt_pk_bf16_f32 %0, %1, %2" : "=v"(r) : "v"(lo), "v"(hi)); return r; }

template <class Epi>
__device__ __forceinline__ void gemm_phase(LAS unsigned char* lds, const int tid, const Gemm g, const StaticOrder& S, const Epi& E) {
    const int wid = __builtin_amdgcn_readfirstlane(tid >> 6), lane = tid & 63, wr = wid >> 2, wc = wid & 3, fr = lane & 15, fq = lane >> 4;
    const int K = g.K, nt = K / BK;
    unsigned voffA[2], voffB[2];
#pragma unroll
    for (int i = 0; i < 2; ++i) { int R, C; stage_rc(tid * 16 + i * 8192, R, C); const int Rb = Epi::PERM ? ((R & ~31) + perm32(R & 31)) : R;
        voffA[i] = (unsigned)(R * g.lda + C) * 2u; voffB[i] = (unsigned)(Rb * g.ldb + C) * 2u; }
    const size_t kstep = (size_t)(BK * 2);
    const size_t hsA = (size_t)HALF * g.lda * 2, hsB = (size_t)HALF * g.ldb * 2;
    const size_t tsA = 2 * hsA, tsB = 2 * hsB;
    const unsigned ldsw = (unsigned)wid * 1024u;
    const int aoff = lds_byte(wr * 64 + fr, fq * 8), boff = lds_byte(wc * 32 + fr, fq * 8);
#define PG8_SA(b, h) (((b) * 2 + (h)) * HTB)
#define PG8_SB(b, h) ((4 + (b) * 2 + (h)) * HTB)
#define PG8_STAGE(bufoff, gbase, voff) do { _Pragma("unroll") for (int _i = 0; _i < 2; ++_i) \
        __builtin_amdgcn_global_load_lds((const unsigned*)((const char*)(gbase) + (voff)[_i]), (LAS unsigned*)(lds + (bufoff) + ldsw + _i * 8192), 16, 0, 0); } while (0)
#define PG8_LDA(dst, b, h) do { _Pragma("unroll") for (int m = 0; m < 4; ++m) _Pragma("unroll") for (int k = 0; k < 2; ++k) dst[m][k] = *(const LAS bf16x8*)(lds + PG8_SA(b, h) + aoff + m * 2048 + k * 1024); } while (0)
#define PG8_LDB(dst, b, h) do { _Pragma("unroll") for (int n = 0; n < 2; ++n) _Pragma("unroll") for (int k = 0; k < 2; ++k) dst[n][k] = *(const LAS bf16x8*)(lds + PG8_SB(b, h) + boff + n * 2048 + k * 1024); } while (0)
#define PG8_MMA(ai, bj, At, Bt) do { __builtin_amdgcn_s_setprio(1); _Pragma("unroll") for (int m = 0; m < 4; ++m) _Pragma("unroll") for (int n = 0; n < 2; ++n) _Pragma("unroll") for (int k = 0; k < 2; ++k) \
        acc[ai][bj][m][n] = __builtin_amdgcn_mfma_f32_16x16x32_bf16(Bt[n][k], At[m][k], acc[ai][bj][m][n], 0, 0, 0); __builtin_amdgcn_s_setprio(0); } while (0)
#define PG8_WAIT_V(n) asm volatile("s_waitcnt vmcnt(" #n ")" ::: "memory")
#define PG8_WAIT_L(n) asm volatile("s_waitcnt lgkmcnt(" #n ")" ::: "memory")
#define PG8_BAR __builtin_amdgcn_s_barrier()
#define PG8_SCHED __builtin_amdgcn_sched_barrier(0)
    Unit cur, nxt; int ui = 0;
    if (!S.next(0, cur)) return;
    if (g.lat) cur.pm += (cur.pm >> 4) + 1;
    f32x4 acc[2][2][4][2];
#pragma unroll
    for (int a = 0; a < 2; ++a)
#pragma unroll
        for (int b = 0; b < 2; ++b)
#pragma unroll
            for (int m = 0; m < 4; ++m)
#pragma unroll
                for (int n = 0; n < 2; ++n) acc[a][b][m][n] = (f32x4){0.f, 0.f, 0.f, 0.f};
    bf16x8 At[4][2], B0[2][2], B1[2][2];
    const char* cA = (const char*)g.A + (size_t)cur.pm * tsA; const char* cB = (const char*)g.Bt + (size_t)cur.pn * tsB;
    PG8_STAGE(PG8_SB(0, 0), cB, voffB); PG8_STAGE(PG8_SA(0, 0), cA, voffA); PG8_STAGE(PG8_SB(0, 1), cB + hsB, voffB); PG8_STAGE(PG8_SA(0, 1), cA + hsA, voffA);
    if (wr == 1) PG8_BAR;
    PG8_WAIT_V(4); PG8_BAR;
    PG8_STAGE(PG8_SB(1, 0), cB + kstep, voffB); PG8_STAGE(PG8_SA(1, 0), cA + kstep, voffA); PG8_STAGE(PG8_SB(1, 1), cB + hsB + kstep, voffB);
    PG8_WAIT_V(6); PG8_BAR;
    for (;;) {
        const bool has_next = S.next(ui + 1, nxt);
        if (g.lat && has_next) nxt.pm += (nxt.pm >> 4) + 1;
        const char* nA = has_next ? (const char*)g.A + (size_t)nxt.pm * tsA : cA; const char* nB = has_next ? (const char*)g.Bt + (size_t)nxt.pn * tsB : cB;
        for (int t = 0; t < nt; t += 2) {
            const bool last = (t == nt - 2);
            const char* a1 = cA + (size_t)(t + 1) * kstep;
            const char* a2 = last ? nA : cA + (size_t)(t + 2) * kstep; const char* b2 = last ? nB : cB + (size_t)(t + 2) * kstep;
            const char* a3 = a2 + kstep; const char* b3 = b2 + kstep;
            PG8_LDB(B0, 0, 0); PG8_SCHED; PG8_LDA(At, 0, 0); PG8_STAGE(PG8_SA(1, 1), a1 + hsA, voffA);
            PG8_WAIT_L(8); PG8_BAR; PG8_WAIT_L(0); PG8_MMA(0, 0, At, B0); PG8_BAR; PG8_SCHED;
            PG8_LDB(B1, 0, 1); PG8_STAGE(PG8_SB(0, 0), b2, voffB);
            PG8_BAR; PG8_WAIT_L(0); PG8_MMA(0, 1, At, B1); PG8_BAR;
            PG8_LDA(At, 0, 1); PG8_STAGE(PG8_SA(0, 0), a2, voffA);
            PG8_BAR; PG8_WAIT_L(0); PG8_MMA(1, 0, At, B0); PG8_BAR; PG8_SCHED;
            PG8_STAGE(PG8_SB(0, 1), b2 + hsB, voffB);
            PG8_WAIT_V(6); PG8_BAR; PG8_MMA(1, 1, At, B1); PG8_BAR;
            PG8_LDB(B0, 1, 0); PG8_SCHED; PG8_LDA(At, 1, 0); PG8_STAGE(PG8_SA(0, 1), a2 + hsA, voffA);
            PG8_WAIT_L(8); PG8_BAR; PG8_WAIT_L(0); PG8_MMA(0, 0, At, B0); PG8_BAR; PG8_SCHED;
            PG8_LDB(B1, 1, 1); PG8_STAGE(PG8_SB(1, 0), b3, voffB);
            PG8_BAR; PG8_WAIT_L(0); PG8_MMA(0, 1, At, B1); PG8_BAR;
            PG8_LDA(At, 1, 1); PG8_STAGE(PG8_SA(1, 0), a3, voffA);
            PG8_BAR; PG8_WAIT_L(0); PG8_MMA(1, 0, At, B0); PG8_BAR; PG8_SCHED;
            PG8_STAGE(PG8_SB(1, 1), b3 + hsB, voffB);
            PG8_WAIT_V(6); PG8_BAR; PG8_MMA(1, 1, At, B1); PG8_BAR;
        }
        E(acc, cur, wr, wc, fr, fq);
        if (!has_next) break;
#pragma unroll
        for (int a = 0; a < 2; ++a)
#pragma unroll
            for (int b = 0; b < 2; ++b)
#pragma unroll
                for (int m = 0; m < 4; ++m)
#pragma unroll
                    for (int n = 0; n < 2; ++n) acc[a][b][m][n] = (f32x4){0.f, 0.f, 0.f, 0.f};
        cur = nxt; cA = nA; cB = nB; ++ui;
    }
    PG8_WAIT_V(0);
    if (wr == 0) PG8_BAR;
    PG8_BAR;
#undef PG8_SA
#undef PG8_SB
#undef PG8_STAGE
#undef PG8_LDA
#undef PG8_LDB
#undef PG8_MMA
#undef PG8_WAIT_V
#undef PG8_WAIT_L
#undef PG8_BAR
#undef PG8_SCHED
}
}

#define EPI_ROWS_COLS_PERM \
    const int row0 = u.pm * 256 + wr * 64 + fr; const int col0 = u.pn * 256 + wc * 32 + 8 * fq;
struct EpiBf16Plain {
    static constexpr bool PERM = true;
    bf16_t* O; int ldc;
    __device__ __forceinline__ void operator()(const f32x4 (&acc)[2][2][4][2], const pg8::Unit& u, int wr, int wc, int fr, int fq) const {
        EPI_ROWS_COLS_PERM
#pragma unroll
        for (int ai = 0; ai < 2; ++ai)
#pragma unroll
            for (int m = 0; m < 4; ++m) { bf16_t* rowp = O + (size_t)(row0 + ai * 128 + m * 16) * ldc + col0;
#pragma unroll
                for (int bj = 0; bj < 2; ++bj) { const f32x4 v0 = acc[ai][bj][m][0], v1 = acc[ai][bj][m][1];
                    u32x4 w; w.x = pk2(v0[0], v0[1]); w.y = pk2(v0[2], v0[3]); w.z = pk2(v1[0], v1[1]); w.w = pk2(v1[2], v1[3]);
                    *(u32x4*)(rowp + bj * 128) = w; } }
    }
};
struct EpiBf16RowScale {
    static constexpr bool PERM = true;
    bf16_t* O; int ldc; const float* rs;
    __device__ __forceinline__ void operator()(const f32x4 (&acc)[2][2][4][2], const pg8::Unit& u, int wr, int wc, int fr, int fq) const {
        EPI_ROWS_COLS_PERM
#pragma unroll
        for (int ai = 0; ai < 2; ++ai)
#pragma unroll
            for (int m = 0; m < 4; ++m) { const int row = row0 + ai * 128 + m * 16; const float s = rs[row]; bf16_t* rowp = O + (size_t)row * ldc + col0;
#pragma unroll
                for (int bj = 0; bj < 2; ++bj) { const f32x4 v0 = acc[ai][bj][m][0] * s, v1 = acc[ai][bj][m][1] * s;
                    u32x4 w; w.x = pk2(v0[0], v0[1]); w.y = pk2(v0[2], v0[3]); w.z = pk2(v1[0], v1[1]); w.w = pk2(v1[2], v1[3]);
                    *(u32x4*)(rowp + bj * 128) = w; } }
    }
};
struct EpiRelu2 {
    static constexpr bool PERM = true;
    bf16_t* O; int ldc;
    __device__ __forceinline__ void operator()(const f32x4 (&acc)[2][2][4][2], const pg8::Unit& u, int wr, int wc, int fr, int fq) const {
        EPI_ROWS_COLS_PERM
#pragma unroll
        for (int ai = 0; ai < 2; ++ai)
#pragma unroll
            for (int m = 0; m < 4; ++m) { bf16_t* rowp = O + (size_t)(row0 + ai * 128 + m * 16) * ldc + col0;
#pragma unroll
                for (int bj = 0; bj < 2; ++bj) { f32x4 v0 = acc[ai][bj][m][0], v1 = acc[ai][bj][m][1];
#pragma unroll
                    for (int j = 0; j < 4; ++j) { const float a = fmaxf(v0[j], 0.f), b = fmaxf(v1[j], 0.f); v0[j] = a * a; v1[j] = b * b; }
                    u32x4 w; w.x = pk2(v0[0], v0[1]); w.y = pk2(v0[2], v0[3]); w.z = pk2(v1[0], v1[1]); w.w = pk2(v1[2], v1[3]);
                    *(u32x4*)(rowp + bj * 128) = w; } }
    }
};
struct EpiResid {
    static constexpr bool PERM = false;
    float* XS; const float* gate; float scale;
    __device__ __forceinline__ void operator()(const f32x4 (&acc)[2][2][4][2], const pg8::Unit& u, int wr, int wc, int fr, int fq) const {
        const int row0 = u.pm * 256 + wr * 64 + fr, col0 = u.pn * 256 + wc * 32 + 4 * fq;
        const int cond = (u.pm % 17 == 0) ? 2 : (u.pm / 17);
        const float* gp = gate + (size_t)cond * MODW + col0;
        f32x4 gv[2][2];
#pragma unroll
        for (int bj = 0; bj < 2; ++bj)
#pragma unroll
            for (int n = 0; n < 2; ++n) gv[bj][n] = *(const f32x4*)(gp + bj * 128 + n * 16) * scale;
#pragma unroll
        for (int ai = 0; ai < 2; ++ai)
#pragma unroll
            for (int m = 0; m < 4; ++m) { float* rowp = XS + (size_t)(row0 + ai * 128 + m * 16) * DM + col0;
#pragma unroll
                for (int bj = 0; bj < 2; ++bj)
#pragma unroll
                    for (int n = 0; n < 2; ++n) { f32x4* p = (f32x4*)(rowp + bj * 128 + n * 16); *p = *p + gv[bj][n] * acc[ai][bj][m][n]; } }
    }
};
struct EpiHG {
    static constexpr bool PERM = true;
    bf16_t* QVG; f16_t* LOGF; const float* lb;
    __device__ __forceinline__ void operator()(const f32x4 (&acc)[2][2][4][2], const pg8::Unit& u, int wr, int wc, int fr, int fq) const {
        const int row0 = u.pm * 256 + wr * 64 + fr; const int seg = u.pn >> 3; const int col0 = (u.pn & 7) * 256 + wc * 32 + 8 * fq;
        if (seg == 1 || seg == 2) {
            f16_t* base = LOGF + (size_t)(seg - 1) * MROWS * DM;
            f32x4 lbv[2][2];
#pragma unroll
            for (int bj = 0; bj < 2; ++bj)
#pragma unroll
                for (int n = 0; n < 2; ++n) lbv[bj][n] = *(const f32x4*)(lb + col0 + bj * 128 + 4 * n);
#pragma unroll
            for (int ai = 0; ai < 2; ++ai)
#pragma unroll
                for (int m = 0; m < 4; ++m) { f16_t* rowp = base + (size_t)(row0 + ai * 128 + m * 16) * DM + col0;
#pragma unroll
                    for (int bj = 0; bj < 2; ++bj) { f16x8 o;
#pragma unroll
                        for (int n = 0; n < 2; ++n) { const f32x4 v = acc[ai][bj][m][n];
#pragma unroll
                            for (int j = 0; j < 4; ++j) { const float l = lbv[bj][n][j]; o[4 * n + j] = (f16_t)__logf(l + (1.0f - l) * fsigmoid(v[j])); } }
                        *(f16x8*)(rowp + bj * 128) = o; } }
        } else {
            const int bi = seg - 2 + (seg == 0 ? 2 : 0);
            bf16_t* base = QVG + (size_t)bi * MROWS * DM;
            const bool act = (seg != 3);
#pragma unroll
            for (int ai = 0; ai < 2; ++ai)
#pragma unroll
                for (int m = 0; m < 4; ++m) { bf16_t* rowp = base + (size_t)(row0 + ai * 128 + m * 16) * DM + col0;
#pragma unroll
                    for (int bj = 0; bj < 2; ++bj) { f32x4 v0 = acc[ai][bj][m][0], v1 = acc[ai][bj][m][1];
                        if (act) {
#pragma unroll
                            for (int j = 0; j < 4; ++j) { v0[j] = v0[j] * fsigmoid(v0[j]); v1[j] = v1[j] * fsigmoid(v1[j]); } }
                        u32x4 w; w.x = pk2(v0[0], v0[1]); w.y = pk2(v0[2], v0[3]); w.z = pk2(v1[0], v1[1]); w.w = pk2(v1[2], v1[3]);
                        *(u32x4*)(rowp + bj * 128) = w; } }
        }
    }
};


namespace sg {
struct SGemm { const bf16_t* A; const bf16_t* Bt; int N, K, lda, ldb; };
__device__ __forceinline__ unsigned red_off(int w, int row, int col) { return (unsigned)((((w * 64 + row) * 16) + ((col >> 2) ^ (row & 15))) * 16); }
template <class Epi>
__device__ __forceinline__ void sgemm_phase(LAS unsigned char* lds, int tid, const SGemm& g, int nbig, const Epi& E) {
    const int G = gridDim.x, c = blockIdx.x, nsm = 8 * (g.N >> 6), r = nbig % G;
    int start, stride;
    if (r == 0) { start = (G % 8 == 0) ? (c % 8) * (G / 8) + c / 8 : c; stride = G; }
    else { start = c - r; stride = G - r; if (c < r) start = nsm; }
    const int w = __builtin_amdgcn_readfirstlane(tid >> 6), lane = tid & 63, fr = lane & 15, fq = lane >> 4;
    const int kw = g.K >> 3, nk2 = kw >> 6;
    bf16x8 xa[4][2], xb[4][2], ya[4][2], yb[4][2];
    const int voA = (fr * g.lda + w * kw + 16 * fq) * 2, voB = (fr * g.ldb + w * kw + 16 * fq) * 2;
    const int sAb = 16 * g.lda * 2, sBb = 16 * g.ldb * 2;
    __amdgpu_buffer_rsrc_t rA, rB;
#define SG_PTRS(su) do { const int mt_ = (su) & 7, nt_ = (su) >> 3; \
        rA = __builtin_amdgcn_make_buffer_rsrc((void*)(g.A + ((size_t)(mt_ >> 2) * SROW + (mt_ & 3) * 64) * g.lda), 0, 64 * g.lda * 2, 0x00020000); \
        rB = __builtin_amdgcn_make_buffer_rsrc((void*)(g.Bt + (size_t)nt_ * 64 * g.ldb), 0, 64 * g.ldb * 2, 0x00020000); } while (0)
#define SG_LD1(r, vo, so) __builtin_bit_cast(bf16x8, __builtin_amdgcn_raw_buffer_load_b128(r, vo, so, 0))
#define SG_LOAD(a, b, k2) do { _Pragma("unroll") for (int i = 0; i < 4; ++i) { a[i][0] = SG_LD1(rA, voA, i * sAb + (k2) * 128); a[i][1] = SG_LD1(rA, voA, i * sAb + (k2) * 128 + 16); \
        b[i][0] = SG_LD1(rB, voB, i * sBb + (k2) * 128); b[i][1] = SG_LD1(rB, voB, i * sBb + (k2) * 128 + 16); } } while (0)
#define SG_MMA(a, b) do { _Pragma("unroll") for (int hh = 0; hh < 2; ++hh) _Pragma("unroll") for (int m = 0; m < 4; ++m) _Pragma("unroll") for (int n = 0; n < 4; ++n) \
        acc[m][n] = __builtin_amdgcn_mfma_f32_16x16x32_bf16(b[n][hh], a[m][hh], acc[m][n], 0, 0, 0); } while (0)
#define SG_SB __builtin_amdgcn_sched_barrier(0)
    if (start < nsm) { SG_PTRS(start); SG_LOAD(xa, xb, 0); }
    for (int su = start; su < nsm; su += stride) {
        f32x4 acc[4][4];
#pragma unroll
        for (int m = 0; m < 4; ++m)
#pragma unroll
            for (int n = 0; n < 4; ++n) acc[m][n] = (f32x4){0.f, 0.f, 0.f, 0.f};
        if (nk2 > 1) SG_LOAD(ya, yb, 1);
        SG_SB;
        for (int k2 = 0; k2 < nk2; k2 += 2) {
            SG_MMA(xa, xb); SG_SB; if (k2 + 2 < nk2) SG_LOAD(xa, xb, k2 + 2); SG_SB;
            if (k2 + 1 < nk2) { SG_MMA(ya, yb); SG_SB; if (k2 + 3 < nk2) SG_LOAD(ya, yb, k2 + 3); SG_SB; }
        }
        if (su + stride < nsm) { SG_PTRS(su + stride); SG_LOAD(xa, xb, 0); }
        SG_SB;
        __syncthreads();
#pragma unroll
        for (int m = 0; m < 4; ++m)
#pragma unroll
            for (int n = 0; n < 4; ++n) *(LAS f32x4*)(lds + red_off(w, 16 * m + fr, 16 * n + 4 * fq)) = acc[m][n];
        __syncthreads();
        const int row = tid >> 3, c8 = (tid & 7) * 8;
        f32x4 s0 = {0.f, 0.f, 0.f, 0.f}, s1 = {0.f, 0.f, 0.f, 0.f};
#pragma unroll
        for (int ww = 0; ww < 8; ++ww) { s0 += *(const LAS f32x4*)(lds + red_off(ww, row, c8)); s1 += *(const LAS f32x4*)(lds + red_off(ww, row, c8 + 4)); }
        float v[8] = {s0.x, s0.y, s0.z, s0.w, s1.x, s1.y, s1.z, s1.w};
        const int mt = su & 7, nt = su >> 3;
        E((size_t)(mt >> 2) * SROW + (mt & 3) * 64 + row, nt * 64 + c8, v);
    }
#undef SG_SB
#undef SG_LOAD
#undef SG_MMA
#undef SG_PTRS
#undef SG_LD1
    __syncthreads();
}
}
__device__ __forceinline__ void st_bf16x8(bf16_t* p, const float (&v)[8]) { u32x4 w; w.x = pk2(v[0], v[1]); w.y = pk2(v[2], v[3]); w.z = pk2(v[4], v[5]); w.w = pk2(v[6], v[7]); *(u32x4*)p = w; }
struct SEpiPlain { bf16_t* O; int ldc;
    __device__ __forceinline__ void operator()(size_t R, int col, const float (&v)[8]) const { st_bf16x8(O + R * ldc + col, v); } };
struct SEpiRowScale { bf16_t* O; int ldc; const float* rs;
    __device__ __forceinline__ void operator()(size_t R, int col, const float (&v)[8]) const { const float s = rs[R]; float o[8];
#pragma unroll
        for (int j = 0; j < 8; ++j) o[j] = v[j] * s;
        st_bf16x8(O + R * ldc + col, o); } };
struct SEpiRelu2 { bf16_t* O; int ldc;
    __device__ __forceinline__ void operator()(size_t R, int col, const float (&v)[8]) const { float o[8];
#pragma unroll
        for (int j = 0; j < 8; ++j) { const float a = fmaxf(v[j], 0.f); o[j] = a * a; }
        st_bf16x8(O + R * ldc + col, o); } };
struct SEpiResid { float* XS; const float* gate; float scale;
    __device__ __forceinline__ void operator()(size_t R, int col, const float (&v)[8]) const { const float* gp = gate + (size_t)2 * MODW + col; float* xp = XS + R * DM + col;
        const f32x4 g0 = *(const f32x4*)gp * scale, g1 = *(const f32x4*)(gp + 4) * scale; f32x4 x0 = *(f32x4*)xp, x1 = *(f32x4*)(xp + 4);
        x0 += g0 * (f32x4){v[0], v[1], v[2], v[3]}; x1 += g1 * (f32x4){v[4], v[5], v[6], v[7]}; *(f32x4*)xp = x0; *(f32x4*)(xp + 4) = x1; } };
struct SEpiHG { bf16_t* QVG; f16_t* LOGF; const float* lb;
    __device__ __forceinline__ void operator()(size_t R, int col, const float (&v)[8]) const { const int seg = col >> 11, cs = col & 2047;
        if (seg == 1 || seg == 2) { f16_t* p = LOGF + (size_t)(seg - 1) * MROWS * DM + R * DM + cs; f16x8 o;
#pragma unroll
            for (int j = 0; j < 8; ++j) { const float l0 = lb[cs + j]; o[j] = (f16_t)__logf(l0 + (1.0f - l0) * fsigmoid(v[j])); }
            *(f16x8*)p = o; }
        else { const int bi = seg - 2 + (seg == 0 ? 2 : 0); float o[8];
#pragma unroll
            for (int j = 0; j < 8; ++j) o[j] = seg == 3 ? v[j] : v[j] * fsigmoid(v[j]);
            st_bf16x8(QVG + (size_t)bi * MROWS * DM + R * DM + cs, o); } } };

namespace att {
using s16x4  = __attribute__((ext_vector_type(4))) short;
using f32x16 = __attribute__((ext_vector_type(16))) float;
constexpr int NW = 8, QBLK = 32, KVBLK = 64;
constexpr float SCALE = ATTN_SCALE;
constexpr float THR = 8.f;
constexpr int SHM_V = KVBLK * 128 * 2, SHM_K = KVBLK * 128 * 2, SHM_KR = KVBLK * 64 * 2;
constexpr int OFF_V = 0, OFF_K = 2 * SHM_V, OFF_KR = OFF_K + 2 * SHM_K, OFF_WS = OFF_KR + 2 * SHM_KR, SHM_ATTN = OFF_WS + NW * 64 * 4;
constexpr int LDQ = QW, LDK = KVW, LDO = DM;
#define KSWZ(row, colB) ((row) * 256 + ((colB) ^ (((row) & 7) << 4)))
#define RSWZ(row, colB) ((row) * 128 + ((colB) ^ ((((row) >> 1) & 7) << 4)))
#define SBAR() __builtin_amdgcn_sched_barrier(0)
__device__ __forceinline__ int crow(int r, int hi) { return (r & 3) + 8 * (r >> 2) + 4 * hi; }
__device__ __forceinline__ unsigned cvtpk(float lo, float hi) { unsigned r; asm volatile("v_cvt_pk_bf16_f32 %0, %1, %2" : "=v"(r) : "v"(lo), "v"(hi)); return r; }
__device__ __forceinline__ bf16x8 ld8(const bf16_t* p) { return *reinterpret_cast<const bf16x8*>(p); }
__device__ __forceinline__ void partialSM(f32x16& p0, f32x16& p1, float& m_reg, float& mn, float& alpha) {
  constexpr float C = SCALE * 1.4426950408889634f;
  float pmax = p0[0];
#pragma unroll
  for (int r = 1; r < 16; ++r) pmax = fmaxf(pmax, p0[r]);
#pragma unroll
  for (int r = 0; r < 16; ++r) pmax = fmaxf(pmax, p1[r]);
  { auto rr = __builtin_amdgcn_permlane32_swap(__float_as_uint(pmax), __float_as_uint(pmax), false, false);
    pmax = fmaxf(__uint_as_float(rr[0]), __uint_as_float(rr[1])); }
  if (__builtin_expect(__all(pmax - m_reg <= THR / SCALE), 1)) { mn = m_reg; alpha = 1.f; }
  else { mn = fmaxf(m_reg, pmax); alpha = __builtin_amdgcn_exp2f((m_reg - mn) * C); m_reg = mn; }
  float mnC = -mn * C;
#pragma unroll
  for (int r = 0; r < 16; ++r) p0[r] = fmaf(p0[r], C, mnC);
#pragma unroll
  for (int r = 0; r < 16; ++r) p1[r] = fmaf(p1[r], C, mnC);
#pragma unroll
  for (int r = 0; r < 16; ++r) p0[r] = __builtin_amdgcn_exp2f(p0[r]);
}
__device__ __forceinline__ void finishSM(f32x16& p0, f32x16& p1, float alpha, float& l_reg, bf16x8& pa0, bf16x8& pa1, bf16x8& pa2, bf16x8& pa3) {
#pragma unroll
  for (int r = 0; r < 16; ++r) p1[r] = __builtin_amdgcn_exp2f(p1[r]);
  float ps = 0;
#pragma unroll
  for (int r = 0; r < 16; ++r) ps += p0[r];
#pragma unroll
  for (int r = 0; r < 16; ++r) ps += p1[r];
  { auto rr = __builtin_amdgcn_permlane32_swap(__float_as_uint(ps), __float_as_uint(ps), false, false);
    ps = __uint_as_float(rr[0]) + __uint_as_float(rr[1]); }
  l_reg = l_reg * alpha + ps;
#define PK4(P, BASE, OUT) do { unsigned a0 = cvtpk(P[BASE + 0], P[BASE + 1]), a1 = cvtpk(P[BASE + 2], P[BASE + 3]);   \
    unsigned b0 = cvtpk(P[BASE + 4], P[BASE + 5]), b1 = cvtpk(P[BASE + 6], P[BASE + 7]);                              \
    auto r0 = __builtin_amdgcn_permlane32_swap(a0, b0, false, false); auto r1 = __builtin_amdgcn_permlane32_swap(a1, b1, false, false); \
    u32x4 w = {r0[0], r1[0], r0[1], r1[1]}; OUT = *reinterpret_cast<bf16x8*>(&w); } while (0)
  PK4(p0, 0, pa0); PK4(p0, 8, pa1); PK4(p1, 0, pa2); PK4(p1, 8, pa3);
#undef PK4
}
__device__ __forceinline__ void qkt(f32x16& p0, f32x16& p1, const char* Ks, const char* Krs, const bf16x8* qr, int r32, int hi) {
  p0 = f32x16{}; p1 = f32x16{};
#pragma unroll
  for (int d0 = 0; d0 < 8; ++d0) { int cb = (d0 * 16 + hi * 8) * 2;
    bf16x8 b0 = *reinterpret_cast<const bf16x8*>(Ks + KSWZ(r32, cb));
    bf16x8 b1 = *reinterpret_cast<const bf16x8*>(Ks + KSWZ(32 + r32, cb));
    p0 = __builtin_amdgcn_mfma_f32_32x32x16_bf16(b0, qr[d0], p0, 0, 0, 0);
    p1 = __builtin_amdgcn_mfma_f32_32x32x16_bf16(b1, qr[d0], p1, 0, 0, 0); }
#pragma unroll
  for (int d0 = 0; d0 < 4; ++d0) { int cb = (d0 * 16 + hi * 8) * 2;
    bf16x8 b0 = *reinterpret_cast<const bf16x8*>(Krs + RSWZ(r32, cb));
    bf16x8 b1 = *reinterpret_cast<const bf16x8*>(Krs + RSWZ(32 + r32, cb));
    p0 = __builtin_amdgcn_mfma_f32_32x32x16_bf16(b0, qr[8 + d0], p0, 0, 0, 0);
    p1 = __builtin_amdgcn_mfma_f32_32x32x16_bf16(b1, qr[8 + d0], p1, 0, 0, 0); }
}
__device__ __forceinline__ int v_st(int k, int c) { const int kk = (k & ~0xC) | ((k & 4) << 1) | ((k & 8) >> 1); return ((kk >> 3) * 4 + (c >> 5)) * 512 + ((kk & 7) * 32 + (c & 31)) * 2; }
__device__ __forceinline__ int v_rd_base(int lane) { return ((lane & 3) << 3) | (((lane >> 2) & 3) << 6) | (((lane >> 4) & 1) << 5) | (((lane >> 5) & 1) << 8); }
constexpr int v_rd_off(int d0, int ks, int half) { return d0 * 512 + ks * 4096 + half * 2048; }
template <int OFF> __device__ __forceinline__ s16x4 tr_read(int vb) {
  s16x4 r; asm volatile("ds_read_b64_tr_b16 %0, %1 offset:%2" : "=&v"(r) : "v"(vb), "i"(OFF) : "memory"); return r;
}
template <int D0> __device__ __forceinline__ void pv_one(f32x16& od, int vb, bf16x8 pa0, bf16x8 pa1, bf16x8 pa2, bf16x8 pa3) {
  const s16x4 l0 = tr_read<v_rd_off(D0, 0, 0)>(vb), h0 = tr_read<v_rd_off(D0, 0, 1)>(vb), l1 = tr_read<v_rd_off(D0, 1, 0)>(vb), h1 = tr_read<v_rd_off(D0, 1, 1)>(vb);
  const s16x4 l2 = tr_read<v_rd_off(D0, 2, 0)>(vb), h2 = tr_read<v_rd_off(D0, 2, 1)>(vb), l3 = tr_read<v_rd_off(D0, 3, 0)>(vb), h3 = tr_read<v_rd_off(D0, 3, 1)>(vb);
  asm volatile("s_waitcnt lgkmcnt(0)" ::: "memory"); SBAR();
#define PK(L, H) (bf16x8){L[0], L[1], L[2], L[3], H[0], H[1], H[2], H[3]}
  od = __builtin_amdgcn_mfma_f32_32x32x16_bf16(pa0, PK(l0, h0), od, 0, 0, 0);
  od = __builtin_amdgcn_mfma_f32_32x32x16_bf16(pa1, PK(l1, h1), od, 0, 0, 0);
  od = __builtin_amdgcn_mfma_f32_32x32x16_bf16(pa2, PK(l2, h2), od, 0, 0, 0);
  od = __builtin_amdgcn_mfma_f32_32x32x16_bf16(pa3, PK(l3, h3), od, 0, 0, 0);
#undef PK
}
__device__ __forceinline__ void pv_d0(f32x16* o, int vb, bf16x8 pa0, bf16x8 pa1, bf16x8 pa2, bf16x8 pa3) {
  pv_one<0>(o[0], vb, pa0, pa1, pa2, pa3); pv_one<1>(o[1], vb, pa0, pa1, pa2, pa3); pv_one<2>(o[2], vb, pa0, pa1, pa2, pa3); pv_one<3>(o[3], vb, pa0, pa1, pa2, pa3);
}
__device__ __forceinline__ void attn_body(const bf16_t* __restrict__ Qb, const bf16_t* __restrict__ Kh, const bf16_t* __restrict__ KRb,
                                          bf16_t* __restrict__ Ob, int seq, int tq0, const float* __restrict__ RC, const float* __restrict__ RS, char* lds, int tid) {
  const bf16_t* Vh = Kh + 128;
  const int wid = tid >> 6, lane = tid & 63, r32 = lane & 31, hi = lane >> 5;
  char* V_lds = lds + OFF_V; char* K_lds = lds + OFF_K; char* KR_lds = lds + OFF_KR;
  float* ws = (float*)(lds + OFF_WS) + wid * 64; float* li_l = ws; float* al_l = ws + 32;
  float m_reg = -1e30f, l_reg = 0; f32x16 o[4] = {}; bf16x8 qr[12];
  const bf16_t* Qw = Qb + (long)(wid * QBLK + r32) * LDQ + hi * 8;
#pragma unroll
  for (int d0 = 0; d0 < 12; ++d0) qr[d0] = ld8(Qw + d0 * 16);
  if (tq0 >= 0) {
    const int t = tq0 + wid * QBLK + r32; const int pr = (t >> 6) * 16 + hi * 8, pc = (t & 63) * 16 + hi * 8;
#pragma unroll
    for (int j = 0; j < 8; ++j) {
      { const float c = RC[pr + j], sn = RS[pr + j]; const float x0 = bf2f((bf16_t)qr[8][j]), x1 = bf2f((bf16_t)qr[9][j]);
        qr[8][j] = (short)f2bf(x0 * c - x1 * sn); qr[9][j] = (short)f2bf(x1 * c + x0 * sn); }
      { const float c = RC[pc + j], sn = RS[pc + j]; const float x0 = bf2f((bf16_t)qr[10][j]), x1 = bf2f((bf16_t)qr[11][j]);
        qr[10][j] = (short)f2bf(x0 * c - x1 * sn); qr[11][j] = (short)f2bf(x1 * c + x0 * sn); }
    }
  }
  const int sr = tid >> 4, sc = (tid & 15) * 8, vst0 = v_st(sr, sc), vst1 = v_st(32 + sr, sc);
  const int rr = tid >> 3, rc = (tid & 7) * 8;
  const int vb0 = (int)(uintptr_t)V_lds + v_rd_base(lane);
  bf16x8 vs0, vs1, ks0, ks1, krs;
#define SLOAD(k0) do { vs0 = ld8(&Vh[(long)((k0) + sr) * LDK + sc]); vs1 = ld8(&Vh[(long)((k0) + 32 + sr) * LDK + sc]); \
    ks0 = ld8(&Kh[(long)((k0) + sr) * LDK + sc]); ks1 = ld8(&Kh[(long)((k0) + 32 + sr) * LDK + sc]); krs = ld8(&KRb[(long)((k0) + rr) * 64 + rc]); } while (0)
#define SWRITE(b) do { *(bf16x8*)(V_lds + (b) * SHM_V + vst0) = vs0; *(bf16x8*)(V_lds + (b) * SHM_V + vst1) = vs1; int kc = sc * 2;   \
    *(bf16x8*)(K_lds + (b) * SHM_K + KSWZ(sr, kc)) = ks0; *(bf16x8*)(K_lds + (b) * SHM_K + KSWZ(32 + sr, kc)) = ks1;                    \
    *(bf16x8*)(KR_lds + (b) * SHM_KR + RSWZ(rr, rc * 2)) = krs; } while (0)
#define SWAIT() asm volatile("s_waitcnt vmcnt(0)" ::: "memory")
#define RESC(a) do { if (__any((a) < 1.f)) { if (hi == 0) al_l[r32] = (a); asm volatile("s_waitcnt lgkmcnt(0)" ::: "memory"); \
    _Pragma("unroll") for (int d = 0; d < 4; ++d) _Pragma("unroll") for (int r = 0; r < 16; ++r) o[d][r] *= al_l[crow(r, hi)]; } } while (0)
  f32x16 p0, p1; float mn, al; bf16x8 pa0, pa1, pa2, pa3; const int NT = seq / KVBLK;
  SLOAD(0); SWAIT(); SWRITE(0); __syncthreads();
  SLOAD(KVBLK);
  for (int j = 0; j < NT; ++j) {
    const int buf = j & 1;
    SBAR(); qkt(p0, p1, K_lds + buf * SHM_K, KR_lds + buf * SHM_KR, qr, r32, hi);
    partialSM(p0, p1, m_reg, mn, al); RESC(al);
    finishSM(p0, p1, al, l_reg, pa0, pa1, pa2, pa3); SBAR();
    if (j + 1 < NT) { SWAIT(); SWRITE(buf ^ 1); }
    if (j + 2 < NT) SLOAD((j + 2) * KVBLK);
    SBAR();
    pv_d0(o, vb0 + buf * SHM_V, pa0, pa1, pa2, pa3);
    __syncthreads();
  }
  if (hi == 0) li_l[r32] = l_reg; asm volatile("s_waitcnt lgkmcnt(0)" ::: "memory");
  float rli[16];
#pragma unroll
  for (int r = 0; r < 16; ++r) rli[r] = __builtin_amdgcn_rcpf(li_l[crow(r, hi)]);
  bf16_t* Ow = Ob + (long)(wid * QBLK) * LDO;
#pragma unroll
  for (int r = 0; r < 16; ++r) { int orow = crow(r, hi);
#pragma unroll
    for (int d0 = 0; d0 < 4; ++d0) Ow[(long)orow * LDO + d0 * 32 + r32] = (bf16_t)f2bf(o[d0][r] * rli[r]); }
#undef SLOAD
#undef SWRITE
#undef SWAIT
#undef RESC
}
}

typedef const float* cfp_t;
typedef const __attribute__((address_space(4))) cfp_t* InPtr;
struct Ctx {
    LAS unsigned char* lds; int tid, lane, wave, gw, ngw, gtid, ngt;
    InPtr in; float* out; unsigned char* ws;
    __device__ __forceinline__ const float* inp(int i) const { return (const float*)(const GAS float*)in[i]; }
};
#define WSP(T, off) ((T*)(C.ws + (off)))

__device__ __forceinline__ void tr_item(const float* W, int K, int N, bf16_t* WT, const float* sck, LAS float* scr, int item, int lane) {
    const int nblk = N / 64, kb = item / nblk, nb = item % nblk, k0 = 64 * kb, n0 = 64 * nb;
    f32x4 v[16];
#pragma unroll
    for (int i = 0; i < 16; ++i) v[i] = *(const f32x4*)(W + (size_t)(k0 + 4 * i + (lane >> 4)) * N + n0 + 4 * (lane & 15));
#pragma unroll
    for (int i = 0; i < 16; ++i) { const int kk = 4 * i + (lane >> 4); f32x4 x = v[i]; if (sck) x *= sck[k0 + kk]; LAS float* d = scr + kk * 65 + 4 * (lane & 15); d[0] = x.x; d[1] = x.y; d[2] = x.z; d[3] = x.w; }
    asm volatile("s_waitcnt lgkmcnt(0)" ::: "memory"); __builtin_amdgcn_wave_barrier();
    const int nl = lane & 7, kc = lane >> 3;
#pragma unroll
    for (int j = 0; j < 8; ++j) { const int n = 8 * j + nl; const LAS float* sp = scr + (8 * kc) * 65 + n;
        u32x4 o; o.x = pk2(sp[0 * 65], sp[1 * 65]); o.y = pk2(sp[2 * 65], sp[3 * 65]); o.z = pk2(sp[4 * 65], sp[5 * 65]); o.w = pk2(sp[6 * 65], sp[7 * 65]);
        *(u32x4*)(WT + (size_t)(n0 + n) * K + k0 + 8 * kc) = o; }
    asm volatile("s_waitcnt lgkmcnt(0)" ::: "memory"); __builtin_amdgcn_wave_barrier();
}
__device__ __forceinline__ void tr_matrix(const Ctx& C, const float* W, int K, int N, bf16_t* WT, const float* sck) {
    LAS float* scr = (LAS float*)(C.lds + C.wave * 16640);
    const int cnt = (K / 64) * (N / 64);
    for (int it = C.gw; it < cnt; it += C.ngw) tr_item(W, K, N, WT, sck, scr, it, C.lane);
}
__device__ __forceinline__ void sincos_d(double x, double& s, double& c) {
    const double twopi = 6.283185307179586476925286766559;
    const double k = __builtin_rint(x / twopi); const double y = x - k * twopi; const double y2 = y * y;
    double ts = y, ss = y, tc = 1.0, sc = 1.0;
#pragma unroll
    for (int n = 1; n <= 16; ++n) { tc *= -y2 / (double)((2 * n - 1) * (2 * n)); sc += tc; ts *= -y2 / (double)((2 * n) * (2 * n + 1)); ss += ts; }
    s = ss; c = sc;
}
__device__ __forceinline__ void phase_prologue(const Ctx& C) {
#pragma unroll 1
    for (int e = 0; e < 2; ++e) {
        tr_matrix(C, C.inp(8) + (size_t)e * DM * ABN, DM, ABN, WSP(bf16_t, WS_WABIN) + (size_t)e * ABNP * DM, nullptr);
        tr_matrix(C, C.inp(9) + (size_t)e * DM * DM, DM, DM, WSP(bf16_t, WS_WABOUT) + (size_t)e * DM * DM, nullptr);
        tr_matrix(C, C.inp(18) + (size_t)e * 512 * QW, 512, QW, WSP(bf16_t, WS_WUQ) + (size_t)e * QW * 512, C.inp(17) + e * 512);
        tr_matrix(C, C.inp(20) + (size_t)e * 512 * KVW, 512, KVW, WSP(bf16_t, WS_WUKV) + (size_t)e * KVW * 512, C.inp(19) + e * 512);
        tr_matrix(C, C.inp(21) + (size_t)e * DM * HGN, DM, HGN, WSP(bf16_t, WS_WHGIN) + (size_t)e * HGN * DM, nullptr);
        tr_matrix(C, C.inp(24) + (size_t)e * DM * DM, DM, DM, WSP(bf16_t, WS_WHGOUT) + (size_t)e * DM * DM, nullptr);
#pragma unroll 1
        for (int dg = 0; dg < 4; ++dg) { const int dir = dg >> 1, gate = dg & 1;
            tr_matrix(C, C.inp(gate ? 14 : 12) + ((size_t)e * 2 + dir) * 8 * 128 * 128, 1024, 128, WSP(bf16_t, WS_WG) + ((size_t)e * 4 + dg) * 128 * 1024, nullptr); }
    }
#pragma unroll 1
    for (int l = 0; l < 4; ++l) {
        tr_matrix(C, C.inp(25) + (size_t)l * DM * DFF, DM, DFF, WSP(bf16_t, WS_W1) + (size_t)l * DFF * DM, nullptr);
        tr_matrix(C, C.inp(26) + (size_t)l * DFF * DM, DFF, DM, WSP(bf16_t, WS_W2) + (size_t)l * DM * DFF, nullptr);
    }
    for (int e = 0; e < 2; ++e) { u32x4* z = (u32x4*)(WSP(bf16_t, WS_WABIN) + (size_t)e * ABNP * DM + (size_t)ABN * DM);
        for (int i = C.gtid; i < (ABNP - ABN) * DM / 8; i += C.ngt) z[i] = (u32x4){0u, 0u, 0u, 0u}; }
    { float* XS = WSP(float, WS_XS);
      for (int i = C.gtid; i < MROWS * (DM / 4); i += C.ngt) { const int R = i / (DM / 4), c4 = i % (DM / 4); const int b = R / SROW, s = R % SROW;
          const float* src = s < CTX ? C.inp(2) + ((size_t)(b * CTX + s)) * DM : C.inp(0) + ((size_t)(b * SEQ + (s - CTX))) * DM;
          ((f32x4*)(XS + (size_t)R * DM))[c4] = ((const f32x4*)src)[c4]; } }
    { float* LB = WSP(float, WS_LB);
      for (int i = C.gtid; i < 2048; i += C.ngt) { float v[4], mx = -1e30f; for (int l = 0; l < 4; ++l) { v[l] = C.inp(22)[l * 2048 + i]; mx = fmaxf(mx, v[l]); }
          float sum = 0.f; for (int l = 0; l < 4; ++l) { v[l] = expf(v[l] - mx); sum += v[l]; }
          float cum = 0.f; const float p0 = v[0] / sum; for (int l = 0; l < 4; ++l) { cum += v[l] / sum; LB[l * 2048 + i] = cum - p0; } }
      float* RC = WSP(float, WS_ROPE); float* RS = RC + 1024;
      for (int i = C.gtid; i < 1024; i += C.ngt) { const int pos = i / 16, j = i % 16; double inv = 1.0; for (int q = 0; q < j; ++q) inv *= 0.56234132519034908;
          const float ang = (float)pos * (float)inv; double s, c; sincos_d((double)ang, s, c); RC[i] = (float)c; RS[i] = (float)s; } }
    { LAS float* sl = (LAS float*)C.lds;
      LAS float* red = sl + 3 * 2048;
      __syncthreads();
      for (int i = C.tid; i < 3 * 2048; i += 512) { const int r = i / 2048, d = i % 2048; const float v = r < 2 ? C.inp(1)[r * 2048 + d] : C.inp(3)[d]; sl[i] = siluf_(v); }
      __syncthreads();
      float* MOD = WSP(float, WS_MOD);
      const int kq = C.tid >> 4, cq = C.tid & 15;
      for (int u = blockIdx.x; u < 4 * (MODW / 64); u += gridDim.x) { const int l = u / (MODW / 64), e0 = (u % (MODW / 64)) * 64;
          const float* w = C.inp(4) + (size_t)l * DM * MODW + e0 + 4 * cq;
          f32x4 a0 = {0, 0, 0, 0}, a1 = {0, 0, 0, 0}, a2 = {0, 0, 0, 0};
#pragma unroll 8
          for (int d = kq; d < DM; d += 32) { const f32x4 wv = *(const f32x4*)(w + (size_t)d * MODW); a0 += wv * sl[d]; a1 += wv * sl[2048 + d]; a2 += wv * sl[4096 + d]; }
#pragma unroll
          for (int j = 0; j < 4; ++j) { red[(kq * 3 + 0) * 64 + 4 * cq + j] = a0[j]; red[(kq * 3 + 1) * 64 + 4 * cq + j] = a1[j]; red[(kq * 3 + 2) * 64 + 4 * cq + j] = a2[j]; }
          __syncthreads();
          if (C.tid < 192) { const int r = C.tid / 64, c = C.tid % 64; float s = 0.f; for (int q = 0; q < 32; ++q) s += red[(q * 3 + r) * 64 + c];
              MOD[((size_t)l * 3 + r) * MODW + e0 + c] = s + C.inp(5)[l * MODW + e0 + c]; }
          __syncthreads(); } }
}

__device__ __forceinline__ void phase_norm_mod(const Ctx& C, const float* w, const float* mod, int sh_idx, int sc_idx) {
    const float* XS = WSP(float, WS_XS); bf16_t* H = WSP(bf16_t, WS_H);
    for (int R = C.gw; R < MROWS; R += C.ngw) {
        const int s = R % SROW, b = R / SROW, cond = s < CTX ? 2 : b;
        const float* shift = mod + (size_t)cond * MODW + sh_idx * DM; const float* scale = mod + (size_t)cond * MODW + sc_idx * DM;
        const f32x4* xr = (const f32x4*)(XS + (size_t)R * DM) + C.lane;
        f32x4 v[8]; float ss = 0.f;
#pragma unroll
        for (int j = 0; j < 8; ++j) { v[j] = xr[64 * j]; ss += (v[j].x * v[j].x + v[j].y * v[j].y) + (v[j].z * v[j].z + v[j].w * v[j].w); }
        const float rstd = 1.0f / sqrtf(wave_sum(ss) * (1.0f / DM) + EPS);
        u32x2* o = (u32x2*)(H + (size_t)R * DM) + C.lane;
#pragma unroll
        for (int j = 0; j < 8; ++j) { const int c = (C.lane + 64 * j) * 4; const f32x4 wv = *(const f32x4*)(w + c), sc = *(const f32x4*)(scale + c), sh = *(const f32x4*)(shift + c);
            const f32x4 y = (v[j] * rstd * wv) * (1.0f + sc) + sh; u32x2 pk; pk.x = pk2(y.x, y.y); pk.y = pk2(y.z, y.w); o[64 * j] = pk; }
    }
}

__device__ __forceinline__ void phase_rs_kr(const Ctx& C) {
    const bf16_t* P = WSP(bf16_t, WS_P);
    float* RSQ = WSP(float, WS_RSQ); float* RSKV = WSP(float, WS_RSKV);
    for (int R = C.gw; R < MROWS; R += C.ngw) {
        const u32x4 a = *(const u32x4*)(P + (size_t)R * ABNP + 2048 + 8 * C.lane), b = *(const u32x4*)(P + (size_t)R * ABNP + 2560 + 8 * C.lane);
        float sa = 0.f, sb = 0.f;
#pragma unroll
        for (int j = 0; j < 4; ++j) { const float a0 = __uint_as_float(a[j] << 16), a1 = __uint_as_float(a[j] & 0xffff0000u), b0 = __uint_as_float(b[j] << 16), b1 = __uint_as_float(b[j] & 0xffff0000u);
            sa += a0 * a0 + a1 * a1; sb += b0 * b0 + b1 * b1; }
        sa = wave_sum(sa); sb = wave_sum(sb);
        if (C.lane == 0) { RSQ[R] = 1.0f / sqrtf(sa * (1.0f / 512.0f) + EPS); RSKV[R] = 1.0f / sqrtf(sb * (1.0f / 512.0f) + EPS); } }
    bf16_t* KR = WSP(bf16_t, WS_KR); const float* RC = WSP(float, WS_ROPE); const float* RS = RC + 1024;
    for (int idx = C.gtid; idx < MROWS * 32; idx += C.ngt) { const int R = idx / 32, p = idx % 32, s = R % SROW; const int i0 = p < 16 ? p : 32 + (p - 16);
        const float x0 = bf2f(P[(size_t)R * ABNP + 3072 + i0]), x1 = bf2f(P[(size_t)R * ABNP + 3072 + i0 + 16]); float o0 = x0, o1 = x1;
        if (s >= CTX) { const int t = s - CTX, pos = p < 16 ? t / 64 : t % 64; const float c = RC[pos * 16 + (p & 15)], sn = RS[pos * 16 + (p & 15)]; o0 = x0 * c - x1 * sn; o1 = x1 * c + x0 * sn; }
        KR[(size_t)R * 64 + i0] = (bf16_t)f2bf(o0); KR[(size_t)R * 64 + i0 + 16] = (bf16_t)f2bf(o1); }
}

__device__ __forceinline__ void phase_attn(const Ctx& C) {
    const bf16_t* Q = WSP(bf16_t, WS_Q); const bf16_t* KV = WSP(bf16_t, WS_KV); const bf16_t* KR = WSP(bf16_t, WS_KR); bf16_t* Y = WSP(bf16_t, WS_Y);
    const float* RC = WSP(float, WS_ROPE); const float* RS = RC + 1024;
    const int G = gridDim.x, c = blockIdx.x;
    for (int u0 = c; u0 < 272; u0 += G) {
        int b, hh, s0, nk, tq0;
        if (u0 < 256) { int v = u0; if (G == 256) { const int x = c & 7, j = c >> 3; v = (x * 2 + (j >> 4)) * 16 + (j & 15); }
            const int p = v >> 4, qb = v & 15; b = p >> 3; hh = p & 7; s0 = CTX + qb * 256; nk = SROW; tq0 = qb * 256; }
        else { const int p = u0 - 256; b = p >> 3; hh = p & 7; s0 = 0; nk = CTX; tq0 = -1; }
        const size_t R0 = (size_t)b * SROW + s0, K0 = (size_t)b * SROW;
        __syncthreads();
        att::attn_body(Q + R0 * QW + hh * 192, KV + K0 * KVW + hh * 256, KR + K0 * 64, Y + R0 * DM + DLRU + hh * 128, nk, tq0, RC, RS, (char*)C.lds, C.tid);
    }
}
namespace hg {
using s16x4  = __attribute__((ext_vector_type(4))) short;
using f32x16 = __attribute__((ext_vector_type(16))) float;
constexpr int NCH = SROW / 64;
constexpr int NCHAIN = NBATCH * 16 * 2;
__device__ __forceinline__ unsigned off_b(unsigned row, unsigned ch) { return 256u * row + 16u * (ch ^ (((row & 3u) << 2) | ((row >> 2) & 3u))); }
__device__ __forceinline__ s16x4 trr(unsigned addr) { s16x4 r; asm volatile("ds_read_b64_tr_b16 %0, %1" : "=&v"(r) : "v"(addr) : "memory"); return r; }
__device__ __forceinline__ bf16x8 pk8(s16x4 L, s16x4 H) { return (bf16x8){L[0], L[1], L[2], L[3], H[0], H[1], H[2], H[3]}; }
__device__ __forceinline__ unsigned tr_nat(unsigned lane, unsigned c, unsigned ks, unsigned t) {
    const unsigned h = lane >> 5, blk = (lane >> 4) & 1, q = (lane & 15) >> 2, p = lane & 3;
    return off_b(16 * ks + 8 * h + 4 * t + q, 4 * c + 2 * blk + (p >> 1)) + 8 * (p & 1); }
__device__ __forceinline__ unsigned tr_perm(unsigned lane, unsigned c, unsigned rb, unsigned t) {
    const unsigned h = lane >> 5, blk = (lane >> 4) & 1, q = (lane & 15) >> 2, p = lane & 3;
    return off_b(rb + 4 * h + 8 * t + q, 4 * c + 2 * blk + (p >> 1)) + 8 * (p & 1); }
__device__ __forceinline__ unsigned row_rd(unsigned lane, unsigned rb, unsigned ks) { return off_b(rb + (lane & 31), 2 * ks + (lane >> 5)); }
__device__ __forceinline__ int crow(int r, int hi) { return (r & 3) + 8 * (r >> 2) + 4 * hi; }
#define HG_WAITL() do { asm volatile("s_waitcnt lgkmcnt(0)" ::: "memory"); __builtin_amdgcn_sched_barrier(0); } while (0)
}

__device__ __forceinline__ void phase_hg_state(const Ctx& C) {
    using namespace hg;
    LAS unsigned char* L = C.lds; const unsigned Lb = (unsigned)(uintptr_t)L;
    constexpr unsigned VT = 0, KP = 16384, TOT = 32768, DECV = 36864;
    const f16_t* LOGF = WSP(f16_t, WS_LOGF); const bf16_t* VH = WSP(bf16_t, WS_VH); bf16_t* SS = WSP(bf16_t, WS_SS);
    const int w = C.wave, lane = C.lane, tid = C.tid, h5 = lane >> 5, r32 = lane & 31;
    const int G = gridDim.x, c = blockIdx.x, v0 = (G % 8 == 0) ? (c % 8) * (G / 8) + c / 8 : c;
    for (int u = v0; u < NCHAIN * 4; u += G) {
        const int chain = u >> 2, sl = u & 3, dir = chain & 1, hh = (chain >> 1) & 15, b = chain >> 5;
        const f16_t* lfb = LOGF + (size_t)dir * MROWS * DM + ((size_t)b * SROW + 8 * w) * DM + hh * 128 + 2 * lane;
        const bf16_t* vb = VH + ((size_t)b * SROW + (tid >> 2)) * DM + hh * 128 + 32 * sl + 8 * (tid & 3);
        f32x16 S = {};
        f32x2 lfA[8], lfB[8]; u32x4 vA = {0u, 0u, 0u, 0u}, vB = {0u, 0u, 0u, 0u};
#define HS_CI(j) (dir == 0 ? (j) : ((j) < 4 ? 3 - (j) : 71 - (j)))
#define HS_LOAD(lf, vr, j) do { const int cn_ = HS_CI(j); _Pragma("unroll") for (int i = 0; i < 8; ++i) { const f16x2 t_ = *(const f16x2*)(lfb + (size_t)(cn_ * 64 + i) * DM); lf[i] = (f32x2){(float)t_.x, (float)t_.y}; } \
        if (tid < 256) vr = *(const u32x4*)(vb + (size_t)cn_ * 64 * DM); } while (0)
#define HS_STEP(lf, vr, j) do { const int ci = HS_CI(j); \
            f32x2 T = {0.f, 0.f}; \
            _Pragma("unroll") for (int i = 0; i < 8; ++i) T += lf[i]; \
            *(LAS f32x2*)(L + TOT + (w * 128 + 2 * lane) * 4) = T; \
            __syncthreads();                                          \
            if (tid < 256) *(LAS u32x4*)(L + VT + off_b(tid >> 2, 4 * sl + (tid & 3))) = vr; \
            f32x2 off = {0.f, 0.f}, total = {0.f, 0.f}; \
            _Pragma("unroll") for (int ww = 0; ww < 8; ++ww) { const f32x2 t = *(const LAS f32x2*)(L + TOT + (ww * 128 + 2 * lane) * 4); total += t; if (dir == 0 ? (ww > w) : (ww < w)) off += t; } \
            f32x2 E[8]; \
            if (dir == 0) { E[7] = off; _Pragma("unroll") for (int i = 6; i >= 0; --i) E[i] = E[i + 1] + lf[i + 1]; } \
            else { E[0] = off; _Pragma("unroll") for (int i = 1; i < 8; ++i) E[i] = E[i - 1] + lf[i - 1]; } \
            _Pragma("unroll") for (int i = 0; i < 8; ++i) { const float k0 = (1.0f - __expf(lf[i].x)) * __expf(E[i].x), k1 = (1.0f - __expf(lf[i].y)) * __expf(E[i].y); \
                *(LAS unsigned*)(L + KP + off_b(8 * w + i, lane >> 2) + (lane & 3) * 4) = pk2(k0, k1); } \
            if (w == 0) { f32x2 d; d.x = __expf(total.x); d.y = __expf(total.y); *(LAS f32x2*)(L + DECV + 2 * lane * 4) = d; } \
            if ((j) + 2 < NCH) HS_LOAD(lf, vr, (j) + 2); \
            __syncthreads(); \
            if (w < 4) {     \
                bf16_t* sp = SS + ((size_t)chain * NCH + ci) * 16384 + 32 * sl + r32; \
                s16x4 al[4], ah[4], bl[4], bh[4]; \
                _Pragma("unroll") for (int ks = 0; ks < 4; ++ks) { al[ks] = trr(Lb + KP + tr_nat(lane, w, ks, 0)); ah[ks] = trr(Lb + KP + tr_nat(lane, w, ks, 1)); \
                    bl[ks] = trr(Lb + VT + tr_nat(lane, sl, ks, 0)); bh[ks] = trr(Lb + VT + tr_nat(lane, sl, ks, 1)); } \
                _Pragma("unroll") for (int r = 0; r < 16; ++r) { const int dk = 32 * w + crow(r, h5); sp[dk * 128] = (bf16_t)f2bf(S[r]); S[r] *= *(const LAS float*)(L + DECV + dk * 4); } \
                HG_WAITL(); \
                _Pragma("unroll") for (int ks = 0; ks < 4; ++ks) S = __builtin_amdgcn_mfma_f32_32x32x16_bf16(pk8(al[ks], ah[ks]), pk8(bl[ks], bh[ks]), S, 0, 0, 0); \
            } } while (0)
        HS_LOAD(lfA, vA, 0); HS_LOAD(lfB, vB, 1);
        __syncthreads();
#pragma unroll 1
        for (int j = 0; j < NCH; j += 2) { HS_STEP(lfA, vA, j); HS_STEP(lfB, vB, j + 1); }
#undef HS_STEP
#undef HS_LOAD
#undef HS_CI
        __syncthreads();
    }
}
__device__ __forceinline__ void phase_hg_out(const Ctx& C, int o_idx) {
    using namespace hg;
    LAS unsigned char* L = C.lds; const unsigned Lb = (unsigned)(uintptr_t)L;
    constexpr unsigned VT = 0, QP = 16384, QM = 32768, KM = 49152, ST = 65536, TOT = 98304, RED = 102400;
    const f16_t* LOGF = WSP(f16_t, WS_LOGF); const bf16_t* VH = WSP(bf16_t, WS_VH); const bf16_t* QH = WSP(bf16_t, WS_QH); const bf16_t* GH = WSP(bf16_t, WS_GH);
    const bf16_t* SS = WSP(bf16_t, WS_SS); bf16_t* Y = WSP(bf16_t, WS_Y); const float* nw = C.inp(23) + o_idx * 128;
    const int w = C.wave, lane = C.lane, tid = C.tid, h5 = lane >> 5, r32 = lane & 31;
    const unsigned tt = w >> 2, dvt = w & 3;
    for (int u = blockIdx.x; u < NBATCH * 16 * NCH; u += gridDim.x) {
        const int b = u / (16 * NCH), hh = (u / NCH) % 16, ci = u % NCH; const size_t R0 = (size_t)b * SROW + ci * 64;
        __syncthreads();
#pragma unroll
        for (int p = 0; p < 2; ++p) { const int row = (tid >> 4) + 32 * p, ch = tid & 15; const u32x4 v = *(const u32x4*)(VH + (R0 + row) * DM + hh * 128 + ch * 8); *(LAS u32x4*)(L + VT + off_b(row, ch)) = v; }
        f32x16 acc = {};
#pragma unroll 1
        for (int dir = 0; dir < 2; ++dir) {
            const int chain = (b * 16 + hh) * 2 + dir;
            u32x4 sreg[4];
#pragma unroll
            for (int p = 0; p < 4; ++p) sreg[p] = *(const u32x4*)(SS + (((size_t)chain * NCH + ci) * 128 + (tid >> 4) + 32 * p) * 128 + (tid & 15) * 8);
            const f16_t* lfp = LOGF + (size_t)dir * MROWS * DM + (R0 + 8 * w) * DM + hh * 128 + 2 * lane;
            const bf16_t* qp = QH + (R0 + 8 * w) * DM + hh * 128 + 2 * lane;
            f32x2 lf[8]; unsigned qv[8]; f32x2 T = {0.f, 0.f};
#pragma unroll
            for (int i = 0; i < 8; ++i) { const f16x2 t_ = *(const f16x2*)(lfp + (size_t)i * DM); lf[i] = (f32x2){(float)t_.x, (float)t_.y}; qv[i] = *(const unsigned*)(qp + (size_t)i * DM); T += lf[i]; }
            *(LAS f32x2*)(L + TOT + (w * 128 + 2 * lane) * 4) = T;
            __syncthreads();
            f32x2 off = {0.f, 0.f}, mid = {0.f, 0.f};
#pragma unroll
            for (int ww = 0; ww < 8; ++ww) { const f32x2 t = *(const LAS f32x2*)(L + TOT + (ww * 128 + 2 * lane) * 4);
                if (dir == 0 ? (ww < w) : (ww > w)) off += t; if (dir == 0 ? (ww < 4) : (ww >= 4)) mid += t; }
            f32x2 B[8];
            if (dir == 0) { B[0] = off + lf[0];
#pragma unroll
                for (int i = 1; i < 8; ++i) B[i] = B[i - 1] + lf[i]; }
            else { B[7] = off + lf[7];
#pragma unroll
                for (int i = 6; i >= 0; --i) B[i] = B[i + 1] + lf[i]; }
#pragma unroll
            for (int i = 0; i < 8; ++i) { const float q0 = __uint_as_float(qv[i] << 16), q1 = __uint_as_float(qv[i] & 0xffff0000u);
                const float k0 = 1.0f - __expf(lf[i].x), k1 = 1.0f - __expf(lf[i].y);
                const unsigned a = off_b(8 * w + i, lane >> 2) + (lane & 3) * 4;
                *(LAS unsigned*)(L + QP + a) = pk2(q0 * __expf(B[i].x), q1 * __expf(B[i].y));
                *(LAS unsigned*)(L + QM + a) = pk2(q0 * __expf(B[i].x - mid.x), q1 * __expf(B[i].y - mid.y));
                *(LAS unsigned*)(L + KM + a) = pk2(k0 * __expf(mid.x - B[i].x), k1 * __expf(mid.y - B[i].y)); }
#pragma unroll
            for (int p = 0; p < 4; ++p) *(LAS u32x4*)(L + ST + off_b((tid >> 4) + 32 * p, tid & 15)) = sreg[p];
            __syncthreads();
            { bf16x8 a[8]; s16x4 bl[8], bh[8];
#pragma unroll
              for (int ks = 0; ks < 8; ++ks) { a[ks] = *(const LAS bf16x8*)(L + QP + row_rd(lane, 32 * tt, ks)); bl[ks] = trr(Lb + ST + tr_nat(lane, dvt, ks, 0)); bh[ks] = trr(Lb + ST + tr_nat(lane, dvt, ks, 1)); }
              HG_WAITL();
#pragma unroll
              for (int ks = 0; ks < 8; ++ks) acc = __builtin_amdgcn_mfma_f32_32x32x16_bf16(a[ks], pk8(bl[ks], bh[ks]), acc, 0, 0, 0); }
            { bf16x8 qb[8];
#pragma unroll
              for (int ks = 0; ks < 8; ++ks) qb[ks] = *(const LAS bf16x8*)(L + QM + row_rd(lane, 32 * tt, ks));
#pragma unroll
              for (unsigned st = 0; st < 2; ++st) { const bool valid = dir == 0 ? (st <= tt) : (st >= tt);
                if (valid) {
                  f32x16 x = {};
#pragma unroll
                  for (int ks = 0; ks < 8; ++ks) { const bf16x8 ka = *(const LAS bf16x8*)(L + KM + row_rd(lane, 32 * st, ks)); x = __builtin_amdgcn_mfma_f32_32x32x16_bf16(ka, qb[ks], x, 0, 0, 0); }
                  if (st == tt) {
#pragma unroll
                    for (int r = 0; r < 16; ++r) { const int kr = crow(r, h5); const bool keep = dir == 0 ? (kr <= r32) : (kr >= r32); x[r] = keep ? x[r] : 0.f; } }
                  const s16x4 v0l = trr(Lb + VT + tr_perm(lane, dvt, 32 * st, 0)), v0h = trr(Lb + VT + tr_perm(lane, dvt, 32 * st, 1));
                  const s16x4 v1l = trr(Lb + VT + tr_perm(lane, dvt, 32 * st + 16, 0)), v1h = trr(Lb + VT + tr_perm(lane, dvt, 32 * st + 16, 1));
                  u32x4 A0, A1; A0.x = pk2(x[0], x[1]); A0.y = pk2(x[2], x[3]); A0.z = pk2(x[4], x[5]); A0.w = pk2(x[6], x[7]);
                  A1.x = pk2(x[8], x[9]); A1.y = pk2(x[10], x[11]); A1.z = pk2(x[12], x[13]); A1.w = pk2(x[14], x[15]);
                  HG_WAITL();
                  acc = __builtin_amdgcn_mfma_f32_32x32x16_bf16(*reinterpret_cast<bf16x8*>(&A0), pk8(v0l, v0h), acc, 0, 0, 0);
                  acc = __builtin_amdgcn_mfma_f32_32x32x16_bf16(*reinterpret_cast<bf16x8*>(&A1), pk8(v1l, v1h), acc, 0, 0, 0);
                } } }
        }
        LAS float* red = (LAS float*)(L + RED);
#pragma unroll
        for (int r = 0; r < 16; ++r) { float s = acc[r] * acc[r]; s += __shfl_xor(s, 1); s += __shfl_xor(s, 2); s += __shfl_xor(s, 4); s += __shfl_xor(s, 8); s += __shfl_xor(s, 16);
            if (r32 == 0) red[(tt * 32 + crow(r, h5)) * 4 + dvt] = s; }
        __syncthreads();
        const int col = hh * 128 + 32 * dvt + r32; const float wv = nw[32 * dvt + r32];
#pragma unroll
        for (int r = 0; r < 16; ++r) { const int row = 32 * tt + crow(r, h5); const f32x4 p = *(const LAS f32x4*)(red + row * 4);
            const float rstd = 1.0f / sqrtf(((p.x + p.y) + (p.z + p.w)) * (1.0f / 128.0f) + EPS); const size_t o = (R0 + row) * DM + col;
            Y[o] = (bf16_t)f2bf(acc[r] * rstd * wv * bf2f(GH[o])); }
    }
}
template <bool FINAL>
__device__ __forceinline__ void phase_lru(const Ctx& C, int e) {
    using namespace hg;
    LAS unsigned char* L = C.lds;
    constexpr unsigned UCB = 0, UCF = 16384, AT = 49152, BT = 81920, SEGB = 114688;
    const bf16_t* P = WSP(bf16_t, WS_P); float* AG = WSP(float, WS_AG); const float* CARRY = WSP(float, WS_CARRY); bf16_t* Y = WSP(bf16_t, WS_Y);
    const bf16_t* WG = WSP(bf16_t, WS_WG) + (size_t)e * 4 * 128 * 1024;
    const float* cw = C.inp(10) + (size_t)e * 4 * DLRU; const float* cb = C.inp(11) + (size_t)e * DLRU;
    const float* ba = C.inp(13) + (size_t)e * 2 * DLRU; const float* bx = C.inp(15) + (size_t)e * 2 * DLRU; const float* lam = C.inp(16) + (size_t)e * 2 * DLRU;
    const int w = C.wave, lane = C.lane, tid = C.tid, h5 = lane >> 5, r32 = lane & 31;
    const unsigned rt = w >> 2, et = w & 3;
    for (int u = gridDim.x - 1 - blockIdx.x; u < (MROWS / 64) * 8; u += gridDim.x) {
        const int ci2 = u >> 3, hd = u & 7; const int c = ci2 % NCH, bb = ci2 / NCH; const size_t R0 = (size_t)ci2 * 64;
        const int s0 = c * 64, lo = c < 4 ? 0 : CTX, hi = c < 4 ? CTX : SROW;
        __syncthreads();
        float cin0 = 0.f, cin1 = 0.f;
        if (FINAL) { const int ch = tid & 127; cin0 = CARRY[(size_t)(ci2 * 2 + 0) * DLRU + hd * 128 + ch]; cin1 = CARRY[(size_t)(ci2 * 2 + 1) * DLRU + hd * 128 + ch]; }
        { const int chn = hd * 128 + 2 * lane; const bf16_t* up = P + DLRU + chn;
          f32x2 uv[11];
#pragma unroll
          for (int i = 0; i < 11; ++i) { const int s = s0 + 8 * w + i - 2; unsigned raw = 0u; if (s >= lo && s < hi) raw = *(const unsigned*)(up + ((size_t)bb * SROW + s) * ABNP);
              uv[i].x = __uint_as_float(raw << 16); uv[i].y = __uint_as_float(raw & 0xffff0000u); }
          f32x2 wj[4];
#pragma unroll
          for (int j = 0; j < 4; ++j) wj[j] = *(const f32x2*)(cw + j * DLRU + chn);
          const f32x2 bias = *(const f32x2*)(cb + chn);
#pragma unroll
          for (int i = 0; i < 8; ++i) { f32x2 a = bias;
#pragma unroll
              for (int j = 0; j < 4; ++j) a += uv[i + j] * wj[j];
              *(LAS unsigned*)(L + UCB + off_b(8 * w + i, lane >> 2) + (lane & 3) * 4) = pk2(a.x, a.y);
              *(LAS f32x2*)(L + UCF + ((8 * w + i) * 128 + 2 * lane) * 4) = a; } }
        __syncthreads();
        bf16x8 af[8]; float ucr[16];
#pragma unroll
        for (int ks = 0; ks < 8; ++ks) af[ks] = *(const LAS bf16x8*)(L + UCB + row_rd(lane, 32 * rt, ks));
#pragma unroll
        for (int r = 0; r < 16; ++r) ucr[r] = *(const LAS float*)(L + UCF + ((32 * rt + crow(r, h5)) * 128 + 32 * et + r32) * 4);
        const int chl = hd * 128 + 32 * et + r32;
#pragma unroll 1
        for (int dir = 0; dir < 2; ++dir) {
            f32x16 ga = {}, gx = {};
            { const bf16_t* wa = WG + ((size_t)(dir * 2 + 0) * 128 + 32 * et + r32) * 1024 + hd * 128 + 8 * h5; const bf16_t* wx = wa + (size_t)128 * 1024;
              bf16x8 fa[8], fx[8];
#pragma unroll
              for (int ks = 0; ks < 8; ++ks) { fa[ks] = *(const bf16x8*)(wa + 16 * ks); fx[ks] = *(const bf16x8*)(wx + 16 * ks); }
#pragma unroll
              for (int ks = 0; ks < 8; ++ks) { ga = __builtin_amdgcn_mfma_f32_32x32x16_bf16(af[ks], fa[ks], ga, 0, 0, 0); gx = __builtin_amdgcn_mfma_f32_32x32x16_bf16(af[ks], fx[ks], gx, 0, 0, 0); } }
            const float bav = ba[dir * DLRU + chl], bxv = bx[dir * DLRU + chl], sp = log1pf(__expf(-lam[dir * DLRU + chl]));
            if (dir == 1) __syncthreads();
#pragma unroll
            for (int r = 0; r < 16; ++r) { const float rg = __builtin_amdgcn_rcpf(1.0f + __expf(-(ga[r] + bav))), ig = __builtin_amdgcn_rcpf(1.0f + __expf(-(gx[r] + bxv)));
                const float la = -8.0f * rg * sp; const unsigned o = ((32 * rt + crow(r, h5)) * 128 + 32 * et + r32) * 4;
                *(LAS float*)(L + AT + o) = __expf(la); *(LAS float*)(L + BT + o) = __builtin_amdgcn_sqrtf(1.0f - __expf(2.0f * la)) * (ig * ucr[r]); }
            __syncthreads();
            { const int seg = tid >> 7, ch = tid & 127; const LAS float* ap = (const LAS float*)(L + AT) + ch; const LAS float* bp = (const LAS float*)(L + BT) + ch;
              LAS f32x2* sg4 = (LAS f32x2*)(L + SEGB);
              float h = 0.f, pr = 1.f;
#pragma unroll
              for (int i = 0; i < 16; ++i) { const int row = dir == 0 ? 16 * seg + i : 63 - 16 * seg - i; const float a = ap[row * 128]; h = a * h + bp[row * 128]; pr *= a; }
              sg4[seg * 128 + ch] = (f32x2){pr, h};
              __syncthreads();
              float cs = FINAL ? (dir == 0 ? cin0 : cin1) : 0.f, pa = 1.f;
#pragma unroll
              for (int q = 0; q < 3; ++q) if (q < seg) { const f32x2 t = sg4[q * 128 + ch]; cs = cs * t.x + t.y; pa *= t.x; }
              if (!FINAL) { if (seg == 3) { float* ag = AG + ((size_t)(ci2 * 2 + dir) * 2) * DLRU + hd * 128 + ch; ag[0] = pa * pr; ag[DLRU] = cs * pr + h; } }
              else { LAS float* hp = (LAS float*)(L + (dir == 0 ? UCF : AT)) + ch;
                  h = cs;
#pragma unroll
                  for (int i = 0; i < 16; ++i) { const int row = dir == 0 ? 16 * seg + i : 63 - 16 * seg - i; h = ap[row * 128] * h + bp[row * 128]; hp[row * 128] = h; } } }
        }
        if (FINAL) {
            __syncthreads();
            const int row = tid >> 3, c16 = (tid & 7) * 16; const bf16_t* gp = P + (R0 + row) * ABNP + hd * 128 + c16; bf16_t* yp = Y + (R0 + row) * DM + hd * 128 + c16;
            const u32x4 g0 = *(const u32x4*)gp, g1 = *(const u32x4*)(gp + 8); u32x4 o0, o1;
            const LAS f32x4* hf = (const LAS f32x4*)(L + UCF + (row * 128 + c16) * 4); const LAS f32x4* hb = (const LAS f32x4*)(L + AT + (row * 128 + c16) * 4);
#pragma unroll
            for (int q = 0; q < 4; ++q) { const f32x4 hs = hf[q] + hb[q]; const unsigned ga = q < 2 ? g0[2 * q] : g1[2 * q - 4], gb = q < 2 ? g0[2 * q + 1] : g1[2 * q - 3];
                const float y0 = hs.x * gelu_tanh(__uint_as_float(ga << 16)), y1 = hs.y * gelu_tanh(__uint_as_float(ga & 0xffff0000u)), y2 = hs.z * gelu_tanh(__uint_as_float(gb << 16)), y3 = hs.w * gelu_tanh(__uint_as_float(gb & 0xffff0000u));
                if (q < 2) { o0[2 * q] = pk2(y0, y1); o0[2 * q + 1] = pk2(y2, y3); } else { o1[2 * q - 4] = pk2(y0, y1); o1[2 * q - 3] = pk2(y2, y3); } }
            *(u32x4*)yp = o0; *(u32x4*)(yp + 8) = o1;
        }
    }
}
__device__ __forceinline__ void phase_lru_carry(const Ctx& C) {
    using namespace hg;
    const float* AG = WSP(float, WS_AG); float* CARRY = WSP(float, WS_CARRY);
    const int G = gridDim.x, first = G >= 8 ? G - 8 : 0;
    if ((int)blockIdx.x < first) return;
    for (int id = ((int)blockIdx.x - first) * 512 + C.tid; id < NBATCH * 2 * DLRU; id += (G - first) * 512) { const int b = id >> 11, dir = (id >> 10) & 1, ch = id & 1023;
        float carry = 0.f;
#pragma unroll 4
        for (int j = 0; j < NCH; ++j) { const int cc = dir == 0 ? j : (j < 4 ? 3 - j : 71 - j); const size_t ci2 = (size_t)b * NCH + cc;
            CARRY[(ci2 * 2 + dir) * DLRU + ch] = carry; const float* ag = AG + ((ci2 * 2 + dir) * 2) * DLRU + ch; carry = carry * ag[0] + ag[DLRU]; } }
}
__device__ __forceinline__ void phase_final(const Ctx& C) {
    const float* XS = WSP(float, WS_XS); const float* w = C.inp(27);
    for (int r = C.gw; r < NBATCH * SEQ; r += C.ngw) { const int b = r / SEQ, t = r % SEQ; const size_t R = (size_t)b * SROW + CTX + t;
        const f32x4* xr = (const f32x4*)(XS + R * DM) + C.lane; f32x4 v[8]; float ss = 0.f;
#pragma unroll
        for (int j = 0; j < 8; ++j) { v[j] = xr[64 * j]; ss += (v[j].x * v[j].x + v[j].y * v[j].y) + (v[j].z * v[j].z + v[j].w * v[j].w); }
        const float rstd = 1.0f / sqrtf(wave_sum(ss) * (1.0f / DM) + EPS);
        f32x4* o = (f32x4*)(C.out + (size_t)r * DM) + C.lane;
#pragma unroll
        for (int j = 0; j < 8; ++j) { const f32x4 wv = *(const f32x4*)(w + (C.lane + 64 * j) * 4); o[64 * j] = v[j] * rstd * wv; } }
}

struct Args { const float* in[28]; float* out; unsigned char* ws; int ph_lo, ph_hi; };
constexpr int N_PHASES = 1 + 2 * 9 + 2 * 8 + 1;

__global__ void __launch_bounds__(512, 2) fwd_kernel(Args args) {
    extern __shared__ __attribute__((aligned(16))) unsigned char lds_raw[];
    LAS unsigned char* const lds0 = (LAS unsigned char*)lds_raw;
    const unsigned long long inaddr = (unsigned long long)__builtin_amdgcn_kernarg_segment_ptr();
    volatile LAS unsigned* misc = (volatile LAS unsigned*)(lds0 + LDS_MISC);
    if (threadIdx.x < 64) misc[threadIdx.x] = 0u;
    __syncthreads();
    const int lo = args.ph_lo, hi = args.ph_hi;
    const int wave0 = __builtin_amdgcn_readfirstlane(threadIdx.x >> 6);
    XcdBarrier bar; bar.bar = (unsigned*)(args.ws + WS_CTL) + 4096; bar.x = 0; bar.st = misc + 8;
    if (hi - lo > 1) bar = xcd_barrier_post((unsigned*)(args.ws + WS_CTL) + 4096, misc + 8);
    int pid = 0;
    const unsigned long long wsaddr = (unsigned long long)args.ws;
#define PH_BEGIN if (pid >= lo && pid < hi) { int l = l_; Ctx C; { unsigned long long a_ = inaddr, w_ = wsaddr; int t_; asm volatile("v_mbcnt_lo_u32_b32 %0, -1, 0\n\tv_mbcnt_hi_u32_b32 %0, -1, %0" : "=v"(t_)); t_ += wave0 * 64; asm volatile("" : "+s"(a_), "+s"(w_), "+s"(l)); \
        C.in = (InPtr)a_; C.ws = (unsigned char*)(GAS unsigned char*)w_; C.out = (float*)(GAS float*)args.out; C.lds = lds0; C.tid = t_; C.lane = t_ & 63; C.wave = __builtin_amdgcn_readfirstlane(t_ >> 6); \
        C.gw = blockIdx.x * 8 + C.wave; C.ngw = gridDim.x * 8; C.gtid = blockIdx.x * 512 + t_; C.ngt = gridDim.x * 512; } \
        const int e = l >> 1; const float* mod = WSP(float, WS_MOD) + (size_t)l * 3 * MODW; const int G = gridDim.x, cb = blockIdx.x; (void)e; (void)mod; (void)G; (void)cb;
#define PH_END } if (pid >= lo && pid + 1 < hi) xcd_barrier(bar); ++pid;
#ifndef PROBE_CAT
#define PROBE_CAT -1
#endif
#define DUP(cat, ...) { if (PROBE_CAT == (cat)) { const float SC_ = 0.f; (void)SC_; __VA_ARGS__ } { const float SC_ = 1.f; (void)SC_; __VA_ARGS__ } }
    int l_ = 0;
    PH_BEGIN
#ifndef SKIP_PRO
    DUP(0, phase_prologue(C);)
#endif
    PH_END

    constexpr int MLAT = NBATCH * SEQ;
    for (l_ = 0; l_ < DEPTH; ++l_) {
        PH_BEGIN DUP(1, phase_norm_mod(C, C.inp(6) + l * DM, mod, 0, 1);) PH_END
        if ((l_ & 1) == 0) {
            PH_BEGIN DUP(2, { const bf16_t* wt = WSP(bf16_t, WS_WABIN) + (size_t)e * ABNP * DM;
                       { pg8::Gemm g{WSP(bf16_t, WS_H), wt, MLAT, ABNP, DM, DM, DM, 1}; pg8::StaticOrder S; S.init(MLAT, ABNP, G, cb); EpiBf16Plain E{WSP(bf16_t, WS_P), ABNP}; pg8::gemm_phase(C.lds, C.tid, g, S, E); }
                       DUP(14, { sg::SGemm g{WSP(bf16_t, WS_H), wt, ABNP, DM, DM, DM}; SEpiPlain E{WSP(bf16_t, WS_P), ABNP}; sg::sgemm_phase(C.lds, C.tid, g, 32 * (ABNP / 256), E); }) }) PH_END
            PH_BEGIN DUP(3, { phase_lru<false>(C, e); phase_rs_kr(C); }) PH_END
            PH_BEGIN phase_lru_carry(C); DUP(4, { const bf16_t* wq = WSP(bf16_t, WS_WUQ) + (size_t)e * QW * 512; const bf16_t* wkv = WSP(bf16_t, WS_WUKV) + (size_t)e * KVW * 512;
                       { pg8::Gemm g{WSP(bf16_t, WS_P) + 2048, wq, MLAT, QW, 512, ABNP, 512, 1}; pg8::StaticOrder S; S.init(MLAT, QW, G, cb); EpiBf16RowScale E{WSP(bf16_t, WS_Q), QW, WSP(float, WS_RSQ)}; pg8::gemm_phase(C.lds, C.tid, g, S, E); }
                       { pg8::Gemm g{WSP(bf16_t, WS_P) + 2560, wkv, MLAT, KVW, 512, ABNP, 512, 1}; pg8::StaticOrder S; S.init(MLAT, KVW, G, cb); EpiBf16RowScale E{WSP(bf16_t, WS_KV), KVW, WSP(float, WS_RSKV)}; pg8::gemm_phase(C.lds, C.tid, g, S, E); }
                       DUP(14, { sg::SGemm g{WSP(bf16_t, WS_P) + 2048, wq, QW, 512, ABNP, 512}; SEpiRowScale E{WSP(bf16_t, WS_Q), QW, WSP(float, WS_RSQ)}; sg::sgemm_phase(C.lds, C.tid, g, 32 * (QW / 256), E); })
                       DUP(14, { sg::SGemm g{WSP(bf16_t, WS_P) + 2560, wkv, KVW, 512, ABNP, 512}; SEpiRowScale E{WSP(bf16_t, WS_KV), KVW, WSP(float, WS_RSKV)}; sg::sgemm_phase(C.lds, C.tid, g, 0, E); }) })
            PH_END
            PH_BEGIN DUP(5, phase_lru<true>(C, e);) DUP(6, phase_attn(C);) PH_END
        } else {
            PH_BEGIN DUP(7, { const bf16_t* wt = WSP(bf16_t, WS_WHGIN) + (size_t)e * HGN * DM;
                       { pg8::Gemm g{WSP(bf16_t, WS_H), wt, MLAT, HGN, DM, DM, DM, 1}; pg8::StaticOrder S; S.init(MLAT, HGN, G, cb); EpiHG E{WSP(bf16_t, WS_QH), WSP(f16_t, WS_LOGF), WSP(float, WS_LB) + l * 2048}; pg8::gemm_phase(C.lds, C.tid, g, S, E); }
                       DUP(14, { sg::SGemm g{WSP(bf16_t, WS_H), wt, HGN, DM, DM, DM}; SEpiHG E{WSP(bf16_t, WS_QH), WSP(f16_t, WS_LOGF), WSP(float, WS_LB) + l * 2048}; sg::sgemm_phase(C.lds, C.tid, g, 32 * (HGN / 256), E); }) }) PH_END
            PH_BEGIN DUP(8, phase_hg_state(C);) PH_END
            PH_BEGIN DUP(10, phase_hg_out(C, e);) PH_END
        }
        PH_BEGIN DUP(11, { const bf16_t* wout = (l & 1) ? WSP(bf16_t, WS_WHGOUT) + (size_t)e * DM * DM : WSP(bf16_t, WS_WABOUT) + (size_t)e * DM * DM;
                   { pg8::Gemm g{WSP(bf16_t, WS_Y), wout, MLAT, DM, DM, DM, DM, 1}; pg8::StaticOrder S; S.init(MLAT, DM, G, cb); EpiResid E{WSP(float, WS_XS), mod + 2 * DM, SC_}; pg8::gemm_phase(C.lds, C.tid, g, S, E); }
                   if (l != DEPTH - 1) DUP(14, { sg::SGemm g{WSP(bf16_t, WS_Y), wout, DM, DM, DM, DM}; SEpiResid E{WSP(float, WS_XS), mod + 2 * DM, SC_}; sg::sgemm_phase(C.lds, C.tid, g, 32 * (DM / 256), E); }) }) PH_END
        PH_BEGIN DUP(1, phase_norm_mod(C, C.inp(7) + l * DM, mod, 3, 4);) PH_END
        PH_BEGIN DUP(12, { const bf16_t* wt = WSP(bf16_t, WS_W1) + (size_t)l * DFF * DM;
                   { pg8::Gemm g{WSP(bf16_t, WS_H), wt, MLAT, DFF, DM, DM, DM, 1}; pg8::StaticOrder S; S.init(MLAT, DFF, G, cb); EpiRelu2 E{WSP(bf16_t, WS_HID), DFF}; pg8::gemm_phase(C.lds, C.tid, g, S, E); }
                   if (l != DEPTH - 1) DUP(16, { sg::SGemm g{WSP(bf16_t, WS_H), wt, DFF, DM, DM, DM}; SEpiRelu2 E{WSP(bf16_t, WS_HID), DFF}; sg::sgemm_phase(C.lds, C.tid, g, 32 * (DFF / 256), E); }) }) PH_END
        PH_BEGIN DUP(13, { const bf16_t* wt = WSP(bf16_t, WS_W2) + (size_t)l * DM * DFF;
                   { pg8::Gemm g{WSP(bf16_t, WS_HID), wt, MLAT, DM, DFF, DFF, DFF, 1}; pg8::StaticOrder S; S.init(MLAT, DM, G, cb); EpiResid E{WSP(float, WS_XS), mod + 5 * DM, SC_}; pg8::gemm_phase(C.lds, C.tid, g, S, E); }
                   if (l != DEPTH - 1) DUP(15, { sg::SGemm g{WSP(bf16_t, WS_HID), wt, DM, DFF, DFF, DFF}; SEpiResid E{WSP(float, WS_XS), mod + 5 * DM, SC_}; sg::sgemm_phase(C.lds, C.tid, g, 32 * (DM / 256), E); }) }) PH_END
    }
    l_ = 0;
    PH_BEGIN phase_final(C); PH_END
}

#ifndef N_LAUNCH_MODE
#define N_LAUNCH_MODE 1
#endif
extern "C" void kernel_launch(void* const* d_in, const int* in_sizes, int n_in, void* d_out, int out_size, void* d_ws, size_t ws_size, hipStream_t stream) {
    static int grid = 0;
    if (grid == 0) {
        if (n_in != 28 || out_size != NBATCH * SEQ * DM || ws_size < WS_END) { fprintf(stderr, "kernel_launch: shape mismatch n_in %d out %d ws %zu (need %zu)\n", n_in, out_size, ws_size, (size_t)WS_END); grid = -1; return; }
        int dev = 0, cus = 0, per_cu = 0;
        if (hipGetDevice(&dev) != hipSuccess || hipDeviceGetAttribute(&cus, hipDeviceAttributeMultiprocessorCount, dev) != hipSuccess) { grid = -1; return; }
        if (hipFuncSetAttribute((const void*)fwd_kernel, hipFuncAttributeMaxDynamicSharedMemorySize, LDS_BYTES) != hipSuccess) { fprintf(stderr, "kernel_launch: hipFuncSetAttribute failed\n"); grid = -1; return; }
        if (hipOccupancyMaxActiveBlocksPerMultiprocessor(&per_cu, (const void*)fwd_kernel, 512, LDS_BYTES) != hipSuccess || per_cu < 1) fprintf(stderr, "kernel_launch: occupancy query says %d\n", per_cu);
        (void)hipGetLastError();
        grid = cus;
    }
    if (grid < 0) return;
    (void)hipMemsetAsync((char*)d_ws + WS_CTL, 0, CTL_BYTES, stream);
    Args a{};
    for (int i = 0; i < 28; ++i) a.in[i] = (const float*)d_in[i];
    a.out = (float*)d_out; a.ws = (unsigned char*)d_ws;
#if N_LAUNCH_MODE == 1
    a.ph_lo = 0; a.ph_hi = N_PHASES;
    hipLaunchKernelGGL(fwd_kernel, dim3(grid), dim3(512), LDS_BYTES, stream, a);
#else
    for (int p = 0; p < N_PHASES; ++p) { a.ph_lo = p; a.ph_hi = p + 1; hipLaunchKernelGGL(fwd_kernel, dim3(grid), dim3(512), LDS_BYTES, stream, a); }
#endif
    const hipError_t le = hipPeekAtLastError();
    if (le != hipSuccess) fprintf(stderr, "kernel_launch: launch failed: %s\n", hipGetErrorName(le));
}
```

```cpp
#include <hip/hip_runtime.h>
#include <cstdio>

#define LAS __attribute__((address_space(3)))
#define GAS __attribute__((address_space(1)))
typedef unsigned short bf16_t;
typedef short bf16x8 __attribute__((ext_vector_type(8)));
typedef float f32x4 __attribute__((ext_vector_type(4)));
typedef float f32x2 __attribute__((ext_vector_type(2)));
typedef unsigned u32x4 __attribute__((ext_vector_type(4)));
typedef unsigned u32x2 __attribute__((ext_vector_type(2)));
typedef _Float16 f16_t;
typedef _Float16 f16x2 __attribute__((ext_vector_type(2)));
typedef _Float16 f16x8 __attribute__((ext_vector_type(8)));

constexpr int DM = 2048, NBATCH = 2, SEQ = 4096, DEPTH = 4, CTX = 256;
constexpr int SROW = CTX + SEQ;
constexpr int MROWS = NBATCH * SROW;
constexpr int DFF = 8192, MODW = 6 * DM;
constexpr int DLRU = 1024;
constexpr int ABN = 3136, ABNP = 3328;
constexpr int QW = 1536, KVW = 2048, HGN = 10240;
constexpr float EPS = 1e-6f;
constexpr float ATTN_SCALE = 0.07216878364870322f;

constexpr size_t al256(size_t x) { return (x + 255) & ~(size_t)255; }
constexpr size_t WS_CTL = 0, CTL_BYTES = 1u << 20;
constexpr size_t WS_MOD = WS_CTL + CTL_BYTES;
constexpr size_t WS_LB = WS_MOD + al256((size_t)DEPTH * 3 * MODW * 4);
constexpr size_t WS_ROPE = WS_LB + al256((size_t)DEPTH * 2048 * 4);
constexpr size_t WS_RSQ = WS_ROPE + al256(2 * 64 * 16 * 4);
constexpr size_t WS_RSKV = WS_RSQ + al256((size_t)MROWS * 4);
constexpr size_t WS_WABIN = WS_RSKV + al256((size_t)MROWS * 4);
constexpr size_t WS_WABOUT = WS_WABIN + (size_t)2 * ABNP * DM * 2;
constexpr size_t WS_WUQ = WS_WABOUT + (size_t)2 * DM * DM * 2;
constexpr size_t WS_WUKV = WS_WUQ + (size_t)2 * QW * 512 * 2;
constexpr size_t WS_WHGIN = WS_WUKV + (size_t)2 * KVW * 512 * 2;
constexpr size_t WS_WHGOUT = WS_WHGIN + (size_t)2 * HGN * DM * 2;
constexpr size_t WS_W1 = WS_WHGOUT + (size_t)2 * DM * DM * 2;
constexpr size_t WS_W2 = WS_W1 + (size_t)4 * DFF * DM * 2;
constexpr size_t WS_WG = WS_W2 + (size_t)4 * DFF * DM * 2;
constexpr size_t WS_XS = WS_WG + (size_t)2 * 4 * 128 * 1024 * 2;
constexpr size_t WS_H = WS_XS + (size_t)MROWS * DM * 4;
constexpr size_t WS_Y = WS_H + (size_t)MROWS * DM * 2;
constexpr size_t WS_BIG = WS_Y + (size_t)MROWS * DM * 2;
constexpr size_t WS_P = WS_BIG;
constexpr size_t WS_AG = WS_P + (size_t)MROWS * ABNP * 2;
constexpr size_t WS_CARRY = WS_AG + al256((size_t)(MROWS / 64) * 2 * 2 * DLRU * 4);
constexpr size_t WS_Q = WS_CARRY + al256((size_t)(MROWS / 64) * 2 * DLRU * 4);
constexpr size_t WS_KV = WS_Q + (size_t)MROWS * QW * 2;
constexpr size_t WS_KR = WS_KV + (size_t)MROWS * KVW * 2;
constexpr size_t WS_AB_END = WS_KR + (size_t)MROWS * 64 * 2;
constexpr size_t WS_QH = WS_BIG;
constexpr size_t WS_VH = WS_QH + (size_t)MROWS * DM * 2;
constexpr size_t WS_GH = WS_VH + (size_t)MROWS * DM * 2;
constexpr size_t WS_LOGF = WS_GH + (size_t)MROWS * DM * 2;
constexpr size_t WS_SS = WS_LOGF + (size_t)2 * MROWS * DM * 2;
constexpr size_t WS_HG_END = WS_SS + (size_t)64 * 68 * 16384 * 2;
constexpr size_t WS_HID = WS_BIG;
constexpr size_t WS_MLP_END = WS_HID + (size_t)MROWS * DFF * 2;
constexpr size_t cmax(size_t a, size_t b) { return a > b ? a : b; }
constexpr size_t WS_END = cmax(cmax(WS_AB_END, WS_HG_END), WS_MLP_END);

constexpr int LDS_BYTES = 147456;
constexpr int LDS_MISC = 139264;

__device__ __forceinline__ float bf2f(bf16_t v) { return __uint_as_float(((unsigned)v) << 16); }
__device__ __forceinline__ unsigned f2bf(float f) { unsigned u = __float_as_uint(f); return (u + 0x7fffu + ((u >> 16) & 1u)) >> 16; }
__device__ __forceinline__ unsigned pk2(float lo, float hi) { return f2bf(lo) | (f2bf(hi) << 16); }
__device__ __forceinline__ float wave_sum(float v) {
#pragma unroll
    for (int o = 1; o < 64; o <<= 1) v += __shfl_xor(v, o);
    return v;
}
__device__ __forceinline__ float wave_max(float v) {
#pragma unroll
    for (int o = 1; o < 64; o <<= 1) v = fmaxf(v, __shfl_xor(v, o));
    return v;
}
__device__ __forceinline__ float sigmoidf_(float x) { return 1.0f / (1.0f + expf(-x)); }
__device__ __forceinline__ float siluf_(float x) { return x / (1.0f + expf(-x)); }
__device__ __forceinline__ float fsigmoid(float x) { return __builtin_amdgcn_rcpf(1.0f + __expf(-x)); }
__device__ __forceinline__ float gelu_tanh(float x) { const float u = 0.7978845608028654f * (x + 0.044715f * x * x * x); return x * fsigmoid(2.0f * u); }

#define XB_TMO      128
#define XB_XCNT(j)  (256  + 64 * (j))
#define XB_XSUB(j)  (1280 + 64 * (j))
#define XB_XGEN(j)  (2304 + 64 * (j))
#define XB_TOP      3328
#define XB_TOPGEN   3392
#define XCD_BAR_WORDS 3456
#define XB_SPIN_CAP (1u << 18)
__device__ __forceinline__ unsigned xb_ld(unsigned* p)              { return __hip_atomic_load(p, __ATOMIC_RELAXED, __HIP_MEMORY_SCOPE_AGENT); }
__device__ __forceinline__ unsigned xb_add(unsigned* p, unsigned v) { return __hip_atomic_fetch_add(p, v, __ATOMIC_RELAXED, __HIP_MEMORY_SCOPE_AGENT); }
__device__ __forceinline__ unsigned xb_xcc_id() { return (unsigned)__builtin_amdgcn_s_getreg((3 << 11) | 20) & 0xFu; }
#define XB_SPIN(cond, bar) do { unsigned _sp = 0; while (cond) { __builtin_amdgcn_s_sleep(1); \
    if ((++_sp & 255u) == 0u) { if (xb_ld(&(bar)[XB_TMO])) break; if (_sp > XB_SPIN_CAP) { atomicAdd(&(bar)[XB_TMO], 1u); break; } } } } while (0)
struct XcdBarrier { unsigned* bar; unsigned x; volatile LAS unsigned* st; };
__device__ __forceinline__ XcdBarrier xcd_barrier_post(unsigned* bar, volatile LAS unsigned* st) {
    XcdBarrier b; b.bar = bar; b.x = xb_xcc_id(); b.st = st;
    if (threadIdx.x == 0) (void)xb_add(&bar[XB_XCNT(b.x)], 1u);
    return b;
}
__device__ __forceinline__ void xcd_barrier_complete(unsigned* bar, unsigned x, unsigned& nloc, unsigned& nx) {
    const unsigned G = gridDim.x * gridDim.y * gridDim.z;
    unsigned sum, cnt, mine, sp = 0u;
    for (;;) {
        sum = 0u; cnt = 0u; mine = 0u;
#pragma unroll
        for (unsigned j = 0; j < 16; ++j) { const unsigned c = xb_ld(&bar[XB_XCNT(j)]); sum += c; cnt += (c > 0u) ? 1u : 0u; mine = (j == x) ? c : mine; }
        if (sum == G) break;
        __builtin_amdgcn_s_sleep(1);
        if ((++sp & 255u) == 0u) { if (xb_ld(&bar[XB_TMO])) break; if (sp > XB_SPIN_CAP) { atomicAdd(&bar[XB_TMO], 1u); break; } }
    }
    nloc = mine > 0u ? mine : 1u; nx = cnt > 0u ? cnt : 1u;
}
__device__ __forceinline__ void xcd_barrier(const XcdBarrier& b) {
    asm volatile("s_waitcnt vmcnt(0)" ::: "memory");
    __syncthreads();
    if (threadIdx.x == 0) {
        unsigned* bar = b.bar; asm volatile("" : "+s"(bar)); bar = (unsigned*)(GAS unsigned*)bar;
        __builtin_amdgcn_s_waitcnt(0);
        unsigned nloc = b.st[0], nx = b.st[1];
        if (nloc == 0u) { xcd_barrier_complete(bar, b.x, nloc, nx); b.st[0] = nloc; b.st[1] = nx; }
        const unsigned old = xb_add(&bar[XB_XSUB(b.x)], 1u);
        const unsigned gen = old / nloc;
        if (old + 1u == (gen + 1u) * nloc) {
            __builtin_amdgcn_fence(__ATOMIC_RELEASE, "agent");
            asm volatile("s_waitcnt vmcnt(0)" ::: "memory");
            const unsigned og = xb_add(&bar[XB_TOP], 1u);
            const unsigned tg = og / nx;
            if (og + 1u == (tg + 1u) * nx) xb_add(&bar[XB_TOPGEN], 1u);
            else XB_SPIN(xb_ld(&bar[XB_TOPGEN]) == tg, bar);
            __builtin_amdgcn_fence(__ATOMIC_ACQUIRE, "agent");
            xb_add(&bar[XB_XGEN(b.x)], 1u);
            asm volatile("s_waitcnt vmcnt(0)" ::: "memory");
        } else {
            XB_SPIN(xb_ld(&bar[XB_XGEN(b.x)]) == gen, bar);
            __builtin_amdgcn_fence(__ATOMIC_ACQUIRE, "agent");
            asm volatile("s_waitcnt vmcnt(0)" ::: "memory");
        }
    }
    __syncthreads();
}

namespace pg8 {
constexpr int BM = 256, BK = 64, HALF = 128, HTB = HALF * BK * 2, STAGE_BYTES = 8 * HTB, NXCD = 8, WGM = 8;
__host__ __device__ __forceinline__ int lds_byte(int r, int c) { const int st = (r >> 4) * 2 + (c >> 5), rr = r & 15, cc = c & 31, ob = rr * 64 + cc * 2; return st * 1024 + (ob ^ (((ob >> 9) & 1) << 5)); }
__host__ __device__ __forceinline__ void stage_rc(int b, int& R, int& C) { const int st = b / 1024, sb = b % 1024, swz = sb ^ (((sb >> 9) & 1) << 5); R = (st >> 1) * 16 + swz / 64; C = (st & 1) * 32 + (swz % 64) / 2; }
__host__ __device__ __forceinline__ int perm32(int rho) { const int n = rho >> 4, i = rho & 15; return 8 * (i >> 2) + 4 * n + (i & 3); }
struct Unit { int pm, pn; };
struct Gemm { const bf16_t* A; const bf16_t* Bt; int M, N, K, lda, ldb, lat; };
struct StaticOrder {
    int nM, nN, nwg, G, c;
    __host__ __device__ void init(int M, int N, int G_, int c_) { nM = M / BM; nN = N / BM; nwg = nM * nN; G = G_; c = c_; }
    __host__ __device__ bool next(int i, Unit& u) const {
        const long L = (long)i * G + c; if (L >= nwg) return false;
        int wgid = (int)L; { const int q = nwg / NXCD, r = nwg % NXCD, xcd = wgid % NXCD, off = wgid / NXCD; wgid = (xcd < r ? xcd * (q + 1) : r * (q + 1) + (xcd - r) * q) + off; }
        const int nig = WGM * nN, gid = wgid / nig, fm = gid * WGM, gsz = (nM - fm) < WGM ? (nM - fm) : WGM;
        u.pm = fm + ((wgid % nig) % gsz); u.pn = (wgid % nig) / gsz; return true;
    }
};
__device__ __forceinline__ unsigned cvt_pk_bf16(float lo, float hi) { unsigned r; asm volatile("v_cvt_pk_bf16_f32 %0, %1, %2" : "=v"(r) : "v"(lo), "v"(hi)); return r; }

template <class Epi>
__device__ __forceinline__ void gemm_phase(LAS unsigned char* lds, const int tid, const Gemm g, const StaticOrder& S, const Epi& E) {
    const int wid = __builtin_amdgcn_readfirstlane(tid >> 6), lane = tid & 63, wr = wid >> 2, wc = wid & 3, fr = lane & 15, fq = lane >> 4;
    const int K = g.K, nt = K / BK;
    unsigned voffA[2], voffB[2];
#pragma unroll
    for (int i = 0; i < 2; ++i) { int R, C; stage_rc(tid * 16 + i * 8192, R, C); const int Rb = Epi::PERM ? ((R & ~31) + perm32(R & 31)) : R;
        voffA[i] = (unsigned)(R * g.lda + C) * 2u; voffB[i] = (unsigned)(Rb * g.ldb + C) * 2u; }
    const size_t kstep = (size_t)(BK * 2);
    const size_t hsA = (size_t)HALF * g.lda * 2, hsB = (size_t)HALF * g.ldb * 2;
    const size_t tsA = 2 * hsA, tsB = 2 * hsB;
    const unsigned ldsw = (unsigned)wid * 1024u;
    const int aoff = lds_byte(wr * 64 + fr, fq * 8), boff = lds_byte(wc * 32 + fr, fq * 8);
#define PG8_SA(b, h) (((b) * 2 + (h)) * HTB)
#define PG8_SB(b, h) ((4 + (b) * 2 + (h)) * HTB)
#define PG8_STAGE(bufoff, gbase, voff) do { _Pragma("unroll") for (int _i = 0; _i < 2; ++_i) \
        __builtin_amdgcn_global_load_lds((const unsigned*)((const char*)(gbase) + (voff)[_i]), (LAS unsigned*)(lds + (bufoff) + ldsw + _i * 8192), 16, 0, 0); } while (0)
#define PG8_LDA(dst, b, h) do { _Pragma("unroll") for (int m = 0; m < 4; ++m) _Pragma("unroll") for (int k = 0; k < 2; ++k) dst[m][k] = *(const LAS bf16x8*)(lds + PG8_SA(b, h) + aoff + m * 2048 + k * 1024); } while (0)
#define PG8_LDB(dst, b, h) do { _Pragma("unroll") for (int n = 0; n < 2; ++n) _Pragma("unroll") for (int k = 0; k < 2; ++k) dst[n][k] = *(const LAS bf16x8*)(lds + PG8_SB(b, h) + boff + n * 2048 + k * 1024); } while (0)
#define PG8_MMA(ai, bj, At, Bt) do { __builtin_amdgcn_s_setprio(1); _Pragma("unroll") for (int m = 0; m < 4; ++m) _Pragma("unroll") for (int n = 0; n < 2; ++n) _Pragma("unroll") for (int k = 0; k < 2; ++k) \
        acc[ai][bj][m][n] = __builtin_amdgcn_mfma_f32_16x16x32_bf16(Bt[n][k], At[m][k], acc[ai][bj][m][n], 0, 0, 0); __builtin_amdgcn_s_setprio(0); } while (0)
#define PG8_WAIT_V(n) asm volatile("s_waitcnt vmcnt(" #n ")" ::: "memory")
#define PG8_WAIT_L(n) asm volatile("s_waitcnt lgkmcnt(" #n ")" ::: "memory")
#define PG8_BAR __builtin_amdgcn_s_barrier()
#define PG8_SCHED __builtin_amdgcn_sched_barrier(0)
    Unit cur, nxt; int ui = 0;
    if (!S.next(0, cur)) return;
    if (g.lat) cur.pm += (cur.pm >> 4) + 1;
    f32x4 acc[2][2][4][2];
#pragma unroll
    for (int a = 0; a < 2; ++a)
#pragma unroll
        for (int b = 0; b < 2; ++b)
#pragma unroll
            for (int m = 0; m < 4; ++m)
#pragma unroll
                for (int n = 0; n < 2; ++n) acc[a][b][m][n] = (f32x4){0.f, 0.f, 0.f, 0.f};
    bf16x8 At[4][2], B0[2][2], B1[2][2];
    const char* cA = (const char*)g.A + (size_t)cur.pm * tsA; const char* cB = (const char*)g.Bt + (size_t)cur.pn * tsB;
    PG8_STAGE(PG8_SB(0, 0), cB, voffB); PG8_STAGE(PG8_SA(0, 0), cA, voffA); PG8_STAGE(PG8_SB(0, 1), cB + hsB, voffB); PG8_STAGE(PG8_SA(0, 1), cA + hsA, voffA);
    if (wr == 1) PG8_BAR;
    PG8_WAIT_V(4); PG8_BAR;
    PG8_STAGE(PG8_SB(1, 0), cB + kstep, voffB); PG8_STAGE(PG8_SA(1, 0), cA + kstep, voffA); PG8_STAGE(PG8_SB(1, 1), cB + hsB + kstep, voffB);
    PG8_WAIT_V(6); PG8_BAR;
    for (;;) {
        const bool has_next = S.next(ui + 1, nxt);
        if (g.lat && has_next) nxt.pm += (nxt.pm >> 4) + 1;
        const char* nA = has_next ? (const char*)g.A + (size_t)nxt.pm * tsA : cA; const char* nB = has_next ? (const char*)g.Bt + (size_t)nxt.pn * tsB : cB;
        for (int t = 0; t < nt; t += 2) {
            const bool last = (t == nt - 2);
            const char* a1 = cA + (size_t)(t + 1) * kstep;
            const char* a2 = last ? nA : cA + (size_t)(t + 2) * kstep; const char* b2 = last ? nB : cB + (size_t)(t + 2) * kstep;
            const char* a3 = a2 + kstep; const char* b3 = b2 + kstep;
            PG8_LDB(B0, 0, 0); PG8_SCHED; PG8_LDA(At, 0, 0); PG8_STAGE(PG8_SA(1, 1), a1 + hsA, voffA);
            PG8_WAIT_L(8); PG8_BAR; PG8_WAIT_L(0); PG8_MMA(0, 0, At, B0); PG8_BAR; PG8_SCHED;
            PG8_LDB(B1, 0, 1); PG8_STAGE(PG8_SB(0, 0), b2, voffB);
            PG8_BAR; PG8_WAIT_L(0); PG8_MMA(0, 1, At, B1); PG8_BAR;
            PG8_LDA(At, 0, 1); PG8_STAGE(PG8_SA(0, 0), a2, voffA);
            PG8_BAR; PG8_WAIT_L(0); PG8_MMA(1, 0, At, B0); PG8_BAR; PG8_SCHED;
            PG8_STAGE(PG8_SB(0, 1), b2 + hsB, voffB);
            PG8_WAIT_V(6); PG8_BAR; PG8_MMA(1, 1, At, B1); PG8_BAR;
            PG8_LDB(B0, 1, 0); PG8_SCHED; PG8_LDA(At, 1, 0); PG8_STAGE(PG8_SA(0, 1), a2 + hsA, voffA);
            PG8_WAIT_L(8); PG8_BAR; PG8_WAIT_L(0); PG8_MMA(0, 0, At, B0); PG8_BAR; PG8_SCHED;
            PG8_LDB(B1, 1, 1); PG8_STAGE(PG8_SB(1, 0), b3, voffB);
            PG8_BAR; PG8_WAIT_L(0); PG8_MMA(0, 1, At, B1); PG8_BAR;
            PG8_LDA(At, 1, 1); PG8_STAGE(PG8_SA(1, 0), a3, voffA);
            PG8_BAR; PG8_WAIT_L(0); PG8_MMA(1, 0, At, B0); PG8_BAR; PG8_SCHED;
            PG8_STAGE(PG8_SB(1, 1), b3 + hsB, voffB);
            PG8_WAIT_V(6); PG8_BAR; PG8_MMA(1, 1, At, B1); PG8_BAR;
        }
        E(acc, cur, wr, wc, fr, fq);
        if (!has_next) break;
#pragma unroll
        for (int a = 0; a < 2; ++a)
#pragma unroll
            for (int b = 0; b < 2; ++b)
#pragma unroll
                for (int m = 0; m < 4; ++m)
#pragma unroll
                    for (int n = 0; n < 2; ++n) acc[a][b][m][n] = (f32x4){0.f, 0.f, 0.f, 0.f};
        cur = nxt; cA = nA; cB = nB; ++ui;
    }
    PG8_WAIT_V(0);
    if (wr == 0) PG8_BAR;
    PG8_BAR;
#undef PG8_SA
#undef PG8_SB
#undef PG8_STAGE
#undef PG8_LDA
#undef PG8_LDB
#undef PG8_MMA
#undef PG8_WAIT_V
#undef PG8_WAIT_L
#undef PG8_BAR
#undef PG8_SCHED
}
}

#define EPI_ROWS_COLS_PERM \
    const int row0 = u.pm * 256 + wr * 64 + fr; const int col0 = u.pn * 256 + wc * 32 + 8 * fq;
struct EpiBf16Plain {
    static constexpr bool PERM = true;
    bf16_t* O; int ldc;
    __device__ __forceinline__ void operator()(const f32x4 (&acc)[2][2][4][2], const pg8::Unit& u, int wr, int wc, int fr, int fq) const {
        EPI_ROWS_COLS_PERM
#pragma unroll
        for (int ai = 0; ai < 2; ++ai)
#pragma unroll
            for (int m = 0; m < 4; ++m) { bf16_t* rowp = O + (size_t)(row0 + ai * 128 + m * 16) * ldc + col0;
#pragma unroll
                for (int bj = 0; bj < 2; ++bj) { const f32x4 v0 = acc[ai][bj][m][0], v1 = acc[ai][bj][m][1];
                    u32x4 w; w.x = pk2(v0[0], v0[1]); w.y = pk2(v0[2], v0[3]); w.z = pk2(v1[0], v1[1]); w.w = pk2(v1[2], v1[3]);
                    *(u32x4*)(rowp + bj * 128) = w; } }
    }
};
struct EpiBf16RowScale {
    static constexpr bool PERM = true;
    bf16_t* O; int ldc; const float* rs;
    __device__ __forceinline__ void operator()(const f32x4 (&acc)[2][2][4][2], const pg8::Unit& u, int wr, int wc, int fr, int fq) const {
        EPI_ROWS_COLS_PERM
#pragma unroll
        for (int ai = 0; ai < 2; ++ai)
#pragma unroll
            for (int m = 0; m < 4; ++m) { const int row = row0 + ai * 128 + m * 16; const float s = rs[row]; bf16_t* rowp = O + (size_t)row * ldc + col0;
#pragma unroll
                for (int bj = 0; bj < 2; ++bj) { const f32x4 v0 = acc[ai][bj][m][0] * s, v1 = acc[ai][bj][m][1] * s;
                    u32x4 w; w.x = pk2(v0[0], v0[1]); w.y = pk2(v0[2], v0[3]); w.z = pk2(v1[0], v1[1]); w.w = pk2(v1[2], v1[3]);
                    *(u32x4*)(rowp + bj * 128) = w; } }
    }
};
struct EpiRelu2 {
    static constexpr bool PERM = true;
    bf16_t* O; int ldc;
    __device__ __forceinline__ void operator()(const f32x4 (&acc)[2][2][4][2], const pg8::Unit& u, int wr, int wc, int fr, int fq) const {
        EPI_ROWS_COLS_PERM
#pragma unroll
        for (int ai = 0; ai < 2; ++ai)
#pragma unroll
            for (int m = 0; m < 4; ++m) { bf16_t* rowp = O + (size_t)(row0 + ai * 128 + m * 16) * ldc + col0;
#pragma unroll
                for (int bj = 0; bj < 2; ++bj) { f32x4 v0 = acc[ai][bj][m][0], v1 = acc[ai][bj][m][1];
#pragma unroll
                    for (int j = 0; j < 4; ++j) { const float a = fmaxf(v0[j], 0.f), b = fmaxf(v1[j], 0.f); v0[j] = a * a; v1[j] = b * b; }
                    u32x4 w; w.x = pk2(v0[0], v0[1]); w.y = pk2(v0[2], v0[3]); w.z = pk2(v1[0], v1[1]); w.w = pk2(v1[2], v1[3]);
                    *(u32x4*)(rowp + bj * 128) = w; } }
    }
};
struct EpiResid {
    static constexpr bool PERM = false;
    float* XS; const float* gate; float scale;
    __device__ __forceinline__ void operator()(const f32x4 (&acc)[2][2][4][2], const pg8::Unit& u, int wr, int wc, int fr, int fq) const {
        const int row0 = u.pm * 256 + wr * 64 + fr, col0 = u.pn * 256 + wc * 32 + 4 * fq;
        const int cond = (u.pm % 17 == 0) ? 2 : (u.pm / 17);
        const float* gp = gate + (size_t)cond * MODW + col0;
        f32x4 gv[2][2];
#pragma unroll
        for (int bj = 0; bj < 2; ++bj)
#pragma unroll
            for (int n = 0; n < 2; ++n) gv[bj][n] = *(const f32x4*)(gp + bj * 128 + n * 16) * scale;
#pragma unroll
        for (int ai = 0; ai < 2; ++ai)
#pragma unroll
            for (int m = 0; m < 4; ++m) { float* rowp = XS + (size_t)(row0 + ai * 128 + m * 16) * DM + col0;
#pragma unroll
                for (int bj = 0; bj < 2; ++bj)
#pragma unroll
                    for (int n = 0; n < 2; ++n) { f32x4* p = (f32x4*)(rowp + bj * 128 + n * 16); *p = *p + gv[bj][n] * acc[ai][bj][m][n]; } }
    }
};
struct EpiHG {
    static constexpr bool PERM = true;
    bf16_t* QVG; f16_t* LOGF; const float* lb;
    __device__ __forceinline__ void operator()(const f32x4 (&acc)[2][2][4][2], const pg8::Unit& u, int wr, int wc, int fr, int fq) const {
        const int row0 = u.pm * 256 + wr * 64 + fr; const int seg = u.pn >> 3; const int col0 = (u.pn & 7) * 256 + wc * 32 + 8 * fq;
        if (seg == 1 || seg == 2) {
            f16_t* base = LOGF + (size_t)(seg - 1) * MROWS * DM;
            f32x4 lbv[2][2];
#pragma unroll
            for (int bj = 0; bj < 2; ++bj)
#pragma unroll
                for (int n = 0; n < 2; ++n) lbv[bj][n] = *(const f32x4*)(lb + col0 + bj * 128 + 4 * n);
#pragma unroll
            for (int ai = 0; ai < 2; ++ai)
#pragma unroll
                for (int m = 0; m < 4; ++m) { f16_t* rowp = base + (size_t)(row0 + ai * 128 + m * 16) * DM + col0;
#pragma unroll
                    for (int bj = 0; bj < 2; ++bj) { f16x8 o;
#pragma unroll
                        for (int n = 0; n < 2; ++n) { const f32x4 v = acc[ai][bj][m][n];
#pragma unroll
                            for (int j = 0; j < 4; ++j) { const float l = lbv[bj][n][j]; o[4 * n + j] = (f16_t)__logf(l + (1.0f - l) * fsigmoid(v[j])); } }
                        *(f16x8*)(rowp + bj * 128) = o; } }
        } else {
            const int bi = seg - 2 + (seg == 0 ? 2 : 0);
            bf16_t* base = QVG + (size_t)bi * MROWS * DM;
            const bool act = (seg != 3);
#pragma unroll
            for (int ai = 0; ai < 2; ++ai)
#pragma unroll
                for (int m = 0; m < 4; ++m) { bf16_t* rowp = base + (size_t)(row0 + ai * 128 + m * 16) * DM + col0;
#pragma unroll
                    for (int bj = 0; bj < 2; ++bj) { f32x4 v0 = acc[ai][bj][m][0], v1 = acc[ai][bj][m][1];
                        if (act) {
#pragma unroll
                            for (int j = 0; j < 4; ++j) { v0[j] = v0[j] * fsigmoid(v0[j]); v1[j] = v1[j] * fsigmoid(v1[j]); } }
                        u32x4 w; w.x = pk2(v0[0], v0[1]); w.y = pk2(v0[2], v0[3]); w.z = pk2(v1[0], v1[1]); w.w = pk2(v1[2], v1[3]);
                        *(u32x4*)(rowp + bj * 128) = w; } }
        }
    }
};


namespace sg {
struct SGemm { const bf16_t* A; const bf16_t* Bt; int N, K, lda, ldb; };
__device__ __forceinline__ unsigned red_off(int w, int row, int col) { return (unsigned)((((w * 64 + row) * 16) + ((col >> 2) ^ (row & 15))) * 16); }
template <class Epi>
__device__ __forceinline__ void sgemm_phase(LAS unsigned char* lds, int tid, const SGemm& g, int nbig, const Epi& E) {
    const int G = gridDim.x, c = blockIdx.x, nsm = 8 * (g.N >> 6), r = nbig % G;
    int start, stride;
    if (r == 0) { start = (G % 8 == 0) ? (c % 8) * (G / 8) + c / 8 : c; stride = G; }
    else { start = c - r; stride = G - r; if (c < r) start = nsm; }
    const int w = __builtin_amdgcn_readfirstlane(tid >> 6), lane = tid & 63, fr = lane & 15, fq = lane >> 4;
    const int kw = g.K >> 3, nk2 = kw >> 6;
    bf16x8 xa[4][2], xb[4][2], ya[4][2], yb[4][2];
    const int voA = (fr * g.lda + w * kw + 16 * fq) * 2, voB = (fr * g.ldb + w * kw + 16 * fq) * 2;
    const int sAb = 16 * g.lda * 2, sBb = 16 * g.ldb * 2;
    __amdgpu_buffer_rsrc_t rA, rB;
#define SG_PTRS(su) do { const int mt_ = (su) & 7, nt_ = (su) >> 3; \
        rA = __builtin_amdgcn_make_buffer_rsrc((void*)(g.A + ((size_t)(mt_ >> 2) * SROW + (mt_ & 3) * 64) * g.lda), 0, 64 * g.lda * 2, 0x00020000); \
        rB = __builtin_amdgcn_make_buffer_rsrc((void*)(g.Bt + (size_t)nt_ * 64 * g.ldb), 0, 64 * g.ldb * 2, 0x00020000); } while (0)
#define SG_LD1(r, vo, so) __builtin_bit_cast(bf16x8, __builtin_amdgcn_raw_buffer_load_b128(r, vo, so, 0))
#define SG_LOAD(a, b, k2) do { _Pragma("unroll") for (int i = 0; i < 4; ++i) { a[i][0] = SG_LD1(rA, voA, i * sAb + (k2) * 128); a[i][1] = SG_LD1(rA, voA, i * sAb + (k2) * 128 + 16); \
        b[i][0] = SG_LD1(rB, voB, i * sBb + (k2) * 128); b[i][1] = SG_LD1(rB, voB, i * sBb + (k2) * 128 + 16); } } while (0)
#define SG_MMA(a, b) do { _Pragma("unroll") for (int hh = 0; hh < 2; ++hh) _Pragma("unroll") for (int m = 0; m < 4; ++m) _Pragma("unroll") for (int n = 0; n < 4; ++n) \
        acc[m][n] = __builtin_amdgcn_mfma_f32_16x16x32_bf16(b[n][hh], a[m][hh], acc[m][n], 0, 0, 0); } while (0)
#define SG_SB __builtin_amdgcn_sched_barrier(0)
    if (start < nsm) { SG_PTRS(start); SG_LOAD(xa, xb, 0); }
    for (int su = start; su < nsm; su += stride) {
        f32x4 acc[4][4];
#pragma unroll
        for (int m = 0; m < 4; ++m)
#pragma unroll
            for (int n = 0; n < 4; ++n) acc[m][n] = (f32x4){0.f, 0.f, 0.f, 0.f};
        if (nk2 > 1) SG_LOAD(ya, yb, 1);
        SG_SB;
        for (int k2 = 0; k2 < nk2; k2 += 2) {
            SG_MMA(xa, xb); SG_SB; if (k2 + 2 < nk2) SG_LOAD(xa, xb, k2 + 2); SG_SB;
            if (k2 + 1 < nk2) { SG_MMA(ya, yb); SG_SB; if (k2 + 3 < nk2) SG_LOAD(ya, yb, k2 + 3); SG_SB; }
        }
        if (su + stride < nsm) { SG_PTRS(su + stride); SG_LOAD(xa, xb, 0); }
        SG_SB;
        __syncthreads();
#pragma unroll
        for (int m = 0; m < 4; ++m)
#pragma unroll
            for (int n = 0; n < 4; ++n) *(LAS f32x4*)(lds + red_off(w, 16 * m + fr, 16 * n + 4 * fq)) = acc[m][n];
        __syncthreads();
        const int row = tid >> 3, c8 = (tid & 7) * 8;
        f32x4 s0 = {0.f, 0.f, 0.f, 0.f}, s1 = {0.f, 0.f, 0.f, 0.f};
#pragma unroll
        for (int ww = 0; ww < 8; ++ww) { s0 += *(const LAS f32x4*)(lds + red_off(ww, row, c8)); s1 += *(const LAS f32x4*)(lds + red_off(ww, row, c8 + 4)); }
        float v[8] = {s0.x, s0.y, s0.z, s0.w, s1.x, s1.y, s1.z, s1.w};
        const int mt = su & 7, nt = su >> 3;
        E((size_t)(mt >> 2) * SROW + (mt & 3) * 64 + row, nt * 64 + c8, v);
    }
#undef SG_SB
#undef SG_LOAD
#undef SG_MMA
#undef SG_PTRS
#undef SG_LD1
    __syncthreads();
}
}
__device__ __forceinline__ void st_bf16x8(bf16_t* p, const float (&v)[8]) { u32x4 w; w.x = pk2(v[0], v[1]); w.y = pk2(v[2], v[3]); w.z = pk2(v[4], v[5]); w.w = pk2(v[6], v[7]); *(u32x4*)p = w; }
struct SEpiPlain { bf16_t* O; int ldc;
    __device__ __forceinline__ void operator()(size_t R, int col, const float (&v)[8]) const { st_bf16x8(O + R * ldc + col, v); } };
struct SEpiRowScale { bf16_t* O; int ldc; const float* rs;
    __device__ __forceinline__ void operator()(size_t R, int col, const float (&v)[8]) const { const float s = rs[R]; float o[8];
#pragma unroll
        for (int j = 0; j < 8; ++j) o[j] = v[j] * s;
        st_bf16x8(O + R * ldc + col, o); } };
struct SEpiRelu2 { bf16_t* O; int ldc;
    __device__ __forceinline__ void operator()(size_t R, int col, const float (&v)[8]) const { float o[8];
#pragma unroll
        for (int j = 0; j < 8; ++j) { const float a = fmaxf(v[j], 0.f); o[j] = a * a; }
        st_bf16x8(O + R * ldc + col, o); } };
struct SEpiResid { float* XS; const float* gate; float scale;
    __device__ __forceinline__ void operator()(size_t R, int col, const float (&v)[8]) const { const float* gp = gate + (size_t)2 * MODW + col; float* xp = XS + R * DM + col;
        const f32x4 g0 = *(const f32x4*)gp * scale, g1 = *(const f32x4*)(gp + 4) * scale; f32x4 x0 = *(f32x4*)xp, x1 = *(f32x4*)(xp + 4);
        x0 += g0 * (f32x4){v[0], v[1], v[2], v[3]}; x1 += g1 * (f32x4){v[4], v[5], v[6], v[7]}; *(f32x4*)xp = x0; *(f32x4*)(xp + 4) = x1; } };
struct SEpiHG { bf16_t* QVG; f16_t* LOGF; const float* lb;
    __device__ __forceinline__ void operator()(size_t R, int col, const float (&v)[8]) const { const int seg = col >> 11, cs = col & 2047;
        if (seg == 1 || seg == 2) { f16_t* p = LOGF + (size_t)(seg - 1) * MROWS * DM + R * DM + cs; f16x8 o;
#pragma unroll
            for (int j = 0; j < 8; ++j) { const float l0 = lb[cs + j]; o[j] = (f16_t)__logf(l0 + (1.0f - l0) * fsigmoid(v[j])); }
            *(f16x8*)p = o; }
        else { const int bi = seg - 2 + (seg == 0 ? 2 : 0); float o[8];
#pragma unroll
            for (int j = 0; j < 8; ++j) o[j] = seg == 3 ? v[j] : v[j] * fsigmoid(v[j]);
            st_bf16x8(QVG + (size_t)bi * MROWS * DM + R * DM + cs, o); } } };

namespace att {
using s16x4  = __attribute__((ext_vector_type(4))) short;
using f32x16 = __attribute__((ext_vector_type(16))) float;
constexpr int NW = 8, QBLK = 32, KVBLK = 64;
constexpr float SCALE = ATTN_SCALE;
constexpr float THR = 8.f;
constexpr int SHM_V = KVBLK * 128 * 2, SHM_K = KVBLK * 128 * 2, SHM_KR = KVBLK * 64 * 2;
constexpr int OFF_V = 0, OFF_K = 2 * SHM_V, OFF_KR = OFF_K + 2 * SHM_K, OFF_WS = OFF_KR + 2 * SHM_KR, SHM_ATTN = OFF_WS + NW * 64 * 4;
constexpr int LDQ = QW, LDK = KVW, LDO = DM;
#define KSWZ(row, colB) ((row) * 256 + ((colB) ^ (((row) & 7) << 4)))
#define RSWZ(row, colB) ((row) * 128 + ((colB) ^ ((((row) >> 1) & 7) << 4)))
#define SBAR() __builtin_amdgcn_sched_barrier(0)
__device__ __forceinline__ int crow(int r, int hi) { return (r & 3) + 8 * (r >> 2) + 4 * hi; }
__device__ __forceinline__ unsigned cvtpk(float lo, float hi) { unsigned r; asm volatile("v_cvt_pk_bf16_f32 %0, %1, %2" : "=v"(r) : "v"(lo), "v"(hi)); return r; }
__device__ __forceinline__ bf16x8 ld8(const bf16_t* p) { return *reinterpret_cast<const bf16x8*>(p); }
__device__ __forceinline__ void partialSM(f32x16& p0, f32x16& p1, float& m_reg, float& mn, float& alpha) {
  constexpr float C = SCALE * 1.4426950408889634f;
  float pmax = p0[0];
#pragma unroll
  for (int r = 1; r < 16; ++r) pmax = fmaxf(pmax, p0[r]);
#pragma unroll
  for (int r = 0; r < 16; ++r) pmax = fmaxf(pmax, p1[r]);
  { auto rr = __builtin_amdgcn_permlane32_swap(__float_as_uint(pmax), __float_as_uint(pmax), false, false);
    pmax = fmaxf(__uint_as_float(rr[0]), __uint_as_float(rr[1])); }
  if (__builtin_expect(__all(pmax - m_reg <= THR / SCALE), 1)) { mn = m_reg; alpha = 1.f; }
  else { mn = fmaxf(m_reg, pmax); alpha = __builtin_amdgcn_exp2f((m_reg - mn) * C); m_reg = mn; }
  float mnC = -mn * C;
#pragma unroll
  for (int r = 0; r < 16; ++r) p0[r] = fmaf(p0[r], C, mnC);
#pragma unroll
  for (int r = 0; r < 16; ++r) p1[r] = fmaf(p1[r], C, mnC);
#pragma unroll
  for (int r = 0; r < 16; ++r) p0[r] = __builtin_amdgcn_exp2f(p0[r]);
}
__device__ __forceinline__ void finishSM(f32x16& p0, f32x16& p1, float alpha, float& l_reg, bf16x8& pa0, bf16x8& pa1, bf16x8& pa2, bf16x8& pa3) {
#pragma unroll
  for (int r = 0; r < 16; ++r) p1[r] = __builtin_amdgcn_exp2f(p1[r]);
  float ps = 0;
#pragma unroll
  for (int r = 0; r < 16; ++r) ps += p0[r];
#pragma unroll
  for (int r = 0; r < 16; ++r) ps += p1[r];
  { auto rr = __builtin_amdgcn_permlane32_swap(__float_as_uint(ps), __float_as_uint(ps), false, false);
    ps = __uint_as_float(rr[0]) + __uint_as_float(rr[1]); }
  l_reg = l_reg * alpha + ps;
#define PK4(P, BASE, OUT) do { unsigned a0 = cvtpk(P[BASE + 0], P[BASE + 1]), a1 = cvtpk(P[BASE + 2], P[BASE + 3]);   \
    unsigned b0 = cvtpk(P[BASE + 4], P[BASE + 5]), b1 = cvtpk(P[BASE + 6], P[BASE + 7]);                              \
    auto r0 = __builtin_amdgcn_permlane32_swap(a0, b0, false, false); auto r1 = __builtin_amdgcn_permlane32_swap(a1, b1, false, false); \
    u32x4 w = {r0[0], r1[0], r0[1], r1[1]}; OUT = *reinterpret_cast<bf16x8*>(&w); } while (0)
  PK4(p0, 0, pa0); PK4(p0, 8, pa1); PK4(p1, 0, pa2); PK4(p1, 8, pa3);
#undef PK4
}
__device__ __forceinline__ void qkt(f32x16& p0, f32x16& p1, const char* Ks, const char* Krs, const bf16x8* qr, int r32, int hi) {
  p0 = f32x16{}; p1 = f32x16{};
#pragma unroll
  for (int d0 = 0; d0 < 8; ++d0) { int cb = (d0 * 16 + hi * 8) * 2;
    bf16x8 b0 = *reinterpret_cast<const bf16x8*>(Ks + KSWZ(r32, cb));
    bf16x8 b1 = *reinterpret_cast<const bf16x8*>(Ks + KSWZ(32 + r32, cb));
    p0 = __builtin_amdgcn_mfma_f32_32x32x16_bf16(b0, qr[d0], p0, 0, 0, 0);
    p1 = __builtin_amdgcn_mfma_f32_32x32x16_bf16(b1, qr[d0], p1, 0, 0, 0); }
#pragma unroll
  for (int d0 = 0; d0 < 4; ++d0) { int cb = (d0 * 16 + hi * 8) * 2;
    bf16x8 b0 = *reinterpret_cast<const bf16x8*>(Krs + RSWZ(r32, cb));
    bf16x8 b1 = *reinterpret_cast<const bf16x8*>(Krs + RSWZ(32 + r32, cb));
    p0 = __builtin_amdgcn_mfma_f32_32x32x16_bf16(b0, qr[8 + d0], p0, 0, 0, 0);
    p1 = __builtin_amdgcn_mfma_f32_32x32x16_bf16(b1, qr[8 + d0], p1, 0, 0, 0); }
}
__device__ __forceinline__ int v_st(int k, int c) { const int kk = (k & ~0xC) | ((k & 4) << 1) | ((k & 8) >> 1); return ((kk >> 3) * 4 + (c >> 5)) * 512 + ((kk & 7) * 32 + (c & 31)) * 2; }
__device__ __forceinline__ int v_rd_base(int lane) { return ((lane & 3) << 3) | (((lane >> 2) & 3) << 6) | (((lane >> 4) & 1) << 5) | (((lane >> 5) & 1) << 8); }
constexpr int v_rd_off(int d0, int ks, int half) { return d0 * 512 + ks * 4096 + half * 2048; }
template <int OFF> __device__ __forceinline__ s16x4 tr_read(int vb) {
  s16x4 r; asm volatile("ds_read_b64_tr_b16 %0, %1 offset:%2" : "=&v"(r) : "v"(vb), "i"(OFF) : "memory"); return r;
}
template <int D0> __device__ __forceinline__ void pv_one(f32x16& od, int vb, bf16x8 pa0, bf16x8 pa1, bf16x8 pa2, bf16x8 pa3) {
  const s16x4 l0 = tr_read<v_rd_off(D0, 0, 0)>(vb), h0 = tr_read<v_rd_off(D0, 0, 1)>(vb), l1 = tr_read<v_rd_off(D0, 1, 0)>(vb), h1 = tr_read<v_rd_off(D0, 1, 1)>(vb);
  const s16x4 l2 = tr_read<v_rd_off(D0, 2, 0)>(vb), h2 = tr_read<v_rd_off(D0, 2, 1)>(vb), l3 = tr_read<v_rd_off(D0, 3, 0)>(vb), h3 = tr_read<v_rd_off(D0, 3, 1)>(vb);
  asm volatile("s_waitcnt lgkmcnt(0)" ::: "memory"); SBAR();
#define PK(L, H) (bf16x8){L[0], L[1], L[2], L[3], H[0], H[1], H[2], H[3]}
  od = __builtin_amdgcn_mfma_f32_32x32x16_bf16(pa0, PK(l0, h0), od, 0, 0, 0);
  od = __builtin_amdgcn_mfma_f32_32x32x16_bf16(pa1, PK(l1, h1), od, 0, 0, 0);
  od = __builtin_amdgcn_mfma_f32_32x32x16_bf16(pa2, PK(l2, h2), od, 0, 0, 0);
  od = __builtin_amdgcn_mfma_f32_32x32x16_bf16(pa3, PK(l3, h3), od, 0, 0, 0);
#undef PK
}
__device__ __forceinline__ void pv_d0(f32x16* o, int vb, bf16x8 pa0, bf16x8 pa1, bf16x8 pa2, bf16x8 pa3) {
  pv_one<0>(o[0], vb, pa0, pa1, pa2, pa3); pv_one<1>(o[1], vb, pa0, pa1, pa2, pa3); pv_one<2>(o[2], vb, pa0, pa1, pa2, pa3); pv_one<3>(o[3], vb, pa0, pa1, pa2, pa3);
}
__device__ __forceinline__ void attn_body(const bf16_t* __restrict__ Qb, const bf16_t* __restrict__ Kh, const bf16_t* __restrict__ KRb,
                                          bf16_t* __restrict__ Ob, int seq, int tq0, const float* __restrict__ RC, const float* __restrict__ RS, char* lds, int tid) {
  const bf16_t* Vh = Kh + 128;
  const int wid = tid >> 6, lane = tid & 63, r32 = lane & 31, hi = lane >> 5;
  char* V_lds = lds + OFF_V; char* K_lds = lds + OFF_K; char* KR_lds = lds + OFF_KR;
  float* ws = (float*)(lds + OFF_WS) + wid * 64; float* li_l = ws; float* al_l = ws + 32;
  float m_reg = -1e30f, l_reg = 0; f32x16 o[4] = {}; bf16x8 qr[12];
  const bf16_t* Qw = Qb + (long)(wid * QBLK + r32) * LDQ + hi * 8;
#pragma unroll
  for (int d0 = 0; d0 < 12; ++d0) qr[d0] = ld8(Qw + d0 * 16);
  if (tq0 >= 0) {
    const int t = tq0 + wid * QBLK + r32; const int pr = (t >> 6) * 16 + hi * 8, pc = (t & 63) * 16 + hi * 8;
#pragma unroll
    for (int j = 0; j < 8; ++j) {
      { const float c = RC[pr + j], sn = RS[pr + j]; const float x0 = bf2f((bf16_t)qr[8][j]), x1 = bf2f((bf16_t)qr[9][j]);
        qr[8][j] = (short)f2bf(x0 * c - x1 * sn); qr[9][j] = (short)f2bf(x1 * c + x0 * sn); }
      { const float c = RC[pc + j], sn = RS[pc + j]; const float x0 = bf2f((bf16_t)qr[10][j]), x1 = bf2f((bf16_t)qr[11][j]);
        qr[10][j] = (short)f2bf(x0 * c - x1 * sn); qr[11][j] = (short)f2bf(x1 * c + x0 * sn); }
    }
  }
  const int sr = tid >> 4, sc = (tid & 15) * 8, vst0 = v_st(sr, sc), vst1 = v_st(32 + sr, sc);
  const int rr = tid >> 3, rc = (tid & 7) * 8;
  const int vb0 = (int)(uintptr_t)V_lds + v_rd_base(lane);
  bf16x8 vs0, vs1, ks0, ks1, krs;
#define SLOAD(k0) do { vs0 = ld8(&Vh[(long)((k0) + sr) * LDK + sc]); vs1 = ld8(&Vh[(long)((k0) + 32 + sr) * LDK + sc]); \
    ks0 = ld8(&Kh[(long)((k0) + sr) * LDK + sc]); ks1 = ld8(&Kh[(long)((k0) + 32 + sr) * LDK + sc]); krs = ld8(&KRb[(long)((k0) + rr) * 64 + rc]); } while (0)
#define SWRITE(b) do { *(bf16x8*)(V_lds + (b) * SHM_V + vst0) = vs0; *(bf16x8*)(V_lds + (b) * SHM_V + vst1) = vs1; int kc = sc * 2;   \
    *(bf16x8*)(K_lds + (b) * SHM_K + KSWZ(sr, kc)) = ks0; *(bf16x8*)(K_lds + (b) * SHM_K + KSWZ(32 + sr, kc)) = ks1;                    \
    *(bf16x8*)(KR_lds + (b) * SHM_KR + RSWZ(rr, rc * 2)) = krs; } while (0)
#define SWAIT() asm volatile("s_waitcnt vmcnt(0)" ::: "memory")
#define RESC(a) do { if (__any((a) < 1.f)) { if (hi == 0) al_l[r32] = (a); asm volatile("s_waitcnt lgkmcnt(0)" ::: "memory"); \
    _Pragma("unroll") for (int d = 0; d < 4; ++d) _Pragma("unroll") for (int r = 0; r < 16; ++r) o[d][r] *= al_l[crow(r, hi)]; } } while (0)
  f32x16 p0, p1; float mn, al; bf16x8 pa0, pa1, pa2, pa3; const int NT = seq / KVBLK;
  SLOAD(0); SWAIT(); SWRITE(0); __syncthreads();
  SLOAD(KVBLK);
  for (int j = 0; j < NT; ++j) {
    const int buf = j & 1;
    SBAR(); qkt(p0, p1, K_lds + buf * SHM_K, KR_lds + buf * SHM_KR, qr, r32, hi);
    partialSM(p0, p1, m_reg, mn, al); RESC(al);
    finishSM(p0, p1, al, l_reg, pa0, pa1, pa2, pa3); SBAR();
    if (j + 1 < NT) { SWAIT(); SWRITE(buf ^ 1); }
    if (j + 2 < NT) SLOAD((j + 2) * KVBLK);
    SBAR();
    pv_d0(o, vb0 + buf * SHM_V, pa0, pa1, pa2, pa3);
    __syncthreads();
  }
  if (hi == 0) li_l[r32] = l_reg; asm volatile("s_waitcnt lgkmcnt(0)" ::: "memory");
  float rli[16];
#pragma unroll
  for (int r = 0; r < 16; ++r) rli[r] = __builtin_amdgcn_rcpf(li_l[crow(r, hi)]);
  bf16_t* Ow = Ob + (long)(wid * QBLK) * LDO;
#pragma unroll
  for (int r = 0; r < 16; ++r) { int orow = crow(r, hi);
#pragma unroll
    for (int d0 = 0; d0 < 4; ++d0) Ow[(long)orow * LDO + d0 * 32 + r32] = (bf16_t)f2bf(o[d0][r] * rli[r]); }
#undef SLOAD
#undef SWRITE
#undef SWAIT
#undef RESC
}
}

typedef const float* cfp_t;
typedef const __attribute__((address_space(4))) cfp_t* InPtr;
struct Ctx {
    LAS unsigned char* lds; int tid, lane, wave, gw, ngw, gtid, ngt;
    InPtr in; float* out; unsigned char* ws;
    __device__ __forceinline__ const float* inp(int i) const { return (const float*)(const GAS float*)in[i]; }
};
#define WSP(T, off) ((T*)(C.ws + (off)))

__device__ __forceinline__ void tr_item(const float* W, int K, int N, bf16_t* WT, const float* sck, LAS float* scr, int item, int lane) {
    const int nblk = N / 64, kb = item / nblk, nb = item % nblk, k0 = 64 * kb, n0 = 64 * nb;
    f32x4 v[16];
#pragma unroll
    for (int i = 0; i < 16; ++i) v[i] = *(const f32x4*)(W + (size_t)(k0 + 4 * i + (lane >> 4)) * N + n0 + 4 * (lane & 15));
#pragma unroll
    for (int i = 0; i < 16; ++i) { const int kk = 4 * i + (lane >> 4); f32x4 x = v[i]; if (sck) x *= sck[k0 + kk]; LAS float* d = scr + kk * 65 + 4 * (lane & 15); d[0] = x.x; d[1] = x.y; d[2] = x.z; d[3] = x.w; }
    asm volatile("s_waitcnt lgkmcnt(0)" ::: "memory"); __builtin_amdgcn_wave_barrier();
    const int nl = lane & 7, kc = lane >> 3;
#pragma unroll
    for (int j = 0; j < 8; ++j) { const int n = 8 * j + nl; const LAS float* sp = scr + (8 * kc) * 65 + n;
        u32x4 o; o.x = pk2(sp[0 * 65], sp[1 * 65]); o.y = pk2(sp[2 * 65], sp[3 * 65]); o.z = pk2(sp[4 * 65], sp[5 * 65]); o.w = pk2(sp[6 * 65], sp[7 * 65]);
        *(u32x4*)(WT + (size_t)(n0 + n) * K + k0 + 8 * kc) = o; }
    asm volatile("s_waitcnt lgkmcnt(0)" ::: "memory"); __builtin_amdgcn_wave_barrier();
}
__device__ __forceinline__ void tr_matrix(const Ctx& C, const float* W, int K, int N, bf16_t* WT, const float* sck) {
    LAS float* scr = (LAS float*)(C.lds + C.wave * 16640);
    const int cnt = (K / 64) * (N / 64);
    for (int it = C.gw; it < cnt; it += C.ngw) tr_item(W, K, N, WT, sck, scr, it, C.lane);
}
__device__ __forceinline__ void sincos_d(double x, double& s, double& c) {
    const double twopi = 6.283185307179586476925286766559;
    const double k = __builtin_rint(x / twopi); const double y = x - k * twopi; const double y2 = y * y;
    double ts = y, ss = y, tc = 1.0, sc = 1.0;
#pragma unroll
    for (int n = 1; n <= 16; ++n) { tc *= -y2 / (double)((2 * n - 1) * (2 * n)); sc += tc; ts *= -y2 / (double)((2 * n) * (2 * n + 1)); ss += ts; }
    s = ss; c = sc;
}
__device__ __forceinline__ void phase_prologue(const Ctx& C) {
#pragma unroll 1
    for (int e = 0; e < 2; ++e) {
        tr_matrix(C, C.inp(8) + (size_t)e * DM * ABN, DM, ABN, WSP(bf16_t, WS_WABIN) + (size_t)e * ABNP * DM, nullptr);
        tr_matrix(C, C.inp(9) + (size_t)e * DM * DM, DM, DM, WSP(bf16_t, WS_WABOUT) + (size_t)e * DM * DM, nullptr);
        tr_matrix(C, C.inp(18) + (size_t)e * 512 * QW, 512, QW, WSP(bf16_t, WS_WUQ) + (size_t)e * QW * 512, C.inp(17) + e * 512);
        tr_matrix(C, C.inp(20) + (size_t)e * 512 * KVW, 512, KVW, WSP(bf16_t, WS_WUKV) + (size_t)e * KVW * 512, C.inp(19) + e * 512);
        tr_matrix(C, C.inp(21) + (size_t)e * DM * HGN, DM, HGN, WSP(bf16_t, WS_WHGIN) + (size_t)e * HGN * DM, nullptr);
        tr_matrix(C, C.inp(24) + (size_t)e * DM * DM, DM, DM, WSP(bf16_t, WS_WHGOUT) + (size_t)e * DM * DM, nullptr);
#pragma unroll 1
        for (int dg = 0; dg < 4; ++dg) { const int dir = dg >> 1, gate = dg & 1;
            tr_matrix(C, C.inp(gate ? 14 : 12) + ((size_t)e * 2 + dir) * 8 * 128 * 128, 1024, 128, WSP(bf16_t, WS_WG) + ((size_t)e * 4 + dg) * 128 * 1024, nullptr); }
    }
#pragma unroll 1
    for (int l = 0; l < 4; ++l) {
        tr_matrix(C, C.inp(25) + (size_t)l * DM * DFF, DM, DFF, WSP(bf16_t, WS_W1) + (size_t)l * DFF * DM, nullptr);
        tr_matrix(C, C.inp(26) + (size_t)l * DFF * DM, DFF, DM, WSP(bf16_t, WS_W2) + (size_t)l * DM * DFF, nullptr);
    }
    for (int e = 0; e < 2; ++e) { u32x4* z = (u32x4*)(WSP(bf16_t, WS_WABIN) + (size_t)e * ABNP * DM + (size_t)ABN * DM);
        for (int i = C.gtid; i < (ABNP - ABN) * DM / 8; i += C.ngt) z[i] = (u32x4){0u, 0u, 0u, 0u}; }
    { float* XS = WSP(float, WS_XS);
      for (int i = C.gtid; i < MROWS * (DM / 4); i += C.ngt) { const int R = i / (DM / 4), c4 = i % (DM / 4); const int b = R / SROW, s = R % SROW;
          const float* src = s < CTX ? C.inp(2) + ((size_t)(b * CTX + s)) * DM : C.inp(0) + ((size_t)(b * SEQ + (s - CTX))) * DM;
          ((f32x4*)(XS + (size_t)R * DM))[c4] = ((const f32x4*)src)[c4]; } }
    { float* LB = WSP(float, WS_LB);
      for (int i = C.gtid; i < 2048; i += C.ngt) { float v[4], mx = -1e30f; for (int l = 0; l < 4; ++l) { v[l] = C.inp(22)[l * 2048 + i]; mx = fmaxf(mx, v[l]); }
          float sum = 0.f; for (int l = 0; l < 4; ++l) { v[l] = expf(v[l] - mx); sum += v[l]; }
          float cum = 0.f; const float p0 = v[0] / sum; for (int l = 0; l < 4; ++l) { cum += v[l] / sum; LB[l * 2048 + i] = cum - p0; } }
      float* RC = WSP(float, WS_ROPE); float* RS = RC + 1024;
      for (int i = C.gtid; i < 1024; i += C.ngt) { const int pos = i / 16, j = i % 16; double inv = 1.0; for (int q = 0; q < j; ++q) inv *= 0.56234132519034908;
          const float ang = (float)pos * (float)inv; double s, c; sincos_d((double)ang, s, c); RC[i] = (float)c; RS[i] = (float)s; } }
    { LAS float* sl = (LAS float*)C.lds;
      LAS float* red = sl + 3 * 2048;
      __syncthreads();
      for (int i = C.tid; i < 3 * 2048; i += 512) { const int r = i / 2048, d = i % 2048; const float v = r < 2 ? C.inp(1)[r * 2048 + d] : C.inp(3)[d]; sl[i] = siluf_(v); }
      __syncthreads();
      float* MOD = WSP(float, WS_MOD);
      const int kq = C.tid >> 4, cq = C.tid & 15;
      for (int u = blockIdx.x; u < 4 * (MODW / 64); u += gridDim.x) { const int l = u / (MODW / 64), e0 = (u % (MODW / 64)) * 64;
          const float* w = C.inp(4) + (size_t)l * DM * MODW + e0 + 4 * cq;
          f32x4 a0 = {0, 0, 0, 0}, a1 = {0, 0, 0, 0}, a2 = {0, 0, 0, 0};
#pragma unroll 8
          for (int d = kq; d < DM; d += 32) { const f32x4 wv = *(const f32x4*)(w + (size_t)d * MODW); a0 += wv * sl[d]; a1 += wv * sl[2048 + d]; a2 += wv * sl[4096 + d]; }
#pragma unroll
          for (int j = 0; j < 4; ++j) { red[(kq * 3 + 0) * 64 + 4 * cq + j] = a0[j]; red[(kq * 3 + 1) * 64 + 4 * cq + j] = a1[j]; red[(kq * 3 + 2) * 64 + 4 * cq + j] = a2[j]; }
          __syncthreads();
          if (C.tid < 192) { const int r = C.tid / 64, c = C.tid % 64; float s = 0.f; for (int q = 0; q < 32; ++q) s += red[(q * 3 + r) * 64 + c];
              MOD[((size_t)l * 3 + r) * MODW + e0 + c] = s + C.inp(5)[l * MODW + e0 + c]; }
          __syncthreads(); } }
}

__device__ __forceinline__ void phase_norm_mod(const Ctx& C, const float* w, const float* mod, int sh_idx, int sc_idx) {
    const float* XS = WSP(float, WS_XS); bf16_t* H = WSP(bf16_t, WS_H);
    for (int R = C.gw; R < MROWS; R += C.ngw) {
        const int s = R % SROW, b = R / SROW, cond = s < CTX ? 2 : b;
        const float* shift = mod + (size_t)cond * MODW + sh_idx * DM; const float* scale = mod + (size_t)cond * MODW + sc_idx * DM;
        const f32x4* xr = (const f32x4*)(XS + (size_t)R * DM) + C.lane;
        f32x4 v[8]; float ss = 0.f;
#pragma unroll
        for (int j = 0; j < 8; ++j) { v[j] = xr[64 * j]; ss += (v[j].x * v[j].x + v[j].y * v[j].y) + (v[j].z * v[j].z + v[j].w * v[j].w); }
        const float rstd = 1.0f / sqrtf(wave_sum(ss) * (1.0f / DM) + EPS);
        u32x2* o = (u32x2*)(H + (size_t)R * DM) + C.lane;
#pragma unroll
        for (int j = 0; j < 8; ++j) { const int c = (C.lane + 64 * j) * 4; const f32x4 wv = *(const f32x4*)(w + c), sc = *(const f32x4*)(scale + c), sh = *(const f32x4*)(shift + c);
            const f32x4 y = (v[j] * rstd * wv) * (1.0f + sc) + sh; u32x2 pk; pk.x = pk2(y.x, y.y); pk.y = pk2(y.z, y.w); o[64 * j] = pk; }
    }
}

__device__ __forceinline__ void phase_rs_kr(const Ctx& C) {
    const bf16_t* P = WSP(bf16_t, WS_P);
    float* RSQ = WSP(float, WS_RSQ); float* RSKV = WSP(float, WS_RSKV);
    for (int R = C.gw; R < MROWS; R += C.ngw) {
        const u32x4 a = *(const u32x4*)(P + (size_t)R * ABNP + 2048 + 8 * C.lane), b = *(const u32x4*)(P + (size_t)R * ABNP + 2560 + 8 * C.lane);
        float sa = 0.f, sb = 0.f;
#pragma unroll
        for (int j = 0; j < 4; ++j) { const float a0 = __uint_as_float(a[j] << 16), a1 = __uint_as_float(a[j] & 0xffff0000u), b0 = __uint_as_float(b[j] << 16), b1 = __uint_as_float(b[j] & 0xffff0000u);
            sa += a0 * a0 + a1 * a1; sb += b0 * b0 + b1 * b1; }
        sa = wave_sum(sa); sb = wave_sum(sb);
        if (C.lane == 0) { RSQ[R] = 1.0f / sqrtf(sa * (1.0f / 512.0f) + EPS); RSKV[R] = 1.0f / sqrtf(sb * (1.0f / 512.0f) + EPS); } }
    bf16_t* KR = WSP(bf16_t, WS_KR); const float* RC = WSP(float, WS_ROPE); const float* RS = RC + 1024;
    for (int idx = C.gtid; idx < MROWS * 32; idx += C.ngt) { const int R = idx / 32, p = idx % 32, s = R % SROW; const int i0 = p < 16 ? p : 32 + (p - 16);
        const float x0 = bf2f(P[(size_t)R * ABNP + 3072 + i0]), x1 = bf2f(P[(size_t)R * ABNP + 3072 + i0 + 16]); float o0 = x0, o1 = x1;
        if (s >= CTX) { const int t = s - CTX, pos = p < 16 ? t / 64 : t % 64; const float c = RC[pos * 16 + (p & 15)], sn = RS[pos * 16 + (p & 15)]; o0 = x0 * c - x1 * sn; o1 = x1 * c + x0 * sn; }
        KR[(size_t)R * 64 + i0] = (bf16_t)f2bf(o0); KR[(size_t)R * 64 + i0 + 16] = (bf16_t)f2bf(o1); }
}

__device__ __forceinline__ void phase_attn(const Ctx& C) {
    const bf16_t* Q = WSP(bf16_t, WS_Q); const bf16_t* KV = WSP(bf16_t, WS_KV); const bf16_t* KR = WSP(bf16_t, WS_KR); bf16_t* Y = WSP(bf16_t, WS_Y);
    const float* RC = WSP(float, WS_ROPE); const float* RS = RC + 1024;
    const int G = gridDim.x, c = blockIdx.x;
    for (int u0 = c; u0 < 272; u0 += G) {
        int b, hh, s0, nk, tq0;
        if (u0 < 256) { int v = u0; if (G == 256) { const int x = c & 7, j = c >> 3; v = (x * 2 + (j >> 4)) * 16 + (j & 15); }
            const int p = v >> 4, qb = v & 15; b = p >> 3; hh = p & 7; s0 = CTX + qb * 256; nk = SROW; tq0 = qb * 256; }
        else { const int p = u0 - 256; b = p >> 3; hh = p & 7; s0 = 0; nk = CTX; tq0 = -1; }
        const size_t R0 = (size_t)b * SROW + s0, K0 = (size_t)b * SROW;
        __syncthreads();
        att::attn_body(Q + R0 * QW + hh * 192, KV + K0 * KVW + hh * 256, KR + K0 * 64, Y + R0 * DM + DLRU + hh * 128, nk, tq0, RC, RS, (char*)C.lds, C.tid);
    }
}
namespace hg {
using s16x4  = __attribute__((ext_vector_type(4))) short;
using f32x16 = __attribute__((ext_vector_type(16))) float;
constexpr int NCH = SROW / 64;
constexpr int NCHAIN = NBATCH * 16 * 2;
__device__ __forceinline__ unsigned off_b(unsigned row, unsigned ch) { return 256u * row + 16u * (ch ^ (((row & 3u) << 2) | ((row >> 2) & 3u))); }
__device__ __forceinline__ s16x4 trr(unsigned addr) { s16x4 r; asm volatile("ds_read_b64_tr_b16 %0, %1" : "=&v"(r) : "v"(addr) : "memory"); return r; }
__device__ __forceinline__ bf16x8 pk8(s16x4 L, s16x4 H) { return (bf16x8){L[0], L[1], L[2], L[3], H[0], H[1], H[2], H[3]}; }
__device__ __forceinline__ unsigned tr_nat(unsigned lane, unsigned c, unsigned ks, unsigned t) {
    const unsigned h = lane >> 5, blk = (lane >> 4) & 1, q = (lane & 15) >> 2, p = lane & 3;
    return off_b(16 * ks + 8 * h + 4 * t + q, 4 * c + 2 * blk + (p >> 1)) + 8 * (p & 1); }
__device__ __forceinline__ unsigned tr_perm(unsigned lane, unsigned c, unsigned rb, unsigned t) {
    const unsigned h = lane >> 5, blk = (lane >> 4) & 1, q = (lane & 15) >> 2, p = lane & 3;
    return off_b(rb + 4 * h + 8 * t + q, 4 * c + 2 * blk + (p >> 1)) + 8 * (p & 1); }
__device__ __forceinline__ unsigned row_rd(unsigned lane, unsigned rb, unsigned ks) { return off_b(rb + (lane & 31), 2 * ks + (lane >> 5)); }
__device__ __forceinline__ int crow(int r, int hi) { return (r & 3) + 8 * (r >> 2) + 4 * hi; }
#define HG_WAITL() do { asm volatile("s_waitcnt lgkmcnt(0)" ::: "memory"); __builtin_amdgcn_sched_barrier(0); } while (0)
}

__device__ __forceinline__ void phase_hg_state(const Ctx& C) {
    using namespace hg;
    LAS unsigned char* L = C.lds; const unsigned Lb = (unsigned)(uintptr_t)L;
    constexpr unsigned VT = 0, KP = 16384, TOT = 32768, DECV = 36864;
    const f16_t* LOGF = WSP(f16_t, WS_LOGF); const bf16_t* VH = WSP(bf16_t, WS_VH); bf16_t* SS = WSP(bf16_t, WS_SS);
    const int w = C.wave, lane = C.lane, tid = C.tid, h5 = lane >> 5, r32 = lane & 31;
    const int G = gridDim.x, c = blockIdx.x, v0 = (G % 8 == 0) ? (c % 8) * (G / 8) + c / 8 : c;
    for (int u = v0; u < NCHAIN * 4; u += G) {
        const int chain = u >> 2, sl = u & 3, dir = chain & 1, hh = (chain >> 1) & 15, b = chain >> 5;
        const f16_t* lfb = LOGF + (size_t)dir * MROWS * DM + ((size_t)b * SROW + 8 * w) * DM + hh * 128 + 2 * lane;
        const bf16_t* vb = VH + ((size_t)b * SROW + (tid >> 2)) * DM + hh * 128 + 32 * sl + 8 * (tid & 3);
        f32x16 S = {};
        f32x2 lfA[8], lfB[8]; u32x4 vA = {0u, 0u, 0u, 0u}, vB = {0u, 0u, 0u, 0u};
#define HS_CI(j) (dir == 0 ? (j) : ((j) < 4 ? 3 - (j) : 71 - (j)))
#define HS_LOAD(lf, vr, j) do { const int cn_ = HS_CI(j); _Pragma("unroll") for (int i = 0; i < 8; ++i) { const f16x2 t_ = *(const f16x2*)(lfb + (size_t)(cn_ * 64 + i) * DM); lf[i] = (f32x2){(float)t_.x, (float)t_.y}; } \
        if (tid < 256) vr = *(const u32x4*)(vb + (size_t)cn_ * 64 * DM); } while (0)
#define HS_STEP(lf, vr, j) do { const int ci = HS_CI(j); \
            f32x2 T = {0.f, 0.f}; \
            _Pragma("unroll") for (int i = 0; i < 8; ++i) T += lf[i]; \
            *(LAS f32x2*)(L + TOT + (w * 128 + 2 * lane) * 4) = T; \
            __syncthreads();                                          \
            if (tid < 256) *(LAS u32x4*)(L + VT + off_b(tid >> 2, 4 * sl + (tid & 3))) = vr; \
            f32x2 off = {0.f, 0.f}, total = {0.f, 0.f}; \
            _Pragma("unroll") for (int ww = 0; ww < 8; ++ww) { const f32x2 t = *(const LAS f32x2*)(L + TOT + (ww * 128 + 2 * lane) * 4); total += t; if (dir == 0 ? (ww > w) : (ww < w)) off += t; } \
            f32x2 E[8]; \
            if (dir == 0) { E[7] = off; _Pragma("unroll") for (int i = 6; i >= 0; --i) E[i] = E[i + 1] + lf[i + 1]; } \
            else { E[0] = off; _Pragma("unroll") for (int i = 1; i < 8; ++i) E[i] = E[i - 1] + lf[i - 1]; } \
            _Pragma("unroll") for (int i = 0; i < 8; ++i) { const float k0 = (1.0f - __expf(lf[i].x)) * __expf(E[i].x), k1 = (1.0f - __expf(lf[i].y)) * __expf(E[i].y); \
                *(LAS unsigned*)(L + KP + off_b(8 * w + i, lane >> 2) + (lane & 3) * 4) = pk2(k0, k1); } \
            if (w == 0) { f32x2 d; d.x = __expf(total.x); d.y = __expf(total.y); *(LAS f32x2*)(L + DECV + 2 * lane * 4) = d; } \
            if ((j) + 2 < NCH) HS_LOAD(lf, vr, (j) + 2); \
            __syncthreads(); \
            if (w < 4) {     \
                bf16_t* sp = SS + ((size_t)chain * NCH + ci) * 16384 + 32 * sl + r32; \
                s16x4 al[4], ah[4], bl[4], bh[4]; \
                _Pragma("unroll") for (int ks = 0; ks < 4; ++ks) { al[ks] = trr(Lb + KP + tr_nat(lane, w, ks, 0)); ah[ks] = trr(Lb + KP + tr_nat(lane, w, ks, 1)); \
                    bl[ks] = trr(Lb + VT + tr_nat(lane, sl, ks, 0)); bh[ks] = trr(Lb + VT + tr_nat(lane, sl, ks, 1)); } \
                _Pragma("unroll") for (int r = 0; r < 16; ++r) { const int dk = 32 * w + crow(r, h5); sp[dk * 128] = (bf16_t)f2bf(S[r]); S[r] *= *(const LAS float*)(L + DECV + dk * 4); } \
                HG_WAITL(); \
                _Pragma("unroll") for (int ks = 0; ks < 4; ++ks) S = __builtin_amdgcn_mfma_f32_32x32x16_bf16(pk8(al[ks], ah[ks]), pk8(bl[ks], bh[ks]), S, 0, 0, 0); \
            } } while (0)
        HS_LOAD(lfA, vA, 0); HS_LOAD(lfB, vB, 1);
        __syncthreads();
#pragma unroll 1
        for (int j = 0; j < NCH; j += 2) { HS_STEP(lfA, vA, j); HS_STEP(lfB, vB, j + 1); }
#undef HS_STEP
#undef HS_LOAD
#undef HS_CI
        __syncthreads();
    }
}
__device__ __forceinline__ void phase_hg_out(const Ctx& C, int o_idx) {
    using namespace hg;
    LAS unsigned char* L = C.lds; const unsigned Lb = (unsigned)(uintptr_t)L;
    constexpr unsigned VT = 0, QP = 16384, QM = 32768, KM = 49152, ST = 65536, TOT = 98304, RED = 102400;
    const f16_t* LOGF = WSP(f16_t, WS_LOGF); const bf16_t* VH = WSP(bf16_t, WS_VH); const bf16_t* QH = WSP(bf16_t, WS_QH); const bf16_t* GH = WSP(bf16_t, WS_GH);
    const bf16_t* SS = WSP(bf16_t, WS_SS); bf16_t* Y = WSP(bf16_t, WS_Y); const float* nw = C.inp(23) + o_idx * 128;
    const int w = C.wave, lane = C.lane, tid = C.tid, h5 = lane >> 5, r32 = lane & 31;
    const unsigned tt = w >> 2, dvt = w & 3;
    for (int u = blockIdx.x; u < NBATCH * 16 * NCH; u += gridDim.x) {
        const int b = u / (16 * NCH), hh = (u / NCH) % 16, ci = u % NCH; const size_t R0 = (size_t)b * SROW + ci * 64;
        __syncthreads();
#pragma unroll
        for (int p = 0; p < 2; ++p) { const int row = (tid >> 4) + 32 * p, ch = tid & 15; const u32x4 v = *(const u32x4*)(VH + (R0 + row) * DM + hh * 128 + ch * 8); *(LAS u32x4*)(L + VT + off_b(row, ch)) = v; }
        f32x16 acc = {};
#pragma unroll 1
        for (int dir = 0; dir < 2; ++dir) {
            const int chain = (b * 16 + hh) * 2 + dir;
            const f16_t* lfp = LOGF + (size_t)dir * MROWS * DM + (R0 + 8 * w) * DM + hh * 128 + 2 * lane;
            const bf16_t* qp = QH + (R0 + 8 * w) * DM + hh * 128 + 2 * lane;
            f16x2 lfh[8]; unsigned qv[8]; u32x4 sreg[4];
#pragma unroll
            for (int i = 0; i < 8; ++i) { lfh[i] = *(const f16x2*)(lfp + (size_t)i * DM); qv[i] = *(const unsigned*)(qp + (size_t)i * DM); }
#pragma unroll
            for (int p = 0; p < 4; ++p) sreg[p] = *(const u32x4*)(SS + (((size_t)chain * NCH + ci) * 128 + (tid >> 4) + 32 * p) * 128 + (tid & 15) * 8);
            f32x2 lf[8]; f32x2 T = {0.f, 0.f};
#pragma unroll
            for (int i = 0; i < 8; ++i) { lf[i] = (f32x2){(float)lfh[i].x, (float)lfh[i].y}; T += lf[i]; }
            *(LAS f32x2*)(L + TOT + (w * 128 + 2 * lane) * 4) = T;
            __syncthreads();
            f32x2 off = {0.f, 0.f}, mid = {0.f, 0.f};
#pragma unroll
            for (int ww = 0; ww < 8; ++ww) { const f32x2 t = *(const LAS f32x2*)(L + TOT + (ww * 128 + 2 * lane) * 4);
                if (dir == 0 ? (ww < w) : (ww > w)) off += t; if (dir == 0 ? (ww < 4) : (ww >= 4)) mid += t; }
            f32x2 B[8];
            if (dir == 0) { B[0] = off + lf[0];
#pragma unroll
                for (int i = 1; i < 8; ++i) B[i] = B[i - 1] + lf[i]; }
            else { B[7] = off + lf[7];
#pragma unroll
                for (int i = 6; i >= 0; --i) B[i] = B[i + 1] + lf[i]; }
#pragma unroll
            for (int i = 0; i < 8; ++i) { const float q0 = __uint_as_float(qv[i] << 16), q1 = __uint_as_float(qv[i] & 0xffff0000u);
                const float k0 = 1.0f - __expf(lf[i].x), k1 = 1.0f - __expf(lf[i].y);
                const unsigned a = off_b(8 * w + i, lane >> 2) + (lane & 3) * 4;
                *(LAS unsigned*)(L + QP + a) = pk2(q0 * __expf(B[i].x), q1 * __expf(B[i].y));
                *(LAS unsigned*)(L + QM + a) = pk2(q0 * __expf(B[i].x - mid.x), q1 * __expf(B[i].y - mid.y));
                *(LAS unsigned*)(L + KM + a) = pk2(k0 * __expf(mid.x - B[i].x), k1 * __expf(mid.y - B[i].y)); }
#pragma unroll
            for (int p = 0; p < 4; ++p) *(LAS u32x4*)(L + ST + off_b((tid >> 4) + 32 * p, tid & 15)) = sreg[p];
            __syncthreads();
            { bf16x8 a[8]; s16x4 bl[8], bh[8];
#pragma unroll
              for (int ks = 0; ks < 8; ++ks) { a[ks] = *(const LAS bf16x8*)(L + QP + row_rd(lane, 32 * tt, ks)); bl[ks] = trr(Lb + ST + tr_nat(lane, dvt, ks, 0)); bh[ks] = trr(Lb + ST + tr_nat(lane, dvt, ks, 1)); }
              HG_WAITL();
#pragma unroll
              for (int ks = 0; ks < 8; ++ks) acc = __builtin_amdgcn_mfma_f32_32x32x16_bf16(a[ks], pk8(bl[ks], bh[ks]), acc, 0, 0, 0); }
            { bf16x8 qb[8];
#pragma unroll
              for (int ks = 0; ks < 8; ++ks) qb[ks] = *(const LAS bf16x8*)(L + QM + row_rd(lane, 32 * tt, ks));
#pragma unroll
              for (unsigned st = 0; st < 2; ++st) { const bool valid = dir == 0 ? (st <= tt) : (st >= tt);
                if (valid) {
                  f32x16 x = {};
#pragma unroll
                  for (int ks = 0; ks < 8; ++ks) { const bf16x8 ka = *(const LAS bf16x8*)(L + KM + row_rd(lane, 32 * st, ks)); x = __builtin_amdgcn_mfma_f32_32x32x16_bf16(ka, qb[ks], x, 0, 0, 0); }
                  if (st == tt) {
#pragma unroll
                    for (int r = 0; r < 16; ++r) { const int kr = crow(r, h5); const bool keep = dir == 0 ? (kr <= r32) : (kr >= r32); x[r] = keep ? x[r] : 0.f; } }
                  const s16x4 v0l = trr(Lb + VT + tr_perm(lane, dvt, 32 * st, 0)), v0h = trr(Lb + VT + tr_perm(lane, dvt, 32 * st, 1));
                  const s16x4 v1l = trr(Lb + VT + tr_perm(lane, dvt, 32 * st + 16, 0)), v1h = trr(Lb + VT + tr_perm(lane, dvt, 32 * st + 16, 1));
                  u32x4 A0, A1; A0.x = pk2(x[0], x[1]); A0.y = pk2(x[2], x[3]); A0.z = pk2(x[4], x[5]); A0.w = pk2(x[6], x[7]);
                  A1.x = pk2(x[8], x[9]); A1.y = pk2(x[10], x[11]); A1.z = pk2(x[12], x[13]); A1.w = pk2(x[14], x[15]);
                  HG_WAITL();
                  acc = __builtin_amdgcn_mfma_f32_32x32x16_bf16(*reinterpret_cast<bf16x8*>(&A0), pk8(v0l, v0h), acc, 0, 0, 0);
                  acc = __builtin_amdgcn_mfma_f32_32x32x16_bf16(*reinterpret_cast<bf16x8*>(&A1), pk8(v1l, v1h), acc, 0, 0, 0);
                } } }
        }
        LAS float* red = (LAS float*)(L + RED);
#pragma unroll
        for (int r = 0; r < 16; ++r) { float s = acc[r] * acc[r]; s += __shfl_xor(s, 1); s += __shfl_xor(s, 2); s += __shfl_xor(s, 4); s += __shfl_xor(s, 8); s += __shfl_xor(s, 16);
            if (r32 == 0) red[(tt * 32 + crow(r, h5)) * 4 + dvt] = s; }
        __syncthreads();
        const int col = hh * 128 + 32 * dvt + r32; const float wv = nw[32 * dvt + r32];
#pragma unroll
        for (int r = 0; r < 16; ++r) { const int row = 32 * tt + crow(r, h5); const f32x4 p = *(const LAS f32x4*)(red + row * 4);
            const float rstd = 1.0f / sqrtf(((p.x + p.y) + (p.z + p.w)) * (1.0f / 128.0f) + EPS); const size_t o = (R0 + row) * DM + col;
            Y[o] = (bf16_t)f2bf(acc[r] * rstd * wv * bf2f(GH[o])); }
    }
}
template <bool FINAL>
__device__ __forceinline__ void phase_lru(const Ctx& C, int e) {
    using namespace hg;
    LAS unsigned char* L = C.lds;
    constexpr unsigned UCB = 0, UCF = 16384, AT = 49152, BT = 81920, SEGB = 114688;
    const bf16_t* P = WSP(bf16_t, WS_P); float* AG = WSP(float, WS_AG); const float* CARRY = WSP(float, WS_CARRY); bf16_t* Y = WSP(bf16_t, WS_Y);
    const bf16_t* WG = WSP(bf16_t, WS_WG) + (size_t)e * 4 * 128 * 1024;
    const float* cw = C.inp(10) + (size_t)e * 4 * DLRU; const float* cb = C.inp(11) + (size_t)e * DLRU;
    const float* ba = C.inp(13) + (size_t)e * 2 * DLRU; const float* bx = C.inp(15) + (size_t)e * 2 * DLRU; const float* lam = C.inp(16) + (size_t)e * 2 * DLRU;
    const int w = C.wave, lane = C.lane, tid = C.tid, h5 = lane >> 5, r32 = lane & 31;
    const unsigned rt = w >> 2, et = w & 3;
    for (int u = gridDim.x - 1 - blockIdx.x; u < (MROWS / 64) * 8; u += gridDim.x) {
        const int ci2 = u >> 3, hd = u & 7; const int c = ci2 % NCH, bb = ci2 / NCH; const size_t R0 = (size_t)ci2 * 64;
        const int s0 = c * 64, lo = c < 4 ? 0 : CTX, hi = c < 4 ? CTX : SROW;
        __syncthreads();
        float cin0 = 0.f, cin1 = 0.f;
        if (FINAL) { const int ch = tid & 127; cin0 = CARRY[(size_t)(ci2 * 2 + 0) * DLRU + hd * 128 + ch]; cin1 = CARRY[(size_t)(ci2 * 2 + 1) * DLRU + hd * 128 + ch]; }
        { const int chn = hd * 128 + 2 * lane; const bf16_t* up = P + DLRU + chn;
          f32x2 uv[11];
#pragma unroll
          for (int i = 0; i < 11; ++i) { const int s = s0 + 8 * w + i - 2; unsigned raw = 0u; if (s >= lo && s < hi) raw = *(const unsigned*)(up + ((size_t)bb * SROW + s) * ABNP);
              uv[i].x = __uint_as_float(raw << 16); uv[i].y = __uint_as_float(raw & 0xffff0000u); }
          f32x2 wj[4];
#pragma unroll
          for (int j = 0; j < 4; ++j) wj[j] = *(const f32x2*)(cw + j * DLRU + chn);
          const f32x2 bias = *(const f32x2*)(cb + chn);
#pragma unroll
          for (int i = 0; i < 8; ++i) { f32x2 a = bias;
#pragma unroll
              for (int j = 0; j < 4; ++j) a += uv[i + j] * wj[j];
              *(LAS unsigned*)(L + UCB + off_b(8 * w + i, lane >> 2) + (lane & 3) * 4) = pk2(a.x, a.y);
              *(LAS f32x2*)(L + UCF + ((8 * w + i) * 128 + 2 * lane) * 4) = a; } }
        __syncthreads();
        bf16x8 af[8]; float ucr[16];
#pragma unroll
        for (int ks = 0; ks < 8; ++ks) af[ks] = *(const LAS bf16x8*)(L + UCB + row_rd(lane, 32 * rt, ks));
#pragma unroll
        for (int r = 0; r < 16; ++r) ucr[r] = *(const LAS float*)(L + UCF + ((32 * rt + crow(r, h5)) * 128 + 32 * et + r32) * 4);
        const int chl = hd * 128 + 32 * et + r32;
#pragma unroll 1
        for (int dir = 0; dir < 2; ++dir) {
            f32x16 ga = {}, gx = {};
            { const bf16_t* wa = WG + ((size_t)(dir * 2 + 0) * 128 + 32 * et + r32) * 1024 + hd * 128 + 8 * h5; const bf16_t* wx = wa + (size_t)128 * 1024;
              bf16x8 fa[8], fx[8];
#pragma unroll
              for (int ks = 0; ks < 8; ++ks) { fa[ks] = *(const bf16x8*)(wa + 16 * ks); fx[ks] = *(const bf16x8*)(wx + 16 * ks); }
#pragma unroll
              for (int ks = 0; ks < 8; ++ks) { ga = __builtin_amdgcn_mfma_f32_32x32x16_bf16(af[ks], fa[ks], ga, 0, 0, 0); gx = __builtin_amdgcn_mfma_f32_32x32x16_bf16(af[ks], fx[ks], gx, 0, 0, 0); } }
            const float bav = ba[dir * DLRU + chl], bxv = bx[dir * DLRU + chl], sp = log1pf(__expf(-lam[dir * DLRU + chl]));
            if (dir == 1) __syncthreads();
#pragma unroll
            for (int r = 0; r < 16; ++r) { const float rg = __builtin_amdgcn_rcpf(1.0f + __expf(-(ga[r] + bav))), ig = __builtin_amdgcn_rcpf(1.0f + __expf(-(gx[r] + bxv)));
                const float la = -8.0f * rg * sp; const unsigned o = ((32 * rt + crow(r, h5)) * 128 + 32 * et + r32) * 4;
                *(LAS float*)(L + AT + o) = __expf(la); *(LAS float*)(L + BT + o) = __builtin_amdgcn_sqrtf(1.0f - __expf(2.0f * la)) * (ig * ucr[r]); }
            __syncthreads();
            { const int seg = tid >> 7, ch = tid & 127; const LAS float* ap = (const LAS float*)(L + AT) + ch; const LAS float* bp = (const LAS float*)(L + BT) + ch;
              LAS f32x2* sg4 = (LAS f32x2*)(L + SEGB);
              float h = 0.f, pr = 1.f;
#pragma unroll
              for (int i = 0; i < 16; ++i) { const int row = dir == 0 ? 16 * seg + i : 63 - 16 * seg - i; const float a = ap[row * 128]; h = a * h + bp[row * 128]; pr *= a; }
              sg4[seg * 128 + ch] = (f32x2){pr, h};
              __syncthreads();
              float cs = FINAL ? (dir == 0 ? cin0 : cin1) : 0.f, pa = 1.f;
#pragma unroll
              for (int q = 0; q < 3; ++q) if (q < seg) { const f32x2 t = sg4[q * 128 + ch]; cs = cs * t.x + t.y; pa *= t.x; }
              if (!FINAL) { if (seg == 3) { float* ag = AG + ((size_t)(ci2 * 2 + dir) * 2) * DLRU + hd * 128 + ch; ag[0] = pa * pr; ag[DLRU] = cs * pr + h; } }
              else { LAS float* hp = (LAS float*)(L + (dir == 0 ? UCF : AT)) + ch;
                  h = cs;
#pragma unroll
                  for (int i = 0; i < 16; ++i) { const int row = dir == 0 ? 16 * seg + i : 63 - 16 * seg - i; h = ap[row * 128] * h + bp[row * 128]; hp[row * 128] = h; } } }
        }
        if (FINAL) {
            __syncthreads();
            const int row = tid >> 3, c16 = (tid & 7) * 16; const bf16_t* gp = P + (R0 + row) * ABNP + hd * 128 + c16; bf16_t* yp = Y + (R0 + row) * DM + hd * 128 + c16;
            const u32x4 g0 = *(const u32x4*)gp, g1 = *(const u32x4*)(gp + 8); u32x4 o0, o1;
            const LAS f32x4* hf = (const LAS f32x4*)(L + UCF + (row * 128 + c16) * 4); const LAS f32x4* hb = (const LAS f32x4*)(L + AT + (row * 128 + c16) * 4);
#pragma unroll
            for (int q = 0; q < 4; ++q) { const f32x4 hs = hf[q] + hb[q]; const unsigned ga = q < 2 ? g0[2 * q] : g1[2 * q - 4], gb = q < 2 ? g0[2 * q + 1] : g1[2 * q - 3];
                const float y0 = hs.x * gelu_tanh(__uint_as_float(ga << 16)), y1 = hs.y * gelu_tanh(__uint_as_float(ga & 0xffff0000u)), y2 = hs.z * gelu_tanh(__uint_as_float(gb << 16)), y3 = hs.w * gelu_tanh(__uint_as_float(gb & 0xffff0000u));
                if (q < 2) { o0[2 * q] = pk2(y0, y1); o0[2 * q + 1] = pk2(y2, y3); } else { o1[2 * q - 4] = pk2(y0, y1); o1[2 * q - 3] = pk2(y2, y3); } }
            *(u32x4*)yp = o0; *(u32x4*)(yp + 8) = o1;
        }
    }
}
__device__ __forceinline__ void phase_lru_carry(const Ctx& C) {
    using namespace hg;
    const float* AG = WSP(float, WS_AG); float* CARRY = WSP(float, WS_CARRY);
    const int G = gridDim.x, first = G >= 8 ? G - 8 : 0;
    if ((int)blockIdx.x < first) return;
    for (int id = ((int)blockIdx.x - first) * 512 + C.tid; id < NBATCH * 2 * DLRU; id += (G - first) * 512) { const int b = id >> 11, dir = (id >> 10) & 1, ch = id & 1023;
        float carry = 0.f;
#pragma unroll 4
        for (int j = 0; j < NCH; ++j) { const int cc = dir == 0 ? j : (j < 4 ? 3 - j : 71 - j); const size_t ci2 = (size_t)b * NCH + cc;
            CARRY[(ci2 * 2 + dir) * DLRU + ch] = carry; const float* ag = AG + ((ci2 * 2 + dir) * 2) * DLRU + ch; carry = carry * ag[0] + ag[DLRU]; } }
}
__device__ __forceinline__ void phase_final(const Ctx& C) {
    const float* XS = WSP(float, WS_XS); const float* w = C.inp(27);
    for (int r = C.gw; r < NBATCH * SEQ; r += C.ngw) { const int b = r / SEQ, t = r % SEQ; const size_t R = (size_t)b * SROW + CTX + t;
        const f32x4* xr = (const f32x4*)(XS + R * DM) + C.lane; f32x4 v[8]; float ss = 0.f;
#pragma unroll
        for (int j = 0; j < 8; ++j) { v[j] = xr[64 * j]; ss += (v[j].x * v[j].x + v[j].y * v[j].y) + (v[j].z * v[j].z + v[j].w * v[j].w); }
        const float rstd = 1.0f / sqrtf(wave_sum(ss) * (1.0f / DM) + EPS);
        f32x4* o = (f32x4*)(C.out + (size_t)r * DM) + C.lane;
#pragma unroll
        for (int j = 0; j < 8; ++j) { const f32x4 wv = *(const f32x4*)(w + (C.lane + 64 * j) * 4); o[64 * j] = v[j] * rstd * wv; } }
}

struct Args { const float* in[28]; float* out; unsigned char* ws; int ph_lo, ph_hi; };
constexpr int N_PHASES = 1 + 2 * 9 + 2 * 8 + 1;

__global__ void __launch_bounds__(512, 2) fwd_kernel(Args args) {
    extern __shared__ __attribute__((aligned(16))) unsigned char lds_raw[];
    LAS unsigned char* const lds0 = (LAS unsigned char*)lds_raw;
    const unsigned long long inaddr = (unsigned long long)__builtin_amdgcn_kernarg_segment_ptr();
    volatile LAS unsigned* misc = (volatile LAS unsigned*)(lds0 + LDS_MISC);
    if (threadIdx.x < 64) misc[threadIdx.x] = 0u;
    __syncthreads();
    const int lo = args.ph_lo, hi = args.ph_hi;
    const int wave0 = __builtin_amdgcn_readfirstlane(threadIdx.x >> 6);
    XcdBarrier bar; bar.bar = (unsigned*)(args.ws + WS_CTL) + 4096; bar.x = 0; bar.st = misc + 8;
    if (hi - lo > 1) bar = xcd_barrier_post((unsigned*)(args.ws + WS_CTL) + 4096, misc + 8);
    int pid = 0;
    const unsigned long long wsaddr = (unsigned long long)args.ws;
#define PH_BEGIN if (pid >= lo && pid < hi) { int l = l_; Ctx C; { unsigned long long a_ = inaddr, w_ = wsaddr; int t_; asm volatile("v_mbcnt_lo_u32_b32 %0, -1, 0\n\tv_mbcnt_hi_u32_b32 %0, -1, %0" : "=v"(t_)); t_ += wave0 * 64; asm volatile("" : "+s"(a_), "+s"(w_), "+s"(l)); \
        C.in = (InPtr)a_; C.ws = (unsigned char*)(GAS unsigned char*)w_; C.out = (float*)(GAS float*)args.out; C.lds = lds0; C.tid = t_; C.lane = t_ & 63; C.wave = __builtin_amdgcn_readfirstlane(t_ >> 6); \
        C.gw = blockIdx.x * 8 + C.wave; C.ngw = gridDim.x * 8; C.gtid = blockIdx.x * 512 + t_; C.ngt = gridDim.x * 512; } \
        const int e = l >> 1; const float* mod = WSP(float, WS_MOD) + (size_t)l * 3 * MODW; const int G = gridDim.x, cb = blockIdx.x; (void)e; (void)mod; (void)G; (void)cb;
#define PH_END } if (pid >= lo && pid + 1 < hi) xcd_barrier(bar); ++pid;
#ifndef PROBE_CAT
#define PROBE_CAT -1
#endif
#define DUP(cat, ...) { if (PROBE_CAT == (cat)) { const float SC_ = 0.f; (void)SC_; __VA_ARGS__ } { const float SC_ = 1.f; (void)SC_; __VA_ARGS__ } }
    int l_ = 0;
    PH_BEGIN
#ifndef SKIP_PRO
    DUP(0, phase_prologue(C);)
#endif
    PH_END

    constexpr int MLAT = NBATCH * SEQ;
    for (l_ = 0; l_ < DEPTH; ++l_) {
        PH_BEGIN DUP(1, phase_norm_mod(C, C.inp(6) + l * DM, mod, 0, 1);) PH_END
        if ((l_ & 1) == 0) {
            PH_BEGIN DUP(2, { const bf16_t* wt = WSP(bf16_t, WS_WABIN) + (size_t)e * ABNP * DM;
                       { pg8::Gemm g{WSP(bf16_t, WS_H), wt, MLAT, ABNP, DM, DM, DM, 1}; pg8::StaticOrder S; S.init(MLAT, ABNP, G, cb); EpiBf16Plain E{WSP(bf16_t, WS_P), ABNP}; pg8::gemm_phase(C.lds, C.tid, g, S, E); }
                       DUP(14, { sg::SGemm g{WSP(bf16_t, WS_H), wt, ABNP, DM, DM, DM}; SEpiPlain E{WSP(bf16_t, WS_P), ABNP}; sg::sgemm_phase(C.lds, C.tid, g, 32 * (ABNP / 256), E); }) }) PH_END
            PH_BEGIN DUP(3, { phase_lru<false>(C, e); phase_rs_kr(C); }) PH_END
            PH_BEGIN phase_lru_carry(C); DUP(4, { const bf16_t* wq = WSP(bf16_t, WS_WUQ) + (size_t)e * QW * 512; const bf16_t* wkv = WSP(bf16_t, WS_WUKV) + (size_t)e * KVW * 512;
                       { pg8::Gemm g{WSP(bf16_t, WS_P) + 2048, wq, MLAT, QW, 512, ABNP, 512, 1}; pg8::StaticOrder S; S.init(MLAT, QW, G, cb); EpiBf16RowScale E{WSP(bf16_t, WS_Q), QW, WSP(float, WS_RSQ)}; pg8::gemm_phase(C.lds, C.tid, g, S, E); }
                       { pg8::Gemm g{WSP(bf16_t, WS_P) + 2560, wkv, MLAT, KVW, 512, ABNP, 512, 1}; pg8::StaticOrder S; S.init(MLAT, KVW, G, cb); EpiBf16RowScale E{WSP(bf16_t, WS_KV), KVW, WSP(float, WS_RSKV)}; pg8::gemm_phase(C.lds, C.tid, g, S, E); }
                       DUP(14, { sg::SGemm g{WSP(bf16_t, WS_P) + 2048, wq, QW, 512, ABNP, 512}; SEpiRowScale E{WSP(bf16_t, WS_Q), QW, WSP(float, WS_RSQ)}; sg::sgemm_phase(C.lds, C.tid, g, 32 * (QW / 256), E); })
                       DUP(14, { sg::SGemm g{WSP(bf16_t, WS_P) + 2560, wkv, KVW, 512, ABNP, 512}; SEpiRowScale E{WSP(bf16_t, WS_KV), KVW, WSP(float, WS_RSKV)}; sg::sgemm_phase(C.lds, C.tid, g, 0, E); }) })
            PH_END
            PH_BEGIN DUP(5, phase_lru<true>(C, e);) DUP(6, phase_attn(C);) PH_END
        } else {
            PH_BEGIN DUP(7, { const bf16_t* wt = WSP(bf16_t, WS_WHGIN) + (size_t)e * HGN * DM;
                       { pg8::Gemm g{WSP(bf16_t, WS_H), wt, MLAT, HGN, DM, DM, DM, 1}; pg8::StaticOrder S; S.init(MLAT, HGN, G, cb); EpiHG E{WSP(bf16_t, WS_QH), WSP(f16_t, WS_LOGF), WSP(float, WS_LB) + l * 2048}; pg8::gemm_phase(C.lds, C.tid, g, S, E); }
                       DUP(14, { sg::SGemm g{WSP(bf16_t, WS_H), wt, HGN, DM, DM, DM}; SEpiHG E{WSP(bf16_t, WS_QH), WSP(f16_t, WS_LOGF), WSP(float, WS_LB) + l * 2048}; sg::sgemm_phase(C.lds, C.tid, g, 32 * (HGN / 256), E); }) }) PH_END
            PH_BEGIN DUP(8, phase_hg_state(C);) PH_END
            PH_BEGIN DUP(10, phase_hg_out(C, e);) PH_END
        }
        PH_BEGIN DUP(11, { const bf16_t* wout = (l & 1) ? WSP(bf16_t, WS_WHGOUT) + (size_t)e * DM * DM : WSP(bf16_t, WS_WABOUT) + (size_t)e * DM * DM;
                   { pg8::Gemm g{WSP(bf16_t, WS_Y), wout, MLAT, DM, DM, DM, DM, 1}; pg8::StaticOrder S; S.init(MLAT, DM, G, cb); EpiResid E{WSP(float, WS_XS), mod + 2 * DM, SC_}; pg8::gemm_phase(C.lds, C.tid, g, S, E); }
                   if (l != DEPTH - 1) DUP(14, { sg::SGemm g{WSP(bf16_t, WS_Y), wout, DM, DM, DM, DM}; SEpiResid E{WSP(float, WS_XS), mod + 2 * DM, SC_}; sg::sgemm_phase(C.lds, C.tid, g, 32 * (DM / 256), E); }) }) PH_END
        PH_BEGIN DUP(1, phase_norm_mod(C, C.inp(7) + l * DM, mod, 3, 4);) PH_END
        PH_BEGIN DUP(12, { const bf16_t* wt = WSP(bf16_t, WS_W1) + (size_t)l * DFF * DM;
                   { pg8::Gemm g{WSP(bf16_t, WS_H), wt, MLAT, DFF, DM, DM, DM, 1}; pg8::StaticOrder S; S.init(MLAT, DFF, G, cb); EpiRelu2 E{WSP(bf16_t, WS_HID), DFF}; pg8::gemm_phase(C.lds, C.tid, g, S, E); }
                   if (l != DEPTH - 1) DUP(16, { sg::SGemm g{WSP(bf16_t, WS_H), wt, DFF, DM, DM, DM}; SEpiRelu2 E{WSP(bf16_t, WS_HID), DFF}; sg::sgemm_phase(C.lds, C.tid, g, 32 * (DFF / 256), E); }) }) PH_END
        PH_BEGIN DUP(13, { const bf16_t* wt = WSP(bf16_t, WS_W2) + (size_t)l * DM * DFF;
                   { pg8::Gemm g{WSP(bf16_t, WS_HID), wt, MLAT, DM, DFF, DFF, DFF, 1}; pg8::StaticOrder S; S.init(MLAT, DM, G, cb); EpiResid E{WSP(float, WS_XS), mod + 5 * DM, SC_}; pg8::gemm_phase(C.lds, C.tid, g, S, E); }
                   if (l != DEPTH - 1) DUP(15, { sg::SGemm g{WSP(bf16_t, WS_HID), wt, DM, DFF, DFF, DFF}; SEpiResid E{WSP(float, WS_XS), mod + 5 * DM, SC_}; sg::sgemm_phase(C.lds, C.tid, g, 32 * (DM / 256), E); }) }) PH_END
    }
    l_ = 0;
    PH_BEGIN phase_final(C); PH_END
}

#ifndef N_LAUNCH_MODE
#define N_LAUNCH_MODE 1
#endif
extern "C" void kernel_launch(void* const* d_in, const int* in_sizes, int n_in, void* d_out, int out_size, void* d_ws, size_t ws_size, hipStream_t stream) {
    static int grid = 0;
    if (grid == 0) {
        if (n_in != 28 || out_size != NBATCH * SEQ * DM || ws_size < WS_END) { fprintf(stderr, "kernel_launch: shape mismatch n_in %d out %d ws %zu (need %zu)\n", n_in, out_size, ws_size, (size_t)WS_END); grid = -1; return; }
        int dev = 0, cus = 0, per_cu = 0;
        if (hipGetDevice(&dev) != hipSuccess || hipDeviceGetAttribute(&cus, hipDeviceAttributeMultiprocessorCount, dev) != hipSuccess) { grid = -1; return; }
        if (hipFuncSetAttribute((const void*)fwd_kernel, hipFuncAttributeMaxDynamicSharedMemorySize, LDS_BYTES) != hipSuccess) { fprintf(stderr, "kernel_launch: hipFuncSetAttribute failed\n"); grid = -1; return; }
        if (hipOccupancyMaxActiveBlocksPerMultiprocessor(&per_cu, (const void*)fwd_kernel, 512, LDS_BYTES) != hipSuccess || per_cu < 1) fprintf(stderr, "kernel_launch: occupancy query says %d\n", per_cu);
        (void)hipGetLastError();
        grid = cus;
    }
    if (grid < 0) return;
    (void)hipMemsetAsync((char*)d_ws + WS_CTL, 0, CTL_BYTES, stream);
    Args a{};
    for (int i = 0; i < 28; ++i) a.in[i] = (const float*)d_in[i];
    a.out = (float*)d_out; a.ws = (unsigned char*)d_ws;
#if N_LAUNCH_MODE == 1
    a.ph_lo = 0; a.ph_hi = N_PHASES;
    hipLaunchKernelGGL(fwd_kernel, dim3(grid), dim3(512), LDS_BYTES, stream, a);
#else
    for (int p = 0; p < N_PHASES; ++p) { a.ph_lo = p; a.ph_hi = p + 1; hipLaunchKernelGGL(fwd_kernel, dim3(grid), dim3(512), LDS_BYTES, stream, a); }
#endif
    const hipError_t le = hipPeekAtLastError();
    if (le != hipSuccess) fprintf(stderr, "kernel_launch: launch failed: %s\n", hipGetErrorName(le));
}
```

```cpp
#include <hip/hip_runtime.h>
#include <cstdio>

#define LAS __attribute__((address_space(3)))
#define GAS __attribute__((address_space(1)))
typedef unsigned short bf16_t;
typedef short bf16x8 __attribute__((ext_vector_type(8)));
typedef float f32x4 __attribute__((ext_vector_type(4)));
typedef float f32x2 __attribute__((ext_vector_type(2)));
typedef unsigned u32x4 __attribute__((ext_vector_type(4)));
typedef unsigned u32x2 __attribute__((ext_vector_type(2)));
typedef _Float16 f16_t;
typedef _Float16 f16x2 __attribute__((ext_vector_type(2)));
typedef _Float16 f16x8 __attribute__((ext_vector_type(8)));

constexpr int DM = 2048, NBATCH = 2, SEQ = 4096, DEPTH = 4, CTX = 256;
constexpr int SROW = CTX + SEQ;
constexpr int MROWS = NBATCH * SROW;
constexpr int DFF = 8192, MODW = 6 * DM;
constexpr int DLRU = 1024;
constexpr int ABN = 3136, ABNP = 3328;
constexpr int QW = 1536, KVW = 2048, HGN = 10240;
constexpr float EPS = 1e-6f;
constexpr float ATTN_SCALE = 0.07216878364870322f;

constexpr size_t al256(size_t x) { return (x + 255) & ~(size_t)255; }
constexpr size_t WS_CTL = 0, CTL_BYTES = 1u << 20;
constexpr size_t WS_MOD = WS_CTL + CTL_BYTES;
constexpr size_t WS_LB = WS_MOD + al256((size_t)DEPTH * 3 * MODW * 4);
constexpr size_t WS_ROPE = WS_LB + al256((size_t)DEPTH * 2048 * 4);
constexpr size_t WS_RSQ = WS_ROPE + al256(2 * 64 * 16 * 4);
constexpr size_t WS_RSKV = WS_RSQ + al256((size_t)MROWS * 4);
constexpr size_t WS_WABIN = WS_RSKV + al256((size_t)MROWS * 4);
constexpr size_t WS_WABOUT = WS_WABIN + (size_t)2 * ABNP * DM * 2;
constexpr size_t WS_WUQ = WS_WABOUT + (size_t)2 * DM * DM * 2;
constexpr size_t WS_WUKV = WS_WUQ + (size_t)2 * QW * 512 * 2;
constexpr size_t WS_WHGIN = WS_WUKV + (size_t)2 * KVW * 512 * 2;
constexpr size_t WS_WHGOUT = WS_WHGIN + (size_t)2 * HGN * DM * 2;
constexpr size_t WS_W1 = WS_WHGOUT + (size_t)2 * DM * DM * 2;
constexpr size_t WS_W2 = WS_W1 + (size_t)4 * DFF * DM * 2;
constexpr size_t WS_WG = WS_W2 + (size_t)4 * DFF * DM * 2;
constexpr size_t WS_XS = WS_WG + (size_t)2 * 4 * 128 * 1024 * 2;
constexpr size_t WS_H = WS_XS + (size_t)MROWS * DM * 4;
constexpr size_t WS_Y = WS_H + (size_t)MROWS * DM * 2;
constexpr size_t WS_BIG = WS_Y + (size_t)MROWS * DM * 2;
constexpr size_t WS_P = WS_BIG;
constexpr size_t WS_AG = WS_P + (size_t)MROWS * ABNP * 2;
constexpr size_t WS_CARRY = WS_AG + al256((size_t)(MROWS / 64) * 2 * 2 * DLRU * 4);
constexpr size_t WS_Q = WS_CARRY + al256((size_t)(MROWS / 64) * 2 * DLRU * 4);
constexpr size_t WS_KV = WS_Q + (size_t)MROWS * QW * 2;
constexpr size_t WS_KR = WS_KV + (size_t)MROWS * KVW * 2;
constexpr size_t WS_AB_END = WS_KR + (size_t)MROWS * 64 * 2;
constexpr size_t WS_QH = WS_BIG;
constexpr size_t WS_VH = WS_QH + (size_t)MROWS * DM * 2;
constexpr size_t WS_GH = WS_VH + (size_t)MROWS * DM * 2;
constexpr size_t WS_LOGF = WS_GH + (size_t)MROWS * DM * 2;
constexpr size_t WS_SS = WS_LOGF + (size_t)2 * MROWS * DM * 2;
constexpr size_t WS_HG_END = WS_SS + (size_t)64 * 68 * 16384 * 2;
constexpr size_t WS_HID = WS_BIG;
constexpr size_t WS_MLP_END = WS_HID + (size_t)MROWS * DFF * 2;
constexpr size_t cmax(size_t a, size_t b) { return a > b ? a : b; }
constexpr size_t WS_END = cmax(cmax(WS_AB_END, WS_HG_END), WS_MLP_END);

constexpr int LDS_BYTES = 147456;
constexpr int LDS_MISC = 139264;

__device__ __forceinline__ float bf2f(bf16_t v) { return __uint_as_float(((unsigned)v) << 16); }
__device__ __forceinline__ unsigned f2bf(float f) { unsigned u = __float_as_uint(f); return (u + 0x7fffu + ((u >> 16) & 1u)) >> 16; }
__device__ __forceinline__ unsigned pk2(float lo, float hi) { return f2bf(lo) | (f2bf(hi) << 16); }
__device__ __forceinline__ float wave_sum(float v) {
#pragma unroll
    for (int o = 1; o < 64; o <<= 1) v += __shfl_xor(v, o);
    return v;
}
__device__ __forceinline__ float wave_max(float v) {
#pragma unroll
    for (int o = 1; o < 64; o <<= 1) v = fmaxf(v, __shfl_xor(v, o));
    return v;
}
__device__ __forceinline__ float sigmoidf_(float x) { return 1.0f / (1.0f + expf(-x)); }
__device__ __forceinline__ float siluf_(float x) { return x / (1.0f + expf(-x)); }
__device__ __forceinline__ float fsigmoid(float x) { return __builtin_amdgcn_rcpf(1.0f + __expf(-x)); }
__device__ __forceinline__ float gelu_tanh(float x) { const float u = 0.7978845608028654f * (x + 0.044715f * x * x * x); return x * fsigmoid(2.0f * u); }

#define XB_TMO      128
#define XB_XCNT(j)  (256  + 64 * (j))
#define XB_XSUB(j)  (1280 + 64 * (j))
#define XB_XGEN(j)  (2304 + 64 * (j))
#define XB_TOP      3328
#define XB_TOPGEN   3392
#define XCD_BAR_WORDS 3456
#define XB_SPIN_CAP (1u << 18)
__device__ __forceinline__ unsigned xb_ld(unsigned* p)              { return __hip_atomic_load(p, __ATOMIC_RELAXED, __HIP_MEMORY_SCOPE_AGENT); }
__device__ __forceinline__ unsigned xb_add(unsigned* p, unsigned v) { return __hip_atomic_fetch_add(p, v, __ATOMIC_RELAXED, __HIP_MEMORY_SCOPE_AGENT); }
__device__ __forceinline__ unsigned xb_xcc_id() { return (unsigned)__builtin_amdgcn_s_getreg((3 << 11) | 20) & 0xFu; }
#define XB_SPIN(cond, bar) do { unsigned _sp = 0; while (cond) { __builtin_amdgcn_s_sleep(1); \
    if ((++_sp & 255u) == 0u) { if (xb_ld(&(bar)[XB_TMO])) break; if (_sp > XB_SPIN_CAP) { atomicAdd(&(bar)[XB_TMO], 1u); break; } } } } while (0)
struct XcdBarrier { unsigned* bar; unsigned x; volatile LAS unsigned* st; };
__device__ __forceinline__ XcdBarrier xcd_barrier_post(unsigned* bar, volatile LAS unsigned* st) {
    XcdBarrier b; b.bar = bar; b.x = xb_xcc_id(); b.st = st;
    if (threadIdx.x == 0) (void)xb_add(&bar[XB_XCNT(b.x)], 1u);
    return b;
}
__device__ __forceinline__ void xcd_barrier_complete(unsigned* bar, unsigned x, unsigned& nloc, unsigned& nx) {
    const unsigned G = gridDim.x * gridDim.y * gridDim.z;
    unsigned sum, cnt, mine, sp = 0u;
    for (;;) {
        sum = 0u; cnt = 0u; mine = 0u;
#pragma unroll
        for (unsigned j = 0; j < 16; ++j) { const unsigned c = xb_ld(&bar[XB_XCNT(j)]); sum += c; cnt += (c > 0u) ? 1u : 0u; mine = (j == x) ? c : mine; }
        if (sum == G) break;
        __builtin_amdgcn_s_sleep(1);
        if ((++sp & 255u) == 0u) { if (xb_ld(&bar[XB_TMO])) break; if (sp > XB_SPIN_CAP) { atomicAdd(&bar[XB_TMO], 1u); break; } }
    }
    nloc = mine > 0u ? mine : 1u; nx = cnt > 0u ? cnt : 1u;
}
__device__ __forceinline__ void xcd_barrier(const XcdBarrier& b) {
    asm volatile("s_waitcnt vmcnt(0)" ::: "memory");
    __syncthreads();
    if (threadIdx.x == 0) {
        unsigned* bar = b.bar; asm volatile("" : "+s"(bar)); bar = (unsigned*)(GAS unsigned*)bar;
        __builtin_amdgcn_s_waitcnt(0);
        unsigned nloc = b.st[0], nx = b.st[1];
        if (nloc == 0u) { xcd_barrier_complete(bar, b.x, nloc, nx); b.st[0] = nloc; b.st[1] = nx; }
        const unsigned old = xb_add(&bar[XB_XSUB(b.x)], 1u);
        const unsigned gen = old / nloc;
        if (old + 1u == (gen + 1u) * nloc) {
            __builtin_amdgcn_fence(__ATOMIC_RELEASE, "agent");
            asm volatile("s_waitcnt vmcnt(0)" ::: "memory");
            const unsigned og = xb_add(&bar[XB_TOP], 1u);
            const unsigned tg = og / nx;
            if (og + 1u == (tg + 1u) * nx) xb_add(&bar[XB_TOPGEN], 1u);
            else XB_SPIN(xb_ld(&bar[XB_TOPGEN]) == tg, bar);
            __builtin_amdgcn_fence(__ATOMIC_ACQUIRE, "agent");
            xb_add(&bar[XB_XGEN(b.x)], 1u);
            asm volatile("s_waitcnt vmcnt(0)" ::: "memory");
        } else {
            XB_SPIN(xb_ld(&bar[XB_XGEN(b.x)]) == gen, bar);
            __builtin_amdgcn_fence(__ATOMIC_ACQUIRE, "agent");
            asm volatile("s_waitcnt vmcnt(0)" ::: "memory");
        }
    }
    __syncthreads();
}

namespace pg8 {
constexpr int BM = 256, BK = 64, HALF = 128, HTB = HALF * BK * 2, STAGE_BYTES = 8 * HTB, NXCD = 8, WGM = 8;
__host__ __device__ __forceinline__ int lds_byte(int r, int c) { const int st = (r >> 4) * 2 + (c >> 5), rr = r & 15, cc = c & 31, ob = rr * 64 + cc * 2; return st * 1024 + (ob ^ (((ob >> 9) & 1) << 5)); }
__host__ __device__ __forceinline__ void stage_rc(int b, int& R, int& C) { const int st = b / 1024, sb = b % 1024, swz = sb ^ (((sb >> 9) & 1) << 5); R = (st >> 1) * 16 + swz / 64; C = (st & 1) * 32 + (swz % 64) / 2; }
__host__ __device__ __forceinline__ int perm32(int rho) { const int n = rho >> 4, i = rho & 15; return 8 * (i >> 2) + 4 * n + (i & 3); }
struct Unit { int pm, pn; };
struct Gemm { const bf16_t* A; const bf16_t* Bt; int M, N, K, lda, ldb, lat; };
struct StaticOrder {
    int nM, nN, nwg, G, c;
    __host__ __device__ void init(int M, int N, int G_, int c_) { nM = M / BM; nN = N / BM; nwg = nM * nN; G = G_; c = c_; }
    __host__ __device__ bool next(int i, Unit& u) const {
        const long L = (long)i * G + c; if (L >= nwg) return false;
        int wgid = (int)L; { const int q = nwg / NXCD, r = nwg % NXCD, xcd = wgid % NXCD, off = wgid / NXCD; wgid = (xcd < r ? xcd * (q + 1) : r * (q + 1) + (xcd - r) * q) + off; }
        const int nig = WGM * nN, gid = wgid / nig, fm = gid * WGM, gsz = (nM - fm) < WGM ? (nM - fm) : WGM;
        u.pm = fm + ((wgid % nig) % gsz); u.pn = (wgid % nig) / gsz; return true;
    }
};
__device__ __forceinline__ unsigned cvt_pk_bf16(float lo, float hi) { unsigned r; asm volatile("v_cvt_pk_bf16_f32 %0, %1, %2" : "=v"(r) : "v"(lo), "v"(hi)); return r; }

template <class Epi>
__device__ __forceinline__ void gemm_phase(LAS unsigned char* lds, const int tid, const Gemm g, const StaticOrder& S, const Epi& E) {
    const int wid = __builtin_amdgcn_readfirstlane(tid >> 6), lane = tid & 63, wr = wid >> 2, wc = wid & 3, fr = lane & 15, fq = lane >> 4;
    const int K = g.K, nt = K / BK;
    unsigned voffA[2], voffB[2];
#pragma unroll
    for (int i = 0; i < 2; ++i) { int R, C; stage_rc(tid * 16 + i * 8192, R, C); const int Rb = Epi::PERM ? ((R & ~31) + perm32(R & 31)) : R;
        voffA[i] = (unsigned)(R * g.lda + C) * 2u; voffB[i] = (unsigned)(Rb * g.ldb + C) * 2u; }
    const size_t kstep = (size_t)(BK * 2);
    const size_t hsA = (size_t)HALF * g.lda * 2, hsB = (size_t)HALF * g.ldb * 2;
    const size_t tsA = 2 * hsA, tsB = 2 * hsB;
    const unsigned ldsw = (unsigned)wid * 1024u;
    const int aoff = lds_byte(wr * 64 + fr, fq * 8), boff = lds_byte(wc * 32 + fr, fq * 8);
#define PG8_SA(b, h) (((b) * 2 + (h)) * HTB)
#define PG8_SB(b, h) ((4 + (b) * 2 + (h)) * HTB)
#define PG8_STAGE(bufoff, gbase, voff) do { _Pragma("unroll") for (int _i = 0; _i < 2; ++_i) \
        __builtin_amdgcn_global_load_lds((const unsigned*)((const char*)(gbase) + (voff)[_i]), (LAS unsigned*)(lds + (bufoff) + ldsw + _i * 8192), 16, 0, 0); } while (0)
#define PG8_LDA(dst, b, h) do { _Pragma("unroll") for (int m = 0; m < 4; ++m) _Pragma("unroll") for (int k = 0; k < 2; ++k) dst[m][k] = *(const LAS bf16x8*)(lds + PG8_SA(b, h) + aoff + m * 2048 + k * 1024); } while (0)
#define PG8_LDB(dst, b, h) do { _Pragma("unroll") for (int n = 0; n < 2; ++n) _Pragma("unroll") for (int k = 0; k < 2; ++k) dst[n][k] = *(const LAS bf16x8*)(lds + PG8_SB(b, h) + boff + n * 2048 + k * 1024); } while (0)
#define PG8_MMA(ai, bj, At, Bt) do { __builtin_amdgcn_s_setprio(1); _Pragma("unroll") for (int m = 0; m < 4; ++m) _Pragma("unroll") for (int n = 0; n < 2; ++n) _Pragma("unroll") for (int k = 0; k < 2; ++k) \
        acc[ai][bj][m][n] = __builtin_amdgcn_mfma_f32_16x16x32_bf16(Bt[n][k], At[m][k], acc[ai][bj][m][n], 0, 0, 0); __builtin_amdgcn_s_setprio(0); } while (0)
#define PG8_WAIT_V(n) asm volatile("s_waitcnt vmcnt(" #n ")" ::: "memory")
#define PG8_WAIT_L(n) asm volatile("s_waitcnt lgkmcnt(" #n ")" ::: "memory")
#define PG8_BAR __builtin_amdgcn_s_barrier()
#define PG8_SCHED __builtin_amdgcn_sched_barrier(0)
    Unit cur, nxt; int ui = 0;
    if (!S.next(0, cur)) return;
    if (g.lat) cur.pm += (cur.pm >> 4) + 1;
    f32x4 acc[2][2][4][2];
#pragma unroll
    for (int a = 0; a < 2; ++a)
#pragma unroll
        for (int b = 0; b < 2; ++b)
#pragma unroll
            for (int m = 0; m < 4; ++m)
#pragma unroll
                for (int n = 0; n < 2; ++n) acc[a][b][m][n] = (f32x4){0.f, 0.f, 0.f, 0.f};
    bf16x8 At[4][2], B0[2][2], B1[2][2];
    const char* cA = (const char*)g.A + (size_t)cur.pm * tsA; const char* cB = (const char*)g.Bt + (size_t)cur.pn * tsB;
    PG8_STAGE(PG8_SB(0, 0), cB, voffB); PG8_STAGE(PG8_SA(0, 0), cA, voffA); PG8_STAGE(PG8_SB(0, 1), cB + hsB, voffB); PG8_STAGE(PG8_SA(0, 1), cA + hsA, voffA);
    if (wr == 1) PG8_BAR;
    PG8_WAIT_V(4); PG8_BAR;
    PG8_STAGE(PG8_SB(1, 0), cB + kstep, voffB); PG8_STAGE(PG8_SA(1, 0), cA + kstep, voffA); PG8_STAGE(PG8_SB(1, 1), cB + hsB + kstep, voffB);
    PG8_WAIT_V(6); PG8_BAR;
    for (;;) {
        const bool has_next = S.next(ui + 1, nxt);
        if (g.lat && has_next) nxt.pm += (nxt.pm >> 4) + 1;
        const char* nA = has_next ? (const char*)g.A + (size_t)nxt.pm * tsA : cA; const char* nB = has_next ? (const char*)g.Bt + (size_t)nxt.pn * tsB : cB;
        for (int t = 0; t < nt; t += 2) {
            const bool last = (t == nt - 2);
            const char* a1 = cA + (size_t)(t + 1) * kstep;
            const char* a2 = last ? nA : cA + (size_t)(t + 2) * kstep; const char* b2 = last ? nB : cB + (size_t)(t + 2) * kstep;
            const char* a3 = a2 + kstep; const char* b3 = b2 + kstep;
            PG8_LDB(B0, 0, 0); PG8_SCHED; PG8_LDA(At, 0, 0); PG8_STAGE(PG8_SA(1, 1), a1 + hsA, voffA);
            PG8_WAIT_L(8); PG8_BAR; PG8_WAIT_L(0); PG8_MMA(0, 0, At, B0); PG8_BAR; PG8_SCHED;
            PG8_LDB(B1, 0, 1); PG8_STAGE(PG8_SB(0, 0), b2, voffB);
            PG8_BAR; PG8_WAIT_L(0); PG8_MMA(0, 1, At, B1); PG8_BAR;
            PG8_LDA(At, 0, 1); PG8_STAGE(PG8_SA(0, 0), a2, voffA);
            PG8_BAR; PG8_WAIT_L(0); PG8_MMA(1, 0, At, B0); PG8_BAR; PG8_SCHED;
            PG8_STAGE(PG8_SB(0, 1), b2 + hsB, voffB);
            PG8_WAIT_V(6); PG8_BAR; PG8_MMA(1, 1, At, B1); PG8_BAR;
            PG8_LDB(B0, 1, 0); PG8_SCHED; PG8_LDA(At, 1, 0); PG8_STAGE(PG8_SA(0, 1), a2 + hsA, voffA);
            PG8_WAIT_L(8); PG8_BAR; PG8_WAIT_L(0); PG8_MMA(0, 0, At, B0); PG8_BAR; PG8_SCHED;
            PG8_LDB(B1, 1, 1); PG8_STAGE(PG8_SB(1, 0), b3, voffB);
            PG8_BAR; PG8_WAIT_L(0); PG8_MMA(0, 1, At, B1); PG8_BAR;
            PG8_LDA(At, 1, 1); PG8_STAGE(PG8_SA(1, 0), a3, voffA);
            PG8_BAR; PG8_WAIT_L(0); PG8_MMA(1, 0, At, B0); PG8_BAR; PG8_SCHED;
            PG8_STAGE(PG8_SB(1, 1), b3 + hsB, voffB);
            PG8_WAIT_V(6); PG8_BAR; PG8_MMA(1, 1, At, B1); PG8_BAR;
        }
        E(acc, cur, wr, wc, fr, fq);
        if (!has_next) break;
#pragma unroll
        for (int a = 0; a < 2; ++a)
#pragma unroll
            for (int b = 0; b < 2; ++b)
#pragma unroll
                for (int m = 0; m < 4; ++m)
#pragma unroll
                    for (int n = 0; n < 2; ++n) acc[a][b][m][n] = (f32x4){0.f, 0.f, 0.f, 0.f};
        cur = nxt; cA = nA; cB = nB; ++ui;
    }
    PG8_WAIT_V(0);
    if (wr == 0) PG8_BAR;
    PG8_BAR;
#undef PG8_SA
#undef PG8_SB
#undef PG8_STAGE
#undef PG8_LDA
#undef PG8_LDB
#undef PG8_MMA
#undef PG8_WAIT_V
#undef PG8_WAIT_L
#undef PG8_BAR
#undef PG8_SCHED
}
}

#define EPI_ROWS_COLS_PERM \
    const int row0 = u.pm * 256 + wr * 64 + fr; const int col0 = u.pn * 256 + wc * 32 + 8 * fq;
struct EpiBf16Plain {
    static constexpr bool PERM = true;
    bf16_t* O; int ldc;
    __device__ __forceinline__ void operator()(const f32x4 (&acc)[2][2][4][2], const pg8::Unit& u, int wr, int wc, int fr, int fq) const {
        EPI_ROWS_COLS_PERM
#pragma unroll
        for (int ai = 0; ai < 2; ++ai)
#pragma unroll
            for (int m = 0; m < 4; ++m) { bf16_t* rowp = O + (size_t)(row0 + ai * 128 + m * 16) * ldc + col0;
#pragma unroll
                for (int bj = 0; bj < 2; ++bj) { const f32x4 v0 = acc[ai][bj][m][0], v1 = acc[ai][bj][m][1];
                    u32x4 w; w.x = pk2(v0[0], v0[1]); w.y = pk2(v0[2], v0[3]); w.z = pk2(v1[0], v1[1]); w.w = pk2(v1[2], v1[3]);
                    *(u32x4*)(rowp + bj * 128) = w; } }
    }
};
struct EpiBf16RowScale {
    static constexpr bool PERM = true;
    bf16_t* O; int ldc; const float* rs;
    __device__ __forceinline__ void operator()(const f32x4 (&acc)[2][2][4][2], const pg8::Unit& u, int wr, int wc, int fr, int fq) const {
        EPI_ROWS_COLS_PERM
#pragma unroll
        for (int ai = 0; ai < 2; ++ai)
#pragma unroll
            for (int m = 0; m < 4; ++m) { const int row = row0 + ai * 128 + m * 16; const float s = rs[row]; bf16_t* rowp = O + (size_t)row * ldc + col0;
#pragma unroll
                for (int bj = 0; bj < 2; ++bj) { const f32x4 v0 = acc[ai][bj][m][0] * s, v1 = acc[ai][bj][m][1] * s;
                    u32x4 w; w.x = pk2(v0[0], v0[1]); w.y = pk2(v0[2], v0[3]); w.z = pk2(v1[0], v1[1]); w.w = pk2(v1[2], v1[3]);
                    *(u32x4*)(rowp + bj * 128) = w; } }
    }
};
struct EpiRelu2 {
    static constexpr bool PERM = true;
    bf16_t* O; int ldc;
    __device__ __forceinline__ void operator()(const f32x4 (&acc)[2][2][4][2], const pg8::Unit& u, int wr, int wc, int fr, int fq) const {
        EPI_ROWS_COLS_PERM
#pragma unroll
        for (int ai = 0; ai < 2; ++ai)
#pragma unroll
            for (int m = 0; m < 4; ++m) { bf16_t* rowp = O + (size_t)(row0 + ai * 128 + m * 16) * ldc + col0;
#pragma unroll
                for (int bj = 0; bj < 2; ++bj) { f32x4 v0 = acc[ai][bj][m][0], v1 = acc[ai][bj][m][1];
#pragma unroll
                    for (int j = 0; j < 4; ++j) { const float a = fmaxf(v0[j], 0.f), b = fmaxf(v1[j], 0.f); v0[j] = a * a; v1[j] = b * b; }
                    u32x4 w; w.x = pk2(v0[0], v0[1]); w.y = pk2(v0[2], v0[3]); w.z = pk2(v1[0], v1[1]); w.w = pk2(v1[2], v1[3]);
                    *(u32x4*)(rowp + bj * 128) = w; } }
    }
};
struct EpiResid {
    static constexpr bool PERM = false;
    float* XS; const float* gate; float scale;
    __device__ __forceinline__ void operator()(const f32x4 (&acc)[2][2][4][2], const pg8::Unit& u, int wr, int wc, int fr, int fq) const {
        const int row0 = u.pm * 256 + wr * 64 + fr, col0 = u.pn * 256 + wc * 32 + 4 * fq;
        const int cond = (u.pm % 17 == 0) ? 2 : (u.pm / 17);
        const float* gp = gate + (size_t)cond * MODW + col0;
        f32x4 gv[2][2];
#pragma unroll
        for (int bj = 0; bj < 2; ++bj)
#pragma unroll
            for (int n = 0; n < 2; ++n) gv[bj][n] = *(const f32x4*)(gp + bj * 128 + n * 16) * scale;
#pragma unroll
        for (int ai = 0; ai < 2; ++ai)
#pragma unroll
            for (int m = 0; m < 4; ++m) { float* rowp = XS + (size_t)(row0 + ai * 128 + m * 16) * DM + col0;
#pragma unroll
                for (int bj = 0; bj < 2; ++bj)
#pragma unroll
                    for (int n = 0; n < 2; ++n) { f32x4* p = (f32x4*)(rowp + bj * 128 + n * 16); *p = *p + gv[bj][n] * acc[ai][bj][m][n]; } }
    }
};
struct EpiHG {
    static constexpr bool PERM = true;
    bf16_t* QVG; f16_t* LOGF; const float* lb;
    __device__ __forceinline__ void operator()(const f32x4 (&acc)[2][2][4][2], const pg8::Unit& u, int wr, int wc, int fr, int fq) const {
        const int row0 = u.pm * 256 + wr * 64 + fr; const int seg = u.pn >> 3; const int col0 = (u.pn & 7) * 256 + wc * 32 + 8 * fq;
        if (seg == 1 || seg == 2) {
            f16_t* base = LOGF + (size_t)(seg - 1) * MROWS * DM;
            f32x4 lbv[2][2];
#pragma unroll
            for (int bj = 0; bj < 2; ++bj)
#pragma unroll
                for (int n = 0; n < 2; ++n) lbv[bj][n] = *(const f32x4*)(lb + col0 + bj * 128 + 4 * n);
#pragma unroll
            for (int ai = 0; ai < 2; ++ai)
#pragma unroll
                for (int m = 0; m < 4; ++m) { f16_t* rowp = base + (size_t)(row0 + ai * 128 + m * 16) * DM + col0;
#pragma unroll
                    for (int bj = 0; bj < 2; ++bj) { f16x8 o;
#pragma unroll
                        for (int n = 0; n < 2; ++n) { const f32x4 v = acc[ai][bj][m][n];
#pragma unroll
                            for (int j = 0; j < 4; ++j) { const float l = lbv[bj][n][j]; o[4 * n + j] = (f16_t)__logf(l + (1.0f - l) * fsigmoid(v[j])); } }
                        *(f16x8*)(rowp + bj * 128) = o; } }
        } else {
            const int bi = seg - 2 + (seg == 0 ? 2 : 0);
            bf16_t* base = QVG + (size_t)bi * MROWS * DM;
            const bool act = (seg != 3);
#pragma unroll
            for (int ai = 0; ai < 2; ++ai)
#pragma unroll
                for (int m = 0; m < 4; ++m) { bf16_t* rowp = base + (size_t)(row0 + ai * 128 + m * 16) * DM + col0;
#pragma unroll
                    for (int bj = 0; bj < 2; ++bj) { f32x4 v0 = acc[ai][bj][m][0], v1 = acc[ai][bj][m][1];
                        if (act) {
#pragma unroll
                            for (int j = 0; j < 4; ++j) { v0[j] = v0[j] * fsigmoid(v0[j]); v1[j] = v1[j] * fsigmoid(v1[j]); } }
                        u32x4 w; w.x = pk2(v0[0], v0[1]); w.y = pk2(v0[2], v0[3]); w.z = pk2(v1[0], v1[1]); w.w = pk2(v1[2], v1[3]);
                        *(u32x4*)(rowp + bj * 128) = w; } }
        }
    }
};


namespace sg {
struct SGemm { const bf16_t* A; const bf16_t* Bt; int N, K, lda, ldb; };
__device__ __forceinline__ unsigned red_off(int w, int row, int col) { return (unsigned)((((w * 64 + row) * 16) + ((col >> 2) ^ (row & 15))) * 16); }
template <class Epi>
__device__ __forceinline__ void sgemm_phase(LAS unsigned char* lds, int tid, const SGemm& g, int nbig, const Epi& E) {
    const int G = gridDim.x, c = blockIdx.x, nsm = 8 * (g.N >> 6), r = nbig % G;
    int start, stride;
    if (r == 0) { start = (G % 8 == 0) ? (c % 8) * (G / 8) + c / 8 : c; stride = G; }
    else { start = c - r; stride = G - r; if (c < r) start = nsm; }
    const int w = __builtin_amdgcn_readfirstlane(tid >> 6), lane = tid & 63, fr = lane & 15, fq = lane >> 4;
    const int kw = g.K >> 3, nk2 = kw >> 6;
    bf16x8 xa[4][2], xb[4][2], ya[4][2], yb[4][2];
    const int voA = (fr * g.lda + w * kw + 16 * fq) * 2, voB = (fr * g.ldb + w * kw + 16 * fq) * 2;
    const int sAb = 16 * g.lda * 2, sBb = 16 * g.ldb * 2;
    __amdgpu_buffer_rsrc_t rA, rB;
#define SG_PTRS(su) do { const int mt_ = (su) & 7, nt_ = (su) >> 3; \
        rA = __builtin_amdgcn_make_buffer_rsrc((void*)(g.A + ((size_t)(mt_ >> 2) * SROW + (mt_ & 3) * 64) * g.lda), 0, 64 * g.lda * 2, 0x00020000); \
        rB = __builtin_amdgcn_make_buffer_rsrc((void*)(g.Bt + (size_t)nt_ * 64 * g.ldb), 0, 64 * g.ldb * 2, 0x00020000); } while (0)
#define SG_LD1(r, vo, so) __builtin_bit_cast(bf16x8, __builtin_amdgcn_raw_buffer_load_b128(r, vo, so, 0))
#define SG_LOAD(a, b, k2) do { _Pragma("unroll") for (int i = 0; i < 4; ++i) { a[i][0] = SG_LD1(rA, voA, i * sAb + (k2) * 128); a[i][1] = SG_LD1(rA, voA, i * sAb + (k2) * 128 + 16); \
        b[i][0] = SG_LD1(rB, voB, i * sBb + (k2) * 128); b[i][1] = SG_LD1(rB, voB, i * sBb + (k2) * 128 + 16); } } while (0)
#define SG_MMA(a, b) do { _Pragma("unroll") for (int hh = 0; hh < 2; ++hh) _Pragma("unroll") for (int m = 0; m < 4; ++m) _Pragma("unroll") for (int n = 0; n < 4; ++n) \
        acc[m][n] = __builtin_amdgcn_mfma_f32_16x16x32_bf16(b[n][hh], a[m][hh], acc[m][n], 0, 0, 0); } while (0)
#define SG_SB __builtin_amdgcn_sched_barrier(0)
    if (start < nsm) { SG_PTRS(start); SG_LOAD(xa, xb, 0); }
    for (int su = start; su < nsm; su += stride) {
        f32x4 acc[4][4];
#pragma unroll
        for (int m = 0; m < 4; ++m)
#pragma unroll
            for (int n = 0; n < 4; ++n) acc[m][n] = (f32x4){0.f, 0.f, 0.f, 0.f};
        if (nk2 > 1) SG_LOAD(ya, yb, 1);
        SG_SB;
        for (int k2 = 0; k2 < nk2; k2 += 2) {
            SG_MMA(xa, xb); SG_SB; if (k2 + 2 < nk2) SG_LOAD(xa, xb, k2 + 2); SG_SB;
            if (k2 + 1 < nk2) { SG_MMA(ya, yb); SG_SB; if (k2 + 3 < nk2) SG_LOAD(ya, yb, k2 + 3); SG_SB; }
        }
        if (su + stride < nsm) { SG_PTRS(su + stride); SG_LOAD(xa, xb, 0); }
        SG_SB;
        __syncthreads();
#pragma unroll
        for (int m = 0; m < 4; ++m)
#pragma unroll
            for (int n = 0; n < 4; ++n) *(LAS f32x4*)(lds + red_off(w, 16 * m + fr, 16 * n + 4 * fq)) = acc[m][n];
        __syncthreads();
        const int row = tid >> 3, c8 = (tid & 7) * 8;
        f32x4 s0 = {0.f, 0.f, 0.f, 0.f}, s1 = {0.f, 0.f, 0.f, 0.f};
#pragma unroll
        for (int ww = 0; ww < 8; ++ww) { s0 += *(const LAS f32x4*)(lds + red_off(ww, row, c8)); s1 += *(const LAS f32x4*)(lds + red_off(ww, row, c8 + 4)); }
        float v[8] = {s0.x, s0.y, s0.z, s0.w, s1.x, s1.y, s1.z, s1.w};
        const int mt = su & 7, nt = su >> 3;
        E((size_t)(mt >> 2) * SROW + (mt & 3) * 64 + row, nt * 64 + c8, v);
    }
#undef SG_SB
#undef SG_LOAD
#undef SG_MMA
#undef SG_PTRS
#undef SG_LD1
    __syncthreads();
}
}
__device__ __forceinline__ void st_bf16x8(bf16_t* p, const float (&v)[8]) { u32x4 w; w.x = pk2(v[0], v[1]); w.y = pk2(v[2], v[3]); w.z = pk2(v[4], v[5]); w.w = pk2(v[6], v[7]); *(u32x4*)p = w; }
struct SEpiPlain { bf16_t* O; int ldc;
    __device__ __forceinline__ void operator()(size_t R, int col, const float (&v)[8]) const { st_bf16x8(O + R * ldc + col, v); } };
struct SEpiRowScale { bf16_t* O; int ldc; const float* rs;
    __device__ __forceinline__ void operator()(size_t R, int col, const float (&v)[8]) const { const float s = rs[R]; float o[8];
#pragma unroll
        for (int j = 0; j < 8; ++j) o[j] = v[j] * s;
        st_bf16x8(O + R * ldc + col, o); } };
struct SEpiRelu2 { bf16_t* O; int ldc;
    __device__ __forceinline__ void operator()(size_t R, int col, const float (&v)[8]) const { float o[8];
#pragma unroll
        for (int j = 0; j < 8; ++j) { const float a = fmaxf(v[j], 0.f); o[j] = a * a; }
        st_bf16x8(O + R * ldc + col, o); } };
struct SEpiResid { float* XS; const float* gate; float scale;
    __device__ __forceinline__ void operator()(size_t R, int col, const float (&v)[8]) const { const float* gp = gate + (size_t)2 * MODW + col; float* xp = XS + R * DM + col;
        const f32x4 g0 = *(const f32x4*)gp * scale, g1 = *(const f32x4*)(gp + 4) * scale; f32x4 x0 = *(f32x4*)xp, x1 = *(f32x4*)(xp + 4);
        x0 += g0 * (f32x4){v[0], v[1], v[2], v[3]}; x1 += g1 * (f32x4){v[4], v[5], v[6], v[7]}; *(f32x4*)xp = x0; *(f32x4*)(xp + 4) = x1; } };
struct SEpiHG { bf16_t* QVG; f16_t* LOGF; const float* lb;
    __device__ __forceinline__ void operator()(size_t R, int col, const float (&v)[8]) const { const int seg = col >> 11, cs = col & 2047;
        if (seg == 1 || seg == 2) { f16_t* p = LOGF + (size_t)(seg - 1) * MROWS * DM + R * DM + cs; f16x8 o;
#pragma unroll
            for (int j = 0; j < 8; ++j) { const float l0 = lb[cs + j]; o[j] = (f16_t)__logf(l0 + (1.0f - l0) * fsigmoid(v[j])); }
            *(f16x8*)p = o; }
        else { const int bi = seg - 2 + (seg == 0 ? 2 : 0); float o[8];
#pragma unroll
            for (int j = 0; j < 8; ++j) o[j] = seg == 3 ? v[j] : v[j] * fsigmoid(v[j]);
            st_bf16x8(QVG + (size_t)bi * MROWS * DM + R * DM + cs, o); } } };

namespace att {
using s16x4  = __attribute__((ext_vector_type(4))) short;
using f32x16 = __attribute__((ext_vector_type(16))) float;
constexpr int NW = 8, QBLK = 32, KVBLK = 64;
constexpr float SCALE = ATTN_SCALE;
constexpr float THR = 8.f;
constexpr int SHM_V = KVBLK * 128 * 2, SHM_K = KVBLK * 128 * 2, SHM_KR = KVBLK * 64 * 2;
constexpr int OFF_V = 0, OFF_K = 2 * SHM_V, OFF_KR = OFF_K + 2 * SHM_K, OFF_WS = OFF_KR + 2 * SHM_KR, SHM_ATTN = OFF_WS + NW * 64 * 4;
constexpr int LDQ = QW, LDK = KVW, LDO = DM;
#define KSWZ(row, colB) ((row) * 256 + ((colB) ^ (((row) & 7) << 4)))
#define RSWZ(row, colB) ((row) * 128 + ((colB) ^ ((((row) >> 1) & 7) << 4)))
#define SBAR() __builtin_amdgcn_sched_barrier(0)
__device__ __forceinline__ int crow(int r, int hi) { return (r & 3) + 8 * (r >> 2) + 4 * hi; }
__device__ __forceinline__ unsigned cvtpk(float lo, float hi) { unsigned r; asm volatile("v_cvt_pk_bf16_f32 %0, %1, %2" : "=v"(r) : "v"(lo), "v"(hi)); return r; }
__device__ __forceinline__ bf16x8 ld8(const bf16_t* p) { return *reinterpret_cast<const bf16x8*>(p); }
__device__ __forceinline__ void partialSM(f32x16& p0, f32x16& p1, float& m_reg, float& mn, float& alpha) {
  constexpr float C = SCALE * 1.4426950408889634f;
  float pmax = p0[0];
#pragma unroll
  for (int r = 1; r < 16; ++r) pmax = fmaxf(pmax, p0[r]);
#pragma unroll
  for (int r = 0; r < 16; ++r) pmax = fmaxf(pmax, p1[r]);
  { auto rr = __builtin_amdgcn_permlane32_swap(__float_as_uint(pmax), __float_as_uint(pmax), false, false);
    pmax = fmaxf(__uint_as_float(rr[0]), __uint_as_float(rr[1])); }
  if (__builtin_expect(__all(pmax - m_reg <= THR / SCALE), 1)) { mn = m_reg; alpha = 1.f; }
  else { mn = fmaxf(m_reg, pmax); alpha = __builtin_amdgcn_exp2f((m_reg - mn) * C); m_reg = mn; }
  float mnC = -mn * C;
#pragma unroll
  for (int r = 0; r < 16; ++r) p0[r] = fmaf(p0[r], C, mnC);
#pragma unroll
  for (int r = 0; r < 16; ++r) p1[r] = fmaf(p1[r], C, mnC);
#pragma unroll
  for (int r = 0; r < 16; ++r) p0[r] = __builtin_amdgcn_exp2f(p0[r]);
}
__device__ __forceinline__ void finishSM(f32x16& p0, f32x16& p1, float alpha, float& l_reg, bf16x8& pa0, bf16x8& pa1, bf16x8& pa2, bf16x8& pa3) {
#pragma unroll
  for (int r = 0; r < 16; ++r) p1[r] = __builtin_amdgcn_exp2f(p1[r]);
  float ps = 0;
#pragma unroll
  for (int r = 0; r < 16; ++r) ps += p0[r];
#pragma unroll
  for (int r = 0; r < 16; ++r) ps += p1[r];
  { auto rr = __builtin_amdgcn_permlane32_swap(__float_as_uint(ps), __float_as_uint(ps), false, false);
    ps = __uint_as_float(rr[0]) + __uint_as_float(rr[1]); }
  l_reg = l_reg * alpha + ps;
#define PK4(P, BASE, OUT) do { unsigned a0 = cvtpk(P[BASE + 0], P[BASE + 1]), a1 = cvtpk(P[BASE + 2], P[BASE + 3]);   \
    unsigned b0 = cvtpk(P[BASE + 4], P[BASE + 5]), b1 = cvtpk(P[BASE + 6], P[BASE + 7]);                              \
    auto r0 = __builtin_amdgcn_permlane32_swap(a0, b0, false, false); auto r1 = __builtin_amdgcn_permlane32_swap(a1, b1, false, false); \
    u32x4 w = {r0[0], r1[0], r0[1], r1[1]}; OUT = *reinterpret_cast<bf16x8*>(&w); } while (0)
  PK4(p0, 0, pa0); PK4(p0, 8, pa1); PK4(p1, 0, pa2); PK4(p1, 8, pa3);
#undef PK4
}
__device__ __forceinline__ void qkt(f32x16& p0, f32x16& p1, const char* Ks, const char* Krs, const bf16x8* qr, int r32, int hi) {
  p0 = f32x16{}; p1 = f32x16{};
#pragma unroll
  for (int d0 = 0; d0 < 8; ++d0) { int cb = (d0 * 16 + hi * 8) * 2;
    bf16x8 b0 = *reinterpret_cast<const bf16x8*>(Ks + KSWZ(r32, cb));
    bf16x8 b1 = *reinterpret_cast<const bf16x8*>(Ks + KSWZ(32 + r32, cb));
    p0 = __builtin_amdgcn_mfma_f32_32x32x16_bf16(b0, qr[d0], p0, 0, 0, 0);
    p1 = __builtin_amdgcn_mfma_f32_32x32x16_bf16(b1, qr[d0], p1, 0, 0, 0); }
#pragma unroll
  for (int d0 = 0; d0 < 4; ++d0) { int cb = (d0 * 16 + hi * 8) * 2;
    bf16x8 b0 = *reinterpret_cast<const bf16x8*>(Krs + RSWZ(r32, cb));
    bf16x8 b1 = *reinterpret_cast<const bf16x8*>(Krs + RSWZ(32 + r32, cb));
    p0 = __builtin_amdgcn_mfma_f32_32x32x16_bf16(b0, qr[8 + d0], p0, 0, 0, 0);
    p1 = __builtin_amdgcn_mfma_f32_32x32x16_bf16(b1, qr[8 + d0], p1, 0, 0, 0); }
}
__device__ __forceinline__ int v_st(int k, int c) { const int kk = (k & ~0xC) | ((k & 4) << 1) | ((k & 8) >> 1); return ((kk >> 3) * 4 + (c >> 5)) * 512 + ((kk & 7) * 32 + (c & 31)) * 2; }
__device__ __forceinline__ int v_rd_base(int lane) { return ((lane & 3) << 3) | (((lane >> 2) & 3) << 6) | (((lane >> 4) & 1) << 5) | (((lane >> 5) & 1) << 8); }
constexpr int v_rd_off(int d0, int ks, int half) { return d0 * 512 + ks * 4096 + half * 2048; }
template <int OFF> __device__ __forceinline__ s16x4 tr_read(int vb) {
  s16x4 r; asm volatile("ds_read_b64_tr_b16 %0, %1 offset:%2" : "=&v"(r) : "v"(vb), "i"(OFF) : "memory"); return r;
}
template <int D0> __device__ __forceinline__ void pv_one(f32x16& od, int vb, bf16x8 pa0, bf16x8 pa1, bf16x8 pa2, bf16x8 pa3) {
  const s16x4 l0 = tr_read<v_rd_off(D0, 0, 0)>(vb), h0 = tr_read<v_rd_off(D0, 0, 1)>(vb), l1 = tr_read<v_rd_off(D0, 1, 0)>(vb), h1 = tr_read<v_rd_off(D0, 1, 1)>(vb);
  const s16x4 l2 = tr_read<v_rd_off(D0, 2, 0)>(vb), h2 = tr_read<v_rd_off(D0, 2, 1)>(vb), l3 = tr_read<v_rd_off(D0, 3, 0)>(vb), h3 = tr_read<v_rd_off(D0, 3, 1)>(vb);
  asm volatile("s_waitcnt lgkmcnt(0)" ::: "memory"); SBAR();
#define PK(L, H) (bf16x8){L[0], L[1], L[2], L[3], H[0], H[1], H[2], H[3]}
  od = __builtin_amdgcn_mfma_f32_32x32x16_bf16(pa0, PK(l0, h0), od, 0, 0, 0);
  od = __builtin_amdgcn_mfma_f32_32x32x16_bf16(pa1, PK(l1, h1), od, 0, 0, 0);
  od = __builtin_amdgcn_mfma_f32_32x32x16_bf16(pa2, PK(l2, h2), od, 0, 0, 0);
  od = __builtin_amdgcn_mfma_f32_32x32x16_bf16(pa3, PK(l3, h3), od, 0, 0, 0);
#undef PK
}
__device__ __forceinline__ void pv_d0(f32x16* o, int vb, bf16x8 pa0, bf16x8 pa1, bf16x8 pa2, bf16x8 pa3) {
  pv_one<0>(o[0], vb, pa0, pa1, pa2, pa3); pv_one<1>(o[1], vb, pa0, pa1, pa2, pa3); pv_one<2>(o[2], vb, pa0, pa1, pa2, pa3); pv_one<3>(o[3], vb, pa0, pa1, pa2, pa3);
}
__device__ __forceinline__ void attn_body(const bf16_t* __restrict__ Qb, const bf16_t* __restrict__ Kh, const bf16_t* __restrict__ KRb,
                                          bf16_t* __restrict__ Ob, int seq, int tq0, const float* __restrict__ RC, const float* __restrict__ RS, char* lds, int tid) {
  const bf16_t* Vh = Kh + 128;
  const int wid = tid >> 6, lane = tid & 63, r32 = lane & 31, hi = lane >> 5;
  char* V_lds = lds + OFF_V; char* K_lds = lds + OFF_K; char* KR_lds = lds + OFF_KR;
  float* ws = (float*)(lds + OFF_WS) + wid * 64; float* li_l = ws; float* al_l = ws + 32;
  float m_reg = -1e30f, l_reg = 0; f32x16 o[4] = {}; bf16x8 qr[12];
  const bf16_t* Qw = Qb + (long)(wid * QBLK + r32) * LDQ + hi * 8;
#pragma unroll
  for (int d0 = 0; d0 < 12; ++d0) qr[d0] = ld8(Qw + d0 * 16);
  if (tq0 >= 0) {
    const int t = tq0 + wid * QBLK + r32; const int pr = (t >> 6) * 16 + hi * 8, pc = (t & 63) * 16 + hi * 8;
#pragma unroll
    for (int j = 0; j < 8; ++j) {
      { const float c = RC[pr + j], sn = RS[pr + j]; const float x0 = bf2f((bf16_t)qr[8][j]), x1 = bf2f((bf16_t)qr[9][j]);
        qr[8][j] = (short)f2bf(x0 * c - x1 * sn); qr[9][j] = (short)f2bf(x1 * c + x0 * sn); }
      { const float c = RC[pc + j], sn = RS[pc + j]; const float x0 = bf2f((bf16_t)qr[10][j]), x1 = bf2f((bf16_t)qr[11][j]);
        qr[10][j] = (short)f2bf(x0 * c - x1 * sn); qr[11][j] = (short)f2bf(x1 * c + x0 * sn); }
    }
  }
  const int sr = tid >> 4, sc = (tid & 15) * 8, vst0 = v_st(sr, sc), vst1 = v_st(32 + sr, sc);
  const int rr = tid >> 3, rc = (tid & 7) * 8;
  const int vb0 = (int)(uintptr_t)V_lds + v_rd_base(lane);
  bf16x8 vs0, vs1, ks0, ks1, krs;
#define SLOAD(k0) do { vs0 = ld8(&Vh[(long)((k0) + sr) * LDK + sc]); vs1 = ld8(&Vh[(long)((k0) + 32 + sr) * LDK + sc]); \
    ks0 = ld8(&Kh[(long)((k0) + sr) * LDK + sc]); ks1 = ld8(&Kh[(long)((k0) + 32 + sr) * LDK + sc]); krs = ld8(&KRb[(long)((k0) + rr) * 64 + rc]); } while (0)
#define SWRITE(b) do { *(bf16x8*)(V_lds + (b) * SHM_V + vst0) = vs0; *(bf16x8*)(V_lds + (b) * SHM_V + vst1) = vs1; int kc = sc * 2;   \
    *(bf16x8*)(K_lds + (b) * SHM_K + KSWZ(sr, kc)) = ks0; *(bf16x8*)(K_lds + (b) * SHM_K + KSWZ(32 + sr, kc)) = ks1;                    \
    *(bf16x8*)(KR_lds + (b) * SHM_KR + RSWZ(rr, rc * 2)) = krs; } while (0)
#define SWAIT() asm volatile("s_waitcnt vmcnt(0)" ::: "memory")
#define RESC(a) do { if (__any((a) < 1.f)) { if (hi == 0) al_l[r32] = (a); asm volatile("s_waitcnt lgkmcnt(0)" ::: "memory"); \
    _Pragma("unroll") for (int d = 0; d < 4; ++d) _Pragma("unroll") for (int r = 0; r < 16; ++r) o[d][r] *= al_l[crow(r, hi)]; } } while (0)
  f32x16 p0, p1; float mn, al; bf16x8 pa0, pa1, pa2, pa3; const int NT = seq / KVBLK;
  SLOAD(0); SWAIT(); SWRITE(0); __syncthreads();
  SLOAD(KVBLK);
  for (int j = 0; j < NT; ++j) {
    const int buf = j & 1;
    SBAR(); qkt(p0, p1, K_lds + buf * SHM_K, KR_lds + buf * SHM_KR, qr, r32, hi);
    partialSM(p0, p1, m_reg, mn, al); RESC(al);
    finishSM(p0, p1, al, l_reg, pa0, pa1, pa2, pa3); SBAR();
    if (j + 1 < NT) { SWAIT(); SWRITE(buf ^ 1); }
    if (j + 2 < NT) SLOAD((j + 2) * KVBLK);
    SBAR();
    pv_d0(o, vb0 + buf * SHM_V, pa0, pa1, pa2, pa3);
    __syncthreads();
  }
  if (hi == 0) li_l[r32] = l_reg; asm volatile("s_waitcnt lgkmcnt(0)" ::: "memory");
  float rli[16];
#pragma unroll
  for (int r = 0; r < 16; ++r) rli[r] = __builtin_amdgcn_rcpf(li_l[crow(r, hi)]);
  bf16_t* Ow = Ob + (long)(wid * QBLK) * LDO;
#pragma unroll
  for (int r = 0; r < 16; ++r) { int orow = crow(r, hi);
#pragma unroll
    for (int d0 = 0; d0 < 4; ++d0) Ow[(long)orow * LDO + d0 * 32 + r32] = (bf16_t)f2bf(o[d0][r] * rli[r]); }
#undef SLOAD
#undef SWRITE
#undef SWAIT
#undef RESC
}
}

typedef const float* cfp_t;
typedef const __attribute__((address_space(4))) cfp_t* InPtr;
struct Ctx {
    LAS unsigned char* lds; int tid, lane, wave, gw, ngw, gtid, ngt;
    InPtr in; float* out; unsigned char* ws;
    __device__ __forceinline__ const float* inp(int i) const { return (const float*)(const GAS float*)in[i]; }
};
#define WSP(T, off) ((T*)(C.ws + (off)))

__device__ __forceinline__ void tr_item(const float* W, int K, int N, bf16_t* WT, const float* sck, LAS float* scr, int item, int lane) {
    const int nblk = N / 64, kb = item / nblk, nb = item % nblk, k0 = 64 * kb, n0 = 64 * nb;
    f32x4 v[16];
#pragma unroll
    for (int i = 0; i < 16; ++i) v[i] = *(const f32x4*)(W + (size_t)(k0 + 4 * i + (lane >> 4)) * N + n0 + 4 * (lane & 15));
#pragma unroll
    for (int i = 0; i < 16; ++i) { const int kk = 4 * i + (lane >> 4); f32x4 x = v[i]; if (sck) x *= sck[k0 + kk]; LAS float* d = scr + kk * 65 + 4 * (lane & 15); d[0] = x.x; d[1] = x.y; d[2] = x.z; d[3] = x.w; }
    asm volatile("s_waitcnt lgkmcnt(0)" ::: "memory"); __builtin_amdgcn_wave_barrier();
    const int nl = lane & 7, kc = lane >> 3;
#pragma unroll
    for (int j = 0; j < 8; ++j) { const int n = 8 * j + nl; const LAS float* sp = scr + (8 * kc) * 65 + n;
        u32x4 o; o.x = pk2(sp[0 * 65], sp[1 * 65]); o.y = pk2(sp[2 * 65], sp[3 * 65]); o.z = pk2(sp[4 * 65], sp[5 * 65]); o.w = pk2(sp[6 * 65], sp[7 * 65]);
        *(u32x4*)(WT + (size_t)(n0 + n) * K + k0 + 8 * kc) = o; }
    asm volatile("s_waitcnt lgkmcnt(0)" ::: "memory"); __builtin_amdgcn_wave_barrier();
}
__device__ __forceinline__ void tr_matrix(const Ctx& C, const float* W, int K, int N, bf16_t* WT, const float* sck) {
    LAS float* scr = (LAS float*)(C.lds + C.wave * 16640);
    const int cnt = (K / 64) * (N / 64);
    for (int it = C.gw; it < cnt; it += C.ngw) tr_item(W, K, N, WT, sck, scr, it, C.lane);
}
__device__ __forceinline__ void sincos_d(double x, double& s, double& c) {
    const double twopi = 6.283185307179586476925286766559;
    const double k = __builtin_rint(x / twopi); const double y = x - k * twopi; const double y2 = y * y;
    double ts = y, ss = y, tc = 1.0, sc = 1.0;
#pragma unroll
    for (int n = 1; n <= 16; ++n) { tc *= -y2 / (double)((2 * n - 1) * (2 * n)); sc += tc; ts *= -y2 / (double)((2 * n) * (2 * n + 1)); ss += ts; }
    s = ss; c = sc;
}
__device__ __forceinline__ void phase_prologue(const Ctx& C) {
#pragma unroll 1
    for (int e = 0; e < 2; ++e) {
        tr_matrix(C, C.inp(8) + (size_t)e * DM * ABN, DM, ABN, WSP(bf16_t, WS_WABIN) + (size_t)e * ABNP * DM, nullptr);
        tr_matrix(C, C.inp(9) + (size_t)e * DM * DM, DM, DM, WSP(bf16_t, WS_WABOUT) + (size_t)e * DM * DM, nullptr);
        tr_matrix(C, C.inp(18) + (size_t)e * 512 * QW, 512, QW, WSP(bf16_t, WS_WUQ) + (size_t)e * QW * 512, C.inp(17) + e * 512);
        tr_matrix(C, C.inp(20) + (size_t)e * 512 * KVW, 512, KVW, WSP(bf16_t, WS_WUKV) + (size_t)e * KVW * 512, C.inp(19) + e * 512);
        tr_matrix(C, C.inp(21) + (size_t)e * DM * HGN, DM, HGN, WSP(bf16_t, WS_WHGIN) + (size_t)e * HGN * DM, nullptr);
        tr_matrix(C, C.inp(24) + (size_t)e * DM * DM, DM, DM, WSP(bf16_t, WS_WHGOUT) + (size_t)e * DM * DM, nullptr);
#pragma unroll 1
        for (int dg = 0; dg < 4; ++dg) { const int dir = dg >> 1, gate = dg & 1;
            tr_matrix(C, C.inp(gate ? 14 : 12) + ((size_t)e * 2 + dir) * 8 * 128 * 128, 1024, 128, WSP(bf16_t, WS_WG) + ((size_t)e * 4 + dg) * 128 * 1024, nullptr); }
    }
#pragma unroll 1
    for (int l = 0; l < 4; ++l) {
        tr_matrix(C, C.inp(25) + (size_t)l * DM * DFF, DM, DFF, WSP(bf16_t, WS_W1) + (size_t)l * DFF * DM, nullptr);
        tr_matrix(C, C.inp(26) + (size_t)l * DFF * DM, DFF, DM, WSP(bf16_t, WS_W2) + (size_t)l * DM * DFF, nullptr);
    }
    for (int e = 0; e < 2; ++e) { u32x4* z = (u32x4*)(WSP(bf16_t, WS_WABIN) + (size_t)e * ABNP * DM + (size_t)ABN * DM);
        for (int i = C.gtid; i < (ABNP - ABN) * DM / 8; i += C.ngt) z[i] = (u32x4){0u, 0u, 0u, 0u}; }
    { float* XS = WSP(float, WS_XS);
      for (int i = C.gtid; i < MROWS * (DM / 4); i += C.ngt) { const int R = i / (DM / 4), c4 = i % (DM / 4); const int b = R / SROW, s = R % SROW;
          const float* src = s < CTX ? C.inp(2) + ((size_t)(b * CTX + s)) * DM : C.inp(0) + ((size_t)(b * SEQ + (s - CTX))) * DM;
          ((f32x4*)(XS + (size_t)R * DM))[c4] = ((const f32x4*)src)[c4]; } }
    { float* LB = WSP(float, WS_LB);
      for (int i = C.gtid; i < 2048; i += C.ngt) { float v[4], mx = -1e30f; for (int l = 0; l < 4; ++l) { v[l] = C.inp(22)[l * 2048 + i]; mx = fmaxf(mx, v[l]); }
          float sum = 0.f; for (int l = 0; l < 4; ++l) { v[l] = expf(v[l] - mx); sum += v[l]; }
          float cum = 0.f; const float p0 = v[0] / sum; for (int l = 0; l < 4; ++l) { cum += v[l] / sum; LB[l * 2048 + i] = cum - p0; } }
      float* RC = WSP(float, WS_ROPE); float* RS = RC + 1024;
      for (int i = C.gtid; i < 1024; i += C.ngt) { const int pos = i / 16, j = i % 16; double inv = 1.0; for (int q = 0; q < j; ++q) inv *= 0.56234132519034908;
          const float ang = (float)pos * (float)inv; double s, c; sincos_d((double)ang, s, c); RC[i] = (float)c; RS[i] = (float)s; } }
    { LAS float* sl = (LAS float*)C.lds;
      LAS float* red = sl + 3 * 2048;
      __syncthreads();
      for (int i = C.tid; i < 3 * 2048; i += 512) { const int r = i / 2048, d = i % 2048; const float v = r < 2 ? C.inp(1)[r * 2048 + d] : C.inp(3)[d]; sl[i] = siluf_(v); }
      __syncthreads();
      float* MOD = WSP(float, WS_MOD);
      const int kq = C.tid >> 4, cq = C.tid & 15;
      for (int u = blockIdx.x; u < 4 * (MODW / 64); u += gridDim.x) { const int l = u / (MODW / 64), e0 = (u % (MODW / 64)) * 64;
          const float* w = C.inp(4) + (size_t)l * DM * MODW + e0 + 4 * cq;
          f32x4 a0 = {0, 0, 0, 0}, a1 = {0, 0, 0, 0}, a2 = {0, 0, 0, 0};
#pragma unroll 8
          for (int d = kq; d < DM; d += 32) { const f32x4 wv = *(const f32x4*)(w + (size_t)d * MODW); a0 += wv * sl[d]; a1 += wv * sl[2048 + d]; a2 += wv * sl[4096 + d]; }
#pragma unroll
          for (int j = 0; j < 4; ++j) { red[(kq * 3 + 0) * 64 + 4 * cq + j] = a0[j]; red[(kq * 3 + 1) * 64 + 4 * cq + j] = a1[j]; red[(kq * 3 + 2) * 64 + 4 * cq + j] = a2[j]; }
          __syncthreads();
          if (C.tid < 192) { const int r = C.tid / 64, c = C.tid % 64; float s = 0.f; for (int q = 0; q < 32; ++q) s += red[(q * 3 + r) * 64 + c];
              MOD[((size_t)l * 3 + r) * MODW + e0 + c] = s + C.inp(5)[l * MODW + e0 + c]; }
          __syncthreads(); } }
}

__device__ __forceinline__ void phase_norm_mod(const Ctx& C, const float* w, const float* mod, int sh_idx, int sc_idx) {
    const float* XS = WSP(float, WS_XS); bf16_t* H = WSP(bf16_t, WS_H);
    for (int R = C.gw; R < MROWS; R += C.ngw) {
        const int s = R % SROW, b = R / SROW, cond = s < CTX ? 2 : b;
        const float* shift = mod + (size_t)cond * MODW + sh_idx * DM; const float* scale = mod + (size_t)cond * MODW + sc_idx * DM;
        const f32x4* xr = (const f32x4*)(XS + (size_t)R * DM) + C.lane;
        f32x4 v[8]; float ss = 0.f;
#pragma unroll
        for (int j = 0; j < 8; ++j) { v[j] = xr[64 * j]; ss += (v[j].x * v[j].x + v[j].y * v[j].y) + (v[j].z * v[j].z + v[j].w * v[j].w); }
        const float rstd = 1.0f / sqrtf(wave_sum(ss) * (1.0f / DM) + EPS);
        u32x2* o = (u32x2*)(H + (size_t)R * DM) + C.lane;
#pragma unroll
        for (int j = 0; j < 8; ++j) { const int c = (C.lane + 64 * j) * 4; const f32x4 wv = *(const f32x4*)(w + c), sc = *(const f32x4*)(scale + c), sh = *(const f32x4*)(shift + c);
            const f32x4 y = (v[j] * rstd * wv) * (1.0f + sc) + sh; u32x2 pk; pk.x = pk2(y.x, y.y); pk.y = pk2(y.z, y.w); o[64 * j] = pk; }
    }
}

__device__ __forceinline__ void phase_rs_kr(const Ctx& C) {
    const bf16_t* P = WSP(bf16_t, WS_P);
    float* RSQ = WSP(float, WS_RSQ); float* RSKV = WSP(float, WS_RSKV);
    for (int R = C.gw; R < MROWS; R += C.ngw) {
        const u32x4 a = *(const u32x4*)(P + (size_t)R * ABNP + 2048 + 8 * C.lane), b = *(const u32x4*)(P + (size_t)R * ABNP + 2560 + 8 * C.lane);
        float sa = 0.f, sb = 0.f;
#pragma unroll
        for (int j = 0; j < 4; ++j) { const float a0 = __uint_as_float(a[j] << 16), a1 = __uint_as_float(a[j] & 0xffff0000u), b0 = __uint_as_float(b[j] << 16), b1 = __uint_as_float(b[j] & 0xffff0000u);
            sa += a0 * a0 + a1 * a1; sb += b0 * b0 + b1 * b1; }
        sa = wave_sum(sa); sb = wave_sum(sb);
        if (C.lane == 0) { RSQ[R] = 1.0f / sqrtf(sa * (1.0f / 512.0f) + EPS); RSKV[R] = 1.0f / sqrtf(sb * (1.0f / 512.0f) + EPS); } }
    bf16_t* KR = WSP(bf16_t, WS_KR); const float* RC = WSP(float, WS_ROPE); const float* RS = RC + 1024;
    for (int idx = C.gtid; idx < MROWS * 32; idx += C.ngt) { const int R = idx / 32, p = idx % 32, s = R % SROW; const int i0 = p < 16 ? p : 32 + (p - 16);
        const float x0 = bf2f(P[(size_t)R * ABNP + 3072 + i0]), x1 = bf2f(P[(size_t)R * ABNP + 3072 + i0 + 16]); float o0 = x0, o1 = x1;
        if (s >= CTX) { const int t = s - CTX, pos = p < 16 ? t / 64 : t % 64; const float c = RC[pos * 16 + (p & 15)], sn = RS[pos * 16 + (p & 15)]; o0 = x0 * c - x1 * sn; o1 = x1 * c + x0 * sn; }
        KR[(size_t)R * 64 + i0] = (bf16_t)f2bf(o0); KR[(size_t)R * 64 + i0 + 16] = (bf16_t)f2bf(o1); }
}

__device__ __forceinline__ void phase_attn(const Ctx& C) {
    const bf16_t* Q = WSP(bf16_t, WS_Q); const bf16_t* KV = WSP(bf16_t, WS_KV); const bf16_t* KR = WSP(bf16_t, WS_KR); bf16_t* Y = WSP(bf16_t, WS_Y);
    const float* RC = WSP(float, WS_ROPE); const float* RS = RC + 1024;
    const int G = gridDim.x, c = blockIdx.x;
    for (int u0 = c; u0 < 272; u0 += G) {
        int b, hh, s0, nk, tq0;
        if (u0 < 256) { int v = u0; if (G == 256) { const int x = c & 7, j = c >> 3; v = (x * 2 + (j >> 4)) * 16 + (j & 15); }
            const int p = v >> 4, qb = v & 15; b = p >> 3; hh = p & 7; s0 = CTX + qb * 256; nk = SROW; tq0 = qb * 256; }
        else { const int p = u0 - 256; b = p >> 3; hh = p & 7; s0 = 0; nk = CTX; tq0 = -1; }
        const size_t R0 = (size_t)b * SROW + s0, K0 = (size_t)b * SROW;
        __syncthreads();
        att::attn_body(Q + R0 * QW + hh * 192, KV + K0 * KVW + hh * 256, KR + K0 * 64, Y + R0 * DM + DLRU + hh * 128, nk, tq0, RC, RS, (char*)C.lds, C.tid);
    }
}
namespace hg {
using s16x4  = __attribute__((ext_vector_type(4))) short;
using f32x16 = __attribute__((ext_vector_type(16))) float;
constexpr int NCH = SROW / 64;
constexpr int NCHAIN = NBATCH * 16 * 2;
__device__ __forceinline__ unsigned off_b(unsigned row, unsigned ch) { return 256u * row + 16u * (ch ^ (((row & 3u) << 2) | ((row >> 2) & 3u))); }
__device__ __forceinline__ s16x4 trr(unsigned addr) { s16x4 r; asm volatile("ds_read_b64_tr_b16 %0, %1" : "=&v"(r) : "v"(addr) : "memory"); return r; }
__device__ __forceinline__ bf16x8 pk8(s16x4 L, s16x4 H) { return (bf16x8){L[0], L[1], L[2], L[3], H[0], H[1], H[2], H[3]}; }
__device__ __forceinline__ unsigned tr_nat(unsigned lane, unsigned c, unsigned ks, unsigned t) {
    const unsigned h = lane >> 5, blk = (lane >> 4) & 1, q = (lane & 15) >> 2, p = lane & 3;
    return off_b(16 * ks + 8 * h + 4 * t + q, 4 * c + 2 * blk + (p >> 1)) + 8 * (p & 1); }
__device__ __forceinline__ unsigned tr_perm(unsigned lane, unsigned c, unsigned rb, unsigned t) {
    const unsigned h = lane >> 5, blk = (lane >> 4) & 1, q = (lane & 15) >> 2, p = lane & 3;
    return off_b(rb + 4 * h + 8 * t + q, 4 * c + 2 * blk + (p >> 1)) + 8 * (p & 1); }
__device__ __forceinline__ unsigned row_rd(unsigned lane, unsigned rb, unsigned ks) { return off_b(rb + (lane & 31), 2 * ks + (lane >> 5)); }
__device__ __forceinline__ int crow(int r, int hi) { return (r & 3) + 8 * (r >> 2) + 4 * hi; }
#define HG_WAITL() do { asm volatile("s_waitcnt lgkmcnt(0)" ::: "memory"); __builtin_amdgcn_sched_barrier(0); } while (0)
}

__device__ __forceinline__ void phase_hg_state(const Ctx& C) {
    using namespace hg;
    LAS unsigned char* L = C.lds; const unsigned Lb = (unsigned)(uintptr_t)L;
    constexpr unsigned VT = 0, KP = 16384, TOT = 32768, DECV = 36864;
    const f16_t* LOGF = WSP(f16_t, WS_LOGF); const bf16_t* VH = WSP(bf16_t, WS_VH); bf16_t* SS = WSP(bf16_t, WS_SS);
    const int w = C.wave, lane = C.lane, tid = C.tid, h5 = lane >> 5, r32 = lane & 31;
    const int G = gridDim.x, c = blockIdx.x, v0 = (G % 8 == 0) ? (c % 8) * (G / 8) + c / 8 : c;
    for (int u = v0; u < NCHAIN * 4; u += G) {
        const int chain = u >> 2, sl = u & 3, dir = chain & 1, hh = (chain >> 1) & 15, b = chain >> 5;
        const f16_t* lfb = LOGF + (size_t)dir * MROWS * DM + ((size_t)b * SROW + 8 * w) * DM + hh * 128 + 2 * lane;
        const bf16_t* vb = VH + ((size_t)b * SROW + (tid >> 2)) * DM + hh * 128 + 32 * sl + 8 * (tid & 3);
        f32x16 S = {};
        f32x2 lfA[8], lfB[8]; u32x4 vA = {0u, 0u, 0u, 0u}, vB = {0u, 0u, 0u, 0u};
#define HS_CI(j) (dir == 0 ? (j) : ((j) < 4 ? 3 - (j) : 71 - (j)))
#define HS_LOAD(lf, vr, j) do { const int cn_ = HS_CI(j); _Pragma("unroll") for (int i = 0; i < 8; ++i) { const f16x2 t_ = *(const f16x2*)(lfb + (size_t)(cn_ * 64 + i) * DM); lf[i] = (f32x2){(float)t_.x, (float)t_.y}; } \
        if (tid < 256) vr = *(const u32x4*)(vb + (size_t)cn_ * 64 * DM); } while (0)
#define HS_STEP(lf, vr, j) do { const int ci = HS_CI(j); \
            f32x2 T = {0.f, 0.f}; \
            _Pragma("unroll") for (int i = 0; i < 8; ++i) T += lf[i]; \
            *(LAS f32x2*)(L + TOT + (w * 128 + 2 * lane) * 4) = T; \
            __syncthreads();                                          \
            if (tid < 256) *(LAS u32x4*)(L + VT + off_b(tid >> 2, 4 * sl + (tid & 3))) = vr; \
            f32x2 off = {0.f, 0.f}, total = {0.f, 0.f}; \
            _Pragma("unroll") for (int ww = 0; ww < 8; ++ww) { const f32x2 t = *(const LAS f32x2*)(L + TOT + (ww * 128 + 2 * lane) * 4); total += t; if (dir == 0 ? (ww > w) : (ww < w)) off += t; } \
            f32x2 E[8]; \
            if (dir == 0) { E[7] = off; _Pragma("unroll") for (int i = 6; i >= 0; --i) E[i] = E[i + 1] + lf[i + 1]; } \
            else { E[0] = off; _Pragma("unroll") for (int i = 1; i < 8; ++i) E[i] = E[i - 1] + lf[i - 1]; } \
            _Pragma("unroll") for (int i = 0; i < 8; ++i) { const float k0 = (1.0f - __expf(lf[i].x)) * __expf(E[i].x), k1 = (1.0f - __expf(lf[i].y)) * __expf(E[i].y); \
                *(LAS unsigned*)(L + KP + off_b(8 * w + i, lane >> 2) + (lane & 3) * 4) = pk2(k0, k1); } \
            if (w == 0) { f32x2 d; d.x = __expf(total.x); d.y = __expf(total.y); *(LAS f32x2*)(L + DECV + 2 * lane * 4) = d; } \
            if ((j) + 2 < NCH) HS_LOAD(lf, vr, (j) + 2); \
            __syncthreads(); \
            if (w < 4) {     \
                bf16_t* sp = SS + ((size_t)chain * NCH + ci) * 16384 + 32 * sl + r32; \
                s16x4 al[4], ah[4], bl[4], bh[4]; \
                _Pragma("unroll") for (int ks = 0; ks < 4; ++ks) { al[ks] = trr(Lb + KP + tr_nat(lane, w, ks, 0)); ah[ks] = trr(Lb + KP + tr_nat(lane, w, ks, 1)); \
                    bl[ks] = trr(Lb + VT + tr_nat(lane, sl, ks, 0)); bh[ks] = trr(Lb + VT + tr_nat(lane, sl, ks, 1)); } \
                _Pragma("unroll") for (int r = 0; r < 16; ++r) { const int dk = 32 * w + crow(r, h5); sp[dk * 128] = (bf16_t)f2bf(S[r]); S[r] *= *(const LAS float*)(L + DECV + dk * 4); } \
                HG_WAITL(); \
                _Pragma("unroll") for (int ks = 0; ks < 4; ++ks) S = __builtin_amdgcn_mfma_f32_32x32x16_bf16(pk8(al[ks], ah[ks]), pk8(bl[ks], bh[ks]), S, 0, 0, 0); \
            } } while (0)
        HS_LOAD(lfA, vA, 0); HS_LOAD(lfB, vB, 1);
        __syncthreads();
#pragma unroll 1
        for (int j = 0; j < NCH; j += 2) { HS_STEP(lfA, vA, j); HS_STEP(lfB, vB, j + 1); }
#undef HS_STEP
#undef HS_LOAD
#undef HS_CI
        __syncthreads();
    }
}
__device__ __forceinline__ void phase_hg_out(const Ctx& C, int o_idx) {
    using namespace hg;
    LAS unsigned char* L = C.lds; const unsigned Lb = (unsigned)(uintptr_t)L;
    constexpr unsigned VT = 0, QP = 16384, QM = 32768, KM = 49152, ST = 65536, TOT = 98304, RED = 102400;
    const f16_t* LOGF = WSP(f16_t, WS_LOGF); const bf16_t* VH = WSP(bf16_t, WS_VH); const bf16_t* QH = WSP(bf16_t, WS_QH); const bf16_t* GH = WSP(bf16_t, WS_GH);
    const bf16_t* SS = WSP(bf16_t, WS_SS); bf16_t* Y = WSP(bf16_t, WS_Y); const float* nw = C.inp(23) + o_idx * 128;
    const int w = C.wave, lane = C.lane, tid = C.tid, h5 = lane >> 5, r32 = lane & 31;
    const unsigned tt = w >> 2, dvt = w & 3;
    for (int u = blockIdx.x; u < NBATCH * 16 * NCH; u += gridDim.x) {
        const int b = u / (16 * NCH), hh = (u / NCH) % 16, ci = u % NCH; const size_t R0 = (size_t)b * SROW + ci * 64;
        __syncthreads();
        u32x4 vreg[2];
        f32x16 acc = {};
#pragma unroll 1
        for (int dir = 0; dir < 2; ++dir) {
            const int chain = (b * 16 + hh) * 2 + dir;
            const f16_t* lfp = LOGF + (size_t)dir * MROWS * DM + (R0 + 8 * w) * DM + hh * 128 + 2 * lane;
            const bf16_t* qp = QH + (R0 + 8 * w) * DM + hh * 128 + 2 * lane;
            f16x2 lfh[8]; unsigned qv[8]; u32x4 sreg[4];
#pragma unroll
            for (int i = 0; i < 8; ++i) { lfh[i] = *(const f16x2*)(lfp + (size_t)i * DM); qv[i] = *(const unsigned*)(qp + (size_t)i * DM); }
#pragma unroll
            for (int p = 0; p < 4; ++p) sreg[p] = *(const u32x4*)(SS + (((size_t)chain * NCH + ci) * 128 + (tid >> 4) + 32 * p) * 128 + (tid & 15) * 8);
            if (dir == 0) {
#pragma unroll
                for (int p = 0; p < 2; ++p) vreg[p] = *(const u32x4*)(VH + (R0 + (tid >> 4) + 32 * p) * DM + hh * 128 + (tid & 15) * 8); }
            f32x2 lf[8]; f32x2 T = {0.f, 0.f};
#pragma unroll
            for (int i = 0; i < 8; ++i) { lf[i] = (f32x2){(float)lfh[i].x, (float)lfh[i].y}; T += lf[i]; }
            *(LAS f32x2*)(L + TOT + (w * 128 + 2 * lane) * 4) = T;
            __syncthreads();
            f32x2 off = {0.f, 0.f}, mid = {0.f, 0.f};
#pragma unroll
            for (int ww = 0; ww < 8; ++ww) { const f32x2 t = *(const LAS f32x2*)(L + TOT + (ww * 128 + 2 * lane) * 4);
                if (dir == 0 ? (ww < w) : (ww > w)) off += t; if (dir == 0 ? (ww < 4) : (ww >= 4)) mid += t; }
            f32x2 B[8];
            if (dir == 0) { B[0] = off + lf[0];
#pragma unroll
                for (int i = 1; i < 8; ++i) B[i] = B[i - 1] + lf[i]; }
            else { B[7] = off + lf[7];
#pragma unroll
                for (int i = 6; i >= 0; --i) B[i] = B[i + 1] + lf[i]; }
#pragma unroll
            for (int i = 0; i < 8; ++i) { const float q0 = __uint_as_float(qv[i] << 16), q1 = __uint_as_float(qv[i] & 0xffff0000u);
                const float k0 = 1.0f - __expf(lf[i].x), k1 = 1.0f - __expf(lf[i].y);
                const unsigned a = off_b(8 * w + i, lane >> 2) + (lane & 3) * 4;
                *(LAS unsigned*)(L + QP + a) = pk2(q0 * __expf(B[i].x), q1 * __expf(B[i].y));
                *(LAS unsigned*)(L + QM + a) = pk2(q0 * __expf(B[i].x - mid.x), q1 * __expf(B[i].y - mid.y));
                *(LAS unsigned*)(L + KM + a) = pk2(k0 * __expf(mid.x - B[i].x), k1 * __expf(mid.y - B[i].y)); }
#pragma unroll
            for (int p = 0; p < 4; ++p) *(LAS u32x4*)(L + ST + off_b((tid >> 4) + 32 * p, tid & 15)) = sreg[p];
            if (dir == 0) {
#pragma unroll
                for (int p = 0; p < 2; ++p) *(LAS u32x4*)(L + VT + off_b((tid >> 4) + 32 * p, tid & 15)) = vreg[p]; }
            __syncthreads();
            { bf16x8 a[8]; s16x4 bl[8], bh[8];
#pragma unroll
              for (int ks = 0; ks < 8; ++ks) { a[ks] = *(const LAS bf16x8*)(L + QP + row_rd(lane, 32 * tt, ks)); bl[ks] = trr(Lb + ST + tr_nat(lane, dvt, ks, 0)); bh[ks] = trr(Lb + ST + tr_nat(lane, dvt, ks, 1)); }
              HG_WAITL();
#pragma unroll
              for (int ks = 0; ks < 8; ++ks) acc = __builtin_amdgcn_mfma_f32_32x32x16_bf16(a[ks], pk8(bl[ks], bh[ks]), acc, 0, 0, 0); }
            { bf16x8 qb[8];
#pragma unroll
              for (int ks = 0; ks < 8; ++ks) qb[ks] = *(const LAS bf16x8*)(L + QM + row_rd(lane, 32 * tt, ks));
#pragma unroll
              for (unsigned st = 0; st < 2; ++st) { const bool valid = dir == 0 ? (st <= tt) : (st >= tt);
                if (valid) {
                  f32x16 x = {};
#pragma unroll
                  for (int ks = 0; ks < 8; ++ks) { const bf16x8 ka = *(const LAS bf16x8*)(L + KM + row_rd(lane, 32 * st, ks)); x = __builtin_amdgcn_mfma_f32_32x32x16_bf16(ka, qb[ks], x, 0, 0, 0); }
                  if (st == tt) {
#pragma unroll
                    for (int r = 0; r < 16; ++r) { const int kr = crow(r, h5); const bool keep = dir == 0 ? (kr <= r32) : (kr >= r32); x[r] = keep ? x[r] : 0.f; } }
                  const s16x4 v0l = trr(Lb + VT + tr_perm(lane, dvt, 32 * st, 0)), v0h = trr(Lb + VT + tr_perm(lane, dvt, 32 * st, 1));
                  const s16x4 v1l = trr(Lb + VT + tr_perm(lane, dvt, 32 * st + 16, 0)), v1h = trr(Lb + VT + tr_perm(lane, dvt, 32 * st + 16, 1));
                  u32x4 A0, A1; A0.x = pk2(x[0], x[1]); A0.y = pk2(x[2], x[3]); A0.z = pk2(x[4], x[5]); A0.w = pk2(x[6], x[7]);
                  A1.x = pk2(x[8], x[9]); A1.y = pk2(x[10], x[11]); A1.z = pk2(x[12], x[13]); A1.w = pk2(x[14], x[15]);
                  HG_WAITL();
                  acc = __builtin_amdgcn_mfma_f32_32x32x16_bf16(*reinterpret_cast<bf16x8*>(&A0), pk8(v0l, v0h), acc, 0, 0, 0);
                  acc = __builtin_amdgcn_mfma_f32_32x32x16_bf16(*reinterpret_cast<bf16x8*>(&A1), pk8(v1l, v1h), acc, 0, 0, 0);
                } } }
        }
        LAS float* red = (LAS float*)(L + RED);
#pragma unroll
        for (int r = 0; r < 16; ++r) { float s = acc[r] * acc[r]; s += __shfl_xor(s, 1); s += __shfl_xor(s, 2); s += __shfl_xor(s, 4); s += __shfl_xor(s, 8); s += __shfl_xor(s, 16);
            if (r32 == 0) red[(tt * 32 + crow(r, h5)) * 4 + dvt] = s; }
        __syncthreads();
        const int col = hh * 128 + 32 * dvt + r32; const float wv = nw[32 * dvt + r32];
#pragma unroll
        for (int r = 0; r < 16; ++r) { const int row = 32 * tt + crow(r, h5); const f32x4 p = *(const LAS f32x4*)(red + row * 4);
            const float rstd = 1.0f / sqrtf(((p.x + p.y) + (p.z + p.w)) * (1.0f / 128.0f) + EPS); const size_t o = (R0 + row) * DM + col;
            Y[o] = (bf16_t)f2bf(acc[r] * rstd * wv * bf2f(GH[o])); }
    }
}
template <bool FINAL>
__device__ __forceinline__ void phase_lru(const Ctx& C, int e) {
    using namespace hg;
    LAS unsigned char* L = C.lds;
    constexpr unsigned UCB = 0, UCF = 16384, AT = 49152, BT = 81920, SEGB = 114688;
    const bf16_t* P = WSP(bf16_t, WS_P); float* AG = WSP(float, WS_AG); const float* CARRY = WSP(float, WS_CARRY); bf16_t* Y = WSP(bf16_t, WS_Y);
    const bf16_t* WG = WSP(bf16_t, WS_WG) + (size_t)e * 4 * 128 * 1024;
    const float* cw = C.inp(10) + (size_t)e * 4 * DLRU; const float* cb = C.inp(11) + (size_t)e * DLRU;
    const float* ba = C.inp(13) + (size_t)e * 2 * DLRU; const float* bx = C.inp(15) + (size_t)e * 2 * DLRU; const float* lam = C.inp(16) + (size_t)e * 2 * DLRU;
    const int w = C.wave, lane = C.lane, tid = C.tid, h5 = lane >> 5, r32 = lane & 31;
    const unsigned rt = w >> 2, et = w & 3;
    for (int u = gridDim.x - 1 - blockIdx.x; u < (MROWS / 64) * 8; u += gridDim.x) {
        const int ci2 = u >> 3, hd = u & 7; const int c = ci2 % NCH, bb = ci2 / NCH; const size_t R0 = (size_t)ci2 * 64;
        const int s0 = c * 64, lo = c < 4 ? 0 : CTX, hi = c < 4 ? CTX : SROW;
        __syncthreads();
        float cin0 = 0.f, cin1 = 0.f;
        if (FINAL) { const int ch = tid & 127; cin0 = CARRY[(size_t)(ci2 * 2 + 0) * DLRU + hd * 128 + ch]; cin1 = CARRY[(size_t)(ci2 * 2 + 1) * DLRU + hd * 128 + ch]; }
        { const int chn = hd * 128 + 2 * lane; const bf16_t* up = P + DLRU + chn;
          f32x2 uv[11];
#pragma unroll
          for (int i = 0; i < 11; ++i) { const int s = s0 + 8 * w + i - 2; unsigned raw = 0u; if (s >= lo && s < hi) raw = *(const unsigned*)(up + ((size_t)bb * SROW + s) * ABNP);
              uv[i].x = __uint_as_float(raw << 16); uv[i].y = __uint_as_float(raw & 0xffff0000u); }
          f32x2 wj[4];
#pragma unroll
          for (int j = 0; j < 4; ++j) wj[j] = *(const f32x2*)(cw + j * DLRU + chn);
          const f32x2 bias = *(const f32x2*)(cb + chn);
#pragma unroll
          for (int i = 0; i < 8; ++i) { f32x2 a = bias;
#pragma unroll
              for (int j = 0; j < 4; ++j) a += uv[i + j] * wj[j];
              *(LAS unsigned*)(L + UCB + off_b(8 * w + i, lane >> 2) + (lane & 3) * 4) = pk2(a.x, a.y);
              *(LAS f32x2*)(L + UCF + ((8 * w + i) * 128 + 2 * lane) * 4) = a; } }
        __syncthreads();
        bf16x8 af[8]; float ucr[16];
#pragma unroll
        for (int ks = 0; ks < 8; ++ks) af[ks] = *(const LAS bf16x8*)(L + UCB + row_rd(lane, 32 * rt, ks));
#pragma unroll
        for (int r = 0; r < 16; ++r) ucr[r] = *(const LAS float*)(L + UCF + ((32 * rt + crow(r, h5)) * 128 + 32 * et + r32) * 4);
        const int chl = hd * 128 + 32 * et + r32;
#pragma unroll 1
        for (int dir = 0; dir < 2; ++dir) {
            f32x16 ga = {}, gx = {};
            { const bf16_t* wa = WG + ((size_t)(dir * 2 + 0) * 128 + 32 * et + r32) * 1024 + hd * 128 + 8 * h5; const bf16_t* wx = wa + (size_t)128 * 1024;
              bf16x8 fa[8], fx[8];
#pragma unroll
              for (int ks = 0; ks < 8; ++ks) { fa[ks] = *(const bf16x8*)(wa + 16 * ks); fx[ks] = *(const bf16x8*)(wx + 16 * ks); }
#pragma unroll
              for (int ks = 0; ks < 8; ++ks) { ga = __builtin_amdgcn_mfma_f32_32x32x16_bf16(af[ks], fa[ks], ga, 0, 0, 0); gx = __builtin_amdgcn_mfma_f32_32x32x16_bf16(af[ks], fx[ks], gx, 0, 0, 0); } }
            const float bav = ba[dir * DLRU + chl], bxv = bx[dir * DLRU + chl], sp = log1pf(__expf(-lam[dir * DLRU + chl]));
            if (dir == 1) __syncthreads();
#pragma unroll
            for (int r = 0; r < 16; ++r) { const float rg = __builtin_amdgcn_rcpf(1.0f + __expf(-(ga[r] + bav))), ig = __builtin_amdgcn_rcpf(1.0f + __expf(-(gx[r] + bxv)));
                const float la = -8.0f * rg * sp; const unsigned o = ((32 * rt + crow(r, h5)) * 128 + 32 * et + r32) * 4;
                *(LAS float*)(L + AT + o) = __expf(la); *(LAS float*)(L + BT + o) = __builtin_amdgcn_sqrtf(1.0f - __expf(2.0f * la)) * (ig * ucr[r]); }
            __syncthreads();
            { const int seg = tid >> 7, ch = tid & 127; const LAS float* ap = (const LAS float*)(L + AT) + ch; const LAS float* bp = (const LAS float*)(L + BT) + ch;
              LAS f32x2* sg4 = (LAS f32x2*)(L + SEGB);
              float h = 0.f, pr = 1.f;
#pragma unroll
              for (int i = 0; i < 16; ++i) { const int row = dir == 0 ? 16 * seg + i : 63 - 16 * seg - i; const float a = ap[row * 128]; h = a * h + bp[row * 128]; pr *= a; }
              sg4[seg * 128 + ch] = (f32x2){pr, h};
              __syncthreads();
              float cs = FINAL ? (dir == 0 ? cin0 : cin1) : 0.f, pa = 1.f;
#pragma unroll
              for (int q = 0; q < 3; ++q) if (q < seg) { const f32x2 t = sg4[q * 128 + ch]; cs = cs * t.x + t.y; pa *= t.x; }
              if (!FINAL) { if (seg == 3) { float* ag = AG + ((size_t)(ci2 * 2 + dir) * 2) * DLRU + hd * 128 + ch; ag[0] = pa * pr; ag[DLRU] = cs * pr + h; } }
              else { LAS float* hp = (LAS float*)(L + (dir == 0 ? UCF : AT)) + ch;
                  h = cs;
#pragma unroll
                  for (int i = 0; i < 16; ++i) { const int row = dir == 0 ? 16 * seg + i : 63 - 16 * seg - i; h = ap[row * 128] * h + bp[row * 128]; hp[row * 128] = h; } } }
        }
        if (FINAL) {
            __syncthreads();
            const int row = tid >> 3, c16 = (tid & 7) * 16; const bf16_t* gp = P + (R0 + row) * ABNP + hd * 128 + c16; bf16_t* yp = Y + (R0 + row) * DM + hd * 128 + c16;
            const u32x4 g0 = *(const u32x4*)gp, g1 = *(const u32x4*)(gp + 8); u32x4 o0, o1;
            const LAS f32x4* hf = (const LAS f32x4*)(L + UCF + (row * 128 + c16) * 4); const LAS f32x4* hb = (const LAS f32x4*)(L + AT + (row * 128 + c16) * 4);
#pragma unroll
            for (int q = 0; q < 4; ++q) { const f32x4 hs = hf[q] + hb[q]; const unsigned ga = q < 2 ? g0[2 * q] : g1[2 * q - 4], gb = q < 2 ? g0[2 * q + 1] : g1[2 * q - 3];
                const float y0 = hs.x * gelu_tanh(__uint_as_float(ga << 16)), y1 = hs.y * gelu_tanh(__uint_as_float(ga & 0xffff0000u)), y2 = hs.z * gelu_tanh(__uint_as_float(gb << 16)), y3 = hs.w * gelu_tanh(__uint_as_float(gb & 0xffff0000u));
                if (q < 2) { o0[2 * q] = pk2(y0, y1); o0[2 * q + 1] = pk2(y2, y3); } else { o1[2 * q - 4] = pk2(y0, y1); o1[2 * q - 3] = pk2(y2, y3); } }
            *(u32x4*)yp = o0; *(u32x4*)(yp + 8) = o1;
        }
    }
}
__device__ __forceinline__ void phase_lru_carry(const Ctx& C) {
    using namespace hg;
    const float* AG = WSP(float, WS_AG); float* CARRY = WSP(float, WS_CARRY);
    const int G = gridDim.x, first = G >= 8 ? G - 8 : 0;
    if ((int)blockIdx.x < first) return;
    for (int id = ((int)blockIdx.x - first) * 512 + C.tid; id < NBATCH * 2 * DLRU; id += (G - first) * 512) { const int b = id >> 11, dir = (id >> 10) & 1, ch = id & 1023;
        float carry = 0.f;
#pragma unroll 4
        for (int j = 0; j < NCH; ++j) { const int cc = dir == 0 ? j : (j < 4 ? 3 - j : 71 - j); const size_t ci2 = (size_t)b * NCH + cc;
            CARRY[(ci2 * 2 + dir) * DLRU + ch] = carry; const float* ag = AG + ((ci2 * 2 + dir) * 2) * DLRU + ch; carry = carry * ag[0] + ag[DLRU]; } }
}
__device__ __forceinline__ void phase_final(const Ctx& C) {
    const float* XS = WSP(float, WS_XS); const float* w = C.inp(27);
    for (int r = C.gw; r < NBATCH * SEQ; r += C.ngw) { const int b = r / SEQ, t = r % SEQ; const size_t R = (size_t)b * SROW + CTX + t;
        const f32x4* xr = (const f32x4*)(XS + R * DM) + C.lane; f32x4 v[8]; float ss = 0.f;
#pragma unroll
        for (int j = 0; j < 8; ++j) { v[j] = xr[64 * j]; ss += (v[j].x * v[j].x + v[j].y * v[j].y) + (v[j].z * v[j].z + v[j].w * v[j].w); }
        const float rstd = 1.0f / sqrtf(wave_sum(ss) * (1.0f / DM) + EPS);
        f32x4* o = (f32x4*)(C.out + (size_t)r * DM) + C.lane;
#pragma unroll
        for (int j = 0; j < 8; ++j) { const f32x4 wv = *(const f32x4*)(w + (C.lane + 64 * j) * 4); o[64 * j] = v[j] * rstd * wv; } }
}

struct Args { const float* in[28]; float* out; unsigned char* ws; int ph_lo, ph_hi; };
constexpr int N_PHASES = 1 + 2 * 9 + 2 * 8 + 1;

__global__ void __launch_bounds__(512, 2) fwd_kernel(Args args) {
    extern __shared__ __attribute__((aligned(16))) unsigned char lds_raw[];
    LAS unsigned char* const lds0 = (LAS unsigned char*)lds_raw;
    const unsigned long long inaddr = (unsigned long long)__builtin_amdgcn_kernarg_segment_ptr();
    volatile LAS unsigned* misc = (volatile LAS unsigned*)(lds0 + LDS_MISC);
    if (threadIdx.x < 64) misc[threadIdx.x] = 0u;
    __syncthreads();
    const int lo = args.ph_lo, hi = args.ph_hi;
    const int wave0 = __builtin_amdgcn_readfirstlane(threadIdx.x >> 6);
    XcdBarrier bar; bar.bar = (unsigned*)(args.ws + WS_CTL) + 4096; bar.x = 0; bar.st = misc + 8;
    if (hi - lo > 1) bar = xcd_barrier_post((unsigned*)(args.ws + WS_CTL) + 4096, misc + 8);
    int pid = 0;
    const unsigned long long wsaddr = (unsigned long long)args.ws;
#define PH_BEGIN if (pid >= lo && pid < hi) { int l = l_; Ctx C; { unsigned long long a_ = inaddr, w_ = wsaddr; int t_; asm volatile("v_mbcnt_lo_u32_b32 %0, -1, 0\n\tv_mbcnt_hi_u32_b32 %0, -1, %0" : "=v"(t_)); t_ += wave0 * 64; asm volatile("" : "+s"(a_), "+s"(w_), "+s"(l)); \
        C.in = (InPtr)a_; C.ws = (unsigned char*)(GAS unsigned char*)w_; C.out = (float*)(GAS float*)args.out; C.lds = lds0; C.tid = t_; C.lane = t_ & 63; C.wave = __builtin_amdgcn_readfirstlane(t_ >> 6); \
        C.gw = blockIdx.x * 8 + C.wave; C.ngw = gridDim.x * 8; C.gtid = blockIdx.x * 512 + t_; C.ngt = gridDim.x * 512; } \
        const int e = l >> 1; const float* mod = WSP(float, WS_MOD) + (size_t)l * 3 * MODW; const int G = gridDim.x, cb = blockIdx.x; (void)e; (void)mod; (void)G; (void)cb;
#define PH_END } if (pid >= lo && pid + 1 < hi) xcd_barrier(bar); ++pid;
#ifndef PROBE_CAT
#define PROBE_CAT -1
#endif
#define DUP(cat, ...) { if (PROBE_CAT == (cat)) { const float SC_ = 0.f; (void)SC_; __VA_ARGS__ } { const float SC_ = 1.f; (void)SC_; __VA_ARGS__ } }
    int l_ = 0;
    PH_BEGIN
#ifndef SKIP_PRO
    DUP(0, phase_prologue(C);)
#endif
    PH_END

    constexpr int MLAT = NBATCH * SEQ;
    for (l_ = 0; l_ < DEPTH; ++l_) {
        PH_BEGIN DUP(1, phase_norm_mod(C, C.inp(6) + l * DM, mod, 0, 1);) PH_END
        if ((l_ & 1) == 0) {
            PH_BEGIN DUP(2, { const bf16_t* wt = WSP(bf16_t, WS_WABIN) + (size_t)e * ABNP * DM;
                       { pg8::Gemm g{WSP(bf16_t, WS_H), wt, MLAT, ABNP, DM, DM, DM, 1}; pg8::StaticOrder S; S.init(MLAT, ABNP, G, cb); EpiBf16Plain E{WSP(bf16_t, WS_P), ABNP}; pg8::gemm_phase(C.lds, C.tid, g, S, E); }
                       DUP(14, { sg::SGemm g{WSP(bf16_t, WS_H), wt, ABNP, DM, DM, DM}; SEpiPlain E{WSP(bf16_t, WS_P), ABNP}; sg::sgemm_phase(C.lds, C.tid, g, 32 * (ABNP / 256), E); }) }) PH_END
            PH_BEGIN DUP(3, { phase_lru<false>(C, e); phase_rs_kr(C); }) PH_END
            PH_BEGIN phase_lru_carry(C); DUP(4, { const bf16_t* wq = WSP(bf16_t, WS_WUQ) + (size_t)e * QW * 512; const bf16_t* wkv = WSP(bf16_t, WS_WUKV) + (size_t)e * KVW * 512;
                       { pg8::Gemm g{WSP(bf16_t, WS_P) + 2048, wq, MLAT, QW, 512, ABNP, 512, 1}; pg8::StaticOrder S; S.init(MLAT, QW, G, cb); EpiBf16RowScale E{WSP(bf16_t, WS_Q), QW, WSP(float, WS_RSQ)}; pg8::gemm_phase(C.lds, C.tid, g, S, E); }
                       { pg8::Gemm g{WSP(bf16_t, WS_P) + 2560, wkv, MLAT, KVW, 512, ABNP, 512, 1}; pg8::StaticOrder S; S.init(MLAT, KVW, G, cb); EpiBf16RowScale E{WSP(bf16_t, WS_KV), KVW, WSP(float, WS_RSKV)}; pg8::gemm_phase(C.lds, C.tid, g, S, E); }
                       DUP(14, { sg::SGemm g{WSP(bf16_t, WS_P) + 2048, wq, QW, 512, ABNP, 512}; SEpiRowScale E{WSP(bf16_t, WS_Q), QW, WSP(float, WS_RSQ)}; sg::sgemm_phase(C.lds, C.tid, g, 32 * (QW / 256), E); })
                       DUP(14, { sg::SGemm g{WSP(bf16_t, WS_P) + 2560, wkv, KVW, 512, ABNP, 512}; SEpiRowScale E{WSP(bf16_t, WS_KV), KVW, WSP(float, WS_RSKV)}; sg::sgemm_phase(C.lds, C.tid, g, 0, E); }) })
            PH_END
            PH_BEGIN DUP(5, phase_lru<true>(C, e);) DUP(6, phase_attn(C);) PH_END
        } else {
            PH_BEGIN DUP(7, { const bf16_t* wt = WSP(bf16_t, WS_WHGIN) + (size_t)e * HGN * DM;
                       { pg8::Gemm g{WSP(bf16_t, WS_H), wt, MLAT, HGN, DM, DM, DM, 1}; pg8::StaticOrder S; S.init(MLAT, HGN, G, cb); EpiHG E{WSP(bf16_t, WS_QH), WSP(f16_t, WS_LOGF), WSP(float, WS_LB) + l * 2048}; pg8::gemm_phase(C.lds, C.tid, g, S, E); }
                       DUP(14, { sg::SGemm g{WSP(bf16_t, WS_H), wt, HGN, DM, DM, DM}; SEpiHG E{WSP(bf16_t, WS_QH), WSP(f16_t, WS_LOGF), WSP(float, WS_LB) + l * 2048}; sg::sgemm_phase(C.lds, C.tid, g, 32 * (HGN / 256), E); }) }) PH_END
            PH_BEGIN DUP(8, phase_hg_state(C);) PH_END
            PH_BEGIN DUP(10, phase_hg_out(C, e);) PH_END
        }
        PH_BEGIN DUP(11, { const bf16_t* wout = (l & 1) ? WSP(bf16_t, WS_WHGOUT) + (size_t)e * DM * DM : WSP(bf16_t, WS_WABOUT) + (size_t)e * DM * DM;
                   { pg8::Gemm g{WSP(bf16_t, WS_Y), wout, MLAT, DM, DM, DM, DM, 1}; pg8::StaticOrder S; S.init(MLAT, DM, G, cb); EpiResid E{WSP(float, WS_XS), mod + 2 * DM, SC_}; pg8::gemm_phase(C.lds, C.tid, g, S, E); }
                   if (l != DEPTH - 1) DUP(14, { sg::SGemm g{WSP(bf16_t, WS_Y), wout, DM, DM, DM, DM}; SEpiResid E{WSP(float, WS_XS), mod + 2 * DM, SC_}; sg::sgemm_phase(C.lds, C.tid, g, 32 * (DM / 256), E); }) }) PH_END
        PH_BEGIN DUP(1, phase_norm_mod(C, C.inp(7) + l * DM, mod, 3, 4);) PH_END
        PH_BEGIN DUP(12, { const bf16_t* wt = WSP(bf16_t, WS_W1) + (size_t)l * DFF * DM;
                   { pg8::Gemm g{WSP(bf16_t, WS_H), wt, MLAT, DFF, DM, DM, DM, 1}; pg8::StaticOrder S; S.init(MLAT, DFF, G, cb); EpiRelu2 E{WSP(bf16_t, WS_HID), DFF}; pg8::gemm_phase(C.lds, C.tid, g, S, E); }
                   if (l != DEPTH - 1) DUP(16, { sg::SGemm g{WSP(bf16_t, WS_H), wt, DFF, DM, DM, DM}; SEpiRelu2 E{WSP(bf16_t, WS_HID), DFF}; sg::sgemm_phase(C.lds, C.tid, g, 32 * (DFF / 256), E); }) }) PH_END
        PH_BEGIN DUP(13, { const bf16_t* wt = WSP(bf16_t, WS_W2) + (size_t)l * DM * DFF;
                   { pg8::Gemm g{WSP(bf16_t, WS_HID), wt, MLAT, DM, DFF, DFF, DFF, 1}; pg8::StaticOrder S; S.init(MLAT, DM, G, cb); EpiResid E{WSP(float, WS_XS), mod + 5 * DM, SC_}; pg8::gemm_phase(C.lds, C.tid, g, S, E); }
                   if (l != DEPTH - 1) DUP(15, { sg::SGemm g{WSP(bf16_t, WS_HID), wt, DM, DFF, DFF, DFF}; SEpiResid E{WSP(float, WS_XS), mod + 5 * DM, SC_}; sg::sgemm_phase(C.lds, C.tid, g, 32 * (DM / 256), E); }) }) PH_END
    }
    l_ = 0;
    PH_BEGIN phase_final(C); PH_END
}

#ifndef N_LAUNCH_MODE
#define N_LAUNCH_MODE 1
#endif
extern "C" void kernel_launch(void* const* d_in, const int* in_sizes, int n_in, void* d_out, int out_size, void* d_ws, size_t ws_size, hipStream_t stream) {
    static int grid = 0;
    if (grid == 0) {
        if (n_in != 28 || out_size != NBATCH * SEQ * DM || ws_size < WS_END) { fprintf(stderr, "kernel_launch: shape mismatch n_in %d out %d ws %zu (need %zu)\n", n_in, out_size, ws_size, (size_t)WS_END); grid = -1; return; }
        int dev = 0, cus = 0, per_cu = 0;
        if (hipGetDevice(&dev) != hipSuccess || hipDeviceGetAttribute(&cus, hipDeviceAttributeMultiprocessorCount, dev) != hipSuccess) { grid = -1; return; }
        if (hipFuncSetAttribute((const void*)fwd_kernel, hipFuncAttributeMaxDynamicSharedMemorySize, LDS_BYTES) != hipSuccess) { fprintf(stderr, "kernel_launch: hipFuncSetAttribute failed\n"); grid = -1; return; }
        if (hipOccupancyMaxActiveBlocksPerMultiprocessor(&per_cu, (const void*)fwd_kernel, 512, LDS_BYTES) != hipSuccess || per_cu < 1) fprintf(stderr, "kernel_launch: occupancy query says %d\n", per_cu);
        (void)hipGetLastError();
        grid = cus;
    }
    if (grid < 0) return;
    (void)hipMemsetAsync((char*)d_ws + WS_CTL, 0, CTL_BYTES, stream);
    Args a{};
    for (int i = 0; i < 28; ++i) a.in[i] = (const float*)d_in[i];
    a.out = (float*)d_out; a.ws = (unsigned char*)d_ws;
#if N_LAUNCH_MODE == 1
    a.ph_lo = 0; a.ph_hi = N_PHASES;
    hipLaunchKernelGGL(fwd_kernel, dim3(grid), dim3(512), LDS_BYTES, stream, a);
#else
    for (int p = 0; p < N_PHASES; ++p) { a.ph_lo = p; a.ph_hi = p + 1; hipLaunchKernelGGL(fwd_kernel, dim3(grid), dim3(512), LDS_BYTES, stream, a); }
#endif
    const hipError_t le = hipPeekAtLastError();
    if (le != hipSuccess) fprintf(stderr, "kernel_launch: launch failed: %s\n", hipGetErrorName(le));
}
```
